# Optimizing an MI355X kernel written in HIP

```python
import math
import jax
import jax.numpy as jnp
from jax import lax
import numpy as np

D_MODEL = 2048
BATCH = 4
SEQ = 4096
DEPTH = 2

F32 = jnp.float32
N_EVEN = (DEPTH + 1) // 2
N_ODD = DEPTH // 2

DN_ALPHA = (2.0 * DEPTH) ** 0.25
DN_BETA = (8.0 * DEPTH) ** -0.25
LN_EPS = 1e-5
RMS_EPS = 1e-6
NEG_INF = -1e30
MIX_WIDTH = D_MODEL

MLA_HEADS = 8
MLA_NOPE = 128
MLA_ROPE = 64
MLA_V = 128
MLA_QK = MLA_NOPE + MLA_ROPE
MLA_Q_RANK = 512
MLA_KV_RANK = 256
ROPE_THETA = 10000.0
Q_BLOCK = 128

S5_WIDTH = MIX_WIDTH - MLA_HEADS * MLA_V
S5_GROUP = 16
S5_GROUPS = S5_WIDTH // S5_GROUP
S5_STATE = 64
S5_DT_MIN = 1e-3
S5_DT_MAX = 1e-1
EVEN_IN = MLA_Q_RANK + MLA_KV_RANK + MLA_ROPE + S5_WIDTH

DIL_PATTERNS = ((128, 1), (512, 4), (2048, 16))
N_DIL = len(DIL_PATTERNS)
DIL_HEADS = 8
DIL_HEAD_DIM = 64
DIL_WIDTH = DIL_HEADS * DIL_HEAD_DIM
DIL_IN = N_DIL * 3 * DIL_WIDTH

T5_BUCKETS = 32
T5_MAX_DIST = 2048
T5_HEADS = N_DIL * DIL_HEADS

RW_WIDTH = MIX_WIDTH - DIL_WIDTH
RW_HEAD = 64
RW_HEADS = RW_WIDTH // RW_HEAD
RW_LORA_W = 64
RW_LORA_A = 64
RW_LORA_G = 224
RW_GN_EPS = 64e-5
RW_IN = 3 * RW_WIDTH + RW_LORA_W + RW_LORA_A + RW_LORA_G
RW_SPLITS = [RW_WIDTH, 2 * RW_WIDTH, 3 * RW_WIDTH, 3 * RW_WIDTH + RW_LORA_W, 3 * RW_WIDTH + RW_LORA_W + RW_LORA_A]
ODD_IN = DIL_IN + RW_IN

N_EXPERTS = 16
N_EXPERT_GROUPS = 4
EXPERTS_PER_GROUP = N_EXPERTS // N_EXPERT_GROUPS
TOP_K = 2
D_EXPERT = 512

kernel_name = "hybrid_mla_s5_dilated_rwkv7_moe"


def _layernorm(x, g, b):
    xf = x.astype(F32)
    mu = xf.mean(-1, keepdims=True)
    var = jnp.square(xf - mu).mean(-1, keepdims=True)
    return (xf - mu) * lax.rsqrt(var + LN_EPS) * g + b


def _rmsnorm(x, g):
    xf = x.astype(F32)
    return xf * lax.rsqrt(jnp.mean(xf * xf, -1, keepdims=True) + RMS_EPS) * g


def _rope_tables(seq):
    inv = ROPE_THETA ** (-jnp.arange(0, MLA_ROPE, 2, dtype=F32) / MLA_ROPE)
    ang = jnp.arange(seq, dtype=F32)[:, None] * inv[None]
    return jnp.cos(ang), jnp.sin(ang)


def _rope(x, cos, sin):
    x1, x2 = jnp.split(x.astype(F32), 2, axis=-1)
    return jnp.concatenate([x1 * cos - x2 * sin, x1 * sin + x2 * cos], axis=-1)


def _mla(q_c, kv_c, k_r, q_norm, w_uq, kv_norm, w_ukv):
    B_, S_, _ = q_c.shape
    q = (_rmsnorm(q_c, q_norm) @ w_uq).astype(F32).reshape(B_, S_, MLA_HEADS, MLA_QK)
    kv = (_rmsnorm(kv_c, kv_norm) @ w_ukv).astype(F32).reshape(B_, S_, MLA_HEADS, MLA_NOPE + MLA_V)
    cos, sin = _rope_tables(S_)
    q_nope = q[..., :MLA_NOPE]
    q_rope = _rope(q[..., MLA_NOPE:], cos[None, :, None], sin[None, :, None])
    k_rope = _rope(k_r, cos[None], sin[None])
    k_nope, v = kv[..., :MLA_NOPE], kv[..., MLA_NOPE:]
    scale = MLA_QK ** -0.5
    outs = []
    for i in range(S_ // Q_BLOCK):
        q0, q1 = i * Q_BLOCK, (i + 1) * Q_BLOCK
        s = (jnp.einsum('bqhc,bkhc->bhqk', q_nope[:, q0:q1], k_nope[:, :q1])
             + jnp.einsum('bqhr,bkr->bhqk', q_rope[:, q0:q1], k_rope[:, :q1])) * scale
        causal = jnp.arange(q1)[None, :] <= jnp.arange(q0, q1)[:, None]
        p = jax.nn.softmax(jnp.where(causal, s, NEG_INF), axis=-1)
        outs.append(jnp.einsum('bhqk,bkhd->bqhd', p, v[:, :q1]))
    return jnp.concatenate(outs, axis=1).reshape(B_, S_, MLA_HEADS * MLA_V)


def _lin_rec(left, right):
    a_l, b_l = left
    a_r, b_r = right
    return a_l * a_r, a_r * b_l + b_r


def _s5(u, lam_re, lam_im, b_re, b_im, c_re, c_im, d_skip, log_dt, w_glu):
    B_, S_, _ = u.shape
    uf = u.astype(F32).reshape(B_, S_, S5_GROUPS, S5_GROUP)
    lam = lax.complex(lam_re.astype(F32), lam_im.astype(F32))
    dt = jnp.exp(log_dt.astype(F32))[:, None]
    lam_bar = jnp.exp(lam * dt)
    b_bar = ((lam_bar - 1.0) / lam)[..., None] * lax.complex(b_re.astype(F32), b_im.astype(F32))
    bu = jnp.einsum('bsgc,gpc->bsgp', uf.astype(jnp.complex64), b_bar)
    a = jnp.broadcast_to(lam_bar[None, None], (1, S_, S5_GROUPS, S5_STATE))
    _, states = lax.associative_scan(_lin_rec, (a, bu), axis=1)
    c = lax.complex(c_re.astype(F32), c_im.astype(F32))
    y = jnp.einsum('bsgp,gcp->bsgc', states, c).real + d_skip.astype(F32) * uf
    y = jax.nn.gelu(y.reshape(B_, S_, S5_WIDTH))
    return y * jax.nn.sigmoid(y @ w_glu)


def _t5_bucket(dist):
    exact = T5_BUCKETS // 2
    logd = jnp.log(jnp.maximum(dist, 1).astype(F32) / exact) / math.log(T5_MAX_DIST / exact)
    large = jnp.minimum(exact + (logd * (T5_BUCKETS - exact)).astype(jnp.int32), T5_BUCKETS - 1)
    return jnp.where(dist < exact, dist, large)


def _dilated_branch(q, k, v, bias_tab, dil, span):
    B_, S_, H, Dh = q.shape
    L = S_ // dil
    nb = -(-L // span)
    Lp = nb * span

    def streams(t):
        return t.reshape(B_, L, dil, H, Dh).transpose(0, 2, 1, 3, 4)

    qb = jnp.pad(streams(q), ((0, 0), (0, 0), (0, Lp - L), (0, 0), (0, 0))).reshape(B_, dil, nb, span, H, Dh)

    def band_blocks(t):
        t = jnp.pad(streams(t), ((0, 0), (0, 0), (span, Lp - L), (0, 0), (0, 0))).reshape(B_, dil, nb + 1, span, H, Dh)
        return jnp.concatenate([t[:, :, :-1], t[:, :, 1:]], axis=3)

    kb, vb = band_blocks(k), band_blocks(v)
    qi = jnp.arange(span)[:, None]
    ku = jnp.arange(2 * span)[None, :]
    delta = span + qi - ku
    key_pos = (jnp.arange(nb)[:, None, None] - 1) * span + ku[None]
    valid = ((delta >= 0) & (delta <= span))[None] & (key_pos >= 0)
    bias = bias_tab.astype(F32)[_t5_bucket(jnp.clip(delta, 0, span) * dil)]
    s = jnp.einsum('bgnihc,bgnuhc->bgnihu', qb, kb) * (Dh ** -0.5) + bias.transpose(0, 2, 1)[None, None, None]
    s = jnp.where(valid[None, None, :, :, None, :], s, NEG_INF)
    m = s.max(-1)
    p = jnp.exp(s - m[..., None])
    l = p.sum(-1)
    acc = jnp.einsum('bgnihu,bgnuhc->bgnihc', p, vb)

    def unstream(t):
        t = t.reshape(B_, dil, Lp, *t.shape[4:])[:, :, :L]
        return jnp.swapaxes(t, 1, 2).reshape(B_, S_, *t.shape[3:])

    return unstream(acc), unstream(m), unstream(l)


def _dilated_mixture(zc, rel_bias):
    B_, S_, _ = zc.shape
    z = zc.astype(F32).reshape(B_, S_, N_DIL, 3, DIL_HEADS, DIL_HEAD_DIM)
    accs, ms, ls = [], [], []
    for gi, (win, dil) in enumerate(DIL_PATTERNS):
        acc, m, l = _dilated_branch(z[:, :, gi, 0], z[:, :, gi, 1], z[:, :, gi, 2],
                                    rel_bias[:, gi * DIL_HEADS:(gi + 1) * DIL_HEADS], dil, win // dil)
        accs.append(acc)
        ms.append(m)
        ls.append(l)
    m_all = jnp.stack(ms)
    wts = jnp.exp(m_all - m_all.max(0))
    num = sum(wts[i][..., None] * accs[i] for i in range(N_DIL))
    den = (wts * jnp.stack(ls)).sum(0)
    return (num / den[..., None]).reshape(B_, S_, DIL_WIDTH)


def _rwkv7(zr, mu, w0, w2, a0, a2, g2, k_k, k_a, r_k, lnx_g, lnx_b):
    B_, S_, _ = zr.shape
    zf = zr.astype(F32)
    prev = jnp.pad(zf[:, :-1], ((0, 0), (1, 0), (0, 0)))
    xs = zf + (prev - zf) * mu
    r, k, v, wd, ad, gd = jnp.split(xs, RW_SPLITS, axis=-1)
    w_log = -jax.nn.softplus(-(w0 + jnp.tanh(wd) @ w2)) - 0.5
    decay = jnp.exp(-jnp.exp(w_log))
    a = jax.nn.sigmoid(a0 + ad @ a2)
    g = jax.nn.sigmoid(gd) @ g2

    def heads(t):
        return t.reshape(B_, S_, RW_HEADS, RW_HEAD)

    kk = heads(k * k_k)
    kk = kk / jnp.maximum(jnp.sqrt(jnp.sum(kk * kk, -1, keepdims=True)), 1e-12)
    k = k * (1.0 + (a - 1.0) * k_a)
    r_h, k_h, v_h, w_h, a_h = heads(r), heads(k), heads(v), heads(decay), heads(a)
    b_h = kk * a_h

    def step(state, inp):
        rt, wt, kt, vt, at, bt = inp
        sa = jnp.einsum('bhij,bhj->bhi', state, at)
        state = state * wt[:, :, None, :] + sa[..., None] * bt[:, :, None, :] + vt[..., None] * kt[:, :, None, :]
        return state, jnp.einsum('bhij,bhj->bhi', state, rt)

    init = jnp.zeros((B_, RW_HEADS, RW_HEAD, RW_HEAD), F32)
    seq = (r_h, w_h, k_h, v_h, -kk, b_h)
    _, y = lax.scan(step, init, tuple(jnp.moveaxis(t, 1, 0) for t in seq))
    y = jnp.moveaxis(y, 0, 1)
    mean = y.mean(-1, keepdims=True)
    var = jnp.square(y - mean).mean(-1, keepdims=True)
    y = ((y - mean) * lax.rsqrt(var + RW_GN_EPS)).reshape(B_, S_, RW_WIDTH) * lnx_g + lnx_b
    bonus = jnp.sum(r_h * k_h * r_k, -1, keepdims=True) * v_h
    y = y + bonus.reshape(B_, S_, RW_WIDTH)
    return y * g


def _moe(h, router_w, router_b, w_gate_up, w_down):
    B_, S_, D = h.shape
    t = h.reshape(B_ * S_, D)
    s = jax.nn.sigmoid((t @ router_w).astype(F32))
    sb = s + router_b.astype(F32)
    sbg = sb.reshape(-1, N_EXPERT_GROUPS, EXPERTS_PER_GROUP)
    gscore = lax.top_k(sbg, TOP_K)[0].sum(-1)
    gmask = jax.nn.one_hot(jnp.argmax(gscore, -1), N_EXPERT_GROUPS, dtype=F32)
    masked = jnp.where(gmask[..., None] > 0, sbg, NEG_INF).reshape(-1, N_EXPERTS)
    _, eidx = lax.top_k(masked, TOP_K)
    s_sel = jnp.take_along_axis(s, eidx, axis=1)
    gw = s_sel / s_sel.sum(-1, keepdims=True)
    gates = (jax.nn.one_hot(eidx, N_EXPERTS, dtype=F32) * gw[..., None]).sum(1)
    y = jnp.zeros((B_ * S_, D), F32)
    for e in range(N_EXPERTS):
        gt, up = jnp.split(t @ w_gate_up[e], 2, axis=-1)
        y = y + gates[:, e:e + 1] * ((jax.nn.silu(gt) * up) @ w_down[e])
    return y.reshape(B_, S_, D)


def setup_inputs(seed: int = 0) -> dict:
    key = jax.random.key(seed)
    ks = iter(jax.random.split(key, 64))
    D = D_MODEL

    def nrm(shape, scale):
        return jax.random.normal(next(ks), shape, F32) * scale

    def gain(shape):
        return 1.0 + nrm(shape, 0.01)

    def unif(shape, lo, hi):
        return jax.random.uniform(next(ks), shape, F32, minval=lo, maxval=hi)

    return {
        "x": nrm((BATCH, SEQ, D), 1.0),
        "c": nrm((BATCH, D), 1.0),
        "ada_w": nrm((DEPTH, D, 6 * D), 0.1 * D ** -0.5),
        "ada_b": nrm((DEPTH, 6 * D), 0.01),
        "ln_mix_g": gain((DEPTH, D)),
        "ln_mix_b": nrm((DEPTH, D), 0.01),
        "ln_ffn_g": gain((DEPTH, D)),
        "ln_ffn_b": nrm((DEPTH, D), 0.01),
        "router_w": nrm((D, N_EXPERTS), D ** -0.5),
        "router_b": nrm((N_EXPERTS,), 0.01),
        "moe_w_gate_up": nrm((DEPTH, N_EXPERTS, D, 2 * D_EXPERT), D ** -0.5),
        "moe_w_down": nrm((DEPTH, N_EXPERTS, D_EXPERT, D), DN_BETA * D_EXPERT ** -0.5),
        "rel_bias": nrm((T5_BUCKETS, T5_HEADS), 0.5),
        "ev_w_in": nrm((N_EVEN, D, EVEN_IN), D ** -0.5),
        "mla_q_norm": gain((N_EVEN, MLA_Q_RANK)),
        "mla_w_uq": nrm((N_EVEN, MLA_Q_RANK, MLA_HEADS * MLA_QK), MLA_Q_RANK ** -0.5),
        "mla_kv_norm": gain((N_EVEN, MLA_KV_RANK)),
        "mla_w_ukv": nrm((N_EVEN, MLA_KV_RANK, MLA_HEADS * (MLA_NOPE + MLA_V)), MLA_KV_RANK ** -0.5),
        "s5_lambda_re": -0.5 + nrm((N_EVEN, S5_GROUPS, S5_STATE), 0.01),
        "s5_lambda_im": jnp.tile(jnp.pi * jnp.arange(S5_STATE, dtype=F32), (N_EVEN, S5_GROUPS, 1)),
        "s5_b_re": nrm((N_EVEN, S5_GROUPS, S5_STATE, S5_GROUP), (2 * S5_GROUP) ** -0.5),
        "s5_b_im": nrm((N_EVEN, S5_GROUPS, S5_STATE, S5_GROUP), (2 * S5_GROUP) ** -0.5),
        "s5_c_re": nrm((N_EVEN, S5_GROUPS, S5_GROUP, S5_STATE), S5_STATE ** -0.5),
        "s5_c_im": nrm((N_EVEN, S5_GROUPS, S5_GROUP, S5_STATE), S5_STATE ** -0.5),
        "s5_d": nrm((N_EVEN, S5_GROUPS, S5_GROUP), 1.0),
        "s5_log_dt": unif((N_EVEN, S5_GROUPS), math.log(S5_DT_MIN), math.log(S5_DT_MAX)),
        "s5_w_glu": nrm((N_EVEN, S5_WIDTH, S5_WIDTH), S5_WIDTH ** -0.5),
        "ev_w_out": nrm((N_EVEN, MIX_WIDTH, D), DN_BETA * MIX_WIDTH ** -0.5),
        "od_w_in": nrm((N_ODD, D, ODD_IN), D ** -0.5),
        "rw_mu": unif((N_ODD, RW_IN), 0.0, 1.0),
        "rw_w0": unif((N_ODD, RW_WIDTH), -5.0, 1.0),
        "rw_w2": nrm((N_ODD, RW_LORA_W, RW_WIDTH), 0.1 * RW_LORA_W ** -0.5),
        "rw_a0": nrm((N_ODD, RW_WIDTH), 0.1),
        "rw_a2": nrm((N_ODD, RW_LORA_A, RW_WIDTH), 0.1 * RW_LORA_A ** -0.5),
        "rw_g2": nrm((N_ODD, RW_LORA_G, RW_WIDTH), RW_LORA_G ** -0.5),
        "rw_k_k": 0.85 + nrm((N_ODD, RW_WIDTH), 0.05),
        "rw_k_a": gain((N_ODD, RW_WIDTH)),
        "rw_r_k": nrm((N_ODD, RW_HEADS, RW_HEAD), 0.1),
        "rw_lnx_g": gain((N_ODD, RW_WIDTH)),
        "rw_lnx_b": nrm((N_ODD, RW_WIDTH), 0.01),
        "od_w_out": nrm((N_ODD, MIX_WIDTH, D), DN_BETA * MIX_WIDTH ** -0.5),
    }


def reference(x, c, ada_w, ada_b, ln_mix_g, ln_mix_b, ln_ffn_g, ln_ffn_b, router_w, router_b,
              moe_w_gate_up, moe_w_down, rel_bias, ev_w_in, mla_q_norm, mla_w_uq, mla_kv_norm, mla_w_ukv,
              s5_lambda_re, s5_lambda_im, s5_b_re, s5_b_im, s5_c_re, s5_c_im, s5_d, s5_log_dt, s5_w_glu,
              ev_w_out, od_w_in, rw_mu, rw_w0, rw_w2, rw_a0, rw_a2, rw_g2, rw_k_k, rw_k_a, rw_r_k,
              rw_lnx_g, rw_lnx_b, od_w_out):
    dt = x.dtype
    cond = jax.nn.silu(c.astype(F32))
    q_split = [MLA_Q_RANK, MLA_Q_RANK + MLA_KV_RANK, MLA_Q_RANK + MLA_KV_RANK + MLA_ROPE]
    for layer in range(DEPTH):
        mod = (cond @ ada_w[layer] + ada_b[layer])[:, None, :]
        sh_m, sc_m, g_m, sh_f, sc_f, g_f = jnp.split(mod, 6, axis=-1)
        h = (x * (1.0 + sc_m) + sh_m).astype(dt)
        if layer % 2 == 0:
            e = layer // 2
            q_c, kv_c, k_r, u = jnp.split(h @ ev_w_in[e], q_split, axis=-1)
            att = _mla(q_c, kv_c, k_r, mla_q_norm[e], mla_w_uq[e], mla_kv_norm[e], mla_w_ukv[e])
            ssm = _s5(u, s5_lambda_re[e], s5_lambda_im[e], s5_b_re[e], s5_b_im[e], s5_c_re[e], s5_c_im[e],
                      s5_d[e], s5_log_dt[e], s5_w_glu[e])
            y = jnp.concatenate([att, ssm], axis=-1).astype(dt) @ ev_w_out[e]
        else:
            o = layer // 2
            z = h @ od_w_in[o]
            att = _dilated_mixture(z[..., :DIL_IN], rel_bias)
            tm = _rwkv7(z[..., DIL_IN:], rw_mu[o], rw_w0[o], rw_w2[o], rw_a0[o], rw_a2[o], rw_g2[o],
                        rw_k_k[o], rw_k_a[o], rw_r_k[o], rw_lnx_g[o], rw_lnx_b[o])
            y = jnp.concatenate([att, tm], axis=-1).astype(dt) @ od_w_out[o]
        x = _layernorm(DN_ALPHA * x + (1.0 + g_m) * y, ln_mix_g[layer], ln_mix_b[layer]).astype(dt)
        h = (x * (1.0 + sc_f) + sh_f).astype(dt)
        y = _moe(h, router_w, router_b, moe_w_gate_up[layer], moe_w_down[layer])
        x = _layernorm(DN_ALPHA * x + (1.0 + g_f) * y, ln_ffn_g[layer], ln_ffn_b[layer]).astype(dt)
    return x
```

```cpp
#include <hip/hip_runtime.h>
#include <cstdio>
#include <cstdint>

#ifndef N_LAUNCH_MODE
#define N_LAUNCH_MODE 0
#endif
#ifndef CHK
#define CHK 0
#endif

#define GAS __attribute__((address_space(1)))
#define LAS __attribute__((address_space(3)))
typedef unsigned short bf16;
typedef short bf16x8 __attribute__((ext_vector_type(8)));
typedef short s16x4 __attribute__((ext_vector_type(4)));
typedef float f32x4 __attribute__((ext_vector_type(4)));
typedef float f32x16 __attribute__((ext_vector_type(16)));
typedef float f32x2 __attribute__((ext_vector_type(2)));
typedef unsigned u32x4 __attribute__((ext_vector_type(4)));
typedef unsigned u32x2 __attribute__((ext_vector_type(2)));
#define DI __device__ __forceinline__

constexpr int D = 2048, NB = 4, SEQ = 4096, T = NB * SEQ;
constexpr float LN_EPS = 1e-5f, RMS_EPS = 1e-6f;
constexpr float DN_ALPHA = 1.41421356237f;
constexpr int EVEN_IN = 1856, ODD_IN = 9568, DIL_IN = 4608, RW_IN = 4960, RWW = 1536;
constexpr int NEXP = 16, DEXP = 512;

typedef __bf16 bf16x2_t __attribute__((ext_vector_type(2)));
DI unsigned pk2(float lo, float hi) { f32x2 v = {lo, hi}; bf16x2_t r = __builtin_convertvector(v, bf16x2_t); return __builtin_bit_cast(unsigned, r); }
DI float bf2f(bf16 b) { return __uint_as_float(((unsigned)b) << 16); }
DI float bflo(unsigned u) { return __uint_as_float(u << 16); }
DI float bfhi(unsigned u) { return __uint_as_float(u & 0xffff0000u); }
DI bf16 f2bf(float f) { unsigned u = __float_as_uint(f); u += 0x7fffu + ((u >> 16) & 1u); return (bf16)(u >> 16); }
DI float wave_sum(float v) {
#pragma unroll
    for (int o = 1; o < 64; o <<= 1) v += __shfl_xor(v, o);
    return v;
}
DI unsigned char* wsl(unsigned char* p) { asm volatile("" : "+s"(p)); return p; }
DI int lane_id() { return (int)__builtin_amdgcn_mbcnt_hi(~0u, __builtin_amdgcn_mbcnt_lo(~0u, 0u)); }
DI int otid(int wv) { int t = wv * 64 + lane_id(); asm volatile("" : "+v"(t)); return t; }
DI float sigmoidf_(float x) { return 1.f / (1.f + __expf(-x)); }

namespace pg8 {
constexpr int BM = 256, BK = 64, HALF = 128, HTB = HALF * BK * 2, STAGE_BYTES = 8 * HTB, NXCD = 8, WGM = 8;
__host__ __device__ __forceinline__ int lds_byte(int r, int c) { const int st = (r >> 4) * 2 + (c >> 5), rr = r & 15, cc = c & 31, ob = rr * 64 + cc * 2; return st * 1024 + (ob ^ (((ob >> 9) & 1) << 5)); }
__host__ __device__ __forceinline__ void stage_rc(int b, int& R, int& C) { const int st = b / 1024, sb = b % 1024, swz = sb ^ (((sb >> 9) & 1) << 5); R = (st >> 1) * 16 + swz / 64; C = (st & 1) * 32 + (swz % 64) / 2; }
__host__ __device__ __forceinline__ int perm32(int rho) { const int n = rho >> 4, i = rho & 15; return 8 * (i >> 2) + 4 * n + (i & 3); }

struct Unit { int pm, pn, aux; };
struct Gemm { const bf16* A; const bf16* Bt; int lda, ldb, K; };

struct StaticOrder {
    int nM, nN, nwg, G, c;
    __host__ __device__ void init(int M, int N, int G_, int c_) { nM = M / BM; nN = N / BM; nwg = nM * nN; G = G_; c = c_; }
    __host__ __device__ bool next(int i, Unit& u) const {
        const long L = (long)i * G + c; if (L >= nwg) return false;
        int wgid = (int)L; { const int q = nwg / NXCD, r = nwg % NXCD, xcd = wgid % NXCD, off = wgid / NXCD; wgid = (xcd < r ? xcd * (q + 1) : r * (q + 1) + (xcd - r) * q) + off; }
        const int nig = WGM * nN, gid = wgid / nig, fm = gid * WGM, gsz = (nM - fm) < WGM ? (nM - fm) : WGM;
        u.pm = fm + ((wgid % nig) % gsz); u.pn = (wgid % nig) / gsz; u.aux = 0; return true;
    }
    __device__ __forceinline__ int arow(const Unit&, int) const { return 0; }
};

template <class Epi, class Sched, bool GATHER>
__device__ __forceinline__ void gemm_phase(LAS unsigned char* lds, const Gemm g, const Sched& S, const Epi& E, int wv) {
    const int tid = otid(wv), wid = __builtin_amdgcn_readfirstlane(tid >> 6), lane = tid & 63, wr = wid >> 2, wc = wid & 3, fr = lane & 15, fq = lane >> 4;
    int K = g.K; asm volatile("" : "+s"(K));
    const int nt = K / BK;
    unsigned voffB[2], vA0[2], vA1[2], nA0[2], nA1[2]; int Rr[2], Cc[2];
#pragma unroll
    for (int i = 0; i < 2; ++i) { int R, C; stage_rc(tid * 16 + i * 8192, R, C); const int Rb = Epi::PERM ? ((R & ~31) + perm32(R & 31)) : R;
        Rr[i] = R; Cc[i] = C; voffB[i] = (unsigned)(Rb * g.ldb + C) * 2u;
        vA0[i] = (unsigned)(R * g.lda + C) * 2u; vA1[i] = (unsigned)((R + HALF) * g.lda + C) * 2u; nA0[i] = vA0[i]; nA1[i] = vA1[i]; }
    const size_t kstep = (size_t)(BK * 2);
    const size_t hstepB = (size_t)HALF * g.ldb * 2, tstepB = 2 * hstepB, tstepA = (size_t)BM * g.lda * 2;
    const unsigned ldsw = (unsigned)wid * 1024u;
    const int aoff = lds_byte(wr * 64 + fr, fq * 8), boff = lds_byte(wc * 32 + fr, fq * 8);
#define PG8_SA(b, h) (((b) * 2 + (h)) * HTB)
#define PG8_SB(b, h) ((4 + (b) * 2 + (h)) * HTB)
#define PG8_STAGE(bufoff, gbase, voff) do { _Pragma("unroll") for (int _i = 0; _i < 2; ++_i) \
        __builtin_amdgcn_global_load_lds((const unsigned*)((const char*)(gbase) + (voff)[_i]), (LAS unsigned*)(lds + (bufoff) + ldsw + _i * 8192), 16, 0, 0); } while (0)
#define PG8_LDA(dst, b, h) do { _Pragma("unroll") for (int m = 0; m < 4; ++m) _Pragma("unroll") for (int k = 0; k < 2; ++k) dst[m][k] = *(const LAS bf16x8*)(lds + PG8_SA(b, h) + aoff + m * 2048 + k * 1024); } while (0)
#define PG8_LDB(dst, b, h) do { _Pragma("unroll") for (int n = 0; n < 2; ++n) _Pragma("unroll") for (int k = 0; k < 2; ++k) dst[n][k] = *(const LAS bf16x8*)(lds + PG8_SB(b, h) + boff + n * 2048 + k * 1024); } while (0)
#define PG8_MMA(ai, bj, At, Bt) do { __builtin_amdgcn_s_setprio(1); _Pragma("unroll") for (int m = 0; m < 4; ++m) _Pragma("unroll") for (int n = 0; n < 2; ++n) _Pragma("unroll") for (int k = 0; k < 2; ++k) \
        acc[ai][bj][m][n] = __builtin_amdgcn_mfma_f32_16x16x32_bf16(Bt[n][k], At[m][k], acc[ai][bj][m][n], 0, 0, 0); __builtin_amdgcn_s_setprio(0); } while (0)
#define PG8_WAIT_V(n) asm volatile("s_waitcnt vmcnt(" #n ")" ::: "memory")
#define PG8_WAIT_L(n) asm volatile("s_waitcnt lgkmcnt(" #n ")" ::: "memory")
#define PG8_BAR __builtin_amdgcn_s_barrier()
#define PG8_SCHED __builtin_amdgcn_sched_barrier(0)
    Unit cur, nxt; int ui = 0;
    if (!S.next(0, cur)) return;
    f32x4 acc[2][2][4][2];
#pragma unroll
    for (int a = 0; a < 2; ++a)
#pragma unroll
        for (int b = 0; b < 2; ++b)
#pragma unroll
            for (int m = 0; m < 4; ++m)
#pragma unroll
                for (int n = 0; n < 2; ++n) acc[a][b][m][n] = (f32x4){0.f, 0.f, 0.f, 0.f};
    bf16x8 At[4][2], B0[2][2], B1[2][2];
    const char* cA = GATHER ? (const char*)g.A : (const char*)g.A + (size_t)cur.pm * tstepA;
    const char* cB = (const char*)g.Bt + (size_t)cur.pn * tstepB;
    if (GATHER) {
#pragma unroll
        for (int i = 0; i < 2; ++i) { vA0[i] = (unsigned)(S.arow(cur, Rr[i]) * g.lda + Cc[i]) * 2u; vA1[i] = (unsigned)(S.arow(cur, Rr[i] + HALF) * g.lda + Cc[i]) * 2u; nA0[i] = vA0[i]; nA1[i] = vA1[i]; } }
    PG8_STAGE(PG8_SB(0, 0), cB, voffB); PG8_STAGE(PG8_SA(0, 0), cA, vA0); PG8_STAGE(PG8_SB(0, 1), cB + hstepB, voffB); PG8_STAGE(PG8_SA(0, 1), cA, vA1);
    if (wr == 1) PG8_BAR;
    PG8_WAIT_V(4); PG8_BAR;
    PG8_STAGE(PG8_SB(1, 0), cB + kstep, voffB); PG8_STAGE(PG8_SA(1, 0), cA + kstep, vA0); PG8_STAGE(PG8_SB(1, 1), cB + hstepB + kstep, voffB);
    PG8_WAIT_V(6); PG8_BAR;
    for (;;) {
        const bool has_next = S.next(ui + 1, nxt);
        const char* nAp = GATHER ? cA : (has_next ? (const char*)g.A + (size_t)nxt.pm * tstepA : cA);
        const char* nB = has_next ? (const char*)g.Bt + (size_t)nxt.pn * tstepB : cB;
        if (GATHER) {
#pragma unroll
            for (int i = 0; i < 2; ++i) { nA0[i] = vA0[i]; nA1[i] = vA1[i]; } }
        for (int t = 0; t < nt; t += 2) {
            const bool last = (t == nt - 2);
            if (GATHER && has_next && t == (nt >= 4 ? nt - 4 : 0)) {
#pragma unroll
                for (int i = 0; i < 2; ++i) { nA0[i] = (unsigned)(S.arow(nxt, Rr[i]) * g.lda + Cc[i]) * 2u; nA1[i] = (unsigned)(S.arow(nxt, Rr[i] + HALF) * g.lda + Cc[i]) * 2u; } }
            const char* a1 = cA + (size_t)(t + 1) * kstep;
            const char* a2 = last ? nAp : cA + (size_t)(t + 2) * kstep; const char* b2 = last ? nB : cB + (size_t)(t + 2) * kstep;
            const char* a3 = a2 + kstep; const char* b3 = b2 + kstep;
            unsigned w0[2], w1[2];
#pragma unroll
            for (int i = 0; i < 2; ++i) { w0[i] = (GATHER && last) ? nA0[i] : vA0[i]; w1[i] = (GATHER && last) ? nA1[i] : vA1[i]; }
            PG8_LDB(B0, 0, 0); PG8_SCHED; PG8_LDA(At, 0, 0); PG8_STAGE(PG8_SA(1, 1), a1, vA1);
            PG8_WAIT_L(8); PG8_BAR; PG8_WAIT_L(0); PG8_MMA(0, 0, At, B0); PG8_BAR; PG8_SCHED;
            PG8_LDB(B1, 0, 1); PG8_STAGE(PG8_SB(0, 0), b2, voffB);
            PG8_BAR; PG8_WAIT_L(0); PG8_MMA(0, 1, At, B1); PG8_BAR;
            PG8_LDA(At, 0, 1); PG8_STAGE(PG8_SA(0, 0), a2, w0);
            PG8_BAR; PG8_WAIT_L(0); PG8_MMA(1, 0, At, B0); PG8_BAR; PG8_SCHED;
            PG8_STAGE(PG8_SB(0, 1), b2 + hstepB, voffB);
            PG8_WAIT_V(6); PG8_BAR; PG8_MMA(1, 1, At, B1); PG8_BAR;
            PG8_LDB(B0, 1, 0); PG8_SCHED; PG8_LDA(At, 1, 0); PG8_STAGE(PG8_SA(0, 1), a2, w1);
            PG8_WAIT_L(8); PG8_BAR; PG8_WAIT_L(0); PG8_MMA(0, 0, At, B0); PG8_BAR; PG8_SCHED;
            PG8_LDB(B1, 1, 1); PG8_STAGE(PG8_SB(1, 0), b3, voffB);
            PG8_BAR; PG8_WAIT_L(0); PG8_MMA(0, 1, At, B1); PG8_BAR;
            PG8_LDA(At, 1, 1); PG8_STAGE(PG8_SA(1, 0), a3, w0);
            PG8_BAR; PG8_WAIT_L(0); PG8_MMA(1, 0, At, B0); PG8_BAR; PG8_SCHED;
            PG8_STAGE(PG8_SB(1, 1), b3 + hstepB, voffB);
            PG8_WAIT_V(6); PG8_BAR; PG8_MMA(1, 1, At, B1); PG8_BAR;
        }
        { int frr = fr, fqq = fq; asm volatile("" : "+v"(frr), "+v"(fqq));
          E(acc, cur, wr, wc, frr, fqq); }
        if (!has_next) break;
#pragma unroll
        for (int a = 0; a < 2; ++a)
#pragma unroll
            for (int b = 0; b < 2; ++b)
#pragma unroll
                for (int m = 0; m < 4; ++m)
#pragma unroll
                    for (int n = 0; n < 2; ++n) acc[a][b][m][n] = (f32x4){0.f, 0.f, 0.f, 0.f};
        cur = nxt; cA = nAp; cB = nB; ++ui;
        if (GATHER) {
#pragma unroll
            for (int i = 0; i < 2; ++i) { vA0[i] = nA0[i]; vA1[i] = nA1[i]; } }
    }
    PG8_WAIT_V(0);
    if (wr == 0) PG8_BAR;
    PG8_BAR;
#undef PG8_SA
#undef PG8_SB
#undef PG8_STAGE
#undef PG8_LDA
#undef PG8_LDB
#undef PG8_MMA
#undef PG8_WAIT_V
#undef PG8_WAIT_L
#undef PG8_BAR
#undef PG8_SCHED
}
}

#define XB_TMO      128
#define XB_XCNT(j)  (256  + 64 * (j))
#define XB_XSUB(j)  (1280 + 64 * (j))
#define XB_XGEN(j)  (2304 + 64 * (j))
#define XB_TOP      3328
#define XB_TOPGEN   3392
#define XCD_BAR_WORDS 3456
#define XB_SPIN_CAP (1u << 18)
__device__ __forceinline__ unsigned xb_ld(unsigned* p)              { return __hip_atomic_load(p, __ATOMIC_RELAXED, __HIP_MEMORY_SCOPE_AGENT); }
__device__ __forceinline__ unsigned xb_add(unsigned* p, unsigned v) { return __hip_atomic_fetch_add(p, v, __ATOMIC_RELAXED, __HIP_MEMORY_SCOPE_AGENT); }
__device__ __forceinline__ unsigned xb_xcc_id() { return (unsigned)__builtin_amdgcn_s_getreg((3 << 11) | 20) & 0xFu; }
#define XB_SPIN(cond, bar) do { unsigned _sp = 0; while (cond) { __builtin_amdgcn_s_sleep(1); \
    if ((++_sp & 255u) == 0u) { if (xb_ld(&(bar)[XB_TMO])) break; if (_sp > XB_SPIN_CAP) { atomicAdd(&(bar)[XB_TMO], 1u); break; } } } } while (0)
struct XcdBarrier { unsigned* bar; unsigned x; volatile LAS unsigned* st; int wv; };
__device__ __forceinline__ XcdBarrier xcd_barrier_post(unsigned* bar, volatile LAS unsigned* st, int wv) {
    XcdBarrier b; b.bar = bar; b.x = xb_xcc_id(); b.st = st; b.wv = wv;
    if (wv == 0 && lane_id() == 0) (void)xb_add(&bar[XB_XCNT(b.x)], 1u);
    return b;
}
__device__ __forceinline__ void xcd_barrier_complete(unsigned* bar, unsigned x, unsigned& nloc, unsigned& nx) {
    const unsigned G = gridDim.x * gridDim.y * gridDim.z;
    unsigned sum, cnt, mine, sp = 0u;
    for (;;) {
        sum = 0u; cnt = 0u; mine = 0u;
#pragma unroll
        for (unsigned j = 0; j < 16; ++j) { const unsigned c = xb_ld(&bar[XB_XCNT(j)]); sum += c; cnt += (c > 0u) ? 1u : 0u; mine = (j == x) ? c : mine; }
        if (sum == G) break;
        __builtin_amdgcn_s_sleep(1);
        if ((++sp & 255u) == 0u) { if (xb_ld(&bar[XB_TMO])) break; if (sp > XB_SPIN_CAP) { atomicAdd(&bar[XB_TMO], 1u); break; } }
    }
    nloc = mine > 0u ? mine : 1u; nx = cnt > 0u ? cnt : 1u;
}
__device__ __forceinline__ void xcd_barrier(const XcdBarrier& b) {
    asm volatile("s_waitcnt vmcnt(0)" ::: "memory");
    __syncthreads();
    if (b.wv == 0 && lane_id() == 0) {
        unsigned* bar = b.bar;
        __builtin_amdgcn_s_waitcnt(0);
        unsigned nloc = b.st[0], nx = b.st[1];
        if (nloc == 0u) { xcd_barrier_complete(bar, b.x, nloc, nx); b.st[0] = nloc; b.st[1] = nx; }
        const unsigned old = xb_add(&bar[XB_XSUB(b.x)], 1u);
        const unsigned gen = old / nloc;
        if (old + 1u == (gen + 1u) * nloc) {
            __builtin_amdgcn_fence(__ATOMIC_RELEASE, "agent");
            asm volatile("s_waitcnt vmcnt(0)" ::: "memory");
            const unsigned og = xb_add(&bar[XB_TOP], 1u);
            const unsigned tg = og / nx;
            if (og + 1u == (tg + 1u) * nx) xb_add(&bar[XB_TOPGEN], 1u);
            else XB_SPIN(xb_ld(&bar[XB_TOPGEN]) == tg, bar);
            __builtin_amdgcn_fence(__ATOMIC_ACQUIRE, "agent");
            xb_add(&bar[XB_XGEN(b.x)], 1u);
            asm volatile("s_waitcnt vmcnt(0)" ::: "memory");
        } else {
            XB_SPIN(xb_ld(&bar[XB_XGEN(b.x)]) == gen, bar);
            __builtin_amdgcn_fence(__ATOMIC_ACQUIRE, "agent");
            asm volatile("s_waitcnt vmcnt(0)" ::: "memory");
        }
    }
    __syncthreads();
}

constexpr size_t MiB = 1u << 20;
constexpr size_t CTL_BAR = 0, CTL_MODI = 16384  , CTL_MOD = CTL_MODI + 2 * 4 * 12288 * 8  , CTL_SSQ = CTL_MOD + 2 * 4 * 12288 * 4  ,
                 CTL_CNT = CTL_SSQ + (size_t)T * 12 * 4, CTL_CHK = CTL_CNT + 2 * 16 * 4, CTL_ZERO_BYTES = 2 * MiB;
static_assert(CTL_CHK + 1024 <= CTL_ZERO_BYTES, "ctl");
constexpr size_t WS_W_IN0 = 2 * MiB, WS_W_UQ = WS_W_IN0 + 8 * MiB, WS_W_UKV = WS_W_UQ + 1536 * 512 * 2, WS_W_GLU = WS_W_UKV + 2048 * 256 * 2, WS_W_OUT0 = WS_W_GLU + 2 * MiB,
                 WS_W_IN1 = WS_W_OUT0 + 8 * MiB, WS_W_OUT1 = WS_W_IN1 + (size_t)9728 * 2048 * 2, WS_W_GU = WS_W_OUT1 + 8 * MiB, WS_W_DN = WS_W_GU + 128 * MiB,
                 WS_W_LORA = WS_W_DN + 64 * MiB, WS_S5BY = WS_W_LORA + (size_t)4608 * 384 * 2, WS_S5BE = WS_S5BY + (size_t)64 * 256 * 384 * 2, WS_ROPE = WS_S5BE + (size_t)64 * 256 * 256 * 2,
                 WS_BIAS = WS_ROPE + 1 * MiB, WS_S5L = WS_BIAS + 16384, WS_H = WS_S5L + 65536;
static_assert(WS_H % 256 == 0, "align");
constexpr size_t WS_X1 = WS_H + 64 * MiB, WS_ARENA = WS_X1 + 128 * MiB;
constexpr size_t A_QC = WS_ARENA, A_KVC = A_QC + 16 * MiB, A_KR = A_KVC + 8 * MiB, A_XH = A_KR + 2 * MiB, A_ES = A_XH + 48 * MiB, A_Q = A_ES + 32 * MiB, A_KF = A_Q + 48 * MiB,
                 A_V = A_KF + 48 * MiB, A_YS5 = A_V + 32 * MiB;
constexpr size_t A_XPRE = WS_ARENA, A_RT = WS_ARENA + 128 * MiB, A_TOKL = A_RT + 1 * MiB, A_ACT = WS_ARENA, A_YS = WS_ARENA + 130 * MiB;
constexpr int MOE_ROWS = 2 * T + 16 * 256;
constexpr size_t A_ZD = WS_ARENA, A_ZR = A_ZD + 144 * MiB, A_LIN = A_ZR + 156 * MiB, A_WDEC = A_LIN + 12 * MiB, A_AA = A_WDEC + 48 * MiB, A_GG = A_AA + 48 * MiB,
                 A_DPO = A_GG + 48 * MiB, A_DPM = A_DPO + 48 * MiB, A_DPL = A_DPM + 2 * MiB, A_YR = WS_ARENA, WS_END = A_DPL + 2 * MiB;
static_assert(A_YS + (size_t)MOE_ROWS * 2048 * 2 <= WS_END && A_YS5 + 32 * MiB <= WS_END && WS_END <= 1024 * MiB, "ws map");

constexpr int RING_BYTES = 131072, LDS_TAB = RING_BYTES, LDS_MISC = RING_BYTES + 1024, LDS_BYTES = 147456;

struct KArgs { const float* in[41]; float* out; unsigned char* ws; int ph_lo, ph_hi; };
enum { I_X = 0, I_C, I_ADAW, I_ADAB, I_LNMG, I_LNMB, I_LNFG, I_LNFB, I_RW, I_RB, I_WGU, I_WDN, I_RELB, I_EVIN, I_QN, I_WUQ, I_KVN, I_WUKV, I_LRE, I_LIM, I_BRE, I_BIM, I_CRE, I_CIM,
       I_S5D, I_LOGDT, I_WGLU, I_EVOUT, I_ODIN, I_MU, I_W0, I_W2, I_A0, I_A2, I_G2, I_KK, I_KA, I_RK, I_LNXG, I_LNXB, I_ODOUT };

DI int ropeperm(int c) { return ((c >> 2) & 1) * 32 + (c >> 3) * 4 + (c & 3); }
DI int srccol(int map, int n) {
    switch (map) {
        case 1: if (n < 768) return n; if (n < 1792) return 832 + (n - 768); if (n < 1856) return 768 + ropeperm(n - 1792); return -1;
        case 2: { const int h = n / 192, j = n % 192; return j < 128 ? n : h * 192 + 128 + ropeperm(j - 128); }
        case 3: { const int pn = n >> 8, half = (n >> 7) & 1, idx = n & 127; return half * 512 + pn * 128 + idx; }
        case 4: return n < ODD_IN ? n : -1;
        default: return n;
    }
}
struct ConvJob { const float* src; bf16* dst; const float* kscale; int ldsrc, K, Nd, nmat, map, kbeg, kend; size_t smat, dmat; };
DI void conv_item(const ConvJob& J, LAS float* scr, int item, int lane) {
    const int nblk = J.Nd / 32, per = (J.K / 64) * nblk, mat = item / per, r = item % per, kb = r / nblk, nb = r % nblk, k0 = 64 * kb, n0 = 32 * nb;
    const float* W = J.src + (size_t)mat * J.smat; bf16* WT = J.dst + (size_t)mat * J.dmat;
    const int sc = srccol(J.map, n0 + (lane & 31));
#pragma unroll 8
    for (int i = 0; i < 32; ++i) { const int kk = 2 * i + (lane >> 5);
        float v = 0.f; const int kg = k0 + kk; if (sc >= 0 && kg >= J.kbeg && kg < J.kend) { v = W[(size_t)(kg - J.kbeg) * J.ldsrc + sc]; if (J.kscale) v *= J.kscale[kg]; }
        scr[kk * 33 + (lane & 31)] = v; }
    asm volatile("s_waitcnt lgkmcnt(0)" ::: "memory");
    const int c = lane & 7;
#pragma unroll
    for (int j = 0; j < 4; ++j) { const int n = (lane >> 3) + 8 * j; const LAS float* s = scr + (8 * c) * 33 + n;
        u32x4 o; o.x = pk2(s[0 * 33], s[1 * 33]); o.y = pk2(s[2 * 33], s[3 * 33]); o.z = pk2(s[4 * 33], s[5 * 33]); o.w = pk2(s[6 * 33], s[7 * 33]);
        *(u32x4*)(WT + (size_t)(n0 + n) * J.K + k0 + 8 * c) = o; }
    asm volatile("s_waitcnt lgkmcnt(0)" ::: "memory");
}
DI ConvJob conv_job(const KArgs& a, int j) {
    unsigned char* ws = a.ws; ConvJob J; J.kscale = nullptr; J.nmat = 1; J.map = 0; J.smat = 0; J.dmat = 0; J.kbeg = 0; J.kend = 1 << 30;
    switch (j) {
        case 0: J.src = a.in[I_EVIN]; J.dst = (bf16*)(ws + WS_W_IN0); J.ldsrc = EVEN_IN; J.K = 2048; J.Nd = 2048; J.map = 1; break;
        case 1: J.src = a.in[I_WUQ]; J.dst = (bf16*)(ws + WS_W_UQ); J.ldsrc = 1536; J.K = 512; J.Nd = 1536; J.map = 2; J.kscale = a.in[I_QN]; break;
        case 2: J.src = a.in[I_WUKV]; J.dst = (bf16*)(ws + WS_W_UKV); J.ldsrc = 2048; J.K = 256; J.Nd = 2048; J.kscale = a.in[I_KVN]; break;
        case 3: J.src = a.in[I_WGLU]; J.dst = (bf16*)(ws + WS_W_GLU); J.ldsrc = 1024; J.K = 1024; J.Nd = 1024; break;
        case 4: J.src = a.in[I_EVOUT]; J.dst = (bf16*)(ws + WS_W_OUT0); J.ldsrc = 2048; J.K = 2048; J.Nd = 2048; break;
        case 5: J.src = a.in[I_ODIN]; J.dst = (bf16*)(ws + WS_W_IN1); J.ldsrc = ODD_IN; J.K = 2048; J.Nd = 9728; J.map = 4; break;
        case 6: J.src = a.in[I_ODOUT]; J.dst = (bf16*)(ws + WS_W_OUT1); J.ldsrc = 2048; J.K = 2048; J.Nd = 2048; break;
        case 7: J.src = a.in[I_WGU]; J.dst = (bf16*)(ws + WS_W_GU); J.ldsrc = 1024; J.K = 2048; J.Nd = 1024; J.map = 3; J.nmat = 32; J.smat = (size_t)2048 * 1024; J.dmat = (size_t)1024 * 2048; break;
        case 8: J.src = a.in[I_WDN]; J.dst = (bf16*)(ws + WS_W_DN); J.ldsrc = 2048; J.K = 512; J.Nd = 2048; J.nmat = 32; J.smat = (size_t)512 * 2048; J.dmat = (size_t)2048 * 512; break;
        case 9: J.src = a.in[I_W2]; J.dst = (bf16*)(ws + WS_W_LORA); J.ldsrc = 1536; J.K = 384; J.Nd = 1536; J.kbeg = 0; J.kend = 64; break;
        case 10: J.src = a.in[I_A2]; J.dst = (bf16*)(ws + WS_W_LORA) + (size_t)1536 * 384; J.ldsrc = 1536; J.K = 384; J.Nd = 1536; J.kbeg = 64; J.kend = 128; break;
        default: J.src = a.in[I_G2]; J.dst = (bf16*)(ws + WS_W_LORA) + (size_t)3072 * 384; J.ldsrc = 1536; J.K = 384; J.Nd = 1536; J.kbeg = 128; J.kend = 352; break;
    }
    return J;
}
constexpr int N_CONV_JOBS = 12;

DI void s5_precompute(const KArgs& a, LAS unsigned char* lds, int g, int wv) {
    LAS float* PW = (LAS float*)lds; LAS float* BB = PW + 17 * 64 * 2; LAS float* CC = BB + 64 * 16 * 2; LAS float* KK = CC + 16 * 64 * 2;
    const int tid = otid(wv);
    const float dt = expf(a.in[I_LOGDT][g]);
    for (int idx = tid; idx < 17 * 64; idx += 512) { const int d = idx / 64, p = idx % 64; const float lre = a.in[I_LRE][g * 64 + p], lim = a.in[I_LIM][g * 64 + p];
        const float mag = expf(lre * dt * (float)d); float sn, cs; sincosf(lim * dt * (float)d, &sn, &cs); PW[idx * 2] = mag * cs; PW[idx * 2 + 1] = mag * sn;
        if (d == 16) { float* L = (float*)(a.ws + WS_S5L); L[(g * 64 + p) * 2] = mag * cs; L[(g * 64 + p) * 2 + 1] = mag * sn; } }
    for (int idx = tid; idx < 64 * 16; idx += 512) { const int p = idx / 16, c = idx % 16; const float lre = a.in[I_LRE][g * 64 + p], lim = a.in[I_LIM][g * 64 + p];
        float sn, cs; sincosf(lim * dt, &sn, &cs); const float mag = expf(lre * dt), sh = sinf(0.5f * lim * dt);
        const float nr = expm1f(lre * dt) * cs - 2.f * sh * sh, ni = mag * sn, den = 1.f / (lre * lre + lim * lim);
        const float cr = (nr * lre + ni * lim) * den, ci = (ni * lre - nr * lim) * den;
        const float br = a.in[I_BRE][(g * 64 + p) * 16 + c], bi = a.in[I_BIM][(g * 64 + p) * 16 + c];
        BB[idx * 2] = cr * br - ci * bi; BB[idx * 2 + 1] = cr * bi + ci * br; }
    for (int idx = tid; idx < 16 * 64; idx += 512) { CC[idx * 2] = a.in[I_CRE][g * 1024 + idx]; CC[idx * 2 + 1] = a.in[I_CIM][g * 1024 + idx]; }
    __syncthreads();
    for (int idx = tid; idx < 4096; idx += 512) { const int d = idx >> 8, c = (idx >> 4) & 15, cp = idx & 15; float s = 0.f;
        for (int p = 0; p < 64; ++p) { const float cr = CC[(c * 64 + p) * 2], ci = CC[(c * 64 + p) * 2 + 1], pr = PW[(d * 64 + p) * 2], pi = PW[(d * 64 + p) * 2 + 1];
            const float xr = cr * pr - ci * pi, xi = cr * pi + ci * pr; s += xr * BB[(p * 16 + cp) * 2] - xi * BB[(p * 16 + cp) * 2 + 1]; }
        KK[idx] = s; }
    __syncthreads();
    bf16* BY = (bf16*)(a.ws + WS_S5BY) + (size_t)g * 256 * 384; bf16* BE = (bf16*)(a.ws + WS_S5BE) + (size_t)g * 256 * 256;
    for (int idx = tid; idx < 256 * 48; idx += 512) { const int row = idx / 48, col0 = (idx % 48) * 8, t = row >> 4, c = row & 15; float v[8];
        if (col0 < 256) { const int s = col0 >> 4, c0 = col0 & 15;
#pragma unroll
            for (int j = 0; j < 8; ++j) v[j] = (s <= t) ? KK[((t - s) << 8) + (c << 4) + c0 + j] : 0.f; }
        else { const int pp = col0 - 256; const bool im = pp >= 64; const int p0 = im ? pp - 64 : pp;
#pragma unroll
            for (int j = 0; j < 8; ++j) { const int p = p0 + j; const float cr = CC[(c * 64 + p) * 2], ci = CC[(c * 64 + p) * 2 + 1], pr = PW[((t + 1) * 64 + p) * 2], pi = PW[((t + 1) * 64 + p) * 2 + 1];
                v[j] = im ? -(cr * pi + ci * pr) : (cr * pr - ci * pi); } }
        u32x4 o = {pk2(v[0], v[1]), pk2(v[2], v[3]), pk2(v[4], v[5]), pk2(v[6], v[7])}; *(u32x4*)(BY + (size_t)row * 384 + col0) = o; }
    for (int idx = tid; idx < 256 * 32; idx += 512) { const int row = idx / 32, col0 = (idx % 32) * 8, s = col0 >> 4, c0 = col0 & 15; float v[8];
#pragma unroll
        for (int j = 0; j < 8; ++j) { if (row < 128) { const int p = row & 63; const float pr = PW[((15 - s) * 64 + p) * 2], pi = PW[((15 - s) * 64 + p) * 2 + 1], br = BB[(p * 16 + c0 + j) * 2], bi = BB[(p * 16 + c0 + j) * 2 + 1];
                v[j] = row < 64 ? (pr * br - pi * bi) : (pr * bi + pi * br); } else v[j] = 0.f; }
        u32x4 o = {pk2(v[0], v[1]), pk2(v[2], v[3]), pk2(v[4], v[5]), pk2(v[6], v[7])}; *(u32x4*)(BE + (size_t)row * 256 + col0) = o; }
    __syncthreads();
}

DI int t5_bucket(int dist) { if (dist < 16) return dist; const float logd = logf((float)dist / 16.f) / logf(128.f); int lg = 16 + (int)(logd * 16.f); return lg < 31 ? lg : 31; }

DI void p0_prologue(const KArgs& a, LAS unsigned char* lds, int wv) {
    const int tid = otid(wv), lane = tid & 63, wave = tid >> 6, G = gridDim.x, gw = blockIdx.x * 8 + wave, NGW = G * 8;
    LAS float* cond = (LAS float*)(lds + 98304);
    for (int i = tid; i < 4 * 2048; i += 512) { const float c = a.in[I_C][i]; cond[i] = c / (1.f + expf(-c)); }
    if (blockIdx.x < 64) s5_precompute(a, lds, blockIdx.x, wv); else __syncthreads();
    unsigned long long* MODI = (unsigned long long*)(a.ws + CTL_MODI);
    for (int it = gw; it < 2 * 48 * 16; it += NGW) { const int l = it / 768, cc = (it % 768) / 16, kc = it % 16, col = cc * 256 + lane * 4;
        const float* W = a.in[I_ADAW] + ((size_t)l * 2048 + kc * 128) * 12288 + col;
        f32x4 acc[4]; for (int b = 0; b < 4; ++b) acc[b] = (f32x4){0.f, 0.f, 0.f, 0.f};
#pragma unroll 8
        for (int k = 0; k < 128; ++k) { const f32x4 w = *(const f32x4*)(W + (size_t)k * 12288);
#pragma unroll
            for (int b = 0; b < 4; ++b) acc[b] += w * cond[b * 2048 + kc * 128 + k]; }
        if (kc == 0) { const f32x4 bb = *(const f32x4*)(a.in[I_ADAB] + l * 12288 + col); for (int b = 0; b < 4; ++b) acc[b] += bb; }
#pragma unroll
        for (int b = 0; b < 4; ++b) { unsigned long long* o = MODI + (size_t)(l * 4 + b) * 12288 + col;
#pragma unroll
            for (int e = 0; e < 4; ++e) atomicAdd(o + e, (unsigned long long)__double2ll_rn((double)acc[b][e] * 1099511627776.0)); } }
    LAS float* scr = (LAS float*)(lds + wave * 8704);
    for (int j = 0; j < N_CONV_JOBS; ++j) { const ConvJob J = conv_job(a, j); const int nit = J.nmat * (J.K / 64) * (J.Nd / 32);
        for (int it = gw; it < nit; it += NGW) conv_item(J, scr, it, lane); }
    { float* RC = (float*)(a.ws + WS_ROPE); float* RS = RC + 4096 * 32; const int gt = blockIdx.x * 512 + tid;
      for (int i = gt; i < 4096 * 32; i += G * 512) { const int pos = i >> 5, j = i & 31; const float inv = powf(10000.f, -(float)(2 * j) / 64.f); float sn, cs; sincosf((float)pos * inv, &sn, &cs); RC[i] = cs; RS[i] = sn; }
      float* BL = (float*)(a.ws + WS_BIAS);
      for (int i = gt; i < 3 * 8 * 132; i += G * 512) { const int gi = i / (8 * 132), h = (i / 132) % 8, dl = i % 132; const int dil = gi == 0 ? 1 : (gi == 1 ? 4 : 16);
          BL[i] = dl <= 128 ? a.in[I_RELB][t5_bucket(dl * dil) * 24 + gi * 8 + h] * 1.44269504089f : 0.f; } }
}

DI float modi2f(unsigned long long v) { return (float)((double)(long long)v * 9.094947017729282e-13); }
DI void modulate_rows(const float* x, const unsigned long long* MODI, float* MODF, bf16* H, int wv) {
    const int lane = otid(wv) & 63, gw = blockIdx.x * 8 + (otid(wv) >> 6), NGW = gridDim.x * 8;
    for (int i = gw * 64 + lane; i < 2 * 4 * 12288; i += NGW * 64) MODF[i] = modi2f(MODI[i]);
    for (int m = gw; m < T; m += NGW) { const int b = m / SEQ; const unsigned long long* sh = MODI + (size_t)b * 12288; const unsigned long long* sc = sh + 2048;
#pragma unroll
        for (int j = 0; j < 8; ++j) { const int col = (lane + 64 * j) * 4; const f32x4 v = *(const f32x4*)(x + (size_t)m * D + col);
            const f32x4 s1 = {modi2f(sc[col]), modi2f(sc[col + 1]), modi2f(sc[col + 2]), modi2f(sc[col + 3])}, s0 = {modi2f(sh[col]), modi2f(sh[col + 1]), modi2f(sh[col + 2]), modi2f(sh[col + 3])};
            const f32x4 h = v * (s1 + 1.f) + s0; u32x2 o = {pk2(h.x, h.y), pk2(h.z, h.w)}; *(u32x2*)(H + (size_t)m * D + col) = o; } }
}

using pg8::Unit;
#define P32(ptr, elemoff) ((decltype(ptr))((char*)(ptr) + (unsigned)((unsigned)(elemoff) * (unsigned)sizeof(*(ptr)))))
typedef f32x4 Acc[2][2][4][2];
#define EPI_ROWS_BEGIN const int row0 = u.pm * 256 + wr * 64 + fr; _Pragma("unroll") for (int ai = 0; ai < 2; ++ai) _Pragma("unroll") for (int m = 0; m < 4; ++m) { const int row = row0 + ai * 128 + m * 16;
#define EPI_ROWS_END __builtin_amdgcn_sched_barrier(0); }
DI u32x4 pack8(const f32x4& v0, const f32x4& v1) { u32x4 o = {pk2(v0.x, v0.y), pk2(v0.z, v0.w), pk2(v1.x, v1.y), pk2(v1.z, v1.w)}; return o; }

struct EpiIn0 { static constexpr bool PERM = true;
    bf16 *QC, *KVC, *KR, *XH; float *ssq;
    DI void operator()(const Acc& acc, const Unit& u, int wr, int wc, int fr, int fq) const {
        EPI_ROWS_BEGIN
            float ss = 0.f;
#pragma unroll
            for (int bj = 0; bj < 2; ++bj) { const f32x4 v0 = acc[ai][bj][m][0], v1 = acc[ai][bj][m][1]; const int col = 128 * bj + 32 * wc + 8 * fq; const u32x4 o = pack8(v0, v1);
                if (u.pn < 2) { *(u32x4*)P32(QC, row * 512 + u.pn * 256 + col) = o; ss += v0.x * v0.x + v0.y * v0.y + v0.z * v0.z + v0.w * v0.w + v1.x * v1.x + v1.y * v1.y + v1.z * v1.z + v1.w * v1.w; }
                else if (u.pn == 2) { *(u32x4*)P32(KVC, row * 256 + col) = o; ss += v0.x * v0.x + v0.y * v0.y + v0.z * v0.z + v0.w * v0.w + v1.x * v1.x + v1.y * v1.y + v1.z * v1.z + v1.w * v1.w; }
                else if (u.pn < 7) { const int uc = (u.pn - 3) * 256 + col, g = uc >> 4; *(u32x4*)P32(XH, (g * 1024 + (row >> 4)) * 384 + (row & 15) * 16 + (uc & 15)) = o; }
                else if (col < 64) { *(u32x4*)P32(KR, row * 64 + col) = o; } }
            if (u.pn <= 2) { ss += __shfl_xor(ss, 16); ss += __shfl_xor(ss, 32); if (fq == 0) *P32(ssq, row * 12 + u.pn * 4 + wc) = ss; }
        EPI_ROWS_END
    }
};
struct EpiQ { static constexpr bool PERM = true;
    bf16* Q; const float* ssq; const float* rope;
    DI void operator()(const Acc& acc, const Unit& u, int wr, int wc, int fr, int fq) const {
        EPI_ROWS_BEGIN
            const f32x4 q0 = *(const f32x4*)P32(ssq, row * 12), q1 = *(const f32x4*)P32(ssq, row * 12 + 4);
            const float rs = rsqrtf((((q0.x + q0.y) + (q0.z + q0.w)) + ((q1.x + q1.y) + (q1.z + q1.w))) * (1.f / 512.f) + RMS_EPS) * (0.07216878364870322f * 1.44269504089f);
            const int b = row / SEQ, s = row % SEQ;
#pragma unroll
            for (int bj = 0; bj < 2; ++bj) { f32x4 v0 = acc[ai][bj][m][0] * rs, v1 = acc[ai][bj][m][1] * rs; const int n = u.pn * 256 + 128 * bj + 32 * wc + 8 * fq, h = n / 192, j = n % 192;
                if (j >= 128) { const int q = (j - 128) >> 3; const f32x4 cs = *(const f32x4*)P32(rope, s * 32 + 4 * q), sn = *(const f32x4*)P32(rope, 4096 * 32 + s * 32 + 4 * q);
                    const f32x4 x1 = v0, x2 = v1; v0 = x1 * cs - x2 * sn; v1 = x1 * sn + x2 * cs; }
                *(u32x4*)P32(Q, ((b * 8 + h) * SEQ + s) * 192 + j) = pack8(v0, v1); }
        EPI_ROWS_END
    }
};
struct EpiKV { static constexpr bool PERM = true;
    bf16 *KF, *V; const float* ssq;
    DI void operator()(const Acc& acc, const Unit& u, int wr, int wc, int fr, int fq) const {
        EPI_ROWS_BEGIN
            const f32x4 q2 = *(const f32x4*)P32(ssq, row * 12 + 8); const float rs = rsqrtf(((q2.x + q2.y) + (q2.z + q2.w)) * (1.f / 256.f) + RMS_EPS); const int b = row / SEQ, s = row % SEQ, h = u.pn, j = 32 * wc + 8 * fq; const int tok = (b * 8 + h) * SEQ + s;
            *(u32x4*)P32(KF, tok * 192 + j) = pack8(acc[ai][0][m][0] * rs, acc[ai][0][m][1] * rs);
            *(u32x4*)P32(V, tok * 128 + j) = pack8(acc[ai][1][m][0] * rs, acc[ai][1][m][1] * rs);
        EPI_ROWS_END
    }
};
struct S5Order { int G, c;
    DI bool next(int i, Unit& u) const { const int L = i * G + c; if (L >= 256) return false; u.pm = L; u.pn = L >> 2; u.aux = 0; return true; }
    DI int arow(const Unit&, int) const { return 0; } };
struct EpiS5E { static constexpr bool PERM = false;
    float* ES;
    DI void operator()(const Acc& acc, const Unit& u, int wr, int wc, int fr, int fq) const {
        EPI_ROWS_BEGIN
#pragma unroll
            for (int n = 0; n < 2; ++n) *(f32x4*)P32(ES, row * 128 + 32 * wc + 16 * n + 4 * fq) = acc[ai][0][m][n];
        EPI_ROWS_END
    }
};
DI float gelu_tanh(float x) { const float t = 0.7978845608028654f * (x + 0.044715f * x * x * x); const float e = __expf(2.f * t); return 0.5f * x * (1.f + (1.f - 2.f / (e + 1.f))); }
struct EpiS5Y { static constexpr bool PERM = true;
    bf16* YS5; const bf16* XH; const float* dsk;
    DI void operator()(const Acc& acc, const Unit& u, int wr, int wc, int fr, int fq) const {
        EPI_ROWS_BEGIN
            const int g = row >> 10, chunk = row & 1023;
#pragma unroll
            for (int bj = 0; bj < 2; ++bj) { const int col = 128 * bj + 32 * wc + 8 * fq, tl = col >> 4, c0 = col & 15; const u32x4 uu = *(const u32x4*)P32(XH, row * 384 + col);
                const f32x4 d0 = *(const f32x4*)P32(dsk, g * 16 + c0), d1 = *(const f32x4*)P32(dsk, g * 16 + c0 + 4); const f32x4 a0 = acc[ai][bj][m][0], a1 = acc[ai][bj][m][1];
                f32x4 y0 = {a0.x + d0.x * bflo(uu.x), a0.y + d0.y * bfhi(uu.x), a0.z + d0.z * bflo(uu.y), a0.w + d0.w * bfhi(uu.y)};
                f32x4 y1 = {a1.x + d1.x * bflo(uu.z), a1.y + d1.y * bfhi(uu.z), a1.z + d1.z * bflo(uu.w), a1.w + d1.w * bfhi(uu.w)};
#pragma unroll
                for (int e = 0; e < 4; ++e) { y0[e] = gelu_tanh(y0[e]); y1[e] = gelu_tanh(y1[e]); }
                *(u32x4*)P32(YS5, (chunk * 16 + tl) * 1024 + g * 16 + c0) = pack8(y0, y1); }
        EPI_ROWS_END
    }
};
struct EpiGlu { static constexpr bool PERM = true;
    bf16* MIX; const bf16* YS5;
    DI void operator()(const Acc& acc, const Unit& u, int wr, int wc, int fr, int fq) const {
        EPI_ROWS_BEGIN
#pragma unroll
            for (int bj = 0; bj < 2; ++bj) { const int col = u.pn * 256 + 128 * bj + 32 * wc + 8 * fq; const u32x4 yy = *(const u32x4*)P32(YS5, row * 1024 + col); const f32x4 a0 = acc[ai][bj][m][0], a1 = acc[ai][bj][m][1];
                const f32x4 o0 = {bflo(yy.x) * sigmoidf_(a0.x), bfhi(yy.x) * sigmoidf_(a0.y), bflo(yy.y) * sigmoidf_(a0.z), bfhi(yy.y) * sigmoidf_(a0.w)};
                const f32x4 o1 = {bflo(yy.z) * sigmoidf_(a1.x), bfhi(yy.z) * sigmoidf_(a1.y), bflo(yy.w) * sigmoidf_(a1.z), bfhi(yy.w) * sigmoidf_(a1.w)};
                *(u32x4*)P32(MIX, row * 2048 + 1024 + col) = pack8(o0, o1); }
        EPI_ROWS_END
    }
};
struct EpiRes { static constexpr bool PERM = false;
    float* XPRE; const float* xres; const float* gate;
    DI void operator()(const Acc& acc, const Unit& u, int wr, int wc, int fr, int fq) const {
        EPI_ROWS_BEGIN
            const int b = row / SEQ;
#pragma unroll
            for (int bj = 0; bj < 2; ++bj)
#pragma unroll
                for (int n = 0; n < 2; ++n) { const int col = u.pn * 256 + 128 * bj + 32 * wc + 16 * n + 4 * fq; const f32x4 xr = *(const f32x4*)P32(xres, row * D + col), gt = *(const f32x4*)P32(gate, b * 12288 + col);
                    *(f32x4*)P32(XPRE, row * D + col) = xr * DN_ALPHA + (gt + 1.f) * acc[ai][bj][m][n]; }
        EPI_ROWS_END
    }
};

DI void krope_pass(const bf16* KR, const float* rope, bf16* KF, int wv) {
    const int gt = blockIdx.x * 512 + otid(wv), NT_ = gridDim.x * 512;
    for (int i = gt; i < T * 8; i += NT_) { const int row = i >> 3, q = i & 7, b = row / SEQ, s = row % SEQ; const u32x4 r = *(const u32x4*)(KR + (size_t)row * 64 + q * 8);
        const f32x4 x1 = {bflo(r.x), bfhi(r.x), bflo(r.y), bfhi(r.y)}, x2 = {bflo(r.z), bfhi(r.z), bflo(r.w), bfhi(r.w)};
        const f32x4 cs = *(const f32x4*)(rope + s * 32 + 4 * q), sn = *(const f32x4*)(rope + 4096 * 32 + s * 32 + 4 * q);
        const u32x4 o = pack8(x1 * cs - x2 * sn, x1 * sn + x2 * cs);
#pragma unroll
        for (int h = 0; h < 8; ++h) *(u32x4*)(KF + ((size_t)(b * 8 + h) * SEQ + s) * 192 + 128 + q * 8) = o; }
}
DI void s5_carry(const float* ES, const float* L16, bf16* XH, int wv) {
    if (otid(wv) < 64) for (int gt = blockIdx.x * 64 + otid(wv); gt < 4 * 64 * 64; gt += gridDim.x * 64) {
        const int p = gt & 63, g = (gt >> 6) & 63, b = gt >> 12; const float lr = L16[(g * 64 + p) * 2], li = L16[(g * 64 + p) * 2 + 1]; float hr = 0.f, hi = 0.f;
        const size_t r0 = (size_t)g * 1024 + b * 256;
#pragma unroll 16
        for (int k = 0; k < 256; ++k) { const float er = ES[(r0 + k) * 128 + p], ei = ES[(r0 + k) * 128 + 64 + p];
            XH[(r0 + k) * 384 + 256 + p] = f2bf(hr); XH[(r0 + k) * 384 + 320 + p] = f2bf(hi);
            const float nr = lr * hr - li * hi + er, ni = lr * hi + li * hr + ei; hr = nr; hi = ni; } }
}

#define MFMA32(a, b, c) __builtin_amdgcn_mfma_f32_32x32x16_bf16((a), (b), (c), 0, 0, 0)
constexpr int AT_KSTR = 400, AT_VSTR = 136, AT_KBYTES = 64 * AT_KSTR, AT_STG = AT_KBYTES + 128 * AT_VSTR;
static_assert(2 * AT_STG <= RING_BYTES, "attention LDS");
DI void mla_attn_unit(LAS unsigned char* lds, const bf16* Qg, const bf16* KFg, const bf16* Vg, bf16* MIX, int unit, int wv) {
    const int tid = otid(wv), lane = tid & 63, w = tid >> 6, r = lane & 31, hh = lane >> 5;
    const int b = unit >> 6, h = (unit >> 3) & 7, pi = unit & 7;
    const bf16* Qh = Qg + (size_t)(b * 8 + h) * SEQ * 192; const bf16* Kh = KFg + (size_t)(b * 8 + h) * SEQ * 192; const bf16* Vh = Vg + (size_t)(b * 8 + h) * SEQ * 128;
    for (int half = 0; half < 2; ++half) {
        const int qb = half ? 15 - pi : pi, q0 = qb * 256 + 32 * w, nkt = (qb + 1) * 4;
        bf16x8 qf[12];
#pragma unroll
        for (int ks = 0; ks < 12; ++ks) qf[ks] = *(const bf16x8*)P32(Qh, (q0 + r) * 192 + 16 * ks + 8 * hh);
        f32x16 O[4];
#pragma unroll
        for (int i = 0; i < 4; ++i) for (int e = 0; e < 16; ++e) O[i][e] = 0.f;
        float mrow = -1e30f, lrow = 0.f;
        u32x4 kreg[3], vreg[2];
#define AT_LOAD(kt) do { _Pragma("unroll") for (int i = 0; i < 3; ++i) { const int p = tid + 512 * i, kr = p / 24, c16 = p % 24; kreg[i] = *(const u32x4*)P32(Kh, ((kt) * 64 + kr) * 192 + c16 * 8); } \
        _Pragma("unroll") for (int i = 0; i < 2; ++i) vreg[i] = *(const u32x4*)P32(Vh, ((kt) * 64 + lane) * 128 + (2 * w + i) * 8); } while (0)
#define AT_STORE(buf) do { LAS unsigned char* sb = lds + (buf) * AT_STG; _Pragma("unroll") for (int i = 0; i < 3; ++i) { const int p = tid + 512 * i, kr = p / 24, c16 = p % 24; *(LAS u32x4*)(sb + kr * AT_KSTR + c16 * 16) = kreg[i]; } \
        _Pragma("unroll") for (int i = 0; i < 2; ++i) { LAS bf16* vt = (LAS bf16*)(sb + AT_KBYTES + ((2 * w + i) * 8) * AT_VSTR + lane * 2); const unsigned* vv = (const unsigned*)&vreg[i]; \
            _Pragma("unroll") for (int e = 0; e < 4; ++e) { vt[(2 * e) * (AT_VSTR / 2)] = (bf16)(vv[e] & 0xffffu); vt[(2 * e + 1) * (AT_VSTR / 2)] = (bf16)(vv[e] >> 16); } } } while (0)
        __syncthreads();
        AT_LOAD(0); AT_STORE(0);
        __syncthreads();
        for (int kt = 0; kt < nkt; ++kt) {
            if (kt + 1 < nkt) AT_LOAD(kt + 1);
            const LAS unsigned char* sb = lds + (kt & 1) * AT_STG;
            if (kt * 64 <= q0 + 31) {
                f32x16 st[2];
#pragma unroll
                for (int mt = 0; mt < 2; ++mt) { for (int e = 0; e < 16; ++e) st[mt][e] = 0.f;
#pragma unroll
                    for (int ks = 0; ks < 12; ++ks) { const bf16x8 a = *(const LAS bf16x8*)(sb + (32 * mt + r) * AT_KSTR + (16 * ks + 8 * hh) * 2); st[mt] = MFMA32(a, qf[ks], st[mt]); } }
                if (kt * 64 + 63 > q0) {
                    const int qg = q0 + r;
#pragma unroll
                    for (int mt = 0; mt < 2; ++mt)
#pragma unroll
                        for (int e = 0; e < 16; ++e) { const int kg = kt * 64 + 32 * mt + (e & 3) + 8 * (e >> 2) + 4 * hh; if (kg > qg) st[mt][e] = -1e30f; }
                }
                float mx = st[0][0];
#pragma unroll
                for (int mt = 0; mt < 2; ++mt)
#pragma unroll
                    for (int e = 0; e < 16; ++e) mx = fmaxf(mx, st[mt][e]);
                mx = fmaxf(mx, __shfl_xor(mx, 32));
                const float mnew = fmaxf(mrow, mx), alpha = exp2f(mrow - mnew); mrow = mnew;
                float ls = 0.f;
#pragma unroll
                for (int mt = 0; mt < 2; ++mt)
#pragma unroll
                    for (int e = 0; e < 16; ++e) { const float p = exp2f(st[mt][e] - mnew); st[mt][e] = p; ls += p; }
                lrow = lrow * alpha + ls;
#pragma unroll
                for (int i = 0; i < 4; ++i) O[i] *= alpha;
                bf16x8 pf[2][2];
#pragma unroll
                for (int mt = 0; mt < 2; ++mt)
#pragma unroll
                    for (int s = 0; s < 2; ++s) { u32x4 pk = {pk2(st[mt][8 * s], st[mt][8 * s + 1]), pk2(st[mt][8 * s + 2], st[mt][8 * s + 3]), pk2(st[mt][8 * s + 4], st[mt][8 * s + 5]), pk2(st[mt][8 * s + 6], st[mt][8 * s + 7])};
                        pf[mt][s] = __builtin_bit_cast(bf16x8, pk); }
#pragma unroll
                for (int dvt = 0; dvt < 4; ++dvt)
#pragma unroll
                    for (int mt = 0; mt < 2; ++mt)
#pragma unroll
                        for (int s = 0; s < 2; ++s) { const LAS unsigned char* vp = sb + AT_KBYTES + (dvt * 32 + r) * AT_VSTR + (32 * mt + 16 * s + 4 * hh) * 2;
                            const s16x4 lo = *(const LAS s16x4*)vp, hi = *(const LAS s16x4*)(vp + 16); const bf16x8 a = __builtin_shufflevector(lo, hi, 0, 1, 2, 3, 4, 5, 6, 7);
                            O[dvt] = MFMA32(a, pf[mt][s], O[dvt]); }
            }
            if (kt + 1 < nkt) AT_STORE((kt + 1) & 1);
            __syncthreads();
        }
        lrow += __shfl_xor(lrow, 32);
        const float inv = 1.f / lrow;
        bf16* orow = P32(MIX, (b * SEQ + q0 + r) * 2048 + h * 128);
#pragma unroll
        for (int dvt = 0; dvt < 4; ++dvt)
#pragma unroll
            for (int g4 = 0; g4 < 4; ++g4) { u32x2 o = {pk2(O[dvt][4 * g4] * inv, O[dvt][4 * g4 + 1] * inv), pk2(O[dvt][4 * g4 + 2] * inv, O[dvt][4 * g4 + 3] * inv)};
                *(u32x2*)(orow + dvt * 32 + 8 * g4 + 4 * hh) = o; }
    }
#undef AT_LOAD
#undef AT_STORE
}

DI void ln_router_phase(const KArgs& a, LAS unsigned char* lds, int layer, const float* XPRE, float* X1, bf16* H, int wv) {
    const int tid = otid(wv), lane = tid & 63, wave = tid >> 6;
    LAS float* wT = (LAS float*)lds;
    for (int i = tid; i < 2048 * 16; i += 512) { const int k = i >> 4, e = i & 15; wT[e * 2048 + k] = a.in[I_RW][i]; }
    __syncthreads();
    const float* MODl = (const float*)(a.ws + CTL_MOD) + (size_t)layer * 4 * 12288;
    const float* lg = a.in[I_LNMG] + layer * D; const float* lb = a.in[I_LNMB] + layer * D;
    unsigned* cnt = (unsigned*)(a.ws + CTL_CNT) + layer * 16;
    int* RTE = (int*)(a.ws + A_RT); int* RTP = RTE + 2 * T; float* RTW = (float*)(RTP + 2 * T); int* TOKL = (int*)(a.ws + A_TOKL);
    for (int m = blockIdx.x * 8 + wave; m < T; m += gridDim.x * 8) {
        const int b = m / SEQ; const float* sh = MODl + (size_t)b * 12288 + 3 * 2048; const float* sc = sh + 2048;
        f32x4 v[8]; float s = 0.f;
#pragma unroll
        for (int j = 0; j < 8; ++j) { v[j] = *(const f32x4*)(XPRE + (size_t)m * D + (lane + 64 * j) * 4); s += (v[j].x + v[j].y) + (v[j].z + v[j].w); }
        const float mean = wave_sum(s) * (1.f / D); float s2 = 0.f;
#pragma unroll
        for (int j = 0; j < 8; ++j) { v[j] = v[j] - mean; s2 += (v[j].x * v[j].x + v[j].y * v[j].y) + (v[j].z * v[j].z + v[j].w * v[j].w); }
        const float rstd = rsqrtf(wave_sum(s2) * (1.f / D) + LN_EPS);
#pragma unroll
        for (int j = 0; j < 8; ++j) { const int col = (lane + 64 * j) * 4; const f32x4 x1 = v[j] * rstd * *(const f32x4*)(lg + col) + *(const f32x4*)(lb + col);
            *(f32x4*)(X1 + (size_t)m * D + col) = x1;
            const f32x4 hv = x1 * (*(const f32x4*)(sc + col) + 1.f) + *(const f32x4*)(sh + col);
            u32x2 o = {pk2(hv.x, hv.y), pk2(hv.z, hv.w)}; *(u32x2*)(H + (size_t)m * D + col) = o; v[j] = hv; }
        float lg_l = 0.f;
#pragma unroll 1
        for (int e = 0; e < 16; ++e) { const LAS float* wp = wT + e * 2048 + lane * 4; float p = 0.f;
#pragma unroll
            for (int j = 0; j < 8; ++j) { const f32x4 w = *(const LAS f32x4*)(wp + j * 256); p += (v[j].x * w.x + v[j].y * w.y) + (v[j].z * w.z + v[j].w * w.w); }
            p = wave_sum(p); lg_l = (lane == e) ? p : lg_l; }
        float sg[16], sb[16];
#pragma unroll
        for (int e = 0; e < 16; ++e) { const float lgt = __builtin_bit_cast(float, __builtin_amdgcn_readlane(__builtin_bit_cast(int, lg_l), e)); sg[e] = 1.f / (1.f + expf(-lgt)); sb[e] = sg[e] + a.in[I_RB][e]; }
        int bg = 0; float bgs = -1e30f;
#pragma unroll
        for (int g = 0; g < 4; ++g) { float m1 = -1e30f, m2 = -1e30f;
#pragma unroll
            for (int i = 0; i < 4; ++i) { const float x = sb[g * 4 + i]; if (x > m1) { m2 = m1; m1 = x; } else if (x > m2) m2 = x; }
            const float gs = m1 + m2; if (gs > bgs) { bgs = gs; bg = g; } }
        int e0 = 0, e1 = 0; float b0 = -1e30f, b1 = -1e30f, s0 = 0.f, s1 = 0.f;
#pragma unroll
        for (int g = 0; g < 4; ++g)
#pragma unroll
            for (int i = 0; i < 4; ++i) { const int e = g * 4 + i; if (g == bg) { const float x = sb[e]; if (x > b0) { b1 = b0; e1 = e0; s1 = s0; b0 = x; e0 = e; s0 = sg[e]; } else if (x > b1) { b1 = x; e1 = e; s1 = sg[e]; } } }
        if (lane == 0) { const float inv = 1.f / (s0 + s1);
            const unsigned p0 = atomicAdd(cnt + e0, 1u), p1 = atomicAdd(cnt + e1, 1u);
            TOKL[e0 * T + p0] = m; TOKL[e1 * T + p1] = m;
            RTE[2 * m] = e0; RTE[2 * m + 1] = e1; RTP[2 * m] = (int)p0; RTP[2 * m + 1] = (int)p1; RTW[2 * m] = s0 * inv; RTW[2 * m + 1] = s1 * inv; }
    }
    __syncthreads();
}

DI void moe_table(const KArgs& a, LAS unsigned char* lds, int layer, int wv) {
    LAS int* tab = (LAS int*)(lds + LDS_TAB);
    if (otid(wv) == 0) { const unsigned* cnt = (const unsigned*)(a.ws + CTL_CNT) + layer * 16; int acc = 0;
        for (int e = 0; e < 16; ++e) { const int c = (int)cnt[e]; tab[e] = acc; tab[32 + e] = c; acc += (c + 255) >> 8; } tab[16] = acc; }
    __syncthreads();
}
template <int NTB> struct MoeOrder {
    int G, c, layer; const LAS int* tab; const int* tokl;
    DI bool next(int i, Unit& u) const { const int L = i * G + c, mt = L / NTB, nt = L % NTB; if (mt >= tab[16]) return false; int e = 0;
#pragma unroll
        for (int k = 1; k < 16; ++k) e += (mt >= tab[k]) ? 1 : 0;
        u.pm = mt; u.pn = (layer * 16 + e) * NTB + nt; u.aux = e | (nt << 8) | ((mt - tab[e]) << 16); return true; }
    DI int arow(const Unit& u, int r) const { const int e = u.aux & 255, j = (u.aux >> 16) * 256 + r; return j < tab[32 + e] ? tokl[e * T + j] : 0; }
};
struct EpiGateUp { static constexpr bool PERM = true;
    bf16* ACT;
    DI void operator()(const Acc& acc, const Unit& u, int wr, int wc, int fr, int fq) const {
        const int nt = (u.aux >> 8) & 255;
        EPI_ROWS_BEGIN
            const f32x4 g0 = acc[ai][0][m][0], g1 = acc[ai][0][m][1], u0 = acc[ai][1][m][0], u1 = acc[ai][1][m][1];
            f32x4 o0, o1;
#pragma unroll
            for (int e = 0; e < 4; ++e) { o0[e] = g0[e] * sigmoidf_(g0[e]) * u0[e]; o1[e] = g1[e] * sigmoidf_(g1[e]) * u1[e]; }
            *(u32x4*)P32(ACT, row * 512 + nt * 128 + 32 * wc + 8 * fq) = pack8(o0, o1);
        EPI_ROWS_END
    }
};
struct EpiDown { static constexpr bool PERM = true;
    bf16* YS;
    DI void operator()(const Acc& acc, const Unit& u, int wr, int wc, int fr, int fq) const {
        const int nt = (u.aux >> 8) & 255;
        EPI_ROWS_BEGIN
#pragma unroll
            for (int bj = 0; bj < 2; ++bj) *(u32x4*)P32(YS, row * 2048 + nt * 256 + 128 * bj + 32 * wc + 8 * fq) = pack8(acc[ai][bj][m][0], acc[ai][bj][m][1]);
        EPI_ROWS_END
    }
};
DI void ln_ffn_phase(const KArgs& a, int layer, const float* X1, float* XO, bf16* Hn, int wv) {
    const int lane = otid(wv) & 63, wave = otid(wv) >> 6;
    const float* MODl = (const float*)(a.ws + CTL_MOD) + (size_t)layer * 4 * 12288; const float* MODn = MODl + 4 * 12288;
    const float* lg = a.in[I_LNFG] + layer * D; const float* lb = a.in[I_LNFB] + layer * D;
    const unsigned* cnt = (const unsigned*)(a.ws + CTL_CNT) + layer * 16;
    const int* RTE = (const int*)(a.ws + A_RT); const int* RTP = RTE + 2 * T; const float* RTW = (const float*)(RTP + 2 * T); const bf16* YS = (const bf16*)(a.ws + A_YS);
    for (int m = blockIdx.x * 8 + wave; m < T; m += gridDim.x * 8) {
        const int b = m / SEQ; const float* gf = MODl + (size_t)b * 12288 + 5 * 2048;
        const int e0 = RTE[2 * m], e1 = RTE[2 * m + 1]; int t0 = 0, t1 = 0;
        for (int e = 0; e < 16; ++e) { const int tl = ((int)cnt[e] + 255) >> 8; t0 += e < e0 ? tl : 0; t1 += e < e1 ? tl : 0; }
        const bf16* y0 = YS + ((size_t)t0 * 256 + RTP[2 * m]) * 2048; const bf16* y1 = YS + ((size_t)t1 * 256 + RTP[2 * m + 1]) * 2048; const float w0 = RTW[2 * m], w1 = RTW[2 * m + 1];
        f32x4 v[8]; float s = 0.f;
#pragma unroll
        for (int j = 0; j < 8; ++j) { const int col = (lane + 64 * j) * 4; const u32x2 a0 = *(const u32x2*)(y0 + col), a1 = *(const u32x2*)(y1 + col);
            const f32x4 y = {w0 * bflo(a0.x) + w1 * bflo(a1.x), w0 * bfhi(a0.x) + w1 * bfhi(a1.x), w0 * bflo(a0.y) + w1 * bflo(a1.y), w0 * bfhi(a0.y) + w1 * bfhi(a1.y)};
            v[j] = *(const f32x4*)(X1 + (size_t)m * D + col) * DN_ALPHA + (*(const f32x4*)(gf + col) + 1.f) * y; s += (v[j].x + v[j].y) + (v[j].z + v[j].w); }
        const float mean = wave_sum(s) * (1.f / D); float s2 = 0.f;
#pragma unroll
        for (int j = 0; j < 8; ++j) { v[j] = v[j] - mean; s2 += (v[j].x * v[j].x + v[j].y * v[j].y) + (v[j].z * v[j].z + v[j].w * v[j].w); }
        const float rstd = rsqrtf(wave_sum(s2) * (1.f / D) + LN_EPS);
#pragma unroll
        for (int j = 0; j < 8; ++j) { const int col = (lane + 64 * j) * 4; const f32x4 xo = v[j] * rstd * *(const f32x4*)(lg + col) + *(const f32x4*)(lb + col);
            *(f32x4*)(XO + (size_t)m * D + col) = xo;
            if (Hn) { const float* sh = MODn + (size_t)b * 12288; const f32x4 hv = xo * (*(const f32x4*)(sh + 2048 + col) + 1.f) + *(const f32x4*)(sh + col);
                u32x2 o = {pk2(hv.x, hv.y), pk2(hv.z, hv.w)}; *(u32x2*)(Hn + (size_t)m * D + col) = o; } }
    }
}

struct EpiIn1 { static constexpr bool PERM = true;
    bf16 *ZD, *ZR;
    DI void operator()(const Acc& acc, const Unit& u, int wr, int wc, int fr, int fq) const {
        EPI_ROWS_BEGIN
#pragma unroll
            for (int bj = 0; bj < 2; ++bj) { const int col = u.pn * 256 + 128 * bj + 32 * wc + 8 * fq; const u32x4 o = pack8(acc[ai][bj][m][0], acc[ai][bj][m][1]);
                if (col < DIL_IN) *(u32x4*)P32(ZD, row * DIL_IN + col) = o; else if (col < ODD_IN) *(u32x4*)P32(ZR, row * RW_IN + (col - DIL_IN)) = o; }
        EPI_ROWS_END
    }
};
constexpr int DA_KSTR = 272, DA_VSTR = 136, DA_KBYTES = 64 * DA_KSTR, DA_STG = DA_KBYTES + 128 * DA_VSTR;
DI void dil_attn_unit(LAS unsigned char* lds, const bf16* ZD, const float* BL, bf16* DPO, float* DPM, float* DPL, int unit, int wv) {
    const int tid = otid(wv), lane = tid & 63, w = tid >> 6, r = lane & 31, hh = lane >> 5, hd = w >> 2, qs = w & 3;
    const int hp = unit & 3, sb_ = (unit >> 2) & 31, gi = (unit >> 7) % 3, b = unit / 384;
    const int dil = gi == 0 ? 1 : (gi == 1 ? 4 : 16), nb = 32 / dil, rr = sb_ / nb, n = sb_ % nb;
    const int h = hp * 2 + hd;
    const bf16* Zb = ZD + (size_t)b * SEQ * DIL_IN + gi * 1536;
    LAS float* bl = (LAS float*)(lds + 2 * DA_STG);
    __syncthreads();
    if (tid < 264) bl[tid] = BL[(gi * 8 + hp * 2 + tid / 132) * 132 + tid % 132];
    const int qi = 32 * qs + r, qtok = (n * 128 + qi) * dil + rr;
    bf16x8 qf[4];
#pragma unroll
    for (int ks = 0; ks < 4; ++ks) qf[ks] = *(const bf16x8*)P32(Zb, qtok * DIL_IN + h * 64 + 16 * ks + 8 * hh);
    f32x16 O[2];
#pragma unroll
    for (int i = 0; i < 2; ++i) for (int e = 0; e < 16; ++e) O[i][e] = 0.f;
    float mrow = -1e30f, lrow = 0.f;
    u32x4 kreg[2], vreg[2];
    const int kt0 = n == 0 ? 2 : 0;
#define DA_LOAD(kt) do { _Pragma("unroll") for (int i = 0; i < 2; ++i) { const int p = tid + 512 * i, kr = p >> 4, c16 = p & 15; const int ktok = ((n - 1) * 128 + (kt) * 64 + kr) * dil + rr; \
            kreg[i] = *(const u32x4*)P32(Zb, ktok * DIL_IN + 512 + hp * 128 + c16 * 8); } \
        { const int ktok = ((n - 1) * 128 + (kt) * 64 + lane) * dil + rr; _Pragma("unroll") for (int i = 0; i < 2; ++i) vreg[i] = *(const u32x4*)P32(Zb, ktok * DIL_IN + 1024 + hp * 128 + (2 * w + i) * 8); } } while (0)
#define DA_STORE(buf) do { LAS unsigned char* sb = lds + (buf) * DA_STG; _Pragma("unroll") for (int i = 0; i < 2; ++i) { const int p = tid + 512 * i, kr = p >> 4, c16 = p & 15; *(LAS u32x4*)(sb + kr * DA_KSTR + c16 * 16) = kreg[i]; } \
        _Pragma("unroll") for (int i = 0; i < 2; ++i) { LAS bf16* vt = (LAS bf16*)(sb + DA_KBYTES + ((2 * w + i) * 8) * DA_VSTR + lane * 2); const unsigned* vv = (const unsigned*)&vreg[i]; \
            _Pragma("unroll") for (int e = 0; e < 4; ++e) { vt[(2 * e) * (DA_VSTR / 2)] = (bf16)(vv[e] & 0xffffu); vt[(2 * e + 1) * (DA_VSTR / 2)] = (bf16)(vv[e] >> 16); } } } while (0)
    DA_LOAD(kt0); DA_STORE(kt0 & 1);
    __syncthreads();
    for (int kt = kt0; kt < 4; ++kt) {
        if (kt + 1 < 4) DA_LOAD(kt + 1);
        const LAS unsigned char* sb = lds + (kt & 1) * DA_STG;
        if (64 * kt + 63 >= 32 * qs && 64 * kt <= 32 * qs + 31 + 128) {
            f32x16 st[2];
#pragma unroll
            for (int mt = 0; mt < 2; ++mt) { for (int e = 0; e < 16; ++e) st[mt][e] = 0.f;
#pragma unroll
                for (int ks = 0; ks < 4; ++ks) { const bf16x8 a = *(const LAS bf16x8*)(sb + (32 * mt + r) * DA_KSTR + (hd * 64 + 16 * ks + 8 * hh) * 2); st[mt] = MFMA32(a, qf[ks], st[mt]); } }
#pragma unroll
            for (int mt = 0; mt < 2; ++mt)
#pragma unroll
                for (int e = 0; e < 16; ++e) { const int uu = 64 * kt + 32 * mt + (e & 3) + 8 * (e >> 2) + 4 * hh, delta = 128 + qi - uu; const bool ok = delta >= 0 && delta <= 128;
                    st[mt][e] = ok ? st[mt][e] * (0.125f * 1.44269504089f) + bl[hd * 132 + (ok ? delta : 0)] : -1e30f; }
            float mx = st[0][0];
#pragma unroll
            for (int mt = 0; mt < 2; ++mt)
#pragma unroll
                for (int e = 0; e < 16; ++e) mx = fmaxf(mx, st[mt][e]);
            mx = fmaxf(mx, __shfl_xor(mx, 32));
            const float mnew = fmaxf(mrow, mx), alpha = exp2f(mrow - mnew); mrow = mnew;
            float ls = 0.f;
#pragma unroll
            for (int mt = 0; mt < 2; ++mt)
#pragma unroll
                for (int e = 0; e < 16; ++e) { const float p = exp2f(st[mt][e] - mnew); st[mt][e] = p; ls += p; }
            lrow = lrow * alpha + ls;
            O[0] *= alpha; O[1] *= alpha;
            bf16x8 pf[2][2];
#pragma unroll
            for (int mt = 0; mt < 2; ++mt)
#pragma unroll
                for (int s = 0; s < 2; ++s) { u32x4 pk = {pk2(st[mt][8 * s], st[mt][8 * s + 1]), pk2(st[mt][8 * s + 2], st[mt][8 * s + 3]), pk2(st[mt][8 * s + 4], st[mt][8 * s + 5]), pk2(st[mt][8 * s + 6], st[mt][8 * s + 7])};
                    pf[mt][s] = __builtin_bit_cast(bf16x8, pk); }
#pragma unroll
            for (int dvt = 0; dvt < 2; ++dvt)
#pragma unroll
                for (int mt = 0; mt < 2; ++mt)
#pragma unroll
                    for (int s = 0; s < 2; ++s) { const LAS unsigned char* vp = sb + DA_KBYTES + (hd * 64 + dvt * 32 + r) * DA_VSTR + (32 * mt + 16 * s + 4 * hh) * 2;
                        const s16x4 lo = *(const LAS s16x4*)vp, hi = *(const LAS s16x4*)(vp + 16); const bf16x8 a = __builtin_shufflevector(lo, hi, 0, 1, 2, 3, 4, 5, 6, 7);
                        O[dvt] = MFMA32(a, pf[mt][s], O[dvt]); }
        }
        if (kt + 1 < 4) DA_STORE((kt + 1) & 1);
        __syncthreads();
    }
    lrow += __shfl_xor(lrow, 32);
    const float inv = 1.f / lrow;
    const int tokg = b * SEQ + qtok;
    bf16* orow = P32(DPO, (gi * T + tokg) * 512 + h * 64);
#pragma unroll
    for (int dvt = 0; dvt < 2; ++dvt)
#pragma unroll
        for (int g4 = 0; g4 < 4; ++g4) { u32x2 o = {pk2(O[dvt][4 * g4] * inv, O[dvt][4 * g4 + 1] * inv), pk2(O[dvt][4 * g4 + 2] * inv, O[dvt][4 * g4 + 3] * inv)};
            *(u32x2*)(orow + dvt * 32 + 8 * g4 + 4 * hh) = o; }
    if (hh == 0) { *P32(DPM, (gi * T + tokg) * 8 + h) = mrow; *P32(DPL, (gi * T + tokg) * 8 + h) = lrow; }
#undef DA_LOAD
#undef DA_STORE
}
DI void dil_merge(const bf16* DPO, const float* DPM, const float* DPL, bf16* MIX, int wv) {
    const int gt = blockIdx.x * 512 + otid(wv), NT_ = gridDim.x * 512;
    for (int i = gt; i < T * 64; i += NT_) { const int tok = i >> 6, c8 = i & 63, h = c8 >> 3;
        float m[3], l[3];
#pragma unroll
        for (int g = 0; g < 3; ++g) { m[g] = DPM[((size_t)g * T + tok) * 8 + h]; l[g] = DPL[((size_t)g * T + tok) * 8 + h]; }
        const float M = fmaxf(m[0], fmaxf(m[1], m[2])); float wsum = 0.f, wg[3];
#pragma unroll
        for (int g = 0; g < 3; ++g) { wg[g] = exp2f(m[g] - M) * l[g]; wsum += wg[g]; }
        const float inv = 1.f / wsum; float o[8];
#pragma unroll
        for (int e = 0; e < 8; ++e) o[e] = 0.f;
#pragma unroll
        for (int g = 0; g < 3; ++g) { const u32x4 v = *(const u32x4*)(DPO + ((size_t)g * T + tok) * 512 + c8 * 8); const float wn = wg[g] * inv;
            o[0] += wn * bflo(v.x); o[1] += wn * bfhi(v.x); o[2] += wn * bflo(v.y); o[3] += wn * bfhi(v.y); o[4] += wn * bflo(v.z); o[5] += wn * bfhi(v.z); o[6] += wn * bflo(v.w); o[7] += wn * bfhi(v.w); }
        u32x4 r = {pk2(o[0], o[1]), pk2(o[2], o[3]), pk2(o[4], o[5]), pk2(o[6], o[7])}; *(u32x4*)(MIX + (size_t)tok * 2048 + c8 * 8) = r; }
}

DI void rwkv_prep(const bf16* ZR, const float* mu, bf16* LIN, int wv) {
    const int gt = blockIdx.x * 512 + otid(wv), NT_ = gridDim.x * 512;
    for (int i = gt; i < T * 48; i += NT_) { const int tok = i / 48, c0 = (i % 48) * 8, s = tok % SEQ; float o[8];
        if (c0 < 352) { const u32x4 z = *(const u32x4*)(ZR + (size_t)tok * RW_IN + 4608 + c0); u32x4 zp = {0u, 0u, 0u, 0u}; if (s > 0) zp = *(const u32x4*)(ZR + (size_t)(tok - 1) * RW_IN + 4608 + c0);
            const unsigned* zz = (const unsigned*)&z; const unsigned* pp = (const unsigned*)&zp;
#pragma unroll
            for (int e = 0; e < 8; ++e) { const float zv = (e & 1) ? bfhi(zz[e >> 1]) : bflo(zz[e >> 1]), pv = (e & 1) ? bfhi(pp[e >> 1]) : bflo(pp[e >> 1]); const float xs = zv + (pv - zv) * mu[4608 + c0 + e];
                o[e] = c0 < 64 ? tanhf(xs) : (c0 < 128 ? xs : sigmoidf_(xs)); } }
        else {
#pragma unroll
            for (int e = 0; e < 8; ++e) o[e] = 0.f; }
        u32x4 r = {pk2(o[0], o[1]), pk2(o[2], o[3]), pk2(o[4], o[5]), pk2(o[6], o[7])}; *(u32x4*)(LIN + (size_t)tok * 384 + c0) = r; }
}
struct EpiLora { static constexpr bool PERM = true;
    bf16 *WDEC, *AA, *GG; const float *w0, *a0;
    DI void operator()(const Acc& acc, const Unit& u, int wr, int wc, int fr, int fq) const {
        const int kind = u.pn / 6;
        EPI_ROWS_BEGIN
#pragma unroll
            for (int bj = 0; bj < 2; ++bj) { const int col = (u.pn % 6) * 256 + 128 * bj + 32 * wc + 8 * fq; f32x4 v0 = acc[ai][bj][m][0], v1 = acc[ai][bj][m][1];
                if (kind == 0) { const f32x4 b0 = *(const f32x4*)P32(w0, col), b1 = *(const f32x4*)P32(w0, col + 4);
#pragma unroll
                    for (int e = 0; e < 4; ++e) { v0[e] = -0.6065306597f * sigmoidf_(v0[e] + b0[e]); v1[e] = -0.6065306597f * sigmoidf_(v1[e] + b1[e]); }
                    *(u32x4*)P32(WDEC, row * RWW + col) = pack8(v0, v1); }
                else if (kind == 1) { const f32x4 b0 = *(const f32x4*)P32(a0, col), b1 = *(const f32x4*)P32(a0, col + 4);
#pragma unroll
                    for (int e = 0; e < 4; ++e) { v0[e] = sigmoidf_(v0[e] + b0[e]); v1[e] = sigmoidf_(v1[e] + b1[e]); }
                    *(u32x4*)P32(AA, row * RWW + col) = pack8(v0, v1); }
                else *(u32x4*)P32(GG, row * RWW + col) = pack8(v0, v1); }
        EPI_ROWS_END
    }
};
DI float dpp_xor1(float x) { return __builtin_bit_cast(float, __builtin_amdgcn_mov_dpp(__builtin_bit_cast(int, x), 0xB1, 0xF, 0xF, true)); }
DI float dpp_xor2(float x) { return __builtin_bit_cast(float, __builtin_amdgcn_mov_dpp(__builtin_bit_cast(int, x), 0x4E, 0xF, 0xF, true)); }
DI float dpp_hmir(float x) { return __builtin_bit_cast(float, __builtin_amdgcn_mov_dpp(__builtin_bit_cast(int, x), 0x141, 0xF, 0xF, true)); }
DI float red8(float x) { x += dpp_xor1(x); x += dpp_xor2(x); x += dpp_hmir(x); return x; }
constexpr int RS_CH = 16, RS_ARR = RS_CH * 64 * 4, RS_BUF = 6 * RS_ARR + 3 * RS_CH * 4 + 64, RS_Y = 2 * RS_BUF;
DI void rwkv_scan_unit(const KArgs& a, LAS unsigned char* lds, int unit, int wv) {
    const int tid = otid(wv), lane = tid & 63, w = tid >> 6, il = lane >> 3, cg = lane & 7, row = 8 * w + il;
    const int b = unit / 24, h = unit % 24;
    const bf16* ZR = (const bf16*)(a.ws + A_ZR); const bf16* WDEC = (const bf16*)(a.ws + A_WDEC); const bf16* AA = (const bf16*)(a.ws + A_AA); const bf16* GG = (const bf16*)(a.ws + A_GG); bf16* MIX = (bf16*)(a.ws + WS_H);
    const int st = tid >> 5, sj = 2 * (tid & 31), col = h * 64 + sj;
    const float* mu = a.in[I_MU];
    const float mr0 = mu[col], mr1 = mu[col + 1], mk0 = mu[1536 + col], mk1 = mu[1536 + col + 1], mv0 = mu[3072 + col], mv1 = mu[3072 + col + 1];
    const float kk0 = a.in[I_KK][col], kk1 = a.in[I_KK][col + 1], ka0 = a.in[I_KA][col], ka1 = a.in[I_KA][col + 1], rk0 = a.in[I_RK][col], rk1 = a.in[I_RK][col + 1];
    const float lg0 = a.in[I_LNXG][col], lg1 = a.in[I_LNXG][col + 1], lb0 = a.in[I_LNXB][col], lb1 = a.in[I_LNXB][col + 1];
    unsigned zr, zk, zv, pr, pk_, pv, za, zw;
#define RS_LOAD(c) do { const int s = (c) * RS_CH + st; const size_t tok = (size_t)b * SEQ + s; const bf16* z = ZR + tok * RW_IN + col; \
        zr = *(const unsigned*)z; zk = *(const unsigned*)(z + 1536); zv = *(const unsigned*)(z + 3072); \
        if (s > 0) { pr = *(const unsigned*)(z - RW_IN); pk_ = *(const unsigned*)(z - RW_IN + 1536); pv = *(const unsigned*)(z - RW_IN + 3072); } else { pr = 0u; pk_ = 0u; pv = 0u; } \
        za = *(const unsigned*)(AA + tok * RWW + col); zw = *(const unsigned*)(WDEC + tok * RWW + col); } while (0)
#define RS_STORE(buf) do { LAS float* B_ = (LAS float*)(lds + (buf) * RS_BUF); \
        const float r0 = bflo(zr) + (bflo(pr) - bflo(zr)) * mr0, r1 = bfhi(zr) + (bfhi(pr) - bfhi(zr)) * mr1; \
        const float k0 = bflo(zk) + (bflo(pk_) - bflo(zk)) * mk0, k1 = bfhi(zk) + (bfhi(pk_) - bfhi(zk)) * mk1; \
        const float v0 = bflo(zv) + (bflo(pv) - bflo(zv)) * mv0, v1 = bfhi(zv) + (bfhi(pv) - bfhi(zv)) * mv1; \
        const float a0_ = bflo(za), a1_ = bfhi(za), w0_ = __expf(bflo(zw)), w1_ = __expf(bfhi(zw)); \
        float q0 = k0 * kk0, q1 = k1 * kk1; float nn = q0 * q0 + q1 * q1; nn += __shfl_xor(nn, 1); nn += __shfl_xor(nn, 2); nn += __shfl_xor(nn, 4); nn += __shfl_xor(nn, 8); nn += __shfl_xor(nn, 16); \
        const float invn = 1.f / fmaxf(sqrtf(nn), 1e-12f); q0 *= invn; q1 *= invn; \
        const float km0 = k0 * (1.f + (a0_ - 1.f) * ka0), km1 = k1 * (1.f + (a1_ - 1.f) * ka1), b0_ = q0 * a0_, b1_ = q1 * a1_; \
        float br = b0_ * r0 + b1_ * r1, kr = km0 * r0 + km1 * r1, bs = r0 * km0 * rk0 + r1 * km1 * rk1; \
        _Pragma("unroll") for (int o = 1; o < 32; o <<= 1) { br += __shfl_xor(br, o); kr += __shfl_xor(kr, o); bs += __shfl_xor(bs, o); } \
        const int ix = st * 64 + sj; \
        *(LAS f32x2*)(B_ + ix) = (f32x2){w0_, w1_}; *(LAS f32x2*)(B_ + 1024 + ix) = (f32x2){km0, km1}; *(LAS f32x2*)(B_ + 2048 + ix) = (f32x2){-q0, -q1}; *(LAS f32x2*)(B_ + 3072 + ix) = (f32x2){b0_, b1_}; \
        *(LAS f32x2*)(B_ + 4096 + ix) = (f32x2){w0_ * r0, w1_ * r1}; *(LAS f32x2*)(B_ + 5120 + ix) = (f32x2){v0, v1}; \
        if ((tid & 31) == 0) { B_[6144 + st] = br; B_[6144 + 16 + st] = kr; B_[6144 + 32 + st] = bs; } } while (0)
    f32x2 S[4];
#pragma unroll
    for (int i = 0; i < 4; ++i) S[i] = (f32x2){0.f, 0.f};
    LAS float* Y = (LAS float*)(lds + RS_Y);
    __syncthreads();
    RS_LOAD(0); RS_STORE(0);
    __syncthreads();
    for (int c = 0; c < SEQ / RS_CH; ++c) {
        if (c + 1 < SEQ / RS_CH) RS_LOAD(c + 1);
        const LAS float* B_ = (const LAS float*)(lds + (c & 1) * RS_BUF);
#pragma unroll 4
        for (int t = 0; t < RS_CH; ++t) { const int o = t * 64 + cg * 8;
            const f32x4 wa = *(const LAS f32x4*)(B_ + o), wb = *(const LAS f32x4*)(B_ + o + 4), ka = *(const LAS f32x4*)(B_ + 1024 + o), kb = *(const LAS f32x4*)(B_ + 1024 + o + 4);
            const f32x4 aa = *(const LAS f32x4*)(B_ + 2048 + o), ab = *(const LAS f32x4*)(B_ + 2048 + o + 4), ba = *(const LAS f32x4*)(B_ + 3072 + o), bb = *(const LAS f32x4*)(B_ + 3072 + o + 4);
            const f32x4 ra = *(const LAS f32x4*)(B_ + 4096 + o), rb = *(const LAS f32x4*)(B_ + 4096 + o + 4);
            const float vi = B_[5120 + t * 64 + row], brs = B_[6144 + t], krs = B_[6144 + 16 + t];
            f32x2 sa2 = S[0] * (f32x2){aa.x, aa.y} + S[1] * (f32x2){aa.z, aa.w} + S[2] * (f32x2){ab.x, ab.y} + S[3] * (f32x2){ab.z, ab.w};
            f32x2 yp2 = S[0] * (f32x2){ra.x, ra.y} + S[1] * (f32x2){ra.z, ra.w} + S[2] * (f32x2){rb.x, rb.y} + S[3] * (f32x2){rb.z, rb.w};
            const float sa = red8(sa2.x + sa2.y), yp = red8(yp2.x + yp2.y);
            const f32x2 sav = {sa, sa}, vv = {vi, vi};
            S[0] = S[0] * (f32x2){wa.x, wa.y} + sav * (f32x2){ba.x, ba.y} + vv * (f32x2){ka.x, ka.y};
            S[1] = S[1] * (f32x2){wa.z, wa.w} + sav * (f32x2){ba.z, ba.w} + vv * (f32x2){ka.z, ka.w};
            S[2] = S[2] * (f32x2){wb.x, wb.y} + sav * (f32x2){bb.x, bb.y} + vv * (f32x2){kb.x, kb.y};
            S[3] = S[3] * (f32x2){wb.z, wb.w} + sav * (f32x2){bb.z, bb.w} + vv * (f32x2){kb.z, kb.w};
            if (cg == 0) Y[t * 64 + row] = yp + sa * brs + vi * krs; }
        __syncthreads();
        { const float y0 = Y[st * 64 + sj], y1 = Y[st * 64 + sj + 1]; float sm = y0 + y1;
#pragma unroll
          for (int o = 1; o < 32; o <<= 1) sm += __shfl_xor(sm, o);
          const float mean = sm * (1.f / 64.f), d0 = y0 - mean, d1 = y1 - mean; float vr = d0 * d0 + d1 * d1;
#pragma unroll
          for (int o = 1; o < 32; o <<= 1) vr += __shfl_xor(vr, o);
          const float rstd = rsqrtf(vr * (1.f / 64.f) + 64e-5f), bs = B_[6144 + 32 + st], v0 = B_[5120 + st * 64 + sj], v1 = B_[5120 + st * 64 + sj + 1];
          const size_t tok = (size_t)b * SEQ + c * RS_CH + st; const unsigned gg = *(const unsigned*)(GG + tok * RWW + col);
          const float o0 = (d0 * rstd * lg0 + lb0 + bs * v0) * bflo(gg), o1 = (d1 * rstd * lg1 + lb1 + bs * v1) * bfhi(gg);
          *(unsigned*)(MIX + tok * 2048 + 512 + col) = pk2(o0, o1); }
        if (c + 1 < SEQ / RS_CH) RS_STORE((c + 1) & 1);
        __syncthreads();
    }
#undef RS_LOAD
#undef RS_STORE
}

constexpr int N_PHASES = 21;
__global__ void __launch_bounds__(512, 2) fwd(KArgs a) {
    extern __shared__ __attribute__((aligned(16))) unsigned char lds_[];
    LAS unsigned char* lds = (LAS unsigned char*)lds_;
    const int wv = __builtin_amdgcn_readfirstlane((int)threadIdx.x >> 6), G = gridDim.x, bid = blockIdx.x;
    volatile LAS unsigned* MISC = (volatile LAS unsigned*)(lds + LDS_MISC);
    if (wv == 0) MISC[lane_id()] = 0u;
    __syncthreads();
    unsigned char* ws0 = a.ws;
#if N_LAUNCH_MODE == 0
    XcdBarrier bar = xcd_barrier_post((unsigned*)(ws0 + CTL_BAR), MISC + 8, wv);
#define SEAM(k) do { if (IN(k) && IN((k) + 1)) xcd_barrier(bar); } while (0)
#else
#define SEAM(k) do { } while (0)
#endif
    const int lo = a.ph_lo, hi = a.ph_hi;
#ifndef PH_MASK
#define PH_MASK 0xFFFFFFFFu
#endif
#define IN(k) (((PH_MASK >> (k)) & 1u) && lo <= (k) && (k) < hi)
#define MOD ((float*)(ws + CTL_MOD))
#define Hb ((bf16*)(ws + WS_H))
#define X1 ((float*)(ws + WS_X1))
#define XPRE ((float*)(ws + A_XPRE))
    pg8::StaticOrder SO;

    if (IN(0)) { unsigned char* ws = wsl(a.ws); p0_prologue(a, lds, wv); } SEAM(0);
    if (IN(1)) { unsigned char* ws = wsl(a.ws); modulate_rows(a.in[I_X], (const unsigned long long*)(ws + CTL_MODI), MOD, Hb, wv); } SEAM(1);
    if (IN(2)) { unsigned char* ws = wsl(a.ws); pg8::Gemm g{Hb, (const bf16*)(ws + WS_W_IN0), 2048, 2048, 2048}; SO.init(T, 2048, G, bid);
        EpiIn0 E{(bf16*)(ws + A_QC), (bf16*)(ws + A_KVC), (bf16*)(ws + A_KR), (bf16*)(ws + A_XH), (float*)(ws + CTL_SSQ)};
        pg8::gemm_phase<EpiIn0, pg8::StaticOrder, false>(lds, g, SO, E, wv); } SEAM(2);
    if (IN(3)) { unsigned char* ws = wsl(a.ws);
        krope_pass((const bf16*)(ws + A_KR), (const float*)(ws + WS_ROPE), (bf16*)(ws + A_KF), wv);
        { pg8::Gemm g{(const bf16*)(ws + A_QC), (const bf16*)(ws + WS_W_UQ), 512, 512, 512}; SO.init(T, 1536, G, bid);
          EpiQ E{(bf16*)(ws + A_Q), (const float*)(ws + CTL_SSQ), (const float*)(ws + WS_ROPE)}; pg8::gemm_phase<EpiQ, pg8::StaticOrder, false>(lds, g, SO, E, wv); }
        { pg8::Gemm g{(const bf16*)(ws + A_KVC), (const bf16*)(ws + WS_W_UKV), 256, 256, 256}; SO.init(T, 2048, G, bid);
          EpiKV E{(bf16*)(ws + A_KF), (bf16*)(ws + A_V), (const float*)(ws + CTL_SSQ)}; pg8::gemm_phase<EpiKV, pg8::StaticOrder, false>(lds, g, SO, E, wv); }
        { pg8::Gemm g{(const bf16*)(ws + A_XH), (const bf16*)(ws + WS_S5BE), 384, 256, 256}; S5Order S{G, bid}; EpiS5E E{(float*)(ws + A_ES)}; pg8::gemm_phase<EpiS5E, S5Order, false>(lds, g, S, E, wv); }
    } SEAM(3);
    if (IN(4)) { unsigned char* ws = wsl(a.ws);
        s5_carry((const float*)(ws + A_ES), (const float*)(ws + WS_S5L), (bf16*)(ws + A_XH), wv);
        for (int u = bid; u < 256; u += G) mla_attn_unit(lds, (const bf16*)(ws + A_Q), (const bf16*)(ws + A_KF), (const bf16*)(ws + A_V), Hb, u, wv);
    } SEAM(4);
    if (IN(5)) { unsigned char* ws = wsl(a.ws); pg8::Gemm g{(const bf16*)(ws + A_XH), (const bf16*)(ws + WS_S5BY), 384, 384, 384}; S5Order S{G, bid};
        EpiS5Y E{(bf16*)(ws + A_YS5), (const bf16*)(ws + A_XH), a.in[I_S5D]}; pg8::gemm_phase<EpiS5Y, S5Order, false>(lds, g, S, E, wv); } SEAM(5);
    if (IN(6)) { unsigned char* ws = wsl(a.ws); pg8::Gemm g{(const bf16*)(ws + A_YS5), (const bf16*)(ws + WS_W_GLU), 1024, 1024, 1024}; SO.init(T, 1024, G, bid);
        EpiGlu E{Hb, (const bf16*)(ws + A_YS5)}; pg8::gemm_phase<EpiGlu, pg8::StaticOrder, false>(lds, g, SO, E, wv); } SEAM(6);
    if (IN(7)) { unsigned char* ws = wsl(a.ws); pg8::Gemm g{Hb, (const bf16*)(ws + WS_W_OUT0), 2048, 2048, 2048}; SO.init(T, 2048, G, bid);
        EpiRes E{XPRE, a.in[I_X], MOD + 2 * 2048}; pg8::gemm_phase<EpiRes, pg8::StaticOrder, false>(lds, g, SO, E, wv); } SEAM(7);
#define MOE_PHASES(layer, pb) \
        if (IN(pb)) { unsigned char* ws = wsl(a.ws); ln_router_phase(a, lds, layer, XPRE, X1, Hb, wv); } SEAM(pb); \
        if (IN(pb + 1)) { unsigned char* ws = wsl(a.ws); moe_table(a, lds, layer, wv); pg8::Gemm g{Hb, (const bf16*)(ws + WS_W_GU), 2048, 2048, 2048}; \
            MoeOrder<4> S{G, bid, layer, (const LAS int*)(lds + LDS_TAB), (const int*)(ws + A_TOKL)}; EpiGateUp E{(bf16*)(ws + A_ACT)}; pg8::gemm_phase<EpiGateUp, MoeOrder<4>, true>(lds, g, S, E, wv); } SEAM(pb + 1); \
        if (IN(pb + 2)) { unsigned char* ws = wsl(a.ws); moe_table(a, lds, layer, wv); pg8::Gemm g{(const bf16*)(ws + A_ACT), (const bf16*)(ws + WS_W_DN), 512, 512, 512}; \
            MoeOrder<8> S{G, bid, layer, (const LAS int*)(lds + LDS_TAB), (const int*)(ws + A_TOKL)}; EpiDown E{(bf16*)(ws + A_YS)}; pg8::gemm_phase<EpiDown, MoeOrder<8>, false>(lds, g, S, E, wv); } SEAM(pb + 2); \
        if (IN(pb + 3)) { unsigned char* ws = wsl(a.ws); ln_ffn_phase(a, layer, X1, a.out, layer == 0 ? Hb : nullptr, wv); } SEAM(pb + 3);
    MOE_PHASES(0, 8)
    if (IN(12)) { unsigned char* ws = wsl(a.ws); pg8::Gemm g{Hb, (const bf16*)(ws + WS_W_IN1), 2048, 2048, 2048}; SO.init(T, 9728, G, bid);
        EpiIn1 E{(bf16*)(ws + A_ZD), (bf16*)(ws + A_ZR)}; pg8::gemm_phase<EpiIn1, pg8::StaticOrder, false>(lds, g, SO, E, wv); } SEAM(12);
    if (IN(13)) { unsigned char* ws = wsl(a.ws); rwkv_prep((const bf16*)(ws + A_ZR), a.in[I_MU], (bf16*)(ws + A_LIN), wv);
        for (int u = bid; u < 1536; u += G) dil_attn_unit(lds, (const bf16*)(ws + A_ZD), (const float*)(ws + WS_BIAS), (bf16*)(ws + A_DPO), (float*)(ws + A_DPM), (float*)(ws + A_DPL), u, wv); } SEAM(13);
    if (IN(14)) { unsigned char* ws = wsl(a.ws); dil_merge((const bf16*)(ws + A_DPO), (const float*)(ws + A_DPM), (const float*)(ws + A_DPL), Hb, wv);
        pg8::Gemm g{(const bf16*)(ws + A_LIN), (const bf16*)(ws + WS_W_LORA), 384, 384, 384}; SO.init(T, 4608, G, bid);
        EpiLora E{(bf16*)(ws + A_WDEC), (bf16*)(ws + A_AA), (bf16*)(ws + A_GG), a.in[I_W0], a.in[I_A0]}; pg8::gemm_phase<EpiLora, pg8::StaticOrder, false>(lds, g, SO, E, wv);
} SEAM(14);
    if (IN(15)) { unsigned char* ws = wsl(a.ws); for (int u = bid; u < 96; u += G) rwkv_scan_unit(a, lds, u, wv); } SEAM(15);
    if (IN(16)) { unsigned char* ws = wsl(a.ws); pg8::Gemm g{Hb, (const bf16*)(ws + WS_W_OUT1), 2048, 2048, 2048}; SO.init(T, 2048, G, bid);
        EpiRes E{XPRE, a.out, MOD + 4 * 12288 + 2 * 2048}; pg8::gemm_phase<EpiRes, pg8::StaticOrder, false>(lds, g, SO, E, wv); } SEAM(16);
    MOE_PHASES(1, 17)
#undef MOE_PHASES
#undef IN
#undef SEAM
#undef MOD
#undef Hb
#undef X1
#undef XPRE
}


#ifdef DBG_DUMP_OFF
__global__ void dbg_dump(const unsigned char* ws, float* out) {
    const size_t n = (size_t)T * D;
    for (size_t i = (size_t)blockIdx.x * 256 + threadIdx.x; i < n; i += (size_t)gridDim.x * 256) {
#if defined(DBG_DUMP_RT)
        { const int m = (int)(i >> 11), c = (int)(i & 2047); const int* RTE = (const int*)(ws + A_RT); const float* RTW = (const float*)(RTE + 4 * T); out[i] = c < 2 ? (float)RTE[2 * m + c] : (c < 4 ? RTW[2 * m + c - 2] : 0.f); }
#elif DBG_DUMP_F32
        out[i] = ((const float*)(ws + DBG_DUMP_OFF))[i];
#else
        out[i] = bf2f(((const bf16*)(ws + DBG_DUMP_OFF))[i]);
#endif
    }
}
#endif
extern "C" void kernel_launch(void* const* d_in, const int* in_sizes, int n_in, void* d_out, int out_size, void* d_ws, size_t ws_size, hipStream_t stream) {
    static int grid = 0;
    if (grid == 0) {
        if (n_in != 41 || out_size != T * D || ws_size < WS_END) { fprintf(stderr, "kernel_launch: unexpected shapes: n_in %d out %d ws %zu (need %zu)\n", n_in, out_size, ws_size, (size_t)WS_END); grid = -1; return; }
        int dev = 0, cus = 0, per_cu = 0;
        if (hipGetDevice(&dev) != hipSuccess || hipDeviceGetAttribute(&cus, hipDeviceAttributeMultiprocessorCount, dev) != hipSuccess) { grid = -1; return; }
        if (hipFuncSetAttribute((const void*)fwd, hipFuncAttributeMaxDynamicSharedMemorySize, LDS_BYTES) != hipSuccess) { fprintf(stderr, "kernel_launch: hipFuncSetAttribute failed\n"); grid = -1; return; }
        if (hipOccupancyMaxActiveBlocksPerMultiprocessor(&per_cu, (const void*)fwd, 512, LDS_BYTES) != hipSuccess || per_cu < 1) fprintf(stderr, "kernel_launch: occupancy query says %d blocks/CU\n", per_cu);
        (void)hipGetLastError();
        grid = cus;
    }
    if (grid < 0) return;
    (void)hipMemsetAsync(d_ws, 0, CTL_ZERO_BYTES, stream);
#ifdef DBG_ZERO_WS
    (void)hipMemsetAsync((char*)d_ws + CTL_ZERO_BYTES, 0, WS_END - CTL_ZERO_BYTES, stream);
#endif
    KArgs a{};
    for (int i = 0; i < 41; ++i) a.in[i] = (const float*)d_in[i];
    a.out = (float*)d_out; a.ws = (unsigned char*)d_ws;
#if N_LAUNCH_MODE == 0
    a.ph_lo = 0; a.ph_hi = N_PHASES;
    hipLaunchKernelGGL(fwd, dim3(grid), dim3(512), LDS_BYTES, stream, a);
#else
#ifdef DBG_DUMP_AFTER
    for (int p = 0; p <= DBG_DUMP_AFTER; ++p) { a.ph_lo = p; a.ph_hi = p + 1; hipLaunchKernelGGL(fwd, dim3(grid), dim3(512), LDS_BYTES, stream, a); }
#ifdef DBG_DUMP_OFF
    hipLaunchKernelGGL(dbg_dump, dim3(2048), dim3(256), 0, stream, (const unsigned char*)d_ws, (float*)d_out);
#endif
#else
    for (int p = 0; p < N_PHASES; ++p) { a.ph_lo = p; a.ph_hi = p + 1; hipLaunchKernelGGL(fwd, dim3(grid), dim3(512), LDS_BYTES, stream, a); }
#endif
#endif
}
```

```cpp
#include <hip/hip_runtime.h>
#include <cstdio>
#include <cstdint>

#ifndef N_LAUNCH_MODE
#define N_LAUNCH_MODE 0
#endif
#ifndef CHK
#define CHK 0
#endif

#define GAS __attribute__((address_space(1)))
#define LAS __attribute__((address_space(3)))
typedef unsigned short bf16;
typedef short bf16x8 __attribute__((ext_vector_type(8)));
typedef short s16x4 __attribute__((ext_vector_type(4)));
typedef float f32x4 __attribute__((ext_vector_type(4)));
typedef float f32x16 __attribute__((ext_vector_type(16)));
typedef float f32x2 __attribute__((ext_vector_type(2)));
typedef unsigned u32x4 __attribute__((ext_vector_type(4)));
typedef unsigned u32x2 __attribute__((ext_vector_type(2)));
#define DI __device__ __forceinline__

constexpr int D = 2048, NB = 4, SEQ = 4096, T = NB * SEQ;
constexpr float LN_EPS = 1e-5f, RMS_EPS = 1e-6f;
constexpr float DN_ALPHA = 1.41421356237f;
constexpr int EVEN_IN = 1856, ODD_IN = 9568, DIL_IN = 4608, RW_IN = 4960, RWW = 1536;
constexpr int NEXP = 16, DEXP = 512;

typedef __bf16 bf16x2_t __attribute__((ext_vector_type(2)));
DI unsigned pk2(float lo, float hi) { f32x2 v = {lo, hi}; bf16x2_t r = __builtin_convertvector(v, bf16x2_t); return __builtin_bit_cast(unsigned, r); }
DI float bf2f(bf16 b) { return __uint_as_float(((unsigned)b) << 16); }
DI float bflo(unsigned u) { return __uint_as_float(u << 16); }
DI float bfhi(unsigned u) { return __uint_as_float(u & 0xffff0000u); }
DI bf16 f2bf(float f) { unsigned u = __float_as_uint(f); u += 0x7fffu + ((u >> 16) & 1u); return (bf16)(u >> 16); }
DI float wave_sum(float v) {
#pragma unroll
    for (int o = 1; o < 64; o <<= 1) v += __shfl_xor(v, o);
    return v;
}
DI unsigned char* wsl(unsigned char* p) { asm volatile("" : "+s"(p)); return p; }
DI int lane_id() { return (int)__builtin_amdgcn_mbcnt_hi(~0u, __builtin_amdgcn_mbcnt_lo(~0u, 0u)); }
DI int otid(int wv) { int t = wv * 64 + lane_id(); asm volatile("" : "+v"(t)); return t; }
DI float dpp_xor1(float x) { return __builtin_bit_cast(float, __builtin_amdgcn_mov_dpp(__builtin_bit_cast(int, x), 0xB1, 0xF, 0xF, true)); }
DI float dpp_xor2(float x) { return __builtin_bit_cast(float, __builtin_amdgcn_mov_dpp(__builtin_bit_cast(int, x), 0x4E, 0xF, 0xF, true)); }
DI float dpp_hmir(float x) { return __builtin_bit_cast(float, __builtin_amdgcn_mov_dpp(__builtin_bit_cast(int, x), 0x141, 0xF, 0xF, true)); }
template <int N> DI float dpp_ror(float x) { return __builtin_bit_cast(float, __builtin_amdgcn_mov_dpp(__builtin_bit_cast(int, x), 0x120 + N, 0xF, 0xF, true)); }
DI float dpp_rmir(float x) { return __builtin_bit_cast(float, __builtin_amdgcn_mov_dpp(__builtin_bit_cast(int, x), 0x140, 0xF, 0xF, true)); }
DI float red8(float x) { x += dpp_xor1(x); x += dpp_xor2(x); x += dpp_hmir(x); return x; }
DI float red16(float x) { x += dpp_xor1(x); x += dpp_xor2(x); x += dpp_hmir(x); x += dpp_rmir(x); return x; }
DI float sat448(float x) { return __builtin_amdgcn_fmed3f(x, -448.f, 448.f); }
DI unsigned pk4_fp8(float a, float b, float c, float d) { int w = 0; w = __builtin_amdgcn_cvt_pk_fp8_f32(sat448(a), sat448(b), w, false); w = __builtin_amdgcn_cvt_pk_fp8_f32(sat448(c), sat448(d), w, true); return (unsigned)w; }
constexpr float F8_WSCALE = 32.f;
DI float sigmoidf_(float x) { return 1.f / (1.f + __expf(-x)); }

namespace pg8 {
constexpr int BM = 256, BK = 64, HALF = 128, HTB = HALF * BK * 2, STAGE_BYTES = 8 * HTB, NXCD = 8, WGM = 8;
__host__ __device__ __forceinline__ int lds_byte(int r, int c) { const int st = (r >> 4) * 2 + (c >> 5), rr = r & 15, cc = c & 31, ob = rr * 64 + cc * 2; return st * 1024 + (ob ^ (((ob >> 9) & 1) << 5)); }
__host__ __device__ __forceinline__ void stage_rc(int b, int& R, int& C) { const int st = b / 1024, sb = b % 1024, swz = sb ^ (((sb >> 9) & 1) << 5); R = (st >> 1) * 16 + swz / 64; C = (st & 1) * 32 + (swz % 64) / 2; }
__host__ __device__ __forceinline__ int perm32(int rho) { const int n = rho >> 4, i = rho & 15; return 8 * (i >> 2) + 4 * n + (i & 3); }

struct Unit { int pm, pn, aux; };
struct Gemm { const bf16* A; const bf16* Bt; int lda, ldb, K; };

struct StaticOrder {
    int nM, nN, nwg, G, c;
    __host__ __device__ void init(int M, int N, int G_, int c_) { nM = M / BM; nN = N / BM; nwg = nM * nN; G = G_; c = c_; }
    __host__ __device__ bool next(int i, Unit& u) const {
        const long L = (long)i * G + c; if (L >= nwg) return false;
        int wgid = (int)L; { const int q = nwg / NXCD, r = nwg % NXCD, xcd = wgid % NXCD, off = wgid / NXCD; wgid = (xcd < r ? xcd * (q + 1) : r * (q + 1) + (xcd - r) * q) + off; }
        const int nig = WGM * nN, gid = wgid / nig, fm = gid * WGM, gsz = (nM - fm) < WGM ? (nM - fm) : WGM;
        u.pm = fm + ((wgid % nig) % gsz); u.pn = (wgid % nig) / gsz; u.aux = 0; return true;
    }
    __device__ __forceinline__ int arow(const Unit&, int) const { return 0; }
    __device__ __forceinline__ int koff(const Unit&) const { return 0; }
};

typedef int v8i __attribute__((ext_vector_type(8)));
template <class Epi, class Sched, bool GATHER, bool F8 = false>
__device__ __forceinline__ void gemm_phase(LAS unsigned char* lds, const Gemm g, const Sched& S, const Epi& E, int wv) {
    const int tid = otid(wv), wid = __builtin_amdgcn_readfirstlane(tid >> 6), lane = tid & 63, wr = wid >> 2, wc = wid & 3, fr = lane & 15, fq = lane >> 4;
    int K = g.K; asm volatile("" : "+s"(K));
    constexpr int ES = F8 ? 1 : 2;
    const int nt = K / (F8 ? 2 * BK : BK);
    unsigned voffB[2], vA0[2], vA1[2], nA0[2], nA1[2]; int Rr[2], Cc[2];
#pragma unroll
    for (int i = 0; i < 2; ++i) { int R, C; stage_rc(tid * 16 + i * 8192, R, C); const int Rb = Epi::PERM ? ((R & ~31) + perm32(R & 31)) : R;
        Rr[i] = R; Cc[i] = C; voffB[i] = (unsigned)(Rb * g.ldb * ES + C * 2);
        vA0[i] = (unsigned)(R * g.lda * ES + C * 2); vA1[i] = (unsigned)((R + HALF) * g.lda * ES + C * 2); nA0[i] = vA0[i]; nA1[i] = vA1[i]; }
    const size_t kstep = (size_t)(BK * 2);
    const size_t hstepB = (size_t)HALF * g.ldb * ES, tstepB = 2 * hstepB, tstepA = (size_t)BM * g.lda * ES, hstepA = (size_t)HALF * g.lda * ES, rbA = (size_t)g.lda * ES, rbB = (size_t)g.ldb * ES;
    const unsigned ldsw = (unsigned)wid * 1024u;
    const int aoff = lds_byte(wr * 64 + fr, F8 ? fq * 16 : fq * 8), boff = lds_byte(wc * 32 + fr, F8 ? fq * 16 : fq * 8);
#define PG8_SA(b, h) (((b) * 2 + (h)) * HTB)
#define PG8_SB(b, h) ((4 + (b) * 2 + (h)) * HTB)
#define PG8_STAGE(bufoff, gbase, voff) do { _Pragma("unroll") for (int _i = 0; _i < 2; ++_i) \
        __builtin_amdgcn_global_load_lds((const unsigned*)((const char*)(gbase) + (voff)[_i]), (LAS unsigned*)(lds + (bufoff) + ldsw + _i * 8192), 16, 0, 0); } while (0)
#define PG8_STAGE1(bufoff, gbase, voff0, rowbytes) do { __builtin_amdgcn_global_load_lds((const unsigned*)((const char*)(gbase) + (voff0)), (LAS unsigned*)(lds + (bufoff) + ldsw), 16, 0, 0); \
        __builtin_amdgcn_global_load_lds((const unsigned*)((const char*)(gbase) + (size_t)64 * (rowbytes) + (voff0)), (LAS unsigned*)(lds + (bufoff) + ldsw + 8192), 16, 0, 0); } while (0)
#define PG8_STAGEA(bufoff, gbase, half, arr) do { if constexpr (GATHER) PG8_STAGE(bufoff, gbase, arr); else PG8_STAGE1(bufoff, (const char*)(gbase) + (half) * hstepA, vA0[0], rbA); } while (0)
#define PG8_LD32(p) __builtin_bit_cast(v8i, __builtin_shufflevector(*(const LAS u32x4*)(p), *(const LAS u32x4*)((p) + 16), 0, 1, 2, 3, 4, 5, 6, 7))
#define PG8_LDA(dst, b, h) do { if constexpr (F8) { _Pragma("unroll") for (int m = 0; m < 4; ++m) dst##8[m] = PG8_LD32(lds + PG8_SA(b, h) + aoff + m * 2048); } \
        else { _Pragma("unroll") for (int m = 0; m < 4; ++m) _Pragma("unroll") for (int k = 0; k < 2; ++k) dst[m][k] = *(const LAS bf16x8*)(lds + PG8_SA(b, h) + aoff + m * 2048 + k * 1024); } } while (0)
#define PG8_LDB(dst, b, h) do { if constexpr (F8) { _Pragma("unroll") for (int n = 0; n < 2; ++n) dst##8[n] = PG8_LD32(lds + PG8_SB(b, h) + boff + n * 2048); } \
        else { _Pragma("unroll") for (int n = 0; n < 2; ++n) _Pragma("unroll") for (int k = 0; k < 2; ++k) dst[n][k] = *(const LAS bf16x8*)(lds + PG8_SB(b, h) + boff + n * 2048 + k * 1024); } } while (0)
#define PG8_MMA(ai, bj, At, Bt) do { __builtin_amdgcn_s_setprio(1); if constexpr (F8) { _Pragma("unroll") for (int m = 0; m < 4; ++m) _Pragma("unroll") for (int n = 0; n < 2; ++n) \
            asm volatile("v_mfma_scale_f32_16x16x128_f8f6f4 %0, %1, %2, %0, %3, %4 op_sel_hi:[0,0,0]" : "+v"(acc[ai][bj][m][n]) : "v"(Bt##8[n]), "v"(At##8[m]), "v"(sc_w), "v"(sc_x)); }     \
        else { _Pragma("unroll") for (int m = 0; m < 4; ++m) _Pragma("unroll") for (int n = 0; n < 2; ++n) _Pragma("unroll") for (int k = 0; k < 2; ++k) \
            acc[ai][bj][m][n] = __builtin_amdgcn_mfma_f32_16x16x32_bf16(Bt[n][k], At[m][k], acc[ai][bj][m][n], 0, 0, 0); } __builtin_amdgcn_s_setprio(0); } while (0)
#define PG8_WAIT_V(n) asm volatile("s_waitcnt vmcnt(" #n ")" ::: "memory")
#define PG8_WAIT_L(n) asm volatile("s_waitcnt lgkmcnt(" #n ")" ::: "memory")
#define PG8_BAR __builtin_amdgcn_s_barrier()
#define PG8_SCHED __builtin_amdgcn_sched_barrier(0)
    Unit cur, nxt; int ui = 0;
    if (!S.next(0, cur)) return;
    f32x4 acc[2][2][4][2];
#pragma unroll
    for (int a = 0; a < 2; ++a)
#pragma unroll
        for (int b = 0; b < 2; ++b)
#pragma unroll
            for (int m = 0; m < 4; ++m)
#pragma unroll
                for (int n = 0; n < 2; ++n) acc[a][b][m][n] = (f32x4){0.f, 0.f, 0.f, 0.f};
    int sc_w = 122, sc_x = 127; if constexpr (F8) asm volatile("" : "+v"(sc_w), "+v"(sc_x));
    bf16x8 At[4][2], B0[2][2], B1[2][2]; v8i At8[4], B08[2], B18[2];
    const char* cA = (GATHER ? (const char*)g.A : (const char*)g.A + (size_t)cur.pm * tstepA) + ES * S.koff(cur);
    const char* cB = (const char*)g.Bt + (size_t)cur.pn * tstepB + ES * S.koff(cur);
    if (GATHER) {
#pragma unroll
        for (int i = 0; i < 2; ++i) { vA0[i] = (unsigned)(S.arow(cur, Rr[i]) * g.lda * ES + Cc[i] * 2); vA1[i] = (unsigned)(S.arow(cur, Rr[i] + HALF) * g.lda * ES + Cc[i] * 2); nA0[i] = vA0[i]; nA1[i] = vA1[i]; } }
    PG8_STAGE1(PG8_SB(0, 0), cB, voffB[0], rbB); PG8_STAGEA(PG8_SA(0, 0), cA, 0, vA0); PG8_STAGE1(PG8_SB(0, 1), cB + hstepB, voffB[0], rbB); PG8_STAGEA(PG8_SA(0, 1), cA, 1, vA1);
    if (wr == 1) PG8_BAR;
    PG8_WAIT_V(4); PG8_BAR;
    PG8_STAGE1(PG8_SB(1, 0), cB + kstep, voffB[0], rbB); PG8_STAGEA(PG8_SA(1, 0), cA + kstep, 0, vA0); PG8_STAGE1(PG8_SB(1, 1), cB + hstepB + kstep, voffB[0], rbB);
    PG8_WAIT_V(6); PG8_BAR;
    for (;;) {
        const bool has_next = S.next(ui + 1, nxt);
        const char* nAp = GATHER ? cA : (has_next ? (const char*)g.A + (size_t)nxt.pm * tstepA + ES * S.koff(nxt) : cA);
        const char* nB = has_next ? (const char*)g.Bt + (size_t)nxt.pn * tstepB + ES * S.koff(nxt) : cB;
        if (GATHER) {
#pragma unroll
            for (int i = 0; i < 2; ++i) { nA0[i] = vA0[i]; nA1[i] = vA1[i]; } }
        for (int t = 0; t < nt; t += 2) {
            const bool last = (t == nt - 2);
            if (GATHER && has_next && t == (nt >= 4 ? nt - 4 : 0)) {
#pragma unroll
                for (int i = 0; i < 2; ++i) { nA0[i] = (unsigned)(S.arow(nxt, Rr[i]) * g.lda * ES + Cc[i] * 2); nA1[i] = (unsigned)(S.arow(nxt, Rr[i] + HALF) * g.lda * ES + Cc[i] * 2); } }
            const char* a1 = cA + (size_t)(t + 1) * kstep;
            const char* a2 = last ? nAp : cA + (size_t)(t + 2) * kstep; const char* b2 = last ? nB : cB + (size_t)(t + 2) * kstep;
            const char* a3 = a2 + kstep; const char* b3 = b2 + kstep;
            unsigned w0[2], w1[2];
#pragma unroll
            for (int i = 0; i < 2; ++i) { w0[i] = (GATHER && last) ? nA0[i] : vA0[i]; w1[i] = (GATHER && last) ? nA1[i] : vA1[i]; }
            PG8_LDB(B0, 0, 0); PG8_SCHED; PG8_LDA(At, 0, 0); PG8_STAGEA(PG8_SA(1, 1), a1, 1, vA1);
            PG8_WAIT_L(8); PG8_BAR; PG8_WAIT_L(0); PG8_MMA(0, 0, At, B0); PG8_BAR; PG8_SCHED;
            PG8_LDB(B1, 0, 1); PG8_STAGE1(PG8_SB(0, 0), b2, voffB[0], rbB);
            PG8_BAR; PG8_WAIT_L(0); PG8_MMA(0, 1, At, B1); PG8_BAR;
            PG8_LDA(At, 0, 1); PG8_STAGEA(PG8_SA(0, 0), a2, 0, w0);
            PG8_BAR; PG8_WAIT_L(0); PG8_MMA(1, 0, At, B0); PG8_BAR; PG8_SCHED;
            PG8_STAGE1(PG8_SB(0, 1), b2 + hstepB, voffB[0], rbB);
            PG8_WAIT_V(6); PG8_BAR; PG8_MMA(1, 1, At, B1); PG8_BAR;
            PG8_LDB(B0, 1, 0); PG8_SCHED; PG8_LDA(At, 1, 0); PG8_STAGEA(PG8_SA(0, 1), a2, 1, w1);
            PG8_WAIT_L(8); PG8_BAR; PG8_WAIT_L(0); PG8_MMA(0, 0, At, B0); PG8_BAR; PG8_SCHED;
            PG8_LDB(B1, 1, 1); PG8_STAGE1(PG8_SB(1, 0), b3, voffB[0], rbB);
            PG8_BAR; PG8_WAIT_L(0); PG8_MMA(0, 1, At, B1); PG8_BAR;
            PG8_LDA(At, 1, 1); PG8_STAGEA(PG8_SA(1, 0), a3, 0, w0);
            PG8_BAR; PG8_WAIT_L(0); PG8_MMA(1, 0, At, B0); PG8_BAR; PG8_SCHED;
            PG8_STAGE1(PG8_SB(1, 1), b3 + hstepB, voffB[0], rbB);
            PG8_WAIT_V(6); PG8_BAR; PG8_MMA(1, 1, At, B1); PG8_BAR;
        }
        if constexpr (F8) asm volatile("s_nop 15\n\ts_nop 15\n\ts_nop 15\n\ts_nop 15" ::: "memory");
        { int frr = fr, fqq = fq; asm volatile("" : "+v"(frr), "+v"(fqq));
          E(acc, cur, wr, wc, frr, fqq); }
        if (!has_next) break;
#pragma unroll
        for (int a = 0; a < 2; ++a)
#pragma unroll
            for (int b = 0; b < 2; ++b)
#pragma unroll
                for (int m = 0; m < 4; ++m)
#pragma unroll
                    for (int n = 0; n < 2; ++n) acc[a][b][m][n] = (f32x4){0.f, 0.f, 0.f, 0.f};
        cur = nxt; cA = nAp; cB = nB; ++ui;
        if (GATHER) {
#pragma unroll
            for (int i = 0; i < 2; ++i) { vA0[i] = nA0[i]; vA1[i] = nA1[i]; } }
    }
    PG8_WAIT_V(0);
    if (wr == 0) PG8_BAR;
    PG8_BAR;
#undef PG8_SA
#undef PG8_SB
#undef PG8_STAGE
#undef PG8_STAGE1
#undef PG8_STAGEA
#undef PG8_LDA
#undef PG8_LDB
#undef PG8_MMA
#undef PG8_LD32
#undef PG8_WAIT_V
#undef PG8_WAIT_L
#undef PG8_BAR
#undef PG8_SCHED
}
}

#define XB_TMO      128
#define XB_XCNT(j)  (256  + 64 * (j))
#define XB_XSUB(j)  (1280 + 64 * (j))
#define XB_XGEN(j)  (2304 + 64 * (j))
#define XB_TOP      3328
#define XB_TOPGEN   3392
#define XCD_BAR_WORDS 3456
#define XB_SPIN_CAP (1u << 18)
__device__ __forceinline__ unsigned xb_ld(unsigned* p)              { return __hip_atomic_load(p, __ATOMIC_RELAXED, __HIP_MEMORY_SCOPE_AGENT); }
__device__ __forceinline__ unsigned xb_add(unsigned* p, unsigned v) { return __hip_atomic_fetch_add(p, v, __ATOMIC_RELAXED, __HIP_MEMORY_SCOPE_AGENT); }
__device__ __forceinline__ unsigned xb_xcc_id() { return (unsigned)__builtin_amdgcn_s_getreg((3 << 11) | 20) & 0xFu; }
#define XB_SPIN(cond, bar) do { unsigned _sp = 0; while (cond) { __builtin_amdgcn_s_sleep(1); \
    if ((++_sp & 255u) == 0u) { if (xb_ld(&(bar)[XB_TMO])) break; if (_sp > XB_SPIN_CAP) { atomicAdd(&(bar)[XB_TMO], 1u); break; } } } } while (0)
struct XcdBarrier { unsigned* bar; unsigned x; volatile LAS unsigned* st; int wv; };
__device__ __forceinline__ XcdBarrier xcd_barrier_post(unsigned* bar, volatile LAS unsigned* st, int wv) {
    XcdBarrier b; b.bar = bar; b.x = xb_xcc_id(); b.st = st; b.wv = wv;
    if (wv == 0 && lane_id() == 0) (void)xb_add(&bar[XB_XCNT(b.x)], 1u);
    return b;
}
__device__ __forceinline__ void xcd_barrier_complete(unsigned* bar, unsigned x, unsigned& nloc, unsigned& nx) {
    const unsigned G = gridDim.x * gridDim.y * gridDim.z;
    unsigned sum, cnt, mine, sp = 0u;
    for (;;) {
        sum = 0u; cnt = 0u; mine = 0u;
#pragma unroll
        for (unsigned j = 0; j < 16; ++j) { const unsigned c = xb_ld(&bar[XB_XCNT(j)]); sum += c; cnt += (c > 0u) ? 1u : 0u; mine = (j == x) ? c : mine; }
        if (sum == G) break;
        __builtin_amdgcn_s_sleep(1);
        if ((++sp & 255u) == 0u) { if (xb_ld(&bar[XB_TMO])) break; if (sp > XB_SPIN_CAP) { atomicAdd(&bar[XB_TMO], 1u); break; } }
    }
    nloc = mine > 0u ? mine : 1u; nx = cnt > 0u ? cnt : 1u;
}
__device__ __forceinline__ void xcd_barrier(const XcdBarrier& b) {
    asm volatile("s_waitcnt vmcnt(0)" ::: "memory");
    __syncthreads();
    if (b.wv == 0 && lane_id() == 0) {
        unsigned* bar = b.bar;
        __builtin_amdgcn_s_waitcnt(0);
        unsigned nloc = b.st[0], nx = b.st[1];
        if (nloc == 0u) { xcd_barrier_complete(bar, b.x, nloc, nx); b.st[0] = nloc; b.st[1] = nx; }
        const unsigned old = xb_add(&bar[XB_XSUB(b.x)], 1u);
        const unsigned gen = old / nloc;
        if (old + 1u == (gen + 1u) * nloc) {
            __builtin_amdgcn_fence(__ATOMIC_RELEASE, "agent");
            asm volatile("s_waitcnt vmcnt(0)" ::: "memory");
            const unsigned og = xb_add(&bar[XB_TOP], 1u);
            const unsigned tg = og / nx;
            if (og + 1u == (tg + 1u) * nx) xb_add(&bar[XB_TOPGEN], 1u);
            else XB_SPIN(xb_ld(&bar[XB_TOPGEN]) == tg, bar);
            __builtin_amdgcn_fence(__ATOMIC_ACQUIRE, "agent");
            xb_add(&bar[XB_XGEN(b.x)], 1u);
            asm volatile("s_waitcnt vmcnt(0)" ::: "memory");
        } else {
            XB_SPIN(xb_ld(&bar[XB_XGEN(b.x)]) == gen, bar);
            __builtin_amdgcn_fence(__ATOMIC_ACQUIRE, "agent");
            asm volatile("s_waitcnt vmcnt(0)" ::: "memory");
        }
    }
    __syncthreads();
}

constexpr size_t MiB = 1u << 20;
constexpr size_t CTL_BAR = 0, CTL_MODI = 16384  , CTL_MOD = CTL_MODI + 2 * 4 * 12288 * 8  , CTL_SSQ = CTL_MOD + 2 * 4 * 12288 * 4  ,
                 CTL_CNT = CTL_SSQ + (size_t)T * 12 * 4  , CTL_CHK = CTL_CNT + 2 * 16 * 256, CTL_ZERO_BYTES = 2 * MiB;
static_assert(CTL_CHK % 8 == 0 && CTL_CHK + 1024 <= CTL_ZERO_BYTES, "ctl");
constexpr size_t WS_W_IN0 = 2 * MiB, WS_W_UQ = WS_W_IN0 + 8 * MiB, WS_W_UKV = WS_W_UQ + 1536 * 512 * 2, WS_W_GLU = WS_W_UKV + 2048 * 256 * 2, WS_W_OUT0 = WS_W_GLU + 2 * MiB,
                 WS_W_IN1 = WS_W_OUT0 + 8 * MiB, WS_W_OUT1 = WS_W_IN1 + (size_t)9728 * 2048 * 2, WS_W_GU = WS_W_OUT1 + 8 * MiB, WS_W_DN = WS_W_GU + 128 * MiB,
                 WS_W_LORA = WS_W_DN + 64 * MiB, WS_S5BY = WS_W_LORA + (size_t)4608 * 384 * 2, WS_S5BE = WS_S5BY + (size_t)64 * 256 * 384 * 2, WS_ROPE = WS_S5BE + (size_t)64 * 256 * 256 * 2,
                 WS_BIAS = WS_ROPE + 1 * MiB, WS_S5L = WS_BIAS + 16384, WS_H = WS_S5L + 65536;
static_assert(WS_H % 256 == 0, "align");
constexpr size_t WS_W_GU8 = WS_W_GU + 64 * MiB;
constexpr size_t WS_X1 = WS_H + 64 * MiB, WS_ARENA = WS_X1 + 128 * MiB;
constexpr size_t A_QC = WS_ARENA, A_KVC = A_QC + 16 * MiB, A_KR = A_KVC + 8 * MiB, A_XH = A_KR + 2 * MiB, A_ES = A_XH + 48 * MiB, A_Q = A_ES + 32 * MiB, A_KF = A_Q + 48 * MiB,
                 A_V = A_KF + 48 * MiB, A_YS5 = A_V + 32 * MiB;
constexpr size_t A_XPRE = WS_ARENA, A_RT = WS_ARENA + 128 * MiB, A_TOKL = A_RT + 1 * MiB, A_ACT = WS_ARENA, A_YS = WS_ARENA + 130 * MiB;
constexpr int MOE_ROWS = 2 * T + 16 * 256;
constexpr size_t A_ZD = WS_ARENA, A_ZR = A_ZD + 144 * MiB, A_LIN = A_ZR + 156 * MiB, A_WDEC = A_LIN + 12 * MiB, A_AA = A_WDEC + 48 * MiB, A_GG = A_AA + 48 * MiB,
                 A_DPO = A_GG + 48 * MiB, A_DPM = A_DPO + 48 * MiB, A_DPL = A_DPM + 2 * MiB, A_BSG = A_DPL + 2 * MiB  , A_YR = WS_ARENA  , A_GST = A_BSG + 2 * MiB  , WS_END = A_GST + 2 * MiB;
static_assert(A_YS + (size_t)MOE_ROWS * 2048 * 2 <= WS_END && A_YS5 + 32 * MiB <= WS_END && WS_END <= 1024 * MiB, "ws map");

constexpr int RING_BYTES = 131072, LDS_TAB = RING_BYTES, LDS_MISC = RING_BYTES + 1024, LDS_BYTES = 147456;

struct KArgs { const float* in[41]; float* out; unsigned char* ws; int ph_lo, ph_hi; };
enum { I_X = 0, I_C, I_ADAW, I_ADAB, I_LNMG, I_LNMB, I_LNFG, I_LNFB, I_RW, I_RB, I_WGU, I_WDN, I_RELB, I_EVIN, I_QN, I_WUQ, I_KVN, I_WUKV, I_LRE, I_LIM, I_BRE, I_BIM, I_CRE, I_CIM,
       I_S5D, I_LOGDT, I_WGLU, I_EVOUT, I_ODIN, I_MU, I_W0, I_W2, I_A0, I_A2, I_G2, I_KK, I_KA, I_RK, I_LNXG, I_LNXB, I_ODOUT };

DI int ropeperm(int c) { return ((c >> 2) & 1) * 32 + (c >> 3) * 4 + (c & 3); }
DI int srccol(int map, int n) {
    switch (map) {
        case 1: if (n < 768) return n; if (n < 1792) return 832 + (n - 768); if (n < 1856) return 768 + ropeperm(n - 1792); return -1;
        case 2: { const int h = n / 192, j = n % 192; return j < 128 ? n : h * 192 + 128 + ropeperm(j - 128); }
        case 3: { const int pn = n >> 8, half = (n >> 7) & 1, idx = n & 127; return half * 512 + pn * 128 + idx; }
        case 4: return n < ODD_IN ? n : -1;
        default: return n;
    }
}
struct ConvJob { const float* src; bf16* dst; const float* kscale; int ldsrc, K, Nd, nmat, map, kbeg, kend, f8; size_t smat, dmat; };
DI void conv_item(const ConvJob& J, LAS unsigned char* scr, int item, int lane) {
    const int nblk = J.Nd / 64, per = (J.K / 64) * nblk, mat = item / per, r = item % per, kb = r / nblk, nb = r % nblk, k0 = 64 * kb, n0 = 64 * nb;
    const float* W = J.src + (size_t)mat * J.smat; bf16* WT = J.f8 ? (bf16*)((unsigned char*)J.dst + (size_t)mat * J.dmat) : J.dst + (size_t)mat * J.dmat;
    const int kq = lane >> 4, nq = lane & 15, sc = srccol(J.map, n0 + 4 * nq);
    f32x4 v[16];
#pragma unroll
    for (int i = 0; i < 16; ++i) { const int kg = k0 + 4 * i + kq; v[i] = (f32x4){0.f, 0.f, 0.f, 0.f};
        if (sc >= 0 && kg >= J.kbeg && kg < J.kend) { v[i] = *(const f32x4*)(W + (size_t)(kg - J.kbeg) * J.ldsrc + sc); if (J.kscale) v[i] *= J.kscale[kg]; } }
#pragma unroll
    for (int i = 0; i < 16; ++i) { LAS bf16* t = (LAS bf16*)(scr + (4 * nq) * 132 + (4 * i + kq) * 2); const unsigned p0 = pk2(v[i].x, v[i].y), p1 = pk2(v[i].z, v[i].w);
        t[0] = (bf16)(p0 & 0xffffu); t[66] = (bf16)(p0 >> 16); t[132] = (bf16)(p1 & 0xffffu); t[198] = (bf16)(p1 >> 16); }
    asm volatile("s_waitcnt lgkmcnt(0)" ::: "memory");
#pragma unroll
    for (int q = 0; q < 8; ++q) { const int id = lane + 64 * q, n = id >> 3, c = id & 7; const LAS unsigned* t = (const LAS unsigned*)(scr + n * 132 + c * 16);
        u32x4 o = {t[0], t[1], t[2], t[3]};
        if (J.f8) { u32x2 o8 = {pk4_fp8(bflo(o.x) * F8_WSCALE, bfhi(o.x) * F8_WSCALE, bflo(o.y) * F8_WSCALE, bfhi(o.y) * F8_WSCALE), pk4_fp8(bflo(o.z) * F8_WSCALE, bfhi(o.z) * F8_WSCALE, bflo(o.w) * F8_WSCALE, bfhi(o.w) * F8_WSCALE)};
            *(u32x2*)((unsigned char*)WT + (size_t)(n0 + n) * J.K + k0 + 8 * c) = o8; }
        else *(u32x4*)(WT + (size_t)(n0 + n) * J.K + k0 + 8 * c) = o; }
    asm volatile("s_waitcnt lgkmcnt(0)" ::: "memory");
}
DI ConvJob conv_job(const KArgs& a, int j) {
    unsigned char* ws = a.ws; ConvJob J; J.kscale = nullptr; J.nmat = 1; J.map = 0; J.smat = 0; J.dmat = 0; J.kbeg = 0; J.kend = 1 << 30; J.f8 = 0;
    switch (j) {
        case 0: J.src = a.in[I_EVIN]; J.dst = (bf16*)(ws + WS_W_IN0); J.f8 = 1; J.ldsrc = EVEN_IN; J.K = 2048; J.Nd = 2048; J.map = 1; break;
        case 1: J.src = a.in[I_WUQ]; J.dst = (bf16*)(ws + WS_W_UQ); J.ldsrc = 1536; J.K = 512; J.Nd = 1536; J.map = 2; J.kscale = a.in[I_QN]; break;
        case 2: J.src = a.in[I_WUKV]; J.dst = (bf16*)(ws + WS_W_UKV); J.ldsrc = 2048; J.K = 256; J.Nd = 2048; J.kscale = a.in[I_KVN]; break;
        case 3: J.src = a.in[I_WGLU]; J.dst = (bf16*)(ws + WS_W_GLU); J.ldsrc = 1024; J.K = 1024; J.Nd = 1024; break;
        case 4: J.src = a.in[I_EVOUT]; J.dst = (bf16*)(ws + WS_W_OUT0); J.f8 = 1; J.ldsrc = 2048; J.K = 2048; J.Nd = 2048; break;
        case 5: J.src = a.in[I_ODIN]; J.dst = (bf16*)(ws + WS_W_IN1); J.f8 = 1; J.ldsrc = ODD_IN; J.K = 2048; J.Nd = 9728; J.map = 4; break;
        case 6: J.src = a.in[I_ODOUT]; J.dst = (bf16*)(ws + WS_W_OUT1); J.f8 = 1; J.ldsrc = 2048; J.K = 2048; J.Nd = 2048; break;
        case 7: J.src = a.in[I_WGU]; J.dst = (bf16*)(ws + WS_W_GU8); J.f8 = 1; J.ldsrc = 1024; J.K = 2048; J.Nd = 1024; J.map = 3; J.nmat = 32; J.smat = (size_t)2048 * 1024; J.dmat = (size_t)1024 * 2048; break;
        case 8: J.src = a.in[I_WDN]; J.dst = (bf16*)(ws + WS_W_DN); J.f8 = 1; J.ldsrc = 2048; J.K = 512; J.Nd = 2048; J.nmat = 32; J.smat = (size_t)512 * 2048; J.dmat = (size_t)2048 * 512; break;
        case 9: J.src = a.in[I_W2]; J.dst = (bf16*)(ws + WS_W_LORA); J.ldsrc = 1536; J.K = 384; J.Nd = 1536; J.kbeg = 0; J.kend = 64; break;
        case 10: J.src = a.in[I_A2]; J.dst = (bf16*)(ws + WS_W_LORA) + (size_t)1536 * 384; J.ldsrc = 1536; J.K = 384; J.Nd = 1536; J.kbeg = 64; J.kend = 128; break;
        default: J.src = a.in[I_G2]; J.dst = (bf16*)(ws + WS_W_LORA) + (size_t)3072 * 384; J.ldsrc = 1536; J.K = 384; J.Nd = 1536; J.kbeg = 128; J.kend = 352; break;
    }
    return J;
}
constexpr int N_CONV_JOBS = 12;

DI void s5_precompute(const KArgs& a, LAS unsigned char* lds, int g, int wv) {
    LAS float* PW = (LAS float*)lds; LAS float* BB = PW + 17 * 64 * 2; LAS float* CC = BB + 64 * 16 * 2; LAS float* KK = CC + 16 * 64 * 2;
    const int tid = otid(wv);
    const float dt = expf(a.in[I_LOGDT][g]);
    for (int idx = tid; idx < 17 * 64; idx += 512) { const int d = idx / 64, p = idx % 64; const float lre = a.in[I_LRE][g * 64 + p], lim = a.in[I_LIM][g * 64 + p];
        const float mag = expf(lre * dt * (float)d); float sn, cs; sincosf(lim * dt * (float)d, &sn, &cs); PW[idx * 2] = mag * cs; PW[idx * 2 + 1] = mag * sn;
        if (d == 16) { float* L = (float*)(a.ws + WS_S5L); L[(g * 64 + p) * 2] = mag * cs; L[(g * 64 + p) * 2 + 1] = mag * sn; } }
    for (int idx = tid; idx < 64 * 16; idx += 512) { const int p = idx / 16, c = idx % 16; const float lre = a.in[I_LRE][g * 64 + p], lim = a.in[I_LIM][g * 64 + p];
        float sn, cs; sincosf(lim * dt, &sn, &cs); const float mag = expf(lre * dt), sh = sinf(0.5f * lim * dt);
        const float nr = expm1f(lre * dt) * cs - 2.f * sh * sh, ni = mag * sn, den = 1.f / (lre * lre + lim * lim);
        const float cr = (nr * lre + ni * lim) * den, ci = (ni * lre - nr * lim) * den;
        const float br = a.in[I_BRE][(g * 64 + p) * 16 + c], bi = a.in[I_BIM][(g * 64 + p) * 16 + c];
        BB[idx * 2] = cr * br - ci * bi; BB[idx * 2 + 1] = cr * bi + ci * br; }
    for (int idx = tid; idx < 16 * 64; idx += 512) { CC[idx * 2] = a.in[I_CRE][g * 1024 + idx]; CC[idx * 2 + 1] = a.in[I_CIM][g * 1024 + idx]; }
    __syncthreads();
    for (int idx = tid; idx < 4096; idx += 512) { const int d = idx >> 8, c = (idx >> 4) & 15, cp = idx & 15; float s = 0.f;
        for (int p = 0; p < 64; ++p) { const float cr = CC[(c * 64 + p) * 2], ci = CC[(c * 64 + p) * 2 + 1], pr = PW[(d * 64 + p) * 2], pi = PW[(d * 64 + p) * 2 + 1];
            const float xr = cr * pr - ci * pi, xi = cr * pi + ci * pr; s += xr * BB[(p * 16 + cp) * 2] - xi * BB[(p * 16 + cp) * 2 + 1]; }
        KK[idx] = s; }
    __syncthreads();
    bf16* BY = (bf16*)(a.ws + WS_S5BY) + (size_t)g * 256 * 384; bf16* BE = (bf16*)(a.ws + WS_S5BE) + (size_t)g * 256 * 256;
    for (int idx = tid; idx < 256 * 48; idx += 512) { const int row = idx / 48, col0 = (idx % 48) * 8, t = row >> 4, c = row & 15; float v[8];
        if (col0 < 256) { const int s = col0 >> 4, c0 = col0 & 15;
#pragma unroll
            for (int j = 0; j < 8; ++j) v[j] = (s <= t) ? KK[((t - s) << 8) + (c << 4) + c0 + j] : 0.f; }
        else { const int pp = col0 - 256; const bool im = pp >= 64; const int p0 = im ? pp - 64 : pp;
#pragma unroll
            for (int j = 0; j < 8; ++j) { const int p = p0 + j; const float cr = CC[(c * 64 + p) * 2], ci = CC[(c * 64 + p) * 2 + 1], pr = PW[((t + 1) * 64 + p) * 2], pi = PW[((t + 1) * 64 + p) * 2 + 1];
                v[j] = im ? -(cr * pi + ci * pr) : (cr * pr - ci * pi); } }
        u32x4 o = {pk2(v[0], v[1]), pk2(v[2], v[3]), pk2(v[4], v[5]), pk2(v[6], v[7])}; *(u32x4*)(BY + (size_t)row * 384 + col0) = o; }
    for (int idx = tid; idx < 256 * 32; idx += 512) { const int row = idx / 32, col0 = (idx % 32) * 8, s = col0 >> 4, c0 = col0 & 15; float v[8];
#pragma unroll
        for (int j = 0; j < 8; ++j) { if (row < 128) { const int p = row & 63; const float pr = PW[((15 - s) * 64 + p) * 2], pi = PW[((15 - s) * 64 + p) * 2 + 1], br = BB[(p * 16 + c0 + j) * 2], bi = BB[(p * 16 + c0 + j) * 2 + 1];
                v[j] = row < 64 ? (pr * br - pi * bi) : (pr * bi + pi * br); } else v[j] = 0.f; }
        u32x4 o = {pk2(v[0], v[1]), pk2(v[2], v[3]), pk2(v[4], v[5]), pk2(v[6], v[7])}; *(u32x4*)(BE + (size_t)row * 256 + col0) = o; }
    __syncthreads();
}

DI int t5_bucket(int dist) { if (dist < 16) return dist; const float logd = logf((float)dist / 16.f) / logf(128.f); int lg = 16 + (int)(logd * 16.f); return lg < 31 ? lg : 31; }

DI void p0_prologue(const KArgs& a, LAS unsigned char* lds, int wv) {
    const int tid = otid(wv), lane = tid & 63, wave = tid >> 6, G = gridDim.x, gw = blockIdx.x * 8 + wave, NGW = G * 8;
    LAS float* cond = (LAS float*)(lds + 98304);
    for (int i = tid; i < 4 * 2048; i += 512) { const float c = a.in[I_C][i]; cond[i] = c / (1.f + expf(-c)); }
    if (blockIdx.x < 64) s5_precompute(a, lds, blockIdx.x, wv); else __syncthreads();
    unsigned long long* MODI = (unsigned long long*)(a.ws + CTL_MODI);
    for (int it = gw; it < 2 * 48 * 16; it += NGW) { const int l = it / 768, cc = (it % 768) / 16, kc = it % 16, col = cc * 256 + lane * 4;
        const float* W = a.in[I_ADAW] + ((size_t)l * 2048 + kc * 128) * 12288 + col;
        f32x4 acc[4]; for (int b = 0; b < 4; ++b) acc[b] = (f32x4){0.f, 0.f, 0.f, 0.f};
#pragma unroll 8
        for (int k = 0; k < 128; ++k) { const f32x4 w = *(const f32x4*)(W + (size_t)k * 12288);
#pragma unroll
            for (int b = 0; b < 4; ++b) acc[b] += w * cond[b * 2048 + kc * 128 + k]; }
        if (kc == 0) { const f32x4 bb = *(const f32x4*)(a.in[I_ADAB] + l * 12288 + col); for (int b = 0; b < 4; ++b) acc[b] += bb; }
#pragma unroll
        for (int b = 0; b < 4; ++b) { unsigned long long* o = MODI + (size_t)(l * 4 + b) * 12288 + col;
#pragma unroll
            for (int e = 0; e < 4; ++e) atomicAdd(o + e, (unsigned long long)__double2ll_rn((double)acc[b][e] * 1099511627776.0)); } }
    LAS unsigned char* scr = lds + wave * 8704;
    for (int j = 0; j < N_CONV_JOBS; ++j) { const ConvJob J = conv_job(a, j); const int nit = J.nmat * (J.K / 64) * (J.Nd / 64);
        for (int it = gw; it < nit; it += NGW) conv_item(J, scr, it, lane); }
    { float* RC = (float*)(a.ws + WS_ROPE); float* RS = RC + 4096 * 32; const int gt = blockIdx.x * 512 + tid;
      for (int i = gt; i < 4096 * 32; i += G * 512) { const int pos = i >> 5, j = i & 31; const float inv = powf(10000.f, -(float)(2 * j) / 64.f); float sn, cs; sincosf((float)pos * inv, &sn, &cs); RC[i] = cs; RS[i] = sn; }
      float* BL = (float*)(a.ws + WS_BIAS);
      for (int i = gt; i < 3 * 8 * 132; i += G * 512) { const int gi = i / (8 * 132), h = (i / 132) % 8, dl = i % 132; const int dil = gi == 0 ? 1 : (gi == 1 ? 4 : 16);
          BL[i] = dl <= 128 ? a.in[I_RELB][t5_bucket(dl * dil) * 24 + gi * 8 + h] * 1.44269504089f : 0.f; } }
}

DI float modi2f(unsigned long long v) { return (float)((double)(long long)v * 9.094947017729282e-13); }
DI void modulate_rows(const float* x, const unsigned long long* MODI, float* MODF, bf16* H, int wv) {
    const int lane = otid(wv) & 63, gw = blockIdx.x * 8 + (otid(wv) >> 6), NGW = gridDim.x * 8;
    for (int i = gw * 64 + lane; i < 2 * 4 * 12288; i += NGW * 64) MODF[i] = modi2f(MODI[i]);
    for (int m = gw; m < T; m += NGW) { const int b = m / SEQ; const unsigned long long* sh = MODI + (size_t)b * 12288; const unsigned long long* sc = sh + 2048;
#pragma unroll
        for (int j = 0; j < 8; ++j) { const int col = (lane + 64 * j) * 4; const f32x4 v = *(const f32x4*)(x + (size_t)m * D + col);
            const f32x4 s1 = {modi2f(sc[col]), modi2f(sc[col + 1]), modi2f(sc[col + 2]), modi2f(sc[col + 3])}, s0 = {modi2f(sh[col]), modi2f(sh[col + 1]), modi2f(sh[col + 2]), modi2f(sh[col + 3])};
            const f32x4 h = v * (s1 + 1.f) + s0; *(unsigned*)((unsigned char*)H + (size_t)m * D + col) = pk4_fp8(h.x, h.y, h.z, h.w); } }
}

using pg8::Unit;
#define P32(ptr, elemoff) ((decltype(ptr))((char*)(ptr) + (unsigned)((unsigned)(elemoff) * (unsigned)sizeof(*(ptr)))))
typedef f32x4 Acc[2][2][4][2];
#define EPI_ROWS_BEGIN const int row0 = u.pm * 256 + wr * 64 + fr; _Pragma("unroll") for (int ai = 0; ai < 2; ++ai) _Pragma("unroll") for (int m = 0; m < 4; ++m) { const int row = row0 + ai * 128 + m * 16;
#define EPI_ROWS_END __builtin_amdgcn_sched_barrier(0); }
DI u32x4 pack8(const f32x4& v0, const f32x4& v1) { u32x4 o = {pk2(v0.x, v0.y), pk2(v0.z, v0.w), pk2(v1.x, v1.y), pk2(v1.z, v1.w)}; return o; }

struct EpiIn0 { static constexpr bool PERM = true;
    bf16 *QC, *KVC, *KR, *XH; float *ssq;
    DI void operator()(const Acc& acc, const Unit& u, int wr, int wc, int fr, int fq) const {
        EPI_ROWS_BEGIN
            float ss = 0.f;
#pragma unroll
            for (int bj = 0; bj < 2; ++bj) { const f32x4 v0 = acc[ai][bj][m][0], v1 = acc[ai][bj][m][1]; const int col = 128 * bj + 32 * wc + 8 * fq; const u32x4 o = pack8(v0, v1);
                if (u.pn < 2) { *(u32x4*)P32(QC, row * 512 + u.pn * 256 + col) = o; ss += v0.x * v0.x + v0.y * v0.y + v0.z * v0.z + v0.w * v0.w + v1.x * v1.x + v1.y * v1.y + v1.z * v1.z + v1.w * v1.w; }
                else if (u.pn == 2) { *(u32x4*)P32(KVC, row * 256 + col) = o; ss += v0.x * v0.x + v0.y * v0.y + v0.z * v0.z + v0.w * v0.w + v1.x * v1.x + v1.y * v1.y + v1.z * v1.z + v1.w * v1.w; }
                else if (u.pn < 7) { const int uc = (u.pn - 3) * 256 + col, g = uc >> 4; *(u32x4*)P32(XH, (g * 1024 + (row >> 4)) * 384 + (row & 15) * 16 + (uc & 15)) = o; }
                else if (col < 64) { *(u32x4*)P32(KR, row * 64 + col) = o; } }
            if (u.pn <= 2) { ss += __shfl_xor(ss, 16); ss += __shfl_xor(ss, 32); if (fq == 0) *P32(ssq, row * 12 + u.pn * 4 + wc) = ss; }
        EPI_ROWS_END
    }
};
struct EpiQ { static constexpr bool PERM = true;
    bf16* Q; const float* ssq; const float* rope;
    DI void operator()(const Acc& acc, const Unit& u, int wr, int wc, int fr, int fq) const {
        EPI_ROWS_BEGIN
            const f32x4 q0 = *(const f32x4*)P32(ssq, row * 12), q1 = *(const f32x4*)P32(ssq, row * 12 + 4);
            const float rs = rsqrtf((((q0.x + q0.y) + (q0.z + q0.w)) + ((q1.x + q1.y) + (q1.z + q1.w))) * (1.f / 512.f) + RMS_EPS) * (0.07216878364870322f * 1.44269504089f);
            const int b = row / SEQ, s = row % SEQ;
#pragma unroll
            for (int bj = 0; bj < 2; ++bj) { f32x4 v0 = acc[ai][bj][m][0] * rs, v1 = acc[ai][bj][m][1] * rs; const int n = u.pn * 256 + 128 * bj + 32 * wc + 8 * fq, h = n / 192, j = n % 192;
                if (j >= 128) { const int q = (j - 128) >> 3; const f32x4 cs = *(const f32x4*)P32(rope, s * 32 + 4 * q), sn = *(const f32x4*)P32(rope, 4096 * 32 + s * 32 + 4 * q);
                    const f32x4 x1 = v0, x2 = v1; v0 = x1 * cs - x2 * sn; v1 = x1 * sn + x2 * cs; }
                *(u32x4*)P32(Q, ((b * 8 + h) * SEQ + s) * 192 + j) = pack8(v0, v1); }
        EPI_ROWS_END
    }
};
struct EpiKV { static constexpr bool PERM = true;
    bf16 *KF, *V; const float* ssq;
    DI void operator()(const Acc& acc, const Unit& u, int wr, int wc, int fr, int fq) const {
        EPI_ROWS_BEGIN
            const f32x4 q2 = *(const f32x4*)P32(ssq, row * 12 + 8); const float rs = rsqrtf(((q2.x + q2.y) + (q2.z + q2.w)) * (1.f / 256.f) + RMS_EPS); const int b = row / SEQ, s = row % SEQ, h = u.pn, j = 32 * wc + 8 * fq; const int tok = (b * 8 + h) * SEQ + s;
            *(u32x4*)P32(KF, tok * 192 + j) = pack8(acc[ai][0][m][0] * rs, acc[ai][0][m][1] * rs);
            *(u32x4*)P32(V, tok * 128 + j) = pack8(acc[ai][1][m][0] * rs, acc[ai][1][m][1] * rs);
        EPI_ROWS_END
    }
};
struct S5Order { int G, c;
    DI bool next(int i, Unit& u) const { const int L = i * G + c; if (L >= 256) return false; u.pm = L; u.pn = L >> 2; u.aux = 0; return true; }
    DI int arow(const Unit&, int) const { return 0; }
    DI int koff(const Unit&) const { return 0; } };
struct EpiS5E { static constexpr bool PERM = false;
    float* ES;
    DI void operator()(const Acc& acc, const Unit& u, int wr, int wc, int fr, int fq) const {
        EPI_ROWS_BEGIN
#pragma unroll
            for (int n = 0; n < 2; ++n) *(f32x4*)P32(ES, row * 128 + 32 * wc + 16 * n + 4 * fq) = acc[ai][0][m][n];
        EPI_ROWS_END
    }
};
DI float gelu_tanh(float x) { const float t = 0.7978845608028654f * (x + 0.044715f * x * x * x); const float e = __expf(2.f * t); return 0.5f * x * (1.f + (1.f - 2.f / (e + 1.f))); }
struct EpiS5Y { static constexpr bool PERM = true;
    bf16* YS5; const bf16* XH; const float* dsk;
    DI void operator()(const Acc& acc, const Unit& u, int wr, int wc, int fr, int fq) const {
        EPI_ROWS_BEGIN
            const int g = row >> 10, chunk = row & 1023;
#pragma unroll
            for (int bj = 0; bj < 2; ++bj) { const int col = 128 * bj + 32 * wc + 8 * fq, tl = col >> 4, c0 = col & 15; const u32x4 uu = *(const u32x4*)P32(XH, row * 384 + col);
                const f32x4 d0 = *(const f32x4*)P32(dsk, g * 16 + c0), d1 = *(const f32x4*)P32(dsk, g * 16 + c0 + 4); const f32x4 a0 = acc[ai][bj][m][0], a1 = acc[ai][bj][m][1];
                f32x4 y0 = {a0.x + d0.x * bflo(uu.x), a0.y + d0.y * bfhi(uu.x), a0.z + d0.z * bflo(uu.y), a0.w + d0.w * bfhi(uu.y)};
                f32x4 y1 = {a1.x + d1.x * bflo(uu.z), a1.y + d1.y * bfhi(uu.z), a1.z + d1.z * bflo(uu.w), a1.w + d1.w * bfhi(uu.w)};
#pragma unroll
                for (int e = 0; e < 4; ++e) { y0[e] = gelu_tanh(y0[e]); y1[e] = gelu_tanh(y1[e]); }
                *(u32x4*)P32(YS5, (chunk * 16 + tl) * 1024 + g * 16 + c0) = pack8(y0, y1); }
        EPI_ROWS_END
    }
};
struct EpiGlu { static constexpr bool PERM = true;
    bf16* MIX; const bf16* YS5;
    DI void operator()(const Acc& acc, const Unit& u, int wr, int wc, int fr, int fq) const {
        EPI_ROWS_BEGIN
#pragma unroll
            for (int bj = 0; bj < 2; ++bj) { const int col = u.pn * 256 + 128 * bj + 32 * wc + 8 * fq; const u32x4 yy = *(const u32x4*)P32(YS5, row * 1024 + col); const f32x4 a0 = acc[ai][bj][m][0], a1 = acc[ai][bj][m][1];
                const f32x4 o0 = {bflo(yy.x) * sigmoidf_(a0.x), bfhi(yy.x) * sigmoidf_(a0.y), bflo(yy.y) * sigmoidf_(a0.z), bfhi(yy.y) * sigmoidf_(a0.w)};
                const f32x4 o1 = {bflo(yy.z) * sigmoidf_(a1.x), bfhi(yy.z) * sigmoidf_(a1.y), bflo(yy.w) * sigmoidf_(a1.z), bfhi(yy.w) * sigmoidf_(a1.w)};
                { unsigned char* mx = (unsigned char*)MIX; u32x2 o8 = {pk4_fp8(o0.x, o0.y, o0.z, o0.w), pk4_fp8(o1.x, o1.y, o1.z, o1.w)}; *(u32x2*)P32(mx, row * 2048 + 1024 + col) = o8; } }
        EPI_ROWS_END
    }
};
template <bool XBF> struct EpiRes { static constexpr bool PERM = true;
    bf16* XPRE; const void* xres; const float* gate;
    DI void operator()(const Acc& acc, const Unit& u, int wr, int wc, int fr, int fq) const {
        EPI_ROWS_BEGIN
            const int b = row / SEQ;
#pragma unroll
            for (int bj = 0; bj < 2; ++bj) { const int col = u.pn * 256 + 128 * bj + 32 * wc + 8 * fq;
                f32x4 x0, x1;
                if (XBF) { const bf16* xb = (const bf16*)xres; const u32x4 xq = *(const u32x4*)P32(xb, row * D + col); x0 = (f32x4){bflo(xq.x), bfhi(xq.x), bflo(xq.y), bfhi(xq.y)}; x1 = (f32x4){bflo(xq.z), bfhi(xq.z), bflo(xq.w), bfhi(xq.w)}; }
                else { const float* xf = (const float*)xres; x0 = *(const f32x4*)P32(xf, row * D + col); x1 = *(const f32x4*)P32(xf, row * D + col + 4); }
                const f32x4 g0 = *(const f32x4*)P32(gate, b * 12288 + col), g1 = *(const f32x4*)P32(gate, b * 12288 + col + 4);
                *(u32x4*)P32(XPRE, row * D + col) = pack8(x0 * DN_ALPHA + (g0 + 1.f) * acc[ai][bj][m][0], x1 * DN_ALPHA + (g1 + 1.f) * acc[ai][bj][m][1]); }
        EPI_ROWS_END
    }
};

DI void krope_pass(const bf16* KR, const float* rope, bf16* KF, int wv) {
    const int gt = blockIdx.x * 512 + otid(wv), NT_ = gridDim.x * 512;
    for (int i = gt; i < T * 8; i += NT_) { const int row = i >> 3, q = i & 7, b = row / SEQ, s = row % SEQ; const u32x4 r = *(const u32x4*)(KR + (size_t)row * 64 + q * 8);
        const f32x4 x1 = {bflo(r.x), bfhi(r.x), bflo(r.y), bfhi(r.y)}, x2 = {bflo(r.z), bfhi(r.z), bflo(r.w), bfhi(r.w)};
        const f32x4 cs = *(const f32x4*)(rope + s * 32 + 4 * q), sn = *(const f32x4*)(rope + 4096 * 32 + s * 32 + 4 * q);
        const u32x4 o = pack8(x1 * cs - x2 * sn, x1 * sn + x2 * cs);
#pragma unroll
        for (int h = 0; h < 8; ++h) *(u32x4*)(KF + ((size_t)(b * 8 + h) * SEQ + s) * 192 + 128 + q * 8) = o; }
}
DI void s5_carry(const float* ES, const float* L16, bf16* XH, LAS unsigned char* lds, int wv) {
    const int tid = otid(wv), lane = tid & 63, w = tid >> 6; LAS float* SEG = (LAS float*)lds;
    for (int base = blockIdx.x * 64; base < 4 * 64 * 64; base += gridDim.x * 64) {
        const int gt = base + lane, p = gt & 63, g = (gt >> 6) & 63, b = gt >> 12; const float lr = L16[(g * 64 + p) * 2], li = L16[(g * 64 + p) * 2 + 1];
        const size_t r0 = (size_t)g * 1024 + b * 256 + 32 * w;
        float hr = 0.f, hi = 0.f;
#pragma unroll 16
        for (int k = 0; k < 32; ++k) { const float er = ES[(r0 + k) * 128 + p], ei = ES[(r0 + k) * 128 + 64 + p]; const float nr = lr * hr - li * hi + er, ni = lr * hi + li * hr + ei; hr = nr; hi = ni; }
        __syncthreads();
        SEG[(w * 64 + lane) * 2] = hr; SEG[(w * 64 + lane) * 2 + 1] = hi;
        float pr = lr, pi = li;
#pragma unroll
        for (int q = 0; q < 5; ++q) { const float nr = pr * pr - pi * pi, ni = 2.f * pr * pi; pr = nr; pi = ni; }
        __syncthreads();
        hr = 0.f; hi = 0.f;
        for (int u = 0; u < w; ++u) { const float er = SEG[(u * 64 + lane) * 2], ei = SEG[(u * 64 + lane) * 2 + 1]; const float nr = pr * hr - pi * hi + er, ni = pr * hi + pi * hr + ei; hr = nr; hi = ni; }
#pragma unroll 16
        for (int k = 0; k < 32; ++k) { const float er = ES[(r0 + k) * 128 + p], ei = ES[(r0 + k) * 128 + 64 + p];
            XH[(r0 + k) * 384 + 256 + p] = f2bf(hr); XH[(r0 + k) * 384 + 320 + p] = f2bf(hi);
            const float nr = lr * hr - li * hi + er, ni = lr * hi + li * hr + ei; hr = nr; hi = ni; }
    }
    __syncthreads();
}

#define MFMA32(a, b, c) __builtin_amdgcn_mfma_f32_32x32x16_bf16((a), (b), (c), 0, 0, 0)
constexpr int AT_KROW = 384, AT_VROW = 256, AT_KBYTES = 64 * AT_KROW, AT_STG = AT_KBYTES + 64 * AT_VROW, AT_NST = 3;
static_assert(AT_NST * AT_STG <= RING_BYTES, "attention LDS");
DI void mla_attn_unit(LAS unsigned char* lds, const bf16* Qg, const bf16* KFg, const bf16* Vg, bf16* MIX, int unit, int wv) {
    const int tid = otid(wv), lane = tid & 63, w = tid >> 6, r = lane & 31, hh = lane >> 5;
    const int b = unit >> 6, h = (unit >> 3) & 7, pi = unit & 7;
    const bf16* Qh = Qg + (size_t)(b * 8 + h) * SEQ * 192; const bf16* Kh = KFg + (size_t)(b * 8 + h) * SEQ * 192; const bf16* Vh = Vg + (size_t)(b * 8 + h) * SEQ * 128;
    const int w_ = __builtin_amdgcn_readfirstlane(w);
    int koff[3], voff[2];
#pragma unroll
    for (int i = 0; i < 3; ++i) { const int p = (3 * w_ + i) * 64 + lane, row = p / 24, cs = p % 24, c = (cs & ~7) | ((cs ^ (row >> 1)) & 7); koff[i] = row * 192 + c * 8; }
#pragma unroll
    for (int i = 0; i < 2; ++i) { const int p = (2 * w_ + i) * 64 + lane, row = p >> 4, cs = p & 15, c = cs ^ ((row & 3) << 2); voff[i] = row * 128 + c * 8; }
    const int kx = (r >> 1) & 7, vq = (lane >> 2) & 3;
    for (int half = 0; half < 2; ++half) {
        const int qb = half ? 15 - pi : pi, q0 = qb * 256 + 32 * w, nkt = (qb + 1) * 4;
        bf16x8 qf[12];
#pragma unroll
        for (int ks = 0; ks < 12; ++ks) qf[ks] = *(const GAS bf16x8*)P32(Qh, (q0 + r) * 192 + 16 * ks + 8 * hh);
        f32x16 O[4];
#pragma unroll
        for (int i = 0; i < 4; ++i) for (int e = 0; e < 16; ++e) O[i][e] = 0.f;
        float mrow = -1e30f, lrow = 0.f;
#define AT_DMA(kt, stg) do { LAS unsigned char* sb_ = lds + (stg) * AT_STG; \
        _Pragma("unroll") for (int i = 0; i < 3; ++i) __builtin_amdgcn_global_load_lds((const unsigned*)P32(Kh, (kt) * 64 * 192 + koff[i]), (LAS unsigned*)(sb_ + (3 * w_ + i) * 1024), 16, 0, 0); \
        _Pragma("unroll") for (int i = 0; i < 2; ++i) __builtin_amdgcn_global_load_lds((const unsigned*)P32(Vh, (kt) * 64 * 128 + voff[i]), (LAS unsigned*)(sb_ + AT_KBYTES + (2 * w_ + i) * 1024), 16, 0, 0); } while (0)
#define AT_BAR() do { asm volatile("s_waitcnt lgkmcnt(0)" ::: "memory"); __builtin_amdgcn_s_barrier(); asm volatile("" ::: "memory"); } while (0)
        __syncthreads();
        AT_DMA(0, 0); AT_DMA(1, 1);
        asm volatile("s_waitcnt vmcnt(5)" ::: "memory");
        AT_BAR();
        int stg = 0;
        for (int kt = 0; kt < nkt; ++kt) {
            if (kt + 2 < nkt) AT_DMA(kt + 2, stg == 0 ? 2 : stg - 1);
            const LAS unsigned char* sb = lds + stg * AT_STG;
            if (kt * 64 <= q0 + 31) {
                f32x16 st[2];
#pragma unroll
                for (int mt = 0; mt < 2; ++mt) for (int e = 0; e < 16; ++e) st[mt][e] = 0.f;
                __builtin_amdgcn_sched_barrier(0);
                {
                    const LAS unsigned char* kb = sb + r * AT_KROW; const LAS unsigned char* kx4[4];
#pragma unroll
                    for (int j = 0; j < 4; ++j) kx4[j] = kb + (((2 * j + hh) ^ kx) & 7) * 16;
                    bf16x8 kf[24];
#pragma unroll
                    for (int i = 0; i < 24; ++i) kf[i] = *(const LAS bf16x8*)(kx4[(i >> 1) & 3] + 32 * (i & 1) * AT_KROW + 128 * (i >> 3));
#pragma unroll
                    for (int i = 0; i < 24; ++i) st[i & 1] = MFMA32(kf[i], qf[i >> 1], st[i & 1]);
                    __builtin_amdgcn_sched_group_barrier(0x100, 4, 0);
#pragma unroll
                    for (int i = 0; i < 24; ++i) { __builtin_amdgcn_sched_group_barrier(0x008, 1, 0); __builtin_amdgcn_sched_group_barrier(0x100, 1, 0); }
                }
                __builtin_amdgcn_sched_barrier(0);
                if (kt * 64 + 63 > q0) {
                    const int qg = q0 + r;
#pragma unroll
                    for (int mt = 0; mt < 2; ++mt)
#pragma unroll
                        for (int e = 0; e < 16; ++e) { const int kg = kt * 64 + 32 * mt + (e & 3) + 8 * (e >> 2) + 4 * hh; if (kg > qg) st[mt][e] = -1e30f; }
                }
                float mx = st[0][0];
#pragma unroll
                for (int mt = 0; mt < 2; ++mt)
#pragma unroll
                    for (int e = 0; e < 16; ++e) mx = fmaxf(mx, st[mt][e]);
                mx = fmaxf(mx, __shfl_xor(mx, 32));
                const float mnew = fmaxf(mrow, mx), alpha = __builtin_amdgcn_exp2f(mrow - mnew); mrow = mnew;
                float ls = 0.f;
#pragma unroll
                for (int mt = 0; mt < 2; ++mt)
#pragma unroll
                    for (int e = 0; e < 16; ++e) { const float p = __builtin_amdgcn_exp2f(st[mt][e] - mnew); st[mt][e] = p; ls += p; }
                lrow = lrow * alpha + ls;
                if (__any(alpha != 1.f)) {
#pragma unroll
                    for (int i = 0; i < 4; ++i) O[i] *= alpha; }
                bf16x8 pf[2][2];
#pragma unroll
                for (int mt = 0; mt < 2; ++mt)
#pragma unroll
                    for (int s = 0; s < 2; ++s) { u32x4 pk = {pk2(st[mt][8 * s], st[mt][8 * s + 1]), pk2(st[mt][8 * s + 2], st[mt][8 * s + 3]), pk2(st[mt][8 * s + 4], st[mt][8 * s + 5]), pk2(st[mt][8 * s + 6], st[mt][8 * s + 7])};
                        pf[mt][s] = __builtin_bit_cast(bf16x8, pk); }
                __builtin_amdgcn_sched_barrier(0);
                {
                    const LAS unsigned char* vb = sb + AT_KBYTES + (4 * hh + vq) * AT_VROW + 32 * ((lane >> 4) & 1) + 8 * (lane & 3); const LAS unsigned char* vx4[4];
#pragma unroll
                    for (int d = 0; d < 4; ++d) vx4[d] = vb + ((d ^ vq) & 3) * 64;
                    bf16x8 af[16];
#pragma unroll
                    for (int i = 0; i < 16; ++i) { const LAS unsigned char* vp = vx4[i & 3] + 16 * (i >> 2) * AT_VROW;
                        const s16x4 lo = __builtin_amdgcn_ds_read_tr16_b64_v4i16((LAS s16x4*)vp), hi = __builtin_amdgcn_ds_read_tr16_b64_v4i16((LAS s16x4*)(vp + 8 * AT_VROW)); af[i] = __builtin_shufflevector(lo, hi, 0, 1, 2, 3, 4, 5, 6, 7); }
#pragma unroll
                    for (int i = 0; i < 16; ++i) O[i & 3] = MFMA32(af[i], pf[i >> 3][(i >> 2) & 1], O[i & 3]);
                    __builtin_amdgcn_sched_group_barrier(0x100, 8, 0);
#pragma unroll
                    for (int i = 0; i < 16; ++i) { __builtin_amdgcn_sched_group_barrier(0x008, 1, 0); __builtin_amdgcn_sched_group_barrier(0x100, 2, 0); }
                }
                __builtin_amdgcn_sched_barrier(0);
            }
            if (kt + 2 < nkt) asm volatile("s_waitcnt vmcnt(5)" ::: "memory"); else asm volatile("s_waitcnt vmcnt(0)" ::: "memory");
            AT_BAR();
            stg = stg == 2 ? 0 : stg + 1;
        }
        lrow += __shfl_xor(lrow, 32);
        const float inv = 1.f / lrow;
        unsigned char* mx_ = (unsigned char*)MIX; unsigned char* orow = P32(mx_, (b * SEQ + q0 + r) * 2048 + h * 128);
#pragma unroll
        for (int dvt = 0; dvt < 4; ++dvt)
#pragma unroll
            for (int g4 = 0; g4 < 4; ++g4) *(GAS unsigned*)(orow + dvt * 32 + 8 * g4 + 4 * hh) = pk4_fp8(O[dvt][4 * g4] * inv, O[dvt][4 * g4 + 1] * inv, O[dvt][4 * g4 + 2] * inv, O[dvt][4 * g4 + 3] * inv);
    }
#undef AT_DMA
#undef AT_BAR
}

DI void ln_router_phase(const KArgs& a, LAS unsigned char* lds, int layer, const bf16* XPRE, bf16* X1, bf16* H, int wv) {
    const int tid = otid(wv), lane = tid & 63, wave = tid >> 6;
    LAS float* wT = (LAS float*)lds;
    { f32x4 rw[4][4];
#pragma unroll
      for (int i = 0; i < 4; ++i)
#pragma unroll
          for (int q4 = 0; q4 < 4; ++q4) rw[i][q4] = *(const f32x4*)(a.in[I_RW] + (size_t)(tid + 512 * i) * 16 + 4 * q4);
#pragma unroll
      for (int i = 0; i < 4; ++i)
#pragma unroll
          for (int q4 = 0; q4 < 4; ++q4)
#pragma unroll
              for (int e4 = 0; e4 < 4; ++e4) wT[(4 * q4 + e4) * 2048 + tid + 512 * i] = rw[i][q4][e4]; }
    __syncthreads();
    const float* MODl = (const float*)(a.ws + CTL_MOD) + (size_t)layer * 4 * 12288;
    const float* lg = a.in[I_LNMG] + layer * D; const float* lb = a.in[I_LNMB] + layer * D;
    unsigned* cnt = (unsigned*)(a.ws + CTL_CNT) + layer * 16 * 64;
    LAS int* lcnt = (LAS int*)(lds + LDS_MISC + 256); LAS int* lbase = lcnt + 16; LAS int* rec = lcnt + 32;
    if (tid < 16) lcnt[tid] = 0;
    int* RTE = (int*)(a.ws + A_RT); int* RTP = RTE + 2 * T; float* RTW = (float*)(RTP + 2 * T); int* TOKL = (int*)(a.ws + A_TOKL);
    const LAS float* wp[16];
#pragma unroll
    for (int e = 0; e < 16; ++e) { wp[e] = wT + e * 2048 + lane * 4; asm volatile("" : "+v"(wp[e])); }
    const float rbl = a.in[I_RB][lane >> 2];
    int lr = wave;
    for (int m = blockIdx.x * 8 + wave; m < T; m += gridDim.x * 8, lr += 8) {
        const int b = m / SEQ; const float* sh = MODl + (size_t)b * 12288 + 3 * 2048; const float* sc = sh + 2048;
        f32x4 v[8]; float s = 0.f;
#pragma unroll
        for (int j = 0; j < 8; ++j) { const u32x2 xp = *(const GAS u32x2*)(XPRE + (size_t)m * D + (lane + 64 * j) * 4); v[j] = (f32x4){bflo(xp.x), bfhi(xp.x), bflo(xp.y), bfhi(xp.y)}; s += (v[j].x + v[j].y) + (v[j].z + v[j].w); }
        const float mean = wave_sum(s) * (1.f / D); float s2 = 0.f;
#pragma unroll
        for (int j = 0; j < 8; ++j) { v[j] = v[j] - mean; s2 += (v[j].x * v[j].x + v[j].y * v[j].y) + (v[j].z * v[j].z + v[j].w * v[j].w); }
        const float rstd = rsqrtf(wave_sum(s2) * (1.f / D) + LN_EPS);
#pragma unroll
        for (int j = 0; j < 8; ++j) { const int col = (lane + 64 * j) * 4; const f32x4 x1 = v[j] * rstd * *(const f32x4*)(lg + col) + *(const f32x4*)(lb + col);
            { u32x2 ox = {pk2(x1.x, x1.y), pk2(x1.z, x1.w)}; *(GAS u32x2*)(X1 + (size_t)m * D + col) = ox; }
            const f32x4 hv = x1 * (*(const f32x4*)(sc + col) + 1.f) + *(const f32x4*)(sh + col);
            *(GAS unsigned*)((unsigned char*)H + (size_t)m * D + col) = pk4_fp8(hv.x, hv.y, hv.z, hv.w); v[j] = hv; }
        f32x2 part2[16];
#pragma unroll
        for (int e = 0; e < 16; ++e) part2[e] = (f32x2){0.f, 0.f};
#pragma unroll
        for (int j = 0; j < 8; ++j) { f32x4 wr_[16];
#pragma unroll
            for (int e = 0; e < 16; ++e) wr_[e] = *(const LAS f32x4*)(wp[e] + j * 256);
            __builtin_amdgcn_sched_barrier(0);
#pragma unroll
            for (int e = 0; e < 16; ++e) { part2[e] += (f32x2){v[j].x, v[j].y} * (f32x2){wr_[e].x, wr_[e].y}; part2[e] += (f32x2){v[j].z, v[j].w} * (f32x2){wr_[e].z, wr_[e].w}; }
            __builtin_amdgcn_sched_barrier(0); }
        float part[16];
#pragma unroll
        for (int e = 0; e < 16; ++e) part[e] = part2[e].x + part2[e].y;
        float r8[8], r4[4], r2[2], lg1;
        { const bool hi = lane & 32;
#pragma unroll
          for (int i = 0; i < 8; ++i) { const float mine = hi ? part[8 + i] : part[i], oth = hi ? part[i] : part[8 + i]; r8[i] = mine + __shfl_xor(oth, 32); } }
        { const bool hi = lane & 16;
#pragma unroll
          for (int i = 0; i < 4; ++i) { const float mine = hi ? r8[4 + i] : r8[i], oth = hi ? r8[i] : r8[4 + i]; r4[i] = mine + __shfl_xor(oth, 16); } }
        { const bool hi = lane & 8;
#pragma unroll
          for (int i = 0; i < 2; ++i) { const float mine = hi ? r4[2 + i] : r4[i], oth = hi ? r4[i] : r4[2 + i]; r2[i] = mine + __shfl_xor(oth, 8); } }
        { const bool hi = lane & 4; const float mine = hi ? r2[1] : r2[0], oth = hi ? r2[0] : r2[1]; lg1 = mine + __shfl_xor(oth, 4); }
        lg1 += dpp_xor1(lg1); lg1 += dpp_xor2(lg1);
        const float sgl = 1.f / (1.f + expf(-lg1)), sbl = sgl + rbl;
        float gs; { const float y1 = dpp_ror<4>(sbl), y2 = dpp_ror<8>(sbl), y3 = dpp_ror<12>(sbl);
            gs = fmaxf(fmaxf(fmaxf(sbl + y1, sbl + y2), fmaxf(sbl + y3, y1 + y2)), fmaxf(y1 + y3, y2 + y3)); }
        int bg = 0; float bgs = __builtin_bit_cast(float, __builtin_amdgcn_readlane(__builtin_bit_cast(int, gs), 0)); asm volatile("" : "+v"(bgs));
#pragma unroll
        for (int g = 1; g < 4; ++g) { float x = __builtin_bit_cast(float, __builtin_amdgcn_readlane(__builtin_bit_cast(int, gs), 16 * g)); asm volatile("" : "+v"(x)); const bool c = x > bgs; bgs = c ? x : bgs; bg = c ? g : bg; }
        const int bgu = __builtin_amdgcn_readfirstlane(bg);
        int e0 = 0, e1 = 0; float b0 = -1e30f, b1 = -1e30f, s0 = 0.f, s1 = 0.f;
#pragma unroll
        for (int i = 0; i < 4; ++i) { float x = __builtin_bit_cast(float, __builtin_amdgcn_readlane(__builtin_bit_cast(int, sbl), 16 * bgu + 4 * i)), sx = __builtin_bit_cast(float, __builtin_amdgcn_readlane(__builtin_bit_cast(int, sgl), 16 * bgu + 4 * i));
            asm volatile("" : "+v"(x), "+v"(sx)); const int e = 4 * bg + i; const bool g0 = x > b0, g1 = x > b1;
            b1 = g0 ? b0 : (g1 ? x : b1); e1 = g0 ? e0 : (g1 ? e : e1); s1 = g0 ? s0 : (g1 ? sx : s1);
            b0 = g0 ? x : b0; e0 = g0 ? e : e0; s0 = g0 ? sx : s0; }
        if (lane == 0) { const float inv = 1.f / (s0 + s1);
            const int p0 = __hip_atomic_fetch_add(lcnt + e0, 1, __ATOMIC_RELAXED, __HIP_MEMORY_SCOPE_WORKGROUP), p1 = __hip_atomic_fetch_add(lcnt + e1, 1, __ATOMIC_RELAXED, __HIP_MEMORY_SCOPE_WORKGROUP);
            rec[lr * 4] = m; rec[lr * 4 + 1] = e0; rec[lr * 4 + 2] = e1; rec[lr * 4 + 3] = p0 | (p1 << 16);
            RTE[2 * m] = e0; RTE[2 * m + 1] = e1; RTW[2 * m] = s0 * inv; RTW[2 * m + 1] = s1 * inv; }
    }
    __syncthreads();
    if (tid < 16) lbase[tid] = (int)atomicAdd(cnt + tid * 64, (unsigned)lcnt[tid]);
    __syncthreads();
    const int nrows = (T - (int)blockIdx.x * 8 + (int)gridDim.x * 8 - 1) / ((int)gridDim.x * 8) * 8;
    for (int i = tid; i < nrows; i += 512) { const int k = i >> 3, w8 = i & 7, m = (int)blockIdx.x * 8 + w8 + k * (int)gridDim.x * 8;
        if (m < T) { const int e0 = rec[i * 4 + 1], e1 = rec[i * 4 + 2], pp = rec[i * 4 + 3], q0 = lbase[e0] + (pp & 0xffff), q1 = lbase[e1] + (pp >> 16);
            TOKL[e0 * T + q0] = m; TOKL[e1 * T + q1] = m; RTP[2 * m] = q0; RTP[2 * m + 1] = q1; } }
    __syncthreads();
}

DI void moe_table(const KArgs& a, LAS unsigned char* lds, int layer, int wv) {
    LAS int* tab = (LAS int*)(lds + LDS_TAB);
    if (otid(wv) == 0) { const unsigned* cnt = (const unsigned*)(a.ws + CTL_CNT) + layer * 16 * 64; int acc = 0;
        for (int e = 0; e < 16; ++e) { const int c = (int)cnt[e * 64]; tab[e] = acc; tab[32 + e] = c; acc += (c + 255) >> 8; } tab[16] = acc; }
    __syncthreads();
}
template <int NTB> struct MoeOrder {
    int G, c, layer; const LAS int* tab; const int* tokl;
    DI bool next(int i, Unit& u) const { const int L = i * G + c, mt = L / NTB, nt = L % NTB; if (mt >= tab[16]) return false; int e = 0;
#pragma unroll
        for (int k = 1; k < 16; ++k) e += (mt >= tab[k]) ? 1 : 0;
        u.pm = mt; u.pn = (layer * 16 + e) * NTB + nt; u.aux = e | (nt << 8) | ((mt - tab[e]) << 16); return true; }
    DI int arow(const Unit& u, int r) const { const int e = u.aux & 255, j = (u.aux >> 16) * 256 + r; return j < tab[32 + e] ? tokl[e * T + j] : 0; }
    DI int koff(const Unit&) const { return 0; }
};
struct EpiGateUp { static constexpr bool PERM = true;
    unsigned char* ACT;
    DI void operator()(const Acc& acc, const Unit& u, int wr, int wc, int fr, int fq) const {
        const int nt = (u.aux >> 8) & 255;
        EPI_ROWS_BEGIN
            const f32x4 g0 = acc[ai][0][m][0], g1 = acc[ai][0][m][1], u0 = acc[ai][1][m][0], u1 = acc[ai][1][m][1];
            f32x4 o0, o1;
#pragma unroll
            for (int e = 0; e < 4; ++e) { o0[e] = g0[e] * sigmoidf_(g0[e]) * u0[e]; o1[e] = g1[e] * sigmoidf_(g1[e]) * u1[e]; }
            u32x2 o8 = {pk4_fp8(o0.x, o0.y, o0.z, o0.w), pk4_fp8(o1.x, o1.y, o1.z, o1.w)}; *(u32x2*)P32(ACT, row * 512 + nt * 128 + 32 * wc + 8 * fq) = o8;
        EPI_ROWS_END
    }
};
struct EpiDown { static constexpr bool PERM = true;
    bf16* YS;
    DI void operator()(const Acc& acc, const Unit& u, int wr, int wc, int fr, int fq) const {
        const int nt = (u.aux >> 8) & 255;
        EPI_ROWS_BEGIN
#pragma unroll
            for (int bj = 0; bj < 2; ++bj) *(u32x4*)P32(YS, row * 2048 + nt * 256 + 128 * bj + 32 * wc + 8 * fq) = pack8(acc[ai][bj][m][0], acc[ai][bj][m][1]);
        EPI_ROWS_END
    }
};
DI void ln_ffn_phase(const KArgs& a, int layer, const bf16* X1, float* XO, bf16* Hn, int wv) {
    const int lane = otid(wv) & 63, wave = otid(wv) >> 6;
    const float* MODl = (const float*)(a.ws + CTL_MOD) + (size_t)layer * 4 * 12288; const float* MODn = MODl + 4 * 12288;
    const float* lg = a.in[I_LNFG] + layer * D; const float* lb = a.in[I_LNFB] + layer * D;
    const unsigned* cnt = (const unsigned*)(a.ws + CTL_CNT) + layer * 16 * 64;
    const int* RTE = (const int*)(a.ws + A_RT); const int* RTP = RTE + 2 * T; const float* RTW = (const float*)(RTP + 2 * T); const bf16* YS = (const bf16*)(a.ws + A_YS);
    for (int m = blockIdx.x * 8 + wave; m < T; m += gridDim.x * 8) {
        const int b = m / SEQ; const float* gf = MODl + (size_t)b * 12288 + 5 * 2048;
        const int e0 = RTE[2 * m], e1 = RTE[2 * m + 1]; int t0 = 0, t1 = 0;
        for (int e = 0; e < 16; ++e) { const int tl = ((int)cnt[e * 64] + 255) >> 8; t0 += e < e0 ? tl : 0; t1 += e < e1 ? tl : 0; }
        const bf16* y0 = YS + ((size_t)t0 * 256 + RTP[2 * m]) * 2048; const bf16* y1 = YS + ((size_t)t1 * 256 + RTP[2 * m + 1]) * 2048; const float w0 = RTW[2 * m], w1 = RTW[2 * m + 1];
        f32x4 v[8]; float s = 0.f;
#pragma unroll
        for (int j = 0; j < 8; ++j) { const int col = (lane + 64 * j) * 4; const u32x2 a0 = *(const u32x2*)(y0 + col), a1 = *(const u32x2*)(y1 + col);
            const f32x4 y = {w0 * bflo(a0.x) + w1 * bflo(a1.x), w0 * bfhi(a0.x) + w1 * bfhi(a1.x), w0 * bflo(a0.y) + w1 * bflo(a1.y), w0 * bfhi(a0.y) + w1 * bfhi(a1.y)};
            const u32x2 xq = *(const u32x2*)(X1 + (size_t)m * D + col); const f32x4 xv = {bflo(xq.x), bfhi(xq.x), bflo(xq.y), bfhi(xq.y)};
            v[j] = xv * DN_ALPHA + (*(const f32x4*)(gf + col) + 1.f) * y; s += (v[j].x + v[j].y) + (v[j].z + v[j].w); }
        const float mean = wave_sum(s) * (1.f / D); float s2 = 0.f;
#pragma unroll
        for (int j = 0; j < 8; ++j) { v[j] = v[j] - mean; s2 += (v[j].x * v[j].x + v[j].y * v[j].y) + (v[j].z * v[j].z + v[j].w * v[j].w); }
        const float rstd = rsqrtf(wave_sum(s2) * (1.f / D) + LN_EPS);
#pragma unroll
        for (int j = 0; j < 8; ++j) { const int col = (lane + 64 * j) * 4; const f32x4 xo = v[j] * rstd * *(const f32x4*)(lg + col) + *(const f32x4*)(lb + col);
            if (Hn) { u32x2 oq = {pk2(xo.x, xo.y), pk2(xo.z, xo.w)}; *(u32x2*)((bf16*)XO + (size_t)m * D + col) = oq; }
            else *(f32x4*)(XO + (size_t)m * D + col) = xo;
            if (Hn) { const float* sh = MODn + (size_t)b * 12288; const f32x4 hv = xo * (*(const f32x4*)(sh + 2048 + col) + 1.f) + *(const f32x4*)(sh + col);
                *(unsigned*)((unsigned char*)Hn + (size_t)m * D + col) = pk4_fp8(hv.x, hv.y, hv.z, hv.w); } }
    }
}

struct EpiIn1 { static constexpr bool PERM = true;
    bf16 *ZD, *ZR;
    DI void operator()(const Acc& acc, const Unit& u, int wr, int wc, int fr, int fq) const {
        EPI_ROWS_BEGIN
#pragma unroll
            for (int bj = 0; bj < 2; ++bj) { const int col = u.pn * 256 + 128 * bj + 32 * wc + 8 * fq; const u32x4 o = pack8(acc[ai][bj][m][0], acc[ai][bj][m][1]);
                if (col < DIL_IN) *(u32x4*)P32(ZD, row * DIL_IN + col) = o; else if (col < ODD_IN) *(u32x4*)P32(ZR, row * RW_IN + (col - DIL_IN)) = o; }
        EPI_ROWS_END
    }
};
constexpr int DA_KSTR = 272, DA_VROW = 320, DA_KBYTES = 64 * DA_KSTR, DA_STG = DA_KBYTES + 64 * DA_VROW;
struct DilPre { bf16x8 qf[4]; u32x4 kreg[2], vreg[2]; float blv[2]; };
DI void dil_issue(const bf16* ZD, const float* BL, int unit, int wv, DilPre& P) {
    const int tid = otid(wv), lane = tid & 63, w = tid >> 6, r = lane & 31, hh = lane >> 5, hd = w >> 2, qs = w & 3;
    const int hp = unit & 3, sb_ = (unit >> 2) & 31, gi = (unit >> 7) % 3, b = unit / 384;
    const int dil = gi == 0 ? 1 : (gi == 1 ? 4 : 16), nb = 32 / dil, rr = sb_ / nb, n = sb_ % nb, h = hp * 2 + hd, kt0 = n == 0 ? 2 : 0;
    const bf16* Zb = ZD + (size_t)b * SEQ * DIL_IN + gi * 1536;
    const int qtok = (n * 128 + 32 * qs + r) * dil + rr;
#pragma unroll
    for (int k = 0; k < 2; ++k) { const int i = tid + 512 * k, hd_ = i >= 384 ? 1 : 0, d = i - 384 * hd_ - 127;
        P.blv[k] = (i < 768 && d >= 0 && d <= 128) ? ((const GAS float*)BL)[(gi * 8 + hp * 2 + hd_) * 132 + d] : -1e30f; }
#pragma unroll
    for (int ks = 0; ks < 4; ++ks) P.qf[ks] = *(const GAS bf16x8*)P32(Zb, qtok * DIL_IN + h * 64 + 16 * ks + 8 * hh);
#pragma unroll
    for (int i = 0; i < 2; ++i) { const int p = tid + 512 * i, kr = p >> 4, c16 = p & 15; const int ktok = ((n - 1) * 128 + kt0 * 64 + kr) * dil + rr;
        P.kreg[i] = *(const GAS u32x4*)P32(Zb, ktok * DIL_IN + 512 + hp * 128 + c16 * 8); P.vreg[i] = *(const GAS u32x4*)P32(Zb, ktok * DIL_IN + 1024 + hp * 128 + c16 * 8); }
}
DI void dil_attn_unit(LAS unsigned char* lds, const bf16* ZD, const float* BL, bf16* DPO, float* DPM, float* DPL, int unit, int next, DilPre& P, int wv) {
    const int tid = otid(wv), lane = tid & 63, w = tid >> 6, r = lane & 31, hh = lane >> 5, hd = w >> 2, qs = w & 3;
    const int hp = unit & 3, sb_ = (unit >> 2) & 31, gi = (unit >> 7) % 3, b = unit / 384;
    const int dil = gi == 0 ? 1 : (gi == 1 ? 4 : 16), nb = 32 / dil, rr = sb_ / nb, n = sb_ % nb;
    const int h = hp * 2 + hd;
    const bf16* Zb = ZD + (size_t)b * SEQ * DIL_IN + gi * 1536;
    LAS float* bl = (LAS float*)(lds + 2 * DA_STG);
    __syncthreads();
    bl[tid] = P.blv[0]; if (tid < 256) bl[512 + tid] = P.blv[1];
    const int qi = 32 * qs + r, qtok = (n * 128 + qi) * dil + rr;
    bf16x8 qf[4];
#pragma unroll
    for (int ks = 0; ks < 4; ++ks) qf[ks] = P.qf[ks];
    f32x16 O[2];
#pragma unroll
    for (int i = 0; i < 2; ++i) for (int e = 0; e < 16; ++e) O[i][e] = 0.f;
    float mrow = -1e30f, lrow = 0.f;
    u32x4 kreg[2] = {P.kreg[0], P.kreg[1]}, vreg[2] = {P.vreg[0], P.vreg[1]};
    const int kt0 = n == 0 ? 2 : 0;
#define DA_LOAD(kt) do { _Pragma("unroll") for (int i = 0; i < 2; ++i) { const int p = tid + 512 * i, kr = p >> 4, c16 = p & 15; const int ktok = ((n - 1) * 128 + (kt) * 64 + kr) * dil + rr; \
            kreg[i] = *(const GAS u32x4*)P32(Zb, ktok * DIL_IN + 512 + hp * 128 + c16 * 8); } \
        _Pragma("unroll") for (int i = 0; i < 2; ++i) { const int p = tid + 512 * i, kr = p >> 4, c16 = p & 15; const int ktok = ((n - 1) * 128 + (kt) * 64 + kr) * dil + rr; vreg[i] = *(const GAS u32x4*)P32(Zb, ktok * DIL_IN + 1024 + hp * 128 + c16 * 8); } } while (0)
#define DA_STORE(buf) do { LAS unsigned char* sb = lds + (buf) * DA_STG; _Pragma("unroll") for (int i = 0; i < 2; ++i) { const int p = tid + 512 * i, kr = p >> 4, c16 = p & 15; *(LAS u32x4*)(sb + kr * DA_KSTR + c16 * 16) = kreg[i]; } \
        _Pragma("unroll") for (int i = 0; i < 2; ++i) { const int p = tid + 512 * i; *(LAS u32x4*)(sb + DA_KBYTES + (p >> 4) * DA_VROW + (p & 15) * 16) = vreg[i]; } } while (0)
    DA_STORE(kt0 & 1);
    __syncthreads();
    for (int kt = kt0; kt < 4; ++kt) {
        if (kt + 1 < 4) DA_LOAD(kt + 1); else if (next >= 0) dil_issue(ZD, BL, next, wv, P);
        const LAS unsigned char* sb = lds + (kt & 1) * DA_STG;
        if (64 * kt + 63 >= 32 * qs && 64 * kt <= 32 * qs + 31 + 128) {
            f32x16 st[2];
#pragma unroll
            for (int mt = 0; mt < 2; ++mt) for (int e = 0; e < 16; ++e) st[mt][e] = 0.f;
            __builtin_amdgcn_sched_barrier(0);
            {
                const LAS unsigned char* kb = sb + r * DA_KSTR + (hd * 64 + 8 * hh) * 2; bf16x8 kf[8];
#pragma unroll
                for (int i = 0; i < 8; ++i) kf[i] = *(const LAS bf16x8*)(kb + 32 * (i & 1) * DA_KSTR + 32 * (i >> 1));
#pragma unroll
                for (int i = 0; i < 8; ++i) st[i & 1] = MFMA32(kf[i], qf[i >> 1], st[i & 1]);
                __builtin_amdgcn_sched_group_barrier(0x100, 3, 0);
#pragma unroll
                for (int i = 0; i < 8; ++i) { __builtin_amdgcn_sched_group_barrier(0x008, 1, 0); __builtin_amdgcn_sched_group_barrier(0x100, 1, 0); }
            }
            __builtin_amdgcn_sched_barrier(0);
#pragma unroll
            for (int mt = 0; mt < 2; ++mt) { const LAS float* lp = bl + hd * 384 + 127 + (128 + qi - 64 * kt - 32 * mt - 4 * hh) - 27;
#pragma unroll
                for (int e = 0; e < 16; ++e) st[mt][e] = st[mt][e] * (0.125f * 1.44269504089f) + lp[27 - ((e & 3) + 8 * (e >> 2))]; }
            float mx = st[0][0];
#pragma unroll
            for (int mt = 0; mt < 2; ++mt)
#pragma unroll
                for (int e = 0; e < 16; ++e) mx = fmaxf(mx, st[mt][e]);
            mx = fmaxf(mx, __shfl_xor(mx, 32));
            const float mnew = fmaxf(mrow, mx), alpha = __builtin_amdgcn_exp2f(mrow - mnew); mrow = mnew;
            float ls = 0.f;
#pragma unroll
            for (int mt = 0; mt < 2; ++mt)
#pragma unroll
                for (int e = 0; e < 16; ++e) { const float p = __builtin_amdgcn_exp2f(st[mt][e] - mnew); st[mt][e] = p; ls += p; }
            lrow = lrow * alpha + ls;
            if (__any(alpha != 1.f)) { O[0] *= alpha; O[1] *= alpha; }
            bf16x8 pf[2][2];
#pragma unroll
            for (int mt = 0; mt < 2; ++mt)
#pragma unroll
                for (int s = 0; s < 2; ++s) { u32x4 pk = {pk2(st[mt][8 * s], st[mt][8 * s + 1]), pk2(st[mt][8 * s + 2], st[mt][8 * s + 3]), pk2(st[mt][8 * s + 4], st[mt][8 * s + 5]), pk2(st[mt][8 * s + 6], st[mt][8 * s + 7])};
                    pf[mt][s] = __builtin_bit_cast(bf16x8, pk); }
            __builtin_amdgcn_sched_barrier(0);
            {
                const LAS unsigned char* vb = sb + DA_KBYTES + (4 * hh + ((lane >> 2) & 3)) * DA_VROW + (hd * 64 + 16 * ((lane >> 4) & 1)) * 2 + 8 * (lane & 3); bf16x8 af[8];
#pragma unroll
                for (int i = 0; i < 8; ++i) { const LAS unsigned char* vp = vb + 16 * (i >> 1) * DA_VROW + (i & 1) * 64;
                    const s16x4 lo = __builtin_amdgcn_ds_read_tr16_b64_v4i16((LAS s16x4*)vp), hi = __builtin_amdgcn_ds_read_tr16_b64_v4i16((LAS s16x4*)(vp + 8 * DA_VROW)); af[i] = __builtin_shufflevector(lo, hi, 0, 1, 2, 3, 4, 5, 6, 7); }
#pragma unroll
                for (int i = 0; i < 8; ++i) O[i & 1] = MFMA32(af[i], pf[i >> 2][(i >> 1) & 1], O[i & 1]);
                __builtin_amdgcn_sched_group_barrier(0x100, 6, 0);
#pragma unroll
                for (int i = 0; i < 8; ++i) { __builtin_amdgcn_sched_group_barrier(0x008, 1, 0); __builtin_amdgcn_sched_group_barrier(0x100, 2, 0); }
            }
            __builtin_amdgcn_sched_barrier(0);
        }
        if (kt + 1 < 4) DA_STORE((kt + 1) & 1);
        __syncthreads();
    }
    lrow += __shfl_xor(lrow, 32);
    const float inv = 1.f / lrow;
    const int tokg = b * SEQ + qtok;
    bf16* orow = P32(DPO, (gi * T + tokg) * 512 + h * 64);
#pragma unroll
    for (int dvt = 0; dvt < 2; ++dvt)
#pragma unroll
        for (int g4 = 0; g4 < 4; ++g4) { u32x2 o = {pk2(O[dvt][4 * g4] * inv, O[dvt][4 * g4 + 1] * inv), pk2(O[dvt][4 * g4 + 2] * inv, O[dvt][4 * g4 + 3] * inv)};
            *(GAS u32x2*)(orow + dvt * 32 + 8 * g4 + 4 * hh) = o; }
    if (hh == 0) { *(GAS float*)P32(DPM, (gi * T + tokg) * 8 + h) = mrow; *(GAS float*)P32(DPL, (gi * T + tokg) * 8 + h) = lrow; }
#undef DA_LOAD
#undef DA_STORE
}
DI void dil_merge(const bf16* DPO, const float* DPM, const float* DPL, bf16* MIX, int wv) {
    const int gt = blockIdx.x * 512 + otid(wv), NT_ = gridDim.x * 512;
    for (int i = gt; i < T * 64; i += NT_) { const int tok = i >> 6, c8 = i & 63, h = c8 >> 3;
        float m[3], l[3];
#pragma unroll
        for (int g = 0; g < 3; ++g) { m[g] = DPM[((size_t)g * T + tok) * 8 + h]; l[g] = DPL[((size_t)g * T + tok) * 8 + h]; }
        const float M = fmaxf(m[0], fmaxf(m[1], m[2])); float wsum = 0.f, wg[3];
#pragma unroll
        for (int g = 0; g < 3; ++g) { wg[g] = exp2f(m[g] - M) * l[g]; wsum += wg[g]; }
        const float inv = 1.f / wsum; float o[8];
#pragma unroll
        for (int e = 0; e < 8; ++e) o[e] = 0.f;
#pragma unroll
        for (int g = 0; g < 3; ++g) { const u32x4 v = *(const u32x4*)(DPO + ((size_t)g * T + tok) * 512 + c8 * 8); const float wn = wg[g] * inv;
            o[0] += wn * bflo(v.x); o[1] += wn * bfhi(v.x); o[2] += wn * bflo(v.y); o[3] += wn * bfhi(v.y); o[4] += wn * bflo(v.z); o[5] += wn * bfhi(v.z); o[6] += wn * bflo(v.w); o[7] += wn * bfhi(v.w); }
        u32x2 r = {pk4_fp8(o[0], o[1], o[2], o[3]), pk4_fp8(o[4], o[5], o[6], o[7])}; *(u32x2*)((unsigned char*)MIX + (size_t)tok * 2048 + c8 * 8) = r; }
}

DI void rwkv_prep(const bf16* ZR, const float* mu, bf16* LIN, int wv) {
    const int gt = blockIdx.x * 512 + otid(wv), NT_ = gridDim.x * 512;
    for (int i = gt; i < T * 48; i += NT_) { const int tok = i / 48, c0 = (i % 48) * 8, s = tok % SEQ; float o[8];
        if (c0 < 352) { const u32x4 z = *(const u32x4*)(ZR + (size_t)tok * RW_IN + 4608 + c0); u32x4 zp = {0u, 0u, 0u, 0u}; if (s > 0) zp = *(const u32x4*)(ZR + (size_t)(tok - 1) * RW_IN + 4608 + c0);
            const unsigned* zz = (const unsigned*)&z; const unsigned* pp = (const unsigned*)&zp;
#pragma unroll
            for (int e = 0; e < 8; ++e) { const float zv = (e & 1) ? bfhi(zz[e >> 1]) : bflo(zz[e >> 1]), pv = (e & 1) ? bfhi(pp[e >> 1]) : bflo(pp[e >> 1]); const float xs = zv + (pv - zv) * mu[4608 + c0 + e];
                o[e] = c0 < 64 ? tanhf(xs) : (c0 < 128 ? xs : sigmoidf_(xs)); } }
        else {
#pragma unroll
            for (int e = 0; e < 8; ++e) o[e] = 0.f; }
        u32x4 r = {pk2(o[0], o[1]), pk2(o[2], o[3]), pk2(o[4], o[5]), pk2(o[6], o[7])}; *(u32x4*)(LIN + (size_t)tok * 384 + c0) = r; }
}
struct LoraOrder : pg8::StaticOrder { DI int koff(const Unit& u) const { return u.pn >= 12 ? 128 : 0; } };
struct EpiLora { static constexpr bool PERM = true;
    bf16 *WDEC, *AA, *GG; const float *w0, *a0;
    DI void operator()(const Acc& acc, const Unit& u, int wr, int wc, int fr, int fq) const {
        const int kind = u.pn / 6;
        EPI_ROWS_BEGIN
#pragma unroll
            for (int bj = 0; bj < 2; ++bj) { const int col = (u.pn % 6) * 256 + 128 * bj + 32 * wc + 8 * fq; f32x4 v0 = acc[ai][bj][m][0], v1 = acc[ai][bj][m][1];
                if (kind == 0) { const f32x4 b0 = *(const f32x4*)P32(w0, col), b1 = *(const f32x4*)P32(w0, col + 4);
#pragma unroll
                    for (int e = 0; e < 4; ++e) { v0[e] = -0.6065306597f * sigmoidf_(v0[e] + b0[e]); v1[e] = -0.6065306597f * sigmoidf_(v1[e] + b1[e]); }
                    *(u32x4*)P32(WDEC, row * RWW + col) = pack8(v0, v1); }
                else if (kind == 1) { const f32x4 b0 = *(const f32x4*)P32(a0, col), b1 = *(const f32x4*)P32(a0, col + 4);
#pragma unroll
                    for (int e = 0; e < 4; ++e) { v0[e] = sigmoidf_(v0[e] + b0[e]); v1[e] = sigmoidf_(v1[e] + b1[e]); }
                    *(u32x4*)P32(AA, row * RWW + col) = pack8(v0, v1); }
                else *(u32x4*)P32(GG, row * RWW + col) = pack8(v0, v1); }
        EPI_ROWS_END
    }
};
constexpr int CK_AT = 0, CK_RT = 2048, CK_BH = 4096, CK_KH = 6144, CK_MT = 8192, CK_NK = 8704, CK_PB = 9216, CK_PK = 9728, CK_G15 = 10240, CK_VT = 10496  , CK_VTS = 40, CK_BS = 13056  , CK_SLOT = 13120;
constexpr int CK_HALF = 128;
constexpr int CK_N1 = (int)((128 * MiB) / CK_SLOT) - 1;
DI unsigned char* ck_slot(unsigned char* ws, int job) { return job < CK_N1 ? ws + WS_X1 + (size_t)job * CK_SLOT : ws + WS_W_GU + (size_t)(job - CK_N1) * CK_SLOT; }
static_assert((size_t)(96 * CK_HALF - CK_N1 + 1) * CK_SLOT <= 64 * MiB, "chunk buffer");
constexpr int PJ = 4;
constexpr int PL_AT = 0, PL_BT = 2304, PL_KT = 4608, PL_RT = 6912, PL_BH = 9216, PL_KH = 11520  ,
              PL_NAB = 13824  , PL_MTS = 14848  , PL_LDT = 15616  , PL_C = 19968  ,
              PL_T = 24064  , PL_VT = 24320  , PL_END = 26880;
static_assert(PJ * PL_END <= RING_BYTES && PJ == 4, "prep LDS");
DI bf16x8 ldfrag(const LAS unsigned char* p) { return *(const LAS bf16x8*)p; }
DI u32x4 ld2x8(const LAS unsigned char* p0, const LAS unsigned char* p1) { const u32x2 lo = *(const LAS u32x2*)p0, hi = *(const LAS u32x2*)p1; return (u32x4){lo.x, lo.y, hi.x, hi.y}; }
DI void unpk8(const u32x4 v, float (&o)[8]) { o[0] = bflo(v.x); o[1] = bfhi(v.x); o[2] = bflo(v.y); o[3] = bfhi(v.y); o[4] = bflo(v.z); o[5] = bfhi(v.z); o[6] = bflo(v.w); o[7] = bfhi(v.w); }
DI void ldf8(const float* p, float (&o)[8]) { const f32x4 x = *(const f32x4*)p, y = *(const f32x4*)(p + 4); o[0] = x.x; o[1] = x.y; o[2] = x.z; o[3] = x.w; o[4] = y.x; o[5] = y.y; o[6] = y.z; o[7] = y.w; }
DI u32x4 pack8(const float (&x)[8]) { return (u32x4){pk2(x[0], x[1]), pk2(x[2], x[3]), pk2(x[4], x[5]), pk2(x[6], x[7])}; }
DI void rwkv_chunk_prep(const KArgs& a, LAS unsigned char* lds0, int half, int wv) {
    const int tid = otid(wv), lane = tid & 63, w = tid >> 6;
    const bf16* ZR = (const bf16*)(a.ws + A_ZR); const bf16* WDEC = (const bf16*)(a.ws + A_WDEC); const bf16* AA = (const bf16*)(a.ws + A_AA);
    const int js = tid >> 7, st = (tid >> 3) & 15, oc = tid & 7;
    LAS unsigned char* ldj = lds0 + js * PL_END;
    const float* mu = a.in[I_MU];
    bf16x8 lfrag;
#pragma unroll
    for (int j = 0; j < 8; ++j) lfrag[j] = ((lane & 31) >= 16 || 8 * (lane >> 5) + j <= (lane & 31)) ? (short)0x3F80 : (short)0;
    for (int it = blockIdx.x; it < 96 * CK_HALF / PJ; it += gridDim.x) {
        const int job0 = it * PJ, bh = job0 / CK_HALF, cl0 = job0 % CK_HALF, b = bh / 24, h = bh % 24, col = h * 64 + 8 * oc;
        const int s = (half * CK_HALF + cl0 + js) * 16 + st; const size_t tok = (size_t)b * SEQ + s;
        unsigned char* slot = ck_slot(a.ws, job0 + js);
        const bf16* z = ZR + tok * RW_IN + col;
        const u32x4 zr = *(const u32x4*)z, zk = *(const u32x4*)(z + 1536), zv = *(const u32x4*)(z + 3072);
        u32x4 pr = {0u, 0u, 0u, 0u}, pk_ = {0u, 0u, 0u, 0u}, pv = {0u, 0u, 0u, 0u};
        if (s > 0) { pr = *(const u32x4*)(z - RW_IN); pk_ = *(const u32x4*)(z - RW_IN + 1536); pv = *(const u32x4*)(z - RW_IN + 3072); }
        const u32x4 za = *(const u32x4*)(AA + tok * RWW + col), zw = *(const u32x4*)(WDEC + tok * RWW + col);
        float r[8], km[8], q[8], bb[8], ld[8];
        {   float cz[8], cp[8], m_[8], k_[8], v_[8], as_[8], c1[8], c2[8];
            unpk8(zr, cz); unpk8(pr, cp); ldf8(mu + col, m_);
#pragma unroll
            for (int e = 0; e < 8; ++e) r[e] = cz[e] + (cp[e] - cz[e]) * m_[e];
            unpk8(zk, cz); unpk8(pk_, cp); ldf8(mu + 1536 + col, m_);
#pragma unroll
            for (int e = 0; e < 8; ++e) k_[e] = cz[e] + (cp[e] - cz[e]) * m_[e];
            unpk8(zv, cz); unpk8(pv, cp); ldf8(mu + 3072 + col, m_);
#pragma unroll
            for (int e = 0; e < 8; ++e) v_[e] = cz[e] + (cp[e] - cz[e]) * m_[e];
            unpk8(za, as_); unpk8(zw, ld); ldf8(a.in[I_KK] + col, c1);
            float nn = 0.f;
#pragma unroll
            for (int e = 0; e < 8; ++e) { q[e] = k_[e] * c1[e]; nn += q[e] * q[e]; }
            nn = red8(nn);
            const float invn = fminf(__builtin_amdgcn_rsqf(nn), 1e12f);
            ldf8(a.in[I_KA] + col, c1); ldf8(a.in[I_RK] + col, c2);
            float bs = 0.f;
#pragma unroll
            for (int e = 0; e < 8; ++e) { q[e] *= invn; km[e] = k_[e] * (1.f + (as_[e] - 1.f) * c1[e]); bb[e] = q[e] * as_[e]; bs += r[e] * km[e] * c2[e]; }
            bs = red8(bs);
            if (oc == 0) *(float*)(slot + CK_BS + st * 4) = bs;
#pragma unroll
            for (int e = 0; e < 8; ++e) *(LAS float*)(ldj + PL_LDT + ((8 * oc + e) * 17 + st) * 4) = ld[e];
#pragma unroll
            for (int e = 0; e < 8; e += 2) { const unsigned pv2 = pk2(v_[e], v_[e + 1]);
                *(LAS bf16*)(ldj + PL_VT + (8 * oc + e) * CK_VTS + st * 2) = (bf16)(pv2 & 0xffffu); *(LAS bf16*)(ldj + PL_VT + (8 * oc + e + 1) * CK_VTS + st * 2) = (bf16)(pv2 >> 16); } }
        __syncthreads();
        {
            LAS unsigned char* lds = lds0 + (w >> 1) * PL_END; const int r_ = lane & 31, hh = lane >> 5, ch = 32 * (w & 1) + r_;
            float x[8];
#pragma unroll
            for (int j = 0; j < 8; ++j) x[j] = *(const LAS float*)(lds + PL_LDT + (ch * 17 + 8 * hh + j) * 4);
            const u32x4 ph = {pk2(x[0], x[1]), pk2(x[2], x[3]), pk2(x[4], x[5]), pk2(x[6], x[7])};
            const u32x4 pl = {pk2(x[0] - bflo(ph.x), x[1] - bfhi(ph.x)), pk2(x[2] - bflo(ph.y), x[3] - bfhi(ph.y)), pk2(x[4] - bflo(ph.z), x[5] - bfhi(ph.z)), pk2(x[6] - bflo(ph.w), x[7] - bfhi(ph.w))};
            f32x16 cs; for (int e = 0; e < 16; ++e) cs[e] = 0.f;
            cs = MFMA32(lfrag, __builtin_bit_cast(bf16x8, ph), cs); cs = MFMA32(lfrag, __builtin_bit_cast(bf16x8, pl), cs);
#pragma unroll
            for (int e = 0; e < 8; ++e) *(LAS float*)(lds + PL_C + (((e & 3) + 8 * (e >> 2) + 4 * hh) * 64 + ch) * 4) = cs[e];
            if (hh == 0) *(LAS float*)(lds + PL_T + ch * 4) = cs[8]; }
        __syncthreads();
        {
            float c[8], t[8];
            { const f32x4 ca = *(const LAS f32x4*)(ldj + PL_C + (st * 64 + 8 * oc) * 4), cb = *(const LAS f32x4*)(ldj + PL_C + (st * 64 + 8 * oc + 4) * 4), ta = *(const LAS f32x4*)(ldj + PL_T + 8 * oc * 4), tb = *(const LAS f32x4*)(ldj + PL_T + (8 * oc + 4) * 4);
              c[0] = ca.x; c[1] = ca.y; c[2] = ca.z; c[3] = ca.w; c[4] = cb.x; c[5] = cb.y; c[6] = cb.z; c[7] = cb.w; t[0] = ta.x; t[1] = ta.y; t[2] = ta.z; t[3] = ta.w; t[4] = tb.x; t[5] = tb.y; t[6] = tb.z; t[7] = tb.w; }
            float at[8], bt[8], kt[8], rt[8], bhv[8], khv[8];
#pragma unroll
            for (int e = 0; e < 8; ++e) { const float g = __expf(c[e]), gp = __expf(c[e] - ld[e]), gi = __expf(-c[e]), gr = __expf(t[e] - c[e]);
                at[e] = -q[e] * gp; bt[e] = bb[e] * gi; kt[e] = km[e] * gi; rt[e] = r[e] * g; bhv[e] = bb[e] * gr; khv[e] = km[e] * gr; }
            LAS unsigned char* row = ldj + st * 144 + oc * 16;
            *(LAS u32x4*)(row + PL_AT) = pack8(at); *(LAS u32x4*)(row + PL_BT) = pack8(bt); *(LAS u32x4*)(row + PL_KT) = pack8(kt); *(LAS u32x4*)(row + PL_RT) = pack8(rt);
            *(LAS u32x4*)(row + PL_BH) = pack8(bhv); *(LAS u32x4*)(row + PL_KH) = pack8(khv);
            if (st == 0) { *(f32x4*)(slot + CK_G15 + 8 * oc * 4) = (f32x4){__expf(t[0]), __expf(t[1]), __expf(t[2]), __expf(t[3])}; *(f32x4*)(slot + CK_G15 + (8 * oc + 4) * 4) = (f32x4){__expf(t[4]), __expf(t[5]), __expf(t[6]), __expf(t[7])}; } }
        __syncthreads();
        if (w < PJ) {
            LAS unsigned char* lds = lds0 + w * PL_END; unsigned char* slot = ck_slot(a.ws, job0 + w); const int r = lane & 31, hh = lane >> 5, r16 = r & 15;
            f32x16 d; for (int e = 0; e < 16; ++e) d[e] = 0.f;
#pragma unroll
            for (int ks = 0; ks < 4; ++ks) d = MFMA32(ldfrag(lds + (r < 16 ? PL_BT : PL_KT) + r16 * 144 + ks * 32 + hh * 16), ldfrag(lds + (r < 16 ? PL_AT : PL_RT) + r16 * 144 + ks * 32 + hh * 16), d);
            float lo8[8], hi8[8];
#pragma unroll
            for (int e = 0; e < 8; ++e) { const int sr = (e & 3) + 8 * (e >> 2) + 4 * hh; const bool keep = r < 16 ? sr < r16 : sr <= r16; lo8[e] = keep ? d[e] : 0.f; hi8[e] = keep ? d[8 + e] : 0.f; }
            const u32x4 plo = {pk2(lo8[0], lo8[1]), pk2(lo8[2], lo8[3]), pk2(lo8[4], lo8[5]), pk2(lo8[6], lo8[7])}, phi = {pk2(hi8[0], hi8[1]), pk2(hi8[2], hi8[3]), pk2(hi8[4], hi8[5]), pk2(hi8[6], hi8[7])};
            if (r < 16) {
#pragma unroll
                for (int e = 0; e < 8; ++e) *(LAS float*)(lds + PL_NAB + (((e & 3) + 8 * (e >> 2) + 4 * hh) * 16 + r16) * 4) = lo8[e];
                *(u32x4*)(slot + CK_NK + (r16 + 16 * hh) * 16) = phi; }
            else { *(u32x4*)(slot + CK_PB + (r16 + 16 * hh) * 16) = plo; *(u32x4*)(slot + CK_PK + (r16 + 16 * hh) * 16) = phi; }
            asm volatile("s_waitcnt lgkmcnt(0)" ::: "memory");
            if (lane < 16) { float mr[16]; int ln = lane; asm volatile("" : "+v"(ln));
#pragma unroll
                for (int t = 0; t < 16; ++t) { float acc = (ln == t) ? 1.f : 0.f;
#pragma unroll
                    for (int u = 0; u < t; ++u) acc += mr[u] * *(const LAS float*)(lds + PL_NAB + (u * 16 + t) * 4);
                    mr[t] = acc; *(LAS bf16*)(lds + PL_MTS + t * 48 + lane * 2) = f2bf(acc); } }
            asm volatile("s_waitcnt lgkmcnt(0)" ::: "memory");
            if (r < 16) *(u32x4*)(slot + CK_MT + (r + 16 * hh) * 16) = ld2x8(lds + PL_MTS + r * 48 + 8 * hh, lds + PL_MTS + r * 48 + 16 + 8 * hh);
        } else {
            const int e2 = tid - 256;
#pragma unroll
            for (int q4 = 0; q4 < PJ; ++q4) { const LAS unsigned char* lds = lds0 + q4 * PL_END; unsigned char* slot = ck_slot(a.ws, job0 + q4);
                { const int arr = e2 >> 7, i7 = e2 & 127, ks = i7 >> 5, t = i7 & 15, hh = (i7 >> 4) & 1;
                  const LAS unsigned char* p = lds + (arr ? PL_RT : PL_AT) + t * 144 + (16 * ks + 4 * hh) * 2;
                  *(u32x4*)(slot + (arr ? CK_RT : CK_AT) + (ks * 32 + t + 16 * hh) * 16) = ld2x8(p, p + 16); }
                { const int arr = e2 >> 7, J = (e2 >> 6) & 1;
                  const LAS unsigned char* p = lds + (arr ? PL_KH : PL_BH) + (4 * (lane >> 5) + ((lane >> 2) & 3)) * 144 + (32 * J + 16 * ((lane >> 4) & 1)) * 2 + 8 * (lane & 3);
                  const s16x4 lo = __builtin_amdgcn_ds_read_tr16_b64_v4i16((LAS s16x4*)p), hi = __builtin_amdgcn_ds_read_tr16_b64_v4i16((LAS s16x4*)(p + 8 * 144));
                  *(bf16x8*)(slot + (arr ? CK_KH : CK_BH) + (J * 64 + lane) * 16) = __builtin_shufflevector(lo, hi, 0, 1, 2, 3, 4, 5, 6, 7); }
                if (e2 < 160) *(u32x4*)(slot + CK_VT + e2 * 16) = *(const LAS u32x4*)(lds + PL_VT + e2 * 16); }
        }
    }
    __syncthreads();
}
constexpr int RC_NS = 8, RC_SLOT = 15360, RC_GG = 13312, RC_AHEAD = 6, RC_Y = RC_NS * RC_SLOT;
static_assert(RC_Y + 8192 <= RING_BYTES && CK_SLOT <= RC_GG, "rwkv ring");
template <int PM = 0> DI void rwkv_chunk_rec(const KArgs& a, LAS unsigned char* lds, int unit, int half, int wv) {
    const int tid = otid(wv), lane = tid & 63, w = __builtin_amdgcn_readfirstlane(tid >> 6), r = lane & 31, hh = lane >> 5;
    const int b = unit / 24, h = unit % 24;
    float* GST = (float*)(a.ws + A_GST) + (size_t)unit * 4096;
    const unsigned char* GGb = a.ws + A_GG; bf16* MIX = (bf16*)(a.ws + WS_H);
#define RC_DMA(srcp, dstp) __builtin_amdgcn_global_load_lds((const unsigned*)(srcp), (LAS unsigned*)(dstp), 16, 0, 0)
#define RC_ISSUE(cc) do { if ((PM & 1) == 0 && (w == 4 || w == 5)) { const unsigned char* src = ck_slot(a.ws, unit * CK_HALF + (cc)) + lane * 16; LAS unsigned char* dst = lds + ((cc) % RC_NS) * RC_SLOT; \
        if (w == 4) { _Pragma("unroll") for (int i_ = 0; i_ < 8; ++i_) RC_DMA(src + i_ * 1024, dst + i_ * 1024); } \
        else { _Pragma("unroll") for (int i_ = 8; i_ < 13; ++i_) RC_DMA(src + i_ * 1024, dst + i_ * 1024); \
            const unsigned char* gsrc = GGb + ((size_t)b * SEQ + (half * CK_HALF + (cc)) * 16 + (lane >> 3)) * (RWW * 2) + h * 128 + (lane & 7) * 16; \
            RC_DMA(gsrc, dst + RC_GG); RC_DMA(gsrc + 8 * RWW * 2, dst + RC_GG + 1024); } } } while (0)
#define RC_BAR() do { asm volatile("s_waitcnt lgkmcnt(0)" ::: "memory"); __builtin_amdgcn_s_barrier(); asm volatile("" ::: "memory"); } while (0)
    const bool epi = (w & 2) != 0; const int et = 4 * ((w & 1) + 2 * (w >> 2)) + (lane >> 4), eiq = lane & 15, ecol = h * 64 + 4 * eiq;
    const f32x4 elg = *(const f32x4*)(a.in[I_LNXG] + ecol), elb = *(const f32x4*)(a.in[I_LNXB] + ecol);
#define RC_EPI(sp, Yp, tokv) do { const f32x4 y = *(const LAS f32x4*)((Yp) + et * 64 + 4 * eiq); const u32x2 gq = *(const LAS u32x2*)((sp) + RC_GG + et * 128 + eiq * 8); \
        const float bsv = *(const LAS float*)((sp) + CK_BS + et * 4); const LAS unsigned char* vq = (sp) + CK_VT + 4 * eiq * CK_VTS + et * 2; \
        const f32x4 v4 = {bflo(*(const LAS unsigned short*)vq), bflo(*(const LAS unsigned short*)(vq + CK_VTS)), bflo(*(const LAS unsigned short*)(vq + 2 * CK_VTS)), bflo(*(const LAS unsigned short*)(vq + 3 * CK_VTS))}; \
        const float mean = red16((y.x + y.y) + (y.z + y.w)) * (1.f / 64.f); const f32x4 d = y - mean; \
        const float rstd = rsqrtf(red16((d.x * d.x + d.y * d.y) + (d.z * d.z + d.w * d.w)) * (1.f / 64.f) + 64e-5f); \
        const f32x4 gg4 = {bflo(gq.x), bfhi(gq.x), bflo(gq.y), bfhi(gq.y)}, o = (d * rstd * elg + elb + v4 * bsv) * gg4; \
        if (PM == 0 || o.x == 1.2345f) *(unsigned*)((unsigned char*)MIX + (size_t)(tokv) * 2048 + 512 + ecol) = pk4_fp8(o.x, o.y, o.z, o.w); } while (0)
    f32x16 G0, G1;
#pragma unroll
    for (int e = 0; e < 16; ++e) { G0[e] = 0.f; G1[e] = 0.f; }
    if (half == 1 && w < 2) {
#pragma unroll
        for (int e = 0; e < 16; ++e) { G0[e] = GST[(w * 2 + 0) * 1024 + e * 64 + lane]; G1[e] = GST[(w * 2 + 1) * 1024 + e * 64 + lane]; } }
    __syncthreads();
#pragma unroll
    for (int cc = 0; cc < RC_AHEAD; ++cc) RC_ISSUE(cc);
    asm volatile("s_waitcnt vmcnt(0)" ::: "memory");
    RC_BAR();
    for (int c = 0; c < CK_HALF; ++c) {
        if (c + RC_AHEAD < CK_HALF) RC_ISSUE(c + RC_AHEAD);
        const LAS unsigned char* sb = lds + (c % RC_NS) * RC_SLOT;
        if (w < 2) {
            const int r16 = r & 15, up = r >> 4;
            bf16x8 fAR[4], fBH0, fBH1, fKH0, fKH1, fM, fNP, fPB; f32x4 gs0[4], gs1[4];
            __builtin_amdgcn_sched_barrier(0);
#pragma unroll
            for (int ks = 0; ks < 4; ++ks) fAR[ks] = ldfrag(sb + (up ? CK_RT : CK_AT) + (ks * 32 + r16 + 16 * hh) * 16);
            fNP = ldfrag(sb + (up ? CK_PK : CK_NK) + (r16 + 16 * hh) * 16);
            const LAS unsigned char* vp_ = sb + CK_VT + (32 * w + r) * CK_VTS + 8 * hh; const s16x4 vlo = *(const LAS s16x4*)vp_, vhi = *(const LAS s16x4*)(vp_ + 16);
            const bf16x8 vtf = __builtin_shufflevector(vlo, vhi, 0, 1, 2, 3, 4, 5, 6, 7);
            fM = ldfrag(sb + CK_MT + (r16 + 16 * hh) * 16); fPB = ldfrag(sb + CK_PB + (r16 + 16 * hh) * 16);
            bf16x8 gf[4];
#pragma unroll
            for (int s2 = 0; s2 < 2; ++s2) { u32x4 p0 = {pk2(G0[8 * s2], G0[8 * s2 + 1]), pk2(G0[8 * s2 + 2], G0[8 * s2 + 3]), pk2(G0[8 * s2 + 4], G0[8 * s2 + 5]), pk2(G0[8 * s2 + 6], G0[8 * s2 + 7])};
                u32x4 p1 = {pk2(G1[8 * s2], G1[8 * s2 + 1]), pk2(G1[8 * s2 + 2], G1[8 * s2 + 3]), pk2(G1[8 * s2 + 4], G1[8 * s2 + 5]), pk2(G1[8 * s2 + 6], G1[8 * s2 + 7])};
                gf[s2] = __builtin_bit_cast(bf16x8, p0); gf[2 + s2] = __builtin_bit_cast(bf16x8, p1); }
            fBH0 = ldfrag(sb + CK_BH + lane * 16); fBH1 = ldfrag(sb + CK_BH + (64 + lane) * 16); fKH0 = ldfrag(sb + CK_KH + lane * 16); fKH1 = ldfrag(sb + CK_KH + (64 + lane) * 16);
#pragma unroll
            for (int g4 = 0; g4 < 4; ++g4) { gs0[g4] = *(const LAS f32x4*)(sb + CK_G15 + (8 * g4 + 4 * hh) * 4); gs1[g4] = *(const LAS f32x4*)(sb + CK_G15 + (32 + 8 * g4 + 4 * hh) * 4); }
            f32x16 XY;
#pragma unroll
            for (int e = 0; e < 16; ++e) XY[e] = 0.f;
#pragma unroll
            for (int ks = 0; ks < 4; ++ks) XY = MFMA32(fAR[ks], gf[ks], XY);
            __builtin_amdgcn_sched_group_barrier(0x100, 9, 0); __builtin_amdgcn_sched_group_barrier(0x002, 16, 0); __builtin_amdgcn_sched_group_barrier(0x008, 1, 0);
            __builtin_amdgcn_sched_group_barrier(0x100, 12, 0); __builtin_amdgcn_sched_group_barrier(0x008, 3, 0);
            __builtin_amdgcn_sched_barrier(0);
            XY = MFMA32(fNP, vtf, XY);
            { u32x4 px = {pk2(XY[0], XY[1]), pk2(XY[2], XY[3]), pk2(XY[4], XY[5]), pk2(XY[6], XY[7])}; const bf16x8 xf = __builtin_bit_cast(bf16x8, px);
              f32x16 U; for (int e = 0; e < 16; ++e) U[e] = 0.f;
              U = MFMA32(fM, xf, U);
              u32x4 pu = {pk2(U[0], U[1]), pk2(U[2], U[3]), pk2(U[4], U[5]), pk2(U[6], U[7])}; const bf16x8 uf = __builtin_bit_cast(bf16x8, pu);
              XY = MFMA32(fPB, uf, XY);
#pragma unroll
              for (int e = 0; e < 16; ++e) { G0[e] *= gs0[e >> 2][e & 3]; G1[e] *= gs1[e >> 2][e & 3]; }
              G0 = MFMA32(fBH0, uf, G0); G1 = MFMA32(fBH1, uf, G1); G0 = MFMA32(fKH0, vtf, G0); G1 = MFMA32(fKH1, vtf, G1); }
            LAS float* Y = (LAS float*)(lds + RC_Y + (c & 1) * 4096);
#pragma unroll
            for (int e = 0; e < 8; ++e) Y[((e & 3) + 8 * (e >> 2) + 4 * hh) * 64 + 32 * w + r] = XY[8 + e];
        } else if (epi) {
            if (c > 0) RC_EPI(lds + ((c - 1) % RC_NS) * RC_SLOT, (const LAS float*)(lds + RC_Y + ((c - 1) & 1) * 4096), (size_t)b * SEQ + (half * CK_HALF + c - 1) * 16 + et);
        } else {
            if (c + RC_AHEAD >= CK_HALF) asm volatile("s_waitcnt vmcnt(0)" ::: "memory"); else if (w == 4) asm volatile("s_waitcnt vmcnt(40)" ::: "memory"); else asm volatile("s_waitcnt vmcnt(35)" ::: "memory");
        }
        RC_BAR();
    }
    if (epi) RC_EPI(lds + ((CK_HALF - 1) % RC_NS) * RC_SLOT, (const LAS float*)(lds + RC_Y + ((CK_HALF - 1) & 1) * 4096), (size_t)b * SEQ + (half * CK_HALF + CK_HALF - 1) * 16 + et);
    else if (w < 2 && half == 0 && (PM == 0 || G0[0] == 1.2345f)) {
#pragma unroll
        for (int e = 0; e < 16; ++e) { GST[(w * 2 + 0) * 1024 + e * 64 + lane] = G0[e]; GST[(w * 2 + 1) * 1024 + e * 64 + lane] = G1[e]; } }
    asm volatile("s_waitcnt vmcnt(0)" ::: "memory");
    __syncthreads();
#undef RC_EPI
#undef RC_DMA
#undef RC_ISSUE
#undef RC_BAR
}

constexpr int N_PHASES = 25;
__global__ void __launch_bounds__(512, 2) fwd(KArgs a) {
    extern __shared__ __attribute__((aligned(16))) unsigned char lds_[];
    LAS unsigned char* lds = (LAS unsigned char*)lds_;
    const int wv = __builtin_amdgcn_readfirstlane((int)threadIdx.x >> 6), G = gridDim.x, bid = blockIdx.x;
    volatile LAS unsigned* MISC = (volatile LAS unsigned*)(lds + LDS_MISC);
    if (wv == 0) MISC[lane_id()] = 0u;
    __syncthreads();
    unsigned char* ws0 = a.ws;
#if N_LAUNCH_MODE == 0
    XcdBarrier bar = xcd_barrier_post((unsigned*)(ws0 + CTL_BAR), MISC + 8, wv);
#ifdef DBG_TIME_K1
#define SEAM(k) do { if (IN(k) && IN((k) + 1)) xcd_barrier(bar); if (bid == 0 && wv == 0 && lane_id() == 0) ((unsigned long long*)(ws0 + CTL_CHK))[1 + (k)] = __builtin_amdgcn_s_memrealtime(); } while (0)
#else
#define SEAM(k) do { if (IN(k) && IN((k) + 1)) xcd_barrier(bar); } while (0)
#endif
#else
#define SEAM(k) do { } while (0)
#endif
    const int lo = a.ph_lo, hi = a.ph_hi;
#ifdef DBG_TIME_K1
    if (bid == 0 && wv == 0 && lane_id() == 0) ((unsigned long long*)(ws0 + CTL_CHK))[0] = __builtin_amdgcn_s_memrealtime();
#endif
#ifndef PH_MASK
#define PH_MASK 0xFFFFFFFFu
#endif
#define IN(k) (((PH_MASK >> (k)) & 1u) && lo <= (k) && (k) < hi)
#ifndef REP_REC
#define REP_REC 0
#endif
#ifndef REP_DIL
#define REP_DIL 0
#endif
#ifndef REPEAT_MASK
#define REPEAT_MASK 0u
#endif
#define PH(k) for (int rp_ = 0; rp_ < (IN(k) ? 1 + (int)((REPEAT_MASK >> (k)) & 1u) : 0); ++rp_)
#define MOD ((float*)(ws + CTL_MOD))
#define Hb ((bf16*)(ws + WS_H))
#define X1 ((bf16*)(ws + WS_X1))
#define XPRE ((bf16*)(ws + A_XPRE))
    pg8::StaticOrder SO;

    PH(0) { unsigned char* ws = wsl(a.ws); p0_prologue(a, lds, wv); } SEAM(0);
    PH(1) { unsigned char* ws = wsl(a.ws); modulate_rows(a.in[I_X], (const unsigned long long*)(ws + CTL_MODI), MOD, Hb, wv); } SEAM(1);
    PH(2) { unsigned char* ws = wsl(a.ws); pg8::Gemm g{Hb, (const bf16*)(ws + WS_W_IN0), 2048, 2048, 2048}; SO.init(T, 2048, G, bid);
        EpiIn0 E{(bf16*)(ws + A_QC), (bf16*)(ws + A_KVC), (bf16*)(ws + A_KR), (bf16*)(ws + A_XH), (float*)(ws + CTL_SSQ)};
        pg8::gemm_phase<EpiIn0, pg8::StaticOrder, false, true>(lds, g, SO, E, wv); } SEAM(2);
    PH(3) { unsigned char* ws = wsl(a.ws);
        krope_pass((const bf16*)(ws + A_KR), (const float*)(ws + WS_ROPE), (bf16*)(ws + A_KF), wv);
        { pg8::Gemm g{(const bf16*)(ws + A_QC), (const bf16*)(ws + WS_W_UQ), 512, 512, 512}; SO.init(T, 1536, G, bid);
          EpiQ E{(bf16*)(ws + A_Q), (const float*)(ws + CTL_SSQ), (const float*)(ws + WS_ROPE)}; pg8::gemm_phase<EpiQ, pg8::StaticOrder, false>(lds, g, SO, E, wv); }
        { pg8::Gemm g{(const bf16*)(ws + A_KVC), (const bf16*)(ws + WS_W_UKV), 256, 256, 256}; SO.init(T, 2048, G, bid);
          EpiKV E{(bf16*)(ws + A_KF), (bf16*)(ws + A_V), (const float*)(ws + CTL_SSQ)}; pg8::gemm_phase<EpiKV, pg8::StaticOrder, false>(lds, g, SO, E, wv); }
        { pg8::Gemm g{(const bf16*)(ws + A_XH), (const bf16*)(ws + WS_S5BE), 384, 256, 256}; S5Order S{G, bid}; EpiS5E E{(float*)(ws + A_ES)}; pg8::gemm_phase<EpiS5E, S5Order, false>(lds, g, S, E, wv); }
    } SEAM(3);
    PH(4) { unsigned char* ws = wsl(a.ws);
        s5_carry((const float*)(ws + A_ES), (const float*)(ws + WS_S5L), (bf16*)(ws + A_XH), lds, wv);
        for (int u = bid; u < 256; u += G) mla_attn_unit(lds, (const bf16*)(ws + A_Q), (const bf16*)(ws + A_KF), (const bf16*)(ws + A_V), Hb, u, wv);
    } SEAM(4);
    PH(5) { unsigned char* ws = wsl(a.ws); pg8::Gemm g{(const bf16*)(ws + A_XH), (const bf16*)(ws + WS_S5BY), 384, 384, 384}; S5Order S{G, bid};
        EpiS5Y E{(bf16*)(ws + A_YS5), (const bf16*)(ws + A_XH), a.in[I_S5D]}; pg8::gemm_phase<EpiS5Y, S5Order, false>(lds, g, S, E, wv); } SEAM(5);
    PH(6) { unsigned char* ws = wsl(a.ws); pg8::Gemm g{(const bf16*)(ws + A_YS5), (const bf16*)(ws + WS_W_GLU), 1024, 1024, 1024}; SO.init(T, 1024, G, bid);
        EpiGlu E{Hb, (const bf16*)(ws + A_YS5)}; pg8::gemm_phase<EpiGlu, pg8::StaticOrder, false>(lds, g, SO, E, wv); } SEAM(6);
    PH(7) { unsigned char* ws = wsl(a.ws); pg8::Gemm g{Hb, (const bf16*)(ws + WS_W_OUT0), 2048, 2048, 2048}; SO.init(T, 2048, G, bid);
        EpiRes<false> E{XPRE, a.in[I_X], MOD + 2 * 2048}; pg8::gemm_phase<EpiRes<false>, pg8::StaticOrder, false, true>(lds, g, SO, E, wv); } SEAM(7);
#define MOE_PHASES(layer, pb) \
        PH(pb) { unsigned char* ws = wsl(a.ws); ln_router_phase(a, lds, layer, XPRE, X1, Hb, wv); } SEAM(pb); \
        PH(pb + 1) { unsigned char* ws = wsl(a.ws); moe_table(a, lds, layer, wv); pg8::Gemm g{Hb, (const bf16*)(ws + WS_W_GU8), 2048, 2048, 2048}; \
            MoeOrder<4> S{G, bid, layer, (const LAS int*)(lds + LDS_TAB), (const int*)(ws + A_TOKL)}; EpiGateUp E{ws + A_ACT}; pg8::gemm_phase<EpiGateUp, MoeOrder<4>, true, true>(lds, g, S, E, wv); } SEAM(pb + 1); \
        PH(pb + 2) { unsigned char* ws = wsl(a.ws); moe_table(a, lds, layer, wv); pg8::Gemm g{(const bf16*)(ws + A_ACT), (const bf16*)(ws + WS_W_DN), 512, 512, 512}; \
            MoeOrder<8> S{G, bid, layer, (const LAS int*)(lds + LDS_TAB), (const int*)(ws + A_TOKL)}; EpiDown E{(bf16*)(ws + A_YS)}; pg8::gemm_phase<EpiDown, MoeOrder<8>, false, true>(lds, g, S, E, wv); } SEAM(pb + 2); \
        PH(pb + 3) { unsigned char* ws = wsl(a.ws); ln_ffn_phase(a, layer, X1, a.out, layer == 0 ? Hb : nullptr, wv); } SEAM(pb + 3);
    MOE_PHASES(0, 8)
    PH(12) { unsigned char* ws = wsl(a.ws); pg8::Gemm g{Hb, (const bf16*)(ws + WS_W_IN1), 2048, 2048, 2048}; SO.init(T, 9728, G, bid);
        EpiIn1 E{(bf16*)(ws + A_ZD), (bf16*)(ws + A_ZR)}; pg8::gemm_phase<EpiIn1, pg8::StaticOrder, false, true>(lds, g, SO, E, wv); } SEAM(12);
    PH(13) { unsigned char* ws = wsl(a.ws); rwkv_prep((const bf16*)(ws + A_ZR), a.in[I_MU], (bf16*)(ws + A_LIN), wv); } SEAM(13);
    PH(14) { unsigned char* ws = wsl(a.ws);
        pg8::Gemm g{(const bf16*)(ws + A_LIN), (const bf16*)(ws + WS_W_LORA), 384, 384, 256}; LoraOrder LO; LO.init(T, 4608, G, bid);
        EpiLora E{(bf16*)(ws + A_WDEC), (bf16*)(ws + A_AA), (bf16*)(ws + A_GG), a.in[I_W0], a.in[I_A0]}; pg8::gemm_phase<EpiLora, LoraOrder, false>(lds, g, LO, E, wv);
} SEAM(14);
    PH(15) { rwkv_chunk_prep(a, lds, 0, wv); } SEAM(15);
    PH(16) { unsigned char* ws = wsl(a.ws); if (bid < 96 || G <= 96) { for (int u = bid; u < 96; u += G) { rwkv_chunk_rec(a, lds, u, 0, wv); if (REP_REC) rwkv_chunk_rec<REP_REC>(a, lds, u, 0, wv); } }
        if (G <= 96 || bid >= 96) { const int nb_ = G <= 96 ? G : G - 96, b0_ = G <= 96 ? bid : bid - 96;
            DilPre P; if (b0_ < 768) dil_issue((const bf16*)(ws + A_ZD), (const float*)(ws + WS_BIAS), b0_, wv, P);
            for (int u = b0_; u < 768; u += nb_) dil_attn_unit(lds, (const bf16*)(ws + A_ZD), (const float*)(ws + WS_BIAS), (bf16*)(ws + A_DPO), (float*)(ws + A_DPM), (float*)(ws + A_DPL), u, u + nb_ < 768 ? u + nb_ : -1, P, wv); } } SEAM(16);
    PH(17) { rwkv_chunk_prep(a, lds, 1, wv); } SEAM(17);
    PH(18) { unsigned char* ws = wsl(a.ws); if (bid < 96 || G <= 96) { for (int u = bid; u < 96; u += G) { rwkv_chunk_rec(a, lds, u, 1, wv); if (REP_REC) rwkv_chunk_rec<REP_REC>(a, lds, u, 1, wv); } }
        if (G <= 96 || bid >= 96) { const int nb_ = G <= 96 ? G : G - 96, b0_ = G <= 96 ? bid : bid - 96;
            DilPre P; if (768 + b0_ < 1536) dil_issue((const bf16*)(ws + A_ZD), (const float*)(ws + WS_BIAS), 768 + b0_, wv, P);
            for (int u = 768 + b0_; u < 1536; u += nb_) dil_attn_unit(lds, (const bf16*)(ws + A_ZD), (const float*)(ws + WS_BIAS), (bf16*)(ws + A_DPO), (float*)(ws + A_DPM), (float*)(ws + A_DPL), u, u + nb_ < 1536 ? u + nb_ : -1, P, wv); } } SEAM(18);
    PH(19) { unsigned char* ws = wsl(a.ws); dil_merge((const bf16*)(ws + A_DPO), (const float*)(ws + A_DPM), (const float*)(ws + A_DPL), Hb, wv); } SEAM(19);
    PH(20) { unsigned char* ws = wsl(a.ws); pg8::Gemm g{Hb, (const bf16*)(ws + WS_W_OUT1), 2048, 2048, 2048}; SO.init(T, 2048, G, bid);
        EpiRes<true> E{XPRE, a.out, MOD + 4 * 12288 + 2 * 2048}; pg8::gemm_phase<EpiRes<true>, pg8::StaticOrder, false, true>(lds, g, SO, E, wv); } SEAM(20);
    MOE_PHASES(1, 21)
#undef MOE_PHASES
#ifdef DBG_TIME_K1
    {
        xcd_barrier(bar);
        const unsigned long long* ts = (const unsigned long long*)(ws0 + CTL_CHK);
        const unsigned long long t0 = ts[0], te = __builtin_amdgcn_s_memrealtime();
        const float tot = (float)(te - t0), f1 = (float)(ts[1 + DBG_TIME_K1] - t0) / tot, f2 = (float)(ts[1 + DBG_TIME_K2] - t0) / tot;
        const float c1 = sqrtf(100.f * f1);
        for (size_t i = (size_t)bid * 512 + wv * 64 + lane_id(); i < (size_t)T * D; i += (size_t)G * 512) a.out[i] = c1;
        xcd_barrier(bar);
        if (bid == 0 && wv == 0 && lane_id() == 0) a.out[0] = 100.f * f2;
    }
#endif
#undef IN
#undef SEAM
#undef MOD
#undef Hb
#undef X1
#undef XPRE
}


#ifdef DBG_DUMP_OFF
__global__ void dbg_dump(const unsigned char* ws, float* out) {
    const size_t n = (size_t)T * D;
    for (size_t i = (size_t)blockIdx.x * 256 + threadIdx.x; i < n; i += (size_t)gridDim.x * 256) {
#if defined(DBG_DUMP_RT)
        { const int m = (int)(i >> 11), c = (int)(i & 2047); const int* RTE = (const int*)(ws + A_RT); const float* RTW = (const float*)(RTE + 4 * T); out[i] = c < 2 ? (float)RTE[2 * m + c] : (c < 4 ? RTW[2 * m + c - 2] : 0.f); }
#elif DBG_DUMP_F32
        out[i] = ((const float*)(ws + DBG_DUMP_OFF))[i];
#else
        out[i] = bf2f(((const bf16*)(ws + DBG_DUMP_OFF))[i]);
#endif
    }
}
#endif
extern "C" void kernel_launch(void* const* d_in, const int* in_sizes, int n_in, void* d_out, int out_size, void* d_ws, size_t ws_size, hipStream_t stream) {
    static int grid = 0;
    if (grid == 0) {
        if (n_in != 41 || out_size != T * D || ws_size < WS_END) { fprintf(stderr, "kernel_launch: unexpected shapes: n_in %d out %d ws %zu (need %zu)\n", n_in, out_size, ws_size, (size_t)WS_END); grid = -1; return; }
        int dev = 0, cus = 0, per_cu = 0;
        if (hipGetDevice(&dev) != hipSuccess || hipDeviceGetAttribute(&cus, hipDeviceAttributeMultiprocessorCount, dev) != hipSuccess) { grid = -1; return; }
        if (hipFuncSetAttribute((const void*)fwd, hipFuncAttributeMaxDynamicSharedMemorySize, LDS_BYTES) != hipSuccess) { fprintf(stderr, "kernel_launch: hipFuncSetAttribute failed\n"); grid = -1; return; }
        if (hipOccupancyMaxActiveBlocksPerMultiprocessor(&per_cu, (const void*)fwd, 512, LDS_BYTES) != hipSuccess || per_cu < 1) fprintf(stderr, "kernel_launch: occupancy query says %d blocks/CU\n", per_cu);
        (void)hipGetLastError();
        grid = cus;
    }
    if (grid < 0) return;
    (void)hipMemsetAsync(d_ws, 0, CTL_ZERO_BYTES, stream);
#ifdef DBG_ZERO_WS
    (void)hipMemsetAsync((char*)d_ws + CTL_ZERO_BYTES, 0, WS_END - CTL_ZERO_BYTES, stream);
#endif
    KArgs a{};
    for (int i = 0; i < 41; ++i) a.in[i] = (const float*)d_in[i];
    a.out = (float*)d_out; a.ws = (unsigned char*)d_ws;
#if N_LAUNCH_MODE == 0
    a.ph_lo = 0; a.ph_hi = N_PHASES;
    hipLaunchKernelGGL(fwd, dim3(grid), dim3(512), LDS_BYTES, stream, a);
#else
#ifdef DBG_DUMP_AFTER
    for (int p = 0; p <= DBG_DUMP_AFTER; ++p) { a.ph_lo = p; a.ph_hi = p + 1; hipLaunchKernelGGL(fwd, dim3(grid), dim3(512), LDS_BYTES, stream, a); }
#ifdef DBG_DUMP_OFF
    hipLaunchKernelGGL(dbg_dump, dim3(2048), dim3(256), 0, stream, (const unsigned char*)d_ws, (float*)d_out);
#endif
#else
    for (int p = 0; p < N_PHASES; ++p) { a.ph_lo = p; a.ph_hi = p + 1; hipLaunchKernelGGL(fwd, dim3(grid), dim3(512), LDS_BYTES, stream, a); }
#endif
#endif
}
```

```cpp
#include <hip/hip_runtime.h>
#include <cstdio>
#include <cstdint>

#ifndef N_LAUNCH_MODE
#define N_LAUNCH_MODE 0
#endif
#ifndef CHK
#define CHK 0
#endif

#define GAS __attribute__((address_space(1)))
#define LAS __attribute__((address_space(3)))
typedef unsigned short bf16;
typedef short bf16x8 __attribute__((ext_vector_type(8)));
typedef short s16x4 __attribute__((ext_vector_type(4)));
typedef float f32x4 __attribute__((ext_vector_type(4)));
typedef float f32x16 __attribute__((ext_vector_type(16)));
typedef float f32x2 __attribute__((ext_vector_type(2)));
typedef unsigned u32x4 __attribute__((ext_vector_type(4)));
typedef unsigned u32x2 __attribute__((ext_vector_type(2)));
#define DI __device__ __forceinline__

constexpr int D = 2048, NB = 4, SEQ = 4096, T = NB * SEQ;
constexpr float LN_EPS = 1e-5f, RMS_EPS = 1e-6f;
constexpr float DN_ALPHA = 1.41421356237f;
constexpr int EVEN_IN = 1856, ODD_IN = 9568, DIL_IN = 4608, RW_IN = 4960, RWW = 1536;
constexpr int NEXP = 16, DEXP = 512;

typedef __bf16 bf16x2_t __attribute__((ext_vector_type(2)));
DI unsigned pk2(float lo, float hi) { f32x2 v = {lo, hi}; bf16x2_t r = __builtin_convertvector(v, bf16x2_t); return __builtin_bit_cast(unsigned, r); }
DI float bf2f(bf16 b) { return __uint_as_float(((unsigned)b) << 16); }
DI float bflo(unsigned u) { return __uint_as_float(u << 16); }
DI float bfhi(unsigned u) { return __uint_as_float(u & 0xffff0000u); }
DI bf16 f2bf(float f) { unsigned u = __float_as_uint(f); u += 0x7fffu + ((u >> 16) & 1u); return (bf16)(u >> 16); }
DI float wave_sum(float v) {
#pragma unroll
    for (int o = 1; o < 64; o <<= 1) v += __shfl_xor(v, o);
    return v;
}
DI unsigned char* wsl(unsigned char* p) { asm volatile("" : "+s"(p)); return p; }
DI int lane_id() { return (int)__builtin_amdgcn_mbcnt_hi(~0u, __builtin_amdgcn_mbcnt_lo(~0u, 0u)); }
DI int otid(int wv) { int t = wv * 64 + lane_id(); asm volatile("" : "+v"(t)); return t; }
DI float dpp_xor1(float x) { return __builtin_bit_cast(float, __builtin_amdgcn_mov_dpp(__builtin_bit_cast(int, x), 0xB1, 0xF, 0xF, true)); }
DI float dpp_xor2(float x) { return __builtin_bit_cast(float, __builtin_amdgcn_mov_dpp(__builtin_bit_cast(int, x), 0x4E, 0xF, 0xF, true)); }
DI float dpp_hmir(float x) { return __builtin_bit_cast(float, __builtin_amdgcn_mov_dpp(__builtin_bit_cast(int, x), 0x141, 0xF, 0xF, true)); }
template <int N> DI float dpp_ror(float x) { return __builtin_bit_cast(float, __builtin_amdgcn_mov_dpp(__builtin_bit_cast(int, x), 0x120 + N, 0xF, 0xF, true)); }
DI float dpp_rmir(float x) { return __builtin_bit_cast(float, __builtin_amdgcn_mov_dpp(__builtin_bit_cast(int, x), 0x140, 0xF, 0xF, true)); }
DI float red8(float x) { x += dpp_xor1(x); x += dpp_xor2(x); x += dpp_hmir(x); return x; }
DI float red16(float x) { x += dpp_xor1(x); x += dpp_xor2(x); x += dpp_hmir(x); x += dpp_rmir(x); return x; }
DI float sat448(float x) { return __builtin_amdgcn_fmed3f(x, -448.f, 448.f); }
DI unsigned pk4_fp8(float a, float b, float c, float d) { int w = 0; w = __builtin_amdgcn_cvt_pk_fp8_f32(sat448(a), sat448(b), w, false); w = __builtin_amdgcn_cvt_pk_fp8_f32(sat448(c), sat448(d), w, true); return (unsigned)w; }
constexpr float F8_WSCALE = 32.f;
DI float sigmoidf_(float x) { return 1.f / (1.f + __expf(-x)); }

namespace pg8 {
constexpr int BM = 256, BK = 64, HALF = 128, HTB = HALF * BK * 2, STAGE_BYTES = 8 * HTB, NXCD = 8, WGM = 8;
__host__ __device__ __forceinline__ int lds_byte(int r, int c) { const int st = (r >> 4) * 2 + (c >> 5), rr = r & 15, cc = c & 31, ob = rr * 64 + cc * 2; return st * 1024 + (ob ^ (((ob >> 9) & 1) << 5)); }
__host__ __device__ __forceinline__ void stage_rc(int b, int& R, int& C) { const int st = b / 1024, sb = b % 1024, swz = sb ^ (((sb >> 9) & 1) << 5); R = (st >> 1) * 16 + swz / 64; C = (st & 1) * 32 + (swz % 64) / 2; }
__host__ __device__ __forceinline__ int perm32(int rho) { const int n = rho >> 4, i = rho & 15; return 8 * (i >> 2) + 4 * n + (i & 3); }

struct Unit { int pm, pn, aux; };
struct Gemm { const bf16* A; const bf16* Bt; int lda, ldb, K; };

struct StaticOrder {
    int nM, nN, nwg, G, c;
    __host__ __device__ void init(int M, int N, int G_, int c_) { nM = M / BM; nN = N / BM; nwg = nM * nN; G = G_; c = c_; }
    __host__ __device__ bool next(int i, Unit& u) const {
        const long L = (long)i * G + c; if (L >= nwg) return false;
        int wgid = (int)L; { const int q = nwg / NXCD, r = nwg % NXCD, xcd = wgid % NXCD, off = wgid / NXCD; wgid = (xcd < r ? xcd * (q + 1) : r * (q + 1) + (xcd - r) * q) + off; }
        const int nig = WGM * nN, gid = wgid / nig, fm = gid * WGM, gsz = (nM - fm) < WGM ? (nM - fm) : WGM;
        u.pm = fm + ((wgid % nig) % gsz); u.pn = (wgid % nig) / gsz; u.aux = 0; return true;
    }
    __device__ __forceinline__ int arow(const Unit&, int) const { return 0; }
    __device__ __forceinline__ int koff(const Unit&) const { return 0; }
};

typedef int v8i __attribute__((ext_vector_type(8)));
template <class Epi, class Sched, bool GATHER, bool F8 = false>
__device__ __forceinline__ void gemm_phase(LAS unsigned char* lds, const Gemm g, const Sched& S, const Epi& E, int wv) {
    const int tid = otid(wv), wid = __builtin_amdgcn_readfirstlane(tid >> 6), lane = tid & 63, wr = wid >> 2, wc = wid & 3, fr = lane & 15, fq = lane >> 4;
    int K = g.K; asm volatile("" : "+s"(K));
    constexpr int ES = F8 ? 1 : 2;
    const int nt = K / (F8 ? 2 * BK : BK);
    unsigned voffB[2], vA0[2], vA1[2], nA0[2], nA1[2]; int Rr[2], Cc[2];
#pragma unroll
    for (int i = 0; i < 2; ++i) { int R, C; stage_rc(tid * 16 + i * 8192, R, C); const int Rb = Epi::PERM ? ((R & ~31) + perm32(R & 31)) : R;
        Rr[i] = R; Cc[i] = C; voffB[i] = (unsigned)(Rb * g.ldb * ES + C * 2);
        vA0[i] = (unsigned)(R * g.lda * ES + C * 2); vA1[i] = (unsigned)((R + HALF) * g.lda * ES + C * 2); nA0[i] = vA0[i]; nA1[i] = vA1[i]; }
    const size_t kstep = (size_t)(BK * 2);
    const size_t hstepB = (size_t)HALF * g.ldb * ES, tstepB = 2 * hstepB, tstepA = (size_t)BM * g.lda * ES, hstepA = (size_t)HALF * g.lda * ES, rbA = (size_t)g.lda * ES, rbB = (size_t)g.ldb * ES;
    const unsigned ldsw = (unsigned)wid * 1024u;
    const int aoff = lds_byte(wr * 64 + fr, F8 ? fq * 16 : fq * 8), boff = lds_byte(wc * 32 + fr, F8 ? fq * 16 : fq * 8);
#define PG8_SA(b, h) (((b) * 2 + (h)) * HTB)
#define PG8_SB(b, h) ((4 + (b) * 2 + (h)) * HTB)
#define PG8_STAGE(bufoff, gbase, voff) do { _Pragma("unroll") for (int _i = 0; _i < 2; ++_i) \
        __builtin_amdgcn_global_load_lds((const unsigned*)((const char*)(gbase) + (voff)[_i]), (LAS unsigned*)(lds + (bufoff) + ldsw + _i * 8192), 16, 0, 0); } while (0)
#define PG8_STAGE1(bufoff, gbase, voff0, rowbytes) do { __builtin_amdgcn_global_load_lds((const unsigned*)((const char*)(gbase) + (voff0)), (LAS unsigned*)(lds + (bufoff) + ldsw), 16, 0, 0); \
        __builtin_amdgcn_global_load_lds((const unsigned*)((const char*)(gbase) + (size_t)64 * (rowbytes) + (voff0)), (LAS unsigned*)(lds + (bufoff) + ldsw + 8192), 16, 0, 0); } while (0)
#define PG8_STAGEA(bufoff, gbase, half, arr) do { if constexpr (GATHER) PG8_STAGE(bufoff, gbase, arr); else PG8_STAGE1(bufoff, (const char*)(gbase) + (half) * hstepA, vA0[0], rbA); } while (0)
#define PG8_LD32(p) __builtin_bit_cast(v8i, __builtin_shufflevector(*(const LAS u32x4*)(p), *(const LAS u32x4*)((p) + 16), 0, 1, 2, 3, 4, 5, 6, 7))
#define PG8_LDA(dst, b, h) do { if constexpr (F8) { _Pragma("unroll") for (int m = 0; m < 4; ++m) dst##8[m] = PG8_LD32(lds + PG8_SA(b, h) + aoff + m * 2048); } \
        else { _Pragma("unroll") for (int m = 0; m < 4; ++m) _Pragma("unroll") for (int k = 0; k < 2; ++k) dst[m][k] = *(const LAS bf16x8*)(lds + PG8_SA(b, h) + aoff + m * 2048 + k * 1024); } } while (0)
#define PG8_LDB(dst, b, h) do { if constexpr (F8) { _Pragma("unroll") for (int n = 0; n < 2; ++n) dst##8[n] = PG8_LD32(lds + PG8_SB(b, h) + boff + n * 2048); } \
        else { _Pragma("unroll") for (int n = 0; n < 2; ++n) _Pragma("unroll") for (int k = 0; k < 2; ++k) dst[n][k] = *(const LAS bf16x8*)(lds + PG8_SB(b, h) + boff + n * 2048 + k * 1024); } } while (0)
#define PG8_MMA(ai, bj, At, Bt) do { __builtin_amdgcn_s_setprio(1); if constexpr (F8) { _Pragma("unroll") for (int m = 0; m < 4; ++m) _Pragma("unroll") for (int n = 0; n < 2; ++n) \
            asm volatile("v_mfma_scale_f32_16x16x128_f8f6f4 %0, %1, %2, %0, %3, %4 op_sel_hi:[0,0,0]" : "+v"(acc[ai][bj][m][n]) : "v"(Bt##8[n]), "v"(At##8[m]), "v"(sc_w), "v"(sc_x)); }     \
        else { _Pragma("unroll") for (int m = 0; m < 4; ++m) _Pragma("unroll") for (int n = 0; n < 2; ++n) _Pragma("unroll") for (int k = 0; k < 2; ++k) \
            acc[ai][bj][m][n] = __builtin_amdgcn_mfma_f32_16x16x32_bf16(Bt[n][k], At[m][k], acc[ai][bj][m][n], 0, 0, 0); } __builtin_amdgcn_s_setprio(0); } while (0)
#define PG8_WAIT_V(n) asm volatile("s_waitcnt vmcnt(" #n ")" ::: "memory")
#define PG8_WAIT_L(n) asm volatile("s_waitcnt lgkmcnt(" #n ")" ::: "memory")
#define PG8_BAR __builtin_amdgcn_s_barrier()
#define PG8_SCHED __builtin_amdgcn_sched_barrier(0)
    Unit cur, nxt; int ui = 0;
    if (!S.next(0, cur)) return;
    f32x4 acc[2][2][4][2];
#pragma unroll
    for (int a = 0; a < 2; ++a)
#pragma unroll
        for (int b = 0; b < 2; ++b)
#pragma unroll
            for (int m = 0; m < 4; ++m)
#pragma unroll
                for (int n = 0; n < 2; ++n) acc[a][b][m][n] = (f32x4){0.f, 0.f, 0.f, 0.f};
    int sc_w = 122, sc_x = 127; if constexpr (F8) asm volatile("" : "+v"(sc_w), "+v"(sc_x));
    bf16x8 At[4][2], B0[2][2], B1[2][2]; v8i At8[4], B08[2], B18[2];
    const char* cA = (GATHER ? (const char*)g.A : (const char*)g.A + (size_t)cur.pm * tstepA) + ES * S.koff(cur);
    const char* cB = (const char*)g.Bt + (size_t)cur.pn * tstepB + ES * S.koff(cur);
    if (GATHER) {
#pragma unroll
        for (int i = 0; i < 2; ++i) { vA0[i] = (unsigned)(S.arow(cur, Rr[i]) * g.lda * ES + Cc[i] * 2); vA1[i] = (unsigned)(S.arow(cur, Rr[i] + HALF) * g.lda * ES + Cc[i] * 2); nA0[i] = vA0[i]; nA1[i] = vA1[i]; } }
    PG8_STAGE1(PG8_SB(0, 0), cB, voffB[0], rbB); PG8_STAGEA(PG8_SA(0, 0), cA, 0, vA0); PG8_STAGE1(PG8_SB(0, 1), cB + hstepB, voffB[0], rbB); PG8_STAGEA(PG8_SA(0, 1), cA, 1, vA1);
    if (wr == 1) PG8_BAR;
    PG8_WAIT_V(4); PG8_BAR;
    PG8_STAGE1(PG8_SB(1, 0), cB + kstep, voffB[0], rbB); PG8_STAGEA(PG8_SA(1, 0), cA + kstep, 0, vA0); PG8_STAGE1(PG8_SB(1, 1), cB + hstepB + kstep, voffB[0], rbB);
    PG8_WAIT_V(6); PG8_BAR;
    for (;;) {
        const bool has_next = S.next(ui + 1, nxt);
        const char* nAp = GATHER ? cA : (has_next ? (const char*)g.A + (size_t)nxt.pm * tstepA + ES * S.koff(nxt) : cA);
        const char* nB = has_next ? (const char*)g.Bt + (size_t)nxt.pn * tstepB + ES * S.koff(nxt) : cB;
        if (GATHER) {
#pragma unroll
            for (int i = 0; i < 2; ++i) { nA0[i] = vA0[i]; nA1[i] = vA1[i]; } }
        for (int t = 0; t < nt; t += 2) {
            const bool last = (t == nt - 2);
            if (GATHER && has_next && t == (nt >= 4 ? nt - 4 : 0)) {
#pragma unroll
                for (int i = 0; i < 2; ++i) { nA0[i] = (unsigned)(S.arow(nxt, Rr[i]) * g.lda * ES + Cc[i] * 2); nA1[i] = (unsigned)(S.arow(nxt, Rr[i] + HALF) * g.lda * ES + Cc[i] * 2); } }
            const char* a1 = cA + (size_t)(t + 1) * kstep;
            const char* a2 = last ? nAp : cA + (size_t)(t + 2) * kstep; const char* b2 = last ? nB : cB + (size_t)(t + 2) * kstep;
            const char* a3 = a2 + kstep; const char* b3 = b2 + kstep;
            unsigned w0[2], w1[2];
#pragma unroll
            for (int i = 0; i < 2; ++i) { w0[i] = (GATHER && last) ? nA0[i] : vA0[i]; w1[i] = (GATHER && last) ? nA1[i] : vA1[i]; }
            PG8_LDB(B0, 0, 0); PG8_SCHED; PG8_LDA(At, 0, 0); PG8_STAGEA(PG8_SA(1, 1), a1, 1, vA1);
            PG8_WAIT_L(8); PG8_BAR; PG8_WAIT_L(0); PG8_MMA(0, 0, At, B0); PG8_BAR; PG8_SCHED;
            PG8_LDB(B1, 0, 1); PG8_STAGE1(PG8_SB(0, 0), b2, voffB[0], rbB);
            PG8_BAR; PG8_WAIT_L(0); PG8_MMA(0, 1, At, B1); PG8_BAR;
            PG8_LDA(At, 0, 1); PG8_STAGEA(PG8_SA(0, 0), a2, 0, w0);
            PG8_BAR; PG8_WAIT_L(0); PG8_MMA(1, 0, At, B0); PG8_BAR; PG8_SCHED;
            PG8_STAGE1(PG8_SB(0, 1), b2 + hstepB, voffB[0], rbB);
            PG8_WAIT_V(6); PG8_BAR; PG8_MMA(1, 1, At, B1); PG8_BAR;
            PG8_LDB(B0, 1, 0); PG8_SCHED; PG8_LDA(At, 1, 0); PG8_STAGEA(PG8_SA(0, 1), a2, 1, w1);
            PG8_WAIT_L(8); PG8_BAR; PG8_WAIT_L(0); PG8_MMA(0, 0, At, B0); PG8_BAR; PG8_SCHED;
            PG8_LDB(B1, 1, 1); PG8_STAGE1(PG8_SB(1, 0), b3, voffB[0], rbB);
            PG8_BAR; PG8_WAIT_L(0); PG8_MMA(0, 1, At, B1); PG8_BAR;
            PG8_LDA(At, 1, 1); PG8_STAGEA(PG8_SA(1, 0), a3, 0, w0);
            PG8_BAR; PG8_WAIT_L(0); PG8_MMA(1, 0, At, B0); PG8_BAR; PG8_SCHED;
            PG8_STAGE1(PG8_SB(1, 1), b3 + hstepB, voffB[0], rbB);
            PG8_WAIT_V(6); PG8_BAR; PG8_MMA(1, 1, At, B1); PG8_BAR;
        }
        if constexpr (F8) asm volatile("s_nop 15\n\ts_nop 15\n\ts_nop 15\n\ts_nop 15" ::: "memory");
        { int frr = fr, fqq = fq; asm volatile("" : "+v"(frr), "+v"(fqq));
          E(acc, cur, wr, wc, frr, fqq); }
        if (!has_next) break;
#pragma unroll
        for (int a = 0; a < 2; ++a)
#pragma unroll
            for (int b = 0; b < 2; ++b)
#pragma unroll
                for (int m = 0; m < 4; ++m)
#pragma unroll
                    for (int n = 0; n < 2; ++n) acc[a][b][m][n] = (f32x4){0.f, 0.f, 0.f, 0.f};
        cur = nxt; cA = nAp; cB = nB; ++ui;
        if (GATHER) {
#pragma unroll
            for (int i = 0; i < 2; ++i) { vA0[i] = nA0[i]; vA1[i] = nA1[i]; } }
    }
    PG8_WAIT_V(0);
    if (wr == 0) PG8_BAR;
    PG8_BAR;
#undef PG8_SA
#undef PG8_SB
#undef PG8_STAGE
#undef PG8_STAGE1
#undef PG8_STAGEA
#undef PG8_LDA
#undef PG8_LDB
#undef PG8_MMA
#undef PG8_LD32
#undef PG8_WAIT_V
#undef PG8_WAIT_L
#undef PG8_BAR
#undef PG8_SCHED
}
}

#define XB_TMO      128
#define XB_XCNT(j)  (256  + 64 * (j))
#define XB_XSUB(j)  (1280 + 64 * (j))
#define XB_XGEN(j)  (2304 + 64 * (j))
#define XB_TOP      3328
#define XB_TOPGEN   3392
#define XCD_BAR_WORDS 3456
#define XB_SPIN_CAP (1u << 18)
__device__ __forceinline__ unsigned xb_ld(unsigned* p)              { return __hip_atomic_load(p, __ATOMIC_RELAXED, __HIP_MEMORY_SCOPE_AGENT); }
__device__ __forceinline__ unsigned xb_add(unsigned* p, unsigned v) { return __hip_atomic_fetch_add(p, v, __ATOMIC_RELAXED, __HIP_MEMORY_SCOPE_AGENT); }
__device__ __forceinline__ unsigned xb_xcc_id() { return (unsigned)__builtin_amdgcn_s_getreg((3 << 11) | 20) & 0xFu; }
#define XB_SPIN(cond, bar) do { unsigned _sp = 0; while (cond) { __builtin_amdgcn_s_sleep(1); \
    if ((++_sp & 255u) == 0u) { if (xb_ld(&(bar)[XB_TMO])) break; if (_sp > XB_SPIN_CAP) { atomicAdd(&(bar)[XB_TMO], 1u); break; } } } } while (0)
struct XcdBarrier { unsigned* bar; unsigned x; volatile LAS unsigned* st; int wv; };
__device__ __forceinline__ XcdBarrier xcd_barrier_post(unsigned* bar, volatile LAS unsigned* st, int wv) {
    XcdBarrier b; b.bar = bar; b.x = xb_xcc_id(); b.st = st; b.wv = wv;
    if (wv == 0 && lane_id() == 0) (void)xb_add(&bar[XB_XCNT(b.x)], 1u);
    return b;
}
__device__ __forceinline__ void xcd_barrier_complete(unsigned* bar, unsigned x, unsigned& nloc, unsigned& nx) {
    const unsigned G = gridDim.x * gridDim.y * gridDim.z;
    unsigned sum, cnt, mine, sp = 0u;
    for (;;) {
        sum = 0u; cnt = 0u; mine = 0u;
#pragma unroll
        for (unsigned j = 0; j < 16; ++j) { const unsigned c = xb_ld(&bar[XB_XCNT(j)]); sum += c; cnt += (c > 0u) ? 1u : 0u; mine = (j == x) ? c : mine; }
        if (sum == G) break;
        __builtin_amdgcn_s_sleep(1);
        if ((++sp & 255u) == 0u) { if (xb_ld(&bar[XB_TMO])) break; if (sp > XB_SPIN_CAP) { atomicAdd(&bar[XB_TMO], 1u); break; } }
    }
    nloc = mine > 0u ? mine : 1u; nx = cnt > 0u ? cnt : 1u;
}
__device__ __forceinline__ void xcd_barrier(const XcdBarrier& b) {
    asm volatile("s_waitcnt vmcnt(0)" ::: "memory");
    __syncthreads();
    if (b.wv == 0 && lane_id() == 0) {
        unsigned* bar = b.bar;
        __builtin_amdgcn_s_waitcnt(0);
        unsigned nloc = b.st[0], nx = b.st[1];
        if (nloc == 0u) { xcd_barrier_complete(bar, b.x, nloc, nx); b.st[0] = nloc; b.st[1] = nx; }
        const unsigned old = xb_add(&bar[XB_XSUB(b.x)], 1u);
        const unsigned gen = old / nloc;
        if (old + 1u == (gen + 1u) * nloc) {
            __builtin_amdgcn_fence(__ATOMIC_RELEASE, "agent");
            asm volatile("s_waitcnt vmcnt(0)" ::: "memory");
            const unsigned og = xb_add(&bar[XB_TOP], 1u);
            const unsigned tg = og / nx;
            if (og + 1u == (tg + 1u) * nx) xb_add(&bar[XB_TOPGEN], 1u);
            else XB_SPIN(xb_ld(&bar[XB_TOPGEN]) == tg, bar);
            __builtin_amdgcn_fence(__ATOMIC_ACQUIRE, "agent");
            xb_add(&bar[XB_XGEN(b.x)], 1u);
            asm volatile("s_waitcnt vmcnt(0)" ::: "memory");
        } else {
            XB_SPIN(xb_ld(&bar[XB_XGEN(b.x)]) == gen, bar);
            __builtin_amdgcn_fence(__ATOMIC_ACQUIRE, "agent");
            asm volatile("s_waitcnt vmcnt(0)" ::: "memory");
        }
    }
    __syncthreads();
}

constexpr size_t MiB = 1u << 20;
constexpr size_t CTL_BAR = 0, CTL_MODI = 16384  , CTL_MOD = CTL_MODI + 2 * 4 * 12288 * 8  , CTL_SSQ = CTL_MOD + 2 * 4 * 12288 * 4  ,
                 CTL_CNT = CTL_SSQ + (size_t)T * 12 * 4  , CTL_CHK = CTL_CNT + 2 * 16 * 256, CTL_ZERO_BYTES = 2 * MiB;
static_assert(CTL_CHK % 8 == 0 && CTL_CHK + 1024 <= CTL_ZERO_BYTES, "ctl");
constexpr size_t WS_W_IN0 = 2 * MiB, WS_W_UQ = WS_W_IN0 + 8 * MiB, WS_W_UKV = WS_W_UQ + 1536 * 512 * 2, WS_W_GLU = WS_W_UKV + 2048 * 256 * 2, WS_W_OUT0 = WS_W_GLU + 2 * MiB,
                 WS_W_IN1 = WS_W_OUT0 + 8 * MiB, WS_W_OUT1 = WS_W_IN1 + (size_t)9728 * 2048 * 2, WS_W_GU = WS_W_OUT1 + 8 * MiB, WS_W_DN = WS_W_GU + 128 * MiB,
                 WS_W_LORA = WS_W_DN + 64 * MiB, WS_S5BY = WS_W_LORA + (size_t)4608 * 384 * 2, WS_S5BE = WS_S5BY + (size_t)64 * 256 * 384 * 2, WS_ROPE = WS_S5BE + (size_t)64 * 256 * 256 * 2,
                 WS_BIAS = WS_ROPE + 1 * MiB, WS_S5L = WS_BIAS + 16384, WS_H = WS_S5L + 65536;
static_assert(WS_H % 256 == 0, "align");
constexpr size_t WS_W_GU8 = WS_W_GU + 64 * MiB;
constexpr size_t WS_X1 = WS_H + 64 * MiB, WS_ARENA = WS_X1 + 128 * MiB;
constexpr size_t A_QC = WS_ARENA, A_KVC = A_QC + 16 * MiB, A_KR = A_KVC + 8 * MiB, A_XH = A_KR + 2 * MiB, A_ES = A_XH + 48 * MiB, A_Q = A_ES + 32 * MiB, A_KF = A_Q + 48 * MiB,
                 A_V = A_KF + 48 * MiB, A_YS5 = A_V + 32 * MiB;
constexpr size_t A_XPRE = WS_ARENA, A_RT = WS_ARENA + 128 * MiB, A_TOKL = A_RT + 1 * MiB, A_ACT = WS_ARENA, A_YS = WS_ARENA + 130 * MiB;
constexpr int MOE_ROWS = 2 * T + 16 * 256;
constexpr size_t A_ZD = WS_ARENA, A_ZR = A_ZD + 144 * MiB, A_LIN = A_ZR + 156 * MiB, A_WDEC = A_LIN + 12 * MiB, A_AA = A_WDEC + 48 * MiB, A_GG = A_AA + 48 * MiB,
                 A_DPO = A_GG + 48 * MiB, A_DPM = A_DPO + 48 * MiB, A_DPL = A_DPM + 2 * MiB, A_BSG = A_DPL + 2 * MiB  , A_YR = WS_ARENA  , A_GST = A_BSG + 2 * MiB  , WS_END = A_GST + 2 * MiB;
static_assert(A_YS + (size_t)MOE_ROWS * 2048 * 2 <= WS_END && A_YS5 + 32 * MiB <= WS_END && WS_END <= 1024 * MiB, "ws map");

constexpr int RING_BYTES = 131072, LDS_TAB = RING_BYTES, LDS_MISC = RING_BYTES + 1024, LDS_BYTES = 147456;

struct KArgs { const float* in[41]; float* out; unsigned char* ws; int ph_lo, ph_hi; };
enum { I_X = 0, I_C, I_ADAW, I_ADAB, I_LNMG, I_LNMB, I_LNFG, I_LNFB, I_RW, I_RB, I_WGU, I_WDN, I_RELB, I_EVIN, I_QN, I_WUQ, I_KVN, I_WUKV, I_LRE, I_LIM, I_BRE, I_BIM, I_CRE, I_CIM,
       I_S5D, I_LOGDT, I_WGLU, I_EVOUT, I_ODIN, I_MU, I_W0, I_W2, I_A0, I_A2, I_G2, I_KK, I_KA, I_RK, I_LNXG, I_LNXB, I_ODOUT };

DI int ropeperm(int c) { return ((c >> 2) & 1) * 32 + (c >> 3) * 4 + (c & 3); }
DI int srccol(int map, int n) {
    switch (map) {
        case 1: if (n < 768) return n; if (n < 1792) return 832 + (n - 768); if (n < 1856) return 768 + ropeperm(n - 1792); return -1;
        case 2: { const int h = n / 192, j = n % 192; return j < 128 ? n : h * 192 + 128 + ropeperm(j - 128); }
        case 3: { const int pn = n >> 8, half = (n >> 7) & 1, idx = n & 127; return half * 512 + pn * 128 + idx; }
        case 4: return n < ODD_IN ? n : -1;
        default: return n;
    }
}
struct ConvJob { const float* src; bf16* dst; const float* kscale; int ldsrc, K, Nd, nmat, map, kbeg, kend, f8; size_t smat, dmat; };
DI void conv_item(const ConvJob& J, LAS unsigned char* scr, int item, int lane) {
    const int nblk = J.Nd / 64, per = (J.K / 64) * nblk, mat = item / per, r = item % per, kb = r / nblk, nb = r % nblk, k0 = 64 * kb, n0 = 64 * nb;
    const float* W = J.src + (size_t)mat * J.smat; bf16* WT = J.f8 ? (bf16*)((unsigned char*)J.dst + (size_t)mat * J.dmat) : J.dst + (size_t)mat * J.dmat;
    const int kq = lane >> 4, nq = lane & 15, sc = srccol(J.map, n0 + 4 * nq);
    f32x4 v[16];
#pragma unroll
    for (int i = 0; i < 16; ++i) { const int kg = k0 + 4 * i + kq; v[i] = (f32x4){0.f, 0.f, 0.f, 0.f};
        if (sc >= 0 && kg >= J.kbeg && kg < J.kend) { v[i] = *(const f32x4*)(W + (size_t)(kg - J.kbeg) * J.ldsrc + sc); if (J.kscale) v[i] *= J.kscale[kg]; } }
#pragma unroll
    for (int i = 0; i < 16; ++i) { LAS bf16* t = (LAS bf16*)(scr + (4 * nq) * 132 + (4 * i + kq) * 2); const unsigned p0 = pk2(v[i].x, v[i].y), p1 = pk2(v[i].z, v[i].w);
        t[0] = (bf16)(p0 & 0xffffu); t[66] = (bf16)(p0 >> 16); t[132] = (bf16)(p1 & 0xffffu); t[198] = (bf16)(p1 >> 16); }
    asm volatile("s_waitcnt lgkmcnt(0)" ::: "memory");
#pragma unroll
    for (int q = 0; q < 8; ++q) { const int id = lane + 64 * q, n = id >> 3, c = id & 7; const LAS unsigned* t = (const LAS unsigned*)(scr + n * 132 + c * 16);
        u32x4 o = {t[0], t[1], t[2], t[3]};
        if (J.f8) { u32x2 o8 = {pk4_fp8(bflo(o.x) * F8_WSCALE, bfhi(o.x) * F8_WSCALE, bflo(o.y) * F8_WSCALE, bfhi(o.y) * F8_WSCALE), pk4_fp8(bflo(o.z) * F8_WSCALE, bfhi(o.z) * F8_WSCALE, bflo(o.w) * F8_WSCALE, bfhi(o.w) * F8_WSCALE)};
            *(u32x2*)((unsigned char*)WT + (size_t)(n0 + n) * J.K + k0 + 8 * c) = o8; }
        else *(u32x4*)(WT + (size_t)(n0 + n) * J.K + k0 + 8 * c) = o; }
    asm volatile("s_waitcnt lgkmcnt(0)" ::: "memory");
}
DI ConvJob conv_job(const KArgs& a, int j) {
    unsigned char* ws = a.ws; ConvJob J; J.kscale = nullptr; J.nmat = 1; J.map = 0; J.smat = 0; J.dmat = 0; J.kbeg = 0; J.kend = 1 << 30; J.f8 = 0;
    switch (j) {
        case 0: J.src = a.in[I_EVIN]; J.dst = (bf16*)(ws + WS_W_IN0); J.f8 = 1; J.ldsrc = EVEN_IN; J.K = 2048; J.Nd = 2048; J.map = 1; break;
        case 1: J.src = a.in[I_WUQ]; J.dst = (bf16*)(ws + WS_W_UQ); J.ldsrc = 1536; J.K = 512; J.Nd = 1536; J.map = 2; J.kscale = a.in[I_QN]; break;
        case 2: J.src = a.in[I_WUKV]; J.dst = (bf16*)(ws + WS_W_UKV); J.ldsrc = 2048; J.K = 256; J.Nd = 2048; J.kscale = a.in[I_KVN]; break;
        case 3: J.src = a.in[I_WGLU]; J.dst = (bf16*)(ws + WS_W_GLU); J.ldsrc = 1024; J.K = 1024; J.Nd = 1024; break;
        case 4: J.src = a.in[I_EVOUT]; J.dst = (bf16*)(ws + WS_W_OUT0); J.f8 = 1; J.ldsrc = 2048; J.K = 2048; J.Nd = 2048; break;
        case 5: J.src = a.in[I_ODIN]; J.dst = (bf16*)(ws + WS_W_IN1); J.f8 = 1; J.ldsrc = ODD_IN; J.K = 2048; J.Nd = 9728; J.map = 4; break;
        case 6: J.src = a.in[I_ODOUT]; J.dst = (bf16*)(ws + WS_W_OUT1); J.f8 = 1; J.ldsrc = 2048; J.K = 2048; J.Nd = 2048; break;
        case 7: J.src = a.in[I_WGU]; J.dst = (bf16*)(ws + WS_W_GU8); J.f8 = 1; J.ldsrc = 1024; J.K = 2048; J.Nd = 1024; J.map = 3; J.nmat = 32; J.smat = (size_t)2048 * 1024; J.dmat = (size_t)1024 * 2048; break;
        case 8: J.src = a.in[I_WDN]; J.dst = (bf16*)(ws + WS_W_DN); J.f8 = 1; J.ldsrc = 2048; J.K = 512; J.Nd = 2048; J.nmat = 32; J.smat = (size_t)512 * 2048; J.dmat = (size_t)2048 * 512; break;
        case 9: J.src = a.in[I_W2]; J.dst = (bf16*)(ws + WS_W_LORA); J.ldsrc = 1536; J.K = 384; J.Nd = 1536; J.kbeg = 0; J.kend = 64; break;
        case 10: J.src = a.in[I_A2]; J.dst = (bf16*)(ws + WS_W_LORA) + (size_t)1536 * 384; J.ldsrc = 1536; J.K = 384; J.Nd = 1536; J.kbeg = 64; J.kend = 128; break;
        default: J.src = a.in[I_G2]; J.dst = (bf16*)(ws + WS_W_LORA) + (size_t)3072 * 384; J.ldsrc = 1536; J.K = 384; J.Nd = 1536; J.kbeg = 128; J.kend = 352; break;
    }
    return J;
}
constexpr int N_CONV_JOBS = 12;

DI void s5_precompute(const KArgs& a, LAS unsigned char* lds, int g, int wv) {
    LAS float* PW = (LAS float*)lds; LAS float* BB = PW + 17 * 64 * 2; LAS float* CC = BB + 64 * 16 * 2; LAS float* KK = CC + 16 * 64 * 2;
    const int tid = otid(wv);
    const float dt = expf(a.in[I_LOGDT][g]);
    for (int idx = tid; idx < 17 * 64; idx += 512) { const int d = idx / 64, p = idx % 64; const float lre = a.in[I_LRE][g * 64 + p], lim = a.in[I_LIM][g * 64 + p];
        const float mag = expf(lre * dt * (float)d); float sn, cs; sincosf(lim * dt * (float)d, &sn, &cs); PW[idx * 2] = mag * cs; PW[idx * 2 + 1] = mag * sn;
        if (d == 16) { float* L = (float*)(a.ws + WS_S5L); L[(g * 64 + p) * 2] = mag * cs; L[(g * 64 + p) * 2 + 1] = mag * sn; } }
    for (int idx = tid; idx < 64 * 16; idx += 512) { const int p = idx / 16, c = idx % 16; const float lre = a.in[I_LRE][g * 64 + p], lim = a.in[I_LIM][g * 64 + p];
        float sn, cs; sincosf(lim * dt, &sn, &cs); const float mag = expf(lre * dt), sh = sinf(0.5f * lim * dt);
        const float nr = expm1f(lre * dt) * cs - 2.f * sh * sh, ni = mag * sn, den = 1.f / (lre * lre + lim * lim);
        const float cr = (nr * lre + ni * lim) * den, ci = (ni * lre - nr * lim) * den;
        const float br = a.in[I_BRE][(g * 64 + p) * 16 + c], bi = a.in[I_BIM][(g * 64 + p) * 16 + c];
        BB[idx * 2] = cr * br - ci * bi; BB[idx * 2 + 1] = cr * bi + ci * br; }
    for (int idx = tid; idx < 16 * 64; idx += 512) { CC[idx * 2] = a.in[I_CRE][g * 1024 + idx]; CC[idx * 2 + 1] = a.in[I_CIM][g * 1024 + idx]; }
    __syncthreads();
    for (int idx = tid; idx < 4096; idx += 512) { const int d = idx >> 8, c = (idx >> 4) & 15, cp = idx & 15; float s = 0.f;
        for (int p = 0; p < 64; ++p) { const float cr = CC[(c * 64 + p) * 2], ci = CC[(c * 64 + p) * 2 + 1], pr = PW[(d * 64 + p) * 2], pi = PW[(d * 64 + p) * 2 + 1];
            const float xr = cr * pr - ci * pi, xi = cr * pi + ci * pr; s += xr * BB[(p * 16 + cp) * 2] - xi * BB[(p * 16 + cp) * 2 + 1]; }
        KK[idx] = s; }
    __syncthreads();
    bf16* BY = (bf16*)(a.ws + WS_S5BY) + (size_t)g * 256 * 384; bf16* BE = (bf16*)(a.ws + WS_S5BE) + (size_t)g * 256 * 256;
    for (int idx = tid; idx < 256 * 48; idx += 512) { const int row = idx / 48, col0 = (idx % 48) * 8, t = row >> 4, c = row & 15; float v[8];
        if (col0 < 256) { const int s = col0 >> 4, c0 = col0 & 15;
#pragma unroll
            for (int j = 0; j < 8; ++j) v[j] = (s <= t) ? KK[((t - s) << 8) + (c << 4) + c0 + j] : 0.f; }
        else { const int pp = col0 - 256; const bool im = pp >= 64; const int p0 = im ? pp - 64 : pp;
#pragma unroll
            for (int j = 0; j < 8; ++j) { const int p = p0 + j; const float cr = CC[(c * 64 + p) * 2], ci = CC[(c * 64 + p) * 2 + 1], pr = PW[((t + 1) * 64 + p) * 2], pi = PW[((t + 1) * 64 + p) * 2 + 1];
                v[j] = im ? -(cr * pi + ci * pr) : (cr * pr - ci * pi); } }
        u32x4 o = {pk2(v[0], v[1]), pk2(v[2], v[3]), pk2(v[4], v[5]), pk2(v[6], v[7])}; *(u32x4*)(BY + (size_t)row * 384 + col0) = o; }
    for (int idx = tid; idx < 256 * 32; idx += 512) { const int row = idx / 32, col0 = (idx % 32) * 8, s = col0 >> 4, c0 = col0 & 15; float v[8];
#pragma unroll
        for (int j = 0; j < 8; ++j) { if (row < 128) { const int p = row & 63; const float pr = PW[((15 - s) * 64 + p) * 2], pi = PW[((15 - s) * 64 + p) * 2 + 1], br = BB[(p * 16 + c0 + j) * 2], bi = BB[(p * 16 + c0 + j) * 2 + 1];
                v[j] = row < 64 ? (pr * br - pi * bi) : (pr * bi + pi * br); } else v[j] = 0.f; }
        u32x4 o = {pk2(v[0], v[1]), pk2(v[2], v[3]), pk2(v[4], v[5]), pk2(v[6], v[7])}; *(u32x4*)(BE + (size_t)row * 256 + col0) = o; }
    __syncthreads();
}

DI int t5_bucket(int dist) { if (dist < 16) return dist; const float logd = logf((float)dist / 16.f) / logf(128.f); int lg = 16 + (int)(logd * 16.f); return lg < 31 ? lg : 31; }

DI void p0_prologue(const KArgs& a, LAS unsigned char* lds, int wv) {
    const int tid = otid(wv), lane = tid & 63, wave = tid >> 6, G = gridDim.x, gw = blockIdx.x * 8 + wave, NGW = G * 8;
    LAS float* cond = (LAS float*)(lds + 98304);
    for (int i = tid; i < 4 * 2048; i += 512) { const float c = a.in[I_C][i]; cond[i] = c / (1.f + expf(-c)); }
    if (blockIdx.x < 64) s5_precompute(a, lds, blockIdx.x, wv); else __syncthreads();
    unsigned long long* MODI = (unsigned long long*)(a.ws + CTL_MODI);
    for (int it = gw; it < 2 * 48 * 16; it += NGW) { const int l = it / 768, cc = (it % 768) / 16, kc = it % 16, col = cc * 256 + lane * 4;
        const float* W = a.in[I_ADAW] + ((size_t)l * 2048 + kc * 128) * 12288 + col;
        f32x4 acc[4]; for (int b = 0; b < 4; ++b) acc[b] = (f32x4){0.f, 0.f, 0.f, 0.f};
#pragma unroll 8
        for (int k = 0; k < 128; ++k) { const f32x4 w = *(const f32x4*)(W + (size_t)k * 12288);
#pragma unroll
            for (int b = 0; b < 4; ++b) acc[b] += w * cond[b * 2048 + kc * 128 + k]; }
        if (kc == 0) { const f32x4 bb = *(const f32x4*)(a.in[I_ADAB] + l * 12288 + col); for (int b = 0; b < 4; ++b) acc[b] += bb; }
#pragma unroll
        for (int b = 0; b < 4; ++b) { unsigned long long* o = MODI + (size_t)(l * 4 + b) * 12288 + col;
#pragma unroll
            for (int e = 0; e < 4; ++e) atomicAdd(o + e, (unsigned long long)__double2ll_rn((double)acc[b][e] * 1099511627776.0)); } }
    LAS unsigned char* scr = lds + wave * 8704;
    for (int j = 0; j < N_CONV_JOBS; ++j) { const ConvJob J = conv_job(a, j); const int nit = J.nmat * (J.K / 64) * (J.Nd / 64);
        for (int it = gw; it < nit; it += NGW) conv_item(J, scr, it, lane); }
    { float* RC = (float*)(a.ws + WS_ROPE); float* RS = RC + 4096 * 32; const int gt = blockIdx.x * 512 + tid;
      for (int i = gt; i < 4096 * 32; i += G * 512) { const int pos = i >> 5, j = i & 31; const float inv = powf(10000.f, -(float)(2 * j) / 64.f); float sn, cs; sincosf((float)pos * inv, &sn, &cs); RC[i] = cs; RS[i] = sn; }
      float* BL = (float*)(a.ws + WS_BIAS);
      for (int i = gt; i < 3 * 8 * 132; i += G * 512) { const int gi = i / (8 * 132), h = (i / 132) % 8, dl = i % 132; const int dil = gi == 0 ? 1 : (gi == 1 ? 4 : 16);
          BL[i] = dl <= 128 ? a.in[I_RELB][t5_bucket(dl * dil) * 24 + gi * 8 + h] * 1.44269504089f : 0.f; } }
}

DI float modi2f(unsigned long long v) { return (float)((double)(long long)v * 9.094947017729282e-13); }
DI void modulate_rows(const float* x, const unsigned long long* MODI, float* MODF, bf16* H, int wv) {
    const int lane = otid(wv) & 63, gw = blockIdx.x * 8 + (otid(wv) >> 6), NGW = gridDim.x * 8;
    for (int i = gw * 64 + lane; i < 2 * 4 * 12288; i += NGW * 64) MODF[i] = modi2f(MODI[i]);
    for (int m = gw; m < T; m += NGW) { const int b = m / SEQ; const unsigned long long* sh = MODI + (size_t)b * 12288; const unsigned long long* sc = sh + 2048;
#pragma unroll
        for (int j = 0; j < 8; ++j) { const int col = (lane + 64 * j) * 4; const f32x4 v = *(const f32x4*)(x + (size_t)m * D + col);
            const f32x4 s1 = {modi2f(sc[col]), modi2f(sc[col + 1]), modi2f(sc[col + 2]), modi2f(sc[col + 3])}, s0 = {modi2f(sh[col]), modi2f(sh[col + 1]), modi2f(sh[col + 2]), modi2f(sh[col + 3])};
            const f32x4 h = v * (s1 + 1.f) + s0; *(unsigned*)((unsigned char*)H + (size_t)m * D + col) = pk4_fp8(h.x, h.y, h.z, h.w); } }
}

using pg8::Unit;
#define P32(ptr, elemoff) ((decltype(ptr))((char*)(ptr) + (unsigned)((unsigned)(elemoff) * (unsigned)sizeof(*(ptr)))))
typedef f32x4 Acc[2][2][4][2];
#define EPI_ROWS_BEGIN const int row0 = u.pm * 256 + wr * 64 + fr; _Pragma("unroll") for (int ai = 0; ai < 2; ++ai) _Pragma("unroll") for (int m = 0; m < 4; ++m) { const int row = row0 + ai * 128 + m * 16;
#define EPI_ROWS_END __builtin_amdgcn_sched_barrier(0); }
DI u32x4 pack8(const f32x4& v0, const f32x4& v1) { u32x4 o = {pk2(v0.x, v0.y), pk2(v0.z, v0.w), pk2(v1.x, v1.y), pk2(v1.z, v1.w)}; return o; }

struct EpiIn0 { static constexpr bool PERM = true;
    bf16 *QC, *KVC, *KR, *XH; float *ssq;
    DI void operator()(const Acc& acc, const Unit& u, int wr, int wc, int fr, int fq) const {
        EPI_ROWS_BEGIN
            float ss = 0.f;
#pragma unroll
            for (int bj = 0; bj < 2; ++bj) { const f32x4 v0 = acc[ai][bj][m][0], v1 = acc[ai][bj][m][1]; const int col = 128 * bj + 32 * wc + 8 * fq; const u32x4 o = pack8(v0, v1);
                if (u.pn < 2) { *(u32x4*)P32(QC, row * 512 + u.pn * 256 + col) = o; ss += v0.x * v0.x + v0.y * v0.y + v0.z * v0.z + v0.w * v0.w + v1.x * v1.x + v1.y * v1.y + v1.z * v1.z + v1.w * v1.w; }
                else if (u.pn == 2) { *(u32x4*)P32(KVC, row * 256 + col) = o; ss += v0.x * v0.x + v0.y * v0.y + v0.z * v0.z + v0.w * v0.w + v1.x * v1.x + v1.y * v1.y + v1.z * v1.z + v1.w * v1.w; }
                else if (u.pn < 7) { const int uc = (u.pn - 3) * 256 + col, g = uc >> 4; *(u32x4*)P32(XH, (g * 1024 + (row >> 4)) * 384 + (row & 15) * 16 + (uc & 15)) = o; }
                else if (col < 64) { *(u32x4*)P32(KR, row * 64 + col) = o; } }
            if (u.pn <= 2) { ss += __shfl_xor(ss, 16); ss += __shfl_xor(ss, 32); if (fq == 0) *P32(ssq, row * 12 + u.pn * 4 + wc) = ss; }
        EPI_ROWS_END
    }
};
struct EpiQ { static constexpr bool PERM = true;
    bf16* Q; const float* ssq; const float* rope;
    DI void operator()(const Acc& acc, const Unit& u, int wr, int wc, int fr, int fq) const {
        EPI_ROWS_BEGIN
            const f32x4 q0 = *(const f32x4*)P32(ssq, row * 12), q1 = *(const f32x4*)P32(ssq, row * 12 + 4);
            const float rs = rsqrtf((((q0.x + q0.y) + (q0.z + q0.w)) + ((q1.x + q1.y) + (q1.z + q1.w))) * (1.f / 512.f) + RMS_EPS) * (0.07216878364870322f * 1.44269504089f);
            const int b = row / SEQ, s = row % SEQ;
#pragma unroll
            for (int bj = 0; bj < 2; ++bj) { f32x4 v0 = acc[ai][bj][m][0] * rs, v1 = acc[ai][bj][m][1] * rs; const int n = u.pn * 256 + 128 * bj + 32 * wc + 8 * fq, h = n / 192, j = n % 192;
                if (j >= 128) { const int q = (j - 128) >> 3; const f32x4 cs = *(const f32x4*)P32(rope, s * 32 + 4 * q), sn = *(const f32x4*)P32(rope, 4096 * 32 + s * 32 + 4 * q);
                    const f32x4 x1 = v0, x2 = v1; v0 = x1 * cs - x2 * sn; v1 = x1 * sn + x2 * cs; }
                *(u32x4*)P32(Q, ((b * 8 + h) * SEQ + s) * 192 + j) = pack8(v0, v1); }
        EPI_ROWS_END
    }
};
struct EpiKV { static constexpr bool PERM = true;
    bf16 *KF, *V; const float* ssq;
    DI void operator()(const Acc& acc, const Unit& u, int wr, int wc, int fr, int fq) const {
        EPI_ROWS_BEGIN
            const f32x4 q2 = *(const f32x4*)P32(ssq, row * 12 + 8); const float rs = rsqrtf(((q2.x + q2.y) + (q2.z + q2.w)) * (1.f / 256.f) + RMS_EPS); const int b = row / SEQ, s = row % SEQ, h = u.pn, j = 32 * wc + 8 * fq; const int tok = (b * 8 + h) * SEQ + s;
            *(u32x4*)P32(KF, tok * 192 + j) = pack8(acc[ai][0][m][0] * rs, acc[ai][0][m][1] * rs);
            *(u32x4*)P32(V, tok * 128 + j) = pack8(acc[ai][1][m][0] * rs, acc[ai][1][m][1] * rs);
        EPI_ROWS_END
    }
};
struct S5Order { int G, c;
    DI bool next(int i, Unit& u) const { const int L = i * G + c; if (L >= 256) return false; u.pm = L; u.pn = L >> 2; u.aux = 0; return true; }
    DI int arow(const Unit&, int) const { return 0; }
    DI int koff(const Unit&) const { return 0; } };
struct EpiS5E { static constexpr bool PERM = false;
    float* ES;
    DI void operator()(const Acc& acc, const Unit& u, int wr, int wc, int fr, int fq) const {
        EPI_ROWS_BEGIN
#pragma unroll
            for (int n = 0; n < 2; ++n) *(f32x4*)P32(ES, row * 128 + 32 * wc + 16 * n + 4 * fq) = acc[ai][0][m][n];
        EPI_ROWS_END
    }
};
DI float gelu_tanh(float x) { const float t = 0.7978845608028654f * (x + 0.044715f * x * x * x); const float e = __expf(2.f * t); return 0.5f * x * (1.f + (1.f - 2.f / (e + 1.f))); }
struct EpiS5Y { static constexpr bool PERM = true;
    bf16* YS5; const bf16* XH; const float* dsk;
    DI void operator()(const Acc& acc, const Unit& u, int wr, int wc, int fr, int fq) const {
        EPI_ROWS_BEGIN
            const int g = row >> 10, chunk = row & 1023;
#pragma unroll
            for (int bj = 0; bj < 2; ++bj) { const int col = 128 * bj + 32 * wc + 8 * fq, tl = col >> 4, c0 = col & 15; const u32x4 uu = *(const u32x4*)P32(XH, row * 384 + col);
                const f32x4 d0 = *(const f32x4*)P32(dsk, g * 16 + c0), d1 = *(const f32x4*)P32(dsk, g * 16 + c0 + 4); const f32x4 a0 = acc[ai][bj][m][0], a1 = acc[ai][bj][m][1];
                f32x4 y0 = {a0.x + d0.x * bflo(uu.x), a0.y + d0.y * bfhi(uu.x), a0.z + d0.z * bflo(uu.y), a0.w + d0.w * bfhi(uu.y)};
                f32x4 y1 = {a1.x + d1.x * bflo(uu.z), a1.y + d1.y * bfhi(uu.z), a1.z + d1.z * bflo(uu.w), a1.w + d1.w * bfhi(uu.w)};
#pragma unroll
                for (int e = 0; e < 4; ++e) { y0[e] = gelu_tanh(y0[e]); y1[e] = gelu_tanh(y1[e]); }
                *(u32x4*)P32(YS5, (chunk * 16 + tl) * 1024 + g * 16 + c0) = pack8(y0, y1); }
        EPI_ROWS_END
    }
};
struct EpiGlu { static constexpr bool PERM = true;
    bf16* MIX; const bf16* YS5;
    DI void operator()(const Acc& acc, const Unit& u, int wr, int wc, int fr, int fq) const {
        EPI_ROWS_BEGIN
#pragma unroll
            for (int bj = 0; bj < 2; ++bj) { const int col = u.pn * 256 + 128 * bj + 32 * wc + 8 * fq; const u32x4 yy = *(const u32x4*)P32(YS5, row * 1024 + col); const f32x4 a0 = acc[ai][bj][m][0], a1 = acc[ai][bj][m][1];
                const f32x4 o0 = {bflo(yy.x) * sigmoidf_(a0.x), bfhi(yy.x) * sigmoidf_(a0.y), bflo(yy.y) * sigmoidf_(a0.z), bfhi(yy.y) * sigmoidf_(a0.w)};
                const f32x4 o1 = {bflo(yy.z) * sigmoidf_(a1.x), bfhi(yy.z) * sigmoidf_(a1.y), bflo(yy.w) * sigmoidf_(a1.z), bfhi(yy.w) * sigmoidf_(a1.w)};
                { unsigned char* mx = (unsigned char*)MIX; u32x2 o8 = {pk4_fp8(o0.x, o0.y, o0.z, o0.w), pk4_fp8(o1.x, o1.y, o1.z, o1.w)}; *(u32x2*)P32(mx, row * 2048 + 1024 + col) = o8; } }
        EPI_ROWS_END
    }
};
template <bool XBF> struct EpiRes { static constexpr bool PERM = true;
    bf16* XPRE; const void* xres; const float* gate;
    DI void operator()(const Acc& acc, const Unit& u, int wr, int wc, int fr, int fq) const {
        EPI_ROWS_BEGIN
            const int b = row / SEQ;
#pragma unroll
            for (int bj = 0; bj < 2; ++bj) { const int col = u.pn * 256 + 128 * bj + 32 * wc + 8 * fq;
                f32x4 x0, x1;
                if (XBF) { const bf16* xb = (const bf16*)xres; const u32x4 xq = *(const u32x4*)P32(xb, row * D + col); x0 = (f32x4){bflo(xq.x), bfhi(xq.x), bflo(xq.y), bfhi(xq.y)}; x1 = (f32x4){bflo(xq.z), bfhi(xq.z), bflo(xq.w), bfhi(xq.w)}; }
                else { const float* xf = (const float*)xres; x0 = *(const f32x4*)P32(xf, row * D + col); x1 = *(const f32x4*)P32(xf, row * D + col + 4); }
                const f32x4 g0 = *(const f32x4*)P32(gate, b * 12288 + col), g1 = *(const f32x4*)P32(gate, b * 12288 + col + 4);
                *(u32x4*)P32(XPRE, row * D + col) = pack8(x0 * DN_ALPHA + (g0 + 1.f) * acc[ai][bj][m][0], x1 * DN_ALPHA + (g1 + 1.f) * acc[ai][bj][m][1]); }
        EPI_ROWS_END
    }
};

DI void krope_pass(const bf16* KR, const float* rope, bf16* KF, int wv) {
    const int gt = blockIdx.x * 512 + otid(wv), NT_ = gridDim.x * 512;
    for (int i = gt; i < T * 8; i += NT_) { const int row = i >> 3, q = i & 7, b = row / SEQ, s = row % SEQ; const u32x4 r = *(const u32x4*)(KR + (size_t)row * 64 + q * 8);
        const f32x4 x1 = {bflo(r.x), bfhi(r.x), bflo(r.y), bfhi(r.y)}, x2 = {bflo(r.z), bfhi(r.z), bflo(r.w), bfhi(r.w)};
        const f32x4 cs = *(const f32x4*)(rope + s * 32 + 4 * q), sn = *(const f32x4*)(rope + 4096 * 32 + s * 32 + 4 * q);
        const u32x4 o = pack8(x1 * cs - x2 * sn, x1 * sn + x2 * cs);
#pragma unroll
        for (int h = 0; h < 8; ++h) *(u32x4*)(KF + ((size_t)(b * 8 + h) * SEQ + s) * 192 + 128 + q * 8) = o; }
}
DI void s5_carry(const float* ES, const float* L16, bf16* XH, LAS unsigned char* lds, int wv) {
    const int tid = otid(wv), lane = tid & 63, w = tid >> 6; LAS float* SEG = (LAS float*)lds;
    for (int base = blockIdx.x * 64; base < 4 * 64 * 64; base += gridDim.x * 64) {
        const int gt = base + lane, p = gt & 63, g = (gt >> 6) & 63, b = gt >> 12; const float lr = L16[(g * 64 + p) * 2], li = L16[(g * 64 + p) * 2 + 1];
        const size_t r0 = (size_t)g * 1024 + b * 256 + 32 * w;
        float hr = 0.f, hi = 0.f;
#pragma unroll 16
        for (int k = 0; k < 32; ++k) { const float er = ES[(r0 + k) * 128 + p], ei = ES[(r0 + k) * 128 + 64 + p]; const float nr = lr * hr - li * hi + er, ni = lr * hi + li * hr + ei; hr = nr; hi = ni; }
        __syncthreads();
        SEG[(w * 64 + lane) * 2] = hr; SEG[(w * 64 + lane) * 2 + 1] = hi;
        float pr = lr, pi = li;
#pragma unroll
        for (int q = 0; q < 5; ++q) { const float nr = pr * pr - pi * pi, ni = 2.f * pr * pi; pr = nr; pi = ni; }
        __syncthreads();
        hr = 0.f; hi = 0.f;
        for (int u = 0; u < w; ++u) { const float er = SEG[(u * 64 + lane) * 2], ei = SEG[(u * 64 + lane) * 2 + 1]; const float nr = pr * hr - pi * hi + er, ni = pr * hi + pi * hr + ei; hr = nr; hi = ni; }
#pragma unroll 16
        for (int k = 0; k < 32; ++k) { const float er = ES[(r0 + k) * 128 + p], ei = ES[(r0 + k) * 128 + 64 + p];
            XH[(r0 + k) * 384 + 256 + p] = f2bf(hr); XH[(r0 + k) * 384 + 320 + p] = f2bf(hi);
            const float nr = lr * hr - li * hi + er, ni = lr * hi + li * hr + ei; hr = nr; hi = ni; }
    }
    __syncthreads();
}

#define MFMA32(a, b, c) __builtin_amdgcn_mfma_f32_32x32x16_bf16((a), (b), (c), 0, 0, 0)
constexpr int AT_KROW = 384, AT_VROW = 256, AT_KBYTES = 64 * AT_KROW, AT_STG = AT_KBYTES + 64 * AT_VROW, AT_NST = 3;
static_assert(AT_NST * AT_STG <= RING_BYTES, "attention LDS");
DI void mla_attn_unit(LAS unsigned char* lds, const bf16* Qg, const bf16* KFg, const bf16* Vg, bf16* MIX, int unit, int wv) {
    const int tid = otid(wv), lane = tid & 63, w = tid >> 6, r = lane & 31, hh = lane >> 5;
    const int b = unit >> 6, h = (unit >> 3) & 7, pi = unit & 7;
    const bf16* Qh = Qg + (size_t)(b * 8 + h) * SEQ * 192; const bf16* Kh = KFg + (size_t)(b * 8 + h) * SEQ * 192; const bf16* Vh = Vg + (size_t)(b * 8 + h) * SEQ * 128;
    const int w_ = __builtin_amdgcn_readfirstlane(w);
    int koff[3], voff[2];
#pragma unroll
    for (int i = 0; i < 3; ++i) { const int p = (3 * w_ + i) * 64 + lane, row = p / 24, cs = p % 24, c = (cs & ~7) | ((cs ^ (row >> 1)) & 7); koff[i] = row * 192 + c * 8; }
#pragma unroll
    for (int i = 0; i < 2; ++i) { const int p = (2 * w_ + i) * 64 + lane, row = p >> 4, cs = p & 15, c = cs ^ ((row & 3) << 2); voff[i] = row * 128 + c * 8; }
    const int kx = (r >> 1) & 7, vq = (lane >> 2) & 3;
    for (int half = 0; half < 2; ++half) {
        const int qb = half ? 15 - pi : pi, q0 = qb * 256 + 32 * w, nkt = (qb + 1) * 4;
        bf16x8 qf[12];
#pragma unroll
        for (int ks = 0; ks < 12; ++ks) qf[ks] = *(const GAS bf16x8*)P32(Qh, (q0 + r) * 192 + 16 * ks + 8 * hh);
        f32x16 O[4];
#pragma unroll
        for (int i = 0; i < 4; ++i) for (int e = 0; e < 16; ++e) O[i][e] = 0.f;
        float mrow = -1e30f, lrow = 0.f;
#define AT_DMA(kt, stg) do { LAS unsigned char* sb_ = lds + (stg) * AT_STG; \
        _Pragma("unroll") for (int i = 0; i < 3; ++i) __builtin_amdgcn_global_load_lds((const unsigned*)P32(Kh, (kt) * 64 * 192 + koff[i]), (LAS unsigned*)(sb_ + (3 * w_ + i) * 1024), 16, 0, 0); \
        _Pragma("unroll") for (int i = 0; i < 2; ++i) __builtin_amdgcn_global_load_lds((const unsigned*)P32(Vh, (kt) * 64 * 128 + voff[i]), (LAS unsigned*)(sb_ + AT_KBYTES + (2 * w_ + i) * 1024), 16, 0, 0); } while (0)
#define AT_BAR() do { asm volatile("s_waitcnt lgkmcnt(0)" ::: "memory"); __builtin_amdgcn_s_barrier(); asm volatile("" ::: "memory"); } while (0)
        __syncthreads();
        AT_DMA(0, 0); AT_DMA(1, 1);
        asm volatile("s_waitcnt vmcnt(5)" ::: "memory");
        AT_BAR();
        int stg = 0;
        for (int kt = 0; kt < nkt; ++kt) {
            if (kt + 2 < nkt) AT_DMA(kt + 2, stg == 0 ? 2 : stg - 1);
            const LAS unsigned char* sb = lds + stg * AT_STG;
            if (kt * 64 <= q0 + 31) {
                f32x16 st[2];
#pragma unroll
                for (int mt = 0; mt < 2; ++mt) for (int e = 0; e < 16; ++e) st[mt][e] = 0.f;
                __builtin_amdgcn_sched_barrier(0);
                {
                    const LAS unsigned char* kb = sb + r * AT_KROW; const LAS unsigned char* kx4[4];
#pragma unroll
                    for (int j = 0; j < 4; ++j) kx4[j] = kb + (((2 * j + hh) ^ kx) & 7) * 16;
                    bf16x8 kf[24];
#pragma unroll
                    for (int i = 0; i < 24; ++i) kf[i] = *(const LAS bf16x8*)(kx4[(i >> 1) & 3] + 32 * (i & 1) * AT_KROW + 128 * (i >> 3));
#pragma unroll
                    for (int i = 0; i < 24; ++i) st[i & 1] = MFMA32(kf[i], qf[i >> 1], st[i & 1]);
                    __builtin_amdgcn_sched_group_barrier(0x100, 4, 0);
#pragma unroll
                    for (int i = 0; i < 24; ++i) { __builtin_amdgcn_sched_group_barrier(0x008, 1, 0); __builtin_amdgcn_sched_group_barrier(0x100, 1, 0); }
                }
                __builtin_amdgcn_sched_barrier(0);
                if (kt * 64 + 63 > q0) {
                    const int qg = q0 + r;
#pragma unroll
                    for (int mt = 0; mt < 2; ++mt)
#pragma unroll
                        for (int e = 0; e < 16; ++e) { const int kg = kt * 64 + 32 * mt + (e & 3) + 8 * (e >> 2) + 4 * hh; if (kg > qg) st[mt][e] = -1e30f; }
                }
                float mx = st[0][0];
#pragma unroll
                for (int mt = 0; mt < 2; ++mt)
#pragma unroll
                    for (int e = 0; e < 16; ++e) mx = fmaxf(mx, st[mt][e]);
                mx = fmaxf(mx, __shfl_xor(mx, 32));
                const float mnew = fmaxf(mrow, mx), alpha = __builtin_amdgcn_exp2f(mrow - mnew); mrow = mnew;
                float ls = 0.f;
#pragma unroll
                for (int mt = 0; mt < 2; ++mt)
#pragma unroll
                    for (int e = 0; e < 16; ++e) { const float p = __builtin_amdgcn_exp2f(st[mt][e] - mnew); st[mt][e] = p; ls += p; }
                lrow = lrow * alpha + ls;
                if (__any(alpha != 1.f)) {
#pragma unroll
                    for (int i = 0; i < 4; ++i) O[i] *= alpha; }
                bf16x8 pf[2][2];
#pragma unroll
                for (int mt = 0; mt < 2; ++mt)
#pragma unroll
                    for (int s = 0; s < 2; ++s) { u32x4 pk = {pk2(st[mt][8 * s], st[mt][8 * s + 1]), pk2(st[mt][8 * s + 2], st[mt][8 * s + 3]), pk2(st[mt][8 * s + 4], st[mt][8 * s + 5]), pk2(st[mt][8 * s + 6], st[mt][8 * s + 7])};
                        pf[mt][s] = __builtin_bit_cast(bf16x8, pk); }
                __builtin_amdgcn_sched_barrier(0);
                {
                    const LAS unsigned char* vb = sb + AT_KBYTES + (4 * hh + vq) * AT_VROW + 32 * ((lane >> 4) & 1) + 8 * (lane & 3); const LAS unsigned char* vx4[4];
#pragma unroll
                    for (int d = 0; d < 4; ++d) vx4[d] = vb + ((d ^ vq) & 3) * 64;
                    bf16x8 af[16];
#pragma unroll
                    for (int i = 0; i < 16; ++i) { const LAS unsigned char* vp = vx4[i & 3] + 16 * (i >> 2) * AT_VROW;
                        const s16x4 lo = __builtin_amdgcn_ds_read_tr16_b64_v4i16((LAS s16x4*)vp), hi = __builtin_amdgcn_ds_read_tr16_b64_v4i16((LAS s16x4*)(vp + 8 * AT_VROW)); af[i] = __builtin_shufflevector(lo, hi, 0, 1, 2, 3, 4, 5, 6, 7); }
#pragma unroll
                    for (int i = 0; i < 16; ++i) O[i & 3] = MFMA32(af[i], pf[i >> 3][(i >> 2) & 1], O[i & 3]);
                    __builtin_amdgcn_sched_group_barrier(0x100, 8, 0);
#pragma unroll
                    for (int i = 0; i < 16; ++i) { __builtin_amdgcn_sched_group_barrier(0x008, 1, 0); __builtin_amdgcn_sched_group_barrier(0x100, 2, 0); }
                }
                __builtin_amdgcn_sched_barrier(0);
            }
            if (kt + 2 < nkt) asm volatile("s_waitcnt vmcnt(5)" ::: "memory"); else asm volatile("s_waitcnt vmcnt(0)" ::: "memory");
            AT_BAR();
            stg = stg == 2 ? 0 : stg + 1;
        }
        lrow += __shfl_xor(lrow, 32);
        const float inv = 1.f / lrow;
        unsigned char* mx_ = (unsigned char*)MIX; unsigned char* orow = P32(mx_, (b * SEQ + q0 + r) * 2048 + h * 128);
#pragma unroll
        for (int dvt = 0; dvt < 4; ++dvt)
#pragma unroll
            for (int g4 = 0; g4 < 4; ++g4) *(GAS unsigned*)(orow + dvt * 32 + 8 * g4 + 4 * hh) = pk4_fp8(O[dvt][4 * g4] * inv, O[dvt][4 * g4 + 1] * inv, O[dvt][4 * g4 + 2] * inv, O[dvt][4 * g4 + 3] * inv);
    }
#undef AT_DMA
#undef AT_BAR
}

DI void ln_router_phase(const KArgs& a, LAS unsigned char* lds, int layer, const bf16* XPRE, bf16* X1, bf16* H, int wv) {
    const int tid = otid(wv), lane = tid & 63, wave = tid >> 6;
    LAS float* wT = (LAS float*)lds;
    { f32x4 rw[4][4];
#pragma unroll
      for (int i = 0; i < 4; ++i)
#pragma unroll
          for (int q4 = 0; q4 < 4; ++q4) rw[i][q4] = *(const f32x4*)(a.in[I_RW] + (size_t)(tid + 512 * i) * 16 + 4 * q4);
#pragma unroll
      for (int i = 0; i < 4; ++i)
#pragma unroll
          for (int q4 = 0; q4 < 4; ++q4)
#pragma unroll
              for (int e4 = 0; e4 < 4; ++e4) wT[(4 * q4 + e4) * 2048 + tid + 512 * i] = rw[i][q4][e4]; }
    __syncthreads();
    const float* MODl = (const float*)(a.ws + CTL_MOD) + (size_t)layer * 4 * 12288;
    const float* lg = a.in[I_LNMG] + layer * D; const float* lb = a.in[I_LNMB] + layer * D;
    unsigned* cnt = (unsigned*)(a.ws + CTL_CNT) + layer * 16 * 64;
    LAS int* lcnt = (LAS int*)(lds + LDS_MISC + 256); LAS int* lbase = lcnt + 16; LAS int* rec = lcnt + 32;
    if (tid < 16) lcnt[tid] = 0;
    int* RTE = (int*)(a.ws + A_RT); int* RTP = RTE + 2 * T; float* RTW = (float*)(RTP + 2 * T); int* TOKL = (int*)(a.ws + A_TOKL);
    const LAS float* wp[16];
#pragma unroll
    for (int e = 0; e < 16; ++e) { wp[e] = wT + e * 2048 + lane * 4; asm volatile("" : "+v"(wp[e])); }
    const float rbl = a.in[I_RB][lane >> 2];
    int lr = wave;
    for (int m = blockIdx.x * 8 + wave; m < T; m += gridDim.x * 8, lr += 8) {
        const int b = m / SEQ; const float* sh = MODl + (size_t)b * 12288 + 3 * 2048; const float* sc = sh + 2048;
        f32x4 v[8]; float s = 0.f;
#pragma unroll
        for (int j = 0; j < 8; ++j) { const u32x2 xp = *(const GAS u32x2*)(XPRE + (size_t)m * D + (lane + 64 * j) * 4); v[j] = (f32x4){bflo(xp.x), bfhi(xp.x), bflo(xp.y), bfhi(xp.y)}; s += (v[j].x + v[j].y) + (v[j].z + v[j].w); }
        const float mean = wave_sum(s) * (1.f / D); float s2 = 0.f;
#pragma unroll
        for (int j = 0; j < 8; ++j) { v[j] = v[j] - mean; s2 += (v[j].x * v[j].x + v[j].y * v[j].y) + (v[j].z * v[j].z + v[j].w * v[j].w); }
        const float rstd = rsqrtf(wave_sum(s2) * (1.f / D) + LN_EPS);
#pragma unroll
        for (int j = 0; j < 8; ++j) { const int col = (lane + 64 * j) * 4; const f32x4 x1 = v[j] * rstd * *(const f32x4*)(lg + col) + *(const f32x4*)(lb + col);
            { u32x2 ox = {pk2(x1.x, x1.y), pk2(x1.z, x1.w)}; *(GAS u32x2*)(X1 + (size_t)m * D + col) = ox; }
            const f32x4 hv = x1 * (*(const f32x4*)(sc + col) + 1.f) + *(const f32x4*)(sh + col);
            *(GAS unsigned*)((unsigned char*)H + (size_t)m * D + col) = pk4_fp8(hv.x, hv.y, hv.z, hv.w); v[j] = hv; }
        f32x2 part2[16];
#pragma unroll
        for (int e = 0; e < 16; ++e) part2[e] = (f32x2){0.f, 0.f};
#pragma unroll
        for (int j = 0; j < 8; ++j) { f32x4 wr_[16];
#pragma unroll
            for (int e = 0; e < 16; ++e) wr_[e] = *(const LAS f32x4*)(wp[e] + j * 256);
            __builtin_amdgcn_sched_barrier(0);
#pragma unroll
            for (int e = 0; e < 16; ++e) { part2[e] += (f32x2){v[j].x, v[j].y} * (f32x2){wr_[e].x, wr_[e].y}; part2[e] += (f32x2){v[j].z, v[j].w} * (f32x2){wr_[e].z, wr_[e].w}; }
            __builtin_amdgcn_sched_barrier(0); }
        float part[16];
#pragma unroll
        for (int e = 0; e < 16; ++e) part[e] = part2[e].x + part2[e].y;
        float r8[8], r4[4], r2[2], lg1;
        { const bool hi = lane & 32;
#pragma unroll
          for (int i = 0; i < 8; ++i) { const float mine = hi ? part[8 + i] : part[i], oth = hi ? part[i] : part[8 + i]; r8[i] = mine + __shfl_xor(oth, 32); } }
        { const bool hi = lane & 16;
#pragma unroll
          for (int i = 0; i < 4; ++i) { const float mine = hi ? r8[4 + i] : r8[i], oth = hi ? r8[i] : r8[4 + i]; r4[i] = mine + __shfl_xor(oth, 16); } }
        { const bool hi = lane & 8;
#pragma unroll
          for (int i = 0; i < 2; ++i) { const float mine = hi ? r4[2 + i] : r4[i], oth = hi ? r4[i] : r4[2 + i]; r2[i] = mine + __shfl_xor(oth, 8); } }
        { const bool hi = lane & 4; const float mine = hi ? r2[1] : r2[0], oth = hi ? r2[0] : r2[1]; lg1 = mine + __shfl_xor(oth, 4); }
        lg1 += dpp_xor1(lg1); lg1 += dpp_xor2(lg1);
        const float sgl = 1.f / (1.f + expf(-lg1)), sbl = sgl + rbl;
        float gs; { const float y1 = dpp_ror<4>(sbl), y2 = dpp_ror<8>(sbl), y3 = dpp_ror<12>(sbl);
            gs = fmaxf(fmaxf(fmaxf(sbl + y1, sbl + y2), fmaxf(sbl + y3, y1 + y2)), fmaxf(y1 + y3, y2 + y3)); }
        int bg = 0; float bgs = __builtin_bit_cast(float, __builtin_amdgcn_readlane(__builtin_bit_cast(int, gs), 0)); asm volatile("" : "+v"(bgs));
#pragma unroll
        for (int g = 1; g < 4; ++g) { float x = __builtin_bit_cast(float, __builtin_amdgcn_readlane(__builtin_bit_cast(int, gs), 16 * g)); asm volatile("" : "+v"(x)); const bool c = x > bgs; bgs = c ? x : bgs; bg = c ? g : bg; }
        const int bgu = __builtin_amdgcn_readfirstlane(bg);
        int e0 = 0, e1 = 0; float b0 = -1e30f, b1 = -1e30f, s0 = 0.f, s1 = 0.f;
#pragma unroll
        for (int i = 0; i < 4; ++i) { float x = __builtin_bit_cast(float, __builtin_amdgcn_readlane(__builtin_bit_cast(int, sbl), 16 * bgu + 4 * i)), sx = __builtin_bit_cast(float, __builtin_amdgcn_readlane(__builtin_bit_cast(int, sgl), 16 * bgu + 4 * i));
            asm volatile("" : "+v"(x), "+v"(sx)); const int e = 4 * bg + i; const bool g0 = x > b0, g1 = x > b1;
            b1 = g0 ? b0 : (g1 ? x : b1); e1 = g0 ? e0 : (g1 ? e : e1); s1 = g0 ? s0 : (g1 ? sx : s1);
            b0 = g0 ? x : b0; e0 = g0 ? e : e0; s0 = g0 ? sx : s0; }
        if (lane == 0) { const float inv = 1.f / (s0 + s1);
            const int p0 = __hip_atomic_fetch_add(lcnt + e0, 1, __ATOMIC_RELAXED, __HIP_MEMORY_SCOPE_WORKGROUP), p1 = __hip_atomic_fetch_add(lcnt + e1, 1, __ATOMIC_RELAXED, __HIP_MEMORY_SCOPE_WORKGROUP);
            rec[lr * 4] = m; rec[lr * 4 + 1] = e0; rec[lr * 4 + 2] = e1; rec[lr * 4 + 3] = p0 | (p1 << 16);
            RTE[2 * m] = e0; RTE[2 * m + 1] = e1; RTW[2 * m] = s0 * inv; RTW[2 * m + 1] = s1 * inv; }
    }
    __syncthreads();
    if (tid < 16) lbase[tid] = (int)atomicAdd(cnt + tid * 64, (unsigned)lcnt[tid]);
    __syncthreads();
    const int nrows = (T - (int)blockIdx.x * 8 + (int)gridDim.x * 8 - 1) / ((int)gridDim.x * 8) * 8;
    for (int i = tid; i < nrows; i += 512) { const int k = i >> 3, w8 = i & 7, m = (int)blockIdx.x * 8 + w8 + k * (int)gridDim.x * 8;
        if (m < T) { const int e0 = rec[i * 4 + 1], e1 = rec[i * 4 + 2], pp = rec[i * 4 + 3], q0 = lbase[e0] + (pp & 0xffff), q1 = lbase[e1] + (pp >> 16);
            TOKL[e0 * T + q0] = m; TOKL[e1 * T + q1] = m; RTP[2 * m] = q0; RTP[2 * m + 1] = q1; } }
    __syncthreads();
}

DI void moe_table(const KArgs& a, LAS unsigned char* lds, int layer, int wv) {
    LAS int* tab = (LAS int*)(lds + LDS_TAB);
    if (otid(wv) == 0) { const unsigned* cnt = (const unsigned*)(a.ws + CTL_CNT) + layer * 16 * 64; int acc = 0;
        for (int e = 0; e < 16; ++e) { const int c = (int)cnt[e * 64]; tab[e] = acc; tab[32 + e] = c; acc += (c + 255) >> 8; } tab[16] = acc; }
    __syncthreads();
}
template <int NTB> struct MoeOrder {
    int G, c, layer; const LAS int* tab; const int* tokl;
    DI bool next(int i, Unit& u) const { const int L = i * G + c, mt = L / NTB, nt = L % NTB; if (mt >= tab[16]) return false; int e = 0;
#pragma unroll
        for (int k = 1; k < 16; ++k) e += (mt >= tab[k]) ? 1 : 0;
        u.pm = mt; u.pn = (layer * 16 + e) * NTB + nt; u.aux = e | (nt << 8) | ((mt - tab[e]) << 16); return true; }
    DI int arow(const Unit& u, int r) const { const int e = u.aux & 255, j = (u.aux >> 16) * 256 + r; return j < tab[32 + e] ? tokl[e * T + j] : 0; }
    DI int koff(const Unit&) const { return 0; }
};
struct EpiGateUp { static constexpr bool PERM = true;
    unsigned char* ACT;
    DI void operator()(const Acc& acc, const Unit& u, int wr, int wc, int fr, int fq) const {
        const int nt = (u.aux >> 8) & 255;
        EPI_ROWS_BEGIN
            const f32x4 g0 = acc[ai][0][m][0], g1 = acc[ai][0][m][1], u0 = acc[ai][1][m][0], u1 = acc[ai][1][m][1];
            f32x4 o0, o1;
#pragma unroll
            for (int e = 0; e < 4; ++e) { o0[e] = g0[e] * sigmoidf_(g0[e]) * u0[e]; o1[e] = g1[e] * sigmoidf_(g1[e]) * u1[e]; }
            u32x2 o8 = {pk4_fp8(o0.x, o0.y, o0.z, o0.w), pk4_fp8(o1.x, o1.y, o1.z, o1.w)}; *(u32x2*)P32(ACT, row * 512 + nt * 128 + 32 * wc + 8 * fq) = o8;
        EPI_ROWS_END
    }
};
struct EpiDown { static constexpr bool PERM = true;
    bf16* YS;
    DI void operator()(const Acc& acc, const Unit& u, int wr, int wc, int fr, int fq) const {
        const int nt = (u.aux >> 8) & 255;
        EPI_ROWS_BEGIN
#pragma unroll
            for (int bj = 0; bj < 2; ++bj) *(u32x4*)P32(YS, row * 2048 + nt * 256 + 128 * bj + 32 * wc + 8 * fq) = pack8(acc[ai][bj][m][0], acc[ai][bj][m][1]);
        EPI_ROWS_END
    }
};
DI void ln_ffn_phase(const KArgs& a, int layer, const bf16* X1, float* XO, bf16* Hn, int wv) {
    const int lane = otid(wv) & 63, wave = otid(wv) >> 6;
    const float* MODl = (const float*)(a.ws + CTL_MOD) + (size_t)layer * 4 * 12288; const float* MODn = MODl + 4 * 12288;
    const float* lg = a.in[I_LNFG] + layer * D; const float* lb = a.in[I_LNFB] + layer * D;
    const unsigned* cnt = (const unsigned*)(a.ws + CTL_CNT) + layer * 16 * 64;
    const int* RTE = (const int*)(a.ws + A_RT); const int* RTP = RTE + 2 * T; const float* RTW = (const float*)(RTP + 2 * T); const bf16* YS = (const bf16*)(a.ws + A_YS);
    for (int m = blockIdx.x * 8 + wave; m < T; m += gridDim.x * 8) {
        const int b = m / SEQ; const float* gf = MODl + (size_t)b * 12288 + 5 * 2048;
        const int e0 = RTE[2 * m], e1 = RTE[2 * m + 1]; int t0 = 0, t1 = 0;
        for (int e = 0; e < 16; ++e) { const int tl = ((int)cnt[e * 64] + 255) >> 8; t0 += e < e0 ? tl : 0; t1 += e < e1 ? tl : 0; }
        const bf16* y0 = YS + ((size_t)t0 * 256 + RTP[2 * m]) * 2048; const bf16* y1 = YS + ((size_t)t1 * 256 + RTP[2 * m + 1]) * 2048; const float w0 = RTW[2 * m], w1 = RTW[2 * m + 1];
        f32x4 v[8]; float s = 0.f;
#pragma unroll
        for (int j = 0; j < 8; ++j) { const int col = (lane + 64 * j) * 4; const u32x2 a0 = *(const u32x2*)(y0 + col), a1 = *(const u32x2*)(y1 + col);
            const f32x4 y = {w0 * bflo(a0.x) + w1 * bflo(a1.x), w0 * bfhi(a0.x) + w1 * bfhi(a1.x), w0 * bflo(a0.y) + w1 * bflo(a1.y), w0 * bfhi(a0.y) + w1 * bfhi(a1.y)};
            const u32x2 xq = *(const u32x2*)(X1 + (size_t)m * D + col); const f32x4 xv = {bflo(xq.x), bfhi(xq.x), bflo(xq.y), bfhi(xq.y)};
            v[j] = xv * DN_ALPHA + (*(const f32x4*)(gf + col) + 1.f) * y; s += (v[j].x + v[j].y) + (v[j].z + v[j].w); }
        const float mean = wave_sum(s) * (1.f / D); float s2 = 0.f;
#pragma unroll
        for (int j = 0; j < 8; ++j) { v[j] = v[j] - mean; s2 += (v[j].x * v[j].x + v[j].y * v[j].y) + (v[j].z * v[j].z + v[j].w * v[j].w); }
        const float rstd = rsqrtf(wave_sum(s2) * (1.f / D) + LN_EPS);
#pragma unroll
        for (int j = 0; j < 8; ++j) { const int col = (lane + 64 * j) * 4; const f32x4 xo = v[j] * rstd * *(const f32x4*)(lg + col) + *(const f32x4*)(lb + col);
            if (Hn) { u32x2 oq = {pk2(xo.x, xo.y), pk2(xo.z, xo.w)}; *(u32x2*)((bf16*)XO + (size_t)m * D + col) = oq; }
            else *(f32x4*)(XO + (size_t)m * D + col) = xo;
            if (Hn) { const float* sh = MODn + (size_t)b * 12288; const f32x4 hv = xo * (*(const f32x4*)(sh + 2048 + col) + 1.f) + *(const f32x4*)(sh + col);
                *(unsigned*)((unsigned char*)Hn + (size_t)m * D + col) = pk4_fp8(hv.x, hv.y, hv.z, hv.w); } }
    }
}

struct EpiIn1 { static constexpr bool PERM = true;
    bf16 *ZD, *ZR;
    DI void operator()(const Acc& acc, const Unit& u, int wr, int wc, int fr, int fq) const {
        EPI_ROWS_BEGIN
#pragma unroll
            for (int bj = 0; bj < 2; ++bj) { const int col = u.pn * 256 + 128 * bj + 32 * wc + 8 * fq; const u32x4 o = pack8(acc[ai][bj][m][0], acc[ai][bj][m][1]);
                if (col < DIL_IN) *(u32x4*)P32(ZD, row * DIL_IN + col) = o; else if (col < ODD_IN) *(u32x4*)P32(ZR, row * RW_IN + (col - DIL_IN)) = o; }
        EPI_ROWS_END
    }
};
constexpr int DA_KSTR = 272, DA_VROW = 320, DA_KBYTES = 64 * DA_KSTR, DA_STG = DA_KBYTES + 64 * DA_VROW;
struct DilPre { bf16x8 qf[4]; u32x4 kreg[2], vreg[2]; float blv[2]; };
DI void dil_issue(const bf16* ZD, const float* BL, int unit, int wv, DilPre& P) {
    const int tid = otid(wv), lane = tid & 63, w = tid >> 6, r = lane & 31, hh = lane >> 5, hd = w >> 2, qs = w & 3;
    const int hp = unit & 3, sb_ = (unit >> 2) & 31, gi = (unit >> 7) % 3, b = unit / 384;
    const int dil = gi == 0 ? 1 : (gi == 1 ? 4 : 16), nb = 32 / dil, rr = sb_ / nb, n = sb_ % nb, h = hp * 2 + hd, kt0 = n == 0 ? 2 : 0;
    const bf16* Zb = ZD + (size_t)b * SEQ * DIL_IN + gi * 1536;
    const int qtok = (n * 128 + 32 * qs + r) * dil + rr;
#pragma unroll
    for (int k = 0; k < 2; ++k) { const int i = tid + 512 * k, hd_ = i >= 384 ? 1 : 0, d = i - 384 * hd_ - 127;
        P.blv[k] = (i < 768 && d >= 0 && d <= 128) ? ((const GAS float*)BL)[(gi * 8 + hp * 2 + hd_) * 132 + d] : -1e30f; }
#pragma unroll
    for (int ks = 0; ks < 4; ++ks) P.qf[ks] = *(const GAS bf16x8*)P32(Zb, qtok * DIL_IN + h * 64 + 16 * ks + 8 * hh);
#pragma unroll
    for (int i = 0; i < 2; ++i) { const int p = tid + 512 * i, kr = p >> 4, c16 = p & 15; const int ktok = ((n - 1) * 128 + kt0 * 64 + kr) * dil + rr;
        P.kreg[i] = *(const GAS u32x4*)P32(Zb, ktok * DIL_IN + 512 + hp * 128 + c16 * 8); P.vreg[i] = *(const GAS u32x4*)P32(Zb, ktok * DIL_IN + 1024 + hp * 128 + c16 * 8); }
}
DI void dil_attn_unit(LAS unsigned char* lds, const bf16* ZD, const float* BL, bf16* DPO, float* DPM, float* DPL, int unit, int next, DilPre& P, int wv) {
    const int tid = otid(wv), lane = tid & 63, w = tid >> 6, r = lane & 31, hh = lane >> 5, hd = w >> 2, qs = w & 3;
    const int hp = unit & 3, sb_ = (unit >> 2) & 31, gi = (unit >> 7) % 3, b = unit / 384;
    const int dil = gi == 0 ? 1 : (gi == 1 ? 4 : 16), nb = 32 / dil, rr = sb_ / nb, n = sb_ % nb;
    const int h = hp * 2 + hd;
    const bf16* Zb = ZD + (size_t)b * SEQ * DIL_IN + gi * 1536;
    LAS float* bl = (LAS float*)(lds + 2 * DA_STG);
    __syncthreads();
    bl[tid] = P.blv[0]; if (tid < 256) bl[512 + tid] = P.blv[1];
    const int qi = 32 * qs + r, qtok = (n * 128 + qi) * dil + rr;
    bf16x8 qf[4];
#pragma unroll
    for (int ks = 0; ks < 4; ++ks) qf[ks] = P.qf[ks];
    f32x16 O[2];
#pragma unroll
    for (int i = 0; i < 2; ++i) for (int e = 0; e < 16; ++e) O[i][e] = 0.f;
    float mrow = -1e30f, lrow = 0.f;
    u32x4 kreg[2] = {P.kreg[0], P.kreg[1]}, vreg[2] = {P.vreg[0], P.vreg[1]};
    const int kt0 = n == 0 ? 2 : 0;
#define DA_LOAD(kt) do { _Pragma("unroll") for (int i = 0; i < 2; ++i) { const int p = tid + 512 * i, kr = p >> 4, c16 = p & 15; const int ktok = ((n - 1) * 128 + (kt) * 64 + kr) * dil + rr; \
            kreg[i] = *(const GAS u32x4*)P32(Zb, ktok * DIL_IN + 512 + hp * 128 + c16 * 8); } \
        _Pragma("unroll") for (int i = 0; i < 2; ++i) { const int p = tid + 512 * i, kr = p >> 4, c16 = p & 15; const int ktok = ((n - 1) * 128 + (kt) * 64 + kr) * dil + rr; vreg[i] = *(const GAS u32x4*)P32(Zb, ktok * DIL_IN + 1024 + hp * 128 + c16 * 8); } } while (0)
#define DA_STORE(buf) do { LAS unsigned char* sb = lds + (buf) * DA_STG; _Pragma("unroll") for (int i = 0; i < 2; ++i) { const int p = tid + 512 * i, kr = p >> 4, c16 = p & 15; *(LAS u32x4*)(sb + kr * DA_KSTR + c16 * 16) = kreg[i]; } \
        _Pragma("unroll") for (int i = 0; i < 2; ++i) { const int p = tid + 512 * i; *(LAS u32x4*)(sb + DA_KBYTES + (p >> 4) * DA_VROW + (p & 15) * 16) = vreg[i]; } } while (0)
    DA_STORE(kt0 & 1);
    __syncthreads();
    for (int kt = kt0; kt < 4; ++kt) {
        if (kt + 1 < 4) DA_LOAD(kt + 1); else if (next >= 0) dil_issue(ZD, BL, next, wv, P);
        const LAS unsigned char* sb = lds + (kt & 1) * DA_STG;
        if (64 * kt + 63 >= 32 * qs && 64 * kt <= 32 * qs + 31 + 128) {
            f32x16 st[2];
#pragma unroll
            for (int mt = 0; mt < 2; ++mt) for (int e = 0; e < 16; ++e) st[mt][e] = 0.f;
            __builtin_amdgcn_sched_barrier(0);
            {
                const LAS unsigned char* kb = sb + r * DA_KSTR + (hd * 64 + 8 * hh) * 2; bf16x8 kf[8];
#pragma unroll
                for (int i = 0; i < 8; ++i) kf[i] = *(const LAS bf16x8*)(kb + 32 * (i & 1) * DA_KSTR + 32 * (i >> 1));
#pragma unroll
                for (int i = 0; i < 8; ++i) st[i & 1] = MFMA32(kf[i], qf[i >> 1], st[i & 1]);
                __builtin_amdgcn_sched_group_barrier(0x100, 3, 0);
#pragma unroll
                for (int i = 0; i < 8; ++i) { __builtin_amdgcn_sched_group_barrier(0x008, 1, 0); __builtin_amdgcn_sched_group_barrier(0x100, 1, 0); }
            }
            __builtin_amdgcn_sched_barrier(0);
#pragma unroll
            for (int mt = 0; mt < 2; ++mt) { const LAS float* lp = bl + hd * 384 + 127 + (128 + qi - 64 * kt - 32 * mt - 4 * hh) - 27;
#pragma unroll
                for (int e = 0; e < 16; ++e) st[mt][e] = st[mt][e] * (0.125f * 1.44269504089f) + lp[27 - ((e & 3) + 8 * (e >> 2))]; }
            float mx = st[0][0];
#pragma unroll
            for (int mt = 0; mt < 2; ++mt)
#pragma unroll
                for (int e = 0; e < 16; ++e) mx = fmaxf(mx, st[mt][e]);
            mx = fmaxf(mx, __shfl_xor(mx, 32));
            const float mnew = fmaxf(mrow, mx), alpha = __builtin_amdgcn_exp2f(mrow - mnew); mrow = mnew;
            float ls = 0.f;
#pragma unroll
            for (int mt = 0; mt < 2; ++mt)
#pragma unroll
                for (int e = 0; e < 16; ++e) { const float p = __builtin_amdgcn_exp2f(st[mt][e] - mnew); st[mt][e] = p; ls += p; }
            lrow = lrow * alpha + ls;
            if (__any(alpha != 1.f)) { O[0] *= alpha; O[1] *= alpha; }
            bf16x8 pf[2][2];
#pragma unroll
            for (int mt = 0; mt < 2; ++mt)
#pragma unroll
                for (int s = 0; s < 2; ++s) { u32x4 pk = {pk2(st[mt][8 * s], st[mt][8 * s + 1]), pk2(st[mt][8 * s + 2], st[mt][8 * s + 3]), pk2(st[mt][8 * s + 4], st[mt][8 * s + 5]), pk2(st[mt][8 * s + 6], st[mt][8 * s + 7])};
                    pf[mt][s] = __builtin_bit_cast(bf16x8, pk); }
            __builtin_amdgcn_sched_barrier(0);
            {
                const LAS unsigned char* vb = sb + DA_KBYTES + (4 * hh + ((lane >> 2) & 3)) * DA_VROW + (hd * 64 + 16 * ((lane >> 4) & 1)) * 2 + 8 * (lane & 3); bf16x8 af[8];
#pragma unroll
                for (int i = 0; i < 8; ++i) { const LAS unsigned char* vp = vb + 16 * (i >> 1) * DA_VROW + (i & 1) * 64;
                    const s16x4 lo = __builtin_amdgcn_ds_read_tr16_b64_v4i16((LAS s16x4*)vp), hi = __builtin_amdgcn_ds_read_tr16_b64_v4i16((LAS s16x4*)(vp + 8 * DA_VROW)); af[i] = __builtin_shufflevector(lo, hi, 0, 1, 2, 3, 4, 5, 6, 7); }
#pragma unroll
                for (int i = 0; i < 8; ++i) O[i & 1] = MFMA32(af[i], pf[i >> 2][(i >> 1) & 1], O[i & 1]);
                __builtin_amdgcn_sched_group_barrier(0x100, 6, 0);
#pragma unroll
                for (int i = 0; i < 8; ++i) { __builtin_amdgcn_sched_group_barrier(0x008, 1, 0); __builtin_amdgcn_sched_group_barrier(0x100, 2, 0); }
            }
            __builtin_amdgcn_sched_barrier(0);
        }
        if (kt + 1 < 4) DA_STORE((kt + 1) & 1);
        __syncthreads();
    }
    lrow += __shfl_xor(lrow, 32);
    const float inv = 1.f / lrow;
    const int tokg = b * SEQ + qtok;
    bf16* orow = P32(DPO, (gi * T + tokg) * 512 + h * 64);
#pragma unroll
    for (int dvt = 0; dvt < 2; ++dvt)
#pragma unroll
        for (int g4 = 0; g4 < 4; ++g4) { u32x2 o = {pk2(O[dvt][4 * g4] * inv, O[dvt][4 * g4 + 1] * inv), pk2(O[dvt][4 * g4 + 2] * inv, O[dvt][4 * g4 + 3] * inv)};
            *(GAS u32x2*)(orow + dvt * 32 + 8 * g4 + 4 * hh) = o; }
    if (hh == 0) { *(GAS float*)P32(DPM, (gi * T + tokg) * 8 + h) = mrow; *(GAS float*)P32(DPL, (gi * T + tokg) * 8 + h) = lrow; }
#undef DA_LOAD
#undef DA_STORE
}
DI void dil_merge(const bf16* DPO, const float* DPM, const float* DPL, bf16* MIX, int wv) {
    const int gt = blockIdx.x * 512 + otid(wv), NT_ = gridDim.x * 512;
    for (int i = gt; i < T * 64; i += NT_) { const int tok = i >> 6, c8 = i & 63, h = c8 >> 3;
        float m[3], l[3];
#pragma unroll
        for (int g = 0; g < 3; ++g) { m[g] = DPM[((size_t)g * T + tok) * 8 + h]; l[g] = DPL[((size_t)g * T + tok) * 8 + h]; }
        const float M = fmaxf(m[0], fmaxf(m[1], m[2])); float wsum = 0.f, wg[3];
#pragma unroll
        for (int g = 0; g < 3; ++g) { wg[g] = exp2f(m[g] - M) * l[g]; wsum += wg[g]; }
        const float inv = 1.f / wsum; float o[8];
#pragma unroll
        for (int e = 0; e < 8; ++e) o[e] = 0.f;
#pragma unroll
        for (int g = 0; g < 3; ++g) { const u32x4 v = *(const u32x4*)(DPO + ((size_t)g * T + tok) * 512 + c8 * 8); const float wn = wg[g] * inv;
            o[0] += wn * bflo(v.x); o[1] += wn * bfhi(v.x); o[2] += wn * bflo(v.y); o[3] += wn * bfhi(v.y); o[4] += wn * bflo(v.z); o[5] += wn * bfhi(v.z); o[6] += wn * bflo(v.w); o[7] += wn * bfhi(v.w); }
        u32x2 r = {pk4_fp8(o[0], o[1], o[2], o[3]), pk4_fp8(o[4], o[5], o[6], o[7])}; *(u32x2*)((unsigned char*)MIX + (size_t)tok * 2048 + c8 * 8) = r; }
}

DI void rwkv_prep(const bf16* ZR, const float* mu, bf16* LIN, int wv) {
    const int gt = blockIdx.x * 512 + otid(wv), NT_ = gridDim.x * 512;
    for (int i = gt; i < T * 48; i += NT_) { const int tok = i / 48, c0 = (i % 48) * 8, s = tok % SEQ; float o[8];
        if (c0 < 352) { const u32x4 z = *(const u32x4*)(ZR + (size_t)tok * RW_IN + 4608 + c0); u32x4 zp = {0u, 0u, 0u, 0u}; if (s > 0) zp = *(const u32x4*)(ZR + (size_t)(tok - 1) * RW_IN + 4608 + c0);
            const unsigned* zz = (const unsigned*)&z; const unsigned* pp = (const unsigned*)&zp;
#pragma unroll
            for (int e = 0; e < 8; ++e) { const float zv = (e & 1) ? bfhi(zz[e >> 1]) : bflo(zz[e >> 1]), pv = (e & 1) ? bfhi(pp[e >> 1]) : bflo(pp[e >> 1]); const float xs = zv + (pv - zv) * mu[4608 + c0 + e];
                o[e] = c0 < 64 ? tanhf(xs) : (c0 < 128 ? xs : sigmoidf_(xs)); } }
        else {
#pragma unroll
            for (int e = 0; e < 8; ++e) o[e] = 0.f; }
        u32x4 r = {pk2(o[0], o[1]), pk2(o[2], o[3]), pk2(o[4], o[5]), pk2(o[6], o[7])}; *(u32x4*)(LIN + (size_t)tok * 384 + c0) = r; }
}
struct LoraOrder : pg8::StaticOrder { DI int koff(const Unit& u) const { return u.pn >= 12 ? 128 : 0; } };
struct EpiLora { static constexpr bool PERM = true;
    bf16 *WDEC, *AA, *GG; const float *w0, *a0;
    DI void operator()(const Acc& acc, const Unit& u, int wr, int wc, int fr, int fq) const {
        const int kind = u.pn / 6;
        EPI_ROWS_BEGIN
#pragma unroll
            for (int bj = 0; bj < 2; ++bj) { const int col = (u.pn % 6) * 256 + 128 * bj + 32 * wc + 8 * fq; f32x4 v0 = acc[ai][bj][m][0], v1 = acc[ai][bj][m][1];
                if (kind == 0) { const f32x4 b0 = *(const f32x4*)P32(w0, col), b1 = *(const f32x4*)P32(w0, col + 4);
#pragma unroll
                    for (int e = 0; e < 4; ++e) { v0[e] = -0.6065306597f * sigmoidf_(v0[e] + b0[e]); v1[e] = -0.6065306597f * sigmoidf_(v1[e] + b1[e]); }
                    *(u32x4*)P32(WDEC, row * RWW + col) = pack8(v0, v1); }
                else if (kind == 1) { const f32x4 b0 = *(const f32x4*)P32(a0, col), b1 = *(const f32x4*)P32(a0, col + 4);
#pragma unroll
                    for (int e = 0; e < 4; ++e) { v0[e] = sigmoidf_(v0[e] + b0[e]); v1[e] = sigmoidf_(v1[e] + b1[e]); }
                    *(u32x4*)P32(AA, row * RWW + col) = pack8(v0, v1); }
                else *(u32x4*)P32(GG, row * RWW + col) = pack8(v0, v1); }
        EPI_ROWS_END
    }
};
constexpr int CK_AT = 0, CK_RT = 2048, CK_BH = 4096, CK_KH = 6144, CK_MT = 8192, CK_NK = 8704, CK_PB = 9216, CK_PK = 9728, CK_G15 = 10240, CK_VT = 10496  , CK_VTS = 40, CK_BS = 13056  , CK_SLOT = 13120;
constexpr int CK_HALF = 128;
constexpr int CK_N1 = (int)((128 * MiB) / CK_SLOT) - 1;
DI unsigned char* ck_slot(unsigned char* ws, int job) { return job < CK_N1 ? ws + WS_X1 + (size_t)job * CK_SLOT : ws + WS_W_GU + (size_t)(job - CK_N1) * CK_SLOT; }
static_assert((size_t)(96 * CK_HALF - CK_N1 + 1) * CK_SLOT <= 64 * MiB, "chunk buffer");
constexpr int PJ = 4;
constexpr int PL_AT = 0, PL_BT = 2304, PL_KT = 4608, PL_RT = 6912, PL_BH = 9216, PL_KH = 11520  ,
              PL_NAB = 13824  , PL_MTS = 14848  , PL_LDT = 15616  , PL_C = 19968  ,
              PL_T = 24064  , PL_VT = 24320  , PL_END = 26880;
static_assert(PJ * PL_END <= RING_BYTES && PJ == 4, "prep LDS");
DI bf16x8 ldfrag(const LAS unsigned char* p) { return *(const LAS bf16x8*)p; }
DI u32x4 ld2x8(const LAS unsigned char* p0, const LAS unsigned char* p1) { const u32x2 lo = *(const LAS u32x2*)p0, hi = *(const LAS u32x2*)p1; return (u32x4){lo.x, lo.y, hi.x, hi.y}; }
DI void unpk8(const u32x4 v, float (&o)[8]) { o[0] = bflo(v.x); o[1] = bfhi(v.x); o[2] = bflo(v.y); o[3] = bfhi(v.y); o[4] = bflo(v.z); o[5] = bfhi(v.z); o[6] = bflo(v.w); o[7] = bfhi(v.w); }
DI void ldf8(const float* p, float (&o)[8]) { const f32x4 x = *(const f32x4*)p, y = *(const f32x4*)(p + 4); o[0] = x.x; o[1] = x.y; o[2] = x.z; o[3] = x.w; o[4] = y.x; o[5] = y.y; o[6] = y.z; o[7] = y.w; }
DI u32x4 pack8(const float (&x)[8]) { return (u32x4){pk2(x[0], x[1]), pk2(x[2], x[3]), pk2(x[4], x[5]), pk2(x[6], x[7])}; }
DI void rwkv_chunk_prep(const KArgs& a, LAS unsigned char* lds0, int half, int wv) {
    const int tid = otid(wv), lane = tid & 63, w = tid >> 6;
    const bf16* ZR = (const bf16*)(a.ws + A_ZR); const bf16* WDEC = (const bf16*)(a.ws + A_WDEC); const bf16* AA = (const bf16*)(a.ws + A_AA);
    const int js = tid >> 7, st = (tid >> 3) & 15, oc = tid & 7;
    LAS unsigned char* ldj = lds0 + js * PL_END;
    const float* mu = a.in[I_MU];
    bf16x8 lfrag;
#pragma unroll
    for (int j = 0; j < 8; ++j) lfrag[j] = ((lane & 31) >= 16 || 8 * (lane >> 5) + j <= (lane & 31)) ? (short)0x3F80 : (short)0;
    for (int it = blockIdx.x; it < 96 * CK_HALF / PJ; it += gridDim.x) {
        const int job0 = it * PJ, bh = job0 / CK_HALF, cl0 = job0 % CK_HALF, b = bh / 24, h = bh % 24, col = h * 64 + 8 * oc;
        const int s = (half * CK_HALF + cl0 + js) * 16 + st; const size_t tok = (size_t)b * SEQ + s;
        unsigned char* slot = ck_slot(a.ws, job0 + js);
        const bf16* z = ZR + tok * RW_IN + col;
        const u32x4 zr = *(const u32x4*)z, zk = *(const u32x4*)(z + 1536), zv = *(const u32x4*)(z + 3072);
        u32x4 pr = {0u, 0u, 0u, 0u}, pk_ = {0u, 0u, 0u, 0u}, pv = {0u, 0u, 0u, 0u};
        if (s > 0) { pr = *(const u32x4*)(z - RW_IN); pk_ = *(const u32x4*)(z - RW_IN + 1536); pv = *(const u32x4*)(z - RW_IN + 3072); }
        const u32x4 za = *(const u32x4*)(AA + tok * RWW + col), zw = *(const u32x4*)(WDEC + tok * RWW + col);
        float r[8], km[8], q[8], bb[8], ld[8];
        {   float cz[8], cp[8], m_[8], k_[8], v_[8], as_[8], c1[8], c2[8];
            unpk8(zr, cz); unpk8(pr, cp); ldf8(mu + col, m_);
#pragma unroll
            for (int e = 0; e < 8; ++e) r[e] = cz[e] + (cp[e] - cz[e]) * m_[e];
            unpk8(zk, cz); unpk8(pk_, cp); ldf8(mu + 1536 + col, m_);
#pragma unroll
            for (int e = 0; e < 8; ++e) k_[e] = cz[e] + (cp[e] - cz[e]) * m_[e];
            unpk8(zv, cz); unpk8(pv, cp); ldf8(mu + 3072 + col, m_);
#pragma unroll
            for (int e = 0; e < 8; ++e) v_[e] = cz[e] + (cp[e] - cz[e]) * m_[e];
            unpk8(za, as_); unpk8(zw, ld); ldf8(a.in[I_KK] + col, c1);
            float nn = 0.f;
#pragma unroll
            for (int e = 0; e < 8; ++e) { q[e] = k_[e] * c1[e]; nn += q[e] * q[e]; }
            nn = red8(nn);
            const float invn = fminf(__builtin_amdgcn_rsqf(nn), 1e12f);
            ldf8(a.in[I_KA] + col, c1); ldf8(a.in[I_RK] + col, c2);
            float bs = 0.f;
#pragma unroll
            for (int e = 0; e < 8; ++e) { q[e] *= invn; km[e] = k_[e] * (1.f + (as_[e] - 1.f) * c1[e]); bb[e] = q[e] * as_[e]; bs += r[e] * km[e] * c2[e]; }
            bs = red8(bs);
            if (oc == 0) *(float*)(slot + CK_BS + st * 4) = bs;
#pragma unroll
            for (int e = 0; e < 8; ++e) *(LAS float*)(ldj + PL_LDT + ((8 * oc + e) * 17 + st) * 4) = ld[e];
#pragma unroll
            for (int e = 0; e < 8; e += 2) { const unsigned pv2 = pk2(v_[e], v_[e + 1]);
                *(LAS bf16*)(ldj + PL_VT + (8 * oc + e) * CK_VTS + st * 2) = (bf16)(pv2 & 0xffffu); *(LAS bf16*)(ldj + PL_VT + (8 * oc + e + 1) * CK_VTS + st * 2) = (bf16)(pv2 >> 16); } }
        __syncthreads();
        {
            LAS unsigned char* lds = lds0 + (w >> 1) * PL_END; const int r_ = lane & 31, hh = lane >> 5, ch = 32 * (w & 1) + r_;
            float x[8];
#pragma unroll
            for (int j = 0; j < 8; ++j) x[j] = *(const LAS float*)(lds + PL_LDT + (ch * 17 + 8 * hh + j) * 4);
            const u32x4 ph = {pk2(x[0], x[1]), pk2(x[2], x[3]), pk2(x[4], x[5]), pk2(x[6], x[7])};
            const u32x4 pl = {pk2(x[0] - bflo(ph.x), x[1] - bfhi(ph.x)), pk2(x[2] - bflo(ph.y), x[3] - bfhi(ph.y)), pk2(x[4] - bflo(ph.z), x[5] - bfhi(ph.z)), pk2(x[6] - bflo(ph.w), x[7] - bfhi(ph.w))};
            f32x16 cs; for (int e = 0; e < 16; ++e) cs[e] = 0.f;
            cs = MFMA32(lfrag, __builtin_bit_cast(bf16x8, ph), cs); cs = MFMA32(lfrag, __builtin_bit_cast(bf16x8, pl), cs);
#pragma unroll
            for (int e = 0; e < 8; ++e) *(LAS float*)(lds + PL_C + (((e & 3) + 8 * (e >> 2) + 4 * hh) * 64 + ch) * 4) = cs[e];
            if (hh == 0) *(LAS float*)(lds + PL_T + ch * 4) = cs[8]; }
        __syncthreads();
        {
            float c[8], t[8];
            { const f32x4 ca = *(const LAS f32x4*)(ldj + PL_C + (st * 64 + 8 * oc) * 4), cb = *(const LAS f32x4*)(ldj + PL_C + (st * 64 + 8 * oc + 4) * 4), ta = *(const LAS f32x4*)(ldj + PL_T + 8 * oc * 4), tb = *(const LAS f32x4*)(ldj + PL_T + (8 * oc + 4) * 4);
              c[0] = ca.x; c[1] = ca.y; c[2] = ca.z; c[3] = ca.w; c[4] = cb.x; c[5] = cb.y; c[6] = cb.z; c[7] = cb.w; t[0] = ta.x; t[1] = ta.y; t[2] = ta.z; t[3] = ta.w; t[4] = tb.x; t[5] = tb.y; t[6] = tb.z; t[7] = tb.w; }
            float at[8], bt[8], kt[8], rt[8], bhv[8], khv[8];
#pragma unroll
            for (int e = 0; e < 8; ++e) { const float g = __expf(c[e]), gp = __expf(c[e] - ld[e]), gi = __expf(-c[e]), gr = __expf(t[e] - c[e]);
                at[e] = -q[e] * gp; bt[e] = bb[e] * gi; kt[e] = km[e] * gi; rt[e] = r[e] * g; bhv[e] = bb[e] * gr; khv[e] = km[e] * gr; }
            LAS unsigned char* row = ldj + st * 144 + oc * 16;
            *(LAS u32x4*)(row + PL_AT) = pack8(at); *(LAS u32x4*)(row + PL_BT) = pack8(bt); *(LAS u32x4*)(row + PL_KT) = pack8(kt); *(LAS u32x4*)(row + PL_RT) = pack8(rt);
            *(LAS u32x4*)(row + PL_BH) = pack8(bhv); *(LAS u32x4*)(row + PL_KH) = pack8(khv);
            if (st == 0) { *(f32x4*)(slot + CK_G15 + 8 * oc * 4) = (f32x4){__expf(t[0]), __expf(t[1]), __expf(t[2]), __expf(t[3])}; *(f32x4*)(slot + CK_G15 + (8 * oc + 4) * 4) = (f32x4){__expf(t[4]), __expf(t[5]), __expf(t[6]), __expf(t[7])}; } }
        __syncthreads();
        if (w < PJ) {
            LAS unsigned char* lds = lds0 + w * PL_END; unsigned char* slot = ck_slot(a.ws, job0 + w); const int r = lane & 31, hh = lane >> 5, r16 = r & 15;
            f32x16 d; for (int e = 0; e < 16; ++e) d[e] = 0.f;
#pragma unroll
            for (int ks = 0; ks < 4; ++ks) d = MFMA32(ldfrag(lds + (r < 16 ? PL_BT : PL_KT) + r16 * 144 + ks * 32 + hh * 16), ldfrag(lds + (r < 16 ? PL_AT : PL_RT) + r16 * 144 + ks * 32 + hh * 16), d);
            float lo8[8], hi8[8];
#pragma unroll
            for (int e = 0; e < 8; ++e) { const int sr = (e & 3) + 8 * (e >> 2) + 4 * hh; const bool keep = r < 16 ? sr < r16 : sr <= r16; lo8[e] = keep ? d[e] : 0.f; hi8[e] = keep ? d[8 + e] : 0.f; }
            const u32x4 plo = {pk2(lo8[0], lo8[1]), pk2(lo8[2], lo8[3]), pk2(lo8[4], lo8[5]), pk2(lo8[6], lo8[7])}, phi = {pk2(hi8[0], hi8[1]), pk2(hi8[2], hi8[3]), pk2(hi8[4], hi8[5]), pk2(hi8[6], hi8[7])};
            if (r < 16) {
#pragma unroll
                for (int e = 0; e < 8; ++e) *(LAS float*)(lds + PL_NAB + (((e & 3) + 8 * (e >> 2) + 4 * hh) * 16 + r16) * 4) = lo8[e];
                *(u32x4*)(slot + CK_NK + (r16 + 16 * hh) * 16) = phi; }
            else { *(u32x4*)(slot + CK_PB + (r16 + 16 * hh) * 16) = plo; *(u32x4*)(slot + CK_PK + (r16 + 16 * hh) * 16) = phi; }
            asm volatile("s_waitcnt lgkmcnt(0)" ::: "memory");
            if (lane < 16) { float mr[16]; int ln = lane; asm volatile("" : "+v"(ln));
#pragma unroll
                for (int t = 0; t < 16; ++t) { float acc = (ln == t) ? 1.f : 0.f;
#pragma unroll
                    for (int u = 0; u < t; ++u) acc += mr[u] * *(const LAS float*)(lds + PL_NAB + (u * 16 + t) * 4);
                    mr[t] = acc; *(LAS bf16*)(lds + PL_MTS + t * 48 + lane * 2) = f2bf(acc); } }
            asm volatile("s_waitcnt lgkmcnt(0)" ::: "memory");
            if (r < 16) *(u32x4*)(slot + CK_MT + (r + 16 * hh) * 16) = ld2x8(lds + PL_MTS + r * 48 + 8 * hh, lds + PL_MTS + r * 48 + 16 + 8 * hh);
        } else {
            const int e2 = tid - 256;
#pragma unroll
            for (int q4 = 0; q4 < PJ; ++q4) { const LAS unsigned char* lds = lds0 + q4 * PL_END; unsigned char* slot = ck_slot(a.ws, job0 + q4);
                { const int arr = e2 >> 7, i7 = e2 & 127, ks = i7 >> 5, t = i7 & 15, hh = (i7 >> 4) & 1;
                  const LAS unsigned char* p = lds + (arr ? PL_RT : PL_AT) + t * 144 + (16 * ks + 4 * hh) * 2;
                  *(u32x4*)(slot + (arr ? CK_RT : CK_AT) + (ks * 32 + t + 16 * hh) * 16) = ld2x8(p, p + 16); }
                { const int arr = e2 >> 7, J = (e2 >> 6) & 1;
                  const LAS unsigned char* p = lds + (arr ? PL_KH : PL_BH) + (4 * (lane >> 5) + ((lane >> 2) & 3)) * 144 + (32 * J + 16 * ((lane >> 4) & 1)) * 2 + 8 * (lane & 3);
                  const s16x4 lo = __builtin_amdgcn_ds_read_tr16_b64_v4i16((LAS s16x4*)p), hi = __builtin_amdgcn_ds_read_tr16_b64_v4i16((LAS s16x4*)(p + 8 * 144));
                  *(bf16x8*)(slot + (arr ? CK_KH : CK_BH) + (J * 64 + lane) * 16) = __builtin_shufflevector(lo, hi, 0, 1, 2, 3, 4, 5, 6, 7); }
                if (e2 < 160) *(u32x4*)(slot + CK_VT + e2 * 16) = *(const LAS u32x4*)(lds + PL_VT + e2 * 16); }
        }
    }
    __syncthreads();
}
constexpr int RC_NS = 8, RC_SLOT = 15360, RC_GG = 13312, RC_AHEAD = 6, RC_Y = RC_NS * RC_SLOT;
static_assert(RC_Y + 8192 <= RING_BYTES && CK_SLOT <= RC_GG, "rwkv ring");
template <int PM = 0> DI void rwkv_chunk_rec(const KArgs& a, LAS unsigned char* lds, int unit, int half, int wv) {
    const int tid = otid(wv), lane = tid & 63, w = __builtin_amdgcn_readfirstlane(tid >> 6), r = lane & 31, hh = lane >> 5;
    const int b = unit / 24, h = unit % 24;
    float* GST = (float*)(a.ws + A_GST) + (size_t)unit * 4096;
    const unsigned char* GGb = a.ws + A_GG; bf16* MIX = (bf16*)(a.ws + WS_H);
#define RC_DMA(srcp, dstp) __builtin_amdgcn_global_load_lds((const unsigned*)(srcp), (LAS unsigned*)(dstp), 16, 0, 0)
#define RC_ISSUE(cc) do { if ((PM & 1) == 0 && (w == 4 || w == 5)) { const unsigned char* src = ck_slot(a.ws, unit * CK_HALF + (cc)) + lane * 16; LAS unsigned char* dst = lds + ((cc) % RC_NS) * RC_SLOT; \
        if (w == 4) { _Pragma("unroll") for (int i_ = 0; i_ < 8; ++i_) RC_DMA(src + i_ * 1024, dst + i_ * 1024); } \
        else { _Pragma("unroll") for (int i_ = 8; i_ < 13; ++i_) RC_DMA(src + i_ * 1024, dst + i_ * 1024); \
            const unsigned char* gsrc = GGb + ((size_t)b * SEQ + (half * CK_HALF + (cc)) * 16 + (lane >> 3)) * (RWW * 2) + h * 128 + (lane & 7) * 16; \
            RC_DMA(gsrc, dst + RC_GG); RC_DMA(gsrc + 8 * RWW * 2, dst + RC_GG + 1024); } } } while (0)
#define RC_BAR() do { asm volatile("s_waitcnt lgkmcnt(0)" ::: "memory"); __builtin_amdgcn_s_barrier(); asm volatile("" ::: "memory"); } while (0)
    const bool epi = (w & 2) != 0; const int et = 4 * ((w & 1) + 2 * (w >> 2)) + (lane >> 4), eiq = lane & 15, ecol = h * 64 + 4 * eiq;
    const f32x4 elg = *(const f32x4*)(a.in[I_LNXG] + ecol), elb = *(const f32x4*)(a.in[I_LNXB] + ecol);
#define RC_EPI(sp, Yp, tokv) do { const f32x4 y = *(const LAS f32x4*)((Yp) + et * 64 + 4 * eiq); const u32x2 gq = *(const LAS u32x2*)((sp) + RC_GG + et * 128 + eiq * 8); \
        const float bsv = *(const LAS float*)((sp) + CK_BS + et * 4); const LAS unsigned char* vq = (sp) + CK_VT + 4 * eiq * CK_VTS + et * 2; \
        const f32x4 v4 = {bflo(*(const LAS unsigned short*)vq), bflo(*(const LAS unsigned short*)(vq + CK_VTS)), bflo(*(const LAS unsigned short*)(vq + 2 * CK_VTS)), bflo(*(const LAS unsigned short*)(vq + 3 * CK_VTS))}; \
        const float mean = red16((y.x + y.y) + (y.z + y.w)) * (1.f / 64.f); const f32x4 d = y - mean; \
        const float rstd = rsqrtf(red16((d.x * d.x + d.y * d.y) + (d.z * d.z + d.w * d.w)) * (1.f / 64.f) + 64e-5f); \
        const f32x4 gg4 = {bflo(gq.x), bfhi(gq.x), bflo(gq.y), bfhi(gq.y)}, o = (d * rstd * elg + elb + v4 * bsv) * gg4; \
        if (PM == 0 || o.x == 1.2345f) *(unsigned*)((unsigned char*)MIX + (size_t)(tokv) * 2048 + 512 + ecol) = pk4_fp8(o.x, o.y, o.z, o.w); } while (0)
    f32x16 G0, G1;
#pragma unroll
    for (int e = 0; e < 16; ++e) { G0[e] = 0.f; G1[e] = 0.f; }
    if (half == 1 && w < 2) {
#pragma unroll
        for (int e = 0; e < 16; ++e) { G0[e] = GST[(w * 2 + 0) * 1024 + e * 64 + lane]; G1[e] = GST[(w * 2 + 1) * 1024 + e * 64 + lane]; } }
    __syncthreads();
#pragma unroll
    for (int cc = 0; cc < RC_AHEAD; ++cc) RC_ISSUE(cc);
    asm volatile("s_waitcnt vmcnt(0)" ::: "memory");
    RC_BAR();
    bf16x8 pAR[4], pNP, pVT;
#define RC_PRE(slotp) do { const LAS unsigned char* sp_ = (slotp); _Pragma("unroll") for (int ks = 0; ks < 4; ++ks) pAR[ks] = ldfrag(sp_ + ((r >> 4) ? CK_RT : CK_AT) + (ks * 32 + (r & 15) + 16 * hh) * 16); \
        pNP = ldfrag(sp_ + ((r >> 4) ? CK_PK : CK_NK) + ((r & 15) + 16 * hh) * 16); \
        { const LAS unsigned char* vq_ = sp_ + CK_VT + (32 * w + r) * CK_VTS + 8 * hh; const s16x4 vlo_ = *(const LAS s16x4*)vq_, vhi_ = *(const LAS s16x4*)(vq_ + 16); pVT = __builtin_shufflevector(vlo_, vhi_, 0, 1, 2, 3, 4, 5, 6, 7); } } while (0)
    if (w < 2) RC_PRE(lds);
    for (int c = 0; c < CK_HALF; ++c) {
        if (c + RC_AHEAD < CK_HALF) RC_ISSUE(c + RC_AHEAD);
        const LAS unsigned char* sb = lds + (c % RC_NS) * RC_SLOT;
        if (w < 2) {
            const int r16 = r & 15, up = r >> 4;
            bf16x8 fAR[4], fBH0, fBH1, fKH0, fKH1, fM, fNP, fPB; f32x4 gs0[4], gs1[4];
#pragma unroll
            for (int ks = 0; ks < 4; ++ks) fAR[ks] = pAR[ks];
            fNP = pNP; const bf16x8 vtf = pVT;
            __builtin_amdgcn_sched_barrier(0);
            fM = ldfrag(sb + CK_MT + (r16 + 16 * hh) * 16); fPB = ldfrag(sb + CK_PB + (r16 + 16 * hh) * 16);
            fBH0 = ldfrag(sb + CK_BH + lane * 16); fBH1 = ldfrag(sb + CK_BH + (64 + lane) * 16); fKH0 = ldfrag(sb + CK_KH + lane * 16); fKH1 = ldfrag(sb + CK_KH + (64 + lane) * 16);
#pragma unroll
            for (int g4 = 0; g4 < 4; ++g4) { gs0[g4] = *(const LAS f32x4*)(sb + CK_G15 + (8 * g4 + 4 * hh) * 4); gs1[g4] = *(const LAS f32x4*)(sb + CK_G15 + (32 + 8 * g4 + 4 * hh) * 4); }
            __builtin_amdgcn_sched_barrier(0);
            bf16x8 gf[4];
#pragma unroll
            for (int s2 = 0; s2 < 2; ++s2) { u32x4 p0 = {pk2(G0[8 * s2], G0[8 * s2 + 1]), pk2(G0[8 * s2 + 2], G0[8 * s2 + 3]), pk2(G0[8 * s2 + 4], G0[8 * s2 + 5]), pk2(G0[8 * s2 + 6], G0[8 * s2 + 7])};
                u32x4 p1 = {pk2(G1[8 * s2], G1[8 * s2 + 1]), pk2(G1[8 * s2 + 2], G1[8 * s2 + 3]), pk2(G1[8 * s2 + 4], G1[8 * s2 + 5]), pk2(G1[8 * s2 + 6], G1[8 * s2 + 7])};
                gf[s2] = __builtin_bit_cast(bf16x8, p0); gf[2 + s2] = __builtin_bit_cast(bf16x8, p1); }
            f32x16 XY;
#pragma unroll
            for (int e = 0; e < 16; ++e) XY[e] = 0.f;
#pragma unroll
            for (int ks = 0; ks < 4; ++ks) XY = MFMA32(fAR[ks], gf[ks], XY);
            XY = MFMA32(fNP, vtf, XY);
            { u32x4 px = {pk2(XY[0], XY[1]), pk2(XY[2], XY[3]), pk2(XY[4], XY[5]), pk2(XY[6], XY[7])}; const bf16x8 xf = __builtin_bit_cast(bf16x8, px);
              f32x16 U; for (int e = 0; e < 16; ++e) U[e] = 0.f;
              U = MFMA32(fM, xf, U);
              u32x4 pu = {pk2(U[0], U[1]), pk2(U[2], U[3]), pk2(U[4], U[5]), pk2(U[6], U[7])}; const bf16x8 uf = __builtin_bit_cast(bf16x8, pu);
              XY = MFMA32(fPB, uf, XY);
#pragma unroll
              for (int e = 0; e < 16; ++e) { G0[e] *= gs0[e >> 2][e & 3]; G1[e] *= gs1[e >> 2][e & 3]; }
              G0 = MFMA32(fBH0, uf, G0); G1 = MFMA32(fBH1, uf, G1); G0 = MFMA32(fKH0, vtf, G0); G1 = MFMA32(fKH1, vtf, G1); }
            __builtin_amdgcn_sched_barrier(0);
            if (c + 1 < CK_HALF) RC_PRE(lds + ((c + 1) % RC_NS) * RC_SLOT);
            LAS float* Y = (LAS float*)(lds + RC_Y + (c & 1) * 4096);
#pragma unroll
            for (int e = 0; e < 8; ++e) Y[((e & 3) + 8 * (e >> 2) + 4 * hh) * 64 + 32 * w + r] = XY[8 + e];
        } else if (epi) {
            if (c > 0) RC_EPI(lds + ((c - 1) % RC_NS) * RC_SLOT, (const LAS float*)(lds + RC_Y + ((c - 1) & 1) * 4096), (size_t)b * SEQ + (half * CK_HALF + c - 1) * 16 + et);
        } else {
            if (c + RC_AHEAD >= CK_HALF) asm volatile("s_waitcnt vmcnt(0)" ::: "memory"); else if (w == 4) asm volatile("s_waitcnt vmcnt(32)" ::: "memory"); else asm volatile("s_waitcnt vmcnt(28)" ::: "memory");
        }
        RC_BAR();
    }
    if (epi) RC_EPI(lds + ((CK_HALF - 1) % RC_NS) * RC_SLOT, (const LAS float*)(lds + RC_Y + ((CK_HALF - 1) & 1) * 4096), (size_t)b * SEQ + (half * CK_HALF + CK_HALF - 1) * 16 + et);
    else if (w < 2 && half == 0 && (PM == 0 || G0[0] == 1.2345f)) {
#pragma unroll
        for (int e = 0; e < 16; ++e) { GST[(w * 2 + 0) * 1024 + e * 64 + lane] = G0[e]; GST[(w * 2 + 1) * 1024 + e * 64 + lane] = G1[e]; } }
    asm volatile("s_waitcnt vmcnt(0)" ::: "memory");
    __syncthreads();
#undef RC_PRE
#undef RC_EPI
#undef RC_DMA
#undef RC_ISSUE
#undef RC_BAR
}

constexpr int N_PHASES = 25;
__global__ void __launch_bounds__(512, 2) fwd(KArgs a) {
    extern __shared__ __attribute__((aligned(16))) unsigned char lds_[];
    LAS unsigned char* lds = (LAS unsigned char*)lds_;
    const int wv = __builtin_amdgcn_readfirstlane((int)threadIdx.x >> 6), G = gridDim.x, bid = blockIdx.x;
    volatile LAS unsigned* MISC = (volatile LAS unsigned*)(lds + LDS_MISC);
    if (wv == 0) MISC[lane_id()] = 0u;
    __syncthreads();
    unsigned char* ws0 = a.ws;
#if N_LAUNCH_MODE == 0
    XcdBarrier bar = xcd_barrier_post((unsigned*)(ws0 + CTL_BAR), MISC + 8, wv);
#ifdef DBG_TIME_K1
#define SEAM(k) do { if (IN(k) && IN((k) + 1)) xcd_barrier(bar); if (bid == 0 && wv == 0 && lane_id() == 0) ((unsigned long long*)(ws0 + CTL_CHK))[1 + (k)] = __builtin_amdgcn_s_memrealtime(); } while (0)
#else
#define SEAM(k) do { if (IN(k) && IN((k) + 1)) xcd_barrier(bar); } while (0)
#endif
#else
#define SEAM(k) do { } while (0)
#endif
    const int lo = a.ph_lo, hi = a.ph_hi;
#ifdef DBG_TIME_K1
    if (bid == 0 && wv == 0 && lane_id() == 0) ((unsigned long long*)(ws0 + CTL_CHK))[0] = __builtin_amdgcn_s_memrealtime();
#endif
#ifndef PH_MASK
#define PH_MASK 0xFFFFFFFFu
#endif
#define IN(k) (((PH_MASK >> (k)) & 1u) && lo <= (k) && (k) < hi)
#ifndef REP_REC
#define REP_REC 0
#endif
#ifndef REP_DIL
#define REP_DIL 0
#endif
#ifndef REPEAT_MASK
#define REPEAT_MASK 0u
#endif
#define PH(k) for (int rp_ = 0; rp_ < (IN(k) ? 1 + (int)((REPEAT_MASK >> (k)) & 1u) : 0); ++rp_)
#define MOD ((float*)(ws + CTL_MOD))
#define Hb ((bf16*)(ws + WS_H))
#define X1 ((bf16*)(ws + WS_X1))
#define XPRE ((bf16*)(ws + A_XPRE))
    pg8::StaticOrder SO;

    PH(0) { unsigned char* ws = wsl(a.ws); p0_prologue(a, lds, wv); } SEAM(0);
    PH(1) { unsigned char* ws = wsl(a.ws); modulate_rows(a.in[I_X], (const unsigned long long*)(ws + CTL_MODI), MOD, Hb, wv); } SEAM(1);
    PH(2) { unsigned char* ws = wsl(a.ws); pg8::Gemm g{Hb, (const bf16*)(ws + WS_W_IN0), 2048, 2048, 2048}; SO.init(T, 2048, G, bid);
        EpiIn0 E{(bf16*)(ws + A_QC), (bf16*)(ws + A_KVC), (bf16*)(ws + A_KR), (bf16*)(ws + A_XH), (float*)(ws + CTL_SSQ)};
        pg8::gemm_phase<EpiIn0, pg8::StaticOrder, false, true>(lds, g, SO, E, wv); } SEAM(2);
    PH(3) { unsigned char* ws = wsl(a.ws);
        krope_pass((const bf16*)(ws + A_KR), (const float*)(ws + WS_ROPE), (bf16*)(ws + A_KF), wv);
        { pg8::Gemm g{(const bf16*)(ws + A_QC), (const bf16*)(ws + WS_W_UQ), 512, 512, 512}; SO.init(T, 1536, G, bid);
          EpiQ E{(bf16*)(ws + A_Q), (const float*)(ws + CTL_SSQ), (const float*)(ws + WS_ROPE)}; pg8::gemm_phase<EpiQ, pg8::StaticOrder, false>(lds, g, SO, E, wv); }
        { pg8::Gemm g{(const bf16*)(ws + A_KVC), (const bf16*)(ws + WS_W_UKV), 256, 256, 256}; SO.init(T, 2048, G, bid);
          EpiKV E{(bf16*)(ws + A_KF), (bf16*)(ws + A_V), (const float*)(ws + CTL_SSQ)}; pg8::gemm_phase<EpiKV, pg8::StaticOrder, false>(lds, g, SO, E, wv); }
        { pg8::Gemm g{(const bf16*)(ws + A_XH), (const bf16*)(ws + WS_S5BE), 384, 256, 256}; S5Order S{G, bid}; EpiS5E E{(float*)(ws + A_ES)}; pg8::gemm_phase<EpiS5E, S5Order, false>(lds, g, S, E, wv); }
    } SEAM(3);
    PH(4) { unsigned char* ws = wsl(a.ws);
        s5_carry((const float*)(ws + A_ES), (const float*)(ws + WS_S5L), (bf16*)(ws + A_XH), lds, wv);
        for (int u = bid; u < 256; u += G) mla_attn_unit(lds, (const bf16*)(ws + A_Q), (const bf16*)(ws + A_KF), (const bf16*)(ws + A_V), Hb, u, wv);
    } SEAM(4);
    PH(5) { unsigned char* ws = wsl(a.ws); pg8::Gemm g{(const bf16*)(ws + A_XH), (const bf16*)(ws + WS_S5BY), 384, 384, 384}; S5Order S{G, bid};
        EpiS5Y E{(bf16*)(ws + A_YS5), (const bf16*)(ws + A_XH), a.in[I_S5D]}; pg8::gemm_phase<EpiS5Y, S5Order, false>(lds, g, S, E, wv); } SEAM(5);
    PH(6) { unsigned char* ws = wsl(a.ws); pg8::Gemm g{(const bf16*)(ws + A_YS5), (const bf16*)(ws + WS_W_GLU), 1024, 1024, 1024}; SO.init(T, 1024, G, bid);
        EpiGlu E{Hb, (const bf16*)(ws + A_YS5)}; pg8::gemm_phase<EpiGlu, pg8::StaticOrder, false>(lds, g, SO, E, wv); } SEAM(6);
    PH(7) { unsigned char* ws = wsl(a.ws); pg8::Gemm g{Hb, (const bf16*)(ws + WS_W_OUT0), 2048, 2048, 2048}; SO.init(T, 2048, G, bid);
        EpiRes<false> E{XPRE, a.in[I_X], MOD + 2 * 2048}; pg8::gemm_phase<EpiRes<false>, pg8::StaticOrder, false, true>(lds, g, SO, E, wv); } SEAM(7);
#define MOE_PHASES(layer, pb) \
        PH(pb) { unsigned char* ws = wsl(a.ws); ln_router_phase(a, lds, layer, XPRE, X1, Hb, wv); } SEAM(pb); \
        PH(pb + 1) { unsigned char* ws = wsl(a.ws); moe_table(a, lds, layer, wv); pg8::Gemm g{Hb, (const bf16*)(ws + WS_W_GU8), 2048, 2048, 2048}; \
            MoeOrder<4> S{G, bid, layer, (const LAS int*)(lds + LDS_TAB), (const int*)(ws + A_TOKL)}; EpiGateUp E{ws + A_ACT}; pg8::gemm_phase<EpiGateUp, MoeOrder<4>, true, true>(lds, g, S, E, wv); } SEAM(pb + 1); \
        PH(pb + 2) { unsigned char* ws = wsl(a.ws); moe_table(a, lds, layer, wv); pg8::Gemm g{(const bf16*)(ws + A_ACT), (const bf16*)(ws + WS_W_DN), 512, 512, 512}; \
            MoeOrder<8> S{G, bid, layer, (const LAS int*)(lds + LDS_TAB), (const int*)(ws + A_TOKL)}; EpiDown E{(bf16*)(ws + A_YS)}; pg8::gemm_phase<EpiDown, MoeOrder<8>, false, true>(lds, g, S, E, wv); } SEAM(pb + 2); \
        PH(pb + 3) { unsigned char* ws = wsl(a.ws); ln_ffn_phase(a, layer, X1, a.out, layer == 0 ? Hb : nullptr, wv); } SEAM(pb + 3);
    MOE_PHASES(0, 8)
    PH(12) { unsigned char* ws = wsl(a.ws); pg8::Gemm g{Hb, (const bf16*)(ws + WS_W_IN1), 2048, 2048, 2048}; SO.init(T, 9728, G, bid);
        EpiIn1 E{(bf16*)(ws + A_ZD), (bf16*)(ws + A_ZR)}; pg8::gemm_phase<EpiIn1, pg8::StaticOrder, false, true>(lds, g, SO, E, wv); } SEAM(12);
    PH(13) { unsigned char* ws = wsl(a.ws); rwkv_prep((const bf16*)(ws + A_ZR), a.in[I_MU], (bf16*)(ws + A_LIN), wv); } SEAM(13);
    PH(14) { unsigned char* ws = wsl(a.ws);
        pg8::Gemm g{(const bf16*)(ws + A_LIN), (const bf16*)(ws + WS_W_LORA), 384, 384, 256}; LoraOrder LO; LO.init(T, 4608, G, bid);
        EpiLora E{(bf16*)(ws + A_WDEC), (bf16*)(ws + A_AA), (bf16*)(ws + A_GG), a.in[I_W0], a.in[I_A0]}; pg8::gemm_phase<EpiLora, LoraOrder, false>(lds, g, LO, E, wv);
} SEAM(14);
    PH(15) { rwkv_chunk_prep(a, lds, 0, wv); } SEAM(15);
    PH(16) { unsigned char* ws = wsl(a.ws); if (bid < 96 || G <= 96) { for (int u = bid; u < 96; u += G) { rwkv_chunk_rec(a, lds, u, 0, wv); if (REP_REC) rwkv_chunk_rec<REP_REC>(a, lds, u, 0, wv); } }
        if (G <= 96 || bid >= 96) { const int nb_ = G <= 96 ? G : G - 96, b0_ = G <= 96 ? bid : bid - 96;
            DilPre P; if (b0_ < 768) dil_issue((const bf16*)(ws + A_ZD), (const float*)(ws + WS_BIAS), b0_, wv, P);
            for (int u = b0_; u < 768; u += nb_) dil_attn_unit(lds, (const bf16*)(ws + A_ZD), (const float*)(ws + WS_BIAS), (bf16*)(ws + A_DPO), (float*)(ws + A_DPM), (float*)(ws + A_DPL), u, u + nb_ < 768 ? u + nb_ : -1, P, wv); } } SEAM(16);
    PH(17) { rwkv_chunk_prep(a, lds, 1, wv); } SEAM(17);
    PH(18) { unsigned char* ws = wsl(a.ws); if (bid < 96 || G <= 96) { for (int u = bid; u < 96; u += G) { rwkv_chunk_rec(a, lds, u, 1, wv); if (REP_REC) rwkv_chunk_rec<REP_REC>(a, lds, u, 1, wv); } }
        if (G <= 96 || bid >= 96) { const int nb_ = G <= 96 ? G : G - 96, b0_ = G <= 96 ? bid : bid - 96;
            DilPre P; if (768 + b0_ < 1536) dil_issue((const bf16*)(ws + A_ZD), (const float*)(ws + WS_BIAS), 768 + b0_, wv, P);
            for (int u = 768 + b0_; u < 1536; u += nb_) dil_attn_unit(lds, (const bf16*)(ws + A_ZD), (const float*)(ws + WS_BIAS), (bf16*)(ws + A_DPO), (float*)(ws + A_DPM), (float*)(ws + A_DPL), u, u + nb_ < 1536 ? u + nb_ : -1, P, wv); } } SEAM(18);
    PH(19) { unsigned char* ws = wsl(a.ws); dil_merge((const bf16*)(ws + A_DPO), (const float*)(ws + A_DPM), (const float*)(ws + A_DPL), Hb, wv); } SEAM(19);
    PH(20) { unsigned char* ws = wsl(a.ws); pg8::Gemm g{Hb, (const bf16*)(ws + WS_W_OUT1), 2048, 2048, 2048}; SO.init(T, 2048, G, bid);
        EpiRes<true> E{XPRE, a.out, MOD + 4 * 12288 + 2 * 2048}; pg8::gemm_phase<EpiRes<true>, pg8::StaticOrder, false, true>(lds, g, SO, E, wv); } SEAM(20);
    MOE_PHASES(1, 21)
#undef MOE_PHASES
#ifdef DBG_TIME_K1
    {
        xcd_barrier(bar);
        const unsigned long long* ts = (const unsigned long long*)(ws0 + CTL_CHK);
        const unsigned long long t0 = ts[0], te = __builtin_amdgcn_s_memrealtime();
        const float tot = (float)(te - t0), f1 = (float)(ts[1 + DBG_TIME_K1] - t0) / tot, f2 = (float)(ts[1 + DBG_TIME_K2] - t0) / tot;
        const float c1 = sqrtf(100.f * f1);
        for (size_t i = (size_t)bid * 512 + wv * 64 + lane_id(); i < (size_t)T * D; i += (size_t)G * 512) a.out[i] = c1;
        xcd_barrier(bar);
        if (bid == 0 && wv == 0 && lane_id() == 0) a.out[0] = 100.f * f2;
    }
#endif
#undef IN
#undef SEAM
#undef MOD
#undef Hb
#undef X1
#undef XPRE
}


#ifdef DBG_DUMP_OFF
__global__ void dbg_dump(const unsigned char* ws, float* out) {
    const size_t n = (size_t)T * D;
    for (size_t i = (size_t)blockIdx.x * 256 + threadIdx.x; i < n; i += (size_t)gridDim.x * 256) {
#if defined(DBG_DUMP_RT)
        { const int m = (int)(i >> 11), c = (int)(i & 2047); const int* RTE = (const int*)(ws + A_RT); const float* RTW = (const float*)(RTE + 4 * T); out[i] = c < 2 ? (float)RTE[2 * m + c] : (c < 4 ? RTW[2 * m + c - 2] : 0.f); }
#elif DBG_DUMP_F32
        out[i] = ((const float*)(ws + DBG_DUMP_OFF))[i];
#else
        out[i] = bf2f(((const bf16*)(ws + DBG_DUMP_OFF))[i]);
#endif
    }
}
#endif
extern "C" void kernel_launch(void* const* d_in, const int* in_sizes, int n_in, void* d_out, int out_size, void* d_ws, size_t ws_size, hipStream_t stream) {
    static int grid = 0;
    if (grid == 0) {
        if (n_in != 41 || out_size != T * D || ws_size < WS_END) { fprintf(stderr, "kernel_launch: unexpected shapes: n_in %d out %d ws %zu (need %zu)\n", n_in, out_size, ws_size, (size_t)WS_END); grid = -1; return; }
        int dev = 0, cus = 0, per_cu = 0;
        if (hipGetDevice(&dev) != hipSuccess || hipDeviceGetAttribute(&cus, hipDeviceAttributeMultiprocessorCount, dev) != hipSuccess) { grid = -1; return; }
        if (hipFuncSetAttribute((const void*)fwd, hipFuncAttributeMaxDynamicSharedMemorySize, LDS_BYTES) != hipSuccess) { fprintf(stderr, "kernel_launch: hipFuncSetAttribute failed\n"); grid = -1; return; }
        if (hipOccupancyMaxActiveBlocksPerMultiprocessor(&per_cu, (const void*)fwd, 512, LDS_BYTES) != hipSuccess || per_cu < 1) fprintf(stderr, "kernel_launch: occupancy query says %d blocks/CU\n", per_cu);
        (void)hipGetLastError();
        grid = cus;
    }
    if (grid < 0) return;
    (void)hipMemsetAsync(d_ws, 0, CTL_ZERO_BYTES, stream);
#ifdef DBG_ZERO_WS
    (void)hipMemsetAsync((char*)d_ws + CTL_ZERO_BYTES, 0, WS_END - CTL_ZERO_BYTES, stream);
#endif
    KArgs a{};
    for (int i = 0; i < 41; ++i) a.in[i] = (const float*)d_in[i];
    a.out = (float*)d_out; a.ws = (unsigned char*)d_ws;
#if N_LAUNCH_MODE == 0
    a.ph_lo = 0; a.ph_hi = N_PHASES;
    hipLaunchKernelGGL(fwd, dim3(grid), dim3(512), LDS_BYTES, stream, a);
#else
#ifdef DBG_DUMP_AFTER
    for (int p = 0; p <= DBG_DUMP_AFTER; ++p) { a.ph_lo = p; a.ph_hi = p + 1; hipLaunchKernelGGL(fwd, dim3(grid), dim3(512), LDS_BYTES, stream, a); }
#ifdef DBG_DUMP_OFF
    hipLaunchKernelGGL(dbg_dump, dim3(2048), dim3(256), 0, stream, (const unsigned char*)d_ws, (float*)d_out);
#endif
#else
    for (int p = 0; p < N_PHASES; ++p) { a.ph_lo = p; a.ph_hi = p + 1; hipLaunchKernelGGL(fwd, dim3(grid), dim3(512), LDS_BYTES, stream, a); }
#endif
#endif
}
```

```cpp
#include <hip/hip_runtime.h>
#include <cstdio>
#include <cstdint>

#ifndef N_LAUNCH_MODE
#define N_LAUNCH_MODE 0
#endif
#ifndef CHK
#define CHK 0
#endif

#define GAS __attribute__((address_space(1)))
#define LAS __attribute__((address_space(3)))
typedef unsigned short bf16;
typedef short bf16x8 __attribute__((ext_vector_type(8)));
typedef short s16x4 __attribute__((ext_vector_type(4)));
typedef float f32x4 __attribute__((ext_vector_type(4)));
typedef float f32x16 __attribute__((ext_vector_type(16)));
typedef float f32x2 __attribute__((ext_vector_type(2)));
typedef unsigned u32x4 __attribute__((ext_vector_type(4)));
typedef unsigned u32x2 __attribute__((ext_vector_type(2)));
#define DI __device__ __forceinline__

constexpr int D = 2048, NB = 4, SEQ = 4096, T = NB * SEQ;
constexpr float LN_EPS = 1e-5f, RMS_EPS = 1e-6f;
constexpr float DN_ALPHA = 1.41421356237f;
constexpr int EVEN_IN = 1856, ODD_IN = 9568, DIL_IN = 4608, RW_IN = 4960, RWW = 1536;
constexpr int NEXP = 16, DEXP = 512;

typedef __bf16 bf16x2_t __attribute__((ext_vector_type(2)));
DI unsigned pk2(float lo, float hi) { f32x2 v = {lo, hi}; bf16x2_t r = __builtin_convertvector(v, bf16x2_t); return __builtin_bit_cast(unsigned, r); }
DI float bf2f(bf16 b) { return __uint_as_float(((unsigned)b) << 16); }
DI float bflo(unsigned u) { return __uint_as_float(u << 16); }
DI float bfhi(unsigned u) { return __uint_as_float(u & 0xffff0000u); }
DI bf16 f2bf(float f) { unsigned u = __float_as_uint(f); u += 0x7fffu + ((u >> 16) & 1u); return (bf16)(u >> 16); }
DI float wave_sum(float v) {
#pragma unroll
    for (int o = 1; o < 64; o <<= 1) v += __shfl_xor(v, o);
    return v;
}
DI unsigned char* wsl(unsigned char* p) { asm volatile("" : "+s"(p)); return p; }
DI int lane_id() { return (int)__builtin_amdgcn_mbcnt_hi(~0u, __builtin_amdgcn_mbcnt_lo(~0u, 0u)); }
DI int otid(int wv) { int t = wv * 64 + lane_id(); asm volatile("" : "+v"(t)); return t; }
DI float dpp_xor1(float x) { return __builtin_bit_cast(float, __builtin_amdgcn_mov_dpp(__builtin_bit_cast(int, x), 0xB1, 0xF, 0xF, true)); }
DI float dpp_xor2(float x) { return __builtin_bit_cast(float, __builtin_amdgcn_mov_dpp(__builtin_bit_cast(int, x), 0x4E, 0xF, 0xF, true)); }
DI float dpp_hmir(float x) { return __builtin_bit_cast(float, __builtin_amdgcn_mov_dpp(__builtin_bit_cast(int, x), 0x141, 0xF, 0xF, true)); }
template <int N> DI float dpp_ror(float x) { return __builtin_bit_cast(float, __builtin_amdgcn_mov_dpp(__builtin_bit_cast(int, x), 0x120 + N, 0xF, 0xF, true)); }
DI float dpp_rmir(float x) { return __builtin_bit_cast(float, __builtin_amdgcn_mov_dpp(__builtin_bit_cast(int, x), 0x140, 0xF, 0xF, true)); }
DI float red8(float x) { x += dpp_xor1(x); x += dpp_xor2(x); x += dpp_hmir(x); return x; }
DI float red16(float x) { x += dpp_xor1(x); x += dpp_xor2(x); x += dpp_hmir(x); x += dpp_rmir(x); return x; }
DI float sat448(float x) { return __builtin_amdgcn_fmed3f(x, -448.f, 448.f); }
DI unsigned pk4_fp8(float a, float b, float c, float d) { int w = 0; w = __builtin_amdgcn_cvt_pk_fp8_f32(sat448(a), sat448(b), w, false); w = __builtin_amdgcn_cvt_pk_fp8_f32(sat448(c), sat448(d), w, true); return (unsigned)w; }
constexpr float F8_WSCALE = 32.f;
DI float sigmoidf_(float x) { return __builtin_amdgcn_rcpf(1.f + __expf(-x)); }

namespace pg8 {
constexpr int BM = 256, BK = 64, HALF = 128, HTB = HALF * BK * 2, STAGE_BYTES = 8 * HTB, NXCD = 8, WGM = 8;
__host__ __device__ __forceinline__ int lds_byte(int r, int c) { const int st = (r >> 4) * 2 + (c >> 5), rr = r & 15, cc = c & 31, ob = rr * 64 + cc * 2; return st * 1024 + (ob ^ (((ob >> 9) & 1) << 5)); }
__host__ __device__ __forceinline__ void stage_rc(int b, int& R, int& C) { const int st = b / 1024, sb = b % 1024, swz = sb ^ (((sb >> 9) & 1) << 5); R = (st >> 1) * 16 + swz / 64; C = (st & 1) * 32 + (swz % 64) / 2; }
__host__ __device__ __forceinline__ int perm32(int rho) { const int n = rho >> 4, i = rho & 15; return 8 * (i >> 2) + 4 * n + (i & 3); }

struct Unit { int pm, pn, aux; };
struct Gemm { const bf16* A; const bf16* Bt; int lda, ldb, K; };

struct StaticOrder {
    int nM, nN, nwg, G, c;
    __host__ __device__ void init(int M, int N, int G_, int c_) { nM = M / BM; nN = N / BM; nwg = nM * nN; G = G_; c = c_; }
    __host__ __device__ bool next(int i, Unit& u) const {
        const long L = (long)i * G + c; if (L >= nwg) return false;
        int wgid = (int)L; { const int q = nwg / NXCD, r = nwg % NXCD, xcd = wgid % NXCD, off = wgid / NXCD; wgid = (xcd < r ? xcd * (q + 1) : r * (q + 1) + (xcd - r) * q) + off; }
        const int nig = WGM * nN, gid = wgid / nig, fm = gid * WGM, gsz = (nM - fm) < WGM ? (nM - fm) : WGM;
        u.pm = fm + ((wgid % nig) % gsz); u.pn = (wgid % nig) / gsz; u.aux = 0; return true;
    }
    __device__ __forceinline__ int arow(const Unit&, int) const { return 0; }
    __device__ __forceinline__ int koff(const Unit&) const { return 0; }
};

typedef int v8i __attribute__((ext_vector_type(8)));
template <class Epi, class Sched, bool GATHER, bool F8 = false>
__device__ __forceinline__ void gemm_phase(LAS unsigned char* lds, const Gemm g, const Sched& S, const Epi& E, int wv) {
    const int tid = otid(wv), wid = __builtin_amdgcn_readfirstlane(tid >> 6), lane = tid & 63, wr = wid >> 2, wc = wid & 3, fr = lane & 15, fq = lane >> 4;
    int K = g.K; asm volatile("" : "+s"(K));
    constexpr int ES = F8 ? 1 : 2;
    const int nt = K / (F8 ? 2 * BK : BK);
    unsigned voffB[2], vA0[2], vA1[2], nA0[2], nA1[2]; int Rr[2], Cc[2];
#pragma unroll
    for (int i = 0; i < 2; ++i) { int R, C; stage_rc(tid * 16 + i * 8192, R, C); const int Rb = Epi::PERM ? ((R & ~31) + perm32(R & 31)) : R;
        Rr[i] = R; Cc[i] = C; voffB[i] = (unsigned)(Rb * g.ldb * ES + C * 2);
        vA0[i] = (unsigned)(R * g.lda * ES + C * 2); vA1[i] = (unsigned)((R + HALF) * g.lda * ES + C * 2); nA0[i] = vA0[i]; nA1[i] = vA1[i]; }
    const size_t kstep = (size_t)(BK * 2);
    const size_t hstepB = (size_t)HALF * g.ldb * ES, tstepB = 2 * hstepB, tstepA = (size_t)BM * g.lda * ES, hstepA = (size_t)HALF * g.lda * ES, rbA = (size_t)g.lda * ES, rbB = (size_t)g.ldb * ES;
    const unsigned ldsw = (unsigned)wid * 1024u;
    const int aoff = lds_byte(wr * 64 + fr, F8 ? fq * 16 : fq * 8), boff = lds_byte(wc * 32 + fr, F8 ? fq * 16 : fq * 8);
#define PG8_SA(b, h) (((b) * 2 + (h)) * HTB)
#define PG8_SB(b, h) ((4 + (b) * 2 + (h)) * HTB)
#define PG8_STAGE(bufoff, gbase, voff) do { _Pragma("unroll") for (int _i = 0; _i < 2; ++_i) \
        __builtin_amdgcn_global_load_lds((const unsigned*)((const char*)(gbase) + (voff)[_i]), (LAS unsigned*)(lds + (bufoff) + ldsw + _i * 8192), 16, 0, 0); } while (0)
#define PG8_STAGE1(bufoff, gbase, voff0, rowbytes) do { __builtin_amdgcn_global_load_lds((const unsigned*)((const char*)(gbase) + (voff0)), (LAS unsigned*)(lds + (bufoff) + ldsw), 16, 0, 0); \
        __builtin_amdgcn_global_load_lds((const unsigned*)((const char*)(gbase) + (size_t)64 * (rowbytes) + (voff0)), (LAS unsigned*)(lds + (bufoff) + ldsw + 8192), 16, 0, 0); } while (0)
#define PG8_STAGEA(bufoff, gbase, half, arr) do { if constexpr (GATHER) PG8_STAGE(bufoff, gbase, arr); else PG8_STAGE1(bufoff, (const char*)(gbase) + (half) * hstepA, vA0[0], rbA); } while (0)
#define PG8_LD32(p) __builtin_bit_cast(v8i, __builtin_shufflevector(*(const LAS u32x4*)(p), *(const LAS u32x4*)((p) + 16), 0, 1, 2, 3, 4, 5, 6, 7))
#define PG8_LDA(dst, b, h) do { if constexpr (F8) { _Pragma("unroll") for (int m = 0; m < 4; ++m) dst##8[m] = PG8_LD32(lds + PG8_SA(b, h) + aoff + m * 2048); } \
        else { _Pragma("unroll") for (int m = 0; m < 4; ++m) _Pragma("unroll") for (int k = 0; k < 2; ++k) dst[m][k] = *(const LAS bf16x8*)(lds + PG8_SA(b, h) + aoff + m * 2048 + k * 1024); } } while (0)
#define PG8_LDB(dst, b, h) do { if constexpr (F8) { _Pragma("unroll") for (int n = 0; n < 2; ++n) dst##8[n] = PG8_LD32(lds + PG8_SB(b, h) + boff + n * 2048); } \
        else { _Pragma("unroll") for (int n = 0; n < 2; ++n) _Pragma("unroll") for (int k = 0; k < 2; ++k) dst[n][k] = *(const LAS bf16x8*)(lds + PG8_SB(b, h) + boff + n * 2048 + k * 1024); } } while (0)
#define PG8_MMA(ai, bj, At, Bt) do { __builtin_amdgcn_s_setprio(1); if constexpr (F8) { _Pragma("unroll") for (int m = 0; m < 4; ++m) _Pragma("unroll") for (int n = 0; n < 2; ++n) \
            asm volatile("v_mfma_scale_f32_16x16x128_f8f6f4 %0, %1, %2, %0, %3, %4 op_sel_hi:[0,0,0]" : "+v"(acc[ai][bj][m][n]) : "v"(Bt##8[n]), "v"(At##8[m]), "v"(sc_w), "v"(sc_x)); }     \
        else { _Pragma("unroll") for (int m = 0; m < 4; ++m) _Pragma("unroll") for (int n = 0; n < 2; ++n) _Pragma("unroll") for (int k = 0; k < 2; ++k) \
            acc[ai][bj][m][n] = __builtin_amdgcn_mfma_f32_16x16x32_bf16(Bt[n][k], At[m][k], acc[ai][bj][m][n], 0, 0, 0); } __builtin_amdgcn_s_setprio(0); } while (0)
#define PG8_WAIT_V(n) asm volatile("s_waitcnt vmcnt(" #n ")" ::: "memory")
#define PG8_WAIT_L(n) asm volatile("s_waitcnt lgkmcnt(" #n ")" ::: "memory")
#define PG8_BAR __builtin_amdgcn_s_barrier()
#define PG8_SCHED __builtin_amdgcn_sched_barrier(0)
    Unit cur, nxt; int ui = 0;
    if (!S.next(0, cur)) return;
    f32x4 acc[2][2][4][2];
#pragma unroll
    for (int a = 0; a < 2; ++a)
#pragma unroll
        for (int b = 0; b < 2; ++b)
#pragma unroll
            for (int m = 0; m < 4; ++m)
#pragma unroll
                for (int n = 0; n < 2; ++n) acc[a][b][m][n] = (f32x4){0.f, 0.f, 0.f, 0.f};
    int sc_w = 122, sc_x = 127; if constexpr (F8) asm volatile("" : "+v"(sc_w), "+v"(sc_x));
    bf16x8 At[4][2], B0[2][2], B1[2][2]; v8i At8[4], B08[2], B18[2];
    const char* cA = (GATHER ? (const char*)g.A : (const char*)g.A + (size_t)cur.pm * tstepA) + ES * S.koff(cur);
    const char* cB = (const char*)g.Bt + (size_t)cur.pn * tstepB + ES * S.koff(cur);
    if (GATHER) {
#pragma unroll
        for (int i = 0; i < 2; ++i) { vA0[i] = (unsigned)(S.arow(cur, Rr[i]) * g.lda * ES + Cc[i] * 2); vA1[i] = (unsigned)(S.arow(cur, Rr[i] + HALF) * g.lda * ES + Cc[i] * 2); nA0[i] = vA0[i]; nA1[i] = vA1[i]; } }
    PG8_STAGE1(PG8_SB(0, 0), cB, voffB[0], rbB); PG8_STAGEA(PG8_SA(0, 0), cA, 0, vA0); PG8_STAGE1(PG8_SB(0, 1), cB + hstepB, voffB[0], rbB); PG8_STAGEA(PG8_SA(0, 1), cA, 1, vA1);
    if (wr == 1) PG8_BAR;
    PG8_WAIT_V(4); PG8_BAR;
    PG8_STAGE1(PG8_SB(1, 0), cB + kstep, voffB[0], rbB); PG8_STAGEA(PG8_SA(1, 0), cA + kstep, 0, vA0); PG8_STAGE1(PG8_SB(1, 1), cB + hstepB + kstep, voffB[0], rbB);
    PG8_WAIT_V(6); PG8_BAR;
    for (;;) {
        const bool has_next = S.next(ui + 1, nxt);
        const char* nAp = GATHER ? cA : (has_next ? (const char*)g.A + (size_t)nxt.pm * tstepA + ES * S.koff(nxt) : cA);
        const char* nB = has_next ? (const char*)g.Bt + (size_t)nxt.pn * tstepB + ES * S.koff(nxt) : cB;
        if (GATHER) {
#pragma unroll
            for (int i = 0; i < 2; ++i) { nA0[i] = vA0[i]; nA1[i] = vA1[i]; } }
        for (int t = 0; t < nt; t += 2) {
            const bool last = (t == nt - 2);
            if (GATHER && has_next && t == (nt >= 4 ? nt - 4 : 0)) {
#pragma unroll
                for (int i = 0; i < 2; ++i) { nA0[i] = (unsigned)(S.arow(nxt, Rr[i]) * g.lda * ES + Cc[i] * 2); nA1[i] = (unsigned)(S.arow(nxt, Rr[i] + HALF) * g.lda * ES + Cc[i] * 2); } }
            const char* a1 = cA + (size_t)(t + 1) * kstep;
            const char* a2 = last ? nAp : cA + (size_t)(t + 2) * kstep; const char* b2 = last ? nB : cB + (size_t)(t + 2) * kstep;
            const char* a3 = a2 + kstep; const char* b3 = b2 + kstep;
            unsigned w0[2], w1[2];
#pragma unroll
            for (int i = 0; i < 2; ++i) { w0[i] = (GATHER && last) ? nA0[i] : vA0[i]; w1[i] = (GATHER && last) ? nA1[i] : vA1[i]; }
            PG8_LDB(B0, 0, 0); PG8_SCHED; PG8_LDA(At, 0, 0); PG8_STAGEA(PG8_SA(1, 1), a1, 1, vA1);
            PG8_WAIT_L(8); PG8_BAR; PG8_WAIT_L(0); PG8_MMA(0, 0, At, B0); PG8_BAR; PG8_SCHED;
            PG8_LDB(B1, 0, 1); PG8_STAGE1(PG8_SB(0, 0), b2, voffB[0], rbB);
            PG8_BAR; PG8_WAIT_L(0); PG8_MMA(0, 1, At, B1); PG8_BAR;
            PG8_LDA(At, 0, 1); PG8_STAGEA(PG8_SA(0, 0), a2, 0, w0);
            PG8_BAR; PG8_WAIT_L(0); PG8_MMA(1, 0, At, B0); PG8_BAR; PG8_SCHED;
            PG8_STAGE1(PG8_SB(0, 1), b2 + hstepB, voffB[0], rbB);
            PG8_WAIT_V(6); PG8_BAR; PG8_MMA(1, 1, At, B1); PG8_BAR;
            PG8_LDB(B0, 1, 0); PG8_SCHED; PG8_LDA(At, 1, 0); PG8_STAGEA(PG8_SA(0, 1), a2, 1, w1);
            PG8_WAIT_L(8); PG8_BAR; PG8_WAIT_L(0); PG8_MMA(0, 0, At, B0); PG8_BAR; PG8_SCHED;
            PG8_LDB(B1, 1, 1); PG8_STAGE1(PG8_SB(1, 0), b3, voffB[0], rbB);
            PG8_BAR; PG8_WAIT_L(0); PG8_MMA(0, 1, At, B1); PG8_BAR;
            PG8_LDA(At, 1, 1); PG8_STAGEA(PG8_SA(1, 0), a3, 0, w0);
            PG8_BAR; PG8_WAIT_L(0); PG8_MMA(1, 0, At, B0); PG8_BAR; PG8_SCHED;
            PG8_STAGE1(PG8_SB(1, 1), b3 + hstepB, voffB[0], rbB);
            PG8_WAIT_V(6); PG8_BAR; PG8_MMA(1, 1, At, B1); PG8_BAR;
        }
        if constexpr (F8) asm volatile("s_nop 15\n\ts_nop 15\n\ts_nop 15\n\ts_nop 15" ::: "memory");
        { int frr = fr, fqq = fq; asm volatile("" : "+v"(frr), "+v"(fqq));
          E(acc, cur, wr, wc, frr, fqq); }
        if (!has_next) break;
#pragma unroll
        for (int a = 0; a < 2; ++a)
#pragma unroll
            for (int b = 0; b < 2; ++b)
#pragma unroll
                for (int m = 0; m < 4; ++m)
#pragma unroll
                    for (int n = 0; n < 2; ++n) acc[a][b][m][n] = (f32x4){0.f, 0.f, 0.f, 0.f};
        cur = nxt; cA = nAp; cB = nB; ++ui;
        if (GATHER) {
#pragma unroll
            for (int i = 0; i < 2; ++i) { vA0[i] = nA0[i]; vA1[i] = nA1[i]; } }
    }
    PG8_WAIT_V(0);
    if (wr == 0) PG8_BAR;
    PG8_BAR;
#undef PG8_SA
#undef PG8_SB
#undef PG8_STAGE
#undef PG8_STAGE1
#undef PG8_STAGEA
#undef PG8_LDA
#undef PG8_LDB
#undef PG8_MMA
#undef PG8_LD32
#undef PG8_WAIT_V
#undef PG8_WAIT_L
#undef PG8_BAR
#undef PG8_SCHED
}
}

#define XB_TMO      128
#define XB_XCNT(j)  (256  + 64 * (j))
#define XB_XSUB(j)  (1280 + 64 * (j))
#define XB_XGEN(j)  (2304 + 64 * (j))
#define XB_TOP      3328
#define XB_TOPGEN   3392
#define XCD_BAR_WORDS 3456
#define XB_SPIN_CAP (1u << 18)
__device__ __forceinline__ unsigned xb_ld(unsigned* p)              { return __hip_atomic_load(p, __ATOMIC_RELAXED, __HIP_MEMORY_SCOPE_AGENT); }
__device__ __forceinline__ unsigned xb_add(unsigned* p, unsigned v) { return __hip_atomic_fetch_add(p, v, __ATOMIC_RELAXED, __HIP_MEMORY_SCOPE_AGENT); }
__device__ __forceinline__ unsigned xb_xcc_id() { return (unsigned)__builtin_amdgcn_s_getreg((3 << 11) | 20) & 0xFu; }
#define XB_SPIN(cond, bar) do { unsigned _sp = 0; while (cond) { __builtin_amdgcn_s_sleep(1); \
    if ((++_sp & 255u) == 0u) { if (xb_ld(&(bar)[XB_TMO])) break; if (_sp > XB_SPIN_CAP) { atomicAdd(&(bar)[XB_TMO], 1u); break; } } } } while (0)
struct XcdBarrier { unsigned* bar; unsigned x; volatile LAS unsigned* st; int wv; };
__device__ __forceinline__ XcdBarrier xcd_barrier_post(unsigned* bar, volatile LAS unsigned* st, int wv) {
    XcdBarrier b; b.bar = bar; b.x = xb_xcc_id(); b.st = st; b.wv = wv;
    if (wv == 0 && lane_id() == 0) (void)xb_add(&bar[XB_XCNT(b.x)], 1u);
    return b;
}
__device__ __forceinline__ void xcd_barrier_complete(unsigned* bar, unsigned x, unsigned& nloc, unsigned& nx) {
    const unsigned G = gridDim.x * gridDim.y * gridDim.z;
    unsigned sum, cnt, mine, sp = 0u;
    for (;;) {
        sum = 0u; cnt = 0u; mine = 0u;
#pragma unroll
        for (unsigned j = 0; j < 16; ++j) { const unsigned c = xb_ld(&bar[XB_XCNT(j)]); sum += c; cnt += (c > 0u) ? 1u : 0u; mine = (j == x) ? c : mine; }
        if (sum == G) break;
        __builtin_amdgcn_s_sleep(1);
        if ((++sp & 255u) == 0u) { if (xb_ld(&bar[XB_TMO])) break; if (sp > XB_SPIN_CAP) { atomicAdd(&bar[XB_TMO], 1u); break; } }
    }
    nloc = mine > 0u ? mine : 1u; nx = cnt > 0u ? cnt : 1u;
}
__device__ __forceinline__ void xcd_barrier(const XcdBarrier& b) {
    asm volatile("s_waitcnt vmcnt(0)" ::: "memory");
    __syncthreads();
    if (b.wv == 0 && lane_id() == 0) {
        unsigned* bar = b.bar;
        __builtin_amdgcn_s_waitcnt(0);
        unsigned nloc = b.st[0], nx = b.st[1];
        if (nloc == 0u) { xcd_barrier_complete(bar, b.x, nloc, nx); b.st[0] = nloc; b.st[1] = nx; }
        const unsigned old = xb_add(&bar[XB_XSUB(b.x)], 1u);
        const unsigned gen = old / nloc;
        if (old + 1u == (gen + 1u) * nloc) {
            __builtin_amdgcn_fence(__ATOMIC_RELEASE, "agent");
            asm volatile("s_waitcnt vmcnt(0)" ::: "memory");
            const unsigned og = xb_add(&bar[XB_TOP], 1u);
            const unsigned tg = og / nx;
            if (og + 1u == (tg + 1u) * nx) xb_add(&bar[XB_TOPGEN], 1u);
            else XB_SPIN(xb_ld(&bar[XB_TOPGEN]) == tg, bar);
            __builtin_amdgcn_fence(__ATOMIC_ACQUIRE, "agent");
            xb_add(&bar[XB_XGEN(b.x)], 1u);
            asm volatile("s_waitcnt vmcnt(0)" ::: "memory");
        } else {
            XB_SPIN(xb_ld(&bar[XB_XGEN(b.x)]) == gen, bar);
            __builtin_amdgcn_fence(__ATOMIC_ACQUIRE, "agent");
            asm volatile("s_waitcnt vmcnt(0)" ::: "memory");
        }
    }
    __syncthreads();
}

constexpr size_t MiB = 1u << 20;
constexpr size_t CTL_BAR = 0, CTL_MODI = 16384  , CTL_MOD = CTL_MODI + 2 * 4 * 12288 * 8  , CTL_SSQ = CTL_MOD + 2 * 4 * 12288 * 4  ,
                 CTL_CNT = CTL_SSQ + (size_t)T * 12 * 4  , CTL_CHK = CTL_CNT + 2 * 16 * 256, CTL_ZERO_BYTES = 2 * MiB;
static_assert(CTL_CHK % 8 == 0 && CTL_CHK + 1024 <= CTL_ZERO_BYTES, "ctl");
constexpr size_t WS_W_IN0 = 2 * MiB, WS_W_UQ = WS_W_IN0 + 8 * MiB, WS_W_UKV = WS_W_UQ + 1536 * 512 * 2, WS_W_GLU = WS_W_UKV + 2048 * 256 * 2, WS_W_OUT0 = WS_W_GLU + 2 * MiB,
                 WS_W_IN1 = WS_W_OUT0 + 8 * MiB, WS_W_OUT1 = WS_W_IN1 + (size_t)9728 * 2048 * 2, WS_W_GU = WS_W_OUT1 + 8 * MiB, WS_W_DN = WS_W_GU + 128 * MiB,
                 WS_W_LORA = WS_W_DN + 64 * MiB, WS_S5BY = WS_W_LORA + (size_t)4608 * 384 * 2, WS_S5BE = WS_S5BY + (size_t)64 * 256 * 384 * 2, WS_ROPE = WS_S5BE + (size_t)64 * 256 * 256 * 2,
                 WS_BIAS = WS_ROPE + 1 * MiB, WS_S5L = WS_BIAS + 16384, WS_H = WS_S5L + 65536;
static_assert(WS_H % 256 == 0, "align");
constexpr size_t WS_W_GU8 = WS_W_GU + 64 * MiB;
constexpr size_t WS_X1 = WS_H + 64 * MiB, WS_ARENA = WS_X1 + 128 * MiB;
constexpr size_t A_QC = WS_ARENA, A_KVC = A_QC + 16 * MiB, A_KR = A_KVC + 8 * MiB, A_XH = A_KR + 2 * MiB, A_ES = A_XH + 48 * MiB, A_Q = A_ES + 32 * MiB, A_KF = A_Q + 48 * MiB,
                 A_V = A_KF + 48 * MiB, A_YS5 = A_V + 32 * MiB;
constexpr size_t A_XPRE = WS_ARENA, A_RT = WS_ARENA + 128 * MiB, A_TOKL = A_RT + 1 * MiB, A_ACT = WS_ARENA, A_YS = WS_ARENA + 130 * MiB;
constexpr int MOE_ROWS = 2 * T + 16 * 256;
constexpr size_t A_ZD = WS_ARENA, A_ZR = A_ZD + 144 * MiB, A_LIN = A_ZR + 156 * MiB, A_WDEC = A_LIN + 12 * MiB, A_AA = A_WDEC + 48 * MiB, A_GG = A_AA + 48 * MiB,
                 A_DPO = A_GG + 48 * MiB, A_DPM = A_DPO + 48 * MiB, A_DPL = A_DPM + 2 * MiB, A_BSG = A_DPL + 2 * MiB  , A_YR = WS_ARENA  , A_GST = A_BSG + 2 * MiB  , WS_END = A_GST + 2 * MiB;
static_assert(A_YS + (size_t)MOE_ROWS * 2048 * 2 <= WS_END && A_YS5 + 32 * MiB <= WS_END && WS_END <= 1024 * MiB, "ws map");

constexpr int RING_BYTES = 131072, LDS_TAB = RING_BYTES, LDS_MISC = RING_BYTES + 1024, LDS_BYTES = 147456;

struct KArgs { const float* in[41]; float* out; unsigned char* ws; int ph_lo, ph_hi; };
enum { I_X = 0, I_C, I_ADAW, I_ADAB, I_LNMG, I_LNMB, I_LNFG, I_LNFB, I_RW, I_RB, I_WGU, I_WDN, I_RELB, I_EVIN, I_QN, I_WUQ, I_KVN, I_WUKV, I_LRE, I_LIM, I_BRE, I_BIM, I_CRE, I_CIM,
       I_S5D, I_LOGDT, I_WGLU, I_EVOUT, I_ODIN, I_MU, I_W0, I_W2, I_A0, I_A2, I_G2, I_KK, I_KA, I_RK, I_LNXG, I_LNXB, I_ODOUT };

DI int ropeperm(int c) { return ((c >> 2) & 1) * 32 + (c >> 3) * 4 + (c & 3); }
DI int srccol(int map, int n) {
    switch (map) {
        case 1: if (n < 768) return n; if (n < 1792) return 832 + (n - 768); if (n < 1856) return 768 + ropeperm(n - 1792); return -1;
        case 2: { const int h = n / 192, j = n % 192; return j < 128 ? n : h * 192 + 128 + ropeperm(j - 128); }
        case 3: { const int pn = n >> 8, half = (n >> 7) & 1, idx = n & 127; return half * 512 + pn * 128 + idx; }
        case 4: return n < ODD_IN ? n : -1;
        default: return n;
    }
}
struct ConvJob { const float* src; bf16* dst; const float* kscale; int ldsrc, K, Nd, nmat, map, kbeg, kend, f8; size_t smat, dmat; };
DI void conv_item(const ConvJob& J, LAS unsigned char* scr, int item, int lane) {
    const int nblk = J.Nd / 64, per = (J.K / 64) * nblk, mat = item / per, r = item % per, kb = r / nblk, nb = r % nblk, k0 = 64 * kb, n0 = 64 * nb;
    const float* W = J.src + (size_t)mat * J.smat; bf16* WT = J.f8 ? (bf16*)((unsigned char*)J.dst + (size_t)mat * J.dmat) : J.dst + (size_t)mat * J.dmat;
    const int kq = lane >> 4, nq = lane & 15, sc = srccol(J.map, n0 + 4 * nq);
    f32x4 v[16];
#pragma unroll
    for (int i = 0; i < 16; ++i) { const int kg = k0 + 4 * i + kq; v[i] = (f32x4){0.f, 0.f, 0.f, 0.f};
        if (sc >= 0 && kg >= J.kbeg && kg < J.kend) { v[i] = *(const f32x4*)(W + (size_t)(kg - J.kbeg) * J.ldsrc + sc); if (J.kscale) v[i] *= J.kscale[kg]; } }
#pragma unroll
    for (int i = 0; i < 16; ++i) { LAS bf16* t = (LAS bf16*)(scr + (4 * nq) * 132 + (4 * i + kq) * 2); const unsigned p0 = pk2(v[i].x, v[i].y), p1 = pk2(v[i].z, v[i].w);
        t[0] = (bf16)(p0 & 0xffffu); t[66] = (bf16)(p0 >> 16); t[132] = (bf16)(p1 & 0xffffu); t[198] = (bf16)(p1 >> 16); }
    asm volatile("s_waitcnt lgkmcnt(0)" ::: "memory");
#pragma unroll
    for (int q = 0; q < 8; ++q) { const int id = lane + 64 * q, n = id >> 3, c = id & 7; const LAS unsigned* t = (const LAS unsigned*)(scr + n * 132 + c * 16);
        u32x4 o = {t[0], t[1], t[2], t[3]};
        if (J.f8) { u32x2 o8 = {pk4_fp8(bflo(o.x) * F8_WSCALE, bfhi(o.x) * F8_WSCALE, bflo(o.y) * F8_WSCALE, bfhi(o.y) * F8_WSCALE), pk4_fp8(bflo(o.z) * F8_WSCALE, bfhi(o.z) * F8_WSCALE, bflo(o.w) * F8_WSCALE, bfhi(o.w) * F8_WSCALE)};
            *(u32x2*)((unsigned char*)WT + (size_t)(n0 + n) * J.K + k0 + 8 * c) = o8; }
        else *(u32x4*)(WT + (size_t)(n0 + n) * J.K + k0 + 8 * c) = o; }
    asm volatile("s_waitcnt lgkmcnt(0)" ::: "memory");
}
DI ConvJob conv_job(const KArgs& a, int j) {
    unsigned char* ws = a.ws; ConvJob J; J.kscale = nullptr; J.nmat = 1; J.map = 0; J.smat = 0; J.dmat = 0; J.kbeg = 0; J.kend = 1 << 30; J.f8 = 0;
    switch (j) {
        case 0: J.src = a.in[I_EVIN]; J.dst = (bf16*)(ws + WS_W_IN0); J.f8 = 1; J.ldsrc = EVEN_IN; J.K = 2048; J.Nd = 2048; J.map = 1; break;
        case 1: J.src = a.in[I_WUQ]; J.dst = (bf16*)(ws + WS_W_UQ); J.ldsrc = 1536; J.K = 512; J.Nd = 1536; J.map = 2; J.kscale = a.in[I_QN]; break;
        case 2: J.src = a.in[I_WUKV]; J.dst = (bf16*)(ws + WS_W_UKV); J.ldsrc = 2048; J.K = 256; J.Nd = 2048; J.kscale = a.in[I_KVN]; break;
        case 3: J.src = a.in[I_WGLU]; J.dst = (bf16*)(ws + WS_W_GLU); J.ldsrc = 1024; J.K = 1024; J.Nd = 1024; break;
        case 4: J.src = a.in[I_EVOUT]; J.dst = (bf16*)(ws + WS_W_OUT0); J.f8 = 1; J.ldsrc = 2048; J.K = 2048; J.Nd = 2048; break;
        case 5: J.src = a.in[I_ODIN]; J.dst = (bf16*)(ws + WS_W_IN1); J.f8 = 1; J.ldsrc = ODD_IN; J.K = 2048; J.Nd = 9728; J.map = 4; break;
        case 6: J.src = a.in[I_ODOUT]; J.dst = (bf16*)(ws + WS_W_OUT1); J.f8 = 1; J.ldsrc = 2048; J.K = 2048; J.Nd = 2048; break;
        case 7: J.src = a.in[I_WGU]; J.dst = (bf16*)(ws + WS_W_GU8); J.f8 = 1; J.ldsrc = 1024; J.K = 2048; J.Nd = 1024; J.map = 3; J.nmat = 32; J.smat = (size_t)2048 * 1024; J.dmat = (size_t)1024 * 2048; break;
        case 8: J.src = a.in[I_WDN]; J.dst = (bf16*)(ws + WS_W_DN); J.f8 = 1; J.ldsrc = 2048; J.K = 512; J.Nd = 2048; J.nmat = 32; J.smat = (size_t)512 * 2048; J.dmat = (size_t)2048 * 512; break;
        case 9: J.src = a.in[I_W2]; J.dst = (bf16*)(ws + WS_W_LORA); J.ldsrc = 1536; J.K = 384; J.Nd = 1536; J.kbeg = 0; J.kend = 64; break;
        case 10: J.src = a.in[I_A2]; J.dst = (bf16*)(ws + WS_W_LORA) + (size_t)1536 * 384; J.ldsrc = 1536; J.K = 384; J.Nd = 1536; J.kbeg = 64; J.kend = 128; break;
        default: J.src = a.in[I_G2]; J.dst = (bf16*)(ws + WS_W_LORA) + (size_t)3072 * 384; J.ldsrc = 1536; J.K = 384; J.Nd = 1536; J.kbeg = 128; J.kend = 352; break;
    }
    return J;
}
constexpr int N_CONV_JOBS = 12;

DI void s5_precompute(const KArgs& a, LAS unsigned char* lds, int g, int wv) {
    LAS float* PW = (LAS float*)lds; LAS float* BB = PW + 17 * 64 * 2; LAS float* CC = BB + 64 * 16 * 2; LAS float* KK = CC + 16 * 64 * 2;
    const int tid = otid(wv);
    const float dt = expf(a.in[I_LOGDT][g]);
    for (int idx = tid; idx < 17 * 64; idx += 512) { const int d = idx / 64, p = idx % 64; const float lre = a.in[I_LRE][g * 64 + p], lim = a.in[I_LIM][g * 64 + p];
        const float mag = expf(lre * dt * (float)d); float sn, cs; sincosf(lim * dt * (float)d, &sn, &cs); PW[idx * 2] = mag * cs; PW[idx * 2 + 1] = mag * sn;
        if (d == 16) { float* L = (float*)(a.ws + WS_S5L); L[(g * 64 + p) * 2] = mag * cs; L[(g * 64 + p) * 2 + 1] = mag * sn; } }
    for (int idx = tid; idx < 64 * 16; idx += 512) { const int p = idx / 16, c = idx % 16; const float lre = a.in[I_LRE][g * 64 + p], lim = a.in[I_LIM][g * 64 + p];
        float sn, cs; sincosf(lim * dt, &sn, &cs); const float mag = expf(lre * dt), sh = sinf(0.5f * lim * dt);
        const float nr = expm1f(lre * dt) * cs - 2.f * sh * sh, ni = mag * sn, den = 1.f / (lre * lre + lim * lim);
        const float cr = (nr * lre + ni * lim) * den, ci = (ni * lre - nr * lim) * den;
        const float br = a.in[I_BRE][(g * 64 + p) * 16 + c], bi = a.in[I_BIM][(g * 64 + p) * 16 + c];
        BB[idx * 2] = cr * br - ci * bi; BB[idx * 2 + 1] = cr * bi + ci * br; }
    for (int idx = tid; idx < 16 * 64; idx += 512) { CC[idx * 2] = a.in[I_CRE][g * 1024 + idx]; CC[idx * 2 + 1] = a.in[I_CIM][g * 1024 + idx]; }
    __syncthreads();
    for (int idx = tid; idx < 4096; idx += 512) { const int d = idx >> 8, c = (idx >> 4) & 15, cp = idx & 15; float s = 0.f;
        for (int p = 0; p < 64; ++p) { const float cr = CC[(c * 64 + p) * 2], ci = CC[(c * 64 + p) * 2 + 1], pr = PW[(d * 64 + p) * 2], pi = PW[(d * 64 + p) * 2 + 1];
            const float xr = cr * pr - ci * pi, xi = cr * pi + ci * pr; s += xr * BB[(p * 16 + cp) * 2] - xi * BB[(p * 16 + cp) * 2 + 1]; }
        KK[idx] = s; }
    __syncthreads();
    bf16* BY = (bf16*)(a.ws + WS_S5BY) + (size_t)g * 256 * 384; bf16* BE = (bf16*)(a.ws + WS_S5BE) + (size_t)g * 256 * 256;
    for (int idx = tid; idx < 256 * 48; idx += 512) { const int row = idx / 48, col0 = (idx % 48) * 8, t = row >> 4, c = row & 15; float v[8];
        if (col0 < 256) { const int s = col0 >> 4, c0 = col0 & 15;
#pragma unroll
            for (int j = 0; j < 8; ++j) v[j] = (s <= t) ? KK[((t - s) << 8) + (c << 4) + c0 + j] : 0.f; }
        else { const int pp = col0 - 256; const bool im = pp >= 64; const int p0 = im ? pp - 64 : pp;
#pragma unroll
            for (int j = 0; j < 8; ++j) { const int p = p0 + j; const float cr = CC[(c * 64 + p) * 2], ci = CC[(c * 64 + p) * 2 + 1], pr = PW[((t + 1) * 64 + p) * 2], pi = PW[((t + 1) * 64 + p) * 2 + 1];
                v[j] = im ? -(cr * pi + ci * pr) : (cr * pr - ci * pi); } }
        u32x4 o = {pk2(v[0], v[1]), pk2(v[2], v[3]), pk2(v[4], v[5]), pk2(v[6], v[7])}; *(u32x4*)(BY + (size_t)row * 384 + col0) = o; }
    for (int idx = tid; idx < 256 * 32; idx += 512) { const int row = idx / 32, col0 = (idx % 32) * 8, s = col0 >> 4, c0 = col0 & 15; float v[8];
#pragma unroll
        for (int j = 0; j < 8; ++j) { if (row < 128) { const int p = row & 63; const float pr = PW[((15 - s) * 64 + p) * 2], pi = PW[((15 - s) * 64 + p) * 2 + 1], br = BB[(p * 16 + c0 + j) * 2], bi = BB[(p * 16 + c0 + j) * 2 + 1];
                v[j] = row < 64 ? (pr * br - pi * bi) : (pr * bi + pi * br); } else v[j] = 0.f; }
        u32x4 o = {pk2(v[0], v[1]), pk2(v[2], v[3]), pk2(v[4], v[5]), pk2(v[6], v[7])}; *(u32x4*)(BE + (size_t)row * 256 + col0) = o; }
    __syncthreads();
}

DI int t5_bucket(int dist) { if (dist < 16) return dist; const float logd = logf((float)dist / 16.f) / logf(128.f); int lg = 16 + (int)(logd * 16.f); return lg < 31 ? lg : 31; }

DI void p0_prologue(const KArgs& a, LAS unsigned char* lds, int wv) {
    const int tid = otid(wv), lane = tid & 63, wave = tid >> 6, G = gridDim.x, gw = blockIdx.x * 8 + wave, NGW = G * 8;
    LAS float* cond = (LAS float*)(lds + 98304);
    for (int i = tid; i < 4 * 2048; i += 512) { const float c = a.in[I_C][i]; cond[i] = c / (1.f + expf(-c)); }
    if (blockIdx.x < 64) s5_precompute(a, lds, blockIdx.x, wv); else __syncthreads();
    unsigned long long* MODI = (unsigned long long*)(a.ws + CTL_MODI);
    for (int it = gw; it < 2 * 48 * 16; it += NGW) { const int l = it / 768, cc = (it % 768) / 16, kc = it % 16, col = cc * 256 + lane * 4;
        const float* W = a.in[I_ADAW] + ((size_t)l * 2048 + kc * 128) * 12288 + col;
        f32x4 acc[4]; for (int b = 0; b < 4; ++b) acc[b] = (f32x4){0.f, 0.f, 0.f, 0.f};
#pragma unroll 8
        for (int k = 0; k < 128; ++k) { const f32x4 w = *(const f32x4*)(W + (size_t)k * 12288);
#pragma unroll
            for (int b = 0; b < 4; ++b) acc[b] += w * cond[b * 2048 + kc * 128 + k]; }
        if (kc == 0) { const f32x4 bb = *(const f32x4*)(a.in[I_ADAB] + l * 12288 + col); for (int b = 0; b < 4; ++b) acc[b] += bb; }
#pragma unroll
        for (int b = 0; b < 4; ++b) { unsigned long long* o = MODI + (size_t)(l * 4 + b) * 12288 + col;
#pragma unroll
            for (int e = 0; e < 4; ++e) atomicAdd(o + e, (unsigned long long)__double2ll_rn((double)acc[b][e] * 1099511627776.0)); } }
    LAS unsigned char* scr = lds + wave * 8704;
    for (int j = 0; j < N_CONV_JOBS; ++j) { const ConvJob J = conv_job(a, j); const int nit = J.nmat * (J.K / 64) * (J.Nd / 64);
        for (int it = gw; it < nit; it += NGW) conv_item(J, scr, it, lane); }
    { float* RC = (float*)(a.ws + WS_ROPE); float* RS = RC + 4096 * 32; const int gt = blockIdx.x * 512 + tid;
      for (int i = gt; i < 4096 * 32; i += G * 512) { const int pos = i >> 5, j = i & 31; const float inv = powf(10000.f, -(float)(2 * j) / 64.f); float sn, cs; sincosf((float)pos * inv, &sn, &cs); RC[i] = cs; RS[i] = sn; }
      float* BL = (float*)(a.ws + WS_BIAS);
      for (int i = gt; i < 3 * 8 * 132; i += G * 512) { const int gi = i / (8 * 132), h = (i / 132) % 8, dl = i % 132; const int dil = gi == 0 ? 1 : (gi == 1 ? 4 : 16);
          BL[i] = dl <= 128 ? a.in[I_RELB][t5_bucket(dl * dil) * 24 + gi * 8 + h] * 1.44269504089f : 0.f; } }
}

DI float modi2f(unsigned long long v) { return (float)((double)(long long)v * 9.094947017729282e-13); }
DI void modulate_rows(const float* x, const unsigned long long* MODI, float* MODF, bf16* H, int wv) {
    const int lane = otid(wv) & 63, gw = blockIdx.x * 8 + (otid(wv) >> 6), NGW = gridDim.x * 8;
    for (int i = gw * 64 + lane; i < 2 * 4 * 12288; i += NGW * 64) MODF[i] = modi2f(MODI[i]);
    for (int m = gw; m < T; m += NGW) { const int b = m / SEQ; const unsigned long long* sh = MODI + (size_t)b * 12288; const unsigned long long* sc = sh + 2048;
#pragma unroll
        for (int j = 0; j < 8; ++j) { const int col = (lane + 64 * j) * 4; const f32x4 v = *(const f32x4*)(x + (size_t)m * D + col);
            const f32x4 s1 = {modi2f(sc[col]), modi2f(sc[col + 1]), modi2f(sc[col + 2]), modi2f(sc[col + 3])}, s0 = {modi2f(sh[col]), modi2f(sh[col + 1]), modi2f(sh[col + 2]), modi2f(sh[col + 3])};
            const f32x4 h = v * (s1 + 1.f) + s0; *(unsigned*)((unsigned char*)H + (size_t)m * D + col) = pk4_fp8(h.x, h.y, h.z, h.w); } }
}

using pg8::Unit;
#define P32(ptr, elemoff) ((decltype(ptr))((char*)(ptr) + (unsigned)((unsigned)(elemoff) * (unsigned)sizeof(*(ptr)))))
typedef f32x4 Acc[2][2][4][2];
#define EPI_ROWS_BEGIN const int row0 = u.pm * 256 + wr * 64 + fr; _Pragma("unroll") for (int ai = 0; ai < 2; ++ai) _Pragma("unroll") for (int m = 0; m < 4; ++m) { const int row = row0 + ai * 128 + m * 16;
#define EPI_ROWS_END __builtin_amdgcn_sched_barrier(0); }
DI u32x4 pack8(const f32x4& v0, const f32x4& v1) { u32x4 o = {pk2(v0.x, v0.y), pk2(v0.z, v0.w), pk2(v1.x, v1.y), pk2(v1.z, v1.w)}; return o; }

struct EpiIn0 { static constexpr bool PERM = true;
    bf16 *QC, *KVC, *KR, *XH; float *ssq;
    DI void operator()(const Acc& acc, const Unit& u, int wr, int wc, int fr, int fq) const {
        EPI_ROWS_BEGIN
            float ss = 0.f;
#pragma unroll
            for (int bj = 0; bj < 2; ++bj) { const f32x4 v0 = acc[ai][bj][m][0], v1 = acc[ai][bj][m][1]; const int col = 128 * bj + 32 * wc + 8 * fq; const u32x4 o = pack8(v0, v1);
                if (u.pn < 2) { *(u32x4*)P32(QC, row * 512 + u.pn * 256 + col) = o; ss += v0.x * v0.x + v0.y * v0.y + v0.z * v0.z + v0.w * v0.w + v1.x * v1.x + v1.y * v1.y + v1.z * v1.z + v1.w * v1.w; }
                else if (u.pn == 2) { *(u32x4*)P32(KVC, row * 256 + col) = o; ss += v0.x * v0.x + v0.y * v0.y + v0.z * v0.z + v0.w * v0.w + v1.x * v1.x + v1.y * v1.y + v1.z * v1.z + v1.w * v1.w; }
                else if (u.pn < 7) { const int uc = (u.pn - 3) * 256 + col, g = uc >> 4; *(u32x4*)P32(XH, (g * 1024 + (row >> 4)) * 384 + (row & 15) * 16 + (uc & 15)) = o; }
                else if (col < 64) { *(u32x4*)P32(KR, row * 64 + col) = o; } }
            if (u.pn <= 2) { ss += __shfl_xor(ss, 16); ss += __shfl_xor(ss, 32); if (fq == 0) *P32(ssq, row * 12 + u.pn * 4 + wc) = ss; }
        EPI_ROWS_END
    }
};
struct EpiQ { static constexpr bool PERM = true;
    bf16* Q; const float* ssq; const float* rope;
    DI void operator()(const Acc& acc, const Unit& u, int wr, int wc, int fr, int fq) const {
        EPI_ROWS_BEGIN
            const f32x4 q0 = *(const f32x4*)P32(ssq, row * 12), q1 = *(const f32x4*)P32(ssq, row * 12 + 4);
            const float rs = __builtin_amdgcn_rsqf((((q0.x + q0.y) + (q0.z + q0.w)) + ((q1.x + q1.y) + (q1.z + q1.w))) * (1.f / 512.f) + RMS_EPS) * (0.07216878364870322f * 1.44269504089f);
            const int b = row / SEQ, s = row % SEQ;
#pragma unroll
            for (int bj = 0; bj < 2; ++bj) { f32x4 v0 = acc[ai][bj][m][0] * rs, v1 = acc[ai][bj][m][1] * rs; const int n = u.pn * 256 + 128 * bj + 32 * wc + 8 * fq, h = n / 192, j = n % 192;
                if (j >= 128) { const int q = (j - 128) >> 3; const f32x4 cs = *(const f32x4*)P32(rope, s * 32 + 4 * q), sn = *(const f32x4*)P32(rope, 4096 * 32 + s * 32 + 4 * q);
                    const f32x4 x1 = v0, x2 = v1; v0 = x1 * cs - x2 * sn; v1 = x1 * sn + x2 * cs; }
                *(u32x4*)P32(Q, ((b * 8 + h) * SEQ + s) * 192 + j) = pack8(v0, v1); }
        EPI_ROWS_END
    }
};
struct EpiKV { static constexpr bool PERM = true;
    bf16 *KF, *V; const float* ssq;
    DI void operator()(const Acc& acc, const Unit& u, int wr, int wc, int fr, int fq) const {
        EPI_ROWS_BEGIN
            const f32x4 q2 = *(const f32x4*)P32(ssq, row * 12 + 8); const float rs = __builtin_amdgcn_rsqf(((q2.x + q2.y) + (q2.z + q2.w)) * (1.f / 256.f) + RMS_EPS); const int b = row / SEQ, s = row % SEQ, h = u.pn, j = 32 * wc + 8 * fq; const int tok = (b * 8 + h) * SEQ + s;
            *(u32x4*)P32(KF, tok * 192 + j) = pack8(acc[ai][0][m][0] * rs, acc[ai][0][m][1] * rs);
            *(u32x4*)P32(V, tok * 128 + j) = pack8(acc[ai][1][m][0] * rs, acc[ai][1][m][1] * rs);
        EPI_ROWS_END
    }
};
struct S5Order { int G, c;
    DI bool next(int i, Unit& u) const { const int L = i * G + c; if (L >= 256) return false; u.pm = L; u.pn = L >> 2; u.aux = 0; return true; }
    DI int arow(const Unit&, int) const { return 0; }
    DI int koff(const Unit&) const { return 0; } };
struct EpiS5E { static constexpr bool PERM = false;
    float* ES;
    DI void operator()(const Acc& acc, const Unit& u, int wr, int wc, int fr, int fq) const {
        EPI_ROWS_BEGIN
#pragma unroll
            for (int n = 0; n < 2; ++n) *(f32x4*)P32(ES, row * 128 + 32 * wc + 16 * n + 4 * fq) = acc[ai][0][m][n];
        EPI_ROWS_END
    }
};
DI float gelu_tanh(float x) { const float t = 0.7978845608028654f * (x + 0.044715f * x * x * x); const float e = __expf(2.f * t); return 0.5f * x * (1.f + (1.f - 2.f * __builtin_amdgcn_rcpf(e + 1.f))); }
struct EpiS5Y { static constexpr bool PERM = true;
    bf16* YS5; const bf16* XH; const float* dsk;
    DI void operator()(const Acc& acc, const Unit& u, int wr, int wc, int fr, int fq) const {
        EPI_ROWS_BEGIN
            const int g = row >> 10, chunk = row & 1023;
#pragma unroll
            for (int bj = 0; bj < 2; ++bj) { const int col = 128 * bj + 32 * wc + 8 * fq, tl = col >> 4, c0 = col & 15; const u32x4 uu = *(const u32x4*)P32(XH, row * 384 + col);
                const f32x4 d0 = *(const f32x4*)P32(dsk, g * 16 + c0), d1 = *(const f32x4*)P32(dsk, g * 16 + c0 + 4); const f32x4 a0 = acc[ai][bj][m][0], a1 = acc[ai][bj][m][1];
                f32x4 y0 = {a0.x + d0.x * bflo(uu.x), a0.y + d0.y * bfhi(uu.x), a0.z + d0.z * bflo(uu.y), a0.w + d0.w * bfhi(uu.y)};
                f32x4 y1 = {a1.x + d1.x * bflo(uu.z), a1.y + d1.y * bfhi(uu.z), a1.z + d1.z * bflo(uu.w), a1.w + d1.w * bfhi(uu.w)};
#pragma unroll
                for (int e = 0; e < 4; ++e) { y0[e] = gelu_tanh(y0[e]); y1[e] = gelu_tanh(y1[e]); }
                *(u32x4*)P32(YS5, (chunk * 16 + tl) * 1024 + g * 16 + c0) = pack8(y0, y1); }
        EPI_ROWS_END
    }
};
struct EpiGlu { static constexpr bool PERM = true;
    bf16* MIX; const bf16* YS5;
    DI void operator()(const Acc& acc, const Unit& u, int wr, int wc, int fr, int fq) const {
        EPI_ROWS_BEGIN
#pragma unroll
            for (int bj = 0; bj < 2; ++bj) { const int col = u.pn * 256 + 128 * bj + 32 * wc + 8 * fq; const u32x4 yy = *(const u32x4*)P32(YS5, row * 1024 + col); const f32x4 a0 = acc[ai][bj][m][0], a1 = acc[ai][bj][m][1];
                const f32x4 o0 = {bflo(yy.x) * sigmoidf_(a0.x), bfhi(yy.x) * sigmoidf_(a0.y), bflo(yy.y) * sigmoidf_(a0.z), bfhi(yy.y) * sigmoidf_(a0.w)};
                const f32x4 o1 = {bflo(yy.z) * sigmoidf_(a1.x), bfhi(yy.z) * sigmoidf_(a1.y), bflo(yy.w) * sigmoidf_(a1.z), bfhi(yy.w) * sigmoidf_(a1.w)};
                { unsigned char* mx = (unsigned char*)MIX; u32x2 o8 = {pk4_fp8(o0.x, o0.y, o0.z, o0.w), pk4_fp8(o1.x, o1.y, o1.z, o1.w)}; *(u32x2*)P32(mx, row * 2048 + 1024 + col) = o8; } }
        EPI_ROWS_END
    }
};
template <bool XBF> struct EpiRes { static constexpr bool PERM = true;
    bf16* XPRE; const void* xres; const float* gate;
    DI void operator()(const Acc& acc, const Unit& u, int wr, int wc, int fr, int fq) const {
        EPI_ROWS_BEGIN
            const int b = row / SEQ;
#pragma unroll
            for (int bj = 0; bj < 2; ++bj) { const int col = u.pn * 256 + 128 * bj + 32 * wc + 8 * fq;
                f32x4 x0, x1;
                if (XBF) { const bf16* xb = (const bf16*)xres; const u32x4 xq = *(const u32x4*)P32(xb, row * D + col); x0 = (f32x4){bflo(xq.x), bfhi(xq.x), bflo(xq.y), bfhi(xq.y)}; x1 = (f32x4){bflo(xq.z), bfhi(xq.z), bflo(xq.w), bfhi(xq.w)}; }
                else { const float* xf = (const float*)xres; x0 = *(const f32x4*)P32(xf, row * D + col); x1 = *(const f32x4*)P32(xf, row * D + col + 4); }
                const f32x4 g0 = *(const f32x4*)P32(gate, b * 12288 + col), g1 = *(const f32x4*)P32(gate, b * 12288 + col + 4);
                *(u32x4*)P32(XPRE, row * D + col) = pack8(x0 * DN_ALPHA + (g0 + 1.f) * acc[ai][bj][m][0], x1 * DN_ALPHA + (g1 + 1.f) * acc[ai][bj][m][1]); }
        EPI_ROWS_END
    }
};

DI void krope_pass(const bf16* KR, const float* rope, bf16* KF, int wv) {
    const int gt = blockIdx.x * 512 + otid(wv), NT_ = gridDim.x * 512;
    for (int i = gt; i < T * 8; i += NT_) { const int row = i >> 3, q = i & 7, b = row / SEQ, s = row % SEQ; const u32x4 r = *(const u32x4*)(KR + (size_t)row * 64 + q * 8);
        const f32x4 x1 = {bflo(r.x), bfhi(r.x), bflo(r.y), bfhi(r.y)}, x2 = {bflo(r.z), bfhi(r.z), bflo(r.w), bfhi(r.w)};
        const f32x4 cs = *(const f32x4*)(rope + s * 32 + 4 * q), sn = *(const f32x4*)(rope + 4096 * 32 + s * 32 + 4 * q);
        const u32x4 o = pack8(x1 * cs - x2 * sn, x1 * sn + x2 * cs);
#pragma unroll
        for (int h = 0; h < 8; ++h) *(u32x4*)(KF + ((size_t)(b * 8 + h) * SEQ + s) * 192 + 128 + q * 8) = o; }
}
DI void s5_carry(const float* ES, const float* L16, bf16* XH, LAS unsigned char* lds, int wv) {
    const int tid = otid(wv), lane = tid & 63, w = tid >> 6; LAS float* SEG = (LAS float*)lds;
    for (int base = blockIdx.x * 64; base < 4 * 64 * 64; base += gridDim.x * 64) {
        const int gt = base + lane, p = gt & 63, g = (gt >> 6) & 63, b = gt >> 12; const float lr = L16[(g * 64 + p) * 2], li = L16[(g * 64 + p) * 2 + 1];
        const size_t r0 = (size_t)g * 1024 + b * 256 + 32 * w;
        float hr = 0.f, hi = 0.f;
#pragma unroll 16
        for (int k = 0; k < 32; ++k) { const float er = ES[(r0 + k) * 128 + p], ei = ES[(r0 + k) * 128 + 64 + p]; const float nr = lr * hr - li * hi + er, ni = lr * hi + li * hr + ei; hr = nr; hi = ni; }
        __syncthreads();
        SEG[(w * 64 + lane) * 2] = hr; SEG[(w * 64 + lane) * 2 + 1] = hi;
        float pr = lr, pi = li;
#pragma unroll
        for (int q = 0; q < 5; ++q) { const float nr = pr * pr - pi * pi, ni = 2.f * pr * pi; pr = nr; pi = ni; }
        __syncthreads();
        hr = 0.f; hi = 0.f;
        for (int u = 0; u < w; ++u) { const float er = SEG[(u * 64 + lane) * 2], ei = SEG[(u * 64 + lane) * 2 + 1]; const float nr = pr * hr - pi * hi + er, ni = pr * hi + pi * hr + ei; hr = nr; hi = ni; }
#pragma unroll 16
        for (int k = 0; k < 32; ++k) { const float er = ES[(r0 + k) * 128 + p], ei = ES[(r0 + k) * 128 + 64 + p];
            XH[(r0 + k) * 384 + 256 + p] = f2bf(hr); XH[(r0 + k) * 384 + 320 + p] = f2bf(hi);
            const float nr = lr * hr - li * hi + er, ni = lr * hi + li * hr + ei; hr = nr; hi = ni; }
    }
    __syncthreads();
}

#define MFMA32(a, b, c) __builtin_amdgcn_mfma_f32_32x32x16_bf16((a), (b), (c), 0, 0, 0)
constexpr int AT_KROW = 384, AT_VROW = 256, AT_KBYTES = 64 * AT_KROW, AT_STG = AT_KBYTES + 64 * AT_VROW, AT_NST = 3;
static_assert(AT_NST * AT_STG <= RING_BYTES, "attention LDS");
DI void mla_attn_unit(LAS unsigned char* lds, const bf16* Qg, const bf16* KFg, const bf16* Vg, bf16* MIX, int unit, int wv) {
    const int tid = otid(wv), lane = tid & 63, w = tid >> 6, r = lane & 31, hh = lane >> 5;
    const int b = unit >> 6, h = (unit >> 3) & 7, pi = unit & 7;
    const bf16* Qh = Qg + (size_t)(b * 8 + h) * SEQ * 192; const bf16* Kh = KFg + (size_t)(b * 8 + h) * SEQ * 192; const bf16* Vh = Vg + (size_t)(b * 8 + h) * SEQ * 128;
    const int w_ = __builtin_amdgcn_readfirstlane(w);
    int koff[3], voff[2];
#pragma unroll
    for (int i = 0; i < 3; ++i) { const int p = (3 * w_ + i) * 64 + lane, row = p / 24, cs = p % 24, c = (cs & ~7) | ((cs ^ (row >> 1)) & 7); koff[i] = row * 192 + c * 8; }
#pragma unroll
    for (int i = 0; i < 2; ++i) { const int p = (2 * w_ + i) * 64 + lane, row = p >> 4, cs = p & 15, c = cs ^ ((row & 3) << 2); voff[i] = row * 128 + c * 8; }
    const int kx = (r >> 1) & 7, vq = (lane >> 2) & 3;
    for (int half = 0; half < 2; ++half) {
        const int qb = half ? 15 - pi : pi, q0 = qb * 256 + 32 * w, nkt = (qb + 1) * 4;
        bf16x8 qf[12];
#pragma unroll
        for (int ks = 0; ks < 12; ++ks) qf[ks] = *(const GAS bf16x8*)P32(Qh, (q0 + r) * 192 + 16 * ks + 8 * hh);
        f32x16 O[4];
#pragma unroll
        for (int i = 0; i < 4; ++i) for (int e = 0; e < 16; ++e) O[i][e] = 0.f;
        float mrow = -1e30f, lrow = 0.f;
#define AT_DMA(kt, stg) do { LAS unsigned char* sb_ = lds + (stg) * AT_STG; \
        _Pragma("unroll") for (int i = 0; i < 3; ++i) __builtin_amdgcn_global_load_lds((const unsigned*)P32(Kh, (kt) * 64 * 192 + koff[i]), (LAS unsigned*)(sb_ + (3 * w_ + i) * 1024), 16, 0, 0); \
        _Pragma("unroll") for (int i = 0; i < 2; ++i) __builtin_amdgcn_global_load_lds((const unsigned*)P32(Vh, (kt) * 64 * 128 + voff[i]), (LAS unsigned*)(sb_ + AT_KBYTES + (2 * w_ + i) * 1024), 16, 0, 0); } while (0)
#define AT_BAR() do { asm volatile("s_waitcnt lgkmcnt(0)" ::: "memory"); __builtin_amdgcn_s_barrier(); asm volatile("" ::: "memory"); } while (0)
        __syncthreads();
        AT_DMA(0, 0); AT_DMA(1, 1);
        asm volatile("s_waitcnt vmcnt(5)" ::: "memory");
        AT_BAR();
        int stg = 0;
        for (int kt = 0; kt < nkt; ++kt) {
            if (kt + 2 < nkt) AT_DMA(kt + 2, stg == 0 ? 2 : stg - 1);
            const LAS unsigned char* sb = lds + stg * AT_STG;
            if (kt * 64 <= q0 + 31) {
                f32x16 st[2];
#pragma unroll
                for (int mt = 0; mt < 2; ++mt) for (int e = 0; e < 16; ++e) st[mt][e] = 0.f;
                __builtin_amdgcn_sched_barrier(0);
                {
                    const LAS unsigned char* kb = sb + r * AT_KROW; const LAS unsigned char* kx4[4];
#pragma unroll
                    for (int j = 0; j < 4; ++j) kx4[j] = kb + (((2 * j + hh) ^ kx) & 7) * 16;
                    bf16x8 kf[24];
#pragma unroll
                    for (int i = 0; i < 24; ++i) kf[i] = *(const LAS bf16x8*)(kx4[(i >> 1) & 3] + 32 * (i & 1) * AT_KROW + 128 * (i >> 3));
#pragma unroll
                    for (int i = 0; i < 24; ++i) st[i & 1] = MFMA32(kf[i], qf[i >> 1], st[i & 1]);
                    __builtin_amdgcn_sched_group_barrier(0x100, 4, 0);
#pragma unroll
                    for (int i = 0; i < 24; ++i) { __builtin_amdgcn_sched_group_barrier(0x008, 1, 0); __builtin_amdgcn_sched_group_barrier(0x100, 1, 0); }
                }
                __builtin_amdgcn_sched_barrier(0);
                if (kt * 64 + 63 > q0) {
                    const int qg = q0 + r;
#pragma unroll
                    for (int mt = 0; mt < 2; ++mt)
#pragma unroll
                        for (int e = 0; e < 16; ++e) { const int kg = kt * 64 + 32 * mt + (e & 3) + 8 * (e >> 2) + 4 * hh; if (kg > qg) st[mt][e] = -1e30f; }
                }
                float mx = st[0][0];
#pragma unroll
                for (int mt = 0; mt < 2; ++mt)
#pragma unroll
                    for (int e = 0; e < 16; ++e) mx = fmaxf(mx, st[mt][e]);
                mx = fmaxf(mx, __shfl_xor(mx, 32));
                const float mnew = fmaxf(mrow, mx), alpha = __builtin_amdgcn_exp2f(mrow - mnew); mrow = mnew;
                float ls = 0.f;
#pragma unroll
                for (int mt = 0; mt < 2; ++mt)
#pragma unroll
                    for (int e = 0; e < 16; ++e) { const float p = __builtin_amdgcn_exp2f(st[mt][e] - mnew); st[mt][e] = p; ls += p; }
                lrow = lrow * alpha + ls;
                if (__any(alpha != 1.f)) {
#pragma unroll
                    for (int i = 0; i < 4; ++i) O[i] *= alpha; }
                bf16x8 pf[2][2];
#pragma unroll
                for (int mt = 0; mt < 2; ++mt)
#pragma unroll
                    for (int s = 0; s < 2; ++s) { u32x4 pk = {pk2(st[mt][8 * s], st[mt][8 * s + 1]), pk2(st[mt][8 * s + 2], st[mt][8 * s + 3]), pk2(st[mt][8 * s + 4], st[mt][8 * s + 5]), pk2(st[mt][8 * s + 6], st[mt][8 * s + 7])};
                        pf[mt][s] = __builtin_bit_cast(bf16x8, pk); }
                __builtin_amdgcn_sched_barrier(0);
                {
                    const LAS unsigned char* vb = sb + AT_KBYTES + (4 * hh + vq) * AT_VROW + 32 * ((lane >> 4) & 1) + 8 * (lane & 3); const LAS unsigned char* vx4[4];
#pragma unroll
                    for (int d = 0; d < 4; ++d) vx4[d] = vb + ((d ^ vq) & 3) * 64;
                    bf16x8 af[16];
#pragma unroll
                    for (int i = 0; i < 16; ++i) { const LAS unsigned char* vp = vx4[i & 3] + 16 * (i >> 2) * AT_VROW;
                        const s16x4 lo = __builtin_amdgcn_ds_read_tr16_b64_v4i16((LAS s16x4*)vp), hi = __builtin_amdgcn_ds_read_tr16_b64_v4i16((LAS s16x4*)(vp + 8 * AT_VROW)); af[i] = __builtin_shufflevector(lo, hi, 0, 1, 2, 3, 4, 5, 6, 7); }
#pragma unroll
                    for (int i = 0; i < 16; ++i) O[i & 3] = MFMA32(af[i], pf[i >> 3][(i >> 2) & 1], O[i & 3]);
                    __builtin_amdgcn_sched_group_barrier(0x100, 8, 0);
#pragma unroll
                    for (int i = 0; i < 16; ++i) { __builtin_amdgcn_sched_group_barrier(0x008, 1, 0); __builtin_amdgcn_sched_group_barrier(0x100, 2, 0); }
                }
                __builtin_amdgcn_sched_barrier(0);
            }
            if (kt + 2 < nkt) asm volatile("s_waitcnt vmcnt(5)" ::: "memory"); else asm volatile("s_waitcnt vmcnt(0)" ::: "memory");
            AT_BAR();
            stg = stg == 2 ? 0 : stg + 1;
        }
        lrow += __shfl_xor(lrow, 32);
        const float inv = 1.f / lrow;
        unsigned char* mx_ = (unsigned char*)MIX; unsigned char* orow = P32(mx_, (b * SEQ + q0 + r) * 2048 + h * 128);
#pragma unroll
        for (int dvt = 0; dvt < 4; ++dvt)
#pragma unroll
            for (int g4 = 0; g4 < 4; ++g4) *(GAS unsigned*)(orow + dvt * 32 + 8 * g4 + 4 * hh) = pk4_fp8(O[dvt][4 * g4] * inv, O[dvt][4 * g4 + 1] * inv, O[dvt][4 * g4 + 2] * inv, O[dvt][4 * g4 + 3] * inv);
    }
#undef AT_DMA
#undef AT_BAR
}

DI void ln_router_phase(const KArgs& a, LAS unsigned char* lds, int layer, const bf16* XPRE, bf16* X1, bf16* H, int wv) {
    const int tid = otid(wv), lane = tid & 63, wave = tid >> 6;
    LAS float* wT = (LAS float*)lds;
    { f32x4 rw[4][4];
#pragma unroll
      for (int i = 0; i < 4; ++i)
#pragma unroll
          for (int q4 = 0; q4 < 4; ++q4) rw[i][q4] = *(const f32x4*)(a.in[I_RW] + (size_t)(tid + 512 * i) * 16 + 4 * q4);
#pragma unroll
      for (int i = 0; i < 4; ++i)
#pragma unroll
          for (int q4 = 0; q4 < 4; ++q4)
#pragma unroll
              for (int e4 = 0; e4 < 4; ++e4) wT[(4 * q4 + e4) * 2048 + tid + 512 * i] = rw[i][q4][e4]; }
    __syncthreads();
    const float* MODl = (const float*)(a.ws + CTL_MOD) + (size_t)layer * 4 * 12288;
    const float* lg = a.in[I_LNMG] + layer * D; const float* lb = a.in[I_LNMB] + layer * D;
    unsigned* cnt = (unsigned*)(a.ws + CTL_CNT) + layer * 16 * 64;
    LAS int* lcnt = (LAS int*)(lds + LDS_MISC + 256); LAS int* lbase = lcnt + 16; LAS int* rec = lcnt + 32;
    if (tid < 16) lcnt[tid] = 0;
    int* RTE = (int*)(a.ws + A_RT); int* RTP = RTE + 2 * T; float* RTW = (float*)(RTP + 2 * T); int* TOKL = (int*)(a.ws + A_TOKL);
    const LAS float* wp[16];
#pragma unroll
    for (int e = 0; e < 16; ++e) { wp[e] = wT + e * 2048 + lane * 4; asm volatile("" : "+v"(wp[e])); }
    const float rbl = a.in[I_RB][lane >> 2];
    int lr = wave;
    for (int m = blockIdx.x * 8 + wave; m < T; m += gridDim.x * 8, lr += 8) {
        const int b = m / SEQ; const float* sh = MODl + (size_t)b * 12288 + 3 * 2048; const float* sc = sh + 2048;
        f32x4 v[8]; float s = 0.f;
#pragma unroll
        for (int j = 0; j < 8; ++j) { const u32x2 xp = *(const GAS u32x2*)(XPRE + (size_t)m * D + (lane + 64 * j) * 4); v[j] = (f32x4){bflo(xp.x), bfhi(xp.x), bflo(xp.y), bfhi(xp.y)}; s += (v[j].x + v[j].y) + (v[j].z + v[j].w); }
        const float mean = wave_sum(s) * (1.f / D); float s2 = 0.f;
#pragma unroll
        for (int j = 0; j < 8; ++j) { v[j] = v[j] - mean; s2 += (v[j].x * v[j].x + v[j].y * v[j].y) + (v[j].z * v[j].z + v[j].w * v[j].w); }
        const float rstd = rsqrtf(wave_sum(s2) * (1.f / D) + LN_EPS);
#pragma unroll
        for (int j = 0; j < 8; ++j) { const int col = (lane + 64 * j) * 4; const f32x4 x1 = v[j] * rstd * *(const f32x4*)(lg + col) + *(const f32x4*)(lb + col);
            { u32x2 ox = {pk2(x1.x, x1.y), pk2(x1.z, x1.w)}; *(GAS u32x2*)(X1 + (size_t)m * D + col) = ox; }
            const f32x4 hv = x1 * (*(const f32x4*)(sc + col) + 1.f) + *(const f32x4*)(sh + col);
            *(GAS unsigned*)((unsigned char*)H + (size_t)m * D + col) = pk4_fp8(hv.x, hv.y, hv.z, hv.w); v[j] = hv; }
        f32x2 part2[16];
#pragma unroll
        for (int e = 0; e < 16; ++e) part2[e] = (f32x2){0.f, 0.f};
#pragma unroll
        for (int j = 0; j < 8; ++j) { f32x4 wr_[16];
#pragma unroll
            for (int e = 0; e < 16; ++e) wr_[e] = *(const LAS f32x4*)(wp[e] + j * 256);
            __builtin_amdgcn_sched_barrier(0);
#pragma unroll
            for (int e = 0; e < 16; ++e) { part2[e] += (f32x2){v[j].x, v[j].y} * (f32x2){wr_[e].x, wr_[e].y}; part2[e] += (f32x2){v[j].z, v[j].w} * (f32x2){wr_[e].z, wr_[e].w}; }
            __builtin_amdgcn_sched_barrier(0); }
        float part[16];
#pragma unroll
        for (int e = 0; e < 16; ++e) part[e] = part2[e].x + part2[e].y;
        float r8[8], r4[4], r2[2], lg1;
        { const bool hi = lane & 32;
#pragma unroll
          for (int i = 0; i < 8; ++i) { const float mine = hi ? part[8 + i] : part[i], oth = hi ? part[i] : part[8 + i]; r8[i] = mine + __shfl_xor(oth, 32); } }
        { const bool hi = lane & 16;
#pragma unroll
          for (int i = 0; i < 4; ++i) { const float mine = hi ? r8[4 + i] : r8[i], oth = hi ? r8[i] : r8[4 + i]; r4[i] = mine + __shfl_xor(oth, 16); } }
        { const bool hi = lane & 8;
#pragma unroll
          for (int i = 0; i < 2; ++i) { const float mine = hi ? r4[2 + i] : r4[i], oth = hi ? r4[i] : r4[2 + i]; r2[i] = mine + __shfl_xor(oth, 8); } }
        { const bool hi = lane & 4; const float mine = hi ? r2[1] : r2[0], oth = hi ? r2[0] : r2[1]; lg1 = mine + __shfl_xor(oth, 4); }
        lg1 += dpp_xor1(lg1); lg1 += dpp_xor2(lg1);
        const float sgl = 1.f / (1.f + expf(-lg1)), sbl = sgl + rbl;
        float gs; { const float y1 = dpp_ror<4>(sbl), y2 = dpp_ror<8>(sbl), y3 = dpp_ror<12>(sbl);
            gs = fmaxf(fmaxf(fmaxf(sbl + y1, sbl + y2), fmaxf(sbl + y3, y1 + y2)), fmaxf(y1 + y3, y2 + y3)); }
        int bg = 0; float bgs = __builtin_bit_cast(float, __builtin_amdgcn_readlane(__builtin_bit_cast(int, gs), 0)); asm volatile("" : "+v"(bgs));
#pragma unroll
        for (int g = 1; g < 4; ++g) { float x = __builtin_bit_cast(float, __builtin_amdgcn_readlane(__builtin_bit_cast(int, gs), 16 * g)); asm volatile("" : "+v"(x)); const bool c = x > bgs; bgs = c ? x : bgs; bg = c ? g : bg; }
        const int bgu = __builtin_amdgcn_readfirstlane(bg);
        int e0 = 0, e1 = 0; float b0 = -1e30f, b1 = -1e30f, s0 = 0.f, s1 = 0.f;
#pragma unroll
        for (int i = 0; i < 4; ++i) { float x = __builtin_bit_cast(float, __builtin_amdgcn_readlane(__builtin_bit_cast(int, sbl), 16 * bgu + 4 * i)), sx = __builtin_bit_cast(float, __builtin_amdgcn_readlane(__builtin_bit_cast(int, sgl), 16 * bgu + 4 * i));
            asm volatile("" : "+v"(x), "+v"(sx)); const int e = 4 * bg + i; const bool g0 = x > b0, g1 = x > b1;
            b1 = g0 ? b0 : (g1 ? x : b1); e1 = g0 ? e0 : (g1 ? e : e1); s1 = g0 ? s0 : (g1 ? sx : s1);
            b0 = g0 ? x : b0; e0 = g0 ? e : e0; s0 = g0 ? sx : s0; }
        if (lane == 0) { const float inv = 1.f / (s0 + s1);
            const int p0 = __hip_atomic_fetch_add(lcnt + e0, 1, __ATOMIC_RELAXED, __HIP_MEMORY_SCOPE_WORKGROUP), p1 = __hip_atomic_fetch_add(lcnt + e1, 1, __ATOMIC_RELAXED, __HIP_MEMORY_SCOPE_WORKGROUP);
            rec[lr * 4] = m; rec[lr * 4 + 1] = e0; rec[lr * 4 + 2] = e1; rec[lr * 4 + 3] = p0 | (p1 << 16);
            RTE[2 * m] = e0; RTE[2 * m + 1] = e1; RTW[2 * m] = s0 * inv; RTW[2 * m + 1] = s1 * inv; }
    }
    __syncthreads();
    if (tid < 16) lbase[tid] = (int)atomicAdd(cnt + tid * 64, (unsigned)lcnt[tid]);
    __syncthreads();
    const int nrows = (T - (int)blockIdx.x * 8 + (int)gridDim.x * 8 - 1) / ((int)gridDim.x * 8) * 8;
    for (int i = tid; i < nrows; i += 512) { const int k = i >> 3, w8 = i & 7, m = (int)blockIdx.x * 8 + w8 + k * (int)gridDim.x * 8;
        if (m < T) { const int e0 = rec[i * 4 + 1], e1 = rec[i * 4 + 2], pp = rec[i * 4 + 3], q0 = lbase[e0] + (pp & 0xffff), q1 = lbase[e1] + (pp >> 16);
            TOKL[e0 * T + q0] = m; TOKL[e1 * T + q1] = m; RTP[2 * m] = q0; RTP[2 * m + 1] = q1; } }
    __syncthreads();
}

DI void moe_table(const KArgs& a, LAS unsigned char* lds, int layer, int wv) {
    LAS int* tab = (LAS int*)(lds + LDS_TAB);
    if (otid(wv) == 0) { const unsigned* cnt = (const unsigned*)(a.ws + CTL_CNT) + layer * 16 * 64; int acc = 0;
        for (int e = 0; e < 16; ++e) { const int c = (int)cnt[e * 64]; tab[e] = acc; tab[32 + e] = c; acc += (c + 255) >> 8; } tab[16] = acc; }
    __syncthreads();
}
template <int NTB> struct MoeOrder {
    int G, c, layer; const LAS int* tab; const int* tokl;
    DI bool next(int i, Unit& u) const { const int L = i * G + c, mt = L / NTB, nt = L % NTB; if (mt >= tab[16]) return false; int e = 0;
#pragma unroll
        for (int k = 1; k < 16; ++k) e += (mt >= tab[k]) ? 1 : 0;
        u.pm = mt; u.pn = (layer * 16 + e) * NTB + nt; u.aux = e | (nt << 8) | ((mt - tab[e]) << 16); return true; }
    DI int arow(const Unit& u, int r) const { const int e = u.aux & 255, j = (u.aux >> 16) * 256 + r; return j < tab[32 + e] ? tokl[e * T + j] : 0; }
    DI int koff(const Unit&) const { return 0; }
};
struct EpiGateUp { static constexpr bool PERM = true;
    unsigned char* ACT;
    DI void operator()(const Acc& acc, const Unit& u, int wr, int wc, int fr, int fq) const {
        const int nt = (u.aux >> 8) & 255;
        EPI_ROWS_BEGIN
            const f32x4 g0 = acc[ai][0][m][0], g1 = acc[ai][0][m][1], u0 = acc[ai][1][m][0], u1 = acc[ai][1][m][1];
            f32x4 o0, o1;
#pragma unroll
            for (int e = 0; e < 4; ++e) { o0[e] = g0[e] * sigmoidf_(g0[e]) * u0[e]; o1[e] = g1[e] * sigmoidf_(g1[e]) * u1[e]; }
            u32x2 o8 = {pk4_fp8(o0.x, o0.y, o0.z, o0.w), pk4_fp8(o1.x, o1.y, o1.z, o1.w)}; *(u32x2*)P32(ACT, row * 512 + nt * 128 + 32 * wc + 8 * fq) = o8;
        EPI_ROWS_END
    }
};
struct EpiDown { static constexpr bool PERM = true;
    bf16* YS;
    DI void operator()(const Acc& acc, const Unit& u, int wr, int wc, int fr, int fq) const {
        const int nt = (u.aux >> 8) & 255;
        EPI_ROWS_BEGIN
#pragma unroll
            for (int bj = 0; bj < 2; ++bj) *(u32x4*)P32(YS, row * 2048 + nt * 256 + 128 * bj + 32 * wc + 8 * fq) = pack8(acc[ai][bj][m][0], acc[ai][bj][m][1]);
        EPI_ROWS_END
    }
};
DI void ln_ffn_phase(const KArgs& a, int layer, const bf16* X1, float* XO, bf16* Hn, int wv) {
    const int lane = otid(wv) & 63, wave = otid(wv) >> 6;
    const float* MODl = (const float*)(a.ws + CTL_MOD) + (size_t)layer * 4 * 12288; const float* MODn = MODl + 4 * 12288;
    const float* lg = a.in[I_LNFG] + layer * D; const float* lb = a.in[I_LNFB] + layer * D;
    const unsigned* cnt = (const unsigned*)(a.ws + CTL_CNT) + layer * 16 * 64;
    const int* RTE = (const int*)(a.ws + A_RT); const int* RTP = RTE + 2 * T; const float* RTW = (const float*)(RTP + 2 * T); const bf16* YS = (const bf16*)(a.ws + A_YS);
    for (int m = blockIdx.x * 8 + wave; m < T; m += gridDim.x * 8) {
        const int b = m / SEQ; const float* gf = MODl + (size_t)b * 12288 + 5 * 2048;
        const int e0 = RTE[2 * m], e1 = RTE[2 * m + 1]; int t0 = 0, t1 = 0;
        for (int e = 0; e < 16; ++e) { const int tl = ((int)cnt[e * 64] + 255) >> 8; t0 += e < e0 ? tl : 0; t1 += e < e1 ? tl : 0; }
        const bf16* y0 = YS + ((size_t)t0 * 256 + RTP[2 * m]) * 2048; const bf16* y1 = YS + ((size_t)t1 * 256 + RTP[2 * m + 1]) * 2048; const float w0 = RTW[2 * m], w1 = RTW[2 * m + 1];
        f32x4 v[8]; float s = 0.f;
#pragma unroll
        for (int j = 0; j < 8; ++j) { const int col = (lane + 64 * j) * 4; const u32x2 a0 = *(const u32x2*)(y0 + col), a1 = *(const u32x2*)(y1 + col);
            const f32x4 y = {w0 * bflo(a0.x) + w1 * bflo(a1.x), w0 * bfhi(a0.x) + w1 * bfhi(a1.x), w0 * bflo(a0.y) + w1 * bflo(a1.y), w0 * bfhi(a0.y) + w1 * bfhi(a1.y)};
            const u32x2 xq = *(const u32x2*)(X1 + (size_t)m * D + col); const f32x4 xv = {bflo(xq.x), bfhi(xq.x), bflo(xq.y), bfhi(xq.y)};
            v[j] = xv * DN_ALPHA + (*(const f32x4*)(gf + col) + 1.f) * y; s += (v[j].x + v[j].y) + (v[j].z + v[j].w); }
        const float mean = wave_sum(s) * (1.f / D); float s2 = 0.f;
#pragma unroll
        for (int j = 0; j < 8; ++j) { v[j] = v[j] - mean; s2 += (v[j].x * v[j].x + v[j].y * v[j].y) + (v[j].z * v[j].z + v[j].w * v[j].w); }
        const float rstd = rsqrtf(wave_sum(s2) * (1.f / D) + LN_EPS);
#pragma unroll
        for (int j = 0; j < 8; ++j) { const int col = (lane + 64 * j) * 4; const f32x4 xo = v[j] * rstd * *(const f32x4*)(lg + col) + *(const f32x4*)(lb + col);
            if (Hn) { u32x2 oq = {pk2(xo.x, xo.y), pk2(xo.z, xo.w)}; *(u32x2*)((bf16*)XO + (size_t)m * D + col) = oq; }
            else *(f32x4*)(XO + (size_t)m * D + col) = xo;
            if (Hn) { const float* sh = MODn + (size_t)b * 12288; const f32x4 hv = xo * (*(const f32x4*)(sh + 2048 + col) + 1.f) + *(const f32x4*)(sh + col);
                *(unsigned*)((unsigned char*)Hn + (size_t)m * D + col) = pk4_fp8(hv.x, hv.y, hv.z, hv.w); } }
    }
}

struct EpiIn1 { static constexpr bool PERM = true;
    bf16 *ZD, *ZR;
    DI void operator()(const Acc& acc, const Unit& u, int wr, int wc, int fr, int fq) const {
        EPI_ROWS_BEGIN
#pragma unroll
            for (int bj = 0; bj < 2; ++bj) { const int col = u.pn * 256 + 128 * bj + 32 * wc + 8 * fq; const u32x4 o = pack8(acc[ai][bj][m][0], acc[ai][bj][m][1]);
                if (col < DIL_IN) *(u32x4*)P32(ZD, row * DIL_IN + col) = o; else if (col < ODD_IN) *(u32x4*)P32(ZR, row * RW_IN + (col - DIL_IN)) = o; }
        EPI_ROWS_END
    }
};
constexpr int DA_KSTR = 272, DA_VROW = 320, DA_KBYTES = 64 * DA_KSTR, DA_STG = DA_KBYTES + 64 * DA_VROW;
struct DilPre { bf16x8 qf[4]; u32x4 kreg[2], vreg[2]; float blv[2]; };
DI void dil_issue(const bf16* ZD, const float* BL, int unit, int wv, DilPre& P) {
    const int tid = otid(wv), lane = tid & 63, w = tid >> 6, r = lane & 31, hh = lane >> 5, hd = w >> 2, qs = w & 3;
    const int hp = unit & 3, sb_ = (unit >> 2) & 31, gi = (unit >> 7) % 3, b = unit / 384;
    const int dil = gi == 0 ? 1 : (gi == 1 ? 4 : 16), nb = 32 / dil, rr = sb_ / nb, n = sb_ % nb, h = hp * 2 + hd, kt0 = n == 0 ? 2 : 0;
    const bf16* Zb = ZD + (size_t)b * SEQ * DIL_IN + gi * 1536;
    const int qtok = (n * 128 + 32 * qs + r) * dil + rr;
#pragma unroll
    for (int k = 0; k < 2; ++k) { const int i = tid + 512 * k, hd_ = i >= 384 ? 1 : 0, d = i - 384 * hd_ - 127;
        P.blv[k] = (i < 768 && d >= 0 && d <= 128) ? ((const GAS float*)BL)[(gi * 8 + hp * 2 + hd_) * 132 + d] : -1e30f; }
#pragma unroll
    for (int ks = 0; ks < 4; ++ks) P.qf[ks] = *(const GAS bf16x8*)P32(Zb, qtok * DIL_IN + h * 64 + 16 * ks + 8 * hh);
#pragma unroll
    for (int i = 0; i < 2; ++i) { const int p = tid + 512 * i, kr = p >> 4, c16 = p & 15; const int ktok = ((n - 1) * 128 + kt0 * 64 + kr) * dil + rr;
        P.kreg[i] = *(const GAS u32x4*)P32(Zb, ktok * DIL_IN + 512 + hp * 128 + c16 * 8); P.vreg[i] = *(const GAS u32x4*)P32(Zb, ktok * DIL_IN + 1024 + hp * 128 + c16 * 8); }
}
DI void dil_attn_unit(LAS unsigned char* lds, const bf16* ZD, const float* BL, bf16* DPO, float* DPM, float* DPL, int unit, int next, DilPre& P, int wv) {
    const int tid = otid(wv), lane = tid & 63, w = tid >> 6, r = lane & 31, hh = lane >> 5, hd = w >> 2, qs = w & 3;
    const int hp = unit & 3, sb_ = (unit >> 2) & 31, gi = (unit >> 7) % 3, b = unit / 384;
    const int dil = gi == 0 ? 1 : (gi == 1 ? 4 : 16), nb = 32 / dil, rr = sb_ / nb, n = sb_ % nb;
    const int h = hp * 2 + hd;
    const bf16* Zb = ZD + (size_t)b * SEQ * DIL_IN + gi * 1536;
    LAS float* bl = (LAS float*)(lds + 2 * DA_STG);
    __syncthreads();
    bl[tid] = P.blv[0]; if (tid < 256) bl[512 + tid] = P.blv[1];
    const int qi = 32 * qs + r, qtok = (n * 128 + qi) * dil + rr;
    bf16x8 qf[4];
#pragma unroll
    for (int ks = 0; ks < 4; ++ks) qf[ks] = P.qf[ks];
    f32x16 O[2];
#pragma unroll
    for (int i = 0; i < 2; ++i) for (int e = 0; e < 16; ++e) O[i][e] = 0.f;
    float mrow = -1e30f, lrow = 0.f;
    u32x4 kreg[2] = {P.kreg[0], P.kreg[1]}, vreg[2] = {P.vreg[0], P.vreg[1]};
    const int kt0 = n == 0 ? 2 : 0;
#define DA_LOAD(kt) do { _Pragma("unroll") for (int i = 0; i < 2; ++i) { const int p = tid + 512 * i, kr = p >> 4, c16 = p & 15; const int ktok = ((n - 1) * 128 + (kt) * 64 + kr) * dil + rr; \
            kreg[i] = *(const GAS u32x4*)P32(Zb, ktok * DIL_IN + 512 + hp * 128 + c16 * 8); } \
        _Pragma("unroll") for (int i = 0; i < 2; ++i) { const int p = tid + 512 * i, kr = p >> 4, c16 = p & 15; const int ktok = ((n - 1) * 128 + (kt) * 64 + kr) * dil + rr; vreg[i] = *(const GAS u32x4*)P32(Zb, ktok * DIL_IN + 1024 + hp * 128 + c16 * 8); } } while (0)
#define DA_STORE(buf) do { LAS unsigned char* sb = lds + (buf) * DA_STG; _Pragma("unroll") for (int i = 0; i < 2; ++i) { const int p = tid + 512 * i, kr = p >> 4, c16 = p & 15; *(LAS u32x4*)(sb + kr * DA_KSTR + c16 * 16) = kreg[i]; } \
        _Pragma("unroll") for (int i = 0; i < 2; ++i) { const int p = tid + 512 * i; *(LAS u32x4*)(sb + DA_KBYTES + (p >> 4) * DA_VROW + (p & 15) * 16) = vreg[i]; } } while (0)
    DA_STORE(kt0 & 1);
    __syncthreads();
    for (int kt = kt0; kt < 4; ++kt) {
        if (kt + 1 < 4) DA_LOAD(kt + 1); else if (next >= 0) dil_issue(ZD, BL, next, wv, P);
        const LAS unsigned char* sb = lds + (kt & 1) * DA_STG;
        if (64 * kt + 63 >= 32 * qs && 64 * kt <= 32 * qs + 31 + 128) {
            f32x16 st[2];
#pragma unroll
            for (int mt = 0; mt < 2; ++mt) for (int e = 0; e < 16; ++e) st[mt][e] = 0.f;
            __builtin_amdgcn_sched_barrier(0);
            {
                const LAS unsigned char* kb = sb + r * DA_KSTR + (hd * 64 + 8 * hh) * 2; bf16x8 kf[8];
#pragma unroll
                for (int i = 0; i < 8; ++i) kf[i] = *(const LAS bf16x8*)(kb + 32 * (i & 1) * DA_KSTR + 32 * (i >> 1));
#pragma unroll
                for (int i = 0; i < 8; ++i) st[i & 1] = MFMA32(kf[i], qf[i >> 1], st[i & 1]);
                __builtin_amdgcn_sched_group_barrier(0x100, 3, 0);
#pragma unroll
                for (int i = 0; i < 8; ++i) { __builtin_amdgcn_sched_group_barrier(0x008, 1, 0); __builtin_amdgcn_sched_group_barrier(0x100, 1, 0); }
            }
            __builtin_amdgcn_sched_barrier(0);
#pragma unroll
            for (int mt = 0; mt < 2; ++mt) { const LAS float* lp = bl + hd * 384 + 127 + (128 + qi - 64 * kt - 32 * mt - 4 * hh) - 27;
#pragma unroll
                for (int e = 0; e < 16; ++e) st[mt][e] = st[mt][e] * (0.125f * 1.44269504089f) + lp[27 - ((e & 3) + 8 * (e >> 2))]; }
            float mx = st[0][0];
#pragma unroll
            for (int mt = 0; mt < 2; ++mt)
#pragma unroll
                for (int e = 0; e < 16; ++e) mx = fmaxf(mx, st[mt][e]);
            mx = fmaxf(mx, __shfl_xor(mx, 32));
            const float mnew = fmaxf(mrow, mx), alpha = __builtin_amdgcn_exp2f(mrow - mnew); mrow = mnew;
            float ls = 0.f;
#pragma unroll
            for (int mt = 0; mt < 2; ++mt)
#pragma unroll
                for (int e = 0; e < 16; ++e) { const float p = __builtin_amdgcn_exp2f(st[mt][e] - mnew); st[mt][e] = p; ls += p; }
            lrow = lrow * alpha + ls;
            if (__any(alpha != 1.f)) { O[0] *= alpha; O[1] *= alpha; }
            bf16x8 pf[2][2];
#pragma unroll
            for (int mt = 0; mt < 2; ++mt)
#pragma unroll
                for (int s = 0; s < 2; ++s) { u32x4 pk = {pk2(st[mt][8 * s], st[mt][8 * s + 1]), pk2(st[mt][8 * s + 2], st[mt][8 * s + 3]), pk2(st[mt][8 * s + 4], st[mt][8 * s + 5]), pk2(st[mt][8 * s + 6], st[mt][8 * s + 7])};
                    pf[mt][s] = __builtin_bit_cast(bf16x8, pk); }
            __builtin_amdgcn_sched_barrier(0);
            {
                const LAS unsigned char* vb = sb + DA_KBYTES + (4 * hh + ((lane >> 2) & 3)) * DA_VROW + (hd * 64 + 16 * ((lane >> 4) & 1)) * 2 + 8 * (lane & 3); bf16x8 af[8];
#pragma unroll
                for (int i = 0; i < 8; ++i) { const LAS unsigned char* vp = vb + 16 * (i >> 1) * DA_VROW + (i & 1) * 64;
                    const s16x4 lo = __builtin_amdgcn_ds_read_tr16_b64_v4i16((LAS s16x4*)vp), hi = __builtin_amdgcn_ds_read_tr16_b64_v4i16((LAS s16x4*)(vp + 8 * DA_VROW)); af[i] = __builtin_shufflevector(lo, hi, 0, 1, 2, 3, 4, 5, 6, 7); }
#pragma unroll
                for (int i = 0; i < 8; ++i) O[i & 1] = MFMA32(af[i], pf[i >> 2][(i >> 1) & 1], O[i & 1]);
                __builtin_amdgcn_sched_group_barrier(0x100, 6, 0);
#pragma unroll
                for (int i = 0; i < 8; ++i) { __builtin_amdgcn_sched_group_barrier(0x008, 1, 0); __builtin_amdgcn_sched_group_barrier(0x100, 2, 0); }
            }
            __builtin_amdgcn_sched_barrier(0);
        }
        if (kt + 1 < 4) DA_STORE((kt + 1) & 1);
        __syncthreads();
    }
    lrow += __shfl_xor(lrow, 32);
    const float inv = 1.f / lrow;
    const int tokg = b * SEQ + qtok;
    bf16* orow = P32(DPO, (gi * T + tokg) * 512 + h * 64);
#pragma unroll
    for (int dvt = 0; dvt < 2; ++dvt)
#pragma unroll
        for (int g4 = 0; g4 < 4; ++g4) { u32x2 o = {pk2(O[dvt][4 * g4] * inv, O[dvt][4 * g4 + 1] * inv), pk2(O[dvt][4 * g4 + 2] * inv, O[dvt][4 * g4 + 3] * inv)};
            *(GAS u32x2*)(orow + dvt * 32 + 8 * g4 + 4 * hh) = o; }
    if (hh == 0) { *(GAS float*)P32(DPM, (gi * T + tokg) * 8 + h) = mrow; *(GAS float*)P32(DPL, (gi * T + tokg) * 8 + h) = lrow; }
#undef DA_LOAD
#undef DA_STORE
}
DI void dil_merge(const bf16* DPO, const float* DPM, const float* DPL, bf16* MIX, int wv) {
    const int gt = blockIdx.x * 512 + otid(wv), NT_ = gridDim.x * 512;
    for (int i = gt; i < T * 64; i += NT_) { const int tok = i >> 6, c8 = i & 63, h = c8 >> 3;
        float m[3], l[3];
#pragma unroll
        for (int g = 0; g < 3; ++g) { m[g] = DPM[((size_t)g * T + tok) * 8 + h]; l[g] = DPL[((size_t)g * T + tok) * 8 + h]; }
        const float M = fmaxf(m[0], fmaxf(m[1], m[2])); float wsum = 0.f, wg[3];
#pragma unroll
        for (int g = 0; g < 3; ++g) { wg[g] = __builtin_amdgcn_exp2f(m[g] - M) * l[g]; wsum += wg[g]; }
        const float inv = __builtin_amdgcn_rcpf(wsum); float o[8];
#pragma unroll
        for (int e = 0; e < 8; ++e) o[e] = 0.f;
#pragma unroll
        for (int g = 0; g < 3; ++g) { const u32x4 v = *(const u32x4*)(DPO + ((size_t)g * T + tok) * 512 + c8 * 8); const float wn = wg[g] * inv;
            o[0] += wn * bflo(v.x); o[1] += wn * bfhi(v.x); o[2] += wn * bflo(v.y); o[3] += wn * bfhi(v.y); o[4] += wn * bflo(v.z); o[5] += wn * bfhi(v.z); o[6] += wn * bflo(v.w); o[7] += wn * bfhi(v.w); }
        u32x2 r = {pk4_fp8(o[0], o[1], o[2], o[3]), pk4_fp8(o[4], o[5], o[6], o[7])}; *(u32x2*)((unsigned char*)MIX + (size_t)tok * 2048 + c8 * 8) = r; }
}

DI void rwkv_prep(const bf16* ZR, const float* mu, bf16* LIN, int wv) {
    const int gt = blockIdx.x * 512 + otid(wv), NT_ = gridDim.x * 512;
    for (int i = gt; i < T * 48; i += NT_) { const int tok = i / 48, c0 = (i % 48) * 8, s = tok % SEQ; float o[8];
        if (c0 < 352) { const u32x4 z = *(const u32x4*)(ZR + (size_t)tok * RW_IN + 4608 + c0); u32x4 zp = {0u, 0u, 0u, 0u}; if (s > 0) zp = *(const u32x4*)(ZR + (size_t)(tok - 1) * RW_IN + 4608 + c0);
            const unsigned* zz = (const unsigned*)&z; const unsigned* pp = (const unsigned*)&zp;
#pragma unroll
            for (int e = 0; e < 8; ++e) { const float zv = (e & 1) ? bfhi(zz[e >> 1]) : bflo(zz[e >> 1]), pv = (e & 1) ? bfhi(pp[e >> 1]) : bflo(pp[e >> 1]); const float xs = zv + (pv - zv) * mu[4608 + c0 + e];
                o[e] = c0 < 64 ? 1.f - 2.f * __builtin_amdgcn_rcpf(1.f + __expf(2.f * xs)) : (c0 < 128 ? xs : sigmoidf_(xs)); } }
        else {
#pragma unroll
            for (int e = 0; e < 8; ++e) o[e] = 0.f; }
        u32x4 r = {pk2(o[0], o[1]), pk2(o[2], o[3]), pk2(o[4], o[5]), pk2(o[6], o[7])}; *(u32x4*)(LIN + (size_t)tok * 384 + c0) = r; }
}
struct LoraOrder : pg8::StaticOrder { DI int koff(const Unit& u) const { return u.pn >= 12 ? 128 : 0; } };
struct EpiLora { static constexpr bool PERM = true;
    bf16 *WDEC, *AA, *GG; const float *w0, *a0;
    DI void operator()(const Acc& acc, const Unit& u, int wr, int wc, int fr, int fq) const {
        const int kind = u.pn / 6;
        EPI_ROWS_BEGIN
#pragma unroll
            for (int bj = 0; bj < 2; ++bj) { const int col = (u.pn % 6) * 256 + 128 * bj + 32 * wc + 8 * fq; f32x4 v0 = acc[ai][bj][m][0], v1 = acc[ai][bj][m][1];
                if (kind == 0) { const f32x4 b0 = *(const f32x4*)P32(w0, col), b1 = *(const f32x4*)P32(w0, col + 4);
#pragma unroll
                    for (int e = 0; e < 4; ++e) { v0[e] = -0.6065306597f * sigmoidf_(v0[e] + b0[e]); v1[e] = -0.6065306597f * sigmoidf_(v1[e] + b1[e]); }
                    *(u32x4*)P32(WDEC, row * RWW + col) = pack8(v0, v1); }
                else if (kind == 1) { const f32x4 b0 = *(const f32x4*)P32(a0, col), b1 = *(const f32x4*)P32(a0, col + 4);
#pragma unroll
                    for (int e = 0; e < 4; ++e) { v0[e] = sigmoidf_(v0[e] + b0[e]); v1[e] = sigmoidf_(v1[e] + b1[e]); }
                    *(u32x4*)P32(AA, row * RWW + col) = pack8(v0, v1); }
                else *(u32x4*)P32(GG, row * RWW + col) = pack8(v0, v1); }
        EPI_ROWS_END
    }
};
constexpr int CK_AT = 0, CK_RT = 2048, CK_BH = 4096, CK_KH = 6144, CK_MT = 8192, CK_NK = 8704, CK_PB = 9216, CK_PK = 9728, CK_G15 = 10240, CK_VT = 10496  , CK_VTS = 40, CK_BS = 13056  , CK_SLOT = 13120;
constexpr int CK_HALF = 128;
constexpr int CK_N1 = (int)((128 * MiB) / CK_SLOT) - 1;
DI unsigned char* ck_slot(unsigned char* ws, int job) { return job < CK_N1 ? ws + WS_X1 + (size_t)job * CK_SLOT : ws + WS_W_GU + (size_t)(job - CK_N1) * CK_SLOT; }
static_assert((size_t)(96 * CK_HALF - CK_N1 + 1) * CK_SLOT <= 64 * MiB, "chunk buffer");
constexpr int PJ = 4;
constexpr int PL_AT = 0, PL_BT = 2304, PL_KT = 4608, PL_RT = 6912, PL_BH = 9216, PL_KH = 11520  ,
              PL_NAB = 13824  , PL_MTS = 14848  , PL_LDT = 15616  , PL_C = 19968  ,
              PL_T = 24064  , PL_VT = 24320  , PL_END = 26880;
static_assert(PJ * PL_END <= RING_BYTES && PJ == 4, "prep LDS");
DI bf16x8 ldfrag(const LAS unsigned char* p) { return *(const LAS bf16x8*)p; }
DI u32x4 ld2x8(const LAS unsigned char* p0, const LAS unsigned char* p1) { const u32x2 lo = *(const LAS u32x2*)p0, hi = *(const LAS u32x2*)p1; return (u32x4){lo.x, lo.y, hi.x, hi.y}; }
DI void unpk8(const u32x4 v, float (&o)[8]) { o[0] = bflo(v.x); o[1] = bfhi(v.x); o[2] = bflo(v.y); o[3] = bfhi(v.y); o[4] = bflo(v.z); o[5] = bfhi(v.z); o[6] = bflo(v.w); o[7] = bfhi(v.w); }
DI void ldf8(const float* p, float (&o)[8]) { const f32x4 x = *(const f32x4*)p, y = *(const f32x4*)(p + 4); o[0] = x.x; o[1] = x.y; o[2] = x.z; o[3] = x.w; o[4] = y.x; o[5] = y.y; o[6] = y.z; o[7] = y.w; }
DI u32x4 pack8(const float (&x)[8]) { return (u32x4){pk2(x[0], x[1]), pk2(x[2], x[3]), pk2(x[4], x[5]), pk2(x[6], x[7])}; }
DI void rwkv_chunk_prep(const KArgs& a, LAS unsigned char* lds0, int half, int wv) {
    const int tid = otid(wv), lane = tid & 63, w = tid >> 6;
    const bf16* ZR = (const bf16*)(a.ws + A_ZR); const bf16* WDEC = (const bf16*)(a.ws + A_WDEC); const bf16* AA = (const bf16*)(a.ws + A_AA);
    const int js = tid >> 7, st = (tid >> 3) & 15, oc = tid & 7;
    LAS unsigned char* ldj = lds0 + js * PL_END;
    const float* mu = a.in[I_MU];
    bf16x8 lfrag;
#pragma unroll
    for (int j = 0; j < 8; ++j) lfrag[j] = ((lane & 31) >= 16 || 8 * (lane >> 5) + j <= (lane & 31)) ? (short)0x3F80 : (short)0;
    for (int it = blockIdx.x; it < 96 * CK_HALF / PJ; it += gridDim.x) {
        const int job0 = it * PJ, bh = job0 / CK_HALF, cl0 = job0 % CK_HALF, b = bh / 24, h = bh % 24, col = h * 64 + 8 * oc;
        const int s = (half * CK_HALF + cl0 + js) * 16 + st; const size_t tok = (size_t)b * SEQ + s;
        unsigned char* slot = ck_slot(a.ws, job0 + js);
        const bf16* z = ZR + tok * RW_IN + col;
        const u32x4 zr = *(const u32x4*)z, zk = *(const u32x4*)(z + 1536), zv = *(const u32x4*)(z + 3072);
        u32x4 pr = {0u, 0u, 0u, 0u}, pk_ = {0u, 0u, 0u, 0u}, pv = {0u, 0u, 0u, 0u};
        if (s > 0) { pr = *(const u32x4*)(z - RW_IN); pk_ = *(const u32x4*)(z - RW_IN + 1536); pv = *(const u32x4*)(z - RW_IN + 3072); }
        const u32x4 za = *(const u32x4*)(AA + tok * RWW + col), zw = *(const u32x4*)(WDEC + tok * RWW + col);
        float r[8], km[8], q[8], bb[8], ld[8];
        {   float cz[8], cp[8], m_[8], k_[8], v_[8], as_[8], c1[8], c2[8];
            unpk8(zr, cz); unpk8(pr, cp); ldf8(mu + col, m_);
#pragma unroll
            for (int e = 0; e < 8; ++e) r[e] = cz[e] + (cp[e] - cz[e]) * m_[e];
            unpk8(zk, cz); unpk8(pk_, cp); ldf8(mu + 1536 + col, m_);
#pragma unroll
            for (int e = 0; e < 8; ++e) k_[e] = cz[e] + (cp[e] - cz[e]) * m_[e];
            unpk8(zv, cz); unpk8(pv, cp); ldf8(mu + 3072 + col, m_);
#pragma unroll
            for (int e = 0; e < 8; ++e) v_[e] = cz[e] + (cp[e] - cz[e]) * m_[e];
            unpk8(za, as_); unpk8(zw, ld); ldf8(a.in[I_KK] + col, c1);
            float nn = 0.f;
#pragma unroll
            for (int e = 0; e < 8; ++e) { q[e] = k_[e] * c1[e]; nn += q[e] * q[e]; }
            nn = red8(nn);
            const float invn = fminf(__builtin_amdgcn_rsqf(nn), 1e12f);
            ldf8(a.in[I_KA] + col, c1); ldf8(a.in[I_RK] + col, c2);
            float bs = 0.f;
#pragma unroll
            for (int e = 0; e < 8; ++e) { q[e] *= invn; km[e] = k_[e] * (1.f + (as_[e] - 1.f) * c1[e]); bb[e] = q[e] * as_[e]; bs += r[e] * km[e] * c2[e]; }
            bs = red8(bs);
            if (oc == 0) *(float*)(slot + CK_BS + st * 4) = bs;
#pragma unroll
            for (int e = 0; e < 8; ++e) *(LAS float*)(ldj + PL_LDT + ((8 * oc + e) * 17 + st) * 4) = ld[e];
#pragma unroll
            for (int e = 0; e < 8; e += 2) { const unsigned pv2 = pk2(v_[e], v_[e + 1]);
                *(LAS bf16*)(ldj + PL_VT + (8 * oc + e) * CK_VTS + st * 2) = (bf16)(pv2 & 0xffffu); *(LAS bf16*)(ldj + PL_VT + (8 * oc + e + 1) * CK_VTS + st * 2) = (bf16)(pv2 >> 16); } }
        __syncthreads();
        {
            LAS unsigned char* lds = lds0 + (w >> 1) * PL_END; const int r_ = lane & 31, hh = lane >> 5, ch = 32 * (w & 1) + r_;
            float x[8];
#pragma unroll
            for (int j = 0; j < 8; ++j) x[j] = *(const LAS float*)(lds + PL_LDT + (ch * 17 + 8 * hh + j) * 4);
            const u32x4 ph = {pk2(x[0], x[1]), pk2(x[2], x[3]), pk2(x[4], x[5]), pk2(x[6], x[7])};
            const u32x4 pl = {pk2(x[0] - bflo(ph.x), x[1] - bfhi(ph.x)), pk2(x[2] - bflo(ph.y), x[3] - bfhi(ph.y)), pk2(x[4] - bflo(ph.z), x[5] - bfhi(ph.z)), pk2(x[6] - bflo(ph.w), x[7] - bfhi(ph.w))};
            f32x16 cs; for (int e = 0; e < 16; ++e) cs[e] = 0.f;
            cs = MFMA32(lfrag, __builtin_bit_cast(bf16x8, ph), cs); cs = MFMA32(lfrag, __builtin_bit_cast(bf16x8, pl), cs);
#pragma unroll
            for (int e = 0; e < 8; ++e) *(LAS float*)(lds + PL_C + (((e & 3) + 8 * (e >> 2) + 4 * hh) * 64 + ch) * 4) = cs[e];
            if (hh == 0) *(LAS float*)(lds + PL_T + ch * 4) = cs[8]; }
        __syncthreads();
        {
            float c[8], t[8];
            { const f32x4 ca = *(const LAS f32x4*)(ldj + PL_C + (st * 64 + 8 * oc) * 4), cb = *(const LAS f32x4*)(ldj + PL_C + (st * 64 + 8 * oc + 4) * 4), ta = *(const LAS f32x4*)(ldj + PL_T + 8 * oc * 4), tb = *(const LAS f32x4*)(ldj + PL_T + (8 * oc + 4) * 4);
              c[0] = ca.x; c[1] = ca.y; c[2] = ca.z; c[3] = ca.w; c[4] = cb.x; c[5] = cb.y; c[6] = cb.z; c[7] = cb.w; t[0] = ta.x; t[1] = ta.y; t[2] = ta.z; t[3] = ta.w; t[4] = tb.x; t[5] = tb.y; t[6] = tb.z; t[7] = tb.w; }
            float at[8], bt[8], kt[8], rt[8], bhv[8], khv[8];
#pragma unroll
            for (int e = 0; e < 8; ++e) { const float g = __expf(c[e]), gp = __expf(c[e] - ld[e]), gi = __expf(-c[e]), gr = __expf(t[e] - c[e]);
                at[e] = -q[e] * gp; bt[e] = bb[e] * gi; kt[e] = km[e] * gi; rt[e] = r[e] * g; bhv[e] = bb[e] * gr; khv[e] = km[e] * gr; }
            LAS unsigned char* row = ldj + st * 144 + oc * 16;
            *(LAS u32x4*)(row + PL_AT) = pack8(at); *(LAS u32x4*)(row + PL_BT) = pack8(bt); *(LAS u32x4*)(row + PL_KT) = pack8(kt); *(LAS u32x4*)(row + PL_RT) = pack8(rt);
            *(LAS u32x4*)(row + PL_BH) = pack8(bhv); *(LAS u32x4*)(row + PL_KH) = pack8(khv);
            if (st == 0) { *(f32x4*)(slot + CK_G15 + 8 * oc * 4) = (f32x4){__expf(t[0]), __expf(t[1]), __expf(t[2]), __expf(t[3])}; *(f32x4*)(slot + CK_G15 + (8 * oc + 4) * 4) = (f32x4){__expf(t[4]), __expf(t[5]), __expf(t[6]), __expf(t[7])}; } }
        __syncthreads();
        if (w < PJ) {
            LAS unsigned char* lds = lds0 + w * PL_END; unsigned char* slot = ck_slot(a.ws, job0 + w); const int r = lane & 31, hh = lane >> 5, r16 = r & 15;
            f32x16 d; for (int e = 0; e < 16; ++e) d[e] = 0.f;
#pragma unroll
            for (int ks = 0; ks < 4; ++ks) d = MFMA32(ldfrag(lds + (r < 16 ? PL_BT : PL_KT) + r16 * 144 + ks * 32 + hh * 16), ldfrag(lds + (r < 16 ? PL_AT : PL_RT) + r16 * 144 + ks * 32 + hh * 16), d);
            float lo8[8], hi8[8];
#pragma unroll
            for (int e = 0; e < 8; ++e) { const int sr = (e & 3) + 8 * (e >> 2) + 4 * hh; const bool keep = r < 16 ? sr < r16 : sr <= r16; lo8[e] = keep ? d[e] : 0.f; hi8[e] = keep ? d[8 + e] : 0.f; }
            const u32x4 plo = {pk2(lo8[0], lo8[1]), pk2(lo8[2], lo8[3]), pk2(lo8[4], lo8[5]), pk2(lo8[6], lo8[7])}, phi = {pk2(hi8[0], hi8[1]), pk2(hi8[2], hi8[3]), pk2(hi8[4], hi8[5]), pk2(hi8[6], hi8[7])};
            if (r < 16) {
#pragma unroll
                for (int e = 0; e < 8; ++e) *(LAS float*)(lds + PL_NAB + (((e & 3) + 8 * (e >> 2) + 4 * hh) * 16 + r16) * 4) = lo8[e];
                *(u32x4*)(slot + CK_NK + (r16 + 16 * hh) * 16) = phi; }
            else { *(u32x4*)(slot + CK_PB + (r16 + 16 * hh) * 16) = plo; *(u32x4*)(slot + CK_PK + (r16 + 16 * hh) * 16) = phi; }
            asm volatile("s_waitcnt lgkmcnt(0)" ::: "memory");
            if (lane < 16) { float mr[16]; int ln = lane; asm volatile("" : "+v"(ln));
#pragma unroll
                for (int t = 0; t < 16; ++t) { float acc = (ln == t) ? 1.f : 0.f;
#pragma unroll
                    for (int u = 0; u < t; ++u) acc += mr[u] * *(const LAS float*)(lds + PL_NAB + (u * 16 + t) * 4);
                    mr[t] = acc; *(LAS bf16*)(lds + PL_MTS + t * 48 + lane * 2) = f2bf(acc); } }
            asm volatile("s_waitcnt lgkmcnt(0)" ::: "memory");
            if (r < 16) *(u32x4*)(slot + CK_MT + (r + 16 * hh) * 16) = ld2x8(lds + PL_MTS + r * 48 + 8 * hh, lds + PL_MTS + r * 48 + 16 + 8 * hh);
        } else {
            const int e2 = tid - 256;
#pragma unroll
            for (int q4 = 0; q4 < PJ; ++q4) { const LAS unsigned char* lds = lds0 + q4 * PL_END; unsigned char* slot = ck_slot(a.ws, job0 + q4);
                { const int arr = e2 >> 7, i7 = e2 & 127, ks = i7 >> 5, t = i7 & 15, hh = (i7 >> 4) & 1;
                  const LAS unsigned char* p = lds + (arr ? PL_RT : PL_AT) + t * 144 + (16 * ks + 4 * hh) * 2;
                  *(u32x4*)(slot + (arr ? CK_RT : CK_AT) + (ks * 32 + t + 16 * hh) * 16) = ld2x8(p, p + 16); }
                { const int arr = e2 >> 7, J = (e2 >> 6) & 1;
                  const LAS unsigned char* p = lds + (arr ? PL_KH : PL_BH) + (4 * (lane >> 5) + ((lane >> 2) & 3)) * 144 + (32 * J + 16 * ((lane >> 4) & 1)) * 2 + 8 * (lane & 3);
                  const s16x4 lo = __builtin_amdgcn_ds_read_tr16_b64_v4i16((LAS s16x4*)p), hi = __builtin_amdgcn_ds_read_tr16_b64_v4i16((LAS s16x4*)(p + 8 * 144));
                  *(bf16x8*)(slot + (arr ? CK_KH : CK_BH) + (J * 64 + lane) * 16) = __builtin_shufflevector(lo, hi, 0, 1, 2, 3, 4, 5, 6, 7); }
                if (e2 < 160) *(u32x4*)(slot + CK_VT + e2 * 16) = *(const LAS u32x4*)(lds + PL_VT + e2 * 16); }
        }
    }
    __syncthreads();
}
constexpr int RC_NS = 8, RC_SLOT = 15360, RC_GG = 13312, RC_AHEAD = 6, RC_Y = RC_NS * RC_SLOT;
static_assert(RC_Y + 8192 <= RING_BYTES && CK_SLOT <= RC_GG, "rwkv ring");
template <int PM = 0> DI void rwkv_chunk_rec(const KArgs& a, LAS unsigned char* lds, int unit, int half, int wv) {
    const int tid = otid(wv), lane = tid & 63, w = __builtin_amdgcn_readfirstlane(tid >> 6), r = lane & 31, hh = lane >> 5;
    const int b = unit / 24, h = unit % 24;
    float* GST = (float*)(a.ws + A_GST) + (size_t)unit * 4096;
    const unsigned char* GGb = a.ws + A_GG; bf16* MIX = (bf16*)(a.ws + WS_H);
#define RC_DMA(srcp, dstp) __builtin_amdgcn_global_load_lds((const unsigned*)(srcp), (LAS unsigned*)(dstp), 16, 0, 0)
#define RC_ISSUE(cc) do { if ((PM & 1) == 0 && (w == 4 || w == 5)) { const unsigned char* src = ck_slot(a.ws, unit * CK_HALF + (cc)) + lane * 16; LAS unsigned char* dst = lds + ((cc) % RC_NS) * RC_SLOT; \
        if (w == 4) { _Pragma("unroll") for (int i_ = 0; i_ < 8; ++i_) RC_DMA(src + i_ * 1024, dst + i_ * 1024); } \
        else { _Pragma("unroll") for (int i_ = 8; i_ < 13; ++i_) RC_DMA(src + i_ * 1024, dst + i_ * 1024); \
            const unsigned char* gsrc = GGb + ((size_t)b * SEQ + (half * CK_HALF + (cc)) * 16 + (lane >> 3)) * (RWW * 2) + h * 128 + (lane & 7) * 16; \
            RC_DMA(gsrc, dst + RC_GG); RC_DMA(gsrc + 8 * RWW * 2, dst + RC_GG + 1024); } } } while (0)
#define RC_BAR() do { asm volatile("s_waitcnt lgkmcnt(0)" ::: "memory"); __builtin_amdgcn_s_barrier(); asm volatile("" ::: "memory"); } while (0)
    const bool epi = (w & 2) != 0; const int et = 4 * ((w & 1) + 2 * (w >> 2)) + (lane >> 4), eiq = lane & 15, ecol = h * 64 + 4 * eiq;
    const f32x4 elg = *(const f32x4*)(a.in[I_LNXG] + ecol), elb = *(const f32x4*)(a.in[I_LNXB] + ecol);
#define RC_EPI(sp, Yp, tokv) do { const f32x4 y = *(const LAS f32x4*)((Yp) + et * 64 + 4 * eiq); const u32x2 gq = *(const LAS u32x2*)((sp) + RC_GG + et * 128 + eiq * 8); \
        const float bsv = *(const LAS float*)((sp) + CK_BS + et * 4); const LAS unsigned char* vq = (sp) + CK_VT + 4 * eiq * CK_VTS + et * 2; \
        const f32x4 v4 = {bflo(*(const LAS unsigned short*)vq), bflo(*(const LAS unsigned short*)(vq + CK_VTS)), bflo(*(const LAS unsigned short*)(vq + 2 * CK_VTS)), bflo(*(const LAS unsigned short*)(vq + 3 * CK_VTS))}; \
        const float mean = red16((y.x + y.y) + (y.z + y.w)) * (1.f / 64.f); const f32x4 d = y - mean; \
        const float rstd = __builtin_amdgcn_rsqf(red16((d.x * d.x + d.y * d.y) + (d.z * d.z + d.w * d.w)) * (1.f / 64.f) + 64e-5f); \
        const f32x4 gg4 = {bflo(gq.x), bfhi(gq.x), bflo(gq.y), bfhi(gq.y)}, o = (d * rstd * elg + elb + v4 * bsv) * gg4; \
        if (PM == 0 || o.x == 1.2345f) *(unsigned*)((unsigned char*)MIX + (size_t)(tokv) * 2048 + 512 + ecol) = pk4_fp8(o.x, o.y, o.z, o.w); } while (0)
    f32x16 G0, G1;
#pragma unroll
    for (int e = 0; e < 16; ++e) { G0[e] = 0.f; G1[e] = 0.f; }
    if (half == 1 && w < 2) {
#pragma unroll
        for (int e = 0; e < 16; ++e) { G0[e] = GST[(w * 2 + 0) * 1024 + e * 64 + lane]; G1[e] = GST[(w * 2 + 1) * 1024 + e * 64 + lane]; } }
    __syncthreads();
#pragma unroll
    for (int cc = 0; cc < RC_AHEAD; ++cc) RC_ISSUE(cc);
    asm volatile("s_waitcnt vmcnt(0)" ::: "memory");
    RC_BAR();
    bf16x8 pAR[4], pNP, pVT;
#define RC_PRE(slotp) do { const LAS unsigned char* sp_ = (slotp); _Pragma("unroll") for (int ks = 0; ks < 4; ++ks) pAR[ks] = ldfrag(sp_ + ((r >> 4) ? CK_RT : CK_AT) + (ks * 32 + (r & 15) + 16 * hh) * 16); \
        pNP = ldfrag(sp_ + ((r >> 4) ? CK_PK : CK_NK) + ((r & 15) + 16 * hh) * 16); \
        { const LAS unsigned char* vq_ = sp_ + CK_VT + (32 * w + r) * CK_VTS + 8 * hh; const s16x4 vlo_ = *(const LAS s16x4*)vq_, vhi_ = *(const LAS s16x4*)(vq_ + 16); pVT = __builtin_shufflevector(vlo_, vhi_, 0, 1, 2, 3, 4, 5, 6, 7); } } while (0)
    if (w < 2) RC_PRE(lds);
    for (int c = 0; c < CK_HALF; ++c) {
        if (c + RC_AHEAD < CK_HALF) RC_ISSUE(c + RC_AHEAD);
        const LAS unsigned char* sb = lds + (c % RC_NS) * RC_SLOT;
        if (w < 2) {
            const int r16 = r & 15, up = r >> 4;
            bf16x8 fAR[4], fBH0, fBH1, fKH0, fKH1, fM, fNP, fPB; f32x4 gs0[4], gs1[4];
#pragma unroll
            for (int ks = 0; ks < 4; ++ks) fAR[ks] = pAR[ks];
            fNP = pNP; const bf16x8 vtf = pVT;
            __builtin_amdgcn_sched_barrier(0);
            fM = ldfrag(sb + CK_MT + (r16 + 16 * hh) * 16); fPB = ldfrag(sb + CK_PB + (r16 + 16 * hh) * 16);
            fBH0 = ldfrag(sb + CK_BH + lane * 16); fBH1 = ldfrag(sb + CK_BH + (64 + lane) * 16); fKH0 = ldfrag(sb + CK_KH + lane * 16); fKH1 = ldfrag(sb + CK_KH + (64 + lane) * 16);
#pragma unroll
            for (int g4 = 0; g4 < 4; ++g4) { gs0[g4] = *(const LAS f32x4*)(sb + CK_G15 + (8 * g4 + 4 * hh) * 4); gs1[g4] = *(const LAS f32x4*)(sb + CK_G15 + (32 + 8 * g4 + 4 * hh) * 4); }
            __builtin_amdgcn_sched_barrier(0);
            bf16x8 gf[4];
#pragma unroll
            for (int s2 = 0; s2 < 2; ++s2) { u32x4 p0 = {pk2(G0[8 * s2], G0[8 * s2 + 1]), pk2(G0[8 * s2 + 2], G0[8 * s2 + 3]), pk2(G0[8 * s2 + 4], G0[8 * s2 + 5]), pk2(G0[8 * s2 + 6], G0[8 * s2 + 7])};
                u32x4 p1 = {pk2(G1[8 * s2], G1[8 * s2 + 1]), pk2(G1[8 * s2 + 2], G1[8 * s2 + 3]), pk2(G1[8 * s2 + 4], G1[8 * s2 + 5]), pk2(G1[8 * s2 + 6], G1[8 * s2 + 7])};
                gf[s2] = __builtin_bit_cast(bf16x8, p0); gf[2 + s2] = __builtin_bit_cast(bf16x8, p1); }
            f32x16 XY;
#pragma unroll
            for (int e = 0; e < 16; ++e) XY[e] = 0.f;
#pragma unroll
            for (int ks = 0; ks < 4; ++ks) XY = MFMA32(fAR[ks], gf[ks], XY);
            XY = MFMA32(fNP, vtf, XY);
            { u32x4 px = {pk2(XY[0], XY[1]), pk2(XY[2], XY[3]), pk2(XY[4], XY[5]), pk2(XY[6], XY[7])}; const bf16x8 xf = __builtin_bit_cast(bf16x8, px);
              f32x16 U; for (int e = 0; e < 16; ++e) U[e] = 0.f;
              U = MFMA32(fM, xf, U);
              u32x4 pu = {pk2(U[0], U[1]), pk2(U[2], U[3]), pk2(U[4], U[5]), pk2(U[6], U[7])}; const bf16x8 uf = __builtin_bit_cast(bf16x8, pu);
              XY = MFMA32(fPB, uf, XY);
#pragma unroll
              for (int e = 0; e < 16; ++e) { G0[e] *= gs0[e >> 2][e & 3]; G1[e] *= gs1[e >> 2][e & 3]; }
              G0 = MFMA32(fBH0, uf, G0); G1 = MFMA32(fBH1, uf, G1); G0 = MFMA32(fKH0, vtf, G0); G1 = MFMA32(fKH1, vtf, G1); }
            __builtin_amdgcn_sched_barrier(0);
            if (c + 1 < CK_HALF) RC_PRE(lds + ((c + 1) % RC_NS) * RC_SLOT);
            LAS float* Y = (LAS float*)(lds + RC_Y + (c & 1) * 4096);
#pragma unroll
            for (int e = 0; e < 8; ++e) Y[((e & 3) + 8 * (e >> 2) + 4 * hh) * 64 + 32 * w + r] = XY[8 + e];
        } else if (epi) {
            if (c > 0) RC_EPI(lds + ((c - 1) % RC_NS) * RC_SLOT, (const LAS float*)(lds + RC_Y + ((c - 1) & 1) * 4096), (size_t)b * SEQ + (half * CK_HALF + c - 1) * 16 + et);
        } else {
            if (c + RC_AHEAD >= CK_HALF) asm volatile("s_waitcnt vmcnt(0)" ::: "memory"); else if (w == 4) asm volatile("s_waitcnt vmcnt(32)" ::: "memory"); else asm volatile("s_waitcnt vmcnt(28)" ::: "memory");
        }
        RC_BAR();
    }
    if (epi) RC_EPI(lds + ((CK_HALF - 1) % RC_NS) * RC_SLOT, (const LAS float*)(lds + RC_Y + ((CK_HALF - 1) & 1) * 4096), (size_t)b * SEQ + (half * CK_HALF + CK_HALF - 1) * 16 + et);
    else if (w < 2 && half == 0 && (PM == 0 || G0[0] == 1.2345f)) {
#pragma unroll
        for (int e = 0; e < 16; ++e) { GST[(w * 2 + 0) * 1024 + e * 64 + lane] = G0[e]; GST[(w * 2 + 1) * 1024 + e * 64 + lane] = G1[e]; } }
    asm volatile("s_waitcnt vmcnt(0)" ::: "memory");
    __syncthreads();
#undef RC_PRE
#undef RC_EPI
#undef RC_DMA
#undef RC_ISSUE
#undef RC_BAR
}

constexpr int N_PHASES = 25;
__global__ void __launch_bounds__(512, 2) fwd(KArgs a) {
    extern __shared__ __attribute__((aligned(16))) unsigned char lds_[];
    LAS unsigned char* lds = (LAS unsigned char*)lds_;
    const int wv = __builtin_amdgcn_readfirstlane((int)threadIdx.x >> 6), G = gridDim.x, bid = blockIdx.x;
    volatile LAS unsigned* MISC = (volatile LAS unsigned*)(lds + LDS_MISC);
    if (wv == 0) MISC[lane_id()] = 0u;
    __syncthreads();
    unsigned char* ws0 = a.ws;
#if N_LAUNCH_MODE == 0
    XcdBarrier bar = xcd_barrier_post((unsigned*)(ws0 + CTL_BAR), MISC + 8, wv);
#ifdef DBG_TIME_K1
#define SEAM(k) do { if (IN(k) && IN((k) + 1)) xcd_barrier(bar); if (bid == 0 && wv == 0 && lane_id() == 0) ((unsigned long long*)(ws0 + CTL_CHK))[1 + (k)] = __builtin_amdgcn_s_memrealtime(); } while (0)
#else
#define SEAM(k) do { if (IN(k) && IN((k) + 1)) xcd_barrier(bar); } while (0)
#endif
#else
#define SEAM(k) do { } while (0)
#endif
    const int lo = a.ph_lo, hi = a.ph_hi;
#ifdef DBG_TIME_K1
    if (bid == 0 && wv == 0 && lane_id() == 0) ((unsigned long long*)(ws0 + CTL_CHK))[0] = __builtin_amdgcn_s_memrealtime();
#endif
#ifndef PH_MASK
#define PH_MASK 0xFFFFFFFFu
#endif
#define IN(k) (((PH_MASK >> (k)) & 1u) && lo <= (k) && (k) < hi)
#ifndef REP_REC
#define REP_REC 0
#endif
#ifndef REP_DIL
#define REP_DIL 0
#endif
#ifndef REPEAT_MASK
#define REPEAT_MASK 0u
#endif
#define PH(k) for (int rp_ = 0; rp_ < (IN(k) ? 1 + (int)((REPEAT_MASK >> (k)) & 1u) : 0); ++rp_)
#define MOD ((float*)(ws + CTL_MOD))
#define Hb ((bf16*)(ws + WS_H))
#define X1 ((bf16*)(ws + WS_X1))
#define XPRE ((bf16*)(ws + A_XPRE))
    pg8::StaticOrder SO;

    PH(0) { unsigned char* ws = wsl(a.ws); p0_prologue(a, lds, wv); } SEAM(0);
    PH(1) { unsigned char* ws = wsl(a.ws); modulate_rows(a.in[I_X], (const unsigned long long*)(ws + CTL_MODI), MOD, Hb, wv); } SEAM(1);
    PH(2) { unsigned char* ws = wsl(a.ws); pg8::Gemm g{Hb, (const bf16*)(ws + WS_W_IN0), 2048, 2048, 2048}; SO.init(T, 2048, G, bid);
        EpiIn0 E{(bf16*)(ws + A_QC), (bf16*)(ws + A_KVC), (bf16*)(ws + A_KR), (bf16*)(ws + A_XH), (float*)(ws + CTL_SSQ)};
        pg8::gemm_phase<EpiIn0, pg8::StaticOrder, false, true>(lds, g, SO, E, wv); } SEAM(2);
    PH(3) { unsigned char* ws = wsl(a.ws);
        krope_pass((const bf16*)(ws + A_KR), (const float*)(ws + WS_ROPE), (bf16*)(ws + A_KF), wv);
        { pg8::Gemm g{(const bf16*)(ws + A_QC), (const bf16*)(ws + WS_W_UQ), 512, 512, 512}; SO.init(T, 1536, G, bid);
          EpiQ E{(bf16*)(ws + A_Q), (const float*)(ws + CTL_SSQ), (const float*)(ws + WS_ROPE)}; pg8::gemm_phase<EpiQ, pg8::StaticOrder, false>(lds, g, SO, E, wv); }
        { pg8::Gemm g{(const bf16*)(ws + A_KVC), (const bf16*)(ws + WS_W_UKV), 256, 256, 256}; SO.init(T, 2048, G, bid);
          EpiKV E{(bf16*)(ws + A_KF), (bf16*)(ws + A_V), (const float*)(ws + CTL_SSQ)}; pg8::gemm_phase<EpiKV, pg8::StaticOrder, false>(lds, g, SO, E, wv); }
        { pg8::Gemm g{(const bf16*)(ws + A_XH), (const bf16*)(ws + WS_S5BE), 384, 256, 256}; S5Order S{G, bid}; EpiS5E E{(float*)(ws + A_ES)}; pg8::gemm_phase<EpiS5E, S5Order, false>(lds, g, S, E, wv); }
    } SEAM(3);
    PH(4) { unsigned char* ws = wsl(a.ws);
        s5_carry((const float*)(ws + A_ES), (const float*)(ws + WS_S5L), (bf16*)(ws + A_XH), lds, wv);
        for (int u = bid; u < 256; u += G) mla_attn_unit(lds, (const bf16*)(ws + A_Q), (const bf16*)(ws + A_KF), (const bf16*)(ws + A_V), Hb, u, wv);
    } SEAM(4);
    PH(5) { unsigned char* ws = wsl(a.ws); pg8::Gemm g{(const bf16*)(ws + A_XH), (const bf16*)(ws + WS_S5BY), 384, 384, 384}; S5Order S{G, bid};
        EpiS5Y E{(bf16*)(ws + A_YS5), (const bf16*)(ws + A_XH), a.in[I_S5D]}; pg8::gemm_phase<EpiS5Y, S5Order, false>(lds, g, S, E, wv); } SEAM(5);
    PH(6) { unsigned char* ws = wsl(a.ws); pg8::Gemm g{(const bf16*)(ws + A_YS5), (const bf16*)(ws + WS_W_GLU), 1024, 1024, 1024}; SO.init(T, 1024, G, bid);
        EpiGlu E{Hb, (const bf16*)(ws + A_YS5)}; pg8::gemm_phase<EpiGlu, pg8::StaticOrder, false>(lds, g, SO, E, wv); } SEAM(6);
    PH(7) { unsigned char* ws = wsl(a.ws); pg8::Gemm g{Hb, (const bf16*)(ws + WS_W_OUT0), 2048, 2048, 2048}; SO.init(T, 2048, G, bid);
        EpiRes<false> E{XPRE, a.in[I_X], MOD + 2 * 2048}; pg8::gemm_phase<EpiRes<false>, pg8::StaticOrder, false, true>(lds, g, SO, E, wv); } SEAM(7);
#define MOE_PHASES(layer, pb) \
        PH(pb) { unsigned char* ws = wsl(a.ws); ln_router_phase(a, lds, layer, XPRE, X1, Hb, wv); } SEAM(pb); \
        PH(pb + 1) { unsigned char* ws = wsl(a.ws); moe_table(a, lds, layer, wv); pg8::Gemm g{Hb, (const bf16*)(ws + WS_W_GU8), 2048, 2048, 2048}; \
            MoeOrder<4> S{G, bid, layer, (const LAS int*)(lds + LDS_TAB), (const int*)(ws + A_TOKL)}; EpiGateUp E{ws + A_ACT}; pg8::gemm_phase<EpiGateUp, MoeOrder<4>, true, true>(lds, g, S, E, wv); } SEAM(pb + 1); \
        PH(pb + 2) { unsigned char* ws = wsl(a.ws); moe_table(a, lds, layer, wv); pg8::Gemm g{(const bf16*)(ws + A_ACT), (const bf16*)(ws + WS_W_DN), 512, 512, 512}; \
            MoeOrder<8> S{G, bid, layer, (const LAS int*)(lds + LDS_TAB), (const int*)(ws + A_TOKL)}; EpiDown E{(bf16*)(ws + A_YS)}; pg8::gemm_phase<EpiDown, MoeOrder<8>, false, true>(lds, g, S, E, wv); } SEAM(pb + 2); \
        PH(pb + 3) { unsigned char* ws = wsl(a.ws); ln_ffn_phase(a, layer, X1, a.out, layer == 0 ? Hb : nullptr, wv); } SEAM(pb + 3);
    MOE_PHASES(0, 8)
    PH(12) { unsigned char* ws = wsl(a.ws); pg8::Gemm g{Hb, (const bf16*)(ws + WS_W_IN1), 2048, 2048, 2048}; SO.init(T, 9728, G, bid);
        EpiIn1 E{(bf16*)(ws + A_ZD), (bf16*)(ws + A_ZR)}; pg8::gemm_phase<EpiIn1, pg8::StaticOrder, false, true>(lds, g, SO, E, wv); } SEAM(12);
    PH(13) { unsigned char* ws = wsl(a.ws); rwkv_prep((const bf16*)(ws + A_ZR), a.in[I_MU], (bf16*)(ws + A_LIN), wv); } SEAM(13);
    PH(14) { unsigned char* ws = wsl(a.ws);
        pg8::Gemm g{(const bf16*)(ws + A_LIN), (const bf16*)(ws + WS_W_LORA), 384, 384, 256}; LoraOrder LO; LO.init(T, 4608, G, bid);
        EpiLora E{(bf16*)(ws + A_WDEC), (bf16*)(ws + A_AA), (bf16*)(ws + A_GG), a.in[I_W0], a.in[I_A0]}; pg8::gemm_phase<EpiLora, LoraOrder, false>(lds, g, LO, E, wv);
} SEAM(14);
    PH(15) { rwkv_chunk_prep(a, lds, 0, wv); } SEAM(15);
    PH(16) { unsigned char* ws = wsl(a.ws); if (bid < 96 || G <= 96) { for (int u = bid; u < 96; u += G) { rwkv_chunk_rec(a, lds, u, 0, wv); if (REP_REC) rwkv_chunk_rec<REP_REC>(a, lds, u, 0, wv); } }
        if (G <= 96 || bid >= 96) { const int nb_ = G <= 96 ? G : G - 96, b0_ = G <= 96 ? bid : bid - 96;
            DilPre P; if (b0_ < 768) dil_issue((const bf16*)(ws + A_ZD), (const float*)(ws + WS_BIAS), b0_, wv, P);
            for (int u = b0_; u < 768; u += nb_) dil_attn_unit(lds, (const bf16*)(ws + A_ZD), (const float*)(ws + WS_BIAS), (bf16*)(ws + A_DPO), (float*)(ws + A_DPM), (float*)(ws + A_DPL), u, u + nb_ < 768 ? u + nb_ : -1, P, wv); } } SEAM(16);
    PH(17) { rwkv_chunk_prep(a, lds, 1, wv); } SEAM(17);
    PH(18) { unsigned char* ws = wsl(a.ws); if (bid < 96 || G <= 96) { for (int u = bid; u < 96; u += G) { rwkv_chunk_rec(a, lds, u, 1, wv); if (REP_REC) rwkv_chunk_rec<REP_REC>(a, lds, u, 1, wv); } }
        if (G <= 96 || bid >= 96) { const int nb_ = G <= 96 ? G : G - 96, b0_ = G <= 96 ? bid : bid - 96;
            DilPre P; if (768 + b0_ < 1536) dil_issue((const bf16*)(ws + A_ZD), (const float*)(ws + WS_BIAS), 768 + b0_, wv, P);
            for (int u = 768 + b0_; u < 1536; u += nb_) dil_attn_unit(lds, (const bf16*)(ws + A_ZD), (const float*)(ws + WS_BIAS), (bf16*)(ws + A_DPO), (float*)(ws + A_DPM), (float*)(ws + A_DPL), u, u + nb_ < 1536 ? u + nb_ : -1, P, wv); } } SEAM(18);
    PH(19) { unsigned char* ws = wsl(a.ws); dil_merge((const bf16*)(ws + A_DPO), (const float*)(ws + A_DPM), (const float*)(ws + A_DPL), Hb, wv); } SEAM(19);
    PH(20) { unsigned char* ws = wsl(a.ws); pg8::Gemm g{Hb, (const bf16*)(ws + WS_W_OUT1), 2048, 2048, 2048}; SO.init(T, 2048, G, bid);
        EpiRes<true> E{XPRE, a.out, MOD + 4 * 12288 + 2 * 2048}; pg8::gemm_phase<EpiRes<true>, pg8::StaticOrder, false, true>(lds, g, SO, E, wv); } SEAM(20);
    MOE_PHASES(1, 21)
#undef MOE_PHASES
#ifdef DBG_TIME_K1
    {
        xcd_barrier(bar);
        const unsigned long long* ts = (const unsigned long long*)(ws0 + CTL_CHK);
        const unsigned long long t0 = ts[0], te = __builtin_amdgcn_s_memrealtime();
        const float tot = (float)(te - t0), f1 = (float)(ts[1 + DBG_TIME_K1] - t0) / tot, f2 = (float)(ts[1 + DBG_TIME_K2] - t0) / tot;
        const float c1 = sqrtf(100.f * f1);
        for (size_t i = (size_t)bid * 512 + wv * 64 + lane_id(); i < (size_t)T * D; i += (size_t)G * 512) a.out[i] = c1;
        xcd_barrier(bar);
        if (bid == 0 && wv == 0 && lane_id() == 0) a.out[0] = 100.f * f2;
    }
#endif
#undef IN
#undef SEAM
#undef MOD
#undef Hb
#undef X1
#undef XPRE
}


#ifdef DBG_DUMP_OFF
__global__ void dbg_dump(const unsigned char* ws, float* out) {
    const size_t n = (size_t)T * D;
    for (size_t i = (size_t)blockIdx.x * 256 + threadIdx.x; i < n; i += (size_t)gridDim.x * 256) {
#if defined(DBG_DUMP_RT)
        { const int m = (int)(i >> 11), c = (int)(i & 2047); const int* RTE = (const int*)(ws + A_RT); const float* RTW = (const float*)(RTE + 4 * T); out[i] = c < 2 ? (float)RTE[2 * m + c] : (c < 4 ? RTW[2 * m + c - 2] : 0.f); }
#elif DBG_DUMP_F32
        out[i] = ((const float*)(ws + DBG_DUMP_OFF))[i];
#else
        out[i] = bf2f(((const bf16*)(ws + DBG_DUMP_OFF))[i]);
#endif
    }
}
#endif
extern "C" void kernel_launch(void* const* d_in, const int* in_sizes, int n_in, void* d_out, int out_size, void* d_ws, size_t ws_size, hipStream_t stream) {
    static int grid = 0;
    if (grid == 0) {
        if (n_in != 41 || out_size != T * D || ws_size < WS_END) { fprintf(stderr, "kernel_launch: unexpected shapes: n_in %d out %d ws %zu (need %zu)\n", n_in, out_size, ws_size, (size_t)WS_END); grid = -1; return; }
        int dev = 0, cus = 0, per_cu = 0;
        if (hipGetDevice(&dev) != hipSuccess || hipDeviceGetAttribute(&cus, hipDeviceAttributeMultiprocessorCount, dev) != hipSuccess) { grid = -1; return; }
        if (hipFuncSetAttribute((const void*)fwd, hipFuncAttributeMaxDynamicSharedMemorySize, LDS_BYTES) != hipSuccess) { fprintf(stderr, "kernel_launch: hipFuncSetAttribute failed\n"); grid = -1; return; }
        if (hipOccupancyMaxActiveBlocksPerMultiprocessor(&per_cu, (const void*)fwd, 512, LDS_BYTES) != hipSuccess || per_cu < 1) fprintf(stderr, "kernel_launch: occupancy query says %d blocks/CU\n", per_cu);
        (void)hipGetLastError();
        grid = cus;
    }
    if (grid < 0) return;
    (void)hipMemsetAsync(d_ws, 0, CTL_ZERO_BYTES, stream);
#ifdef DBG_ZERO_WS
    (void)hipMemsetAsync((char*)d_ws + CTL_ZERO_BYTES, 0, WS_END - CTL_ZERO_BYTES, stream);
#endif
    KArgs a{};
    for (int i = 0; i < 41; ++i) a.in[i] = (const float*)d_in[i];
    a.out = (float*)d_out; a.ws = (unsigned char*)d_ws;
#if N_LAUNCH_MODE == 0
    a.ph_lo = 0; a.ph_hi = N_PHASES;
    hipLaunchKernelGGL(fwd, dim3(grid), dim3(512), LDS_BYTES, stream, a);
#else
#ifdef DBG_DUMP_AFTER
    for (int p = 0; p <= DBG_DUMP_AFTER; ++p) { a.ph_lo = p; a.ph_hi = p + 1; hipLaunchKernelGGL(fwd, dim3(grid), dim3(512), LDS_BYTES, stream, a); }
#ifdef DBG_DUMP_OFF
    hipLaunchKernelGGL(dbg_dump, dim3(2048), dim3(256), 0, stream, (const unsigned char*)d_ws, (float*)d_out);
#endif
#else
    for (int p = 0; p < N_PHASES; ++p) { a.ph_lo = p; a.ph_hi = p + 1; hipLaunchKernelGGL(fwd, dim3(grid), dim3(512), LDS_BYTES, stream, a); }
#endif
#endif
}
```

```cpp
#include <hip/hip_runtime.h>
#include <cstdio>
#include <cstdint>

#ifndef N_LAUNCH_MODE
#define N_LAUNCH_MODE 0
#endif
#ifndef CHK
#define CHK 0
#endif

#define GAS __attribute__((address_space(1)))
#define LAS __attribute__((address_space(3)))
typedef unsigned short bf16;
typedef short bf16x8 __attribute__((ext_vector_type(8)));
typedef short s16x4 __attribute__((ext_vector_type(4)));
typedef float f32x4 __attribute__((ext_vector_type(4)));
typedef float f32x16 __attribute__((ext_vector_type(16)));
typedef float f32x2 __attribute__((ext_vector_type(2)));
typedef unsigned u32x4 __attribute__((ext_vector_type(4)));
typedef unsigned u32x2 __attribute__((ext_vector_type(2)));
#define DI __device__ __forceinline__

constexpr int D = 2048, NB = 4, SEQ = 4096, T = NB * SEQ;
constexpr float LN_EPS = 1e-5f, RMS_EPS = 1e-6f;
constexpr float DN_ALPHA = 1.41421356237f;
constexpr int EVEN_IN = 1856, ODD_IN = 9568, DIL_IN = 4608, RW_IN = 4960, RWW = 1536;
constexpr int NEXP = 16, DEXP = 512;

typedef __bf16 bf16x2_t __attribute__((ext_vector_type(2)));
DI unsigned pk2(float lo, float hi) { f32x2 v = {lo, hi}; bf16x2_t r = __builtin_convertvector(v, bf16x2_t); return __builtin_bit_cast(unsigned, r); }
DI float bf2f(bf16 b) { return __uint_as_float(((unsigned)b) << 16); }
DI float bflo(unsigned u) { return __uint_as_float(u << 16); }
DI float bfhi(unsigned u) { return __uint_as_float(u & 0xffff0000u); }
DI bf16 f2bf(float f) { unsigned u = __float_as_uint(f); u += 0x7fffu + ((u >> 16) & 1u); return (bf16)(u >> 16); }
DI float wave_sum(float v) {
#pragma unroll
    for (int o = 1; o < 64; o <<= 1) v += __shfl_xor(v, o);
    return v;
}
DI unsigned char* wsl(unsigned char* p) { asm volatile("" : "+s"(p)); return p; }
DI int lane_id() { return (int)__builtin_amdgcn_mbcnt_hi(~0u, __builtin_amdgcn_mbcnt_lo(~0u, 0u)); }
DI int otid(int wv) { int t = wv * 64 + lane_id(); asm volatile("" : "+v"(t)); return t; }
DI float dpp_xor1(float x) { return __builtin_bit_cast(float, __builtin_amdgcn_mov_dpp(__builtin_bit_cast(int, x), 0xB1, 0xF, 0xF, true)); }
DI float dpp_xor2(float x) { return __builtin_bit_cast(float, __builtin_amdgcn_mov_dpp(__builtin_bit_cast(int, x), 0x4E, 0xF, 0xF, true)); }
DI float dpp_hmir(float x) { return __builtin_bit_cast(float, __builtin_amdgcn_mov_dpp(__builtin_bit_cast(int, x), 0x141, 0xF, 0xF, true)); }
template <int N> DI float dpp_ror(float x) { return __builtin_bit_cast(float, __builtin_amdgcn_mov_dpp(__builtin_bit_cast(int, x), 0x120 + N, 0xF, 0xF, true)); }
DI float dpp_rmir(float x) { return __builtin_bit_cast(float, __builtin_amdgcn_mov_dpp(__builtin_bit_cast(int, x), 0x140, 0xF, 0xF, true)); }
DI float red8(float x) { x += dpp_xor1(x); x += dpp_xor2(x); x += dpp_hmir(x); return x; }
DI float red16(float x) { x += dpp_xor1(x); x += dpp_xor2(x); x += dpp_hmir(x); x += dpp_rmir(x); return x; }
DI float sat448(float x) { return __builtin_amdgcn_fmed3f(x, -448.f, 448.f); }
DI unsigned pk4_fp8(float a, float b, float c, float d) { int w = 0; w = __builtin_amdgcn_cvt_pk_fp8_f32(sat448(a), sat448(b), w, false); w = __builtin_amdgcn_cvt_pk_fp8_f32(sat448(c), sat448(d), w, true); return (unsigned)w; }
constexpr float F8_WSCALE = 32.f;
DI float sigmoidf_(float x) { return __builtin_amdgcn_rcpf(1.f + __expf(-x)); }

namespace pg8 {
constexpr int BM = 256, BK = 64, HALF = 128, HTB = HALF * BK * 2, STAGE_BYTES = 8 * HTB, NXCD = 8, WGM = 8;
__host__ __device__ __forceinline__ int lds_byte(int r, int c) { const int st = (r >> 4) * 2 + (c >> 5), rr = r & 15, cc = c & 31, ob = rr * 64 + cc * 2; return st * 1024 + (ob ^ (((ob >> 9) & 1) << 5)); }
__host__ __device__ __forceinline__ void stage_rc(int b, int& R, int& C) { const int st = b / 1024, sb = b % 1024, swz = sb ^ (((sb >> 9) & 1) << 5); R = (st >> 1) * 16 + swz / 64; C = (st & 1) * 32 + (swz % 64) / 2; }
__host__ __device__ __forceinline__ int perm32(int rho) { const int n = rho >> 4, i = rho & 15; return 8 * (i >> 2) + 4 * n + (i & 3); }

struct Unit { int pm, pn, aux; };
struct Gemm { const bf16* A; const bf16* Bt; int lda, ldb, K; };

struct StaticOrder {
    int nM, nN, nwg, G, c;
    __host__ __device__ void init(int M, int N, int G_, int c_) { nM = M / BM; nN = N / BM; nwg = nM * nN; G = G_; c = c_; }
    __host__ __device__ bool next(int i, Unit& u) const {
        const long L = (long)i * G + c; if (L >= nwg) return false;
        int wgid = (int)L; { const int q = nwg / NXCD, r = nwg % NXCD, xcd = wgid % NXCD, off = wgid / NXCD; wgid = (xcd < r ? xcd * (q + 1) : r * (q + 1) + (xcd - r) * q) + off; }
        const int nig = WGM * nN, gid = wgid / nig, fm = gid * WGM, gsz = (nM - fm) < WGM ? (nM - fm) : WGM;
        u.pm = fm + ((wgid % nig) % gsz); u.pn = (wgid % nig) / gsz; u.aux = 0; return true;
    }
    __device__ __forceinline__ int arow(const Unit&, int) const { return 0; }
    __device__ __forceinline__ int koff(const Unit&) const { return 0; }
};

typedef int v8i __attribute__((ext_vector_type(8)));
template <class Epi, class Sched, bool GATHER, bool F8 = false>
__device__ __forceinline__ void gemm_phase(LAS unsigned char* lds, const Gemm g, const Sched& S, const Epi& E, int wv) {
    const int tid = otid(wv), wid = __builtin_amdgcn_readfirstlane(tid >> 6), lane = tid & 63, wr = wid >> 2, wc = wid & 3, fr = lane & 15, fq = lane >> 4;
    int K = g.K; asm volatile("" : "+s"(K));
    constexpr int ES = F8 ? 1 : 2;
    const int nt = K / (F8 ? 2 * BK : BK);
    unsigned voffB[2], vA0[2], vA1[2], nA0[2], nA1[2]; int Rr[2], Cc[2];
#pragma unroll
    for (int i = 0; i < 2; ++i) { int R, C; stage_rc(tid * 16 + i * 8192, R, C); const int Rb = Epi::PERM ? ((R & ~31) + perm32(R & 31)) : R;
        Rr[i] = R; Cc[i] = C; voffB[i] = (unsigned)(Rb * g.ldb * ES + C * 2);
        vA0[i] = (unsigned)(R * g.lda * ES + C * 2); vA1[i] = (unsigned)((R + HALF) * g.lda * ES + C * 2); nA0[i] = vA0[i]; nA1[i] = vA1[i]; }
    const size_t kstep = (size_t)(BK * 2);
    const size_t hstepB = (size_t)HALF * g.ldb * ES, tstepB = 2 * hstepB, tstepA = (size_t)BM * g.lda * ES, hstepA = (size_t)HALF * g.lda * ES, rbA = (size_t)g.lda * ES, rbB = (size_t)g.ldb * ES;
    const unsigned ldsw = (unsigned)wid * 1024u;
    const int aoff = lds_byte(wr * 64 + fr, F8 ? fq * 16 : fq * 8), boff = lds_byte(wc * 32 + fr, F8 ? fq * 16 : fq * 8);
#define PG8_SA(b, h) (((b) * 2 + (h)) * HTB)
#define PG8_SB(b, h) ((4 + (b) * 2 + (h)) * HTB)
#define PG8_STAGE(bufoff, gbase, voff) do { _Pragma("unroll") for (int _i = 0; _i < 2; ++_i) \
        __builtin_amdgcn_global_load_lds((const unsigned*)((const char*)(gbase) + (voff)[_i]), (LAS unsigned*)(lds + (bufoff) + ldsw + _i * 8192), 16, 0, 0); } while (0)
#define PG8_STAGE1(bufoff, gbase, voff0, rowbytes) do { __builtin_amdgcn_global_load_lds((const unsigned*)((const char*)(gbase) + (voff0)), (LAS unsigned*)(lds + (bufoff) + ldsw), 16, 0, 0); \
        __builtin_amdgcn_global_load_lds((const unsigned*)((const char*)(gbase) + (size_t)64 * (rowbytes) + (voff0)), (LAS unsigned*)(lds + (bufoff) + ldsw + 8192), 16, 0, 0); } while (0)
#define PG8_STAGEA(bufoff, gbase, half, arr) do { if constexpr (GATHER) PG8_STAGE(bufoff, gbase, arr); else PG8_STAGE1(bufoff, (const char*)(gbase) + (half) * hstepA, vA0[0], rbA); } while (0)
#define PG8_LD32(p) __builtin_bit_cast(v8i, __builtin_shufflevector(*(const LAS u32x4*)(p), *(const LAS u32x4*)((p) + 16), 0, 1, 2, 3, 4, 5, 6, 7))
#define PG8_LDA(dst, b, h) do { if constexpr (F8) { _Pragma("unroll") for (int m = 0; m < 4; ++m) dst##8[m] = PG8_LD32(lds + PG8_SA(b, h) + aoff + m * 2048); } \
        else { _Pragma("unroll") for (int m = 0; m < 4; ++m) _Pragma("unroll") for (int k = 0; k < 2; ++k) dst[m][k] = *(const LAS bf16x8*)(lds + PG8_SA(b, h) + aoff + m * 2048 + k * 1024); } } while (0)
#define PG8_LDB(dst, b, h) do { if constexpr (F8) { _Pragma("unroll") for (int n = 0; n < 2; ++n) dst##8[n] = PG8_LD32(lds + PG8_SB(b, h) + boff + n * 2048); } \
        else { _Pragma("unroll") for (int n = 0; n < 2; ++n) _Pragma("unroll") for (int k = 0; k < 2; ++k) dst[n][k] = *(const LAS bf16x8*)(lds + PG8_SB(b, h) + boff + n * 2048 + k * 1024); } } while (0)
#define PG8_MMA(ai, bj, At, Bt) do { __builtin_amdgcn_s_setprio(1); if constexpr (F8) { _Pragma("unroll") for (int m = 0; m < 4; ++m) _Pragma("unroll") for (int n = 0; n < 2; ++n) \
            asm volatile("v_mfma_scale_f32_16x16x128_f8f6f4 %0, %1, %2, %0, %3, %4 op_sel_hi:[0,0,0]" : "+v"(acc[ai][bj][m][n]) : "v"(Bt##8[n]), "v"(At##8[m]), "v"(sc_w), "v"(sc_x)); }     \
        else { _Pragma("unroll") for (int m = 0; m < 4; ++m) _Pragma("unroll") for (int n = 0; n < 2; ++n) _Pragma("unroll") for (int k = 0; k < 2; ++k) \
            acc[ai][bj][m][n] = __builtin_amdgcn_mfma_f32_16x16x32_bf16(Bt[n][k], At[m][k], acc[ai][bj][m][n], 0, 0, 0); } __builtin_amdgcn_s_setprio(0); } while (0)
#define PG8_WAIT_V(n) asm volatile("s_waitcnt vmcnt(" #n ")" ::: "memory")
#define PG8_WAIT_L(n) asm volatile("s_waitcnt lgkmcnt(" #n ")" ::: "memory")
#define PG8_BAR __builtin_amdgcn_s_barrier()
#define PG8_SCHED __builtin_amdgcn_sched_barrier(0)
    Unit cur, nxt; int ui = 0;
    if (!S.next(0, cur)) return;
    f32x4 acc[2][2][4][2];
#pragma unroll
    for (int a = 0; a < 2; ++a)
#pragma unroll
        for (int b = 0; b < 2; ++b)
#pragma unroll
            for (int m = 0; m < 4; ++m)
#pragma unroll
                for (int n = 0; n < 2; ++n) acc[a][b][m][n] = (f32x4){0.f, 0.f, 0.f, 0.f};
    int sc_w = 122, sc_x = 127; if constexpr (F8) asm volatile("" : "+v"(sc_w), "+v"(sc_x));
    bf16x8 At[4][2], B0[2][2], B1[2][2]; v8i At8[4], B08[2], B18[2];
    const char* cA = (GATHER ? (const char*)g.A : (const char*)g.A + (size_t)cur.pm * tstepA) + ES * S.koff(cur);
    const char* cB = (const char*)g.Bt + (size_t)cur.pn * tstepB + ES * S.koff(cur);
    if (GATHER) {
#pragma unroll
        for (int i = 0; i < 2; ++i) { vA0[i] = (unsigned)(S.arow(cur, Rr[i]) * g.lda * ES + Cc[i] * 2); vA1[i] = (unsigned)(S.arow(cur, Rr[i] + HALF) * g.lda * ES + Cc[i] * 2); nA0[i] = vA0[i]; nA1[i] = vA1[i]; } }
    PG8_STAGE1(PG8_SB(0, 0), cB, voffB[0], rbB); PG8_STAGEA(PG8_SA(0, 0), cA, 0, vA0); PG8_STAGE1(PG8_SB(0, 1), cB + hstepB, voffB[0], rbB); PG8_STAGEA(PG8_SA(0, 1), cA, 1, vA1);
    if (wr == 1) PG8_BAR;
    PG8_WAIT_V(4); PG8_BAR;
    PG8_STAGE1(PG8_SB(1, 0), cB + kstep, voffB[0], rbB); PG8_STAGEA(PG8_SA(1, 0), cA + kstep, 0, vA0); PG8_STAGE1(PG8_SB(1, 1), cB + hstepB + kstep, voffB[0], rbB);
    PG8_WAIT_V(6); PG8_BAR;
    for (;;) {
        const bool has_next = S.next(ui + 1, nxt);
        const char* nAp = GATHER ? cA : (has_next ? (const char*)g.A + (size_t)nxt.pm * tstepA + ES * S.koff(nxt) : cA);
        const char* nB = has_next ? (const char*)g.Bt + (size_t)nxt.pn * tstepB + ES * S.koff(nxt) : cB;
        if (GATHER) {
#pragma unroll
            for (int i = 0; i < 2; ++i) { nA0[i] = vA0[i]; nA1[i] = vA1[i]; } }
        for (int t = 0; t < nt; t += 2) {
            const bool last = (t == nt - 2);
            if (GATHER && has_next && t == (nt >= 4 ? nt - 4 : 0)) {
#pragma unroll
                for (int i = 0; i < 2; ++i) { nA0[i] = (unsigned)(S.arow(nxt, Rr[i]) * g.lda * ES + Cc[i] * 2); nA1[i] = (unsigned)(S.arow(nxt, Rr[i] + HALF) * g.lda * ES + Cc[i] * 2); } }
            const char* a1 = cA + (size_t)(t + 1) * kstep;
            const char* a2 = last ? nAp : cA + (size_t)(t + 2) * kstep; const char* b2 = last ? nB : cB + (size_t)(t + 2) * kstep;
            const char* a3 = a2 + kstep; const char* b3 = b2 + kstep;
            unsigned w0[2], w1[2];
#pragma unroll
            for (int i = 0; i < 2; ++i) { w0[i] = (GATHER && last) ? nA0[i] : vA0[i]; w1[i] = (GATHER && last) ? nA1[i] : vA1[i]; }
            PG8_LDB(B0, 0, 0); PG8_SCHED; PG8_LDA(At, 0, 0); PG8_STAGEA(PG8_SA(1, 1), a1, 1, vA1);
            PG8_WAIT_L(8); PG8_BAR; PG8_WAIT_L(0); PG8_MMA(0, 0, At, B0); PG8_BAR; PG8_SCHED;
            PG8_LDB(B1, 0, 1); PG8_STAGE1(PG8_SB(0, 0), b2, voffB[0], rbB);
            PG8_BAR; PG8_WAIT_L(0); PG8_MMA(0, 1, At, B1); PG8_BAR;
            PG8_LDA(At, 0, 1); PG8_STAGEA(PG8_SA(0, 0), a2, 0, w0);
            PG8_BAR; PG8_WAIT_L(0); PG8_MMA(1, 0, At, B0); PG8_BAR; PG8_SCHED;
            PG8_STAGE1(PG8_SB(0, 1), b2 + hstepB, voffB[0], rbB);
            PG8_WAIT_V(6); PG8_BAR; PG8_MMA(1, 1, At, B1); PG8_BAR;
            PG8_LDB(B0, 1, 0); PG8_SCHED; PG8_LDA(At, 1, 0); PG8_STAGEA(PG8_SA(0, 1), a2, 1, w1);
            PG8_WAIT_L(8); PG8_BAR; PG8_WAIT_L(0); PG8_MMA(0, 0, At, B0); PG8_BAR; PG8_SCHED;
            PG8_LDB(B1, 1, 1); PG8_STAGE1(PG8_SB(1, 0), b3, voffB[0], rbB);
            PG8_BAR; PG8_WAIT_L(0); PG8_MMA(0, 1, At, B1); PG8_BAR;
            PG8_LDA(At, 1, 1); PG8_STAGEA(PG8_SA(1, 0), a3, 0, w0);
            PG8_BAR; PG8_WAIT_L(0); PG8_MMA(1, 0, At, B0); PG8_BAR; PG8_SCHED;
            PG8_STAGE1(PG8_SB(1, 1), b3 + hstepB, voffB[0], rbB);
            PG8_WAIT_V(6); PG8_BAR; PG8_MMA(1, 1, At, B1); PG8_BAR;
        }
        if constexpr (F8) asm volatile("s_nop 15\n\ts_nop 15\n\ts_nop 15\n\ts_nop 15" ::: "memory");
        { int frr = fr, fqq = fq; asm volatile("" : "+v"(frr), "+v"(fqq));
          E(acc, cur, wr, wc, frr, fqq); }
        if (!has_next) break;
#pragma unroll
        for (int a = 0; a < 2; ++a)
#pragma unroll
            for (int b = 0; b < 2; ++b)
#pragma unroll
                for (int m = 0; m < 4; ++m)
#pragma unroll
                    for (int n = 0; n < 2; ++n) acc[a][b][m][n] = (f32x4){0.f, 0.f, 0.f, 0.f};
        cur = nxt; cA = nAp; cB = nB; ++ui;
        if (GATHER) {
#pragma unroll
            for (int i = 0; i < 2; ++i) { vA0[i] = nA0[i]; vA1[i] = nA1[i]; } }
    }
    PG8_WAIT_V(0);
    if (wr == 0) PG8_BAR;
    PG8_BAR;
#undef PG8_SA
#undef PG8_SB
#undef PG8_STAGE
#undef PG8_STAGE1
#undef PG8_STAGEA
#undef PG8_LDA
#undef PG8_LDB
#undef PG8_MMA
#undef PG8_LD32
#undef PG8_WAIT_V
#undef PG8_WAIT_L
#undef PG8_BAR
#undef PG8_SCHED
}
}

#define XB_TMO      128
#define XB_XCNT(j)  (256  + 64 * (j))
#define XB_XSUB(j)  (1280 + 64 * (j))
#define XB_XGEN(j)  (2304 + 64 * (j))
#define XB_TOP      3328
#define XB_TOPGEN   3392
#define XCD_BAR_WORDS 3456
#define XB_SPIN_CAP (1u << 18)
__device__ __forceinline__ unsigned xb_ld(unsigned* p)              { return __hip_atomic_load(p, __ATOMIC_RELAXED, __HIP_MEMORY_SCOPE_AGENT); }
__device__ __forceinline__ unsigned xb_add(unsigned* p, unsigned v) { return __hip_atomic_fetch_add(p, v, __ATOMIC_RELAXED, __HIP_MEMORY_SCOPE_AGENT); }
__device__ __forceinline__ unsigned xb_xcc_id() { return (unsigned)__builtin_amdgcn_s_getreg((3 << 11) | 20) & 0xFu; }
#define XB_SPIN(cond, bar) do { unsigned _sp = 0; while (cond) { __builtin_amdgcn_s_sleep(1); \
    if ((++_sp & 255u) == 0u) { if (xb_ld(&(bar)[XB_TMO])) break; if (_sp > XB_SPIN_CAP) { atomicAdd(&(bar)[XB_TMO], 1u); break; } } } } while (0)
struct XcdBarrier { unsigned* bar; unsigned x; volatile LAS unsigned* st; int wv; };
__device__ __forceinline__ XcdBarrier xcd_barrier_post(unsigned* bar, volatile LAS unsigned* st, int wv) {
    XcdBarrier b; b.bar = bar; b.x = xb_xcc_id(); b.st = st; b.wv = wv;
    if (wv == 0 && lane_id() == 0) (void)xb_add(&bar[XB_XCNT(b.x)], 1u);
    return b;
}
__device__ __forceinline__ void xcd_barrier_complete(unsigned* bar, unsigned x, unsigned& nloc, unsigned& nx) {
    const unsigned G = gridDim.x * gridDim.y * gridDim.z;
    unsigned sum, cnt, mine, sp = 0u;
    for (;;) {
        sum = 0u; cnt = 0u; mine = 0u;
#pragma unroll
        for (unsigned j = 0; j < 16; ++j) { const unsigned c = xb_ld(&bar[XB_XCNT(j)]); sum += c; cnt += (c > 0u) ? 1u : 0u; mine = (j == x) ? c : mine; }
        if (sum == G) break;
        __builtin_amdgcn_s_sleep(1);
        if ((++sp & 255u) == 0u) { if (xb_ld(&bar[XB_TMO])) break; if (sp > XB_SPIN_CAP) { atomicAdd(&bar[XB_TMO], 1u); break; } }
    }
    nloc = mine > 0u ? mine : 1u; nx = cnt > 0u ? cnt : 1u;
}
__device__ __forceinline__ void xcd_barrier(const XcdBarrier& b) {
    asm volatile("s_waitcnt vmcnt(0)" ::: "memory");
    __syncthreads();
    if (b.wv == 0 && lane_id() == 0) {
        unsigned* bar = b.bar;
        __builtin_amdgcn_s_waitcnt(0);
        unsigned nloc = b.st[0], nx = b.st[1];
        if (nloc == 0u) { xcd_barrier_complete(bar, b.x, nloc, nx); b.st[0] = nloc; b.st[1] = nx; }
        const unsigned old = xb_add(&bar[XB_XSUB(b.x)], 1u);
        const unsigned gen = old / nloc;
        if (old + 1u == (gen + 1u) * nloc) {
            __builtin_amdgcn_fence(__ATOMIC_RELEASE, "agent");
            asm volatile("s_waitcnt vmcnt(0)" ::: "memory");
            const unsigned og = xb_add(&bar[XB_TOP], 1u);
            const unsigned tg = og / nx;
            if (og + 1u == (tg + 1u) * nx) xb_add(&bar[XB_TOPGEN], 1u);
            else XB_SPIN(xb_ld(&bar[XB_TOPGEN]) == tg, bar);
            __builtin_amdgcn_fence(__ATOMIC_ACQUIRE, "agent");
            xb_add(&bar[XB_XGEN(b.x)], 1u);
            asm volatile("s_waitcnt vmcnt(0)" ::: "memory");
        } else {
            XB_SPIN(xb_ld(&bar[XB_XGEN(b.x)]) == gen, bar);
            __builtin_amdgcn_fence(__ATOMIC_ACQUIRE, "agent");
            asm volatile("s_waitcnt vmcnt(0)" ::: "memory");
        }
    }
    __syncthreads();
}

constexpr size_t MiB = 1u << 20;
constexpr size_t CTL_BAR = 0, CTL_MODI = 16384  , CTL_MOD = CTL_MODI + 2 * 4 * 12288 * 8  , CTL_SSQ = CTL_MOD + 2 * 4 * 12288 * 4  ,
                 CTL_CNT = CTL_SSQ + (size_t)T * 12 * 4  , CTL_CHK = CTL_CNT + 2 * 16 * 256, CTL_ZERO_BYTES = 2 * MiB;
static_assert(CTL_CHK % 8 == 0 && CTL_CHK + 1024 <= CTL_ZERO_BYTES, "ctl");
constexpr size_t WS_W_IN0 = 2 * MiB, WS_W_UQ = WS_W_IN0 + 8 * MiB, WS_W_UKV = WS_W_UQ + 1536 * 512 * 2, WS_W_GLU = WS_W_UKV + 2048 * 256 * 2, WS_W_OUT0 = WS_W_GLU + 2 * MiB,
                 WS_W_IN1 = WS_W_OUT0 + 8 * MiB, WS_W_OUT1 = WS_W_IN1 + (size_t)9728 * 2048 * 2, WS_W_GU = WS_W_OUT1 + 8 * MiB, WS_W_DN = WS_W_GU + 128 * MiB,
                 WS_W_LORA = WS_W_DN + 64 * MiB, WS_S5BY = WS_W_LORA + (size_t)4608 * 384 * 2, WS_S5BE = WS_S5BY + (size_t)64 * 256 * 384 * 2, WS_ROPE = WS_S5BE + (size_t)64 * 256 * 256 * 2,
                 WS_BIAS = WS_ROPE + 1 * MiB, WS_S5L = WS_BIAS + 16384, WS_H = WS_S5L + 65536;
static_assert(WS_H % 256 == 0, "align");
constexpr size_t WS_W_GU8 = WS_W_GU + 64 * MiB;
constexpr size_t WS_X1 = WS_H + 64 * MiB, WS_ARENA = WS_X1 + 128 * MiB;
constexpr size_t A_QC = WS_ARENA, A_KVC = A_QC + 16 * MiB, A_KR = A_KVC + 8 * MiB, A_XH = A_KR + 2 * MiB, A_ES = A_XH + 48 * MiB, A_Q = A_ES + 32 * MiB, A_KF = A_Q + 48 * MiB,
                 A_V = A_KF + 48 * MiB, A_YS5 = A_V + 32 * MiB;
constexpr size_t A_XPRE = WS_ARENA, A_RT = WS_ARENA + 128 * MiB, A_TOKL = A_RT + 1 * MiB, A_ACT = WS_ARENA, A_YS = WS_ARENA + 130 * MiB;
constexpr int MOE_ROWS = 2 * T + 16 * 256;
constexpr size_t A_ZD = WS_ARENA, A_ZR = A_ZD + 144 * MiB, A_LIN = A_ZR + 156 * MiB, A_WDEC = A_LIN + 12 * MiB, A_AA = A_WDEC + 48 * MiB, A_GG = A_AA + 48 * MiB,
                 A_DPO = A_GG + 48 * MiB, A_DPM = A_DPO + 48 * MiB, A_DPL = A_DPM + 2 * MiB, A_BSG = A_DPL + 2 * MiB  , A_YR = WS_ARENA  , A_GST = A_BSG + 2 * MiB  , WS_END = A_GST + 2 * MiB;
static_assert(A_YS + (size_t)MOE_ROWS * 2048 * 2 <= WS_END && A_YS5 + 32 * MiB <= WS_END && WS_END <= 1024 * MiB, "ws map");

constexpr int RING_BYTES = 131072, LDS_TAB = RING_BYTES, LDS_MISC = RING_BYTES + 1024, LDS_BYTES = 147456;

struct KArgs { const float* in[41]; float* out; unsigned char* ws; int ph_lo, ph_hi; };
enum { I_X = 0, I_C, I_ADAW, I_ADAB, I_LNMG, I_LNMB, I_LNFG, I_LNFB, I_RW, I_RB, I_WGU, I_WDN, I_RELB, I_EVIN, I_QN, I_WUQ, I_KVN, I_WUKV, I_LRE, I_LIM, I_BRE, I_BIM, I_CRE, I_CIM,
       I_S5D, I_LOGDT, I_WGLU, I_EVOUT, I_ODIN, I_MU, I_W0, I_W2, I_A0, I_A2, I_G2, I_KK, I_KA, I_RK, I_LNXG, I_LNXB, I_ODOUT };

DI int ropeperm(int c) { return ((c >> 2) & 1) * 32 + (c >> 3) * 4 + (c & 3); }
DI int srccol(int map, int n) {
    switch (map) {
        case 1: if (n < 768) return n; if (n < 1792) return 832 + (n - 768); if (n < 1856) return 768 + ropeperm(n - 1792); return -1;
        case 2: { const int h = n / 192, j = n % 192; return j < 128 ? n : h * 192 + 128 + ropeperm(j - 128); }
        case 3: { const int pn = n >> 8, half = (n >> 7) & 1, idx = n & 127; return half * 512 + pn * 128 + idx; }
        case 4: return n < ODD_IN ? n : -1;
        default: return n;
    }
}
struct ConvJob { const float* src; bf16* dst; const float* kscale; int ldsrc, K, Nd, nmat, map, kbeg, kend, f8; size_t smat, dmat; };
DI void conv_item(const ConvJob& J, LAS unsigned char* scr, int item, int lane) {
    const int nblk = J.Nd / 64, per = (J.K / 64) * nblk, mat = item / per, r = item % per, kb = r / nblk, nb = r % nblk, k0 = 64 * kb, n0 = 64 * nb;
    const float* W = J.src + (size_t)mat * J.smat; bf16* WT = J.f8 ? (bf16*)((unsigned char*)J.dst + (size_t)mat * J.dmat) : J.dst + (size_t)mat * J.dmat;
    const int kq = lane >> 4, nq = lane & 15, sc = srccol(J.map, n0 + 4 * nq);
    f32x4 v[16];
#pragma unroll
    for (int i = 0; i < 16; ++i) { const int kg = k0 + 4 * i + kq; v[i] = (f32x4){0.f, 0.f, 0.f, 0.f};
        if (sc >= 0 && kg >= J.kbeg && kg < J.kend) { v[i] = *(const f32x4*)(W + (size_t)(kg - J.kbeg) * J.ldsrc + sc); if (J.kscale) v[i] *= J.kscale[kg]; } }
#pragma unroll
    for (int i = 0; i < 16; ++i) { LAS bf16* t = (LAS bf16*)(scr + (4 * nq) * 132 + (4 * i + kq) * 2); const unsigned p0 = pk2(v[i].x, v[i].y), p1 = pk2(v[i].z, v[i].w);
        t[0] = (bf16)(p0 & 0xffffu); t[66] = (bf16)(p0 >> 16); t[132] = (bf16)(p1 & 0xffffu); t[198] = (bf16)(p1 >> 16); }
    asm volatile("s_waitcnt lgkmcnt(0)" ::: "memory");
#pragma unroll
    for (int q = 0; q < 8; ++q) { const int id = lane + 64 * q, n = id >> 3, c = id & 7; const LAS unsigned* t = (const LAS unsigned*)(scr + n * 132 + c * 16);
        u32x4 o = {t[0], t[1], t[2], t[3]};
        if (J.f8) { u32x2 o8 = {pk4_fp8(bflo(o.x) * F8_WSCALE, bfhi(o.x) * F8_WSCALE, bflo(o.y) * F8_WSCALE, bfhi(o.y) * F8_WSCALE), pk4_fp8(bflo(o.z) * F8_WSCALE, bfhi(o.z) * F8_WSCALE, bflo(o.w) * F8_WSCALE, bfhi(o.w) * F8_WSCALE)};
            *(u32x2*)((unsigned char*)WT + (size_t)(n0 + n) * J.K + k0 + 8 * c) = o8; }
        else *(u32x4*)(WT + (size_t)(n0 + n) * J.K + k0 + 8 * c) = o; }
    asm volatile("s_waitcnt lgkmcnt(0)" ::: "memory");
}
DI ConvJob conv_job(const KArgs& a, int j) {
    unsigned char* ws = a.ws; ConvJob J; J.kscale = nullptr; J.nmat = 1; J.map = 0; J.smat = 0; J.dmat = 0; J.kbeg = 0; J.kend = 1 << 30; J.f8 = 0;
    switch (j) {
        case 0: J.src = a.in[I_EVIN]; J.dst = (bf16*)(ws + WS_W_IN0); J.f8 = 1; J.ldsrc = EVEN_IN; J.K = 2048; J.Nd = 2048; J.map = 1; break;
        case 1: J.src = a.in[I_WUQ]; J.dst = (bf16*)(ws + WS_W_UQ); J.ldsrc = 1536; J.K = 512; J.Nd = 1536; J.map = 2; J.kscale = a.in[I_QN]; break;
        case 2: J.src = a.in[I_WUKV]; J.dst = (bf16*)(ws + WS_W_UKV); J.ldsrc = 2048; J.K = 256; J.Nd = 2048; J.kscale = a.in[I_KVN]; break;
        case 3: J.src = a.in[I_WGLU]; J.dst = (bf16*)(ws + WS_W_GLU); J.ldsrc = 1024; J.K = 1024; J.Nd = 1024; break;
        case 4: J.src = a.in[I_EVOUT]; J.dst = (bf16*)(ws + WS_W_OUT0); J.f8 = 1; J.ldsrc = 2048; J.K = 2048; J.Nd = 2048; break;
        case 5: J.src = a.in[I_ODIN]; J.dst = (bf16*)(ws + WS_W_IN1); J.f8 = 1; J.ldsrc = ODD_IN; J.K = 2048; J.Nd = 9728; J.map = 4; break;
        case 6: J.src = a.in[I_ODOUT]; J.dst = (bf16*)(ws + WS_W_OUT1); J.f8 = 1; J.ldsrc = 2048; J.K = 2048; J.Nd = 2048; break;
        case 7: J.src = a.in[I_WGU]; J.dst = (bf16*)(ws + WS_W_GU8); J.f8 = 1; J.ldsrc = 1024; J.K = 2048; J.Nd = 1024; J.map = 3; J.nmat = 32; J.smat = (size_t)2048 * 1024; J.dmat = (size_t)1024 * 2048; break;
        case 8: J.src = a.in[I_WDN]; J.dst = (bf16*)(ws + WS_W_DN); J.f8 = 1; J.ldsrc = 2048; J.K = 512; J.Nd = 2048; J.nmat = 32; J.smat = (size_t)512 * 2048; J.dmat = (size_t)2048 * 512; break;
        case 9: J.src = a.in[I_W2]; J.dst = (bf16*)(ws + WS_W_LORA); J.ldsrc = 1536; J.K = 384; J.Nd = 1536; J.kbeg = 0; J.kend = 64; break;
        case 10: J.src = a.in[I_A2]; J.dst = (bf16*)(ws + WS_W_LORA) + (size_t)1536 * 384; J.ldsrc = 1536; J.K = 384; J.Nd = 1536; J.kbeg = 64; J.kend = 128; break;
        default: J.src = a.in[I_G2]; J.dst = (bf16*)(ws + WS_W_LORA) + (size_t)3072 * 384; J.ldsrc = 1536; J.K = 384; J.Nd = 1536; J.kbeg = 128; J.kend = 352; break;
    }
    return J;
}
constexpr int N_CONV_JOBS = 12;

DI void s5_precompute(const KArgs& a, LAS unsigned char* lds, int g, int wv) {
    LAS float* PW = (LAS float*)lds; LAS float* BB = PW + 17 * 64 * 2; LAS float* CC = BB + 64 * 16 * 2; LAS float* KK = CC + 16 * 64 * 2;
    const int tid = otid(wv);
    const float dt = expf(a.in[I_LOGDT][g]);
    for (int idx = tid; idx < 17 * 64; idx += 512) { const int d = idx / 64, p = idx % 64; const float lre = a.in[I_LRE][g * 64 + p], lim = a.in[I_LIM][g * 64 + p];
        const float mag = expf(lre * dt * (float)d); float sn, cs; sincosf(lim * dt * (float)d, &sn, &cs); PW[idx * 2] = mag * cs; PW[idx * 2 + 1] = mag * sn;
        if (d == 16) { float* L = (float*)(a.ws + WS_S5L); L[(g * 64 + p) * 2] = mag * cs; L[(g * 64 + p) * 2 + 1] = mag * sn; } }
    for (int idx = tid; idx < 64 * 16; idx += 512) { const int p = idx / 16, c = idx % 16; const float lre = a.in[I_LRE][g * 64 + p], lim = a.in[I_LIM][g * 64 + p];
        float sn, cs; sincosf(lim * dt, &sn, &cs); const float mag = expf(lre * dt), sh = sinf(0.5f * lim * dt);
        const float nr = expm1f(lre * dt) * cs - 2.f * sh * sh, ni = mag * sn, den = 1.f / (lre * lre + lim * lim);
        const float cr = (nr * lre + ni * lim) * den, ci = (ni * lre - nr * lim) * den;
        const float br = a.in[I_BRE][(g * 64 + p) * 16 + c], bi = a.in[I_BIM][(g * 64 + p) * 16 + c];
        BB[idx * 2] = cr * br - ci * bi; BB[idx * 2 + 1] = cr * bi + ci * br; }
    for (int idx = tid; idx < 16 * 64; idx += 512) { CC[idx * 2] = a.in[I_CRE][g * 1024 + idx]; CC[idx * 2 + 1] = a.in[I_CIM][g * 1024 + idx]; }
    __syncthreads();
    for (int idx = tid; idx < 4096; idx += 512) { const int d = idx >> 8, c = (idx >> 4) & 15, cp = idx & 15; float s = 0.f;
        for (int p = 0; p < 64; ++p) { const float cr = CC[(c * 64 + p) * 2], ci = CC[(c * 64 + p) * 2 + 1], pr = PW[(d * 64 + p) * 2], pi = PW[(d * 64 + p) * 2 + 1];
            const float xr = cr * pr - ci * pi, xi = cr * pi + ci * pr; s += xr * BB[(p * 16 + cp) * 2] - xi * BB[(p * 16 + cp) * 2 + 1]; }
        KK[idx] = s; }
    __syncthreads();
    bf16* BY = (bf16*)(a.ws + WS_S5BY) + (size_t)g * 256 * 384; bf16* BE = (bf16*)(a.ws + WS_S5BE) + (size_t)g * 256 * 256;
    for (int idx = tid; idx < 256 * 48; idx += 512) { const int row = idx / 48, col0 = (idx % 48) * 8, t = row >> 4, c = row & 15; float v[8];
        if (col0 < 256) { const int s = col0 >> 4, c0 = col0 & 15;
#pragma unroll
            for (int j = 0; j < 8; ++j) v[j] = (s <= t) ? KK[((t - s) << 8) + (c << 4) + c0 + j] : 0.f; }
        else { const int pp = col0 - 256; const bool im = pp >= 64; const int p0 = im ? pp - 64 : pp;
#pragma unroll
            for (int j = 0; j < 8; ++j) { const int p = p0 + j; const float cr = CC[(c * 64 + p) * 2], ci = CC[(c * 64 + p) * 2 + 1], pr = PW[((t + 1) * 64 + p) * 2], pi = PW[((t + 1) * 64 + p) * 2 + 1];
                v[j] = im ? -(cr * pi + ci * pr) : (cr * pr - ci * pi); } }
        u32x4 o = {pk2(v[0], v[1]), pk2(v[2], v[3]), pk2(v[4], v[5]), pk2(v[6], v[7])}; *(u32x4*)(BY + (size_t)row * 384 + col0) = o; }
    for (int idx = tid; idx < 256 * 32; idx += 512) { const int row = idx / 32, col0 = (idx % 32) * 8, s = col0 >> 4, c0 = col0 & 15; float v[8];
#pragma unroll
        for (int j = 0; j < 8; ++j) { if (row < 128) { const int p = row & 63; const float pr = PW[((15 - s) * 64 + p) * 2], pi = PW[((15 - s) * 64 + p) * 2 + 1], br = BB[(p * 16 + c0 + j) * 2], bi = BB[(p * 16 + c0 + j) * 2 + 1];
                v[j] = row < 64 ? (pr * br - pi * bi) : (pr * bi + pi * br); } else v[j] = 0.f; }
        u32x4 o = {pk2(v[0], v[1]), pk2(v[2], v[3]), pk2(v[4], v[5]), pk2(v[6], v[7])}; *(u32x4*)(BE + (size_t)row * 256 + col0) = o; }
    __syncthreads();
}

DI int t5_bucket(int dist) { if (dist < 16) return dist; const float logd = logf((float)dist / 16.f) / logf(128.f); int lg = 16 + (int)(logd * 16.f); return lg < 31 ? lg : 31; }

DI void p0_prologue(const KArgs& a, LAS unsigned char* lds, int wv) {
    const int tid = otid(wv), lane = tid & 63, wave = tid >> 6, G = gridDim.x, gw = blockIdx.x * 8 + wave, NGW = G * 8;
    LAS float* cond = (LAS float*)(lds + 98304);
    for (int i = tid; i < 4 * 2048; i += 512) { const float c = a.in[I_C][i]; cond[i] = c / (1.f + expf(-c)); }
    if (blockIdx.x < 64) s5_precompute(a, lds, blockIdx.x, wv); else __syncthreads();
    unsigned long long* MODI = (unsigned long long*)(a.ws + CTL_MODI);
    for (int it = gw; it < 2 * 48 * 16; it += NGW) { const int l = it / 768, cc = (it % 768) / 16, kc = it % 16, col = cc * 256 + lane * 4;
        const float* W = a.in[I_ADAW] + ((size_t)l * 2048 + kc * 128) * 12288 + col;
        f32x4 acc[4]; for (int b = 0; b < 4; ++b) acc[b] = (f32x4){0.f, 0.f, 0.f, 0.f};
#pragma unroll 8
        for (int k = 0; k < 128; ++k) { const f32x4 w = *(const f32x4*)(W + (size_t)k * 12288);
#pragma unroll
            for (int b = 0; b < 4; ++b) acc[b] += w * cond[b * 2048 + kc * 128 + k]; }
        if (kc == 0) { const f32x4 bb = *(const f32x4*)(a.in[I_ADAB] + l * 12288 + col); for (int b = 0; b < 4; ++b) acc[b] += bb; }
#pragma unroll
        for (int b = 0; b < 4; ++b) { unsigned long long* o = MODI + (size_t)(l * 4 + b) * 12288 + col;
#pragma unroll
            for (int e = 0; e < 4; ++e) atomicAdd(o + e, (unsigned long long)__double2ll_rn((double)acc[b][e] * 1099511627776.0)); } }
    LAS unsigned char* scr = lds + wave * 8704;
    for (int j = 0; j < N_CONV_JOBS; ++j) { const ConvJob J = conv_job(a, j); const int nit = J.nmat * (J.K / 64) * (J.Nd / 64);
        for (int it = gw; it < nit; it += NGW) conv_item(J, scr, it, lane); }
    { float* RC = (float*)(a.ws + WS_ROPE); float* RS = RC + 4096 * 32; const int gt = blockIdx.x * 512 + tid;
      for (int i = gt; i < 4096 * 32; i += G * 512) { const int pos = i >> 5, j = i & 31; const float inv = powf(10000.f, -(float)(2 * j) / 64.f); float sn, cs; sincosf((float)pos * inv, &sn, &cs); RC[i] = cs; RS[i] = sn; }
      float* BL = (float*)(a.ws + WS_BIAS);
      for (int i = gt; i < 3 * 8 * 132; i += G * 512) { const int gi = i / (8 * 132), h = (i / 132) % 8, dl = i % 132; const int dil = gi == 0 ? 1 : (gi == 1 ? 4 : 16);
          BL[i] = dl <= 128 ? a.in[I_RELB][t5_bucket(dl * dil) * 24 + gi * 8 + h] * 1.44269504089f : 0.f; } }
}

DI float modi2f(unsigned long long v) { return fmaf((float)(unsigned)v, 0x1p-40f, (float)(int)(v >> 32) * 0x1p-8f); }
DI void modulate_rows(const float* x, const unsigned long long* MODI, float* MODF, bf16* H, int wv) {
    const int lane = otid(wv) & 63, gw = blockIdx.x * 8 + (otid(wv) >> 6), NGW = gridDim.x * 8;
    for (int i = gw * 64 + lane; i < 2 * 4 * 12288; i += NGW * 64) MODF[i] = modi2f(MODI[i]);
    for (int m = gw; m < T; m += NGW) { const int b = m / SEQ; const unsigned long long* sh = MODI + (size_t)b * 12288; const unsigned long long* sc = sh + 2048;
#pragma unroll
        for (int j = 0; j < 8; ++j) { const int col = (lane + 64 * j) * 4; const f32x4 v = *(const f32x4*)(x + (size_t)m * D + col);
            const f32x4 s1 = {modi2f(sc[col]), modi2f(sc[col + 1]), modi2f(sc[col + 2]), modi2f(sc[col + 3])}, s0 = {modi2f(sh[col]), modi2f(sh[col + 1]), modi2f(sh[col + 2]), modi2f(sh[col + 3])};
            const f32x4 h = v * (s1 + 1.f) + s0; *(unsigned*)((unsigned char*)H + (size_t)m * D + col) = pk4_fp8(h.x, h.y, h.z, h.w); } }
}

using pg8::Unit;
#define P32(ptr, elemoff) ((decltype(ptr))((char*)(ptr) + (unsigned)((unsigned)(elemoff) * (unsigned)sizeof(*(ptr)))))
typedef f32x4 Acc[2][2][4][2];
#define EPI_ROWS_BEGIN const int row0 = u.pm * 256 + wr * 64 + fr; _Pragma("unroll") for (int ai = 0; ai < 2; ++ai) _Pragma("unroll") for (int m = 0; m < 4; ++m) { const int row = row0 + ai * 128 + m * 16;
#define EPI_ROWS_END __builtin_amdgcn_sched_barrier(0); }
DI u32x4 pack8(const f32x4& v0, const f32x4& v1) { u32x4 o = {pk2(v0.x, v0.y), pk2(v0.z, v0.w), pk2(v1.x, v1.y), pk2(v1.z, v1.w)}; return o; }

struct EpiIn0 { static constexpr bool PERM = true;
    bf16 *QC, *KVC, *KR, *XH; float *ssq;
    DI void operator()(const Acc& acc, const Unit& u, int wr, int wc, int fr, int fq) const {
        EPI_ROWS_BEGIN
            float ss = 0.f;
#pragma unroll
            for (int bj = 0; bj < 2; ++bj) { const f32x4 v0 = acc[ai][bj][m][0], v1 = acc[ai][bj][m][1]; const int col = 128 * bj + 32 * wc + 8 * fq; const u32x4 o = pack8(v0, v1);
                if (u.pn < 2) { *(u32x4*)P32(QC, row * 512 + u.pn * 256 + col) = o; ss += v0.x * v0.x + v0.y * v0.y + v0.z * v0.z + v0.w * v0.w + v1.x * v1.x + v1.y * v1.y + v1.z * v1.z + v1.w * v1.w; }
                else if (u.pn == 2) { *(u32x4*)P32(KVC, row * 256 + col) = o; ss += v0.x * v0.x + v0.y * v0.y + v0.z * v0.z + v0.w * v0.w + v1.x * v1.x + v1.y * v1.y + v1.z * v1.z + v1.w * v1.w; }
                else if (u.pn < 7) { const int uc = (u.pn - 3) * 256 + col, g = uc >> 4; *(u32x4*)P32(XH, (g * 1024 + (row >> 4)) * 384 + (row & 15) * 16 + (uc & 15)) = o; }
                else if (col < 64) { *(u32x4*)P32(KR, row * 64 + col) = o; } }
            if (u.pn <= 2) { ss += __shfl_xor(ss, 16); ss += __shfl_xor(ss, 32); if (fq == 0) *P32(ssq, row * 12 + u.pn * 4 + wc) = ss; }
        EPI_ROWS_END
    }
};
struct EpiQ { static constexpr bool PERM = true;
    bf16* Q; const float* ssq; const float* rope;
    DI void operator()(const Acc& acc, const Unit& u, int wr, int wc, int fr, int fq) const {
        EPI_ROWS_BEGIN
            const f32x4 q0 = *(const f32x4*)P32(ssq, row * 12), q1 = *(const f32x4*)P32(ssq, row * 12 + 4);
            const float rs = __builtin_amdgcn_rsqf((((q0.x + q0.y) + (q0.z + q0.w)) + ((q1.x + q1.y) + (q1.z + q1.w))) * (1.f / 512.f) + RMS_EPS) * (0.07216878364870322f * 1.44269504089f);
            const int b = row / SEQ, s = row % SEQ;
#pragma unroll
            for (int bj = 0; bj < 2; ++bj) { f32x4 v0 = acc[ai][bj][m][0] * rs, v1 = acc[ai][bj][m][1] * rs; const int n = u.pn * 256 + 128 * bj + 32 * wc + 8 * fq, h = n / 192, j = n % 192;
                if (j >= 128) { const int q = (j - 128) >> 3; const f32x4 cs = *(const f32x4*)P32(rope, s * 32 + 4 * q), sn = *(const f32x4*)P32(rope, 4096 * 32 + s * 32 + 4 * q);
                    const f32x4 x1 = v0, x2 = v1; v0 = x1 * cs - x2 * sn; v1 = x1 * sn + x2 * cs; }
                *(u32x4*)P32(Q, ((b * 8 + h) * SEQ + s) * 192 + j) = pack8(v0, v1); }
        EPI_ROWS_END
    }
};
struct EpiKV { static constexpr bool PERM = true;
    bf16 *KF, *V; const float* ssq;
    DI void operator()(const Acc& acc, const Unit& u, int wr, int wc, int fr, int fq) const {
        EPI_ROWS_BEGIN
            const f32x4 q2 = *(const f32x4*)P32(ssq, row * 12 + 8); const float rs = __builtin_amdgcn_rsqf(((q2.x + q2.y) + (q2.z + q2.w)) * (1.f / 256.f) + RMS_EPS); const int b = row / SEQ, s = row % SEQ, h = u.pn, j = 32 * wc + 8 * fq; const int tok = (b * 8 + h) * SEQ + s;
            *(u32x4*)P32(KF, tok * 192 + j) = pack8(acc[ai][0][m][0] * rs, acc[ai][0][m][1] * rs);
            *(u32x4*)P32(V, tok * 128 + j) = pack8(acc[ai][1][m][0] * rs, acc[ai][1][m][1] * rs);
        EPI_ROWS_END
    }
};
struct S5Order { int G, c;
    DI bool next(int i, Unit& u) const { const int L = i * G + c; if (L >= 256) return false; u.pm = L; u.pn = L >> 2; u.aux = 0; return true; }
    DI int arow(const Unit&, int) const { return 0; }
    DI int koff(const Unit&) const { return 0; } };
struct EpiS5E { static constexpr bool PERM = false;
    float* ES;
    DI void operator()(const Acc& acc, const Unit& u, int wr, int wc, int fr, int fq) const {
        EPI_ROWS_BEGIN
#pragma unroll
            for (int n = 0; n < 2; ++n) *(f32x4*)P32(ES, row * 128 + 32 * wc + 16 * n + 4 * fq) = acc[ai][0][m][n];
        EPI_ROWS_END
    }
};
DI float gelu_tanh(float x) { const float t = 0.7978845608028654f * (x + 0.044715f * x * x * x); const float e = __expf(2.f * t); return 0.5f * x * (1.f + (1.f - 2.f * __builtin_amdgcn_rcpf(e + 1.f))); }
struct EpiS5Y { static constexpr bool PERM = true;
    bf16* YS5; const bf16* XH; const float* dsk;
    DI void operator()(const Acc& acc, const Unit& u, int wr, int wc, int fr, int fq) const {
        EPI_ROWS_BEGIN
            const int g = row >> 10, chunk = row & 1023;
#pragma unroll
            for (int bj = 0; bj < 2; ++bj) { const int col = 128 * bj + 32 * wc + 8 * fq, tl = col >> 4, c0 = col & 15; const u32x4 uu = *(const u32x4*)P32(XH, row * 384 + col);
                const f32x4 d0 = *(const f32x4*)P32(dsk, g * 16 + c0), d1 = *(const f32x4*)P32(dsk, g * 16 + c0 + 4); const f32x4 a0 = acc[ai][bj][m][0], a1 = acc[ai][bj][m][1];
                f32x4 y0 = {a0.x + d0.x * bflo(uu.x), a0.y + d0.y * bfhi(uu.x), a0.z + d0.z * bflo(uu.y), a0.w + d0.w * bfhi(uu.y)};
                f32x4 y1 = {a1.x + d1.x * bflo(uu.z), a1.y + d1.y * bfhi(uu.z), a1.z + d1.z * bflo(uu.w), a1.w + d1.w * bfhi(uu.w)};
#pragma unroll
                for (int e = 0; e < 4; ++e) { y0[e] = gelu_tanh(y0[e]); y1[e] = gelu_tanh(y1[e]); }
                *(u32x4*)P32(YS5, (chunk * 16 + tl) * 1024 + g * 16 + c0) = pack8(y0, y1); }
        EPI_ROWS_END
    }
};
struct EpiGlu { static constexpr bool PERM = true;
    bf16* MIX; const bf16* YS5;
    DI void operator()(const Acc& acc, const Unit& u, int wr, int wc, int fr, int fq) const {
        EPI_ROWS_BEGIN
#pragma unroll
            for (int bj = 0; bj < 2; ++bj) { const int col = u.pn * 256 + 128 * bj + 32 * wc + 8 * fq; const u32x4 yy = *(const u32x4*)P32(YS5, row * 1024 + col); const f32x4 a0 = acc[ai][bj][m][0], a1 = acc[ai][bj][m][1];
                const f32x4 o0 = {bflo(yy.x) * sigmoidf_(a0.x), bfhi(yy.x) * sigmoidf_(a0.y), bflo(yy.y) * sigmoidf_(a0.z), bfhi(yy.y) * sigmoidf_(a0.w)};
                const f32x4 o1 = {bflo(yy.z) * sigmoidf_(a1.x), bfhi(yy.z) * sigmoidf_(a1.y), bflo(yy.w) * sigmoidf_(a1.z), bfhi(yy.w) * sigmoidf_(a1.w)};
                { unsigned char* mx = (unsigned char*)MIX; u32x2 o8 = {pk4_fp8(o0.x, o0.y, o0.z, o0.w), pk4_fp8(o1.x, o1.y, o1.z, o1.w)}; *(u32x2*)P32(mx, row * 2048 + 1024 + col) = o8; } }
        EPI_ROWS_END
    }
};
template <bool XBF> struct EpiRes { static constexpr bool PERM = true;
    bf16* XPRE; const void* xres; const float* gate;
    DI void operator()(const Acc& acc, const Unit& u, int wr, int wc, int fr, int fq) const {
        EPI_ROWS_BEGIN
            const int b = row / SEQ;
#pragma unroll
            for (int bj = 0; bj < 2; ++bj) { const int col = u.pn * 256 + 128 * bj + 32 * wc + 8 * fq;
                f32x4 x0, x1;
                if (XBF) { const bf16* xb = (const bf16*)xres; const u32x4 xq = *(const u32x4*)P32(xb, row * D + col); x0 = (f32x4){bflo(xq.x), bfhi(xq.x), bflo(xq.y), bfhi(xq.y)}; x1 = (f32x4){bflo(xq.z), bfhi(xq.z), bflo(xq.w), bfhi(xq.w)}; }
                else { const float* xf = (const float*)xres; x0 = *(const f32x4*)P32(xf, row * D + col); x1 = *(const f32x4*)P32(xf, row * D + col + 4); }
                const f32x4 g0 = *(const f32x4*)P32(gate, b * 12288 + col), g1 = *(const f32x4*)P32(gate, b * 12288 + col + 4);
                *(u32x4*)P32(XPRE, row * D + col) = pack8(x0 * DN_ALPHA + (g0 + 1.f) * acc[ai][bj][m][0], x1 * DN_ALPHA + (g1 + 1.f) * acc[ai][bj][m][1]); }
        EPI_ROWS_END
    }
};

DI void krope_pass(const bf16* KR, const float* rope, bf16* KF, int wv) {
    const int gt = blockIdx.x * 512 + otid(wv), NT_ = gridDim.x * 512;
    for (int i = gt; i < T * 8; i += NT_) { const int row = i >> 3, q = i & 7, b = row / SEQ, s = row % SEQ; const u32x4 r = *(const u32x4*)(KR + (size_t)row * 64 + q * 8);
        const f32x4 x1 = {bflo(r.x), bfhi(r.x), bflo(r.y), bfhi(r.y)}, x2 = {bflo(r.z), bfhi(r.z), bflo(r.w), bfhi(r.w)};
        const f32x4 cs = *(const f32x4*)(rope + s * 32 + 4 * q), sn = *(const f32x4*)(rope + 4096 * 32 + s * 32 + 4 * q);
        const u32x4 o = pack8(x1 * cs - x2 * sn, x1 * sn + x2 * cs);
#pragma unroll
        for (int h = 0; h < 8; ++h) *(u32x4*)(KF + ((size_t)(b * 8 + h) * SEQ + s) * 192 + 128 + q * 8) = o; }
}
DI void s5_carry(const float* ES, const float* L16, bf16* XH, LAS unsigned char* lds, int wv) {
    const int tid = otid(wv), lane = tid & 63, w = tid >> 6; LAS float* SEG = (LAS float*)lds;
    for (int base = blockIdx.x * 64; base < 4 * 64 * 64; base += gridDim.x * 64) {
        const int gt = base + lane, p = gt & 63, g = (gt >> 6) & 63, b = gt >> 12; const float lr = L16[(g * 64 + p) * 2], li = L16[(g * 64 + p) * 2 + 1];
        const size_t r0 = (size_t)g * 1024 + b * 256 + 32 * w;
        float hr = 0.f, hi = 0.f;
#pragma unroll 16
        for (int k = 0; k < 32; ++k) { const float er = ES[(r0 + k) * 128 + p], ei = ES[(r0 + k) * 128 + 64 + p]; const float nr = lr * hr - li * hi + er, ni = lr * hi + li * hr + ei; hr = nr; hi = ni; }
        __syncthreads();
        SEG[(w * 64 + lane) * 2] = hr; SEG[(w * 64 + lane) * 2 + 1] = hi;
        float pr = lr, pi = li;
#pragma unroll
        for (int q = 0; q < 5; ++q) { const float nr = pr * pr - pi * pi, ni = 2.f * pr * pi; pr = nr; pi = ni; }
        __syncthreads();
        hr = 0.f; hi = 0.f;
        for (int u = 0; u < w; ++u) { const float er = SEG[(u * 64 + lane) * 2], ei = SEG[(u * 64 + lane) * 2 + 1]; const float nr = pr * hr - pi * hi + er, ni = pr * hi + pi * hr + ei; hr = nr; hi = ni; }
#pragma unroll 16
        for (int k = 0; k < 32; ++k) { const float er = ES[(r0 + k) * 128 + p], ei = ES[(r0 + k) * 128 + 64 + p];
            XH[(r0 + k) * 384 + 256 + p] = f2bf(hr); XH[(r0 + k) * 384 + 320 + p] = f2bf(hi);
            const float nr = lr * hr - li * hi + er, ni = lr * hi + li * hr + ei; hr = nr; hi = ni; }
    }
    __syncthreads();
}

#define MFMA32(a, b, c) __builtin_amdgcn_mfma_f32_32x32x16_bf16((a), (b), (c), 0, 0, 0)
constexpr int AT_KROW = 384, AT_VROW = 256, AT_KBYTES = 64 * AT_KROW, AT_STG = AT_KBYTES + 64 * AT_VROW, AT_NST = 3;
static_assert(AT_NST * AT_STG <= RING_BYTES, "attention LDS");
DI void mla_attn_unit(LAS unsigned char* lds, const bf16* Qg, const bf16* KFg, const bf16* Vg, bf16* MIX, int unit, int wv) {
    const int tid = otid(wv), lane = tid & 63, w = tid >> 6, r = lane & 31, hh = lane >> 5;
    const int b = unit >> 6, h = (unit >> 3) & 7, pi = unit & 7;
    const bf16* Qh = Qg + (size_t)(b * 8 + h) * SEQ * 192; const bf16* Kh = KFg + (size_t)(b * 8 + h) * SEQ * 192; const bf16* Vh = Vg + (size_t)(b * 8 + h) * SEQ * 128;
    const int w_ = __builtin_amdgcn_readfirstlane(w);
    int koff[3], voff[2];
#pragma unroll
    for (int i = 0; i < 3; ++i) { const int p = (3 * w_ + i) * 64 + lane, row = p / 24, cs = p % 24, c = (cs & ~7) | ((cs ^ (row >> 1)) & 7); koff[i] = row * 192 + c * 8; }
#pragma unroll
    for (int i = 0; i < 2; ++i) { const int p = (2 * w_ + i) * 64 + lane, row = p >> 4, cs = p & 15, c = cs ^ ((row & 3) << 2); voff[i] = row * 128 + c * 8; }
    const int kx = (r >> 1) & 7, vq = (lane >> 2) & 3;
    for (int half = 0; half < 2; ++half) {
        const int qb = half ? 15 - pi : pi, q0 = qb * 256 + 32 * w, nkt = (qb + 1) * 4;
        bf16x8 qf[12];
#pragma unroll
        for (int ks = 0; ks < 12; ++ks) qf[ks] = *(const GAS bf16x8*)P32(Qh, (q0 + r) * 192 + 16 * ks + 8 * hh);
        f32x16 O[4];
#pragma unroll
        for (int i = 0; i < 4; ++i) for (int e = 0; e < 16; ++e) O[i][e] = 0.f;
        float mrow = -1e30f, lrow = 0.f;
#define AT_DMA(kt, stg) do { LAS unsigned char* sb_ = lds + (stg) * AT_STG; \
        _Pragma("unroll") for (int i = 0; i < 3; ++i) __builtin_amdgcn_global_load_lds((const unsigned*)P32(Kh, (kt) * 64 * 192 + koff[i]), (LAS unsigned*)(sb_ + (3 * w_ + i) * 1024), 16, 0, 0); \
        _Pragma("unroll") for (int i = 0; i < 2; ++i) __builtin_amdgcn_global_load_lds((const unsigned*)P32(Vh, (kt) * 64 * 128 + voff[i]), (LAS unsigned*)(sb_ + AT_KBYTES + (2 * w_ + i) * 1024), 16, 0, 0); } while (0)
#define AT_BAR() do { asm volatile("s_waitcnt lgkmcnt(0)" ::: "memory"); __builtin_amdgcn_s_barrier(); asm volatile("" ::: "memory"); } while (0)
        __syncthreads();
        AT_DMA(0, 0); AT_DMA(1, 1);
        asm volatile("s_waitcnt vmcnt(5)" ::: "memory");
        AT_BAR();
        int stg = 0;
        for (int kt = 0; kt < nkt; ++kt) {
            if (kt + 2 < nkt) AT_DMA(kt + 2, stg == 0 ? 2 : stg - 1);
            const LAS unsigned char* sb = lds + stg * AT_STG;
            if (kt * 64 <= q0 + 31) {
                f32x16 st[2];
#pragma unroll
                for (int mt = 0; mt < 2; ++mt) for (int e = 0; e < 16; ++e) st[mt][e] = 0.f;
                __builtin_amdgcn_sched_barrier(0);
                {
                    const LAS unsigned char* kb = sb + r * AT_KROW; const LAS unsigned char* kx4[4];
#pragma unroll
                    for (int j = 0; j < 4; ++j) kx4[j] = kb + (((2 * j + hh) ^ kx) & 7) * 16;
                    bf16x8 kf[24];
#pragma unroll
                    for (int i = 0; i < 24; ++i) kf[i] = *(const LAS bf16x8*)(kx4[(i >> 1) & 3] + 32 * (i & 1) * AT_KROW + 128 * (i >> 3));
#pragma unroll
                    for (int i = 0; i < 24; ++i) st[i & 1] = MFMA32(kf[i], qf[i >> 1], st[i & 1]);
                    __builtin_amdgcn_sched_group_barrier(0x100, 4, 0);
#pragma unroll
                    for (int i = 0; i < 24; ++i) { __builtin_amdgcn_sched_group_barrier(0x008, 1, 0); __builtin_amdgcn_sched_group_barrier(0x100, 1, 0); }
                }
                __builtin_amdgcn_sched_barrier(0);
                if (kt * 64 + 63 > q0) {
                    const int qg = q0 + r;
#pragma unroll
                    for (int mt = 0; mt < 2; ++mt)
#pragma unroll
                        for (int e = 0; e < 16; ++e) { const int kg = kt * 64 + 32 * mt + (e & 3) + 8 * (e >> 2) + 4 * hh; if (kg > qg) st[mt][e] = -1e30f; }
                }
                float mx = st[0][0];
#pragma unroll
                for (int mt = 0; mt < 2; ++mt)
#pragma unroll
                    for (int e = 0; e < 16; ++e) mx = fmaxf(mx, st[mt][e]);
                mx = fmaxf(mx, __shfl_xor(mx, 32));
                const float mnew = fmaxf(mrow, mx), alpha = __builtin_amdgcn_exp2f(mrow - mnew); mrow = mnew;
                float ls = 0.f;
#pragma unroll
                for (int mt = 0; mt < 2; ++mt)
#pragma unroll
                    for (int e = 0; e < 16; ++e) { const float p = __builtin_amdgcn_exp2f(st[mt][e] - mnew); st[mt][e] = p; ls += p; }
                lrow = lrow * alpha + ls;
                if (__any(alpha != 1.f)) {
#pragma unroll
                    for (int i = 0; i < 4; ++i) O[i] *= alpha; }
                bf16x8 pf[2][2];
#pragma unroll
                for (int mt = 0; mt < 2; ++mt)
#pragma unroll
                    for (int s = 0; s < 2; ++s) { u32x4 pk = {pk2(st[mt][8 * s], st[mt][8 * s + 1]), pk2(st[mt][8 * s + 2], st[mt][8 * s + 3]), pk2(st[mt][8 * s + 4], st[mt][8 * s + 5]), pk2(st[mt][8 * s + 6], st[mt][8 * s + 7])};
                        pf[mt][s] = __builtin_bit_cast(bf16x8, pk); }
                __builtin_amdgcn_sched_barrier(0);
                {
                    const LAS unsigned char* vb = sb + AT_KBYTES + (4 * hh + vq) * AT_VROW + 32 * ((lane >> 4) & 1) + 8 * (lane & 3); const LAS unsigned char* vx4[4];
#pragma unroll
                    for (int d = 0; d < 4; ++d) vx4[d] = vb + ((d ^ vq) & 3) * 64;
                    bf16x8 af[16];
#pragma unroll
                    for (int i = 0; i < 16; ++i) { const LAS unsigned char* vp = vx4[i & 3] + 16 * (i >> 2) * AT_VROW;
                        const s16x4 lo = __builtin_amdgcn_ds_read_tr16_b64_v4i16((LAS s16x4*)vp), hi = __builtin_amdgcn_ds_read_tr16_b64_v4i16((LAS s16x4*)(vp + 8 * AT_VROW)); af[i] = __builtin_shufflevector(lo, hi, 0, 1, 2, 3, 4, 5, 6, 7); }
#pragma unroll
                    for (int i = 0; i < 16; ++i) O[i & 3] = MFMA32(af[i], pf[i >> 3][(i >> 2) & 1], O[i & 3]);
                    __builtin_amdgcn_sched_group_barrier(0x100, 8, 0);
#pragma unroll
                    for (int i = 0; i < 16; ++i) { __builtin_amdgcn_sched_group_barrier(0x008, 1, 0); __builtin_amdgcn_sched_group_barrier(0x100, 2, 0); }
                }
                __builtin_amdgcn_sched_barrier(0);
            }
            if (kt + 2 < nkt) asm volatile("s_waitcnt vmcnt(5)" ::: "memory"); else asm volatile("s_waitcnt vmcnt(0)" ::: "memory");
            AT_BAR();
            stg = stg == 2 ? 0 : stg + 1;
        }
        lrow += __shfl_xor(lrow, 32);
        const float inv = 1.f / lrow;
        unsigned char* mx_ = (unsigned char*)MIX; unsigned char* orow = P32(mx_, (b * SEQ + q0 + r) * 2048 + h * 128);
#pragma unroll
        for (int dvt = 0; dvt < 4; ++dvt)
#pragma unroll
            for (int g4 = 0; g4 < 4; ++g4) *(GAS unsigned*)(orow + dvt * 32 + 8 * g4 + 4 * hh) = pk4_fp8(O[dvt][4 * g4] * inv, O[dvt][4 * g4 + 1] * inv, O[dvt][4 * g4 + 2] * inv, O[dvt][4 * g4 + 3] * inv);
    }
#undef AT_DMA
#undef AT_BAR
}

DI void ln_router_phase(const KArgs& a, LAS unsigned char* lds, int layer, const bf16* XPRE, bf16* X1, bf16* H, int wv) {
    const int tid = otid(wv), lane = tid & 63, wave = tid >> 6;
    LAS float* wT = (LAS float*)lds;
    { f32x4 rw[4][4];
#pragma unroll
      for (int i = 0; i < 4; ++i)
#pragma unroll
          for (int q4 = 0; q4 < 4; ++q4) rw[i][q4] = *(const f32x4*)(a.in[I_RW] + (size_t)(tid + 512 * i) * 16 + 4 * q4);
#pragma unroll
      for (int i = 0; i < 4; ++i)
#pragma unroll
          for (int q4 = 0; q4 < 4; ++q4)
#pragma unroll
              for (int e4 = 0; e4 < 4; ++e4) wT[(4 * q4 + e4) * 2048 + tid + 512 * i] = rw[i][q4][e4]; }
    __syncthreads();
    const float* MODl = (const float*)(a.ws + CTL_MOD) + (size_t)layer * 4 * 12288;
    const float* lg = a.in[I_LNMG] + layer * D; const float* lb = a.in[I_LNMB] + layer * D;
    unsigned* cnt = (unsigned*)(a.ws + CTL_CNT) + layer * 16 * 64;
    LAS int* lcnt = (LAS int*)(lds + LDS_MISC + 256); LAS int* lbase = lcnt + 16; LAS int* rec = lcnt + 32;
    if (tid < 16) lcnt[tid] = 0;
    int* RTE = (int*)(a.ws + A_RT); int* RTP = RTE + 2 * T; float* RTW = (float*)(RTP + 2 * T); int* TOKL = (int*)(a.ws + A_TOKL);
    const LAS float* wp[16];
#pragma unroll
    for (int e = 0; e < 16; ++e) { wp[e] = wT + e * 2048 + lane * 4; asm volatile("" : "+v"(wp[e])); }
    const float rbl = a.in[I_RB][lane >> 2];
    int lr = wave;
    for (int m = blockIdx.x * 8 + wave; m < T; m += gridDim.x * 8, lr += 8) {
        const int b = m / SEQ; const float* sh = MODl + (size_t)b * 12288 + 3 * 2048; const float* sc = sh + 2048;
        f32x4 v[8]; float s = 0.f;
#pragma unroll
        for (int j = 0; j < 8; ++j) { const u32x2 xp = *(const GAS u32x2*)(XPRE + (size_t)m * D + (lane + 64 * j) * 4); v[j] = (f32x4){bflo(xp.x), bfhi(xp.x), bflo(xp.y), bfhi(xp.y)}; s += (v[j].x + v[j].y) + (v[j].z + v[j].w); }
        const float mean = wave_sum(s) * (1.f / D); float s2 = 0.f;
#pragma unroll
        for (int j = 0; j < 8; ++j) { v[j] = v[j] - mean; s2 += (v[j].x * v[j].x + v[j].y * v[j].y) + (v[j].z * v[j].z + v[j].w * v[j].w); }
        const float rstd = rsqrtf(wave_sum(s2) * (1.f / D) + LN_EPS);
#pragma unroll
        for (int j = 0; j < 8; ++j) { const int col = (lane + 64 * j) * 4; const f32x4 x1 = v[j] * rstd * *(const f32x4*)(lg + col) + *(const f32x4*)(lb + col);
            { u32x2 ox = {pk2(x1.x, x1.y), pk2(x1.z, x1.w)}; *(GAS u32x2*)(X1 + (size_t)m * D + col) = ox; }
            const f32x4 hv = x1 * (*(const f32x4*)(sc + col) + 1.f) + *(const f32x4*)(sh + col);
            *(GAS unsigned*)((unsigned char*)H + (size_t)m * D + col) = pk4_fp8(hv.x, hv.y, hv.z, hv.w); v[j] = hv; }
        f32x2 part2[16];
#pragma unroll
        for (int e = 0; e < 16; ++e) part2[e] = (f32x2){0.f, 0.f};
#pragma unroll
        for (int j = 0; j < 8; ++j) { f32x4 wr_[16];
#pragma unroll
            for (int e = 0; e < 16; ++e) wr_[e] = *(const LAS f32x4*)(wp[e] + j * 256);
            __builtin_amdgcn_sched_barrier(0);
#pragma unroll
            for (int e = 0; e < 16; ++e) { part2[e] += (f32x2){v[j].x, v[j].y} * (f32x2){wr_[e].x, wr_[e].y}; part2[e] += (f32x2){v[j].z, v[j].w} * (f32x2){wr_[e].z, wr_[e].w}; }
            __builtin_amdgcn_sched_barrier(0); }
        float part[16];
#pragma unroll
        for (int e = 0; e < 16; ++e) part[e] = part2[e].x + part2[e].y;
        float r8[8], r4[4], r2[2], lg1;
        { const bool hi = lane & 32;
#pragma unroll
          for (int i = 0; i < 8; ++i) { const float mine = hi ? part[8 + i] : part[i], oth = hi ? part[i] : part[8 + i]; r8[i] = mine + __shfl_xor(oth, 32); } }
        { const bool hi = lane & 16;
#pragma unroll
          for (int i = 0; i < 4; ++i) { const float mine = hi ? r8[4 + i] : r8[i], oth = hi ? r8[i] : r8[4 + i]; r4[i] = mine + __shfl_xor(oth, 16); } }
        { const bool hi = lane & 8;
#pragma unroll
          for (int i = 0; i < 2; ++i) { const float mine = hi ? r4[2 + i] : r4[i], oth = hi ? r4[i] : r4[2 + i]; r2[i] = mine + __shfl_xor(oth, 8); } }
        { const bool hi = lane & 4; const float mine = hi ? r2[1] : r2[0], oth = hi ? r2[0] : r2[1]; lg1 = mine + __shfl_xor(oth, 4); }
        lg1 += dpp_xor1(lg1); lg1 += dpp_xor2(lg1);
        const float sgl = 1.f / (1.f + expf(-lg1)), sbl = sgl + rbl;
        float gs; { const float y1 = dpp_ror<4>(sbl), y2 = dpp_ror<8>(sbl), y3 = dpp_ror<12>(sbl);
            gs = fmaxf(fmaxf(fmaxf(sbl + y1, sbl + y2), fmaxf(sbl + y3, y1 + y2)), fmaxf(y1 + y3, y2 + y3)); }
        int bg = 0; float bgs = __builtin_bit_cast(float, __builtin_amdgcn_readlane(__builtin_bit_cast(int, gs), 0)); asm volatile("" : "+v"(bgs));
#pragma unroll
        for (int g = 1; g < 4; ++g) { float x = __builtin_bit_cast(float, __builtin_amdgcn_readlane(__builtin_bit_cast(int, gs), 16 * g)); asm volatile("" : "+v"(x)); const bool c = x > bgs; bgs = c ? x : bgs; bg = c ? g : bg; }
        const int bgu = __builtin_amdgcn_readfirstlane(bg);
        int e0 = 0, e1 = 0; float b0 = -1e30f, b1 = -1e30f, s0 = 0.f, s1 = 0.f;
#pragma unroll
        for (int i = 0; i < 4; ++i) { float x = __builtin_bit_cast(float, __builtin_amdgcn_readlane(__builtin_bit_cast(int, sbl), 16 * bgu + 4 * i)), sx = __builtin_bit_cast(float, __builtin_amdgcn_readlane(__builtin_bit_cast(int, sgl), 16 * bgu + 4 * i));
            asm volatile("" : "+v"(x), "+v"(sx)); const int e = 4 * bg + i; const bool g0 = x > b0, g1 = x > b1;
            b1 = g0 ? b0 : (g1 ? x : b1); e1 = g0 ? e0 : (g1 ? e : e1); s1 = g0 ? s0 : (g1 ? sx : s1);
            b0 = g0 ? x : b0; e0 = g0 ? e : e0; s0 = g0 ? sx : s0; }
        if (lane == 0) { const float inv = 1.f / (s0 + s1);
            const int p0 = __hip_atomic_fetch_add(lcnt + e0, 1, __ATOMIC_RELAXED, __HIP_MEMORY_SCOPE_WORKGROUP), p1 = __hip_atomic_fetch_add(lcnt + e1, 1, __ATOMIC_RELAXED, __HIP_MEMORY_SCOPE_WORKGROUP);
            rec[lr * 4] = m; rec[lr * 4 + 1] = e0; rec[lr * 4 + 2] = e1; rec[lr * 4 + 3] = p0 | (p1 << 16);
            RTE[2 * m] = e0; RTE[2 * m + 1] = e1; RTW[2 * m] = s0 * inv; RTW[2 * m + 1] = s1 * inv; }
    }
    __syncthreads();
    if (tid < 16) lbase[tid] = (int)atomicAdd(cnt + tid * 64, (unsigned)lcnt[tid]);
    __syncthreads();
    const int nrows = (T - (int)blockIdx.x * 8 + (int)gridDim.x * 8 - 1) / ((int)gridDim.x * 8) * 8;
    for (int i = tid; i < nrows; i += 512) { const int k = i >> 3, w8 = i & 7, m = (int)blockIdx.x * 8 + w8 + k * (int)gridDim.x * 8;
        if (m < T) { const int e0 = rec[i * 4 + 1], e1 = rec[i * 4 + 2], pp = rec[i * 4 + 3], q0 = lbase[e0] + (pp & 0xffff), q1 = lbase[e1] + (pp >> 16);
            TOKL[e0 * T + q0] = m; TOKL[e1 * T + q1] = m; RTP[2 * m] = q0; RTP[2 * m + 1] = q1; } }
    __syncthreads();
}

DI void moe_table(const KArgs& a, LAS unsigned char* lds, int layer, int wv) {
    LAS int* tab = (LAS int*)(lds + LDS_TAB);
    if (otid(wv) == 0) { const unsigned* cnt = (const unsigned*)(a.ws + CTL_CNT) + layer * 16 * 64; int acc = 0;
        for (int e = 0; e < 16; ++e) { const int c = (int)cnt[e * 64]; tab[e] = acc; tab[32 + e] = c; acc += (c + 255) >> 8; } tab[16] = acc; }
    __syncthreads();
}
template <int NTB> struct MoeOrder {
    int G, c, layer; const LAS int* tab; const int* tokl;
    DI bool next(int i, Unit& u) const { const int L = i * G + c, mt = L / NTB, nt = L % NTB; if (mt >= tab[16]) return false; int e = 0;
#pragma unroll
        for (int k = 1; k < 16; ++k) e += (mt >= tab[k]) ? 1 : 0;
        u.pm = mt; u.pn = (layer * 16 + e) * NTB + nt; u.aux = e | (nt << 8) | ((mt - tab[e]) << 16); return true; }
    DI int arow(const Unit& u, int r) const { const int e = u.aux & 255, j = (u.aux >> 16) * 256 + r; return j < tab[32 + e] ? tokl[e * T + j] : 0; }
    DI int koff(const Unit&) const { return 0; }
};
struct EpiGateUp { static constexpr bool PERM = true;
    unsigned char* ACT;
    DI void operator()(const Acc& acc, const Unit& u, int wr, int wc, int fr, int fq) const {
        const int nt = (u.aux >> 8) & 255;
        EPI_ROWS_BEGIN
            const f32x4 g0 = acc[ai][0][m][0], g1 = acc[ai][0][m][1], u0 = acc[ai][1][m][0], u1 = acc[ai][1][m][1];
            f32x4 o0, o1;
#pragma unroll
            for (int e = 0; e < 4; ++e) { o0[e] = g0[e] * sigmoidf_(g0[e]) * u0[e]; o1[e] = g1[e] * sigmoidf_(g1[e]) * u1[e]; }
            u32x2 o8 = {pk4_fp8(o0.x, o0.y, o0.z, o0.w), pk4_fp8(o1.x, o1.y, o1.z, o1.w)}; *(u32x2*)P32(ACT, row * 512 + nt * 128 + 32 * wc + 8 * fq) = o8;
        EPI_ROWS_END
    }
};
struct EpiDown { static constexpr bool PERM = true;
    bf16* YS;
    DI void operator()(const Acc& acc, const Unit& u, int wr, int wc, int fr, int fq) const {
        const int nt = (u.aux >> 8) & 255;
        EPI_ROWS_BEGIN
#pragma unroll
            for (int bj = 0; bj < 2; ++bj) *(u32x4*)P32(YS, row * 2048 + nt * 256 + 128 * bj + 32 * wc + 8 * fq) = pack8(acc[ai][bj][m][0], acc[ai][bj][m][1]);
        EPI_ROWS_END
    }
};
DI void ln_ffn_phase(const KArgs& a, int layer, const bf16* X1, float* XO, bf16* Hn, int wv) {
    const int lane = otid(wv) & 63, wave = otid(wv) >> 6;
    const float* MODl = (const float*)(a.ws + CTL_MOD) + (size_t)layer * 4 * 12288; const float* MODn = MODl + 4 * 12288;
    const float* lg = a.in[I_LNFG] + layer * D; const float* lb = a.in[I_LNFB] + layer * D;
    const unsigned* cnt = (const unsigned*)(a.ws + CTL_CNT) + layer * 16 * 64;
    const int* RTE = (const int*)(a.ws + A_RT); const int* RTP = RTE + 2 * T; const float* RTW = (const float*)(RTP + 2 * T); const bf16* YS = (const bf16*)(a.ws + A_YS);
    for (int m = blockIdx.x * 8 + wave; m < T; m += gridDim.x * 8) {
        const int b = m / SEQ; const float* gf = MODl + (size_t)b * 12288 + 5 * 2048;
        const int e0 = RTE[2 * m], e1 = RTE[2 * m + 1]; int t0 = 0, t1 = 0;
        for (int e = 0; e < 16; ++e) { const int tl = ((int)cnt[e * 64] + 255) >> 8; t0 += e < e0 ? tl : 0; t1 += e < e1 ? tl : 0; }
        const bf16* y0 = YS + ((size_t)t0 * 256 + RTP[2 * m]) * 2048; const bf16* y1 = YS + ((size_t)t1 * 256 + RTP[2 * m + 1]) * 2048; const float w0 = RTW[2 * m], w1 = RTW[2 * m + 1];
        f32x4 v[8]; float s = 0.f;
#pragma unroll
        for (int j = 0; j < 8; ++j) { const int col = (lane + 64 * j) * 4; const u32x2 a0 = *(const u32x2*)(y0 + col), a1 = *(const u32x2*)(y1 + col);
            const f32x4 y = {w0 * bflo(a0.x) + w1 * bflo(a1.x), w0 * bfhi(a0.x) + w1 * bfhi(a1.x), w0 * bflo(a0.y) + w1 * bflo(a1.y), w0 * bfhi(a0.y) + w1 * bfhi(a1.y)};
            const u32x2 xq = *(const u32x2*)(X1 + (size_t)m * D + col); const f32x4 xv = {bflo(xq.x), bfhi(xq.x), bflo(xq.y), bfhi(xq.y)};
            v[j] = xv * DN_ALPHA + (*(const f32x4*)(gf + col) + 1.f) * y; s += (v[j].x + v[j].y) + (v[j].z + v[j].w); }
        const float mean = wave_sum(s) * (1.f / D); float s2 = 0.f;
#pragma unroll
        for (int j = 0; j < 8; ++j) { v[j] = v[j] - mean; s2 += (v[j].x * v[j].x + v[j].y * v[j].y) + (v[j].z * v[j].z + v[j].w * v[j].w); }
        const float rstd = rsqrtf(wave_sum(s2) * (1.f / D) + LN_EPS);
#pragma unroll
        for (int j = 0; j < 8; ++j) { const int col = (lane + 64 * j) * 4; const f32x4 xo = v[j] * rstd * *(const f32x4*)(lg + col) + *(const f32x4*)(lb + col);
            if (Hn) { u32x2 oq = {pk2(xo.x, xo.y), pk2(xo.z, xo.w)}; *(u32x2*)((bf16*)XO + (size_t)m * D + col) = oq; }
            else *(f32x4*)(XO + (size_t)m * D + col) = xo;
            if (Hn) { const float* sh = MODn + (size_t)b * 12288; const f32x4 hv = xo * (*(const f32x4*)(sh + 2048 + col) + 1.f) + *(const f32x4*)(sh + col);
                *(unsigned*)((unsigned char*)Hn + (size_t)m * D + col) = pk4_fp8(hv.x, hv.y, hv.z, hv.w); } }
    }
}

struct EpiIn1 { static constexpr bool PERM = true;
    bf16 *ZD, *ZR;
    DI void operator()(const Acc& acc, const Unit& u, int wr, int wc, int fr, int fq) const {
        EPI_ROWS_BEGIN
#pragma unroll
            for (int bj = 0; bj < 2; ++bj) { const int col = u.pn * 256 + 128 * bj + 32 * wc + 8 * fq; const u32x4 o = pack8(acc[ai][bj][m][0], acc[ai][bj][m][1]);
                if (col < DIL_IN) *(u32x4*)P32(ZD, row * DIL_IN + col) = o; else if (col < ODD_IN) *(u32x4*)P32(ZR, row * RW_IN + (col - DIL_IN)) = o; }
        EPI_ROWS_END
    }
};
constexpr int DA_KSTR = 272, DA_VROW = 320, DA_KBYTES = 64 * DA_KSTR, DA_STG = DA_KBYTES + 64 * DA_VROW;
struct DilPre { bf16x8 qf[4]; u32x4 kreg[2], vreg[2]; float blv[2]; };
DI void dil_issue(const bf16* ZD, const float* BL, int unit, int wv, DilPre& P) {
    const int tid = otid(wv), lane = tid & 63, w = tid >> 6, r = lane & 31, hh = lane >> 5, hd = w >> 2, qs = w & 3;
    const int hp = unit & 3, sb_ = (unit >> 2) & 31, gi = (unit >> 7) % 3, b = unit / 384;
    const int dil = gi == 0 ? 1 : (gi == 1 ? 4 : 16), nb = 32 / dil, rr = sb_ / nb, n = sb_ % nb, h = hp * 2 + hd, kt0 = n == 0 ? 2 : 0;
    const bf16* Zb = ZD + (size_t)b * SEQ * DIL_IN + gi * 1536;
    const int qtok = (n * 128 + 32 * qs + r) * dil + rr;
#pragma unroll
    for (int k = 0; k < 2; ++k) { const int i = tid + 512 * k, hd_ = i >= 384 ? 1 : 0, d = i - 384 * hd_ - 127;
        P.blv[k] = (i < 768 && d >= 0 && d <= 128) ? ((const GAS float*)BL)[(gi * 8 + hp * 2 + hd_) * 132 + d] : -1e30f; }
#pragma unroll
    for (int ks = 0; ks < 4; ++ks) P.qf[ks] = *(const GAS bf16x8*)P32(Zb, qtok * DIL_IN + h * 64 + 16 * ks + 8 * hh);
#pragma unroll
    for (int i = 0; i < 2; ++i) { const int p = tid + 512 * i, kr = p >> 4, c16 = p & 15; const int ktok = ((n - 1) * 128 + kt0 * 64 + kr) * dil + rr;
        P.kreg[i] = *(const GAS u32x4*)P32(Zb, ktok * DIL_IN + 512 + hp * 128 + c16 * 8); P.vreg[i] = *(const GAS u32x4*)P32(Zb, ktok * DIL_IN + 1024 + hp * 128 + c16 * 8); }
}
DI void dil_attn_unit(LAS unsigned char* lds, const bf16* ZD, const float* BL, bf16* DPO, float* DPM, float* DPL, int unit, int next, DilPre& P, int wv) {
    const int tid = otid(wv), lane = tid & 63, w = tid >> 6, r = lane & 31, hh = lane >> 5, hd = w >> 2, qs = w & 3;
    const int hp = unit & 3, sb_ = (unit >> 2) & 31, gi = (unit >> 7) % 3, b = unit / 384;
    const int dil = gi == 0 ? 1 : (gi == 1 ? 4 : 16), nb = 32 / dil, rr = sb_ / nb, n = sb_ % nb;
    const int h = hp * 2 + hd;
    const bf16* Zb = ZD + (size_t)b * SEQ * DIL_IN + gi * 1536;
    LAS float* bl = (LAS float*)(lds + 2 * DA_STG);
    __syncthreads();
    bl[tid] = P.blv[0]; if (tid < 256) bl[512 + tid] = P.blv[1];
    const int qi = 32 * qs + r, qtok = (n * 128 + qi) * dil + rr;
    bf16x8 qf[4];
#pragma unroll
    for (int ks = 0; ks < 4; ++ks) qf[ks] = P.qf[ks];
    f32x16 O[2];
#pragma unroll
    for (int i = 0; i < 2; ++i) for (int e = 0; e < 16; ++e) O[i][e] = 0.f;
    float mrow = -1e30f, lrow = 0.f;
    u32x4 kreg[2] = {P.kreg[0], P.kreg[1]}, vreg[2] = {P.vreg[0], P.vreg[1]};
    const int kt0 = n == 0 ? 2 : 0;
#define DA_LOAD(kt) do { _Pragma("unroll") for (int i = 0; i < 2; ++i) { const int p = tid + 512 * i, kr = p >> 4, c16 = p & 15; const int ktok = ((n - 1) * 128 + (kt) * 64 + kr) * dil + rr; \
            kreg[i] = *(const GAS u32x4*)P32(Zb, ktok * DIL_IN + 512 + hp * 128 + c16 * 8); } \
        _Pragma("unroll") for (int i = 0; i < 2; ++i) { const int p = tid + 512 * i, kr = p >> 4, c16 = p & 15; const int ktok = ((n - 1) * 128 + (kt) * 64 + kr) * dil + rr; vreg[i] = *(const GAS u32x4*)P32(Zb, ktok * DIL_IN + 1024 + hp * 128 + c16 * 8); } } while (0)
#define DA_STORE(buf) do { LAS unsigned char* sb = lds + (buf) * DA_STG; _Pragma("unroll") for (int i = 0; i < 2; ++i) { const int p = tid + 512 * i, kr = p >> 4, c16 = p & 15; *(LAS u32x4*)(sb + kr * DA_KSTR + c16 * 16) = kreg[i]; } \
        _Pragma("unroll") for (int i = 0; i < 2; ++i) { const int p = tid + 512 * i; *(LAS u32x4*)(sb + DA_KBYTES + (p >> 4) * DA_VROW + (p & 15) * 16) = vreg[i]; } } while (0)
    DA_STORE(kt0 & 1);
    __syncthreads();
    for (int kt = kt0; kt < 4; ++kt) {
        if (kt + 1 < 4) DA_LOAD(kt + 1); else if (next >= 0) dil_issue(ZD, BL, next, wv, P);
        const LAS unsigned char* sb = lds + (kt & 1) * DA_STG;
        if (64 * kt + 63 >= 32 * qs && 64 * kt <= 32 * qs + 31 + 128) {
            f32x16 st[2];
#pragma unroll
            for (int mt = 0; mt < 2; ++mt) for (int e = 0; e < 16; ++e) st[mt][e] = 0.f;
            __builtin_amdgcn_sched_barrier(0);
            {
                const LAS unsigned char* kb = sb + r * DA_KSTR + (hd * 64 + 8 * hh) * 2; bf16x8 kf[8];
#pragma unroll
                for (int i = 0; i < 8; ++i) kf[i] = *(const LAS bf16x8*)(kb + 32 * (i & 1) * DA_KSTR + 32 * (i >> 1));
#pragma unroll
                for (int i = 0; i < 8; ++i) st[i & 1] = MFMA32(kf[i], qf[i >> 1], st[i & 1]);
                __builtin_amdgcn_sched_group_barrier(0x100, 3, 0);
#pragma unroll
                for (int i = 0; i < 8; ++i) { __builtin_amdgcn_sched_group_barrier(0x008, 1, 0); __builtin_amdgcn_sched_group_barrier(0x100, 1, 0); }
            }
            __builtin_amdgcn_sched_barrier(0);
#pragma unroll
            for (int mt = 0; mt < 2; ++mt) { const LAS float* lp = bl + hd * 384 + 127 + (128 + qi - 64 * kt - 32 * mt - 4 * hh) - 27;
#pragma unroll
                for (int e = 0; e < 16; ++e) st[mt][e] = st[mt][e] * (0.125f * 1.44269504089f) + lp[27 - ((e & 3) + 8 * (e >> 2))]; }
            float mx = st[0][0];
#pragma unroll
            for (int mt = 0; mt < 2; ++mt)
#pragma unroll
                for (int e = 0; e < 16; ++e) mx = fmaxf(mx, st[mt][e]);
            mx = fmaxf(mx, __shfl_xor(mx, 32));
            const float mnew = fmaxf(mrow, mx), alpha = __builtin_amdgcn_exp2f(mrow - mnew); mrow = mnew;
            float ls = 0.f;
#pragma unroll
            for (int mt = 0; mt < 2; ++mt)
#pragma unroll
                for (int e = 0; e < 16; ++e) { const float p = __builtin_amdgcn_exp2f(st[mt][e] - mnew); st[mt][e] = p; ls += p; }
            lrow = lrow * alpha + ls;
            if (__any(alpha != 1.f)) { O[0] *= alpha; O[1] *= alpha; }
            bf16x8 pf[2][2];
#pragma unroll
            for (int mt = 0; mt < 2; ++mt)
#pragma unroll
                for (int s = 0; s < 2; ++s) { u32x4 pk = {pk2(st[mt][8 * s], st[mt][8 * s + 1]), pk2(st[mt][8 * s + 2], st[mt][8 * s + 3]), pk2(st[mt][8 * s + 4], st[mt][8 * s + 5]), pk2(st[mt][8 * s + 6], st[mt][8 * s + 7])};
                    pf[mt][s] = __builtin_bit_cast(bf16x8, pk); }
            __builtin_amdgcn_sched_barrier(0);
            {
                const LAS unsigned char* vb = sb + DA_KBYTES + (4 * hh + ((lane >> 2) & 3)) * DA_VROW + (hd * 64 + 16 * ((lane >> 4) & 1)) * 2 + 8 * (lane & 3); bf16x8 af[8];
#pragma unroll
                for (int i = 0; i < 8; ++i) { const LAS unsigned char* vp = vb + 16 * (i >> 1) * DA_VROW + (i & 1) * 64;
                    const s16x4 lo = __builtin_amdgcn_ds_read_tr16_b64_v4i16((LAS s16x4*)vp), hi = __builtin_amdgcn_ds_read_tr16_b64_v4i16((LAS s16x4*)(vp + 8 * DA_VROW)); af[i] = __builtin_shufflevector(lo, hi, 0, 1, 2, 3, 4, 5, 6, 7); }
#pragma unroll
                for (int i = 0; i < 8; ++i) O[i & 1] = MFMA32(af[i], pf[i >> 2][(i >> 1) & 1], O[i & 1]);
                __builtin_amdgcn_sched_group_barrier(0x100, 6, 0);
#pragma unroll
                for (int i = 0; i < 8; ++i) { __builtin_amdgcn_sched_group_barrier(0x008, 1, 0); __builtin_amdgcn_sched_group_barrier(0x100, 2, 0); }
            }
            __builtin_amdgcn_sched_barrier(0);
        }
        if (kt + 1 < 4) DA_STORE((kt + 1) & 1);
        __syncthreads();
    }
    lrow += __shfl_xor(lrow, 32);
    const float inv = 1.f / lrow;
    const int tokg = b * SEQ + qtok;
    bf16* orow = P32(DPO, (gi * T + tokg) * 512 + h * 64);
#pragma unroll
    for (int dvt = 0; dvt < 2; ++dvt)
#pragma unroll
        for (int g4 = 0; g4 < 4; ++g4) { u32x2 o = {pk2(O[dvt][4 * g4] * inv, O[dvt][4 * g4 + 1] * inv), pk2(O[dvt][4 * g4 + 2] * inv, O[dvt][4 * g4 + 3] * inv)};
            *(GAS u32x2*)(orow + dvt * 32 + 8 * g4 + 4 * hh) = o; }
    if (hh == 0) { *(GAS float*)P32(DPM, (gi * T + tokg) * 8 + h) = mrow; *(GAS float*)P32(DPL, (gi * T + tokg) * 8 + h) = lrow; }
#undef DA_LOAD
#undef DA_STORE
}
DI void dil_merge(const bf16* DPO, const float* DPM, const float* DPL, bf16* MIX, int wv) {
    const int gt = blockIdx.x * 512 + otid(wv), NT_ = gridDim.x * 512;
    for (int i = gt; i < T * 64; i += NT_) { const int tok = i >> 6, c8 = i & 63, h = c8 >> 3;
        float m[3], l[3];
#pragma unroll
        for (int g = 0; g < 3; ++g) { m[g] = DPM[((size_t)g * T + tok) * 8 + h]; l[g] = DPL[((size_t)g * T + tok) * 8 + h]; }
        const float M = fmaxf(m[0], fmaxf(m[1], m[2])); float wsum = 0.f, wg[3];
#pragma unroll
        for (int g = 0; g < 3; ++g) { wg[g] = __builtin_amdgcn_exp2f(m[g] - M) * l[g]; wsum += wg[g]; }
        const float inv = __builtin_amdgcn_rcpf(wsum); float o[8];
#pragma unroll
        for (int e = 0; e < 8; ++e) o[e] = 0.f;
#pragma unroll
        for (int g = 0; g < 3; ++g) { const u32x4 v = *(const u32x4*)(DPO + ((size_t)g * T + tok) * 512 + c8 * 8); const float wn = wg[g] * inv;
            o[0] += wn * bflo(v.x); o[1] += wn * bfhi(v.x); o[2] += wn * bflo(v.y); o[3] += wn * bfhi(v.y); o[4] += wn * bflo(v.z); o[5] += wn * bfhi(v.z); o[6] += wn * bflo(v.w); o[7] += wn * bfhi(v.w); }
        u32x2 r = {pk4_fp8(o[0], o[1], o[2], o[3]), pk4_fp8(o[4], o[5], o[6], o[7])}; *(u32x2*)((unsigned char*)MIX + (size_t)tok * 2048 + c8 * 8) = r; }
}

DI void rwkv_prep(const bf16* ZR, const float* mu, bf16* LIN, int wv) {
    const int gt = blockIdx.x * 512 + otid(wv), NT_ = gridDim.x * 512;
    for (int i = gt; i < T * 48; i += NT_) { const int tok = i / 48, c0 = (i % 48) * 8, s = tok % SEQ; float o[8];
        if (c0 < 352) { const u32x4 z = *(const u32x4*)(ZR + (size_t)tok * RW_IN + 4608 + c0); u32x4 zp = {0u, 0u, 0u, 0u}; if (s > 0) zp = *(const u32x4*)(ZR + (size_t)(tok - 1) * RW_IN + 4608 + c0);
            const unsigned* zz = (const unsigned*)&z; const unsigned* pp = (const unsigned*)&zp;
#pragma unroll
            for (int e = 0; e < 8; ++e) { const float zv = (e & 1) ? bfhi(zz[e >> 1]) : bflo(zz[e >> 1]), pv = (e & 1) ? bfhi(pp[e >> 1]) : bflo(pp[e >> 1]); const float xs = zv + (pv - zv) * mu[4608 + c0 + e];
                o[e] = c0 < 64 ? 1.f - 2.f * __builtin_amdgcn_rcpf(1.f + __expf(2.f * xs)) : (c0 < 128 ? xs : sigmoidf_(xs)); } }
        else {
#pragma unroll
            for (int e = 0; e < 8; ++e) o[e] = 0.f; }
        u32x4 r = {pk2(o[0], o[1]), pk2(o[2], o[3]), pk2(o[4], o[5]), pk2(o[6], o[7])}; *(u32x4*)(LIN + (size_t)tok * 384 + c0) = r; }
}
struct LoraOrder : pg8::StaticOrder { DI int koff(const Unit& u) const { return u.pn >= 12 ? 128 : 0; } };
struct EpiLora { static constexpr bool PERM = true;
    bf16 *WDEC, *AA, *GG; const float *w0, *a0;
    DI void operator()(const Acc& acc, const Unit& u, int wr, int wc, int fr, int fq) const {
        const int kind = u.pn / 6;
        EPI_ROWS_BEGIN
#pragma unroll
            for (int bj = 0; bj < 2; ++bj) { const int col = (u.pn % 6) * 256 + 128 * bj + 32 * wc + 8 * fq; f32x4 v0 = acc[ai][bj][m][0], v1 = acc[ai][bj][m][1];
                if (kind == 0) { const f32x4 b0 = *(const f32x4*)P32(w0, col), b1 = *(const f32x4*)P32(w0, col + 4);
#pragma unroll
                    for (int e = 0; e < 4; ++e) { v0[e] = -0.6065306597f * sigmoidf_(v0[e] + b0[e]); v1[e] = -0.6065306597f * sigmoidf_(v1[e] + b1[e]); }
                    *(u32x4*)P32(WDEC, row * RWW + col) = pack8(v0, v1); }
                else if (kind == 1) { const f32x4 b0 = *(const f32x4*)P32(a0, col), b1 = *(const f32x4*)P32(a0, col + 4);
#pragma unroll
                    for (int e = 0; e < 4; ++e) { v0[e] = sigmoidf_(v0[e] + b0[e]); v1[e] = sigmoidf_(v1[e] + b1[e]); }
                    *(u32x4*)P32(AA, row * RWW + col) = pack8(v0, v1); }
                else *(u32x4*)P32(GG, row * RWW + col) = pack8(v0, v1); }
        EPI_ROWS_END
    }
};
constexpr int CK_AT = 0, CK_RT = 2048, CK_BH = 4096, CK_KH = 6144, CK_MT = 8192, CK_NK = 8704, CK_PB = 9216, CK_PK = 9728, CK_G15 = 10240, CK_VT = 10496  , CK_VTS = 40, CK_BS = 13056  , CK_SLOT = 13120;
constexpr int CK_HALF = 128;
constexpr int CK_N1 = (int)((128 * MiB) / CK_SLOT) - 1;
DI unsigned char* ck_slot(unsigned char* ws, int job) { return job < CK_N1 ? ws + WS_X1 + (size_t)job * CK_SLOT : ws + WS_W_GU + (size_t)(job - CK_N1) * CK_SLOT; }
static_assert((size_t)(96 * CK_HALF - CK_N1 + 1) * CK_SLOT <= 64 * MiB, "chunk buffer");
constexpr int PJ = 4;
constexpr int PL_AT = 0, PL_BT = 2304, PL_KT = 4608, PL_RT = 6912, PL_BH = 9216, PL_KH = 11520  ,
              PL_NAB = 13824  , PL_MTS = 14848  , PL_LDT = 15616  , PL_C = 19968  ,
              PL_T = 24064  , PL_VT = 24320  , PL_END = 26880;
static_assert(PJ * PL_END <= RING_BYTES && PJ == 4, "prep LDS");
DI bf16x8 ldfrag(const LAS unsigned char* p) { return *(const LAS bf16x8*)p; }
DI u32x4 ld2x8(const LAS unsigned char* p0, const LAS unsigned char* p1) { const u32x2 lo = *(const LAS u32x2*)p0, hi = *(const LAS u32x2*)p1; return (u32x4){lo.x, lo.y, hi.x, hi.y}; }
DI void unpk8(const u32x4 v, float (&o)[8]) { o[0] = bflo(v.x); o[1] = bfhi(v.x); o[2] = bflo(v.y); o[3] = bfhi(v.y); o[4] = bflo(v.z); o[5] = bfhi(v.z); o[6] = bflo(v.w); o[7] = bfhi(v.w); }
DI void ldf8(const float* p, float (&o)[8]) { const f32x4 x = *(const f32x4*)p, y = *(const f32x4*)(p + 4); o[0] = x.x; o[1] = x.y; o[2] = x.z; o[3] = x.w; o[4] = y.x; o[5] = y.y; o[6] = y.z; o[7] = y.w; }
DI u32x4 pack8(const float (&x)[8]) { return (u32x4){pk2(x[0], x[1]), pk2(x[2], x[3]), pk2(x[4], x[5]), pk2(x[6], x[7])}; }
DI void rwkv_chunk_prep(const KArgs& a, LAS unsigned char* lds0, int half, int wv) {
    const int tid = otid(wv), lane = tid & 63, w = tid >> 6;
    const bf16* ZR = (const bf16*)(a.ws + A_ZR); const bf16* WDEC = (const bf16*)(a.ws + A_WDEC); const bf16* AA = (const bf16*)(a.ws + A_AA);
    const int js = tid >> 7, st = (tid >> 3) & 15, oc = tid & 7;
    LAS unsigned char* ldj = lds0 + js * PL_END;
    const float* mu = a.in[I_MU];
    bf16x8 lfrag;
#pragma unroll
    for (int j = 0; j < 8; ++j) lfrag[j] = ((lane & 31) >= 16 || 8 * (lane >> 5) + j <= (lane & 31)) ? (short)0x3F80 : (short)0;
    for (int it = blockIdx.x; it < 96 * CK_HALF / PJ; it += gridDim.x) {
        const int job0 = it * PJ, bh = job0 / CK_HALF, cl0 = job0 % CK_HALF, b = bh / 24, h = bh % 24, col = h * 64 + 8 * oc;
        const int s = (half * CK_HALF + cl0 + js) * 16 + st; const size_t tok = (size_t)b * SEQ + s;
        unsigned char* slot = ck_slot(a.ws, job0 + js);
        const bf16* z = ZR + tok * RW_IN + col;
        const u32x4 zr = *(const u32x4*)z, zk = *(const u32x4*)(z + 1536), zv = *(const u32x4*)(z + 3072);
        u32x4 pr = {0u, 0u, 0u, 0u}, pk_ = {0u, 0u, 0u, 0u}, pv = {0u, 0u, 0u, 0u};
        if (s > 0) { pr = *(const u32x4*)(z - RW_IN); pk_ = *(const u32x4*)(z - RW_IN + 1536); pv = *(const u32x4*)(z - RW_IN + 3072); }
        const u32x4 za = *(const u32x4*)(AA + tok * RWW + col), zw = *(const u32x4*)(WDEC + tok * RWW + col);
        float r[8], km[8], q[8], bb[8], ld[8];
        {   float cz[8], cp[8], m_[8], k_[8], v_[8], as_[8], c1[8], c2[8];
            unpk8(zr, cz); unpk8(pr, cp); ldf8(mu + col, m_);
#pragma unroll
            for (int e = 0; e < 8; ++e) r[e] = cz[e] + (cp[e] - cz[e]) * m_[e];
            unpk8(zk, cz); unpk8(pk_, cp); ldf8(mu + 1536 + col, m_);
#pragma unroll
            for (int e = 0; e < 8; ++e) k_[e] = cz[e] + (cp[e] - cz[e]) * m_[e];
            unpk8(zv, cz); unpk8(pv, cp); ldf8(mu + 3072 + col, m_);
#pragma unroll
            for (int e = 0; e < 8; ++e) v_[e] = cz[e] + (cp[e] - cz[e]) * m_[e];
            unpk8(za, as_); unpk8(zw, ld); ldf8(a.in[I_KK] + col, c1);
            float nn = 0.f;
#pragma unroll
            for (int e = 0; e < 8; ++e) { q[e] = k_[e] * c1[e]; nn += q[e] * q[e]; }
            nn = red8(nn);
            const float invn = fminf(__builtin_amdgcn_rsqf(nn), 1e12f);
            ldf8(a.in[I_KA] + col, c1); ldf8(a.in[I_RK] + col, c2);
            float bs = 0.f;
#pragma unroll
            for (int e = 0; e < 8; ++e) { q[e] *= invn; km[e] = k_[e] * (1.f + (as_[e] - 1.f) * c1[e]); bb[e] = q[e] * as_[e]; bs += r[e] * km[e] * c2[e]; }
            bs = red8(bs);
            if (oc == 0) *(float*)(slot + CK_BS + st * 4) = bs;
#pragma unroll
            for (int e = 0; e < 8; ++e) *(LAS float*)(ldj + PL_LDT + ((8 * oc + e) * 17 + st) * 4) = ld[e];
#pragma unroll
            for (int e = 0; e < 8; e += 2) { const unsigned pv2 = pk2(v_[e], v_[e + 1]);
                *(LAS bf16*)(ldj + PL_VT + (8 * oc + e) * CK_VTS + st * 2) = (bf16)(pv2 & 0xffffu); *(LAS bf16*)(ldj + PL_VT + (8 * oc + e + 1) * CK_VTS + st * 2) = (bf16)(pv2 >> 16); } }
        __syncthreads();
        {
            LAS unsigned char* lds = lds0 + (w >> 1) * PL_END; const int r_ = lane & 31, hh = lane >> 5, ch = 32 * (w & 1) + r_;
            float x[8];
#pragma unroll
            for (int j = 0; j < 8; ++j) x[j] = *(const LAS float*)(lds + PL_LDT + (ch * 17 + 8 * hh + j) * 4);
            const u32x4 ph = {pk2(x[0], x[1]), pk2(x[2], x[3]), pk2(x[4], x[5]), pk2(x[6], x[7])};
            const u32x4 pl = {pk2(x[0] - bflo(ph.x), x[1] - bfhi(ph.x)), pk2(x[2] - bflo(ph.y), x[3] - bfhi(ph.y)), pk2(x[4] - bflo(ph.z), x[5] - bfhi(ph.z)), pk2(x[6] - bflo(ph.w), x[7] - bfhi(ph.w))};
            f32x16 cs; for (int e = 0; e < 16; ++e) cs[e] = 0.f;
            cs = MFMA32(lfrag, __builtin_bit_cast(bf16x8, ph), cs); cs = MFMA32(lfrag, __builtin_bit_cast(bf16x8, pl), cs);
#pragma unroll
            for (int e = 0; e < 8; ++e) *(LAS float*)(lds + PL_C + (((e & 3) + 8 * (e >> 2) + 4 * hh) * 64 + ch) * 4) = cs[e];
            if (hh == 0) *(LAS float*)(lds + PL_T + ch * 4) = cs[8]; }
        __syncthreads();
        {
            float c[8], t[8];
            { const f32x4 ca = *(const LAS f32x4*)(ldj + PL_C + (st * 64 + 8 * oc) * 4), cb = *(const LAS f32x4*)(ldj + PL_C + (st * 64 + 8 * oc + 4) * 4), ta = *(const LAS f32x4*)(ldj + PL_T + 8 * oc * 4), tb = *(const LAS f32x4*)(ldj + PL_T + (8 * oc + 4) * 4);
              c[0] = ca.x; c[1] = ca.y; c[2] = ca.z; c[3] = ca.w; c[4] = cb.x; c[5] = cb.y; c[6] = cb.z; c[7] = cb.w; t[0] = ta.x; t[1] = ta.y; t[2] = ta.z; t[3] = ta.w; t[4] = tb.x; t[5] = tb.y; t[6] = tb.z; t[7] = tb.w; }
            float at[8], bt[8], kt[8], rt[8], bhv[8], khv[8];
#pragma unroll
            for (int e = 0; e < 8; ++e) { const float g = __expf(c[e]), gp = __expf(c[e] - ld[e]), gi = __expf(-c[e]), gr = __expf(t[e] - c[e]);
                at[e] = -q[e] * gp; bt[e] = bb[e] * gi; kt[e] = km[e] * gi; rt[e] = r[e] * g; bhv[e] = bb[e] * gr; khv[e] = km[e] * gr; }
            LAS unsigned char* row = ldj + st * 144 + oc * 16;
            *(LAS u32x4*)(row + PL_AT) = pack8(at); *(LAS u32x4*)(row + PL_BT) = pack8(bt); *(LAS u32x4*)(row + PL_KT) = pack8(kt); *(LAS u32x4*)(row + PL_RT) = pack8(rt);
            *(LAS u32x4*)(row + PL_BH) = pack8(bhv); *(LAS u32x4*)(row + PL_KH) = pack8(khv);
            if (st == 0) { *(f32x4*)(slot + CK_G15 + 8 * oc * 4) = (f32x4){__expf(t[0]), __expf(t[1]), __expf(t[2]), __expf(t[3])}; *(f32x4*)(slot + CK_G15 + (8 * oc + 4) * 4) = (f32x4){__expf(t[4]), __expf(t[5]), __expf(t[6]), __expf(t[7])}; } }
        __syncthreads();
        if (w < PJ) {
            LAS unsigned char* lds = lds0 + w * PL_END; unsigned char* slot = ck_slot(a.ws, job0 + w); const int r = lane & 31, hh = lane >> 5, r16 = r & 15;
            f32x16 d; for (int e = 0; e < 16; ++e) d[e] = 0.f;
#pragma unroll
            for (int ks = 0; ks < 4; ++ks) d = MFMA32(ldfrag(lds + (r < 16 ? PL_BT : PL_KT) + r16 * 144 + ks * 32 + hh * 16), ldfrag(lds + (r < 16 ? PL_AT : PL_RT) + r16 * 144 + ks * 32 + hh * 16), d);
            float lo8[8], hi8[8];
#pragma unroll
            for (int e = 0; e < 8; ++e) { const int sr = (e & 3) + 8 * (e >> 2) + 4 * hh; const bool keep = r < 16 ? sr < r16 : sr <= r16; lo8[e] = keep ? d[e] : 0.f; hi8[e] = keep ? d[8 + e] : 0.f; }
            const u32x4 plo = {pk2(lo8[0], lo8[1]), pk2(lo8[2], lo8[3]), pk2(lo8[4], lo8[5]), pk2(lo8[6], lo8[7])}, phi = {pk2(hi8[0], hi8[1]), pk2(hi8[2], hi8[3]), pk2(hi8[4], hi8[5]), pk2(hi8[6], hi8[7])};
            if (r < 16) {
#pragma unroll
                for (int e = 0; e < 8; ++e) *(LAS float*)(lds + PL_NAB + (((e & 3) + 8 * (e >> 2) + 4 * hh) * 16 + r16) * 4) = lo8[e];
                *(u32x4*)(slot + CK_NK + (r16 + 16 * hh) * 16) = phi; }
            else { *(u32x4*)(slot + CK_PB + (r16 + 16 * hh) * 16) = plo; *(u32x4*)(slot + CK_PK + (r16 + 16 * hh) * 16) = phi; }
            asm volatile("s_waitcnt lgkmcnt(0)" ::: "memory");
            if (lane < 16) { float mr[16]; int ln = lane; asm volatile("" : "+v"(ln));
#pragma unroll
                for (int t = 0; t < 16; ++t) { float acc = (ln == t) ? 1.f : 0.f;
#pragma unroll
                    for (int u = 0; u < t; ++u) acc += mr[u] * *(const LAS float*)(lds + PL_NAB + (u * 16 + t) * 4);
                    mr[t] = acc; *(LAS bf16*)(lds + PL_MTS + t * 48 + lane * 2) = f2bf(acc); } }
            asm volatile("s_waitcnt lgkmcnt(0)" ::: "memory");
            if (r < 16) *(u32x4*)(slot + CK_MT + (r + 16 * hh) * 16) = ld2x8(lds + PL_MTS + r * 48 + 8 * hh, lds + PL_MTS + r * 48 + 16 + 8 * hh);
        } else {
            const int e2 = tid - 256;
#pragma unroll
            for (int q4 = 0; q4 < PJ; ++q4) { const LAS unsigned char* lds = lds0 + q4 * PL_END; unsigned char* slot = ck_slot(a.ws, job0 + q4);
                { const int arr = e2 >> 7, i7 = e2 & 127, ks = i7 >> 5, t = i7 & 15, hh = (i7 >> 4) & 1;
                  const LAS unsigned char* p = lds + (arr ? PL_RT : PL_AT) + t * 144 + (16 * ks + 4 * hh) * 2;
                  *(u32x4*)(slot + (arr ? CK_RT : CK_AT) + (ks * 32 + t + 16 * hh) * 16) = ld2x8(p, p + 16); }
                { const int arr = e2 >> 7, J = (e2 >> 6) & 1;
                  const LAS unsigned char* p = lds + (arr ? PL_KH : PL_BH) + (4 * (lane >> 5) + ((lane >> 2) & 3)) * 144 + (32 * J + 16 * ((lane >> 4) & 1)) * 2 + 8 * (lane & 3);
                  const s16x4 lo = __builtin_amdgcn_ds_read_tr16_b64_v4i16((LAS s16x4*)p), hi = __builtin_amdgcn_ds_read_tr16_b64_v4i16((LAS s16x4*)(p + 8 * 144));
                  *(bf16x8*)(slot + (arr ? CK_KH : CK_BH) + (J * 64 + lane) * 16) = __builtin_shufflevector(lo, hi, 0, 1, 2, 3, 4, 5, 6, 7); }
                if (e2 < 160) *(u32x4*)(slot + CK_VT + e2 * 16) = *(const LAS u32x4*)(lds + PL_VT + e2 * 16); }
        }
    }
    __syncthreads();
}
constexpr int RC_NS = 8, RC_SLOT = 15360, RC_GG = 13312, RC_AHEAD = 6, RC_Y = RC_NS * RC_SLOT;
static_assert(RC_Y + 8192 <= RING_BYTES && CK_SLOT <= RC_GG, "rwkv ring");
template <int PM = 0> DI void rwkv_chunk_rec(const KArgs& a, LAS unsigned char* lds, int unit, int half, int wv) {
    const int tid = otid(wv), lane = tid & 63, w = __builtin_amdgcn_readfirstlane(tid >> 6), r = lane & 31, hh = lane >> 5;
    const int b = unit / 24, h = unit % 24;
    float* GST = (float*)(a.ws + A_GST) + (size_t)unit * 4096;
    const unsigned char* GGb = a.ws + A_GG; bf16* MIX = (bf16*)(a.ws + WS_H);
#define RC_DMA(srcp, dstp) __builtin_amdgcn_global_load_lds((const unsigned*)(srcp), (LAS unsigned*)(dstp), 16, 0, 0)
#define RC_ISSUE(cc) do { if ((PM & 1) == 0 && (w == 4 || w == 5)) { const unsigned char* src = ck_slot(a.ws, unit * CK_HALF + (cc)) + lane * 16; LAS unsigned char* dst = lds + ((cc) % RC_NS) * RC_SLOT; \
        if (w == 4) { _Pragma("unroll") for (int i_ = 0; i_ < 8; ++i_) RC_DMA(src + i_ * 1024, dst + i_ * 1024); } \
        else { _Pragma("unroll") for (int i_ = 8; i_ < 13; ++i_) RC_DMA(src + i_ * 1024, dst + i_ * 1024); \
            const unsigned char* gsrc = GGb + ((size_t)b * SEQ + (half * CK_HALF + (cc)) * 16 + (lane >> 3)) * (RWW * 2) + h * 128 + (lane & 7) * 16; \
            RC_DMA(gsrc, dst + RC_GG); RC_DMA(gsrc + 8 * RWW * 2, dst + RC_GG + 1024); } } } while (0)
#define RC_BAR() do { asm volatile("s_waitcnt lgkmcnt(0)" ::: "memory"); __builtin_amdgcn_s_barrier(); asm volatile("" ::: "memory"); } while (0)
    const bool epi = (w & 2) != 0; const int et = 4 * ((w & 1) + 2 * (w >> 2)) + (lane >> 4), eiq = lane & 15, ecol = h * 64 + 4 * eiq;
    const f32x4 elg = *(const f32x4*)(a.in[I_LNXG] + ecol), elb = *(const f32x4*)(a.in[I_LNXB] + ecol);
#define RC_EPI(sp, Yp, tokv) do { const f32x4 y = *(const LAS f32x4*)((Yp) + et * 64 + 4 * eiq); const u32x2 gq = *(const LAS u32x2*)((sp) + RC_GG + et * 128 + eiq * 8); \
        const float bsv = *(const LAS float*)((sp) + CK_BS + et * 4); const LAS unsigned char* vq = (sp) + CK_VT + 4 * eiq * CK_VTS + et * 2; \
        const f32x4 v4 = {bflo(*(const LAS unsigned short*)vq), bflo(*(const LAS unsigned short*)(vq + CK_VTS)), bflo(*(const LAS unsigned short*)(vq + 2 * CK_VTS)), bflo(*(const LAS unsigned short*)(vq + 3 * CK_VTS))}; \
        const float mean = red16((y.x + y.y) + (y.z + y.w)) * (1.f / 64.f); const f32x4 d = y - mean; \
        const float rstd = __builtin_amdgcn_rsqf(red16((d.x * d.x + d.y * d.y) + (d.z * d.z + d.w * d.w)) * (1.f / 64.f) + 64e-5f); \
        const f32x4 gg4 = {bflo(gq.x), bfhi(gq.x), bflo(gq.y), bfhi(gq.y)}, o = (d * rstd * elg + elb + v4 * bsv) * gg4; \
        if (PM == 0 || o.x == 1.2345f) *(unsigned*)((unsigned char*)MIX + (size_t)(tokv) * 2048 + 512 + ecol) = pk4_fp8(o.x, o.y, o.z, o.w); } while (0)
    f32x16 G0, G1;
#pragma unroll
    for (int e = 0; e < 16; ++e) { G0[e] = 0.f; G1[e] = 0.f; }
    if (half == 1 && w < 2) {
#pragma unroll
        for (int e = 0; e < 16; ++e) { G0[e] = GST[(w * 2 + 0) * 1024 + e * 64 + lane]; G1[e] = GST[(w * 2 + 1) * 1024 + e * 64 + lane]; } }
    __syncthreads();
#pragma unroll
    for (int cc = 0; cc < RC_AHEAD; ++cc) RC_ISSUE(cc);
    asm volatile("s_waitcnt vmcnt(0)" ::: "memory");
    RC_BAR();
    bf16x8 pAR[4], pNP, pVT;
#define RC_PRE(slotp) do { const LAS unsigned char* sp_ = (slotp); _Pragma("unroll") for (int ks = 0; ks < 4; ++ks) pAR[ks] = ldfrag(sp_ + ((r >> 4) ? CK_RT : CK_AT) + (ks * 32 + (r & 15) + 16 * hh) * 16); \
        pNP = ldfrag(sp_ + ((r >> 4) ? CK_PK : CK_NK) + ((r & 15) + 16 * hh) * 16); \
        { const LAS unsigned char* vq_ = sp_ + CK_VT + (32 * w + r) * CK_VTS + 8 * hh; const s16x4 vlo_ = *(const LAS s16x4*)vq_, vhi_ = *(const LAS s16x4*)(vq_ + 16); pVT = __builtin_shufflevector(vlo_, vhi_, 0, 1, 2, 3, 4, 5, 6, 7); } } while (0)
    if (w < 2) RC_PRE(lds);
    for (int c = 0; c < CK_HALF; ++c) {
        if (c + RC_AHEAD < CK_HALF) RC_ISSUE(c + RC_AHEAD);
        const LAS unsigned char* sb = lds + (c % RC_NS) * RC_SLOT;
        if (w < 2) {
            const int r16 = r & 15, up = r >> 4;
            bf16x8 fAR[4], fBH0, fBH1, fKH0, fKH1, fM, fNP, fPB; f32x4 gs0[4], gs1[4];
#pragma unroll
            for (int ks = 0; ks < 4; ++ks) fAR[ks] = pAR[ks];
            fNP = pNP; const bf16x8 vtf = pVT;
            __builtin_amdgcn_sched_barrier(0);
            fM = ldfrag(sb + CK_MT + (r16 + 16 * hh) * 16); fPB = ldfrag(sb + CK_PB + (r16 + 16 * hh) * 16);
            fBH0 = ldfrag(sb + CK_BH + lane * 16); fBH1 = ldfrag(sb + CK_BH + (64 + lane) * 16); fKH0 = ldfrag(sb + CK_KH + lane * 16); fKH1 = ldfrag(sb + CK_KH + (64 + lane) * 16);
#pragma unroll
            for (int g4 = 0; g4 < 4; ++g4) { gs0[g4] = *(const LAS f32x4*)(sb + CK_G15 + (8 * g4 + 4 * hh) * 4); gs1[g4] = *(const LAS f32x4*)(sb + CK_G15 + (32 + 8 * g4 + 4 * hh) * 4); }
            __builtin_amdgcn_sched_barrier(0);
            bf16x8 gf[4];
#pragma unroll
            for (int s2 = 0; s2 < 2; ++s2) { u32x4 p0 = {pk2(G0[8 * s2], G0[8 * s2 + 1]), pk2(G0[8 * s2 + 2], G0[8 * s2 + 3]), pk2(G0[8 * s2 + 4], G0[8 * s2 + 5]), pk2(G0[8 * s2 + 6], G0[8 * s2 + 7])};
                u32x4 p1 = {pk2(G1[8 * s2], G1[8 * s2 + 1]), pk2(G1[8 * s2 + 2], G1[8 * s2 + 3]), pk2(G1[8 * s2 + 4], G1[8 * s2 + 5]), pk2(G1[8 * s2 + 6], G1[8 * s2 + 7])};
                gf[s2] = __builtin_bit_cast(bf16x8, p0); gf[2 + s2] = __builtin_bit_cast(bf16x8, p1); }
            f32x16 XY;
#pragma unroll
            for (int e = 0; e < 16; ++e) XY[e] = 0.f;
#pragma unroll
            for (int ks = 0; ks < 4; ++ks) XY = MFMA32(fAR[ks], gf[ks], XY);
            XY = MFMA32(fNP, vtf, XY);
            { u32x4 px = {pk2(XY[0], XY[1]), pk2(XY[2], XY[3]), pk2(XY[4], XY[5]), pk2(XY[6], XY[7])}; const bf16x8 xf = __builtin_bit_cast(bf16x8, px);
              f32x16 U; for (int e = 0; e < 16; ++e) U[e] = 0.f;
              U = MFMA32(fM, xf, U);
              u32x4 pu = {pk2(U[0], U[1]), pk2(U[2], U[3]), pk2(U[4], U[5]), pk2(U[6], U[7])}; const bf16x8 uf = __builtin_bit_cast(bf16x8, pu);
              XY = MFMA32(fPB, uf, XY);
#pragma unroll
              for (int e = 0; e < 16; ++e) { G0[e] *= gs0[e >> 2][e & 3]; G1[e] *= gs1[e >> 2][e & 3]; }
              G0 = MFMA32(fBH0, uf, G0); G1 = MFMA32(fBH1, uf, G1); G0 = MFMA32(fKH0, vtf, G0); G1 = MFMA32(fKH1, vtf, G1); }
            __builtin_amdgcn_sched_barrier(0);
            if (c + 1 < CK_HALF) RC_PRE(lds + ((c + 1) % RC_NS) * RC_SLOT);
            LAS float* Y = (LAS float*)(lds + RC_Y + (c & 1) * 4096);
#pragma unroll
            for (int e = 0; e < 8; ++e) Y[((e & 3) + 8 * (e >> 2) + 4 * hh) * 64 + 32 * w + r] = XY[8 + e];
        } else if (epi) {
            if (c > 0) RC_EPI(lds + ((c - 1) % RC_NS) * RC_SLOT, (const LAS float*)(lds + RC_Y + ((c - 1) & 1) * 4096), (size_t)b * SEQ + (half * CK_HALF + c - 1) * 16 + et);
        } else {
            if (c + RC_AHEAD >= CK_HALF) asm volatile("s_waitcnt vmcnt(0)" ::: "memory"); else if (w == 4) asm volatile("s_waitcnt vmcnt(32)" ::: "memory"); else asm volatile("s_waitcnt vmcnt(28)" ::: "memory");
        }
        RC_BAR();
    }
    if (epi) RC_EPI(lds + ((CK_HALF - 1) % RC_NS) * RC_SLOT, (const LAS float*)(lds + RC_Y + ((CK_HALF - 1) & 1) * 4096), (size_t)b * SEQ + (half * CK_HALF + CK_HALF - 1) * 16 + et);
    else if (w < 2 && half == 0 && (PM == 0 || G0[0] == 1.2345f)) {
#pragma unroll
        for (int e = 0; e < 16; ++e) { GST[(w * 2 + 0) * 1024 + e * 64 + lane] = G0[e]; GST[(w * 2 + 1) * 1024 + e * 64 + lane] = G1[e]; } }
    asm volatile("s_waitcnt vmcnt(0)" ::: "memory");
    __syncthreads();
#undef RC_PRE
#undef RC_EPI
#undef RC_DMA
#undef RC_ISSUE
#undef RC_BAR
}

constexpr int N_PHASES = 25;
__global__ void __launch_bounds__(512, 2) fwd(KArgs a) {
    extern __shared__ __attribute__((aligned(16))) unsigned char lds_[];
    LAS unsigned char* lds = (LAS unsigned char*)lds_;
    const int wv = __builtin_amdgcn_readfirstlane((int)threadIdx.x >> 6), G = gridDim.x, bid = blockIdx.x;
    volatile LAS unsigned* MISC = (volatile LAS unsigned*)(lds + LDS_MISC);
    if (wv == 0) MISC[lane_id()] = 0u;
    __syncthreads();
    unsigned char* ws0 = a.ws;
#if N_LAUNCH_MODE == 0
    XcdBarrier bar = xcd_barrier_post((unsigned*)(ws0 + CTL_BAR), MISC + 8, wv);
#ifdef DBG_TIME_K1
#define SEAM(k) do { if (IN(k) && IN((k) + 1)) xcd_barrier(bar); if (bid == 0 && wv == 0 && lane_id() == 0) ((unsigned long long*)(ws0 + CTL_CHK))[1 + (k)] = __builtin_amdgcn_s_memrealtime(); } while (0)
#else
#define SEAM(k) do { if (IN(k) && IN((k) + 1)) xcd_barrier(bar); } while (0)
#endif
#else
#define SEAM(k) do { } while (0)
#endif
    const int lo = a.ph_lo, hi = a.ph_hi;
#ifdef DBG_TIME_K1
    if (bid == 0 && wv == 0 && lane_id() == 0) ((unsigned long long*)(ws0 + CTL_CHK))[0] = __builtin_amdgcn_s_memrealtime();
#endif
#ifndef PH_MASK
#define PH_MASK 0xFFFFFFFFu
#endif
#define IN(k) (((PH_MASK >> (k)) & 1u) && lo <= (k) && (k) < hi)
#ifndef REP_REC
#define REP_REC 0
#endif
#ifndef REP_DIL
#define REP_DIL 0
#endif
#ifndef REPEAT_MASK
#define REPEAT_MASK 0u
#endif
#define PH(k) for (int rp_ = 0; rp_ < (IN(k) ? 1 + (int)((REPEAT_MASK >> (k)) & 1u) : 0); ++rp_)
#define MOD ((float*)(ws + CTL_MOD))
#define Hb ((bf16*)(ws + WS_H))
#define X1 ((bf16*)(ws + WS_X1))
#define XPRE ((bf16*)(ws + A_XPRE))
    pg8::StaticOrder SO;

    PH(0) { unsigned char* ws = wsl(a.ws); p0_prologue(a, lds, wv); } SEAM(0);
    PH(1) { unsigned char* ws = wsl(a.ws); modulate_rows(a.in[I_X], (const unsigned long long*)(ws + CTL_MODI), MOD, Hb, wv); } SEAM(1);
    PH(2) { unsigned char* ws = wsl(a.ws); pg8::Gemm g{Hb, (const bf16*)(ws + WS_W_IN0), 2048, 2048, 2048}; SO.init(T, 2048, G, bid);
        EpiIn0 E{(bf16*)(ws + A_QC), (bf16*)(ws + A_KVC), (bf16*)(ws + A_KR), (bf16*)(ws + A_XH), (float*)(ws + CTL_SSQ)};
        pg8::gemm_phase<EpiIn0, pg8::StaticOrder, false, true>(lds, g, SO, E, wv); } SEAM(2);
    PH(3) { unsigned char* ws = wsl(a.ws);
        krope_pass((const bf16*)(ws + A_KR), (const float*)(ws + WS_ROPE), (bf16*)(ws + A_KF), wv);
        { pg8::Gemm g{(const bf16*)(ws + A_QC), (const bf16*)(ws + WS_W_UQ), 512, 512, 512}; SO.init(T, 1536, G, bid);
          EpiQ E{(bf16*)(ws + A_Q), (const float*)(ws + CTL_SSQ), (const float*)(ws + WS_ROPE)}; pg8::gemm_phase<EpiQ, pg8::StaticOrder, false>(lds, g, SO, E, wv); }
        { pg8::Gemm g{(const bf16*)(ws + A_KVC), (const bf16*)(ws + WS_W_UKV), 256, 256, 256}; SO.init(T, 2048, G, bid);
          EpiKV E{(bf16*)(ws + A_KF), (bf16*)(ws + A_V), (const float*)(ws + CTL_SSQ)}; pg8::gemm_phase<EpiKV, pg8::StaticOrder, false>(lds, g, SO, E, wv); }
        { pg8::Gemm g{(const bf16*)(ws + A_XH), (const bf16*)(ws + WS_S5BE), 384, 256, 256}; S5Order S{G, bid}; EpiS5E E{(float*)(ws + A_ES)}; pg8::gemm_phase<EpiS5E, S5Order, false>(lds, g, S, E, wv); }
    } SEAM(3);
    PH(4) { unsigned char* ws = wsl(a.ws);
        s5_carry((const float*)(ws + A_ES), (const float*)(ws + WS_S5L), (bf16*)(ws + A_XH), lds, wv);
        for (int u = bid; u < 256; u += G) mla_attn_unit(lds, (const bf16*)(ws + A_Q), (const bf16*)(ws + A_KF), (const bf16*)(ws + A_V), Hb, u, wv);
    } SEAM(4);
    PH(5) { unsigned char* ws = wsl(a.ws); pg8::Gemm g{(const bf16*)(ws + A_XH), (const bf16*)(ws + WS_S5BY), 384, 384, 384}; S5Order S{G, bid};
        EpiS5Y E{(bf16*)(ws + A_YS5), (const bf16*)(ws + A_XH), a.in[I_S5D]}; pg8::gemm_phase<EpiS5Y, S5Order, false>(lds, g, S, E, wv); } SEAM(5);
    PH(6) { unsigned char* ws = wsl(a.ws); pg8::Gemm g{(const bf16*)(ws + A_YS5), (const bf16*)(ws + WS_W_GLU), 1024, 1024, 1024}; SO.init(T, 1024, G, bid);
        EpiGlu E{Hb, (const bf16*)(ws + A_YS5)}; pg8::gemm_phase<EpiGlu, pg8::StaticOrder, false>(lds, g, SO, E, wv); } SEAM(6);
    PH(7) { unsigned char* ws = wsl(a.ws); pg8::Gemm g{Hb, (const bf16*)(ws + WS_W_OUT0), 2048, 2048, 2048}; SO.init(T, 2048, G, bid);
        EpiRes<false> E{XPRE, a.in[I_X], MOD + 2 * 2048}; pg8::gemm_phase<EpiRes<false>, pg8::StaticOrder, false, true>(lds, g, SO, E, wv); } SEAM(7);
#define MOE_PHASES(layer, pb) \
        PH(pb) { unsigned char* ws = wsl(a.ws); ln_router_phase(a, lds, layer, XPRE, X1, Hb, wv); } SEAM(pb); \
        PH(pb + 1) { unsigned char* ws = wsl(a.ws); moe_table(a, lds, layer, wv); pg8::Gemm g{Hb, (const bf16*)(ws + WS_W_GU8), 2048, 2048, 2048}; \
            MoeOrder<4> S{G, bid, layer, (const LAS int*)(lds + LDS_TAB), (const int*)(ws + A_TOKL)}; EpiGateUp E{ws + A_ACT}; pg8::gemm_phase<EpiGateUp, MoeOrder<4>, true, true>(lds, g, S, E, wv); } SEAM(pb + 1); \
        PH(pb + 2) { unsigned char* ws = wsl(a.ws); moe_table(a, lds, layer, wv); pg8::Gemm g{(const bf16*)(ws + A_ACT), (const bf16*)(ws + WS_W_DN), 512, 512, 512}; \
            MoeOrder<8> S{G, bid, layer, (const LAS int*)(lds + LDS_TAB), (const int*)(ws + A_TOKL)}; EpiDown E{(bf16*)(ws + A_YS)}; pg8::gemm_phase<EpiDown, MoeOrder<8>, false, true>(lds, g, S, E, wv); } SEAM(pb + 2); \
        PH(pb + 3) { unsigned char* ws = wsl(a.ws); ln_ffn_phase(a, layer, X1, a.out, layer == 0 ? Hb : nullptr, wv); } SEAM(pb + 3);
    MOE_PHASES(0, 8)
    PH(12) { unsigned char* ws = wsl(a.ws); pg8::Gemm g{Hb, (const bf16*)(ws + WS_W_IN1), 2048, 2048, 2048}; SO.init(T, 9728, G, bid);
        EpiIn1 E{(bf16*)(ws + A_ZD), (bf16*)(ws + A_ZR)}; pg8::gemm_phase<EpiIn1, pg8::StaticOrder, false, true>(lds, g, SO, E, wv); } SEAM(12);
    PH(13) { unsigned char* ws = wsl(a.ws); rwkv_prep((const bf16*)(ws + A_ZR), a.in[I_MU], (bf16*)(ws + A_LIN), wv); } SEAM(13);
    PH(14) { unsigned char* ws = wsl(a.ws);
        pg8::Gemm g{(const bf16*)(ws + A_LIN), (const bf16*)(ws + WS_W_LORA), 384, 384, 256}; LoraOrder LO; LO.init(T, 4608, G, bid);
        EpiLora E{(bf16*)(ws + A_WDEC), (bf16*)(ws + A_AA), (bf16*)(ws + A_GG), a.in[I_W0], a.in[I_A0]}; pg8::gemm_phase<EpiLora, LoraOrder, false>(lds, g, LO, E, wv);
} SEAM(14);
    PH(15) { rwkv_chunk_prep(a, lds, 0, wv); } SEAM(15);
    PH(16) { unsigned char* ws = wsl(a.ws); if (bid < 96 || G <= 96) { for (int u = bid; u < 96; u += G) { rwkv_chunk_rec(a, lds, u, 0, wv); if (REP_REC) rwkv_chunk_rec<REP_REC>(a, lds, u, 0, wv); } }
        if (G <= 96 || bid >= 96) { const int nb_ = G <= 96 ? G : G - 96, b0_ = G <= 96 ? bid : bid - 96;
            DilPre P; if (b0_ < 768) dil_issue((const bf16*)(ws + A_ZD), (const float*)(ws + WS_BIAS), b0_, wv, P);
            for (int u = b0_; u < 768; u += nb_) dil_attn_unit(lds, (const bf16*)(ws + A_ZD), (const float*)(ws + WS_BIAS), (bf16*)(ws + A_DPO), (float*)(ws + A_DPM), (float*)(ws + A_DPL), u, u + nb_ < 768 ? u + nb_ : -1, P, wv); } } SEAM(16);
    PH(17) { rwkv_chunk_prep(a, lds, 1, wv); } SEAM(17);
    PH(18) { unsigned char* ws = wsl(a.ws); if (bid < 96 || G <= 96) { for (int u = bid; u < 96; u += G) { rwkv_chunk_rec(a, lds, u, 1, wv); if (REP_REC) rwkv_chunk_rec<REP_REC>(a, lds, u, 1, wv); } }
        if (G <= 96 || bid >= 96) { const int nb_ = G <= 96 ? G : G - 96, b0_ = G <= 96 ? bid : bid - 96;
            DilPre P; if (768 + b0_ < 1536) dil_issue((const bf16*)(ws + A_ZD), (const float*)(ws + WS_BIAS), 768 + b0_, wv, P);
            for (int u = 768 + b0_; u < 1536; u += nb_) dil_attn_unit(lds, (const bf16*)(ws + A_ZD), (const float*)(ws + WS_BIAS), (bf16*)(ws + A_DPO), (float*)(ws + A_DPM), (float*)(ws + A_DPL), u, u + nb_ < 1536 ? u + nb_ : -1, P, wv); } } SEAM(18);
    PH(19) { unsigned char* ws = wsl(a.ws); dil_merge((const bf16*)(ws + A_DPO), (const float*)(ws + A_DPM), (const float*)(ws + A_DPL), Hb, wv); } SEAM(19);
    PH(20) { unsigned char* ws = wsl(a.ws); pg8::Gemm g{Hb, (const bf16*)(ws + WS_W_OUT1), 2048, 2048, 2048}; SO.init(T, 2048, G, bid);
        EpiRes<true> E{XPRE, a.out, MOD + 4 * 12288 + 2 * 2048}; pg8::gemm_phase<EpiRes<true>, pg8::StaticOrder, false, true>(lds, g, SO, E, wv); } SEAM(20);
    MOE_PHASES(1, 21)
#undef MOE_PHASES
#ifdef DBG_TIME_K1
    {
        xcd_barrier(bar);
        const unsigned long long* ts = (const unsigned long long*)(ws0 + CTL_CHK);
        const unsigned long long t0 = ts[0], te = __builtin_amdgcn_s_memrealtime();
        const float tot = (float)(te - t0), f1 = (float)(ts[1 + DBG_TIME_K1] - t0) / tot, f2 = (float)(ts[1 + DBG_TIME_K2] - t0) / tot;
        const float c1 = sqrtf(100.f * f1);
        for (size_t i = (size_t)bid * 512 + wv * 64 + lane_id(); i < (size_t)T * D; i += (size_t)G * 512) a.out[i] = c1;
        xcd_barrier(bar);
        if (bid == 0 && wv == 0 && lane_id() == 0) a.out[0] = 100.f * f2;
    }
#endif
#undef IN
#undef SEAM
#undef MOD
#undef Hb
#undef X1
#undef XPRE
}


#ifdef DBG_DUMP_OFF
__global__ void dbg_dump(const unsigned char* ws, float* out) {
    const size_t n = (size_t)T * D;
    for (size_t i = (size_t)blockIdx.x * 256 + threadIdx.x; i < n; i += (size_t)gridDim.x * 256) {
#if defined(DBG_DUMP_RT)
        { const int m = (int)(i >> 11), c = (int)(i & 2047); const int* RTE = (const int*)(ws + A_RT); const float* RTW = (const float*)(RTE + 4 * T); out[i] = c < 2 ? (float)RTE[2 * m + c] : (c < 4 ? RTW[2 * m + c - 2] : 0.f); }
#elif DBG_DUMP_F32
        out[i] = ((const float*)(ws + DBG_DUMP_OFF))[i];
#else
        out[i] = bf2f(((const bf16*)(ws + DBG_DUMP_OFF))[i]);
#endif
    }
}
#endif
extern "C" void kernel_launch(void* const* d_in, const int* in_sizes, int n_in, void* d_out, int out_size, void* d_ws, size_t ws_size, hipStream_t stream) {
    static int grid = 0;
    if (grid == 0) {
        if (n_in != 41 || out_size != T * D || ws_size < WS_END) { fprintf(stderr, "kernel_launch: unexpected shapes: n_in %d out %d ws %zu (need %zu)\n", n_in, out_size, ws_size, (size_t)WS_END); grid = -1; return; }
        int dev = 0, cus = 0, per_cu = 0;
        if (hipGetDevice(&dev) != hipSuccess || hipDeviceGetAttribute(&cus, hipDeviceAttributeMultiprocessorCount, dev) != hipSuccess) { grid = -1; return; }
        if (hipFuncSetAttribute((const void*)fwd, hipFuncAttributeMaxDynamicSharedMemorySize, LDS_BYTES) != hipSuccess) { fprintf(stderr, "kernel_launch: hipFuncSetAttribute failed\n"); grid = -1; return; }
        if (hipOccupancyMaxActiveBlocksPerMultiprocessor(&per_cu, (const void*)fwd, 512, LDS_BYTES) != hipSuccess || per_cu < 1) fprintf(stderr, "kernel_launch: occupancy query says %d blocks/CU\n", per_cu);
        (void)hipGetLastError();
        grid = cus;
    }
    if (grid < 0) return;
    (void)hipMemsetAsync(d_ws, 0, CTL_ZERO_BYTES, stream);
#ifdef DBG_ZERO_WS
    (void)hipMemsetAsync((char*)d_ws + CTL_ZERO_BYTES, 0, WS_END - CTL_ZERO_BYTES, stream);
#endif
    KArgs a{};
    for (int i = 0; i < 41; ++i) a.in[i] = (const float*)d_in[i];
    a.out = (float*)d_out; a.ws = (unsigned char*)d_ws;
#if N_LAUNCH_MODE == 0
    a.ph_lo = 0; a.ph_hi = N_PHASES;
    hipLaunchKernelGGL(fwd, dim3(grid), dim3(512), LDS_BYTES, stream, a);
#else
#ifdef DBG_DUMP_AFTER
    for (int p = 0; p <= DBG_DUMP_AFTER; ++p) { a.ph_lo = p; a.ph_hi = p + 1; hipLaunchKernelGGL(fwd, dim3(grid), dim3(512), LDS_BYTES, stream, a); }
#ifdef DBG_DUMP_OFF
    hipLaunchKernelGGL(dbg_dump, dim3(2048), dim3(256), 0, stream, (const unsigned char*)d_ws, (float*)d_out);
#endif
#else
    for (int p = 0; p < N_PHASES; ++p) { a.ph_lo = p; a.ph_hi = p + 1; hipLaunchKernelGGL(fwd, dim3(grid), dim3(512), LDS_BYTES, stream, a); }
#endif
#endif
}
```

```cpp
#include <hip/hip_runtime.h>
#include <cstdio>
#include <cstdint>

#ifndef N_LAUNCH_MODE
#define N_LAUNCH_MODE 0
#endif
#ifndef CHK
#define CHK 0
#endif

#define GAS __attribute__((address_space(1)))
#define LAS __attribute__((address_space(3)))
typedef unsigned short bf16;
typedef short bf16x8 __attribute__((ext_vector_type(8)));
typedef short s16x4 __attribute__((ext_vector_type(4)));
typedef float f32x4 __attribute__((ext_vector_type(4)));
typedef float f32x16 __attribute__((ext_vector_type(16)));
typedef float f32x2 __attribute__((ext_vector_type(2)));
typedef unsigned u32x4 __attribute__((ext_vector_type(4)));
typedef unsigned u32x2 __attribute__((ext_vector_type(2)));
#define DI __device__ __forceinline__

constexpr int D = 2048, NB = 4, SEQ = 4096, T = NB * SEQ;
constexpr float LN_EPS = 1e-5f, RMS_EPS = 1e-6f;
constexpr float DN_ALPHA = 1.41421356237f;
constexpr int EVEN_IN = 1856, ODD_IN = 9568, DIL_IN = 4608, RW_IN = 4960, RWW = 1536;
constexpr int NEXP = 16, DEXP = 512;

typedef __bf16 bf16x2_t __attribute__((ext_vector_type(2)));
DI unsigned pk2(float lo, float hi) { f32x2 v = {lo, hi}; bf16x2_t r = __builtin_convertvector(v, bf16x2_t); return __builtin_bit_cast(unsigned, r); }
DI float bf2f(bf16 b) { return __uint_as_float(((unsigned)b) << 16); }
DI float bflo(unsigned u) { return __uint_as_float(u << 16); }
DI float bfhi(unsigned u) { return __uint_as_float(u & 0xffff0000u); }
DI bf16 f2bf(float f) { unsigned u = __float_as_uint(f); u += 0x7fffu + ((u >> 16) & 1u); return (bf16)(u >> 16); }
DI float wave_sum(float v) {
#pragma unroll
    for (int o = 1; o < 64; o <<= 1) v += __shfl_xor(v, o);
    return v;
}
DI unsigned char* wsl(unsigned char* p) { asm volatile("" : "+s"(p)); return p; }
DI int lane_id() { return (int)__builtin_amdgcn_mbcnt_hi(~0u, __builtin_amdgcn_mbcnt_lo(~0u, 0u)); }
DI int otid(int wv) { int t = wv * 64 + lane_id(); asm volatile("" : "+v"(t)); return t; }
DI float dpp_xor1(float x) { return __builtin_bit_cast(float, __builtin_amdgcn_mov_dpp(__builtin_bit_cast(int, x), 0xB1, 0xF, 0xF, true)); }
DI float dpp_xor2(float x) { return __builtin_bit_cast(float, __builtin_amdgcn_mov_dpp(__builtin_bit_cast(int, x), 0x4E, 0xF, 0xF, true)); }
DI float dpp_hmir(float x) { return __builtin_bit_cast(float, __builtin_amdgcn_mov_dpp(__builtin_bit_cast(int, x), 0x141, 0xF, 0xF, true)); }
template <int N> DI float dpp_ror(float x) { return __builtin_bit_cast(float, __builtin_amdgcn_mov_dpp(__builtin_bit_cast(int, x), 0x120 + N, 0xF, 0xF, true)); }
DI float dpp_rmir(float x) { return __builtin_bit_cast(float, __builtin_amdgcn_mov_dpp(__builtin_bit_cast(int, x), 0x140, 0xF, 0xF, true)); }
DI float red8(float x) { x += dpp_xor1(x); x += dpp_xor2(x); x += dpp_hmir(x); return x; }
DI float red16(float x) { x += dpp_xor1(x); x += dpp_xor2(x); x += dpp_hmir(x); x += dpp_rmir(x); return x; }
DI float sat448(float x) { return __builtin_amdgcn_fmed3f(x, -448.f, 448.f); }
DI unsigned pk4_fp8(float a, float b, float c, float d) { int w = 0; w = __builtin_amdgcn_cvt_pk_fp8_f32(sat448(a), sat448(b), w, false); w = __builtin_amdgcn_cvt_pk_fp8_f32(sat448(c), sat448(d), w, true); return (unsigned)w; }
constexpr float F8_WSCALE = 32.f;
DI float sigmoidf_(float x) { return __builtin_amdgcn_rcpf(1.f + __expf(-x)); }

namespace pg8 {
constexpr int BM = 256, BK = 64, HALF = 128, HTB = HALF * BK * 2, STAGE_BYTES = 8 * HTB, NXCD = 8, WGM = 8;
__host__ __device__ __forceinline__ int lds_byte(int r, int c) { const int st = (r >> 4) * 2 + (c >> 5), rr = r & 15, cc = c & 31, ob = rr * 64 + cc * 2; return st * 1024 + (ob ^ (((ob >> 9) & 1) << 5)); }
__host__ __device__ __forceinline__ void stage_rc(int b, int& R, int& C) { const int st = b / 1024, sb = b % 1024, swz = sb ^ (((sb >> 9) & 1) << 5); R = (st >> 1) * 16 + swz / 64; C = (st & 1) * 32 + (swz % 64) / 2; }
__host__ __device__ __forceinline__ int perm32(int rho) { const int n = rho >> 4, i = rho & 15; return 8 * (i >> 2) + 4 * n + (i & 3); }

struct Unit { int pm, pn, aux; };
struct Gemm { const bf16* A; const bf16* Bt; int lda, ldb, K; };

struct StaticOrder {
    int nM, nN, nwg, G, c;
    __host__ __device__ void init(int M, int N, int G_, int c_) { nM = M / BM; nN = N / BM; nwg = nM * nN; G = G_; c = c_; }
    __host__ __device__ bool next(int i, Unit& u) const {
        const long L = (long)i * G + c; if (L >= nwg) return false;
        int wgid = (int)L; { const int q = nwg / NXCD, r = nwg % NXCD, xcd = wgid % NXCD, off = wgid / NXCD; wgid = (xcd < r ? xcd * (q + 1) : r * (q + 1) + (xcd - r) * q) + off; }
        const int nig = WGM * nN, gid = wgid / nig, fm = gid * WGM, gsz = (nM - fm) < WGM ? (nM - fm) : WGM;
        u.pm = fm + ((wgid % nig) % gsz); u.pn = (wgid % nig) / gsz; u.aux = 0; return true;
    }
    __device__ __forceinline__ int arow(const Unit&, int) const { return 0; }
    __device__ __forceinline__ int koff(const Unit&) const { return 0; }
};

typedef int v8i __attribute__((ext_vector_type(8)));
template <class Epi, class Sched, bool GATHER, bool F8 = false>
__device__ __forceinline__ void gemm_phase(LAS unsigned char* lds, const Gemm g, const Sched& S, const Epi& E, int wv) {
    const int tid = otid(wv), wid = __builtin_amdgcn_readfirstlane(tid >> 6), lane = tid & 63, wr = wid >> 2, wc = wid & 3, fr = lane & 15, fq = lane >> 4;
    int K = g.K; asm volatile("" : "+s"(K));
    constexpr int ES = F8 ? 1 : 2;
    const int nt = K / (F8 ? 2 * BK : BK);
    unsigned voffB[2], vA0[2], vA1[2], nA0[2], nA1[2]; int Rr[2], Cc[2];
#pragma unroll
    for (int i = 0; i < 2; ++i) { int R, C; stage_rc(tid * 16 + i * 8192, R, C); const int Rb = Epi::PERM ? ((R & ~31) + perm32(R & 31)) : R;
        Rr[i] = R; Cc[i] = C; voffB[i] = (unsigned)(Rb * g.ldb * ES + C * 2);
        vA0[i] = (unsigned)(R * g.lda * ES + C * 2); vA1[i] = (unsigned)((R + HALF) * g.lda * ES + C * 2); nA0[i] = vA0[i]; nA1[i] = vA1[i]; }
    const size_t kstep = (size_t)(BK * 2);
    const size_t hstepB = (size_t)HALF * g.ldb * ES, tstepB = 2 * hstepB, tstepA = (size_t)BM * g.lda * ES, hstepA = (size_t)HALF * g.lda * ES, rbA = (size_t)g.lda * ES, rbB = (size_t)g.ldb * ES;
    const unsigned ldsw = (unsigned)wid * 1024u;
    const int aoff = lds_byte(wr * 64 + fr, F8 ? fq * 16 : fq * 8), boff = lds_byte(wc * 32 + fr, F8 ? fq * 16 : fq * 8);
#define PG8_SA(b, h) (((b) * 2 + (h)) * HTB)
#define PG8_SB(b, h) ((4 + (b) * 2 + (h)) * HTB)
#define PG8_STAGE(bufoff, gbase, voff) do { _Pragma("unroll") for (int _i = 0; _i < 2; ++_i) \
        __builtin_amdgcn_global_load_lds((const unsigned*)((const char*)(gbase) + (voff)[_i]), (LAS unsigned*)(lds + (bufoff) + ldsw + _i * 8192), 16, 0, 0); } while (0)
#define PG8_STAGE1(bufoff, gbase, voff0, rowbytes) do { __builtin_amdgcn_global_load_lds((const unsigned*)((const char*)(gbase) + (voff0)), (LAS unsigned*)(lds + (bufoff) + ldsw), 16, 0, 0); \
        __builtin_amdgcn_global_load_lds((const unsigned*)((const char*)(gbase) + (size_t)64 * (rowbytes) + (voff0)), (LAS unsigned*)(lds + (bufoff) + ldsw + 8192), 16, 0, 0); } while (0)
#define PG8_STAGEA(bufoff, gbase, half, arr) do { if constexpr (GATHER) PG8_STAGE(bufoff, gbase, arr); else PG8_STAGE1(bufoff, (const char*)(gbase) + (half) * hstepA, vA0[0], rbA); } while (0)
#define PG8_LD32(p) __builtin_bit_cast(v8i, __builtin_shufflevector(*(const LAS u32x4*)(p), *(const LAS u32x4*)((p) + 16), 0, 1, 2, 3, 4, 5, 6, 7))
#define PG8_LDA(dst, b, h) do { if constexpr (F8) { _Pragma("unroll") for (int m = 0; m < 4; ++m) dst##8[m] = PG8_LD32(lds + PG8_SA(b, h) + aoff + m * 2048); } \
        else { _Pragma("unroll") for (int m = 0; m < 4; ++m) _Pragma("unroll") for (int k = 0; k < 2; ++k) dst[m][k] = *(const LAS bf16x8*)(lds + PG8_SA(b, h) + aoff + m * 2048 + k * 1024); } } while (0)
#define PG8_LDB(dst, b, h) do { if constexpr (F8) { _Pragma("unroll") for (int n = 0; n < 2; ++n) dst##8[n] = PG8_LD32(lds + PG8_SB(b, h) + boff + n * 2048); } \
        else { _Pragma("unroll") for (int n = 0; n < 2; ++n) _Pragma("unroll") for (int k = 0; k < 2; ++k) dst[n][k] = *(const LAS bf16x8*)(lds + PG8_SB(b, h) + boff + n * 2048 + k * 1024); } } while (0)
#define PG8_MMA(ai, bj, At, Bt) do { __builtin_amdgcn_s_setprio(1); if constexpr (F8) { _Pragma("unroll") for (int m = 0; m < 4; ++m) _Pragma("unroll") for (int n = 0; n < 2; ++n) \
            asm volatile("v_mfma_scale_f32_16x16x128_f8f6f4 %0, %1, %2, %0, %3, %4 op_sel_hi:[0,0,0]" : "+v"(acc[ai][bj][m][n]) : "v"(Bt##8[n]), "v"(At##8[m]), "v"(sc_w), "v"(sc_x)); }     \
        else { _Pragma("unroll") for (int m = 0; m < 4; ++m) _Pragma("unroll") for (int n = 0; n < 2; ++n) _Pragma("unroll") for (int k = 0; k < 2; ++k) \
            acc[ai][bj][m][n] = __builtin_amdgcn_mfma_f32_16x16x32_bf16(Bt[n][k], At[m][k], acc[ai][bj][m][n], 0, 0, 0); } __builtin_amdgcn_s_setprio(0); } while (0)
#define PG8_WAIT_V(n) asm volatile("s_waitcnt vmcnt(" #n ")" ::: "memory")
#define PG8_WAIT_L(n) asm volatile("s_waitcnt lgkmcnt(" #n ")" ::: "memory")
#define PG8_BAR __builtin_amdgcn_s_barrier()
#define PG8_SCHED __builtin_amdgcn_sched_barrier(0)
    Unit cur, nxt; int ui = 0;
    if (!S.next(0, cur)) return;
    f32x4 acc[2][2][4][2];
#pragma unroll
    for (int a = 0; a < 2; ++a)
#pragma unroll
        for (int b = 0; b < 2; ++b)
#pragma unroll
            for (int m = 0; m < 4; ++m)
#pragma unroll
                for (int n = 0; n < 2; ++n) acc[a][b][m][n] = (f32x4){0.f, 0.f, 0.f, 0.f};
    int sc_w = 122, sc_x = 127; if constexpr (F8) asm volatile("" : "+v"(sc_w), "+v"(sc_x));
    bf16x8 At[4][2], B0[2][2], B1[2][2]; v8i At8[4], B08[2], B18[2];
    const char* cA = (GATHER ? (const char*)g.A : (const char*)g.A + (size_t)cur.pm * tstepA) + ES * S.koff(cur);
    const char* cB = (const char*)g.Bt + (size_t)cur.pn * tstepB + ES * S.koff(cur);
    if (GATHER) {
#pragma unroll
        for (int i = 0; i < 2; ++i) { vA0[i] = (unsigned)(S.arow(cur, Rr[i]) * g.lda * ES + Cc[i] * 2); vA1[i] = (unsigned)(S.arow(cur, Rr[i] + HALF) * g.lda * ES + Cc[i] * 2); nA0[i] = vA0[i]; nA1[i] = vA1[i]; } }
    PG8_STAGE1(PG8_SB(0, 0), cB, voffB[0], rbB); PG8_STAGEA(PG8_SA(0, 0), cA, 0, vA0); PG8_STAGE1(PG8_SB(0, 1), cB + hstepB, voffB[0], rbB); PG8_STAGEA(PG8_SA(0, 1), cA, 1, vA1);
    if (wr == 1) PG8_BAR;
    PG8_WAIT_V(4); PG8_BAR;
    PG8_STAGE1(PG8_SB(1, 0), cB + kstep, voffB[0], rbB); PG8_STAGEA(PG8_SA(1, 0), cA + kstep, 0, vA0); PG8_STAGE1(PG8_SB(1, 1), cB + hstepB + kstep, voffB[0], rbB);
    PG8_WAIT_V(6); PG8_BAR;
    for (;;) {
        const bool has_next = S.next(ui + 1, nxt);
        const char* nAp = GATHER ? cA : (has_next ? (const char*)g.A + (size_t)nxt.pm * tstepA + ES * S.koff(nxt) : cA);
        const char* nB = has_next ? (const char*)g.Bt + (size_t)nxt.pn * tstepB + ES * S.koff(nxt) : cB;
        if (GATHER) {
#pragma unroll
            for (int i = 0; i < 2; ++i) { nA0[i] = vA0[i]; nA1[i] = vA1[i]; } }
        for (int t = 0; t < nt; t += 2) {
            const bool last = (t == nt - 2);
            if (GATHER && has_next && t == (nt >= 4 ? nt - 4 : 0)) {
#pragma unroll
                for (int i = 0; i < 2; ++i) { nA0[i] = (unsigned)(S.arow(nxt, Rr[i]) * g.lda * ES + Cc[i] * 2); nA1[i] = (unsigned)(S.arow(nxt, Rr[i] + HALF) * g.lda * ES + Cc[i] * 2); } }
            const char* a1 = cA + (size_t)(t + 1) * kstep;
            const char* a2 = last ? nAp : cA + (size_t)(t + 2) * kstep; const char* b2 = last ? nB : cB + (size_t)(t + 2) * kstep;
            const char* a3 = a2 + kstep; const char* b3 = b2 + kstep;
            unsigned w0[2], w1[2];
#pragma unroll
            for (int i = 0; i < 2; ++i) { w0[i] = (GATHER && last) ? nA0[i] : vA0[i]; w1[i] = (GATHER && last) ? nA1[i] : vA1[i]; }
            PG8_LDB(B0, 0, 0); PG8_SCHED; PG8_LDA(At, 0, 0); PG8_STAGEA(PG8_SA(1, 1), a1, 1, vA1);
            PG8_WAIT_L(8); PG8_BAR; PG8_WAIT_L(0); PG8_MMA(0, 0, At, B0); PG8_BAR; PG8_SCHED;
            PG8_LDB(B1, 0, 1); PG8_STAGE1(PG8_SB(0, 0), b2, voffB[0], rbB);
            PG8_BAR; PG8_WAIT_L(0); PG8_MMA(0, 1, At, B1); PG8_BAR;
            PG8_LDA(At, 0, 1); PG8_STAGEA(PG8_SA(0, 0), a2, 0, w0);
            PG8_BAR; PG8_WAIT_L(0); PG8_MMA(1, 0, At, B0); PG8_BAR; PG8_SCHED;
            PG8_STAGE1(PG8_SB(0, 1), b2 + hstepB, voffB[0], rbB);
            PG8_WAIT_V(6); PG8_BAR; PG8_MMA(1, 1, At, B1); PG8_BAR;
            PG8_LDB(B0, 1, 0); PG8_SCHED; PG8_LDA(At, 1, 0); PG8_STAGEA(PG8_SA(0, 1), a2, 1, w1);
            PG8_WAIT_L(8); PG8_BAR; PG8_WAIT_L(0); PG8_MMA(0, 0, At, B0); PG8_BAR; PG8_SCHED;
            PG8_LDB(B1, 1, 1); PG8_STAGE1(PG8_SB(1, 0), b3, voffB[0], rbB);
            PG8_BAR; PG8_WAIT_L(0); PG8_MMA(0, 1, At, B1); PG8_BAR;
            PG8_LDA(At, 1, 1); PG8_STAGEA(PG8_SA(1, 0), a3, 0, w0);
            PG8_BAR; PG8_WAIT_L(0); PG8_MMA(1, 0, At, B0); PG8_BAR; PG8_SCHED;
            PG8_STAGE1(PG8_SB(1, 1), b3 + hstepB, voffB[0], rbB);
            PG8_WAIT_V(6); PG8_BAR; PG8_MMA(1, 1, At, B1); PG8_BAR;
        }
        if constexpr (F8) asm volatile("s_nop 15\n\ts_nop 15\n\ts_nop 15\n\ts_nop 15" ::: "memory");
        { int frr = fr, fqq = fq; asm volatile("" : "+v"(frr), "+v"(fqq));
          E(acc, cur, wr, wc, frr, fqq); }
        if (!has_next) break;
#pragma unroll
        for (int a = 0; a < 2; ++a)
#pragma unroll
            for (int b = 0; b < 2; ++b)
#pragma unroll
                for (int m = 0; m < 4; ++m)
#pragma unroll
                    for (int n = 0; n < 2; ++n) acc[a][b][m][n] = (f32x4){0.f, 0.f, 0.f, 0.f};
        cur = nxt; cA = nAp; cB = nB; ++ui;
        if (GATHER) {
#pragma unroll
            for (int i = 0; i < 2; ++i) { vA0[i] = nA0[i]; vA1[i] = nA1[i]; } }
    }
    PG8_WAIT_V(0);
    if (wr == 0) PG8_BAR;
    PG8_BAR;
#undef PG8_SA
#undef PG8_SB
#undef PG8_STAGE
#undef PG8_STAGE1
#undef PG8_STAGEA
#undef PG8_LDA
#undef PG8_LDB
#undef PG8_MMA
#undef PG8_LD32
#undef PG8_WAIT_V
#undef PG8_WAIT_L
#undef PG8_BAR
#undef PG8_SCHED
}
}

#define XB_TMO      128
#define XB_XCNT(j)  (256  + 64 * (j))
#define XB_XSUB(j)  (1280 + 64 * (j))
#define XB_XGEN(j)  (2304 + 64 * (j))
#define XB_TOP      3328
#define XB_TOPGEN   3392
#define XCD_BAR_WORDS 3456
#define XB_SPIN_CAP (1u << 18)
__device__ __forceinline__ unsigned xb_ld(unsigned* p)              { return __hip_atomic_load(p, __ATOMIC_RELAXED, __HIP_MEMORY_SCOPE_AGENT); }
__device__ __forceinline__ unsigned xb_add(unsigned* p, unsigned v) { return __hip_atomic_fetch_add(p, v, __ATOMIC_RELAXED, __HIP_MEMORY_SCOPE_AGENT); }
__device__ __forceinline__ unsigned xb_xcc_id() { return (unsigned)__builtin_amdgcn_s_getreg((3 << 11) | 20) & 0xFu; }
#define XB_SPIN(cond, bar) do { unsigned _sp = 0; while (cond) { __builtin_amdgcn_s_sleep(1); \
    if ((++_sp & 255u) == 0u) { if (xb_ld(&(bar)[XB_TMO])) break; if (_sp > XB_SPIN_CAP) { atomicAdd(&(bar)[XB_TMO], 1u); break; } } } } while (0)
struct XcdBarrier { unsigned* bar; unsigned x; volatile LAS unsigned* st; int wv; };
__device__ __forceinline__ XcdBarrier xcd_barrier_post(unsigned* bar, volatile LAS unsigned* st, int wv) {
    XcdBarrier b; b.bar = bar; b.x = xb_xcc_id(); b.st = st; b.wv = wv;
    if (wv == 0 && lane_id() == 0) (void)xb_add(&bar[XB_XCNT(b.x)], 1u);
    return b;
}
__device__ __forceinline__ void xcd_barrier_complete(unsigned* bar, unsigned x, unsigned& nloc, unsigned& nx) {
    const unsigned G = gridDim.x * gridDim.y * gridDim.z;
    unsigned sum, cnt, mine, sp = 0u;
    for (;;) {
        sum = 0u; cnt = 0u; mine = 0u;
#pragma unroll
        for (unsigned j = 0; j < 16; ++j) { const unsigned c = xb_ld(&bar[XB_XCNT(j)]); sum += c; cnt += (c > 0u) ? 1u : 0u; mine = (j == x) ? c : mine; }
        if (sum == G) break;
        __builtin_amdgcn_s_sleep(1);
        if ((++sp & 255u) == 0u) { if (xb_ld(&bar[XB_TMO])) break; if (sp > XB_SPIN_CAP) { atomicAdd(&bar[XB_TMO], 1u); break; } }
    }
    nloc = mine > 0u ? mine : 1u; nx = cnt > 0u ? cnt : 1u;
}
__device__ __forceinline__ void xcd_barrier(const XcdBarrier& b) {
    asm volatile("s_waitcnt vmcnt(0)" ::: "memory");
    __syncthreads();
    if (b.wv == 0 && lane_id() == 0) {
        unsigned* bar = b.bar;
        __builtin_amdgcn_s_waitcnt(0);
        unsigned nloc = b.st[0], nx = b.st[1];
        if (nloc == 0u) { xcd_barrier_complete(bar, b.x, nloc, nx); b.st[0] = nloc; b.st[1] = nx; }
        const unsigned old = xb_add(&bar[XB_XSUB(b.x)], 1u);
        const unsigned gen = old / nloc;
        if (old + 1u == (gen + 1u) * nloc) {
            __builtin_amdgcn_fence(__ATOMIC_RELEASE, "agent");
            asm volatile("s_waitcnt vmcnt(0)" ::: "memory");
            const unsigned og = xb_add(&bar[XB_TOP], 1u);
            const unsigned tg = og / nx;
            if (og + 1u == (tg + 1u) * nx) xb_add(&bar[XB_TOPGEN], 1u);
            else XB_SPIN(xb_ld(&bar[XB_TOPGEN]) == tg, bar);
            __builtin_amdgcn_fence(__ATOMIC_ACQUIRE, "agent");
            xb_add(&bar[XB_XGEN(b.x)], 1u);
            asm volatile("s_waitcnt vmcnt(0)" ::: "memory");
        } else {
            XB_SPIN(xb_ld(&bar[XB_XGEN(b.x)]) == gen, bar);
            __builtin_amdgcn_fence(__ATOMIC_ACQUIRE, "agent");
            asm volatile("s_waitcnt vmcnt(0)" ::: "memory");
        }
    }
    __syncthreads();
}

constexpr size_t MiB = 1u << 20;
constexpr size_t CTL_BAR = 0, CTL_MODI = 16384  , CTL_MOD = CTL_MODI + 2 * 4 * 12288 * 8  , CTL_SSQ = CTL_MOD + 2 * 4 * 12288 * 4  ,
                 CTL_CNT = CTL_SSQ + (size_t)T * 12 * 4  , CTL_CHK = CTL_CNT + 2 * 16 * 256, CTL_ZERO_BYTES = 2 * MiB;
static_assert(CTL_CHK % 8 == 0 && CTL_CHK + 1024 <= CTL_ZERO_BYTES, "ctl");
constexpr size_t WS_W_IN0 = 2 * MiB, WS_W_UQ = WS_W_IN0 + 8 * MiB, WS_W_UKV = WS_W_UQ + 1536 * 512 * 2, WS_W_GLU = WS_W_UKV + 2048 * 256 * 2, WS_W_OUT0 = WS_W_GLU + 2 * MiB,
                 WS_W_IN1 = WS_W_OUT0 + 8 * MiB, WS_W_OUT1 = WS_W_IN1 + (size_t)9728 * 2048 * 2, WS_W_GU = WS_W_OUT1 + 8 * MiB, WS_W_DN = WS_W_GU + 128 * MiB,
                 WS_W_LORA = WS_W_DN + 64 * MiB, WS_S5BY = WS_W_LORA + (size_t)4608 * 384 * 2, WS_S5BE = WS_S5BY + (size_t)64 * 256 * 384 * 2, WS_ROPE = WS_S5BE + (size_t)64 * 256 * 256 * 2,
                 WS_BIAS = WS_ROPE + 1 * MiB, WS_S5L = WS_BIAS + 16384, WS_H = WS_S5L + 65536;
static_assert(WS_H % 256 == 0, "align");
constexpr size_t WS_W_GU8 = WS_W_GU + 64 * MiB;
constexpr size_t WS_X1 = WS_H + 64 * MiB, WS_ARENA = WS_X1 + 128 * MiB;
constexpr size_t A_QC = WS_ARENA, A_KVC = A_QC + 16 * MiB, A_KR = A_KVC + 8 * MiB, A_XH = A_KR + 2 * MiB, A_ES = A_XH + 48 * MiB, A_Q = A_ES + 32 * MiB, A_KF = A_Q + 48 * MiB,
                 A_V = A_KF + 48 * MiB, A_YS5 = A_V + 32 * MiB;
constexpr size_t A_XPRE = WS_ARENA, A_RT = WS_ARENA + 128 * MiB, A_TOKL = A_RT + 1 * MiB, A_ACT = WS_ARENA, A_YS = WS_ARENA + 130 * MiB;
constexpr int MOE_ROWS = 2 * T + 16 * 256;
constexpr size_t A_ZD = WS_ARENA, A_ZR = A_ZD + 144 * MiB, A_LIN = A_ZR + 156 * MiB, A_WDEC = A_LIN + 12 * MiB, A_AA = A_WDEC + 48 * MiB, A_GG = A_AA + 48 * MiB,
                 A_DPO = A_GG + 48 * MiB, A_DPM = A_DPO + 48 * MiB, A_DPL = A_DPM + 2 * MiB, A_BSG = A_DPL + 2 * MiB  , A_YR = WS_ARENA  , A_GST = A_BSG + 2 * MiB  , WS_END = A_GST + 2 * MiB;
static_assert(A_YS + (size_t)MOE_ROWS * 2048 * 2 <= WS_END && A_YS5 + 32 * MiB <= WS_END && WS_END <= 1024 * MiB, "ws map");

constexpr int RING_BYTES = 131072, LDS_TAB = RING_BYTES, LDS_MISC = RING_BYTES + 1024, LDS_BYTES = 147456;

struct KArgs { const float* in[41]; float* out; unsigned char* ws; int ph_lo, ph_hi; };
enum { I_X = 0, I_C, I_ADAW, I_ADAB, I_LNMG, I_LNMB, I_LNFG, I_LNFB, I_RW, I_RB, I_WGU, I_WDN, I_RELB, I_EVIN, I_QN, I_WUQ, I_KVN, I_WUKV, I_LRE, I_LIM, I_BRE, I_BIM, I_CRE, I_CIM,
       I_S5D, I_LOGDT, I_WGLU, I_EVOUT, I_ODIN, I_MU, I_W0, I_W2, I_A0, I_A2, I_G2, I_KK, I_KA, I_RK, I_LNXG, I_LNXB, I_ODOUT };

DI int ropeperm(int c) { return ((c >> 2) & 1) * 32 + (c >> 3) * 4 + (c & 3); }
DI int srccol(int map, int n) {
    switch (map) {
        case 1: if (n < 768) return n; if (n < 1792) return 832 + (n - 768); if (n < 1856) return 768 + ropeperm(n - 1792); return -1;
        case 2: { const int h = n / 192, j = n % 192; return j < 128 ? n : h * 192 + 128 + ropeperm(j - 128); }
        case 3: { const int pn = n >> 8, half = (n >> 7) & 1, idx = n & 127; return half * 512 + pn * 128 + idx; }
        case 4: return n < ODD_IN ? n : -1;
        default: return n;
    }
}
struct ConvJob { const float* src; bf16* dst; const float* kscale; int ldsrc, K, Nd, nmat, map, kbeg, kend, f8; size_t smat, dmat; };
DI void conv_item(const ConvJob& J, LAS unsigned char* scr, int item, int lane) {
    const int nblk = J.Nd / 64, per = (J.K / 64) * nblk, mat = item / per, r = item % per, kb = r / nblk, nb = r % nblk, k0 = 64 * kb, n0 = 64 * nb;
    const float* W = J.src + (size_t)mat * J.smat; bf16* WT = J.f8 ? (bf16*)((unsigned char*)J.dst + (size_t)mat * J.dmat) : J.dst + (size_t)mat * J.dmat;
    const int kq = lane >> 4, nq = lane & 15, sc = srccol(J.map, n0 + 4 * nq);
    f32x4 v[16];
#pragma unroll
    for (int i = 0; i < 16; ++i) { const int kg = k0 + 4 * i + kq; v[i] = (f32x4){0.f, 0.f, 0.f, 0.f};
        if (sc >= 0 && kg >= J.kbeg && kg < J.kend) { v[i] = *(const f32x4*)(W + (size_t)(kg - J.kbeg) * J.ldsrc + sc); if (J.kscale) v[i] *= J.kscale[kg]; } }
#pragma unroll
    for (int i = 0; i < 16; ++i) { LAS bf16* t = (LAS bf16*)(scr + (4 * nq) * 132 + (4 * i + kq) * 2); const unsigned p0 = pk2(v[i].x, v[i].y), p1 = pk2(v[i].z, v[i].w);
        t[0] = (bf16)(p0 & 0xffffu); t[66] = (bf16)(p0 >> 16); t[132] = (bf16)(p1 & 0xffffu); t[198] = (bf16)(p1 >> 16); }
    asm volatile("s_waitcnt lgkmcnt(0)" ::: "memory");
#pragma unroll
    for (int q = 0; q < 8; ++q) { const int id = lane + 64 * q, n = id >> 3, c = id & 7; const LAS unsigned* t = (const LAS unsigned*)(scr + n * 132 + c * 16);
        u32x4 o = {t[0], t[1], t[2], t[3]};
        if (J.f8) { u32x2 o8 = {pk4_fp8(bflo(o.x) * F8_WSCALE, bfhi(o.x) * F8_WSCALE, bflo(o.y) * F8_WSCALE, bfhi(o.y) * F8_WSCALE), pk4_fp8(bflo(o.z) * F8_WSCALE, bfhi(o.z) * F8_WSCALE, bflo(o.w) * F8_WSCALE, bfhi(o.w) * F8_WSCALE)};
            *(u32x2*)((unsigned char*)WT + (size_t)(n0 + n) * J.K + k0 + 8 * c) = o8; }
        else *(u32x4*)(WT + (size_t)(n0 + n) * J.K + k0 + 8 * c) = o; }
    asm volatile("s_waitcnt lgkmcnt(0)" ::: "memory");
}
DI ConvJob conv_job(const KArgs& a, int j) {
    unsigned char* ws = a.ws; ConvJob J; J.kscale = nullptr; J.nmat = 1; J.map = 0; J.smat = 0; J.dmat = 0; J.kbeg = 0; J.kend = 1 << 30; J.f8 = 0;
    switch (j) {
        case 0: J.src = a.in[I_EVIN]; J.dst = (bf16*)(ws + WS_W_IN0); J.f8 = 1; J.ldsrc = EVEN_IN; J.K = 2048; J.Nd = 2048; J.map = 1; break;
        case 1: J.src = a.in[I_WUQ]; J.dst = (bf16*)(ws + WS_W_UQ); J.ldsrc = 1536; J.K = 512; J.Nd = 1536; J.map = 2; J.kscale = a.in[I_QN]; break;
        case 2: J.src = a.in[I_WUKV]; J.dst = (bf16*)(ws + WS_W_UKV); J.ldsrc = 2048; J.K = 256; J.Nd = 2048; J.kscale = a.in[I_KVN]; break;
        case 3: J.src = a.in[I_WGLU]; J.dst = (bf16*)(ws + WS_W_GLU); J.ldsrc = 1024; J.K = 1024; J.Nd = 1024; break;
        case 4: J.src = a.in[I_EVOUT]; J.dst = (bf16*)(ws + WS_W_OUT0); J.f8 = 1; J.ldsrc = 2048; J.K = 2048; J.Nd = 2048; break;
        case 5: J.src = a.in[I_ODIN]; J.dst = (bf16*)(ws + WS_W_IN1); J.f8 = 1; J.ldsrc = ODD_IN; J.K = 2048; J.Nd = 9728; J.map = 4; break;
        case 6: J.src = a.in[I_ODOUT]; J.dst = (bf16*)(ws + WS_W_OUT1); J.f8 = 1; J.ldsrc = 2048; J.K = 2048; J.Nd = 2048; break;
        case 7: J.src = a.in[I_WGU]; J.dst = (bf16*)(ws + WS_W_GU8); J.f8 = 1; J.ldsrc = 1024; J.K = 2048; J.Nd = 1024; J.map = 3; J.nmat = 32; J.smat = (size_t)2048 * 1024; J.dmat = (size_t)1024 * 2048; break;
        case 8: J.src = a.in[I_WDN]; J.dst = (bf16*)(ws + WS_W_DN); J.f8 = 1; J.ldsrc = 2048; J.K = 512; J.Nd = 2048; J.nmat = 32; J.smat = (size_t)512 * 2048; J.dmat = (size_t)2048 * 512; break;
        case 9: J.src = a.in[I_W2]; J.dst = (bf16*)(ws + WS_W_LORA); J.ldsrc = 1536; J.K = 384; J.Nd = 1536; J.kbeg = 0; J.kend = 64; break;
        case 10: J.src = a.in[I_A2]; J.dst = (bf16*)(ws + WS_W_LORA) + (size_t)1536 * 384; J.ldsrc = 1536; J.K = 384; J.Nd = 1536; J.kbeg = 64; J.kend = 128; break;
        default: J.src = a.in[I_G2]; J.dst = (bf16*)(ws + WS_W_LORA) + (size_t)3072 * 384; J.ldsrc = 1536; J.K = 384; J.Nd = 1536; J.kbeg = 128; J.kend = 352; break;
    }
    return J;
}
constexpr int N_CONV_JOBS = 12;

DI void s5_precompute(const KArgs& a, LAS unsigned char* lds, int g, int wv) {
    LAS float* PW = (LAS float*)lds; LAS float* BB = PW + 17 * 64 * 2; LAS float* CC = BB + 64 * 16 * 2; LAS float* KK = CC + 16 * 64 * 2;
    const int tid = otid(wv);
    const float dt = expf(a.in[I_LOGDT][g]);
    for (int idx = tid; idx < 17 * 64; idx += 512) { const int d = idx / 64, p = idx % 64; const float lre = a.in[I_LRE][g * 64 + p], lim = a.in[I_LIM][g * 64 + p];
        const float mag = expf(lre * dt * (float)d); float sn, cs; sincosf(lim * dt * (float)d, &sn, &cs); PW[idx * 2] = mag * cs; PW[idx * 2 + 1] = mag * sn;
        if (d == 16) { float* L = (float*)(a.ws + WS_S5L); L[(g * 64 + p) * 2] = mag * cs; L[(g * 64 + p) * 2 + 1] = mag * sn; } }
    for (int idx = tid; idx < 64 * 16; idx += 512) { const int p = idx / 16, c = idx % 16; const float lre = a.in[I_LRE][g * 64 + p], lim = a.in[I_LIM][g * 64 + p];
        float sn, cs; sincosf(lim * dt, &sn, &cs); const float mag = expf(lre * dt), sh = sinf(0.5f * lim * dt);
        const float nr = expm1f(lre * dt) * cs - 2.f * sh * sh, ni = mag * sn, den = 1.f / (lre * lre + lim * lim);
        const float cr = (nr * lre + ni * lim) * den, ci = (ni * lre - nr * lim) * den;
        const float br = a.in[I_BRE][(g * 64 + p) * 16 + c], bi = a.in[I_BIM][(g * 64 + p) * 16 + c];
        BB[idx * 2] = cr * br - ci * bi; BB[idx * 2 + 1] = cr * bi + ci * br; }
    for (int idx = tid; idx < 16 * 64; idx += 512) { CC[idx * 2] = a.in[I_CRE][g * 1024 + idx]; CC[idx * 2 + 1] = a.in[I_CIM][g * 1024 + idx]; }
    __syncthreads();
    for (int idx = tid; idx < 4096; idx += 512) { const int d = idx >> 8, c = (idx >> 4) & 15, cp = idx & 15; float s = 0.f;
        for (int p = 0; p < 64; ++p) { const float cr = CC[(c * 64 + p) * 2], ci = CC[(c * 64 + p) * 2 + 1], pr = PW[(d * 64 + p) * 2], pi = PW[(d * 64 + p) * 2 + 1];
            const float xr = cr * pr - ci * pi, xi = cr * pi + ci * pr; s += xr * BB[(p * 16 + cp) * 2] - xi * BB[(p * 16 + cp) * 2 + 1]; }
        KK[idx] = s; }
    __syncthreads();
    bf16* BY = (bf16*)(a.ws + WS_S5BY) + (size_t)g * 256 * 384; bf16* BE = (bf16*)(a.ws + WS_S5BE) + (size_t)g * 256 * 256;
    for (int idx = tid; idx < 256 * 48; idx += 512) { const int row = idx / 48, col0 = (idx % 48) * 8, t = row >> 4, c = row & 15; float v[8];
        if (col0 < 256) { const int s = col0 >> 4, c0 = col0 & 15;
#pragma unroll
            for (int j = 0; j < 8; ++j) v[j] = (s <= t) ? KK[((t - s) << 8) + (c << 4) + c0 + j] : 0.f; }
        else { const int pp = col0 - 256; const bool im = pp >= 64; const int p0 = im ? pp - 64 : pp;
#pragma unroll
            for (int j = 0; j < 8; ++j) { const int p = p0 + j; const float cr = CC[(c * 64 + p) * 2], ci = CC[(c * 64 + p) * 2 + 1], pr = PW[((t + 1) * 64 + p) * 2], pi = PW[((t + 1) * 64 + p) * 2 + 1];
                v[j] = im ? -(cr * pi + ci * pr) : (cr * pr - ci * pi); } }
        u32x4 o = {pk2(v[0], v[1]), pk2(v[2], v[3]), pk2(v[4], v[5]), pk2(v[6], v[7])}; *(u32x4*)(BY + (size_t)row * 384 + col0) = o; }
    for (int idx = tid; idx < 256 * 32; idx += 512) { const int row = idx / 32, col0 = (idx % 32) * 8, s = col0 >> 4, c0 = col0 & 15; float v[8];
#pragma unroll
        for (int j = 0; j < 8; ++j) { if (row < 128) { const int p = row & 63; const float pr = PW[((15 - s) * 64 + p) * 2], pi = PW[((15 - s) * 64 + p) * 2 + 1], br = BB[(p * 16 + c0 + j) * 2], bi = BB[(p * 16 + c0 + j) * 2 + 1];
                v[j] = row < 64 ? (pr * br - pi * bi) : (pr * bi + pi * br); } else v[j] = 0.f; }
        u32x4 o = {pk2(v[0], v[1]), pk2(v[2], v[3]), pk2(v[4], v[5]), pk2(v[6], v[7])}; *(u32x4*)(BE + (size_t)row * 256 + col0) = o; }
    __syncthreads();
}

DI int t5_bucket(int dist) { if (dist < 16) return dist; const float logd = logf((float)dist / 16.f) / logf(128.f); int lg = 16 + (int)(logd * 16.f); return lg < 31 ? lg : 31; }

DI void p0_prologue(const KArgs& a, LAS unsigned char* lds, int wv) {
    const int tid = otid(wv), lane = tid & 63, wave = tid >> 6, G = gridDim.x, gw = blockIdx.x * 8 + wave, NGW = G * 8;
    LAS float* cond = (LAS float*)(lds + 98304);
    for (int i = tid; i < 4 * 2048; i += 512) { const float c = a.in[I_C][i]; cond[i] = c / (1.f + expf(-c)); }
    if (blockIdx.x < 64) s5_precompute(a, lds, blockIdx.x, wv); else __syncthreads();
    unsigned long long* MODI = (unsigned long long*)(a.ws + CTL_MODI);
    for (int it = gw; it < 2 * 48 * 16; it += NGW) { const int l = it / 768, cc = (it % 768) / 16, kc = it % 16, col = cc * 256 + lane * 4;
        const float* W = a.in[I_ADAW] + ((size_t)l * 2048 + kc * 128) * 12288 + col;
        f32x4 acc[4]; for (int b = 0; b < 4; ++b) acc[b] = (f32x4){0.f, 0.f, 0.f, 0.f};
#pragma unroll 8
        for (int k = 0; k < 128; ++k) { const f32x4 w = *(const f32x4*)(W + (size_t)k * 12288);
#pragma unroll
            for (int b = 0; b < 4; ++b) acc[b] += w * cond[b * 2048 + kc * 128 + k]; }
        if (kc == 0) { const f32x4 bb = *(const f32x4*)(a.in[I_ADAB] + l * 12288 + col); for (int b = 0; b < 4; ++b) acc[b] += bb; }
#pragma unroll
        for (int b = 0; b < 4; ++b) { unsigned long long* o = MODI + (size_t)(l * 4 + b) * 12288 + col;
#pragma unroll
            for (int e = 0; e < 4; ++e) atomicAdd(o + e, (unsigned long long)__double2ll_rn((double)acc[b][e] * 1099511627776.0)); } }
    LAS unsigned char* scr = lds + wave * 8704;
    for (int j = 0; j < N_CONV_JOBS; ++j) { const ConvJob J = conv_job(a, j); const int nit = J.nmat * (J.K / 64) * (J.Nd / 64);
        for (int it = gw; it < nit; it += NGW) conv_item(J, scr, it, lane); }
    { float* RC = (float*)(a.ws + WS_ROPE); float* RS = RC + 4096 * 32; const int gt = blockIdx.x * 512 + tid;
      for (int i = gt; i < 4096 * 32; i += G * 512) { const int pos = i >> 5, j = i & 31; const float inv = powf(10000.f, -(float)(2 * j) / 64.f); float sn, cs; sincosf((float)pos * inv, &sn, &cs); RC[i] = cs; RS[i] = sn; }
      float* BL = (float*)(a.ws + WS_BIAS);
      for (int i = gt; i < 3 * 8 * 132; i += G * 512) { const int gi = i / (8 * 132), h = (i / 132) % 8, dl = i % 132; const int dil = gi == 0 ? 1 : (gi == 1 ? 4 : 16);
          BL[i] = dl <= 128 ? a.in[I_RELB][t5_bucket(dl * dil) * 24 + gi * 8 + h] * 1.44269504089f : 0.f; } }
}

DI float modi2f(unsigned long long v) { return fmaf((float)(unsigned)v, 0x1p-40f, (float)(int)(v >> 32) * 0x1p-8f); }
DI void modulate_rows(const float* x, const unsigned long long* MODI, float* MODF, bf16* H, int wv) {
    const int lane = otid(wv) & 63, gw = blockIdx.x * 8 + (otid(wv) >> 6), NGW = gridDim.x * 8;
    for (int i = gw * 64 + lane; i < 2 * 4 * 12288; i += NGW * 64) MODF[i] = modi2f(MODI[i]);
    for (int m = gw; m < T; m += NGW) { const int b = m / SEQ; const unsigned long long* sh = MODI + (size_t)b * 12288; const unsigned long long* sc = sh + 2048;
#pragma unroll
        for (int j = 0; j < 8; ++j) { const int col = (lane + 64 * j) * 4; const f32x4 v = *(const f32x4*)(x + (size_t)m * D + col);
            const f32x4 s1 = {modi2f(sc[col]), modi2f(sc[col + 1]), modi2f(sc[col + 2]), modi2f(sc[col + 3])}, s0 = {modi2f(sh[col]), modi2f(sh[col + 1]), modi2f(sh[col + 2]), modi2f(sh[col + 3])};
            const f32x4 h = v * (s1 + 1.f) + s0; *(unsigned*)((unsigned char*)H + (size_t)m * D + col) = pk4_fp8(h.x, h.y, h.z, h.w); } }
}

using pg8::Unit;
#define P32(ptr, elemoff) ((decltype(ptr))((char*)(ptr) + (unsigned)((unsigned)(elemoff) * (unsigned)sizeof(*(ptr)))))
typedef f32x4 Acc[2][2][4][2];
#define EPI_ROWS_BEGIN const int row0 = u.pm * 256 + wr * 64 + fr; _Pragma("unroll") for (int ai = 0; ai < 2; ++ai) _Pragma("unroll") for (int m = 0; m < 4; ++m) { const int row = row0 + ai * 128 + m * 16;
#define EPI_ROWS_END __builtin_amdgcn_sched_barrier(0); }
DI u32x4 pack8(const f32x4& v0, const f32x4& v1) { u32x4 o = {pk2(v0.x, v0.y), pk2(v0.z, v0.w), pk2(v1.x, v1.y), pk2(v1.z, v1.w)}; return o; }

struct EpiIn0 { static constexpr bool PERM = true;
    bf16 *QC, *KVC, *KR, *XH; float *ssq;
    DI void operator()(const Acc& acc, const Unit& u, int wr, int wc, int fr, int fq) const {
        EPI_ROWS_BEGIN
            float ss = 0.f;
#pragma unroll
            for (int bj = 0; bj < 2; ++bj) { const f32x4 v0 = acc[ai][bj][m][0], v1 = acc[ai][bj][m][1]; const int col = 128 * bj + 32 * wc + 8 * fq; const u32x4 o = pack8(v0, v1);
                if (u.pn < 2) { *(u32x4*)P32(QC, row * 512 + u.pn * 256 + col) = o; ss += v0.x * v0.x + v0.y * v0.y + v0.z * v0.z + v0.w * v0.w + v1.x * v1.x + v1.y * v1.y + v1.z * v1.z + v1.w * v1.w; }
                else if (u.pn == 2) { *(u32x4*)P32(KVC, row * 256 + col) = o; ss += v0.x * v0.x + v0.y * v0.y + v0.z * v0.z + v0.w * v0.w + v1.x * v1.x + v1.y * v1.y + v1.z * v1.z + v1.w * v1.w; }
                else if (u.pn < 7) { const int uc = (u.pn - 3) * 256 + col, g = uc >> 4; *(u32x4*)P32(XH, (g * 1024 + (row >> 4)) * 384 + (row & 15) * 16 + (uc & 15)) = o; }
                else if (col < 64) { *(u32x4*)P32(KR, row * 64 + col) = o; } }
            if (u.pn <= 2) { ss += __shfl_xor(ss, 16); ss += __shfl_xor(ss, 32); if (fq == 0) *P32(ssq, row * 12 + u.pn * 4 + wc) = ss; }
        EPI_ROWS_END
    }
};
struct EpiQ { static constexpr bool PERM = true;
    bf16* Q; const float* ssq; const float* rope;
    DI void operator()(const Acc& acc, const Unit& u, int wr, int wc, int fr, int fq) const {
        EPI_ROWS_BEGIN
            const f32x4 q0 = *(const f32x4*)P32(ssq, row * 12), q1 = *(const f32x4*)P32(ssq, row * 12 + 4);
            const float rs = __builtin_amdgcn_rsqf((((q0.x + q0.y) + (q0.z + q0.w)) + ((q1.x + q1.y) + (q1.z + q1.w))) * (1.f / 512.f) + RMS_EPS) * (0.07216878364870322f * 1.44269504089f);
            const int b = row / SEQ, s = row % SEQ;
#pragma unroll
            for (int bj = 0; bj < 2; ++bj) { f32x4 v0 = acc[ai][bj][m][0] * rs, v1 = acc[ai][bj][m][1] * rs; const int n = u.pn * 256 + 128 * bj + 32 * wc + 8 * fq, h = n / 192, j = n % 192;
                if (j >= 128) { const int q = (j - 128) >> 3; const f32x4 cs = *(const f32x4*)P32(rope, s * 32 + 4 * q), sn = *(const f32x4*)P32(rope, 4096 * 32 + s * 32 + 4 * q);
                    const f32x4 x1 = v0, x2 = v1; v0 = x1 * cs - x2 * sn; v1 = x1 * sn + x2 * cs; }
                *(u32x4*)P32(Q, ((b * 8 + h) * SEQ + s) * 192 + j) = pack8(v0, v1); }
        EPI_ROWS_END
    }
};
struct EpiKV { static constexpr bool PERM = true;
    bf16 *KF, *V; const float* ssq;
    DI void operator()(const Acc& acc, const Unit& u, int wr, int wc, int fr, int fq) const {
        EPI_ROWS_BEGIN
            const f32x4 q2 = *(const f32x4*)P32(ssq, row * 12 + 8); const float rs = __builtin_amdgcn_rsqf(((q2.x + q2.y) + (q2.z + q2.w)) * (1.f / 256.f) + RMS_EPS); const int b = row / SEQ, s = row % SEQ, h = u.pn, j = 32 * wc + 8 * fq; const int tok = (b * 8 + h) * SEQ + s;
            *(u32x4*)P32(KF, tok * 192 + j) = pack8(acc[ai][0][m][0] * rs, acc[ai][0][m][1] * rs);
            *(u32x4*)P32(V, tok * 128 + j) = pack8(acc[ai][1][m][0] * rs, acc[ai][1][m][1] * rs);
        EPI_ROWS_END
    }
};
struct S5Order { int G, c;
    DI bool next(int i, Unit& u) const { const int L = i * G + c; if (L >= 256) return false; u.pm = L; u.pn = L >> 2; u.aux = 0; return true; }
    DI int arow(const Unit&, int) const { return 0; }
    DI int koff(const Unit&) const { return 0; } };
struct EpiS5E { static constexpr bool PERM = false;
    float* ES;
    DI void operator()(const Acc& acc, const Unit& u, int wr, int wc, int fr, int fq) const {
        EPI_ROWS_BEGIN
#pragma unroll
            for (int n = 0; n < 2; ++n) *(f32x4*)P32(ES, row * 128 + 32 * wc + 16 * n + 4 * fq) = acc[ai][0][m][n];
        EPI_ROWS_END
    }
};
DI float gelu_tanh(float x) { const float t = 0.7978845608028654f * (x + 0.044715f * x * x * x); const float e = __expf(2.f * t); return 0.5f * x * (1.f + (1.f - 2.f * __builtin_amdgcn_rcpf(e + 1.f))); }
struct EpiS5Y { static constexpr bool PERM = true;
    bf16* YS5; const bf16* XH; const float* dsk;
    DI void operator()(const Acc& acc, const Unit& u, int wr, int wc, int fr, int fq) const {
        EPI_ROWS_BEGIN
            const int g = row >> 10, chunk = row & 1023;
#pragma unroll
            for (int bj = 0; bj < 2; ++bj) { const int col = 128 * bj + 32 * wc + 8 * fq, tl = col >> 4, c0 = col & 15; const u32x4 uu = *(const u32x4*)P32(XH, row * 384 + col);
                const f32x4 d0 = *(const f32x4*)P32(dsk, g * 16 + c0), d1 = *(const f32x4*)P32(dsk, g * 16 + c0 + 4); const f32x4 a0 = acc[ai][bj][m][0], a1 = acc[ai][bj][m][1];
                f32x4 y0 = {a0.x + d0.x * bflo(uu.x), a0.y + d0.y * bfhi(uu.x), a0.z + d0.z * bflo(uu.y), a0.w + d0.w * bfhi(uu.y)};
                f32x4 y1 = {a1.x + d1.x * bflo(uu.z), a1.y + d1.y * bfhi(uu.z), a1.z + d1.z * bflo(uu.w), a1.w + d1.w * bfhi(uu.w)};
#pragma unroll
                for (int e = 0; e < 4; ++e) { y0[e] = gelu_tanh(y0[e]); y1[e] = gelu_tanh(y1[e]); }
                *(u32x4*)P32(YS5, (chunk * 16 + tl) * 1024 + g * 16 + c0) = pack8(y0, y1); }
        EPI_ROWS_END
    }
};
struct EpiGlu { static constexpr bool PERM = true;
    bf16* MIX; const bf16* YS5;
    DI void operator()(const Acc& acc, const Unit& u, int wr, int wc, int fr, int fq) const {
        EPI_ROWS_BEGIN
#pragma unroll
            for (int bj = 0; bj < 2; ++bj) { const int col = u.pn * 256 + 128 * bj + 32 * wc + 8 * fq; const u32x4 yy = *(const u32x4*)P32(YS5, row * 1024 + col); const f32x4 a0 = acc[ai][bj][m][0], a1 = acc[ai][bj][m][1];
                const f32x4 o0 = {bflo(yy.x) * sigmoidf_(a0.x), bfhi(yy.x) * sigmoidf_(a0.y), bflo(yy.y) * sigmoidf_(a0.z), bfhi(yy.y) * sigmoidf_(a0.w)};
                const f32x4 o1 = {bflo(yy.z) * sigmoidf_(a1.x), bfhi(yy.z) * sigmoidf_(a1.y), bflo(yy.w) * sigmoidf_(a1.z), bfhi(yy.w) * sigmoidf_(a1.w)};
                { unsigned char* mx = (unsigned char*)MIX; u32x2 o8 = {pk4_fp8(o0.x, o0.y, o0.z, o0.w), pk4_fp8(o1.x, o1.y, o1.z, o1.w)}; *(u32x2*)P32(mx, row * 2048 + 1024 + col) = o8; } }
        EPI_ROWS_END
    }
};
template <bool XBF> struct EpiRes { static constexpr bool PERM = true;
    bf16* XPRE; const void* xres; const float* gate;
    DI void operator()(const Acc& acc, const Unit& u, int wr, int wc, int fr, int fq) const {
        EPI_ROWS_BEGIN
            const int b = row / SEQ;
#pragma unroll
            for (int bj = 0; bj < 2; ++bj) { const int col = u.pn * 256 + 128 * bj + 32 * wc + 8 * fq;
                f32x4 x0, x1;
                if (XBF) { const bf16* xb = (const bf16*)xres; const u32x4 xq = *(const u32x4*)P32(xb, row * D + col); x0 = (f32x4){bflo(xq.x), bfhi(xq.x), bflo(xq.y), bfhi(xq.y)}; x1 = (f32x4){bflo(xq.z), bfhi(xq.z), bflo(xq.w), bfhi(xq.w)}; }
                else { const float* xf = (const float*)xres; x0 = *(const f32x4*)P32(xf, row * D + col); x1 = *(const f32x4*)P32(xf, row * D + col + 4); }
                const f32x4 g0 = *(const f32x4*)P32(gate, b * 12288 + col), g1 = *(const f32x4*)P32(gate, b * 12288 + col + 4);
                *(u32x4*)P32(XPRE, row * D + col) = pack8(x0 * DN_ALPHA + (g0 + 1.f) * acc[ai][bj][m][0], x1 * DN_ALPHA + (g1 + 1.f) * acc[ai][bj][m][1]); }
        EPI_ROWS_END
    }
};

DI void krope_pass(const bf16* KR, const float* rope, bf16* KF, int wv) {
    const int gt = blockIdx.x * 512 + otid(wv), NT_ = gridDim.x * 512;
    for (int i = gt; i < T * 8; i += NT_) { const int row = i >> 3, q = i & 7, b = row / SEQ, s = row % SEQ; const u32x4 r = *(const u32x4*)(KR + (size_t)row * 64 + q * 8);
        const f32x4 x1 = {bflo(r.x), bfhi(r.x), bflo(r.y), bfhi(r.y)}, x2 = {bflo(r.z), bfhi(r.z), bflo(r.w), bfhi(r.w)};
        const f32x4 cs = *(const f32x4*)(rope + s * 32 + 4 * q), sn = *(const f32x4*)(rope + 4096 * 32 + s * 32 + 4 * q);
        const u32x4 o = pack8(x1 * cs - x2 * sn, x1 * sn + x2 * cs);
#pragma unroll
        for (int h = 0; h < 8; ++h) *(u32x4*)(KF + ((size_t)(b * 8 + h) * SEQ + s) * 192 + 128 + q * 8) = o; }
}
DI void s5_carry(const float* ES, const float* L16, bf16* XH, LAS unsigned char* lds, int wv) {
    const int tid = otid(wv), lane = tid & 63, w = tid >> 6; LAS float* SEG = (LAS float*)lds;
    for (int base = blockIdx.x * 64; base < 4 * 64 * 64; base += gridDim.x * 64) {
        const int gt = base + lane, p = gt & 63, g = (gt >> 6) & 63, b = gt >> 12; const float lr = L16[(g * 64 + p) * 2], li = L16[(g * 64 + p) * 2 + 1];
        const size_t r0 = (size_t)g * 1024 + b * 256 + 32 * w;
        float hr = 0.f, hi = 0.f;
#pragma unroll 16
        for (int k = 0; k < 32; ++k) { const float er = ES[(r0 + k) * 128 + p], ei = ES[(r0 + k) * 128 + 64 + p]; const float nr = lr * hr - li * hi + er, ni = lr * hi + li * hr + ei; hr = nr; hi = ni; }
        __syncthreads();
        SEG[(w * 64 + lane) * 2] = hr; SEG[(w * 64 + lane) * 2 + 1] = hi;
        float pr = lr, pi = li;
#pragma unroll
        for (int q = 0; q < 5; ++q) { const float nr = pr * pr - pi * pi, ni = 2.f * pr * pi; pr = nr; pi = ni; }
        __syncthreads();
        hr = 0.f; hi = 0.f;
        for (int u = 0; u < w; ++u) { const float er = SEG[(u * 64 + lane) * 2], ei = SEG[(u * 64 + lane) * 2 + 1]; const float nr = pr * hr - pi * hi + er, ni = pr * hi + pi * hr + ei; hr = nr; hi = ni; }
#pragma unroll 16
        for (int k = 0; k < 32; ++k) { const float er = ES[(r0 + k) * 128 + p], ei = ES[(r0 + k) * 128 + 64 + p];
            XH[(r0 + k) * 384 + 256 + p] = f2bf(hr); XH[(r0 + k) * 384 + 320 + p] = f2bf(hi);
            const float nr = lr * hr - li * hi + er, ni = lr * hi + li * hr + ei; hr = nr; hi = ni; }
    }
    __syncthreads();
}

#define MFMA32(a, b, c) __builtin_amdgcn_mfma_f32_32x32x16_bf16((a), (b), (c), 0, 0, 0)
constexpr int AT_KROW = 384, AT_VROW = 256, AT_KBYTES = 64 * AT_KROW, AT_STG = AT_KBYTES + 64 * AT_VROW, AT_NST = 3;
static_assert(AT_NST * AT_STG <= RING_BYTES, "attention LDS");
DI void mla_attn_unit(LAS unsigned char* lds, const bf16* Qg, const bf16* KFg, const bf16* Vg, bf16* MIX, int unit, int wv) {
    const int tid = otid(wv), lane = tid & 63, w = tid >> 6, r = lane & 31, hh = lane >> 5;
    const int b = unit >> 6, h = (unit >> 3) & 7, pi = unit & 7;
    const bf16* Qh = Qg + (size_t)(b * 8 + h) * SEQ * 192; const bf16* Kh = KFg + (size_t)(b * 8 + h) * SEQ * 192; const bf16* Vh = Vg + (size_t)(b * 8 + h) * SEQ * 128;
    const int w_ = __builtin_amdgcn_readfirstlane(w);
    int koff[3], voff[2];
#pragma unroll
    for (int i = 0; i < 3; ++i) { const int p = (3 * w_ + i) * 64 + lane, row = p / 24, cs = p % 24, c = (cs & ~7) | ((cs ^ (row >> 1)) & 7); koff[i] = row * 192 + c * 8; }
#pragma unroll
    for (int i = 0; i < 2; ++i) { const int p = (2 * w_ + i) * 64 + lane, row = p >> 4, cs = p & 15, c = cs ^ ((row & 3) << 2); voff[i] = row * 128 + c * 8; }
    const int kx = (r >> 1) & 7, vq = (lane >> 2) & 3;
    for (int half = 0; half < 2; ++half) {
        const int qb = half ? 15 - pi : pi, q0 = qb * 256 + 32 * w, nkt = (qb + 1) * 4;
        bf16x8 qf[12];
#pragma unroll
        for (int ks = 0; ks < 12; ++ks) qf[ks] = *(const GAS bf16x8*)P32(Qh, (q0 + r) * 192 + 16 * ks + 8 * hh);
        f32x16 O[4];
#pragma unroll
        for (int i = 0; i < 4; ++i) for (int e = 0; e < 16; ++e) O[i][e] = 0.f;
        float mrow = -1e30f, lrow = 0.f;
#define AT_DMA(kt, stg) do { LAS unsigned char* sb_ = lds + (stg) * AT_STG; \
        _Pragma("unroll") for (int i = 0; i < 3; ++i) __builtin_amdgcn_global_load_lds((const unsigned*)P32(Kh, (kt) * 64 * 192 + koff[i]), (LAS unsigned*)(sb_ + (3 * w_ + i) * 1024), 16, 0, 0); \
        _Pragma("unroll") for (int i = 0; i < 2; ++i) __builtin_amdgcn_global_load_lds((const unsigned*)P32(Vh, (kt) * 64 * 128 + voff[i]), (LAS unsigned*)(sb_ + AT_KBYTES + (2 * w_ + i) * 1024), 16, 0, 0); } while (0)
#define AT_BAR() do { asm volatile("s_waitcnt lgkmcnt(0)" ::: "memory"); __builtin_amdgcn_s_barrier(); asm volatile("" ::: "memory"); } while (0)
        __syncthreads();
        AT_DMA(0, 0); AT_DMA(1, 1);
        asm volatile("s_waitcnt vmcnt(5)" ::: "memory");
        AT_BAR();
        int stg = 0;
        for (int kt = 0; kt < nkt; ++kt) {
            if (kt + 2 < nkt) AT_DMA(kt + 2, stg == 0 ? 2 : stg - 1);
            const LAS unsigned char* sb = lds + stg * AT_STG;
            if (kt * 64 <= q0 + 31) {
                f32x16 st[2];
#pragma unroll
                for (int mt = 0; mt < 2; ++mt) for (int e = 0; e < 16; ++e) st[mt][e] = 0.f;
                __builtin_amdgcn_sched_barrier(0);
                {
                    const LAS unsigned char* kb = sb + r * AT_KROW; const LAS unsigned char* kx4[4];
#pragma unroll
                    for (int j = 0; j < 4; ++j) kx4[j] = kb + (((2 * j + hh) ^ kx) & 7) * 16;
                    bf16x8 kf[24];
#pragma unroll
                    for (int i = 0; i < 24; ++i) kf[i] = *(const LAS bf16x8*)(kx4[(i >> 1) & 3] + 32 * (i & 1) * AT_KROW + 128 * (i >> 3));
#pragma unroll
                    for (int i = 0; i < 24; ++i) st[i & 1] = MFMA32(kf[i], qf[i >> 1], st[i & 1]);
                    __builtin_amdgcn_sched_group_barrier(0x100, 4, 0);
#pragma unroll
                    for (int i = 0; i < 24; ++i) { __builtin_amdgcn_sched_group_barrier(0x008, 1, 0); __builtin_amdgcn_sched_group_barrier(0x100, 1, 0); }
                }
                __builtin_amdgcn_sched_barrier(0);
                if (kt * 64 + 63 > q0) {
                    const int qg = q0 + r;
#pragma unroll
                    for (int mt = 0; mt < 2; ++mt)
#pragma unroll
                        for (int e = 0; e < 16; ++e) { const int kg = kt * 64 + 32 * mt + (e & 3) + 8 * (e >> 2) + 4 * hh; if (kg > qg) st[mt][e] = -1e30f; }
                }
                float mx = st[0][0];
#pragma unroll
                for (int mt = 0; mt < 2; ++mt)
#pragma unroll
                    for (int e = 0; e < 16; ++e) mx = fmaxf(mx, st[mt][e]);
                mx = fmaxf(mx, __shfl_xor(mx, 32));
                float alpha = 1.f;
                if (__any(mx - mrow > 8.f)) { const float mnew = fmaxf(mrow, mx); alpha = __builtin_amdgcn_exp2f(mrow - mnew); mrow = mnew;
#pragma unroll
                    for (int i = 0; i < 4; ++i) O[i] *= alpha; }
                float ls = 0.f;
#pragma unroll
                for (int mt = 0; mt < 2; ++mt)
#pragma unroll
                    for (int e = 0; e < 16; ++e) { const float p = __builtin_amdgcn_exp2f(st[mt][e] - mrow); st[mt][e] = p; ls += p; }
                lrow = lrow * alpha + ls;
                bf16x8 pf[2][2];
#pragma unroll
                for (int mt = 0; mt < 2; ++mt)
#pragma unroll
                    for (int s = 0; s < 2; ++s) { u32x4 pk = {pk2(st[mt][8 * s], st[mt][8 * s + 1]), pk2(st[mt][8 * s + 2], st[mt][8 * s + 3]), pk2(st[mt][8 * s + 4], st[mt][8 * s + 5]), pk2(st[mt][8 * s + 6], st[mt][8 * s + 7])};
                        pf[mt][s] = __builtin_bit_cast(bf16x8, pk); }
                __builtin_amdgcn_sched_barrier(0);
                {
                    const LAS unsigned char* vb = sb + AT_KBYTES + (4 * hh + vq) * AT_VROW + 32 * ((lane >> 4) & 1) + 8 * (lane & 3); const LAS unsigned char* vx4[4];
#pragma unroll
                    for (int d = 0; d < 4; ++d) vx4[d] = vb + ((d ^ vq) & 3) * 64;
                    bf16x8 af[16];
#pragma unroll
                    for (int i = 0; i < 16; ++i) { const LAS unsigned char* vp = vx4[i & 3] + 16 * (i >> 2) * AT_VROW;
                        const s16x4 lo = __builtin_amdgcn_ds_read_tr16_b64_v4i16((LAS s16x4*)vp), hi = __builtin_amdgcn_ds_read_tr16_b64_v4i16((LAS s16x4*)(vp + 8 * AT_VROW)); af[i] = __builtin_shufflevector(lo, hi, 0, 1, 2, 3, 4, 5, 6, 7); }
#pragma unroll
                    for (int i = 0; i < 16; ++i) O[i & 3] = MFMA32(af[i], pf[i >> 3][(i >> 2) & 1], O[i & 3]);
                    __builtin_amdgcn_sched_group_barrier(0x100, 8, 0);
#pragma unroll
                    for (int i = 0; i < 16; ++i) { __builtin_amdgcn_sched_group_barrier(0x008, 1, 0); __builtin_amdgcn_sched_group_barrier(0x100, 2, 0); }
                }
                __builtin_amdgcn_sched_barrier(0);
            }
            if (kt + 2 < nkt) asm volatile("s_waitcnt vmcnt(5)" ::: "memory"); else asm volatile("s_waitcnt vmcnt(0)" ::: "memory");
            AT_BAR();
            stg = stg == 2 ? 0 : stg + 1;
        }
        lrow += __shfl_xor(lrow, 32);
        const float inv = 1.f / lrow;
        unsigned char* mx_ = (unsigned char*)MIX; unsigned char* orow = P32(mx_, (b * SEQ + q0 + r) * 2048 + h * 128);
#pragma unroll
        for (int dvt = 0; dvt < 4; ++dvt)
#pragma unroll
            for (int g4 = 0; g4 < 4; ++g4) *(GAS unsigned*)(orow + dvt * 32 + 8 * g4 + 4 * hh) = pk4_fp8(O[dvt][4 * g4] * inv, O[dvt][4 * g4 + 1] * inv, O[dvt][4 * g4 + 2] * inv, O[dvt][4 * g4 + 3] * inv);
    }
#undef AT_DMA
#undef AT_BAR
}

DI void ln_router_phase(const KArgs& a, LAS unsigned char* lds, int layer, const bf16* XPRE, bf16* X1, bf16* H, int wv) {
    const int tid = otid(wv), lane = tid & 63, wave = tid >> 6;
    LAS float* wT = (LAS float*)lds;
    { f32x4 rw[4][4];
#pragma unroll
      for (int i = 0; i < 4; ++i)
#pragma unroll
          for (int q4 = 0; q4 < 4; ++q4) rw[i][q4] = *(const f32x4*)(a.in[I_RW] + (size_t)(tid + 512 * i) * 16 + 4 * q4);
#pragma unroll
      for (int i = 0; i < 4; ++i)
#pragma unroll
          for (int q4 = 0; q4 < 4; ++q4)
#pragma unroll
              for (int e4 = 0; e4 < 4; ++e4) wT[(4 * q4 + e4) * 2048 + tid + 512 * i] = rw[i][q4][e4]; }
    __syncthreads();
    const float* MODl = (const float*)(a.ws + CTL_MOD) + (size_t)layer * 4 * 12288;
    const float* lg = a.in[I_LNMG] + layer * D; const float* lb = a.in[I_LNMB] + layer * D;
    unsigned* cnt = (unsigned*)(a.ws + CTL_CNT) + layer * 16 * 64;
    LAS int* lcnt = (LAS int*)(lds + LDS_MISC + 256); LAS int* lbase = lcnt + 16; LAS int* rec = lcnt + 32;
    if (tid < 16) lcnt[tid] = 0;
    int* RTE = (int*)(a.ws + A_RT); int* RTP = RTE + 2 * T; float* RTW = (float*)(RTP + 2 * T); int* TOKL = (int*)(a.ws + A_TOKL);
    const LAS float* wp[16];
#pragma unroll
    for (int e = 0; e < 16; ++e) { wp[e] = wT + e * 2048 + lane * 4; asm volatile("" : "+v"(wp[e])); }
    const float rbl = a.in[I_RB][lane >> 2];
    int lr = wave;
    for (int m = blockIdx.x * 8 + wave; m < T; m += gridDim.x * 8, lr += 8) {
        const int b = m / SEQ; const float* sh = MODl + (size_t)b * 12288 + 3 * 2048; const float* sc = sh + 2048;
        f32x4 v[8]; float s = 0.f;
#pragma unroll
        for (int j = 0; j < 8; ++j) { const u32x2 xp = *(const GAS u32x2*)(XPRE + (size_t)m * D + (lane + 64 * j) * 4); v[j] = (f32x4){bflo(xp.x), bfhi(xp.x), bflo(xp.y), bfhi(xp.y)}; s += (v[j].x + v[j].y) + (v[j].z + v[j].w); }
        const float mean = wave_sum(s) * (1.f / D); float s2 = 0.f;
#pragma unroll
        for (int j = 0; j < 8; ++j) { v[j] = v[j] - mean; s2 += (v[j].x * v[j].x + v[j].y * v[j].y) + (v[j].z * v[j].z + v[j].w * v[j].w); }
        const float rstd = rsqrtf(wave_sum(s2) * (1.f / D) + LN_EPS);
#pragma unroll
        for (int j = 0; j < 8; ++j) { const int col = (lane + 64 * j) * 4; const f32x4 x1 = v[j] * rstd * *(const f32x4*)(lg + col) + *(const f32x4*)(lb + col);
            { u32x2 ox = {pk2(x1.x, x1.y), pk2(x1.z, x1.w)}; *(GAS u32x2*)(X1 + (size_t)m * D + col) = ox; }
            const f32x4 hv = x1 * (*(const f32x4*)(sc + col) + 1.f) + *(const f32x4*)(sh + col);
            *(GAS unsigned*)((unsigned char*)H + (size_t)m * D + col) = pk4_fp8(hv.x, hv.y, hv.z, hv.w); v[j] = hv; }
        f32x2 part2[16];
#pragma unroll
        for (int e = 0; e < 16; ++e) part2[e] = (f32x2){0.f, 0.f};
#pragma unroll
        for (int j = 0; j < 8; ++j) { f32x4 wr_[16];
#pragma unroll
            for (int e = 0; e < 16; ++e) wr_[e] = *(const LAS f32x4*)(wp[e] + j * 256);
            __builtin_amdgcn_sched_barrier(0);
#pragma unroll
            for (int e = 0; e < 16; ++e) { part2[e] += (f32x2){v[j].x, v[j].y} * (f32x2){wr_[e].x, wr_[e].y}; part2[e] += (f32x2){v[j].z, v[j].w} * (f32x2){wr_[e].z, wr_[e].w}; }
            __builtin_amdgcn_sched_barrier(0); }
        float part[16];
#pragma unroll
        for (int e = 0; e < 16; ++e) part[e] = part2[e].x + part2[e].y;
        float r8[8], r4[4], r2[2], lg1;
        { const bool hi = lane & 32;
#pragma unroll
          for (int i = 0; i < 8; ++i) { const float mine = hi ? part[8 + i] : part[i], oth = hi ? part[i] : part[8 + i]; r8[i] = mine + __shfl_xor(oth, 32); } }
        { const bool hi = lane & 16;
#pragma unroll
          for (int i = 0; i < 4; ++i) { const float mine = hi ? r8[4 + i] : r8[i], oth = hi ? r8[i] : r8[4 + i]; r4[i] = mine + __shfl_xor(oth, 16); } }
        { const bool hi = lane & 8;
#pragma unroll
          for (int i = 0; i < 2; ++i) { const float mine = hi ? r4[2 + i] : r4[i], oth = hi ? r4[i] : r4[2 + i]; r2[i] = mine + __shfl_xor(oth, 8); } }
        { const bool hi = lane & 4; const float mine = hi ? r2[1] : r2[0], oth = hi ? r2[0] : r2[1]; lg1 = mine + __shfl_xor(oth, 4); }
        lg1 += dpp_xor1(lg1); lg1 += dpp_xor2(lg1);
        const float sgl = 1.f / (1.f + expf(-lg1)), sbl = sgl + rbl;
        float gs; { const float y1 = dpp_ror<4>(sbl), y2 = dpp_ror<8>(sbl), y3 = dpp_ror<12>(sbl);
            gs = fmaxf(fmaxf(fmaxf(sbl + y1, sbl + y2), fmaxf(sbl + y3, y1 + y2)), fmaxf(y1 + y3, y2 + y3)); }
        int bg = 0; float bgs = __builtin_bit_cast(float, __builtin_amdgcn_readlane(__builtin_bit_cast(int, gs), 0)); asm volatile("" : "+v"(bgs));
#pragma unroll
        for (int g = 1; g < 4; ++g) { float x = __builtin_bit_cast(float, __builtin_amdgcn_readlane(__builtin_bit_cast(int, gs), 16 * g)); asm volatile("" : "+v"(x)); const bool c = x > bgs; bgs = c ? x : bgs; bg = c ? g : bg; }
        const int bgu = __builtin_amdgcn_readfirstlane(bg);
        int e0 = 0, e1 = 0; float b0 = -1e30f, b1 = -1e30f, s0 = 0.f, s1 = 0.f;
#pragma unroll
        for (int i = 0; i < 4; ++i) { float x = __builtin_bit_cast(float, __builtin_amdgcn_readlane(__builtin_bit_cast(int, sbl), 16 * bgu + 4 * i)), sx = __builtin_bit_cast(float, __builtin_amdgcn_readlane(__builtin_bit_cast(int, sgl), 16 * bgu + 4 * i));
            asm volatile("" : "+v"(x), "+v"(sx)); const int e = 4 * bg + i; const bool g0 = x > b0, g1 = x > b1;
            b1 = g0 ? b0 : (g1 ? x : b1); e1 = g0 ? e0 : (g1 ? e : e1); s1 = g0 ? s0 : (g1 ? sx : s1);
            b0 = g0 ? x : b0; e0 = g0 ? e : e0; s0 = g0 ? sx : s0; }
        if (lane == 0) { const float inv = 1.f / (s0 + s1);
            const int p0 = __hip_atomic_fetch_add(lcnt + e0, 1, __ATOMIC_RELAXED, __HIP_MEMORY_SCOPE_WORKGROUP), p1 = __hip_atomic_fetch_add(lcnt + e1, 1, __ATOMIC_RELAXED, __HIP_MEMORY_SCOPE_WORKGROUP);
            rec[lr * 4] = m; rec[lr * 4 + 1] = e0; rec[lr * 4 + 2] = e1; rec[lr * 4 + 3] = p0 | (p1 << 16);
            RTE[2 * m] = e0; RTE[2 * m + 1] = e1; RTW[2 * m] = s0 * inv; RTW[2 * m + 1] = s1 * inv; }
    }
    __syncthreads();
    if (tid < 16) lbase[tid] = (int)atomicAdd(cnt + tid * 64, (unsigned)lcnt[tid]);
    __syncthreads();
    const int nrows = (T - (int)blockIdx.x * 8 + (int)gridDim.x * 8 - 1) / ((int)gridDim.x * 8) * 8;
    for (int i = tid; i < nrows; i += 512) { const int k = i >> 3, w8 = i & 7, m = (int)blockIdx.x * 8 + w8 + k * (int)gridDim.x * 8;
        if (m < T) { const int e0 = rec[i * 4 + 1], e1 = rec[i * 4 + 2], pp = rec[i * 4 + 3], q0 = lbase[e0] + (pp & 0xffff), q1 = lbase[e1] + (pp >> 16);
            TOKL[e0 * T + q0] = m; TOKL[e1 * T + q1] = m; RTP[2 * m] = q0; RTP[2 * m + 1] = q1; } }
    __syncthreads();
}

DI void moe_table(const KArgs& a, LAS unsigned char* lds, int layer, int wv) {
    LAS int* tab = (LAS int*)(lds + LDS_TAB);
    if (otid(wv) == 0) { const unsigned* cnt = (const unsigned*)(a.ws + CTL_CNT) + layer * 16 * 64; int acc = 0;
        for (int e = 0; e < 16; ++e) { const int c = (int)cnt[e * 64]; tab[e] = acc; tab[32 + e] = c; acc += (c + 255) >> 8; } tab[16] = acc; }
    __syncthreads();
}
template <int NTB> struct MoeOrder {
    int G, c, layer; const LAS int* tab; const int* tokl;
    DI bool next(int i, Unit& u) const { const int L = i * G + c, mt = L / NTB, nt = L % NTB; if (mt >= tab[16]) return false; int e = 0;
#pragma unroll
        for (int k = 1; k < 16; ++k) e += (mt >= tab[k]) ? 1 : 0;
        u.pm = mt; u.pn = (layer * 16 + e) * NTB + nt; u.aux = e | (nt << 8) | ((mt - tab[e]) << 16); return true; }
    DI int arow(const Unit& u, int r) const { const int e = u.aux & 255, j = (u.aux >> 16) * 256 + r; return j < tab[32 + e] ? tokl[e * T + j] : 0; }
    DI int koff(const Unit&) const { return 0; }
};
struct EpiGateUp { static constexpr bool PERM = true;
    unsigned char* ACT;
    DI void operator()(const Acc& acc, const Unit& u, int wr, int wc, int fr, int fq) const {
        const int nt = (u.aux >> 8) & 255;
        EPI_ROWS_BEGIN
            const f32x4 g0 = acc[ai][0][m][0], g1 = acc[ai][0][m][1], u0 = acc[ai][1][m][0], u1 = acc[ai][1][m][1];
            f32x4 o0, o1;
#pragma unroll
            for (int e = 0; e < 4; ++e) { o0[e] = g0[e] * sigmoidf_(g0[e]) * u0[e]; o1[e] = g1[e] * sigmoidf_(g1[e]) * u1[e]; }
            u32x2 o8 = {pk4_fp8(o0.x, o0.y, o0.z, o0.w), pk4_fp8(o1.x, o1.y, o1.z, o1.w)}; *(u32x2*)P32(ACT, row * 512 + nt * 128 + 32 * wc + 8 * fq) = o8;
        EPI_ROWS_END
    }
};
struct EpiDown { static constexpr bool PERM = true;
    bf16* YS;
    DI void operator()(const Acc& acc, const Unit& u, int wr, int wc, int fr, int fq) const {
        const int nt = (u.aux >> 8) & 255;
        EPI_ROWS_BEGIN
#pragma unroll
            for (int bj = 0; bj < 2; ++bj) *(u32x4*)P32(YS, row * 2048 + nt * 256 + 128 * bj + 32 * wc + 8 * fq) = pack8(acc[ai][bj][m][0], acc[ai][bj][m][1]);
        EPI_ROWS_END
    }
};
DI void ln_ffn_phase(const KArgs& a, int layer, const bf16* X1, float* XO, bf16* Hn, int wv) {
    const int lane = otid(wv) & 63, wave = otid(wv) >> 6;
    const float* MODl = (const float*)(a.ws + CTL_MOD) + (size_t)layer * 4 * 12288; const float* MODn = MODl + 4 * 12288;
    const float* lg = a.in[I_LNFG] + layer * D; const float* lb = a.in[I_LNFB] + layer * D;
    const unsigned* cnt = (const unsigned*)(a.ws + CTL_CNT) + layer * 16 * 64;
    const int* RTE = (const int*)(a.ws + A_RT); const int* RTP = RTE + 2 * T; const float* RTW = (const float*)(RTP + 2 * T); const bf16* YS = (const bf16*)(a.ws + A_YS);
    for (int m = blockIdx.x * 8 + wave; m < T; m += gridDim.x * 8) {
        const int b = m / SEQ; const float* gf = MODl + (size_t)b * 12288 + 5 * 2048;
        const int e0 = RTE[2 * m], e1 = RTE[2 * m + 1]; int t0 = 0, t1 = 0;
        for (int e = 0; e < 16; ++e) { const int tl = ((int)cnt[e * 64] + 255) >> 8; t0 += e < e0 ? tl : 0; t1 += e < e1 ? tl : 0; }
        const bf16* y0 = YS + ((size_t)t0 * 256 + RTP[2 * m]) * 2048; const bf16* y1 = YS + ((size_t)t1 * 256 + RTP[2 * m + 1]) * 2048; const float w0 = RTW[2 * m], w1 = RTW[2 * m + 1];
        f32x4 v[8]; float s = 0.f;
#pragma unroll
        for (int j = 0; j < 8; ++j) { const int col = (lane + 64 * j) * 4; const u32x2 a0 = *(const u32x2*)(y0 + col), a1 = *(const u32x2*)(y1 + col);
            const f32x4 y = {w0 * bflo(a0.x) + w1 * bflo(a1.x), w0 * bfhi(a0.x) + w1 * bfhi(a1.x), w0 * bflo(a0.y) + w1 * bflo(a1.y), w0 * bfhi(a0.y) + w1 * bfhi(a1.y)};
            const u32x2 xq = *(const u32x2*)(X1 + (size_t)m * D + col); const f32x4 xv = {bflo(xq.x), bfhi(xq.x), bflo(xq.y), bfhi(xq.y)};
            v[j] = xv * DN_ALPHA + (*(const f32x4*)(gf + col) + 1.f) * y; s += (v[j].x + v[j].y) + (v[j].z + v[j].w); }
        const float mean = wave_sum(s) * (1.f / D); float s2 = 0.f;
#pragma unroll
        for (int j = 0; j < 8; ++j) { v[j] = v[j] - mean; s2 += (v[j].x * v[j].x + v[j].y * v[j].y) + (v[j].z * v[j].z + v[j].w * v[j].w); }
        const float rstd = rsqrtf(wave_sum(s2) * (1.f / D) + LN_EPS);
#pragma unroll
        for (int j = 0; j < 8; ++j) { const int col = (lane + 64 * j) * 4; const f32x4 xo = v[j] * rstd * *(const f32x4*)(lg + col) + *(const f32x4*)(lb + col);
            if (Hn) { u32x2 oq = {pk2(xo.x, xo.y), pk2(xo.z, xo.w)}; *(u32x2*)((bf16*)XO + (size_t)m * D + col) = oq; }
            else *(f32x4*)(XO + (size_t)m * D + col) = xo;
            if (Hn) { const float* sh = MODn + (size_t)b * 12288; const f32x4 hv = xo * (*(const f32x4*)(sh + 2048 + col) + 1.f) + *(const f32x4*)(sh + col);
                *(unsigned*)((unsigned char*)Hn + (size_t)m * D + col) = pk4_fp8(hv.x, hv.y, hv.z, hv.w); } }
    }
}

struct EpiIn1 { static constexpr bool PERM = true;
    bf16 *ZD, *ZR;
    DI void operator()(const Acc& acc, const Unit& u, int wr, int wc, int fr, int fq) const {
        EPI_ROWS_BEGIN
#pragma unroll
            for (int bj = 0; bj < 2; ++bj) { const int col = u.pn * 256 + 128 * bj + 32 * wc + 8 * fq; const u32x4 o = pack8(acc[ai][bj][m][0], acc[ai][bj][m][1]);
                if (col < DIL_IN) *(u32x4*)P32(ZD, row * DIL_IN + col) = o; else if (col < ODD_IN) *(u32x4*)P32(ZR, row * RW_IN + (col - DIL_IN)) = o; }
        EPI_ROWS_END
    }
};
constexpr int DA_KSTR = 272, DA_VROW = 320, DA_KBYTES = 64 * DA_KSTR, DA_STG = DA_KBYTES + 64 * DA_VROW;
struct DilPre { bf16x8 qf[4]; u32x4 kreg[2], vreg[2]; float blv[2]; };
DI void dil_issue(const bf16* ZD, const float* BL, int unit, int wv, DilPre& P) {
    const int tid = otid(wv), lane = tid & 63, w = tid >> 6, r = lane & 31, hh = lane >> 5, hd = w >> 2, qs = w & 3;
    const int hp = unit & 3, sb_ = (unit >> 2) & 31, gi = (unit >> 7) % 3, b = unit / 384;
    const int dil = gi == 0 ? 1 : (gi == 1 ? 4 : 16), nb = 32 / dil, rr = sb_ / nb, n = sb_ % nb, h = hp * 2 + hd, kt0 = n == 0 ? 2 : 0;
    const bf16* Zb = ZD + (size_t)b * SEQ * DIL_IN + gi * 1536;
    const int qtok = (n * 128 + 32 * qs + r) * dil + rr;
#pragma unroll
    for (int k = 0; k < 2; ++k) { const int i = tid + 512 * k, hd_ = i >= 384 ? 1 : 0, d = i - 384 * hd_ - 127;
        P.blv[k] = (i < 768 && d >= 0 && d <= 128) ? ((const GAS float*)BL)[(gi * 8 + hp * 2 + hd_) * 132 + d] : -1e30f; }
#pragma unroll
    for (int ks = 0; ks < 4; ++ks) P.qf[ks] = *(const GAS bf16x8*)P32(Zb, qtok * DIL_IN + h * 64 + 16 * ks + 8 * hh);
#pragma unroll
    for (int i = 0; i < 2; ++i) { const int p = tid + 512 * i, kr = p >> 4, c16 = p & 15; const int ktok = ((n - 1) * 128 + kt0 * 64 + kr) * dil + rr;
        P.kreg[i] = *(const GAS u32x4*)P32(Zb, ktok * DIL_IN + 512 + hp * 128 + c16 * 8); P.vreg[i] = *(const GAS u32x4*)P32(Zb, ktok * DIL_IN + 1024 + hp * 128 + c16 * 8); }
}
DI void dil_attn_unit(LAS unsigned char* lds, const bf16* ZD, const float* BL, bf16* DPO, float* DPM, float* DPL, int unit, int next, DilPre& P, int wv) {
    const int tid = otid(wv), lane = tid & 63, w = tid >> 6, r = lane & 31, hh = lane >> 5, hd = w >> 2, qs = w & 3;
    const int hp = unit & 3, sb_ = (unit >> 2) & 31, gi = (unit >> 7) % 3, b = unit / 384;
    const int dil = gi == 0 ? 1 : (gi == 1 ? 4 : 16), nb = 32 / dil, rr = sb_ / nb, n = sb_ % nb;
    const int h = hp * 2 + hd;
    const bf16* Zb = ZD + (size_t)b * SEQ * DIL_IN + gi * 1536;
    LAS float* bl = (LAS float*)(lds + 2 * DA_STG);
    __syncthreads();
    bl[tid] = P.blv[0]; if (tid < 256) bl[512 + tid] = P.blv[1];
    const int qi = 32 * qs + r, qtok = (n * 128 + qi) * dil + rr;
    bf16x8 qf[4];
#pragma unroll
    for (int ks = 0; ks < 4; ++ks) qf[ks] = P.qf[ks];
    f32x16 O[2];
#pragma unroll
    for (int i = 0; i < 2; ++i) for (int e = 0; e < 16; ++e) O[i][e] = 0.f;
    float mrow = -1e30f, lrow = 0.f;
    u32x4 kreg[2] = {P.kreg[0], P.kreg[1]}, vreg[2] = {P.vreg[0], P.vreg[1]};
    const int kt0 = n == 0 ? 2 : 0;
#define DA_LOAD(kt) do { _Pragma("unroll") for (int i = 0; i < 2; ++i) { const int p = tid + 512 * i, kr = p >> 4, c16 = p & 15; const int ktok = ((n - 1) * 128 + (kt) * 64 + kr) * dil + rr; \
            kreg[i] = *(const GAS u32x4*)P32(Zb, ktok * DIL_IN + 512 + hp * 128 + c16 * 8); } \
        _Pragma("unroll") for (int i = 0; i < 2; ++i) { const int p = tid + 512 * i, kr = p >> 4, c16 = p & 15; const int ktok = ((n - 1) * 128 + (kt) * 64 + kr) * dil + rr; vreg[i] = *(const GAS u32x4*)P32(Zb, ktok * DIL_IN + 1024 + hp * 128 + c16 * 8); } } while (0)
#define DA_STORE(buf) do { LAS unsigned char* sb = lds + (buf) * DA_STG; _Pragma("unroll") for (int i = 0; i < 2; ++i) { const int p = tid + 512 * i, kr = p >> 4, c16 = p & 15; *(LAS u32x4*)(sb + kr * DA_KSTR + c16 * 16) = kreg[i]; } \
        _Pragma("unroll") for (int i = 0; i < 2; ++i) { const int p = tid + 512 * i; *(LAS u32x4*)(sb + DA_KBYTES + (p >> 4) * DA_VROW + (p & 15) * 16) = vreg[i]; } } while (0)
    DA_STORE(kt0 & 1);
    __syncthreads();
    for (int kt = kt0; kt < 4; ++kt) {
        if (kt + 1 < 4) DA_LOAD(kt + 1); else if (next >= 0) dil_issue(ZD, BL, next, wv, P);
        const LAS unsigned char* sb = lds + (kt & 1) * DA_STG;
        if (64 * kt + 63 >= 32 * qs && 64 * kt <= 32 * qs + 31 + 128) {
            f32x16 st[2];
#pragma unroll
            for (int mt = 0; mt < 2; ++mt) for (int e = 0; e < 16; ++e) st[mt][e] = 0.f;
            __builtin_amdgcn_sched_barrier(0);
            {
                const LAS unsigned char* kb = sb + r * DA_KSTR + (hd * 64 + 8 * hh) * 2; bf16x8 kf[8];
#pragma unroll
                for (int i = 0; i < 8; ++i) kf[i] = *(const LAS bf16x8*)(kb + 32 * (i & 1) * DA_KSTR + 32 * (i >> 1));
#pragma unroll
                for (int i = 0; i < 8; ++i) st[i & 1] = MFMA32(kf[i], qf[i >> 1], st[i & 1]);
                __builtin_amdgcn_sched_group_barrier(0x100, 3, 0);
#pragma unroll
                for (int i = 0; i < 8; ++i) { __builtin_amdgcn_sched_group_barrier(0x008, 1, 0); __builtin_amdgcn_sched_group_barrier(0x100, 1, 0); }
            }
            __builtin_amdgcn_sched_barrier(0);
#pragma unroll
            for (int mt = 0; mt < 2; ++mt) { const LAS float* lp = bl + hd * 384 + 127 + (128 + qi - 64 * kt - 32 * mt - 4 * hh) - 27;
#pragma unroll
                for (int e = 0; e < 16; ++e) st[mt][e] = st[mt][e] * (0.125f * 1.44269504089f) + lp[27 - ((e & 3) + 8 * (e >> 2))]; }
            float mx = st[0][0];
#pragma unroll
            for (int mt = 0; mt < 2; ++mt)
#pragma unroll
                for (int e = 0; e < 16; ++e) mx = fmaxf(mx, st[mt][e]);
            mx = fmaxf(mx, __shfl_xor(mx, 32));
            float alpha = 1.f;
            if (__any(mx - mrow > 8.f)) { const float mnew = fmaxf(mrow, mx); alpha = __builtin_amdgcn_exp2f(mrow - mnew); mrow = mnew; O[0] *= alpha; O[1] *= alpha; }
            float ls = 0.f;
#pragma unroll
            for (int mt = 0; mt < 2; ++mt)
#pragma unroll
                for (int e = 0; e < 16; ++e) { const float p = __builtin_amdgcn_exp2f(st[mt][e] - mrow); st[mt][e] = p; ls += p; }
            lrow = lrow * alpha + ls;
            bf16x8 pf[2][2];
#pragma unroll
            for (int mt = 0; mt < 2; ++mt)
#pragma unroll
                for (int s = 0; s < 2; ++s) { u32x4 pk = {pk2(st[mt][8 * s], st[mt][8 * s + 1]), pk2(st[mt][8 * s + 2], st[mt][8 * s + 3]), pk2(st[mt][8 * s + 4], st[mt][8 * s + 5]), pk2(st[mt][8 * s + 6], st[mt][8 * s + 7])};
                    pf[mt][s] = __builtin_bit_cast(bf16x8, pk); }
            __builtin_amdgcn_sched_barrier(0);
            {
                const LAS unsigned char* vb = sb + DA_KBYTES + (4 * hh + ((lane >> 2) & 3)) * DA_VROW + (hd * 64 + 16 * ((lane >> 4) & 1)) * 2 + 8 * (lane & 3); bf16x8 af[8];
#pragma unroll
                for (int i = 0; i < 8; ++i) { const LAS unsigned char* vp = vb + 16 * (i >> 1) * DA_VROW + (i & 1) * 64;
                    const s16x4 lo = __builtin_amdgcn_ds_read_tr16_b64_v4i16((LAS s16x4*)vp), hi = __builtin_amdgcn_ds_read_tr16_b64_v4i16((LAS s16x4*)(vp + 8 * DA_VROW)); af[i] = __builtin_shufflevector(lo, hi, 0, 1, 2, 3, 4, 5, 6, 7); }
#pragma unroll
                for (int i = 0; i < 8; ++i) O[i & 1] = MFMA32(af[i], pf[i >> 2][(i >> 1) & 1], O[i & 1]);
                __builtin_amdgcn_sched_group_barrier(0x100, 6, 0);
#pragma unroll
                for (int i = 0; i < 8; ++i) { __builtin_amdgcn_sched_group_barrier(0x008, 1, 0); __builtin_amdgcn_sched_group_barrier(0x100, 2, 0); }
            }
            __builtin_amdgcn_sched_barrier(0);
        }
        if (kt + 1 < 4) DA_STORE((kt + 1) & 1);
        __syncthreads();
    }
    lrow += __shfl_xor(lrow, 32);
    const float inv = 1.f / lrow;
    const int tokg = b * SEQ + qtok;
    bf16* orow = P32(DPO, (gi * T + tokg) * 512 + h * 64);
#pragma unroll
    for (int dvt = 0; dvt < 2; ++dvt)
#pragma unroll
        for (int g4 = 0; g4 < 4; ++g4) { u32x2 o = {pk2(O[dvt][4 * g4] * inv, O[dvt][4 * g4 + 1] * inv), pk2(O[dvt][4 * g4 + 2] * inv, O[dvt][4 * g4 + 3] * inv)};
            *(GAS u32x2*)(orow + dvt * 32 + 8 * g4 + 4 * hh) = o; }
    if (hh == 0) { *(GAS float*)P32(DPM, (gi * T + tokg) * 8 + h) = mrow; *(GAS float*)P32(DPL, (gi * T + tokg) * 8 + h) = lrow; }
#undef DA_LOAD
#undef DA_STORE
}
DI void dil_merge(const bf16* DPO, const float* DPM, const float* DPL, bf16* MIX, int wv) {
    const int gt = blockIdx.x * 512 + otid(wv), NT_ = gridDim.x * 512;
    for (int i = gt; i < T * 64; i += NT_) { const int tok = i >> 6, c8 = i & 63, h = c8 >> 3;
        float m[3], l[3];
#pragma unroll
        for (int g = 0; g < 3; ++g) { m[g] = DPM[((size_t)g * T + tok) * 8 + h]; l[g] = DPL[((size_t)g * T + tok) * 8 + h]; }
        const float M = fmaxf(m[0], fmaxf(m[1], m[2])); float wsum = 0.f, wg[3];
#pragma unroll
        for (int g = 0; g < 3; ++g) { wg[g] = __builtin_amdgcn_exp2f(m[g] - M) * l[g]; wsum += wg[g]; }
        const float inv = __builtin_amdgcn_rcpf(wsum); float o[8];
#pragma unroll
        for (int e = 0; e < 8; ++e) o[e] = 0.f;
#pragma unroll
        for (int g = 0; g < 3; ++g) { const u32x4 v = *(const u32x4*)(DPO + ((size_t)g * T + tok) * 512 + c8 * 8); const float wn = wg[g] * inv;
            o[0] += wn * bflo(v.x); o[1] += wn * bfhi(v.x); o[2] += wn * bflo(v.y); o[3] += wn * bfhi(v.y); o[4] += wn * bflo(v.z); o[5] += wn * bfhi(v.z); o[6] += wn * bflo(v.w); o[7] += wn * bfhi(v.w); }
        u32x2 r = {pk4_fp8(o[0], o[1], o[2], o[3]), pk4_fp8(o[4], o[5], o[6], o[7])}; *(u32x2*)((unsigned char*)MIX + (size_t)tok * 2048 + c8 * 8) = r; }
}

DI void rwkv_prep(const bf16* ZR, const float* mu, bf16* LIN, int wv) {
    const int gt = blockIdx.x * 512 + otid(wv), NT_ = gridDim.x * 512;
    for (int i = gt; i < T * 48; i += NT_) { const int tok = i / 48, c0 = (i % 48) * 8, s = tok % SEQ; float o[8];
        if (c0 < 352) { const u32x4 z = *(const u32x4*)(ZR + (size_t)tok * RW_IN + 4608 + c0); u32x4 zp = {0u, 0u, 0u, 0u}; if (s > 0) zp = *(const u32x4*)(ZR + (size_t)(tok - 1) * RW_IN + 4608 + c0);
            const unsigned* zz = (const unsigned*)&z; const unsigned* pp = (const unsigned*)&zp;
#pragma unroll
            for (int e = 0; e < 8; ++e) { const float zv = (e & 1) ? bfhi(zz[e >> 1]) : bflo(zz[e >> 1]), pv = (e & 1) ? bfhi(pp[e >> 1]) : bflo(pp[e >> 1]); const float xs = zv + (pv - zv) * mu[4608 + c0 + e];
                o[e] = c0 < 64 ? 1.f - 2.f * __builtin_amdgcn_rcpf(1.f + __expf(2.f * xs)) : (c0 < 128 ? xs : sigmoidf_(xs)); } }
        else {
#pragma unroll
            for (int e = 0; e < 8; ++e) o[e] = 0.f; }
        u32x4 r = {pk2(o[0], o[1]), pk2(o[2], o[3]), pk2(o[4], o[5]), pk2(o[6], o[7])}; *(u32x4*)(LIN + (size_t)tok * 384 + c0) = r; }
}
struct LoraOrder : pg8::StaticOrder { DI int koff(const Unit& u) const { return u.pn >= 12 ? 128 : 0; } };
struct EpiLora { static constexpr bool PERM = true;
    bf16 *WDEC, *AA, *GG; const float *w0, *a0;
    DI void operator()(const Acc& acc, const Unit& u, int wr, int wc, int fr, int fq) const {
        const int kind = u.pn / 6;
        EPI_ROWS_BEGIN
#pragma unroll
            for (int bj = 0; bj < 2; ++bj) { const int col = (u.pn % 6) * 256 + 128 * bj + 32 * wc + 8 * fq; f32x4 v0 = acc[ai][bj][m][0], v1 = acc[ai][bj][m][1];
                if (kind == 0) { const f32x4 b0 = *(const f32x4*)P32(w0, col), b1 = *(const f32x4*)P32(w0, col + 4);
#pragma unroll
                    for (int e = 0; e < 4; ++e) { v0[e] = -0.6065306597f * sigmoidf_(v0[e] + b0[e]); v1[e] = -0.6065306597f * sigmoidf_(v1[e] + b1[e]); }
                    *(u32x4*)P32(WDEC, row * RWW + col) = pack8(v0, v1); }
                else if (kind == 1) { const f32x4 b0 = *(const f32x4*)P32(a0, col), b1 = *(const f32x4*)P32(a0, col + 4);
#pragma unroll
                    for (int e = 0; e < 4; ++e) { v0[e] = sigmoidf_(v0[e] + b0[e]); v1[e] = sigmoidf_(v1[e] + b1[e]); }
                    *(u32x4*)P32(AA, row * RWW + col) = pack8(v0, v1); }
                else *(u32x4*)P32(GG, row * RWW + col) = pack8(v0, v1); }
        EPI_ROWS_END
    }
};
constexpr int CK_AT = 0, CK_RT = 2048, CK_BH = 4096, CK_KH = 6144, CK_MT = 8192, CK_NK = 8704, CK_PB = 9216, CK_PK = 9728, CK_G15 = 10240, CK_VT = 10496  , CK_VTS = 40, CK_BS = 13056  , CK_SLOT = 13120;
constexpr int CK_HALF = 128;
constexpr int CK_N1 = (int)((128 * MiB) / CK_SLOT) - 1;
DI unsigned char* ck_slot(unsigned char* ws, int job) { return job < CK_N1 ? ws + WS_X1 + (size_t)job * CK_SLOT : ws + WS_W_GU + (size_t)(job - CK_N1) * CK_SLOT; }
static_assert((size_t)(96 * CK_HALF - CK_N1 + 1) * CK_SLOT <= 64 * MiB, "chunk buffer");
constexpr int PJ = 4;
constexpr int PL_AT = 0, PL_BT = 2304, PL_KT = 4608, PL_RT = 6912, PL_BH = 9216, PL_KH = 11520  ,
              PL_NAB = 13824  , PL_MTS = 14848  , PL_LDT = 15616  , PL_C = 19968  ,
              PL_T = 24064  , PL_VT = 24320  , PL_END = 26880;
static_assert(PJ * PL_END <= RING_BYTES && PJ == 4, "prep LDS");
DI bf16x8 ldfrag(const LAS unsigned char* p) { return *(const LAS bf16x8*)p; }
DI u32x4 ld2x8(const LAS unsigned char* p0, const LAS unsigned char* p1) { const u32x2 lo = *(const LAS u32x2*)p0, hi = *(const LAS u32x2*)p1; return (u32x4){lo.x, lo.y, hi.x, hi.y}; }
DI void unpk8(const u32x4 v, float (&o)[8]) { o[0] = bflo(v.x); o[1] = bfhi(v.x); o[2] = bflo(v.y); o[3] = bfhi(v.y); o[4] = bflo(v.z); o[5] = bfhi(v.z); o[6] = bflo(v.w); o[7] = bfhi(v.w); }
DI void ldf8(const float* p, float (&o)[8]) { const f32x4 x = *(const f32x4*)p, y = *(const f32x4*)(p + 4); o[0] = x.x; o[1] = x.y; o[2] = x.z; o[3] = x.w; o[4] = y.x; o[5] = y.y; o[6] = y.z; o[7] = y.w; }
DI u32x4 pack8(const float (&x)[8]) { return (u32x4){pk2(x[0], x[1]), pk2(x[2], x[3]), pk2(x[4], x[5]), pk2(x[6], x[7])}; }
DI void rwkv_chunk_prep(const KArgs& a, LAS unsigned char* lds0, int half, int wv) {
    const int tid = otid(wv), lane = tid & 63, w = tid >> 6;
    const bf16* ZR = (const bf16*)(a.ws + A_ZR); const bf16* WDEC = (const bf16*)(a.ws + A_WDEC); const bf16* AA = (const bf16*)(a.ws + A_AA);
    const int js = tid >> 7, st = (tid >> 3) & 15, oc = tid & 7;
    LAS unsigned char* ldj = lds0 + js * PL_END;
    const float* mu = a.in[I_MU];
    bf16x8 lfrag;
#pragma unroll
    for (int j = 0; j < 8; ++j) lfrag[j] = ((lane & 31) >= 16 || 8 * (lane >> 5) + j <= (lane & 31)) ? (short)0x3F80 : (short)0;
    for (int it = blockIdx.x; it < 96 * CK_HALF / PJ; it += gridDim.x) {
        const int job0 = it * PJ, bh = job0 / CK_HALF, cl0 = job0 % CK_HALF, b = bh / 24, h = bh % 24, col = h * 64 + 8 * oc;
        const int s = (half * CK_HALF + cl0 + js) * 16 + st; const size_t tok = (size_t)b * SEQ + s;
        unsigned char* slot = ck_slot(a.ws, job0 + js);
        const bf16* z = ZR + tok * RW_IN + col;
        const u32x4 zr = *(const u32x4*)z, zk = *(const u32x4*)(z + 1536), zv = *(const u32x4*)(z + 3072);
        u32x4 pr = {0u, 0u, 0u, 0u}, pk_ = {0u, 0u, 0u, 0u}, pv = {0u, 0u, 0u, 0u};
        if (s > 0) { pr = *(const u32x4*)(z - RW_IN); pk_ = *(const u32x4*)(z - RW_IN + 1536); pv = *(const u32x4*)(z - RW_IN + 3072); }
        const u32x4 za = *(const u32x4*)(AA + tok * RWW + col), zw = *(const u32x4*)(WDEC + tok * RWW + col);
        float r[8], km[8], q[8], bb[8], ld[8];
        {   float cz[8], cp[8], m_[8], k_[8], v_[8], as_[8], c1[8], c2[8];
            unpk8(zr, cz); unpk8(pr, cp); ldf8(mu + col, m_);
#pragma unroll
            for (int e = 0; e < 8; ++e) r[e] = cz[e] + (cp[e] - cz[e]) * m_[e];
            unpk8(zk, cz); unpk8(pk_, cp); ldf8(mu + 1536 + col, m_);
#pragma unroll
            for (int e = 0; e < 8; ++e) k_[e] = cz[e] + (cp[e] - cz[e]) * m_[e];
            unpk8(zv, cz); unpk8(pv, cp); ldf8(mu + 3072 + col, m_);
#pragma unroll
            for (int e = 0; e < 8; ++e) v_[e] = cz[e] + (cp[e] - cz[e]) * m_[e];
            unpk8(za, as_); unpk8(zw, ld); ldf8(a.in[I_KK] + col, c1);
            float nn = 0.f;
#pragma unroll
            for (int e = 0; e < 8; ++e) { q[e] = k_[e] * c1[e]; nn += q[e] * q[e]; }
            nn = red8(nn);
            const float invn = fminf(__builtin_amdgcn_rsqf(nn), 1e12f);
            ldf8(a.in[I_KA] + col, c1); ldf8(a.in[I_RK] + col, c2);
            float bs = 0.f;
#pragma unroll
            for (int e = 0; e < 8; ++e) { q[e] *= invn; km[e] = k_[e] * (1.f + (as_[e] - 1.f) * c1[e]); bb[e] = q[e] * as_[e]; bs += r[e] * km[e] * c2[e]; }
            bs = red8(bs);
            if (oc == 0) *(float*)(slot + CK_BS + st * 4) = bs;
#pragma unroll
            for (int e = 0; e < 8; ++e) *(LAS float*)(ldj + PL_LDT + ((8 * oc + e) * 17 + st) * 4) = ld[e];
#pragma unroll
            for (int e = 0; e < 8; e += 2) { const unsigned pv2 = pk2(v_[e], v_[e + 1]);
                *(LAS bf16*)(ldj + PL_VT + (8 * oc + e) * CK_VTS + st * 2) = (bf16)(pv2 & 0xffffu); *(LAS bf16*)(ldj + PL_VT + (8 * oc + e + 1) * CK_VTS + st * 2) = (bf16)(pv2 >> 16); } }
        __syncthreads();
        {
            LAS unsigned char* lds = lds0 + (w >> 1) * PL_END; const int r_ = lane & 31, hh = lane >> 5, ch = 32 * (w & 1) + r_;
            float x[8];
#pragma unroll
            for (int j = 0; j < 8; ++j) x[j] = *(const LAS float*)(lds + PL_LDT + (ch * 17 + 8 * hh + j) * 4);
            const u32x4 ph = {pk2(x[0], x[1]), pk2(x[2], x[3]), pk2(x[4], x[5]), pk2(x[6], x[7])};
            const u32x4 pl = {pk2(x[0] - bflo(ph.x), x[1] - bfhi(ph.x)), pk2(x[2] - bflo(ph.y), x[3] - bfhi(ph.y)), pk2(x[4] - bflo(ph.z), x[5] - bfhi(ph.z)), pk2(x[6] - bflo(ph.w), x[7] - bfhi(ph.w))};
            f32x16 cs; for (int e = 0; e < 16; ++e) cs[e] = 0.f;
            cs = MFMA32(lfrag, __builtin_bit_cast(bf16x8, ph), cs); cs = MFMA32(lfrag, __builtin_bit_cast(bf16x8, pl), cs);
#pragma unroll
            for (int e = 0; e < 8; ++e) *(LAS float*)(lds + PL_C + (((e & 3) + 8 * (e >> 2) + 4 * hh) * 64 + ch) * 4) = cs[e];
            if (hh == 0) *(LAS float*)(lds + PL_T + ch * 4) = cs[8]; }
        __syncthreads();
        {
            float c[8], t[8];
            { const f32x4 ca = *(const LAS f32x4*)(ldj + PL_C + (st * 64 + 8 * oc) * 4), cb = *(const LAS f32x4*)(ldj + PL_C + (st * 64 + 8 * oc + 4) * 4), ta = *(const LAS f32x4*)(ldj + PL_T + 8 * oc * 4), tb = *(const LAS f32x4*)(ldj + PL_T + (8 * oc + 4) * 4);
              c[0] = ca.x; c[1] = ca.y; c[2] = ca.z; c[3] = ca.w; c[4] = cb.x; c[5] = cb.y; c[6] = cb.z; c[7] = cb.w; t[0] = ta.x; t[1] = ta.y; t[2] = ta.z; t[3] = ta.w; t[4] = tb.x; t[5] = tb.y; t[6] = tb.z; t[7] = tb.w; }
            float at[8], bt[8], kt[8], rt[8], bhv[8], khv[8];
#pragma unroll
            for (int e = 0; e < 8; ++e) { const float g = __expf(c[e]), gp = __expf(c[e] - ld[e]), gi = __expf(-c[e]), gr = __expf(t[e] - c[e]);
                at[e] = -q[e] * gp; bt[e] = bb[e] * gi; kt[e] = km[e] * gi; rt[e] = r[e] * g; bhv[e] = bb[e] * gr; khv[e] = km[e] * gr; }
            LAS unsigned char* row = ldj + st * 144 + oc * 16;
            *(LAS u32x4*)(row + PL_AT) = pack8(at); *(LAS u32x4*)(row + PL_BT) = pack8(bt); *(LAS u32x4*)(row + PL_KT) = pack8(kt); *(LAS u32x4*)(row + PL_RT) = pack8(rt);
            *(LAS u32x4*)(row + PL_BH) = pack8(bhv); *(LAS u32x4*)(row + PL_KH) = pack8(khv);
            if (st == 0) { *(f32x4*)(slot + CK_G15 + 8 * oc * 4) = (f32x4){__expf(t[0]), __expf(t[1]), __expf(t[2]), __expf(t[3])}; *(f32x4*)(slot + CK_G15 + (8 * oc + 4) * 4) = (f32x4){__expf(t[4]), __expf(t[5]), __expf(t[6]), __expf(t[7])}; } }
        __syncthreads();
        if (w < PJ) {
            LAS unsigned char* lds = lds0 + w * PL_END; unsigned char* slot = ck_slot(a.ws, job0 + w); const int r = lane & 31, hh = lane >> 5, r16 = r & 15;
            f32x16 d; for (int e = 0; e < 16; ++e) d[e] = 0.f;
#pragma unroll
            for (int ks = 0; ks < 4; ++ks) d = MFMA32(ldfrag(lds + (r < 16 ? PL_BT : PL_KT) + r16 * 144 + ks * 32 + hh * 16), ldfrag(lds + (r < 16 ? PL_AT : PL_RT) + r16 * 144 + ks * 32 + hh * 16), d);
            float lo8[8], hi8[8];
#pragma unroll
            for (int e = 0; e < 8; ++e) { const int sr = (e & 3) + 8 * (e >> 2) + 4 * hh; const bool keep = r < 16 ? sr < r16 : sr <= r16; lo8[e] = keep ? d[e] : 0.f; hi8[e] = keep ? d[8 + e] : 0.f; }
            const u32x4 plo = {pk2(lo8[0], lo8[1]), pk2(lo8[2], lo8[3]), pk2(lo8[4], lo8[5]), pk2(lo8[6], lo8[7])}, phi = {pk2(hi8[0], hi8[1]), pk2(hi8[2], hi8[3]), pk2(hi8[4], hi8[5]), pk2(hi8[6], hi8[7])};
            if (r < 16) {
#pragma unroll
                for (int e = 0; e < 8; ++e) *(LAS float*)(lds + PL_NAB + (((e & 3) + 8 * (e >> 2) + 4 * hh) * 16 + r16) * 4) = lo8[e];
                *(u32x4*)(slot + CK_NK + (r16 + 16 * hh) * 16) = phi; }
            else { *(u32x4*)(slot + CK_PB + (r16 + 16 * hh) * 16) = plo; *(u32x4*)(slot + CK_PK + (r16 + 16 * hh) * 16) = phi; }
            asm volatile("s_waitcnt lgkmcnt(0)" ::: "memory");
            if (lane < 16) { float mr[16]; int ln = lane; asm volatile("" : "+v"(ln));
#pragma unroll
                for (int t = 0; t < 16; ++t) { float acc = (ln == t) ? 1.f : 0.f;
#pragma unroll
                    for (int u = 0; u < t; ++u) acc += mr[u] * *(const LAS float*)(lds + PL_NAB + (u * 16 + t) * 4);
                    mr[t] = acc; *(LAS bf16*)(lds + PL_MTS + t * 48 + lane * 2) = f2bf(acc); } }
            asm volatile("s_waitcnt lgkmcnt(0)" ::: "memory");
            if (r < 16) *(u32x4*)(slot + CK_MT + (r + 16 * hh) * 16) = ld2x8(lds + PL_MTS + r * 48 + 8 * hh, lds + PL_MTS + r * 48 + 16 + 8 * hh);
        } else {
            const int e2 = tid - 256;
#pragma unroll
            for (int q4 = 0; q4 < PJ; ++q4) { const LAS unsigned char* lds = lds0 + q4 * PL_END; unsigned char* slot = ck_slot(a.ws, job0 + q4);
                { const int arr = e2 >> 7, i7 = e2 & 127, ks = i7 >> 5, t = i7 & 15, hh = (i7 >> 4) & 1;
                  const LAS unsigned char* p = lds + (arr ? PL_RT : PL_AT) + t * 144 + (16 * ks + 4 * hh) * 2;
                  *(u32x4*)(slot + (arr ? CK_RT : CK_AT) + (ks * 32 + t + 16 * hh) * 16) = ld2x8(p, p + 16); }
                { const int arr = e2 >> 7, J = (e2 >> 6) & 1;
                  const LAS unsigned char* p = lds + (arr ? PL_KH : PL_BH) + (4 * (lane >> 5) + ((lane >> 2) & 3)) * 144 + (32 * J + 16 * ((lane >> 4) & 1)) * 2 + 8 * (lane & 3);
                  const s16x4 lo = __builtin_amdgcn_ds_read_tr16_b64_v4i16((LAS s16x4*)p), hi = __builtin_amdgcn_ds_read_tr16_b64_v4i16((LAS s16x4*)(p + 8 * 144));
                  *(bf16x8*)(slot + (arr ? CK_KH : CK_BH) + (J * 64 + lane) * 16) = __builtin_shufflevector(lo, hi, 0, 1, 2, 3, 4, 5, 6, 7); }
                if (e2 < 160) *(u32x4*)(slot + CK_VT + e2 * 16) = *(const LAS u32x4*)(lds + PL_VT + e2 * 16); }
        }
    }
    __syncthreads();
}
constexpr int RC_NS = 8, RC_SLOT = 15360, RC_GG = 13312, RC_AHEAD = 6, RC_Y = RC_NS * RC_SLOT;
static_assert(RC_Y + 8192 <= RING_BYTES && CK_SLOT <= RC_GG, "rwkv ring");
template <int PM = 0> DI void rwkv_chunk_rec(const KArgs& a, LAS unsigned char* lds, int unit, int half, int wv) {
    const int tid = otid(wv), lane = tid & 63, w = __builtin_amdgcn_readfirstlane(tid >> 6), r = lane & 31, hh = lane >> 5;
    const int b = unit / 24, h = unit % 24;
    float* GST = (float*)(a.ws + A_GST) + (size_t)unit * 4096;
    const unsigned char* GGb = a.ws + A_GG; bf16* MIX = (bf16*)(a.ws + WS_H);
#define RC_DMA(srcp, dstp) __builtin_amdgcn_global_load_lds((const unsigned*)(srcp), (LAS unsigned*)(dstp), 16, 0, 0)
#define RC_ISSUE(cc) do { if ((PM & 1) == 0 && (w == 4 || w == 5)) { const unsigned char* src = ck_slot(a.ws, unit * CK_HALF + (cc)) + lane * 16; LAS unsigned char* dst = lds + ((cc) % RC_NS) * RC_SLOT; \
        if (w == 4) { _Pragma("unroll") for (int i_ = 0; i_ < 8; ++i_) RC_DMA(src + i_ * 1024, dst + i_ * 1024); } \
        else { _Pragma("unroll") for (int i_ = 8; i_ < 13; ++i_) RC_DMA(src + i_ * 1024, dst + i_ * 1024); \
            const unsigned char* gsrc = GGb + ((size_t)b * SEQ + (half * CK_HALF + (cc)) * 16 + (lane >> 3)) * (RWW * 2) + h * 128 + (lane & 7) * 16; \
            RC_DMA(gsrc, dst + RC_GG); RC_DMA(gsrc + 8 * RWW * 2, dst + RC_GG + 1024); } } } while (0)
#define RC_BAR() do { asm volatile("s_waitcnt lgkmcnt(0)" ::: "memory"); __builtin_amdgcn_s_barrier(); asm volatile("" ::: "memory"); } while (0)
    const bool epi = (w & 2) != 0; const int et = 4 * ((w & 1) + 2 * (w >> 2)) + (lane >> 4), eiq = lane & 15, ecol = h * 64 + 4 * eiq;
    const f32x4 elg = *(const f32x4*)(a.in[I_LNXG] + ecol), elb = *(const f32x4*)(a.in[I_LNXB] + ecol);
#define RC_EPI(sp, Yp, tokv) do { const f32x4 y = *(const LAS f32x4*)((Yp) + et * 64 + 4 * eiq); const u32x2 gq = *(const LAS u32x2*)((sp) + RC_GG + et * 128 + eiq * 8); \
        const float bsv = *(const LAS float*)((sp) + CK_BS + et * 4); const LAS unsigned char* vq = (sp) + CK_VT + 4 * eiq * CK_VTS + et * 2; \
        const f32x4 v4 = {bflo(*(const LAS unsigned short*)vq), bflo(*(const LAS unsigned short*)(vq + CK_VTS)), bflo(*(const LAS unsigned short*)(vq + 2 * CK_VTS)), bflo(*(const LAS unsigned short*)(vq + 3 * CK_VTS))}; \
        const float mean = red16((y.x + y.y) + (y.z + y.w)) * (1.f / 64.f); const f32x4 d = y - mean; \
        const float rstd = __builtin_amdgcn_rsqf(red16((d.x * d.x + d.y * d.y) + (d.z * d.z + d.w * d.w)) * (1.f / 64.f) + 64e-5f); \
        const f32x4 gg4 = {bflo(gq.x), bfhi(gq.x), bflo(gq.y), bfhi(gq.y)}, o = (d * rstd * elg + elb + v4 * bsv) * gg4; \
        if (PM == 0 || o.x == 1.2345f) *(unsigned*)((unsigned char*)MIX + (size_t)(tokv) * 2048 + 512 + ecol) = pk4_fp8(o.x, o.y, o.z, o.w); } while (0)
    f32x16 G0, G1;
#pragma unroll
    for (int e = 0; e < 16; ++e) { G0[e] = 0.f; G1[e] = 0.f; }
    if (half == 1 && w < 2) {
#pragma unroll
        for (int e = 0; e < 16; ++e) { G0[e] = GST[(w * 2 + 0) * 1024 + e * 64 + lane]; G1[e] = GST[(w * 2 + 1) * 1024 + e * 64 + lane]; } }
    __syncthreads();
#pragma unroll
    for (int cc = 0; cc < RC_AHEAD; ++cc) RC_ISSUE(cc);
    asm volatile("s_waitcnt vmcnt(0)" ::: "memory");
    RC_BAR();
    bf16x8 pAR[4], pNP, pVT;
#define RC_PRE(slotp) do { const LAS unsigned char* sp_ = (slotp); _Pragma("unroll") for (int ks = 0; ks < 4; ++ks) pAR[ks] = ldfrag(sp_ + ((r >> 4) ? CK_RT : CK_AT) + (ks * 32 + (r & 15) + 16 * hh) * 16); \
        pNP = ldfrag(sp_ + ((r >> 4) ? CK_PK : CK_NK) + ((r & 15) + 16 * hh) * 16); \
        { const LAS unsigned char* vq_ = sp_ + CK_VT + (32 * w + r) * CK_VTS + 8 * hh; const s16x4 vlo_ = *(const LAS s16x4*)vq_, vhi_ = *(const LAS s16x4*)(vq_ + 16); pVT = __builtin_shufflevector(vlo_, vhi_, 0, 1, 2, 3, 4, 5, 6, 7); } } while (0)
    if (w < 2) RC_PRE(lds);
    for (int c = 0; c < CK_HALF; ++c) {
        if (c + RC_AHEAD < CK_HALF) RC_ISSUE(c + RC_AHEAD);
        const LAS unsigned char* sb = lds + (c % RC_NS) * RC_SLOT;
        if (w < 2) {
            const int r16 = r & 15, up = r >> 4;
            bf16x8 fAR[4], fBH0, fBH1, fKH0, fKH1, fM, fNP, fPB; f32x4 gs0[4], gs1[4];
#pragma unroll
            for (int ks = 0; ks < 4; ++ks) fAR[ks] = pAR[ks];
            fNP = pNP; const bf16x8 vtf = pVT;
            __builtin_amdgcn_sched_barrier(0);
            fM = ldfrag(sb + CK_MT + (r16 + 16 * hh) * 16); fPB = ldfrag(sb + CK_PB + (r16 + 16 * hh) * 16);
            fBH0 = ldfrag(sb + CK_BH + lane * 16); fBH1 = ldfrag(sb + CK_BH + (64 + lane) * 16); fKH0 = ldfrag(sb + CK_KH + lane * 16); fKH1 = ldfrag(sb + CK_KH + (64 + lane) * 16);
#pragma unroll
            for (int g4 = 0; g4 < 4; ++g4) { gs0[g4] = *(const LAS f32x4*)(sb + CK_G15 + (8 * g4 + 4 * hh) * 4); gs1[g4] = *(const LAS f32x4*)(sb + CK_G15 + (32 + 8 * g4 + 4 * hh) * 4); }
            __builtin_amdgcn_sched_barrier(0);
            bf16x8 gf[4];
#pragma unroll
            for (int s2 = 0; s2 < 2; ++s2) { u32x4 p0 = {pk2(G0[8 * s2], G0[8 * s2 + 1]), pk2(G0[8 * s2 + 2], G0[8 * s2 + 3]), pk2(G0[8 * s2 + 4], G0[8 * s2 + 5]), pk2(G0[8 * s2 + 6], G0[8 * s2 + 7])};
                u32x4 p1 = {pk2(G1[8 * s2], G1[8 * s2 + 1]), pk2(G1[8 * s2 + 2], G1[8 * s2 + 3]), pk2(G1[8 * s2 + 4], G1[8 * s2 + 5]), pk2(G1[8 * s2 + 6], G1[8 * s2 + 7])};
                gf[s2] = __builtin_bit_cast(bf16x8, p0); gf[2 + s2] = __builtin_bit_cast(bf16x8, p1); }
            f32x16 XY;
#pragma unroll
            for (int e = 0; e < 16; ++e) XY[e] = 0.f;
#pragma unroll
            for (int ks = 0; ks < 4; ++ks) XY = MFMA32(fAR[ks], gf[ks], XY);
            XY = MFMA32(fNP, vtf, XY);
            { u32x4 px = {pk2(XY[0], XY[1]), pk2(XY[2], XY[3]), pk2(XY[4], XY[5]), pk2(XY[6], XY[7])}; const bf16x8 xf = __builtin_bit_cast(bf16x8, px);
              f32x16 U; for (int e = 0; e < 16; ++e) U[e] = 0.f;
              U = MFMA32(fM, xf, U);
              u32x4 pu = {pk2(U[0], U[1]), pk2(U[2], U[3]), pk2(U[4], U[5]), pk2(U[6], U[7])}; const bf16x8 uf = __builtin_bit_cast(bf16x8, pu);
              XY = MFMA32(fPB, uf, XY);
#pragma unroll
              for (int e = 0; e < 16; ++e) { G0[e] *= gs0[e >> 2][e & 3]; G1[e] *= gs1[e >> 2][e & 3]; }
              G0 = MFMA32(fBH0, uf, G0); G1 = MFMA32(fBH1, uf, G1); G0 = MFMA32(fKH0, vtf, G0); G1 = MFMA32(fKH1, vtf, G1); }
            __builtin_amdgcn_sched_barrier(0);
            if (c + 1 < CK_HALF) RC_PRE(lds + ((c + 1) % RC_NS) * RC_SLOT);
            LAS float* Y = (LAS float*)(lds + RC_Y + (c & 1) * 4096);
#pragma unroll
            for (int e = 0; e < 8; ++e) Y[((e & 3) + 8 * (e >> 2) + 4 * hh) * 64 + 32 * w + r] = XY[8 + e];
        } else if (epi) {
            if (c > 0) RC_EPI(lds + ((c - 1) % RC_NS) * RC_SLOT, (const LAS float*)(lds + RC_Y + ((c - 1) & 1) * 4096), (size_t)b * SEQ + (half * CK_HALF + c - 1) * 16 + et);
        } else {
            if (c + RC_AHEAD >= CK_HALF) asm volatile("s_waitcnt vmcnt(0)" ::: "memory"); else if (w == 4) asm volatile("s_waitcnt vmcnt(32)" ::: "memory"); else asm volatile("s_waitcnt vmcnt(28)" ::: "memory");
        }
        RC_BAR();
    }
    if (epi) RC_EPI(lds + ((CK_HALF - 1) % RC_NS) * RC_SLOT, (const LAS float*)(lds + RC_Y + ((CK_HALF - 1) & 1) * 4096), (size_t)b * SEQ + (half * CK_HALF + CK_HALF - 1) * 16 + et);
    else if (w < 2 && half == 0 && (PM == 0 || G0[0] == 1.2345f)) {
#pragma unroll
        for (int e = 0; e < 16; ++e) { GST[(w * 2 + 0) * 1024 + e * 64 + lane] = G0[e]; GST[(w * 2 + 1) * 1024 + e * 64 + lane] = G1[e]; } }
    asm volatile("s_waitcnt vmcnt(0)" ::: "memory");
    __syncthreads();
#undef RC_PRE
#undef RC_EPI
#undef RC_DMA
#undef RC_ISSUE
#undef RC_BAR
}

constexpr int N_PHASES = 25;
__global__ void __launch_bounds__(512, 2) fwd(KArgs a) {
    extern __shared__ __attribute__((aligned(16))) unsigned char lds_[];
    LAS unsigned char* lds = (LAS unsigned char*)lds_;
    const int wv = __builtin_amdgcn_readfirstlane((int)threadIdx.x >> 6), G = gridDim.x, bid = blockIdx.x;
    volatile LAS unsigned* MISC = (volatile LAS unsigned*)(lds + LDS_MISC);
    if (wv == 0) MISC[lane_id()] = 0u;
    __syncthreads();
    unsigned char* ws0 = a.ws;
#if N_LAUNCH_MODE == 0
    XcdBarrier bar = xcd_barrier_post((unsigned*)(ws0 + CTL_BAR), MISC + 8, wv);
#ifdef DBG_TIME_K1
#define SEAM(k) do { if (IN(k) && IN((k) + 1)) xcd_barrier(bar); if (bid == 0 && wv == 0 && lane_id() == 0) ((unsigned long long*)(ws0 + CTL_CHK))[1 + (k)] = __builtin_amdgcn_s_memrealtime(); } while (0)
#else
#define SEAM(k) do { if (IN(k) && IN((k) + 1)) xcd_barrier(bar); } while (0)
#endif
#else
#define SEAM(k) do { } while (0)
#endif
    const int lo = a.ph_lo, hi = a.ph_hi;
#ifdef DBG_TIME_K1
    if (bid == 0 && wv == 0 && lane_id() == 0) ((unsigned long long*)(ws0 + CTL_CHK))[0] = __builtin_amdgcn_s_memrealtime();
#endif
#ifndef PH_MASK
#define PH_MASK 0xFFFFFFFFu
#endif
#define IN(k) (((PH_MASK >> (k)) & 1u) && lo <= (k) && (k) < hi)
#ifndef REP_REC
#define REP_REC 0
#endif
#ifndef REP_DIL
#define REP_DIL 0
#endif
#ifndef REPEAT_MASK
#define REPEAT_MASK 0u
#endif
#define PH(k) for (int rp_ = 0; rp_ < (IN(k) ? 1 + (int)((REPEAT_MASK >> (k)) & 1u) : 0); ++rp_)
#define MOD ((float*)(ws + CTL_MOD))
#define Hb ((bf16*)(ws + WS_H))
#define X1 ((bf16*)(ws + WS_X1))
#define XPRE ((bf16*)(ws + A_XPRE))
    pg8::StaticOrder SO;

    PH(0) { unsigned char* ws = wsl(a.ws); p0_prologue(a, lds, wv); } SEAM(0);
    PH(1) { unsigned char* ws = wsl(a.ws); modulate_rows(a.in[I_X], (const unsigned long long*)(ws + CTL_MODI), MOD, Hb, wv); } SEAM(1);
    PH(2) { unsigned char* ws = wsl(a.ws); pg8::Gemm g{Hb, (const bf16*)(ws + WS_W_IN0), 2048, 2048, 2048}; SO.init(T, 2048, G, bid);
        EpiIn0 E{(bf16*)(ws + A_QC), (bf16*)(ws + A_KVC), (bf16*)(ws + A_KR), (bf16*)(ws + A_XH), (float*)(ws + CTL_SSQ)};
        pg8::gemm_phase<EpiIn0, pg8::StaticOrder, false, true>(lds, g, SO, E, wv); } SEAM(2);
    PH(3) { unsigned char* ws = wsl(a.ws);
        krope_pass((const bf16*)(ws + A_KR), (const float*)(ws + WS_ROPE), (bf16*)(ws + A_KF), wv);
        { pg8::Gemm g{(const bf16*)(ws + A_QC), (const bf16*)(ws + WS_W_UQ), 512, 512, 512}; SO.init(T, 1536, G, bid);
          EpiQ E{(bf16*)(ws + A_Q), (const float*)(ws + CTL_SSQ), (const float*)(ws + WS_ROPE)}; pg8::gemm_phase<EpiQ, pg8::StaticOrder, false>(lds, g, SO, E, wv); }
        { pg8::Gemm g{(const bf16*)(ws + A_KVC), (const bf16*)(ws + WS_W_UKV), 256, 256, 256}; SO.init(T, 2048, G, bid);
          EpiKV E{(bf16*)(ws + A_KF), (bf16*)(ws + A_V), (const float*)(ws + CTL_SSQ)}; pg8::gemm_phase<EpiKV, pg8::StaticOrder, false>(lds, g, SO, E, wv); }
        { pg8::Gemm g{(const bf16*)(ws + A_XH), (const bf16*)(ws + WS_S5BE), 384, 256, 256}; S5Order S{G, bid}; EpiS5E E{(float*)(ws + A_ES)}; pg8::gemm_phase<EpiS5E, S5Order, false>(lds, g, S, E, wv); }
    } SEAM(3);
    PH(4) { unsigned char* ws = wsl(a.ws);
        s5_carry((const float*)(ws + A_ES), (const float*)(ws + WS_S5L), (bf16*)(ws + A_XH), lds, wv);
        for (int u = bid; u < 256; u += G) mla_attn_unit(lds, (const bf16*)(ws + A_Q), (const bf16*)(ws + A_KF), (const bf16*)(ws + A_V), Hb, u, wv);
    } SEAM(4);
    PH(5) { unsigned char* ws = wsl(a.ws); pg8::Gemm g{(const bf16*)(ws + A_XH), (const bf16*)(ws + WS_S5BY), 384, 384, 384}; S5Order S{G, bid};
        EpiS5Y E{(bf16*)(ws + A_YS5), (const bf16*)(ws + A_XH), a.in[I_S5D]}; pg8::gemm_phase<EpiS5Y, S5Order, false>(lds, g, S, E, wv); } SEAM(5);
    PH(6) { unsigned char* ws = wsl(a.ws); pg8::Gemm g{(const bf16*)(ws + A_YS5), (const bf16*)(ws + WS_W_GLU), 1024, 1024, 1024}; SO.init(T, 1024, G, bid);
        EpiGlu E{Hb, (const bf16*)(ws + A_YS5)}; pg8::gemm_phase<EpiGlu, pg8::StaticOrder, false>(lds, g, SO, E, wv); } SEAM(6);
    PH(7) { unsigned char* ws = wsl(a.ws); pg8::Gemm g{Hb, (const bf16*)(ws + WS_W_OUT0), 2048, 2048, 2048}; SO.init(T, 2048, G, bid);
        EpiRes<false> E{XPRE, a.in[I_X], MOD + 2 * 2048}; pg8::gemm_phase<EpiRes<false>, pg8::StaticOrder, false, true>(lds, g, SO, E, wv); } SEAM(7);
#define MOE_PHASES(layer, pb) \
        PH(pb) { unsigned char* ws = wsl(a.ws); ln_router_phase(a, lds, layer, XPRE, X1, Hb, wv); } SEAM(pb); \
        PH(pb + 1) { unsigned char* ws = wsl(a.ws); moe_table(a, lds, layer, wv); pg8::Gemm g{Hb, (const bf16*)(ws + WS_W_GU8), 2048, 2048, 2048}; \
            MoeOrder<4> S{G, bid, layer, (const LAS int*)(lds + LDS_TAB), (const int*)(ws + A_TOKL)}; EpiGateUp E{ws + A_ACT}; pg8::gemm_phase<EpiGateUp, MoeOrder<4>, true, true>(lds, g, S, E, wv); } SEAM(pb + 1); \
        PH(pb + 2) { unsigned char* ws = wsl(a.ws); moe_table(a, lds, layer, wv); pg8::Gemm g{(const bf16*)(ws + A_ACT), (const bf16*)(ws + WS_W_DN), 512, 512, 512}; \
            MoeOrder<8> S{G, bid, layer, (const LAS int*)(lds + LDS_TAB), (const int*)(ws + A_TOKL)}; EpiDown E{(bf16*)(ws + A_YS)}; pg8::gemm_phase<EpiDown, MoeOrder<8>, false, true>(lds, g, S, E, wv); } SEAM(pb + 2); \
        PH(pb + 3) { unsigned char* ws = wsl(a.ws); ln_ffn_phase(a, layer, X1, a.out, layer == 0 ? Hb : nullptr, wv); } SEAM(pb + 3);
    MOE_PHASES(0, 8)
    PH(12) { unsigned char* ws = wsl(a.ws); pg8::Gemm g{Hb, (const bf16*)(ws + WS_W_IN1), 2048, 2048, 2048}; SO.init(T, 9728, G, bid);
        EpiIn1 E{(bf16*)(ws + A_ZD), (bf16*)(ws + A_ZR)}; pg8::gemm_phase<EpiIn1, pg8::StaticOrder, false, true>(lds, g, SO, E, wv); } SEAM(12);
    PH(13) { unsigned char* ws = wsl(a.ws); rwkv_prep((const bf16*)(ws + A_ZR), a.in[I_MU], (bf16*)(ws + A_LIN), wv); } SEAM(13);
    PH(14) { unsigned char* ws = wsl(a.ws);
        pg8::Gemm g{(const bf16*)(ws + A_LIN), (const bf16*)(ws + WS_W_LORA), 384, 384, 256}; LoraOrder LO; LO.init(T, 4608, G, bid);
        EpiLora E{(bf16*)(ws + A_WDEC), (bf16*)(ws + A_AA), (bf16*)(ws + A_GG), a.in[I_W0], a.in[I_A0]}; pg8::gemm_phase<EpiLora, LoraOrder, false>(lds, g, LO, E, wv);
} SEAM(14);
    PH(15) { rwkv_chunk_prep(a, lds, 0, wv); } SEAM(15);
    PH(16) { unsigned char* ws = wsl(a.ws); if (bid < 96 || G <= 96) { for (int u = bid; u < 96; u += G) { rwkv_chunk_rec(a, lds, u, 0, wv); if (REP_REC) rwkv_chunk_rec<REP_REC>(a, lds, u, 0, wv); } }
        if (G <= 96 || bid >= 96) { const int nb_ = G <= 96 ? G : G - 96, b0_ = G <= 96 ? bid : bid - 96;
            DilPre P; if (b0_ < 768) dil_issue((const bf16*)(ws + A_ZD), (const float*)(ws + WS_BIAS), b0_, wv, P);
            for (int u = b0_; u < 768; u += nb_) dil_attn_unit(lds, (const bf16*)(ws + A_ZD), (const float*)(ws + WS_BIAS), (bf16*)(ws + A_DPO), (float*)(ws + A_DPM), (float*)(ws + A_DPL), u, u + nb_ < 768 ? u + nb_ : -1, P, wv); } } SEAM(16);
    PH(17) { rwkv_chunk_prep(a, lds, 1, wv); } SEAM(17);
    PH(18) { unsigned char* ws = wsl(a.ws); if (bid < 96 || G <= 96) { for (int u = bid; u < 96; u += G) { rwkv_chunk_rec(a, lds, u, 1, wv); if (REP_REC) rwkv_chunk_rec<REP_REC>(a, lds, u, 1, wv); } }
        if (G <= 96 || bid >= 96) { const int nb_ = G <= 96 ? G : G - 96, b0_ = G <= 96 ? bid : bid - 96;
            DilPre P; if (768 + b0_ < 1536) dil_issue((const bf16*)(ws + A_ZD), (const float*)(ws + WS_BIAS), 768 + b0_, wv, P);
            for (int u = 768 + b0_; u < 1536; u += nb_) dil_attn_unit(lds, (const bf16*)(ws + A_ZD), (const float*)(ws + WS_BIAS), (bf16*)(ws + A_DPO), (float*)(ws + A_DPM), (float*)(ws + A_DPL), u, u + nb_ < 1536 ? u + nb_ : -1, P, wv); } } SEAM(18);
    PH(19) { unsigned char* ws = wsl(a.ws); dil_merge((const bf16*)(ws + A_DPO), (const float*)(ws + A_DPM), (const float*)(ws + A_DPL), Hb, wv); } SEAM(19);
    PH(20) { unsigned char* ws = wsl(a.ws); pg8::Gemm g{Hb, (const bf16*)(ws + WS_W_OUT1), 2048, 2048, 2048}; SO.init(T, 2048, G, bid);
        EpiRes<true> E{XPRE, a.out, MOD + 4 * 12288 + 2 * 2048}; pg8::gemm_phase<EpiRes<true>, pg8::StaticOrder, false, true>(lds, g, SO, E, wv); } SEAM(20);
    MOE_PHASES(1, 21)
#undef MOE_PHASES
#ifdef DBG_TIME_K1
    {
        xcd_barrier(bar);
        const unsigned long long* ts = (const unsigned long long*)(ws0 + CTL_CHK);
        const unsigned long long t0 = ts[0], te = __builtin_amdgcn_s_memrealtime();
        const float tot = (float)(te - t0), f1 = (float)(ts[1 + DBG_TIME_K1] - t0) / tot, f2 = (float)(ts[1 + DBG_TIME_K2] - t0) / tot;
        const float c1 = sqrtf(100.f * f1);
        for (size_t i = (size_t)bid * 512 + wv * 64 + lane_id(); i < (size_t)T * D; i += (size_t)G * 512) a.out[i] = c1;
        xcd_barrier(bar);
        if (bid == 0 && wv == 0 && lane_id() == 0) a.out[0] = 100.f * f2;
    }
#endif
#undef IN
#undef SEAM
#undef MOD
#undef Hb
#undef X1
#undef XPRE
}


#ifdef DBG_DUMP_OFF
__global__ void dbg_dump(const unsigned char* ws, float* out) {
    const size_t n = (size_t)T * D;
    for (size_t i = (size_t)blockIdx.x * 256 + threadIdx.x; i < n; i += (size_t)gridDim.x * 256) {
#if defined(DBG_DUMP_RT)
        { const int m = (int)(i >> 11), c = (int)(i & 2047); const int* RTE = (const int*)(ws + A_RT); const float* RTW = (const float*)(RTE + 4 * T); out[i] = c < 2 ? (float)RTE[2 * m + c] : (c < 4 ? RTW[2 * m + c - 2] : 0.f); }
#elif DBG_DUMP_F32
        out[i] = ((const float*)(ws + DBG_DUMP_OFF))[i];
#else
        out[i] = bf2f(((const bf16*)(ws + DBG_DUMP_OFF))[i]);
#endif
    }
}
#endif
extern "C" void kernel_launch(void* const* d_in, const int* in_sizes, int n_in, void* d_out, int out_size, void* d_ws, size_t ws_size, hipStream_t stream) {
    static int grid = 0;
    if (grid == 0) {
        if (n_in != 41 || out_size != T * D || ws_size < WS_END) { fprintf(stderr, "kernel_launch: unexpected shapes: n_in %d out %d ws %zu (need %zu)\n", n_in, out_size, ws_size, (size_t)WS_END); grid = -1; return; }
        int dev = 0, cus = 0, per_cu = 0;
        if (hipGetDevice(&dev) != hipSuccess || hipDeviceGetAttribute(&cus, hipDeviceAttributeMultiprocessorCount, dev) != hipSuccess) { grid = -1; return; }
        if (hipFuncSetAttribute((const void*)fwd, hipFuncAttributeMaxDynamicSharedMemorySize, LDS_BYTES) != hipSuccess) { fprintf(stderr, "kernel_launch: hipFuncSetAttribute failed\n"); grid = -1; return; }
        if (hipOccupancyMaxActiveBlocksPerMultiprocessor(&per_cu, (const void*)fwd, 512, LDS_BYTES) != hipSuccess || per_cu < 1) fprintf(stderr, "kernel_launch: occupancy query says %d blocks/CU\n", per_cu);
        (void)hipGetLastError();
        grid = cus;
    }
    if (grid < 0) return;
    (void)hipMemsetAsync(d_ws, 0, CTL_ZERO_BYTES, stream);
#ifdef DBG_ZERO_WS
    (void)hipMemsetAsync((char*)d_ws + CTL_ZERO_BYTES, 0, WS_END - CTL_ZERO_BYTES, stream);
#endif
    KArgs a{};
    for (int i = 0; i < 41; ++i) a.in[i] = (const float*)d_in[i];
    a.out = (float*)d_out; a.ws = (unsigned char*)d_ws;
#if N_LAUNCH_MODE == 0
    a.ph_lo = 0; a.ph_hi = N_PHASES;
    hipLaunchKernelGGL(fwd, dim3(grid), dim3(512), LDS_BYTES, stream, a);
#else
#ifdef DBG_DUMP_AFTER
    for (int p = 0; p <= DBG_DUMP_AFTER; ++p) { a.ph_lo = p; a.ph_hi = p + 1; hipLaunchKernelGGL(fwd, dim3(grid), dim3(512), LDS_BYTES, stream, a); }
#ifdef DBG_DUMP_OFF
    hipLaunchKernelGGL(dbg_dump, dim3(2048), dim3(256), 0, stream, (const unsigned char*)d_ws, (float*)d_out);
#endif
#else
    for (int p = 0; p < N_PHASES; ++p) { a.ph_lo = p; a.ph_hi = p + 1; hipLaunchKernelGGL(fwd, dim3(grid), dim3(512), LDS_BYTES, stream, a); }
#endif
#endif
}
```

```cpp
#include <hip/hip_runtime.h>
#include <cstdio>
#include <cstdint>

#ifndef N_LAUNCH_MODE
#define N_LAUNCH_MODE 0
#endif
#ifndef CHK
#define CHK 0
#endif

#define GAS __attribute__((address_space(1)))
#define LAS __attribute__((address_space(3)))
typedef unsigned short bf16;
typedef short bf16x8 __attribute__((ext_vector_type(8)));
typedef short s16x4 __attribute__((ext_vector_type(4)));
typedef float f32x4 __attribute__((ext_vector_type(4)));
typedef float f32x16 __attribute__((ext_vector_type(16)));
typedef float f32x2 __attribute__((ext_vector_type(2)));
typedef unsigned u32x4 __attribute__((ext_vector_type(4)));
typedef unsigned u32x2 __attribute__((ext_vector_type(2)));
#define DI __device__ __forceinline__

constexpr int D = 2048, NB = 4, SEQ = 4096, T = NB * SEQ;
constexpr float LN_EPS = 1e-5f, RMS_EPS = 1e-6f;
constexpr float DN_ALPHA = 1.41421356237f;
constexpr int EVEN_IN = 1856, ODD_IN = 9568, DIL_IN = 4608, RW_IN = 4960, RWW = 1536;
constexpr int NEXP = 16, DEXP = 512;

typedef __bf16 bf16x2_t __attribute__((ext_vector_type(2)));
DI unsigned pk2(float lo, float hi) { f32x2 v = {lo, hi}; bf16x2_t r = __builtin_convertvector(v, bf16x2_t); return __builtin_bit_cast(unsigned, r); }
DI float bf2f(bf16 b) { return __uint_as_float(((unsigned)b) << 16); }
DI float bflo(unsigned u) { return __uint_as_float(u << 16); }
DI float bfhi(unsigned u) { return __uint_as_float(u & 0xffff0000u); }
DI bf16 f2bf(float f) { unsigned u = __float_as_uint(f); u += 0x7fffu + ((u >> 16) & 1u); return (bf16)(u >> 16); }
DI float wave_sum_bp(float v) {
#pragma unroll
    for (int o = 1; o < 64; o <<= 1) v += __shfl_xor(v, o);
    return v;
}
DI unsigned char* wsl(unsigned char* p) { asm volatile("" : "+s"(p)); return p; }
DI int lane_id() { return (int)__builtin_amdgcn_mbcnt_hi(~0u, __builtin_amdgcn_mbcnt_lo(~0u, 0u)); }
DI int otid(int wv) { int t = wv * 64 + lane_id(); asm volatile("" : "+v"(t)); return t; }
DI float dpp_xor1(float x) { return __builtin_bit_cast(float, __builtin_amdgcn_mov_dpp(__builtin_bit_cast(int, x), 0xB1, 0xF, 0xF, true)); }
DI float dpp_xor2(float x) { return __builtin_bit_cast(float, __builtin_amdgcn_mov_dpp(__builtin_bit_cast(int, x), 0x4E, 0xF, 0xF, true)); }
DI float dpp_hmir(float x) { return __builtin_bit_cast(float, __builtin_amdgcn_mov_dpp(__builtin_bit_cast(int, x), 0x141, 0xF, 0xF, true)); }
template <int N> DI float dpp_ror(float x) { return __builtin_bit_cast(float, __builtin_amdgcn_mov_dpp(__builtin_bit_cast(int, x), 0x120 + N, 0xF, 0xF, true)); }
DI float dpp_rmir(float x) { return __builtin_bit_cast(float, __builtin_amdgcn_mov_dpp(__builtin_bit_cast(int, x), 0x140, 0xF, 0xF, true)); }
DI float red8(float x) { x += dpp_xor1(x); x += dpp_xor2(x); x += dpp_hmir(x); return x; }
DI float red16(float x) { x += dpp_xor1(x); x += dpp_xor2(x); x += dpp_hmir(x); x += dpp_rmir(x); return x; }
DI float wave_sum(float v) { float x = red16(v);
    { const auto rr = __builtin_amdgcn_permlane16_swap(__float_as_uint(x), __float_as_uint(x), false, false); x = __uint_as_float(rr[0]) + __uint_as_float(rr[1]); }
    { const auto rr = __builtin_amdgcn_permlane32_swap(__float_as_uint(x), __float_as_uint(x), false, false); x = __uint_as_float(rr[0]) + __uint_as_float(rr[1]); }
    return x; }
DI float sat448(float x) { return __builtin_amdgcn_fmed3f(x, -448.f, 448.f); }
DI unsigned pk4_fp8(float a, float b, float c, float d) { int w = 0; w = __builtin_amdgcn_cvt_pk_fp8_f32(sat448(a), sat448(b), w, false); w = __builtin_amdgcn_cvt_pk_fp8_f32(sat448(c), sat448(d), w, true); return (unsigned)w; }
constexpr float F8_WSCALE = 32.f;
DI float sigmoidf_(float x) { return __builtin_amdgcn_rcpf(1.f + __expf(-x)); }

namespace pg8 {
constexpr int BM = 256, BK = 64, HALF = 128, HTB = HALF * BK * 2, STAGE_BYTES = 8 * HTB, NXCD = 8, WGM = 8;
__host__ __device__ __forceinline__ int lds_byte(int r, int c) { const int st = (r >> 4) * 2 + (c >> 5), rr = r & 15, cc = c & 31, ob = rr * 64 + cc * 2; return st * 1024 + (ob ^ (((ob >> 9) & 1) << 5)); }
__host__ __device__ __forceinline__ void stage_rc(int b, int& R, int& C) { const int st = b / 1024, sb = b % 1024, swz = sb ^ (((sb >> 9) & 1) << 5); R = (st >> 1) * 16 + swz / 64; C = (st & 1) * 32 + (swz % 64) / 2; }
__host__ __device__ __forceinline__ int perm32(int rho) { const int n = rho >> 4, i = rho & 15; return 8 * (i >> 2) + 4 * n + (i & 3); }

struct Unit { int pm, pn, aux; };
struct Gemm { const bf16* A; const bf16* Bt; int lda, ldb, K; };

struct StaticOrder {
    int nM, nN, nwg, G, c;
    __host__ __device__ void init(int M, int N, int G_, int c_) { nM = M / BM; nN = N / BM; nwg = nM * nN; G = G_; c = c_; }
    __host__ __device__ bool next(int i, Unit& u) const {
        const long L = (long)i * G + c; if (L >= nwg) return false;
        int wgid = (int)L; { const int q = nwg / NXCD, r = nwg % NXCD, xcd = wgid % NXCD, off = wgid / NXCD; wgid = (xcd < r ? xcd * (q + 1) : r * (q + 1) + (xcd - r) * q) + off; }
        const int nig = WGM * nN, gid = wgid / nig, fm = gid * WGM, gsz = (nM - fm) < WGM ? (nM - fm) : WGM;
        u.pm = fm + ((wgid % nig) % gsz); u.pn = (wgid % nig) / gsz; u.aux = 0; return true;
    }
    __device__ __forceinline__ int arow(const Unit&, int) const { return 0; }
    __device__ __forceinline__ int koff(const Unit&) const { return 0; }
};

typedef int v8i __attribute__((ext_vector_type(8)));
template <class Epi, class Sched, bool GATHER, bool F8 = false>
__device__ __forceinline__ void gemm_phase(LAS unsigned char* lds, const Gemm g, const Sched& S, const Epi& E, int wv) {
    const int tid = otid(wv), wid = __builtin_amdgcn_readfirstlane(tid >> 6), lane = tid & 63, wr = wid >> 2, wc = wid & 3, fr = lane & 15, fq = lane >> 4;
    int K = g.K; asm volatile("" : "+s"(K));
    constexpr int ES = F8 ? 1 : 2;
    const int nt = K / (F8 ? 2 * BK : BK);
    unsigned voffB[2], vA0[2], vA1[2], nA0[2], nA1[2]; int Rr[2], Cc[2];
#pragma unroll
    for (int i = 0; i < 2; ++i) { int R, C; stage_rc(tid * 16 + i * 8192, R, C); const int Rb = Epi::PERM ? ((R & ~31) + perm32(R & 31)) : R;
        Rr[i] = R; Cc[i] = C; voffB[i] = (unsigned)(Rb * g.ldb * ES + C * 2);
        vA0[i] = (unsigned)(R * g.lda * ES + C * 2); vA1[i] = (unsigned)((R + HALF) * g.lda * ES + C * 2); nA0[i] = vA0[i]; nA1[i] = vA1[i]; }
    const size_t kstep = (size_t)(BK * 2);
    const size_t hstepB = (size_t)HALF * g.ldb * ES, tstepB = 2 * hstepB, tstepA = (size_t)BM * g.lda * ES, hstepA = (size_t)HALF * g.lda * ES, rbA = (size_t)g.lda * ES, rbB = (size_t)g.ldb * ES;
    const unsigned ldsw = (unsigned)wid * 1024u;
    const int aoff = lds_byte(wr * 64 + fr, F8 ? fq * 16 : fq * 8), boff = lds_byte(wc * 32 + fr, F8 ? fq * 16 : fq * 8);
#define PG8_SA(b, h) (((b) * 2 + (h)) * HTB)
#define PG8_SB(b, h) ((4 + (b) * 2 + (h)) * HTB)
#define PG8_STAGE(bufoff, gbase, voff) do { _Pragma("unroll") for (int _i = 0; _i < 2; ++_i) \
        __builtin_amdgcn_global_load_lds((const unsigned*)((const char*)(gbase) + (voff)[_i]), (LAS unsigned*)(lds + (bufoff) + ldsw + _i * 8192), 16, 0, 0); } while (0)
#define PG8_STAGE1(bufoff, gbase, voff0, rowbytes) do { __builtin_amdgcn_global_load_lds((const unsigned*)((const char*)(gbase) + (voff0)), (LAS unsigned*)(lds + (bufoff) + ldsw), 16, 0, 0); \
        __builtin_amdgcn_global_load_lds((const unsigned*)((const char*)(gbase) + (size_t)64 * (rowbytes) + (voff0)), (LAS unsigned*)(lds + (bufoff) + ldsw + 8192), 16, 0, 0); } while (0)
#define PG8_STAGEA(bufoff, gbase, half, arr) do { if constexpr (GATHER) PG8_STAGE(bufoff, gbase, arr); else PG8_STAGE1(bufoff, (const char*)(gbase) + (half) * hstepA, vA0[0], rbA); } while (0)
#define PG8_LD32(p) __builtin_bit_cast(v8i, __builtin_shufflevector(*(const LAS u32x4*)(p), *(const LAS u32x4*)((p) + 16), 0, 1, 2, 3, 4, 5, 6, 7))
#define PG8_LDA(dst, b, h) do { if constexpr (F8) { _Pragma("unroll") for (int m = 0; m < 4; ++m) dst##8[m] = PG8_LD32(lds + PG8_SA(b, h) + aoff + m * 2048); } \
        else { _Pragma("unroll") for (int m = 0; m < 4; ++m) _Pragma("unroll") for (int k = 0; k < 2; ++k) dst[m][k] = *(const LAS bf16x8*)(lds + PG8_SA(b, h) + aoff + m * 2048 + k * 1024); } } while (0)
#define PG8_LDB(dst, b, h) do { if constexpr (F8) { _Pragma("unroll") for (int n = 0; n < 2; ++n) dst##8[n] = PG8_LD32(lds + PG8_SB(b, h) + boff + n * 2048); } \
        else { _Pragma("unroll") for (int n = 0; n < 2; ++n) _Pragma("unroll") for (int k = 0; k < 2; ++k) dst[n][k] = *(const LAS bf16x8*)(lds + PG8_SB(b, h) + boff + n * 2048 + k * 1024); } } while (0)
#define PG8_MMA(ai, bj, At, Bt) do { __builtin_amdgcn_s_setprio(1); if constexpr (F8) { _Pragma("unroll") for (int m = 0; m < 4; ++m) _Pragma("unroll") for (int n = 0; n < 2; ++n) \
            asm volatile("v_mfma_scale_f32_16x16x128_f8f6f4 %0, %1, %2, %0, %3, %4 op_sel_hi:[0,0,0]" : "+v"(acc[ai][bj][m][n]) : "v"(Bt##8[n]), "v"(At##8[m]), "v"(sc_w), "v"(sc_x)); }     \
        else { _Pragma("unroll") for (int m = 0; m < 4; ++m) _Pragma("unroll") for (int n = 0; n < 2; ++n) _Pragma("unroll") for (int k = 0; k < 2; ++k) \
            acc[ai][bj][m][n] = __builtin_amdgcn_mfma_f32_16x16x32_bf16(Bt[n][k], At[m][k], acc[ai][bj][m][n], 0, 0, 0); } __builtin_amdgcn_s_setprio(0); } while (0)
#define PG8_WAIT_V(n) asm volatile("s_waitcnt vmcnt(" #n ")" ::: "memory")
#define PG8_WAIT_L(n) asm volatile("s_waitcnt lgkmcnt(" #n ")" ::: "memory")
#define PG8_BAR __builtin_amdgcn_s_barrier()
#define PG8_SCHED __builtin_amdgcn_sched_barrier(0)
    Unit cur, nxt; int ui = 0;
    if (!S.next(0, cur)) return;
    f32x4 acc[2][2][4][2];
#pragma unroll
    for (int a = 0; a < 2; ++a)
#pragma unroll
        for (int b = 0; b < 2; ++b)
#pragma unroll
            for (int m = 0; m < 4; ++m)
#pragma unroll
                for (int n = 0; n < 2; ++n) acc[a][b][m][n] = (f32x4){0.f, 0.f, 0.f, 0.f};
    int sc_w = 122, sc_x = 127; if constexpr (F8) asm volatile("" : "+v"(sc_w), "+v"(sc_x));
    bf16x8 At[4][2], B0[2][2], B1[2][2]; v8i At8[4], B08[2], B18[2];
    const char* cA = (GATHER ? (const char*)g.A : (const char*)g.A + (size_t)cur.pm * tstepA) + ES * S.koff(cur);
    const char* cB = (const char*)g.Bt + (size_t)cur.pn * tstepB + ES * S.koff(cur);
    if (GATHER) {
#pragma unroll
        for (int i = 0; i < 2; ++i) { vA0[i] = (unsigned)(S.arow(cur, Rr[i]) * g.lda * ES + Cc[i] * 2); vA1[i] = (unsigned)(S.arow(cur, Rr[i] + HALF) * g.lda * ES + Cc[i] * 2); nA0[i] = vA0[i]; nA1[i] = vA1[i]; } }
    PG8_STAGE1(PG8_SB(0, 0), cB, voffB[0], rbB); PG8_STAGEA(PG8_SA(0, 0), cA, 0, vA0); PG8_STAGE1(PG8_SB(0, 1), cB + hstepB, voffB[0], rbB); PG8_STAGEA(PG8_SA(0, 1), cA, 1, vA1);
    if (wr == 1) PG8_BAR;
    PG8_WAIT_V(4); PG8_BAR;
    PG8_STAGE1(PG8_SB(1, 0), cB + kstep, voffB[0], rbB); PG8_STAGEA(PG8_SA(1, 0), cA + kstep, 0, vA0); PG8_STAGE1(PG8_SB(1, 1), cB + hstepB + kstep, voffB[0], rbB);
    PG8_WAIT_V(6); PG8_BAR;
    for (;;) {
        const bool has_next = S.next(ui + 1, nxt);
        const char* nAp = GATHER ? cA : (has_next ? (const char*)g.A + (size_t)nxt.pm * tstepA + ES * S.koff(nxt) : cA);
        const char* nB = has_next ? (const char*)g.Bt + (size_t)nxt.pn * tstepB + ES * S.koff(nxt) : cB;
        if (GATHER) {
#pragma unroll
            for (int i = 0; i < 2; ++i) { nA0[i] = vA0[i]; nA1[i] = vA1[i]; } }
        for (int t = 0; t < nt; t += 2) {
            const bool last = (t == nt - 2);
            if (GATHER && has_next && t == (nt >= 4 ? nt - 4 : 0)) {
#pragma unroll
                for (int i = 0; i < 2; ++i) { nA0[i] = (unsigned)(S.arow(nxt, Rr[i]) * g.lda * ES + Cc[i] * 2); nA1[i] = (unsigned)(S.arow(nxt, Rr[i] + HALF) * g.lda * ES + Cc[i] * 2); } }
            const char* a1 = cA + (size_t)(t + 1) * kstep;
            const char* a2 = last ? nAp : cA + (size_t)(t + 2) * kstep; const char* b2 = last ? nB : cB + (size_t)(t + 2) * kstep;
            const char* a3 = a2 + kstep; const char* b3 = b2 + kstep;
            unsigned w0[2], w1[2];
#pragma unroll
            for (int i = 0; i < 2; ++i) { w0[i] = (GATHER && last) ? nA0[i] : vA0[i]; w1[i] = (GATHER && last) ? nA1[i] : vA1[i]; }
            PG8_LDB(B0, 0, 0); PG8_SCHED; PG8_LDA(At, 0, 0); PG8_STAGEA(PG8_SA(1, 1), a1, 1, vA1);
            PG8_WAIT_L(8); PG8_BAR; PG8_WAIT_L(0); PG8_MMA(0, 0, At, B0); PG8_BAR; PG8_SCHED;
            PG8_LDB(B1, 0, 1); PG8_STAGE1(PG8_SB(0, 0), b2, voffB[0], rbB);
            PG8_BAR; PG8_WAIT_L(0); PG8_MMA(0, 1, At, B1); PG8_BAR;
            PG8_LDA(At, 0, 1); PG8_STAGEA(PG8_SA(0, 0), a2, 0, w0);
            PG8_BAR; PG8_WAIT_L(0); PG8_MMA(1, 0, At, B0); PG8_BAR; PG8_SCHED;
            PG8_STAGE1(PG8_SB(0, 1), b2 + hstepB, voffB[0], rbB);
            PG8_WAIT_V(6); PG8_BAR; PG8_MMA(1, 1, At, B1); PG8_BAR;
            PG8_LDB(B0, 1, 0); PG8_SCHED; PG8_LDA(At, 1, 0); PG8_STAGEA(PG8_SA(0, 1), a2, 1, w1);
            PG8_WAIT_L(8); PG8_BAR; PG8_WAIT_L(0); PG8_MMA(0, 0, At, B0); PG8_BAR; PG8_SCHED;
            PG8_LDB(B1, 1, 1); PG8_STAGE1(PG8_SB(1, 0), b3, voffB[0], rbB);
            PG8_BAR; PG8_WAIT_L(0); PG8_MMA(0, 1, At, B1); PG8_BAR;
            PG8_LDA(At, 1, 1); PG8_STAGEA(PG8_SA(1, 0), a3, 0, w0);
            PG8_BAR; PG8_WAIT_L(0); PG8_MMA(1, 0, At, B0); PG8_BAR; PG8_SCHED;
            PG8_STAGE1(PG8_SB(1, 1), b3 + hstepB, voffB[0], rbB);
            PG8_WAIT_V(6); PG8_BAR; PG8_MMA(1, 1, At, B1); PG8_BAR;
        }
        if constexpr (F8) asm volatile("s_nop 15\n\ts_nop 15\n\ts_nop 15\n\ts_nop 15" ::: "memory");
        { int frr = fr, fqq = fq; asm volatile("" : "+v"(frr), "+v"(fqq));
          E(acc, cur, wr, wc, frr, fqq); }
        if (!has_next) break;
#pragma unroll
        for (int a = 0; a < 2; ++a)
#pragma unroll
            for (int b = 0; b < 2; ++b)
#pragma unroll
                for (int m = 0; m < 4; ++m)
#pragma unroll
                    for (int n = 0; n < 2; ++n) acc[a][b][m][n] = (f32x4){0.f, 0.f, 0.f, 0.f};
        cur = nxt; cA = nAp; cB = nB; ++ui;
        if (GATHER) {
#pragma unroll
            for (int i = 0; i < 2; ++i) { vA0[i] = nA0[i]; vA1[i] = nA1[i]; } }
    }
    PG8_WAIT_V(0);
    if (wr == 0) PG8_BAR;
    PG8_BAR;
#undef PG8_SA
#undef PG8_SB
#undef PG8_STAGE
#undef PG8_STAGE1
#undef PG8_STAGEA
#undef PG8_LDA
#undef PG8_LDB
#undef PG8_MMA
#undef PG8_LD32
#undef PG8_WAIT_V
#undef PG8_WAIT_L
#undef PG8_BAR
#undef PG8_SCHED
}
}

#define XB_TMO      128
#define XB_XCNT(j)  (256  + 64 * (j))
#define XB_XSUB(j)  (1280 + 64 * (j))
#define XB_XGEN(j)  (2304 + 64 * (j))
#define XB_TOP      3328
#define XB_TOPGEN   3392
#define XCD_BAR_WORDS 3456
#define XB_SPIN_CAP (1u << 18)
__device__ __forceinline__ unsigned xb_ld(unsigned* p)              { return __hip_atomic_load(p, __ATOMIC_RELAXED, __HIP_MEMORY_SCOPE_AGENT); }
__device__ __forceinline__ unsigned xb_add(unsigned* p, unsigned v) { return __hip_atomic_fetch_add(p, v, __ATOMIC_RELAXED, __HIP_MEMORY_SCOPE_AGENT); }
__device__ __forceinline__ unsigned xb_xcc_id() { return (unsigned)__builtin_amdgcn_s_getreg((3 << 11) | 20) & 0xFu; }
#define XB_SPIN(cond, bar) do { unsigned _sp = 0; while (cond) { __builtin_amdgcn_s_sleep(1); \
    if ((++_sp & 255u) == 0u) { if (xb_ld(&(bar)[XB_TMO])) break; if (_sp > XB_SPIN_CAP) { atomicAdd(&(bar)[XB_TMO], 1u); break; } } } } while (0)
struct XcdBarrier { unsigned* bar; unsigned x; volatile LAS unsigned* st; int wv; };
__device__ __forceinline__ XcdBarrier xcd_barrier_post(unsigned* bar, volatile LAS unsigned* st, int wv) {
    XcdBarrier b; b.bar = bar; b.x = xb_xcc_id(); b.st = st; b.wv = wv;
    if (wv == 0 && lane_id() == 0) (void)xb_add(&bar[XB_XCNT(b.x)], 1u);
    return b;
}
__device__ __forceinline__ void xcd_barrier_complete(unsigned* bar, unsigned x, unsigned& nloc, unsigned& nx) {
    const unsigned G = gridDim.x * gridDim.y * gridDim.z;
    unsigned sum, cnt, mine, sp = 0u;
    for (;;) {
        sum = 0u; cnt = 0u; mine = 0u;
#pragma unroll
        for (unsigned j = 0; j < 16; ++j) { const unsigned c = xb_ld(&bar[XB_XCNT(j)]); sum += c; cnt += (c > 0u) ? 1u : 0u; mine = (j == x) ? c : mine; }
        if (sum == G) break;
        __builtin_amdgcn_s_sleep(1);
        if ((++sp & 255u) == 0u) { if (xb_ld(&bar[XB_TMO])) break; if (sp > XB_SPIN_CAP) { atomicAdd(&bar[XB_TMO], 1u); break; } }
    }
    nloc = mine > 0u ? mine : 1u; nx = cnt > 0u ? cnt : 1u;
}
__device__ __forceinline__ void xcd_barrier(const XcdBarrier& b) {
    asm volatile("s_waitcnt vmcnt(0)" ::: "memory");
    __syncthreads();
    if (b.wv == 0 && lane_id() == 0) {
        unsigned* bar = b.bar;
        __builtin_amdgcn_s_waitcnt(0);
        unsigned nloc = b.st[0], nx = b.st[1];
        if (nloc == 0u) { xcd_barrier_complete(bar, b.x, nloc, nx); b.st[0] = nloc; b.st[1] = nx; }
        const unsigned old = xb_add(&bar[XB_XSUB(b.x)], 1u);
        const unsigned gen = old / nloc;
        if (old + 1u == (gen + 1u) * nloc) {
            __builtin_amdgcn_fence(__ATOMIC_RELEASE, "agent");
            asm volatile("s_waitcnt vmcnt(0)" ::: "memory");
            const unsigned og = xb_add(&bar[XB_TOP], 1u);
            const unsigned tg = og / nx;
            if (og + 1u == (tg + 1u) * nx) xb_add(&bar[XB_TOPGEN], 1u);
            else XB_SPIN(xb_ld(&bar[XB_TOPGEN]) == tg, bar);
            __builtin_amdgcn_fence(__ATOMIC_ACQUIRE, "agent");
            xb_add(&bar[XB_XGEN(b.x)], 1u);
            asm volatile("s_waitcnt vmcnt(0)" ::: "memory");
        } else {
            XB_SPIN(xb_ld(&bar[XB_XGEN(b.x)]) == gen, bar);
            __builtin_amdgcn_fence(__ATOMIC_ACQUIRE, "agent");
            asm volatile("s_waitcnt vmcnt(0)" ::: "memory");
        }
    }
    __syncthreads();
}

constexpr size_t MiB = 1u << 20;
constexpr size_t CTL_BAR = 0, CTL_MODI = 16384  , CTL_MOD = CTL_MODI + 2 * 4 * 12288 * 8  , CTL_SSQ = CTL_MOD + 2 * 4 * 12288 * 4  ,
                 CTL_CNT = CTL_SSQ + (size_t)T * 12 * 4  , CTL_CHK = CTL_CNT + 2 * 16 * 256, CTL_ZERO_BYTES = 2 * MiB;
static_assert(CTL_CHK % 8 == 0 && CTL_CHK + 1024 <= CTL_ZERO_BYTES, "ctl");
constexpr size_t WS_W_IN0 = 2 * MiB, WS_W_UQ = WS_W_IN0 + 8 * MiB, WS_W_UKV = WS_W_UQ + 1536 * 512 * 2, WS_W_GLU = WS_W_UKV + 2048 * 256 * 2, WS_W_OUT0 = WS_W_GLU + 2 * MiB,
                 WS_W_IN1 = WS_W_OUT0 + 8 * MiB, WS_W_OUT1 = WS_W_IN1 + (size_t)9728 * 2048 * 2, WS_W_GU = WS_W_OUT1 + 8 * MiB, WS_W_DN = WS_W_GU + 128 * MiB,
                 WS_W_LORA = WS_W_DN + 64 * MiB, WS_S5BY = WS_W_LORA + (size_t)4608 * 384 * 2, WS_S5BE = WS_S5BY + (size_t)64 * 256 * 384 * 2, WS_ROPE = WS_S5BE + (size_t)64 * 256 * 256 * 2,
                 WS_BIAS = WS_ROPE + 1 * MiB, WS_S5L = WS_BIAS + 16384, WS_H = WS_S5L + 65536;
static_assert(WS_H % 256 == 0, "align");
constexpr size_t WS_W_GU8 = WS_W_GU + 64 * MiB;
constexpr size_t WS_X1 = WS_H + 64 * MiB, WS_ARENA = WS_X1 + 128 * MiB;
constexpr size_t A_QC = WS_ARENA, A_KVC = A_QC + 16 * MiB, A_KR = A_KVC + 8 * MiB, A_XH = A_KR + 2 * MiB, A_ES = A_XH + 48 * MiB, A_Q = A_ES + 32 * MiB, A_KF = A_Q + 48 * MiB,
                 A_V = A_KF + 48 * MiB, A_YS5 = A_V + 32 * MiB;
constexpr size_t A_XPRE = WS_ARENA, A_RT = WS_ARENA + 128 * MiB, A_TOKL = A_RT + 1 * MiB, A_ACT = WS_ARENA, A_YS = WS_ARENA + 130 * MiB;
constexpr int MOE_ROWS = 2 * T + 16 * 256;
constexpr size_t A_ZD = WS_ARENA, A_ZR = A_ZD + 144 * MiB, A_LIN = A_ZR + 156 * MiB, A_WDEC = A_LIN + 12 * MiB, A_AA = A_WDEC + 48 * MiB, A_GG = A_AA + 48 * MiB,
                 A_DPO = A_GG + 48 * MiB, A_DPM = A_DPO + 48 * MiB, A_DPL = A_DPM + 2 * MiB, A_BSG = A_DPL + 2 * MiB  , A_YR = WS_ARENA  , A_GST = A_BSG + 2 * MiB  , WS_END = A_GST + 2 * MiB;
static_assert(A_YS + (size_t)MOE_ROWS * 2048 * 2 <= WS_END && A_YS5 + 32 * MiB <= WS_END && WS_END <= 1024 * MiB, "ws map");

constexpr int RING_BYTES = 131072, LDS_TAB = RING_BYTES, LDS_MISC = RING_BYTES + 1024, LDS_BYTES = 147456;

struct KArgs { const float* in[41]; float* out; unsigned char* ws; int ph_lo, ph_hi; };
enum { I_X = 0, I_C, I_ADAW, I_ADAB, I_LNMG, I_LNMB, I_LNFG, I_LNFB, I_RW, I_RB, I_WGU, I_WDN, I_RELB, I_EVIN, I_QN, I_WUQ, I_KVN, I_WUKV, I_LRE, I_LIM, I_BRE, I_BIM, I_CRE, I_CIM,
       I_S5D, I_LOGDT, I_WGLU, I_EVOUT, I_ODIN, I_MU, I_W0, I_W2, I_A0, I_A2, I_G2, I_KK, I_KA, I_RK, I_LNXG, I_LNXB, I_ODOUT };

DI int ropeperm(int c) { return ((c >> 2) & 1) * 32 + (c >> 3) * 4 + (c & 3); }
DI int srccol(int map, int n) {
    switch (map) {
        case 1: if (n < 768) return n; if (n < 1792) return 832 + (n - 768); if (n < 1856) return 768 + ropeperm(n - 1792); return -1;
        case 2: { const int h = n / 192, j = n % 192; return j < 128 ? n : h * 192 + 128 + ropeperm(j - 128); }
        case 3: { const int pn = n >> 8, half = (n >> 7) & 1, idx = n & 127; return half * 512 + pn * 128 + idx; }
        case 4: return n < ODD_IN ? n : -1;
        default: return n;
    }
}
struct ConvJob { const float* src; bf16* dst; const float* kscale; int ldsrc, K, Nd, nmat, map, kbeg, kend, f8; size_t smat, dmat; };
DI void conv_item(const ConvJob& J, LAS unsigned char* scr, int item, int lane) {
    const int nblk = J.Nd / 64, per = (J.K / 64) * nblk, mat = item / per, r = item % per, kb = r / nblk, nb = r % nblk, k0 = 64 * kb, n0 = 64 * nb;
    const float* W = J.src + (size_t)mat * J.smat; bf16* WT = J.f8 ? (bf16*)((unsigned char*)J.dst + (size_t)mat * J.dmat) : J.dst + (size_t)mat * J.dmat;
    const int kq = lane >> 4, nq = lane & 15, sc = srccol(J.map, n0 + 4 * nq);
    f32x4 v[16];
#pragma unroll
    for (int i = 0; i < 16; ++i) { const int kg = k0 + 4 * i + kq; v[i] = (f32x4){0.f, 0.f, 0.f, 0.f};
        if (sc >= 0 && kg >= J.kbeg && kg < J.kend) { v[i] = *(const f32x4*)(W + (size_t)(kg - J.kbeg) * J.ldsrc + sc); if (J.kscale) v[i] *= J.kscale[kg]; } }
#pragma unroll
    for (int i = 0; i < 16; ++i) { LAS bf16* t = (LAS bf16*)(scr + (4 * nq) * 132 + (4 * i + kq) * 2); const unsigned p0 = pk2(v[i].x, v[i].y), p1 = pk2(v[i].z, v[i].w);
        t[0] = (bf16)(p0 & 0xffffu); t[66] = (bf16)(p0 >> 16); t[132] = (bf16)(p1 & 0xffffu); t[198] = (bf16)(p1 >> 16); }
    asm volatile("s_waitcnt lgkmcnt(0)" ::: "memory");
#pragma unroll
    for (int q = 0; q < 8; ++q) { const int id = lane + 64 * q, n = id >> 3, c = id & 7; const LAS unsigned* t = (const LAS unsigned*)(scr + n * 132 + c * 16);
        u32x4 o = {t[0], t[1], t[2], t[3]};
        if (J.f8) { u32x2 o8 = {pk4_fp8(bflo(o.x) * F8_WSCALE, bfhi(o.x) * F8_WSCALE, bflo(o.y) * F8_WSCALE, bfhi(o.y) * F8_WSCALE), pk4_fp8(bflo(o.z) * F8_WSCALE, bfhi(o.z) * F8_WSCALE, bflo(o.w) * F8_WSCALE, bfhi(o.w) * F8_WSCALE)};
            *(u32x2*)((unsigned char*)WT + (size_t)(n0 + n) * J.K + k0 + 8 * c) = o8; }
        else *(u32x4*)(WT + (size_t)(n0 + n) * J.K + k0 + 8 * c) = o; }
    asm volatile("s_waitcnt lgkmcnt(0)" ::: "memory");
}
DI ConvJob conv_job(const KArgs& a, int j) {
    unsigned char* ws = a.ws; ConvJob J; J.kscale = nullptr; J.nmat = 1; J.map = 0; J.smat = 0; J.dmat = 0; J.kbeg = 0; J.kend = 1 << 30; J.f8 = 0;
    switch (j) {
        case 0: J.src = a.in[I_EVIN]; J.dst = (bf16*)(ws + WS_W_IN0); J.f8 = 1; J.ldsrc = EVEN_IN; J.K = 2048; J.Nd = 2048; J.map = 1; break;
        case 1: J.src = a.in[I_WUQ]; J.dst = (bf16*)(ws + WS_W_UQ); J.ldsrc = 1536; J.K = 512; J.Nd = 1536; J.map = 2; J.kscale = a.in[I_QN]; break;
        case 2: J.src = a.in[I_WUKV]; J.dst = (bf16*)(ws + WS_W_UKV); J.ldsrc = 2048; J.K = 256; J.Nd = 2048; J.kscale = a.in[I_KVN]; break;
        case 3: J.src = a.in[I_WGLU]; J.dst = (bf16*)(ws + WS_W_GLU); J.ldsrc = 1024; J.K = 1024; J.Nd = 1024; break;
        case 4: J.src = a.in[I_EVOUT]; J.dst = (bf16*)(ws + WS_W_OUT0); J.f8 = 1; J.ldsrc = 2048; J.K = 2048; J.Nd = 2048; break;
        case 5: J.src = a.in[I_ODIN]; J.dst = (bf16*)(ws + WS_W_IN1); J.f8 = 1; J.ldsrc = ODD_IN; J.K = 2048; J.Nd = 9728; J.map = 4; break;
        case 6: J.src = a.in[I_ODOUT]; J.dst = (bf16*)(ws + WS_W_OUT1); J.f8 = 1; J.ldsrc = 2048; J.K = 2048; J.Nd = 2048; break;
        case 7: J.src = a.in[I_WGU]; J.dst = (bf16*)(ws + WS_W_GU8); J.f8 = 1; J.ldsrc = 1024; J.K = 2048; J.Nd = 1024; J.map = 3; J.nmat = 32; J.smat = (size_t)2048 * 1024; J.dmat = (size_t)1024 * 2048; break;
        case 8: J.src = a.in[I_WDN]; J.dst = (bf16*)(ws + WS_W_DN); J.f8 = 1; J.ldsrc = 2048; J.K = 512; J.Nd = 2048; J.nmat = 32; J.smat = (size_t)512 * 2048; J.dmat = (size_t)2048 * 512; break;
        case 9: J.src = a.in[I_W2]; J.dst = (bf16*)(ws + WS_W_LORA); J.ldsrc = 1536; J.K = 384; J.Nd = 1536; J.kbeg = 0; J.kend = 64; break;
        case 10: J.src = a.in[I_A2]; J.dst = (bf16*)(ws + WS_W_LORA) + (size_t)1536 * 384; J.ldsrc = 1536; J.K = 384; J.Nd = 1536; J.kbeg = 64; J.kend = 128; break;
        default: J.src = a.in[I_G2]; J.dst = (bf16*)(ws + WS_W_LORA) + (size_t)3072 * 384; J.ldsrc = 1536; J.K = 384; J.Nd = 1536; J.kbeg = 128; J.kend = 352; break;
    }
    return J;
}
constexpr int N_CONV_JOBS = 12;

DI void s5_precompute(const KArgs& a, LAS unsigned char* lds, int g, int wv) {
    LAS float* PW = (LAS float*)lds; LAS float* BB = PW + 17 * 64 * 2; LAS float* CC = BB + 64 * 16 * 2; LAS float* KK = CC + 16 * 64 * 2;
    const int tid = otid(wv);
    const float dt = expf(a.in[I_LOGDT][g]);
    for (int idx = tid; idx < 17 * 64; idx += 512) { const int d = idx / 64, p = idx % 64; const float lre = a.in[I_LRE][g * 64 + p], lim = a.in[I_LIM][g * 64 + p];
        const float mag = expf(lre * dt * (float)d); float sn, cs; sincosf(lim * dt * (float)d, &sn, &cs); PW[idx * 2] = mag * cs; PW[idx * 2 + 1] = mag * sn;
        if (d == 16) { float* L = (float*)(a.ws + WS_S5L); L[(g * 64 + p) * 2] = mag * cs; L[(g * 64 + p) * 2 + 1] = mag * sn; } }
    for (int idx = tid; idx < 64 * 16; idx += 512) { const int p = idx / 16, c = idx % 16; const float lre = a.in[I_LRE][g * 64 + p], lim = a.in[I_LIM][g * 64 + p];
        float sn, cs; sincosf(lim * dt, &sn, &cs); const float mag = expf(lre * dt), sh = sinf(0.5f * lim * dt);
        const float nr = expm1f(lre * dt) * cs - 2.f * sh * sh, ni = mag * sn, den = 1.f / (lre * lre + lim * lim);
        const float cr = (nr * lre + ni * lim) * den, ci = (ni * lre - nr * lim) * den;
        const float br = a.in[I_BRE][(g * 64 + p) * 16 + c], bi = a.in[I_BIM][(g * 64 + p) * 16 + c];
        BB[idx * 2] = cr * br - ci * bi; BB[idx * 2 + 1] = cr * bi + ci * br; }
    for (int idx = tid; idx < 16 * 64; idx += 512) { CC[idx * 2] = a.in[I_CRE][g * 1024 + idx]; CC[idx * 2 + 1] = a.in[I_CIM][g * 1024 + idx]; }
    __syncthreads();
    for (int idx = tid; idx < 4096; idx += 512) { const int d = idx >> 8, c = (idx >> 4) & 15, cp = idx & 15; float s = 0.f;
        for (int p = 0; p < 64; ++p) { const float cr = CC[(c * 64 + p) * 2], ci = CC[(c * 64 + p) * 2 + 1], pr = PW[(d * 64 + p) * 2], pi = PW[(d * 64 + p) * 2 + 1];
            const float xr = cr * pr - ci * pi, xi = cr * pi + ci * pr; s += xr * BB[(p * 16 + cp) * 2] - xi * BB[(p * 16 + cp) * 2 + 1]; }
        KK[idx] = s; }
    __syncthreads();
    bf16* BY = (bf16*)(a.ws + WS_S5BY) + (size_t)g * 256 * 384; bf16* BE = (bf16*)(a.ws + WS_S5BE) + (size_t)g * 256 * 256;
    for (int idx = tid; idx < 256 * 48; idx += 512) { const int row = idx / 48, col0 = (idx % 48) * 8, t = row >> 4, c = row & 15; float v[8];
        if (col0 < 256) { const int s = col0 >> 4, c0 = col0 & 15;
#pragma unroll
            for (int j = 0; j < 8; ++j) v[j] = (s <= t) ? KK[((t - s) << 8) + (c << 4) + c0 + j] : 0.f; }
        else { const int pp = col0 - 256; const bool im = pp >= 64; const int p0 = im ? pp - 64 : pp;
#pragma unroll
            for (int j = 0; j < 8; ++j) { const int p = p0 + j; const float cr = CC[(c * 64 + p) * 2], ci = CC[(c * 64 + p) * 2 + 1], pr = PW[((t + 1) * 64 + p) * 2], pi = PW[((t + 1) * 64 + p) * 2 + 1];
                v[j] = im ? -(cr * pi + ci * pr) : (cr * pr - ci * pi); } }
        u32x4 o = {pk2(v[0], v[1]), pk2(v[2], v[3]), pk2(v[4], v[5]), pk2(v[6], v[7])}; *(u32x4*)(BY + (size_t)row * 384 + col0) = o; }
    for (int idx = tid; idx < 256 * 32; idx += 512) { const int row = idx / 32, col0 = (idx % 32) * 8, s = col0 >> 4, c0 = col0 & 15; float v[8];
#pragma unroll
        for (int j = 0; j < 8; ++j) { if (row < 128) { const int p = row & 63; const float pr = PW[((15 - s) * 64 + p) * 2], pi = PW[((15 - s) * 64 + p) * 2 + 1], br = BB[(p * 16 + c0 + j) * 2], bi = BB[(p * 16 + c0 + j) * 2 + 1];
                v[j] = row < 64 ? (pr * br - pi * bi) : (pr * bi + pi * br); } else v[j] = 0.f; }
        u32x4 o = {pk2(v[0], v[1]), pk2(v[2], v[3]), pk2(v[4], v[5]), pk2(v[6], v[7])}; *(u32x4*)(BE + (size_t)row * 256 + col0) = o; }
    __syncthreads();
}

DI int t5_bucket(int dist) { if (dist < 16) return dist; const float logd = logf((float)dist / 16.f) / logf(128.f); int lg = 16 + (int)(logd * 16.f); return lg < 31 ? lg : 31; }

DI void p0_prologue(const KArgs& a, LAS unsigned char* lds, int wv) {
    const int tid = otid(wv), lane = tid & 63, wave = tid >> 6, G = gridDim.x, gw = blockIdx.x * 8 + wave, NGW = G * 8;
    LAS float* cond = (LAS float*)(lds + 98304);
    for (int i = tid; i < 4 * 2048; i += 512) { const float c = a.in[I_C][i]; cond[i] = c / (1.f + expf(-c)); }
    if (blockIdx.x < 64) s5_precompute(a, lds, blockIdx.x, wv); else __syncthreads();
    unsigned long long* MODI = (unsigned long long*)(a.ws + CTL_MODI);
    for (int it = gw; it < 2 * 48 * 16; it += NGW) { const int l = it / 768, cc = (it % 768) / 16, kc = it % 16, col = cc * 256 + lane * 4;
        const float* W = a.in[I_ADAW] + ((size_t)l * 2048 + kc * 128) * 12288 + col;
        f32x4 acc[4]; for (int b = 0; b < 4; ++b) acc[b] = (f32x4){0.f, 0.f, 0.f, 0.f};
#pragma unroll 8
        for (int k = 0; k < 128; ++k) { const f32x4 w = *(const f32x4*)(W + (size_t)k * 12288);
#pragma unroll
            for (int b = 0; b < 4; ++b) acc[b] += w * cond[b * 2048 + kc * 128 + k]; }
        if (kc == 0) { const f32x4 bb = *(const f32x4*)(a.in[I_ADAB] + l * 12288 + col); for (int b = 0; b < 4; ++b) acc[b] += bb; }
#pragma unroll
        for (int b = 0; b < 4; ++b) { unsigned long long* o = MODI + (size_t)(l * 4 + b) * 12288 + col;
#pragma unroll
            for (int e = 0; e < 4; ++e) atomicAdd(o + e, (unsigned long long)__double2ll_rn((double)acc[b][e] * 1099511627776.0)); } }
    LAS unsigned char* scr = lds + wave * 8704;
    for (int j = 0; j < N_CONV_JOBS; ++j) { const ConvJob J = conv_job(a, j); const int nit = J.nmat * (J.K / 64) * (J.Nd / 64);
        for (int it = gw; it < nit; it += NGW) conv_item(J, scr, it, lane); }
    { float* RC = (float*)(a.ws + WS_ROPE); float* RS = RC + 4096 * 32; const int gt = blockIdx.x * 512 + tid;
      for (int i = gt; i < 4096 * 32; i += G * 512) { const int pos = i >> 5, j = i & 31; const float inv = powf(10000.f, -(float)(2 * j) / 64.f); float sn, cs; sincosf((float)pos * inv, &sn, &cs); RC[i] = cs; RS[i] = sn; }
      float* BL = (float*)(a.ws + WS_BIAS);
      for (int i = gt; i < 3 * 8 * 132; i += G * 512) { const int gi = i / (8 * 132), h = (i / 132) % 8, dl = i % 132; const int dil = gi == 0 ? 1 : (gi == 1 ? 4 : 16);
          BL[i] = dl <= 128 ? a.in[I_RELB][t5_bucket(dl * dil) * 24 + gi * 8 + h] * 1.44269504089f : 0.f; } }
}

DI float modi2f(unsigned long long v) { return fmaf((float)(unsigned)v, 0x1p-40f, (float)(int)(v >> 32) * 0x1p-8f); }
DI void modulate_rows(const float* x, const unsigned long long* MODI, float* MODF, bf16* H, int wv) {
    const int lane = otid(wv) & 63, gw = blockIdx.x * 8 + (otid(wv) >> 6), NGW = gridDim.x * 8;
    for (int i = gw * 64 + lane; i < 2 * 4 * 12288; i += NGW * 64) MODF[i] = modi2f(MODI[i]);
    for (int m = gw; m < T; m += NGW) { const int b = m / SEQ; const unsigned long long* sh = MODI + (size_t)b * 12288; const unsigned long long* sc = sh + 2048;
#pragma unroll
        for (int j = 0; j < 8; ++j) { const int col = (lane + 64 * j) * 4; const f32x4 v = *(const f32x4*)(x + (size_t)m * D + col);
            const f32x4 s1 = {modi2f(sc[col]), modi2f(sc[col + 1]), modi2f(sc[col + 2]), modi2f(sc[col + 3])}, s0 = {modi2f(sh[col]), modi2f(sh[col + 1]), modi2f(sh[col + 2]), modi2f(sh[col + 3])};
            const f32x4 h = v * (s1 + 1.f) + s0; *(unsigned*)((unsigned char*)H + (size_t)m * D + col) = pk4_fp8(h.x, h.y, h.z, h.w); } }
}

using pg8::Unit;
#define P32(ptr, elemoff) ((decltype(ptr))((char*)(ptr) + (unsigned)((unsigned)(elemoff) * (unsigned)sizeof(*(ptr)))))
typedef f32x4 Acc[2][2][4][2];
#define EPI_ROWS_BEGIN const int row0 = u.pm * 256 + wr * 64 + fr; _Pragma("unroll") for (int ai = 0; ai < 2; ++ai) _Pragma("unroll") for (int m = 0; m < 4; ++m) { const int row = row0 + ai * 128 + m * 16;
#define EPI_ROWS_END __builtin_amdgcn_sched_barrier(0); }
DI u32x4 pack8(const f32x4& v0, const f32x4& v1) { u32x4 o = {pk2(v0.x, v0.y), pk2(v0.z, v0.w), pk2(v1.x, v1.y), pk2(v1.z, v1.w)}; return o; }

struct EpiIn0 { static constexpr bool PERM = true;
    bf16 *QC, *KVC, *KR, *XH; float *ssq;
    DI void operator()(const Acc& acc, const Unit& u, int wr, int wc, int fr, int fq) const {
        EPI_ROWS_BEGIN
            float ss = 0.f;
#pragma unroll
            for (int bj = 0; bj < 2; ++bj) { const f32x4 v0 = acc[ai][bj][m][0], v1 = acc[ai][bj][m][1]; const int col = 128 * bj + 32 * wc + 8 * fq; const u32x4 o = pack8(v0, v1);
                if (u.pn < 2) { *(u32x4*)P32(QC, row * 512 + u.pn * 256 + col) = o; ss += v0.x * v0.x + v0.y * v0.y + v0.z * v0.z + v0.w * v0.w + v1.x * v1.x + v1.y * v1.y + v1.z * v1.z + v1.w * v1.w; }
                else if (u.pn == 2) { *(u32x4*)P32(KVC, row * 256 + col) = o; ss += v0.x * v0.x + v0.y * v0.y + v0.z * v0.z + v0.w * v0.w + v1.x * v1.x + v1.y * v1.y + v1.z * v1.z + v1.w * v1.w; }
                else if (u.pn < 7) { const int uc = (u.pn - 3) * 256 + col, g = uc >> 4; *(u32x4*)P32(XH, (g * 1024 + (row >> 4)) * 384 + (row & 15) * 16 + (uc & 15)) = o; }
                else if (col < 64) { *(u32x4*)P32(KR, row * 64 + col) = o; } }
            if (u.pn <= 2) { ss += __shfl_xor(ss, 16); ss += __shfl_xor(ss, 32); if (fq == 0) *P32(ssq, row * 12 + u.pn * 4 + wc) = ss; }
        EPI_ROWS_END
    }
};
struct EpiQ { static constexpr bool PERM = true;
    bf16* Q; const float* ssq; const float* rope;
    DI void operator()(const Acc& acc, const Unit& u, int wr, int wc, int fr, int fq) const {
        EPI_ROWS_BEGIN
            const f32x4 q0 = *(const f32x4*)P32(ssq, row * 12), q1 = *(const f32x4*)P32(ssq, row * 12 + 4);
            const float rs = __builtin_amdgcn_rsqf((((q0.x + q0.y) + (q0.z + q0.w)) + ((q1.x + q1.y) + (q1.z + q1.w))) * (1.f / 512.f) + RMS_EPS) * (0.07216878364870322f * 1.44269504089f);
            const int b = row / SEQ, s = row % SEQ;
#pragma unroll
            for (int bj = 0; bj < 2; ++bj) { f32x4 v0 = acc[ai][bj][m][0] * rs, v1 = acc[ai][bj][m][1] * rs; const int n = u.pn * 256 + 128 * bj + 32 * wc + 8 * fq, h = n / 192, j = n % 192;
                if (j >= 128) { const int q = (j - 128) >> 3; const f32x4 cs = *(const f32x4*)P32(rope, s * 32 + 4 * q), sn = *(const f32x4*)P32(rope, 4096 * 32 + s * 32 + 4 * q);
                    const f32x4 x1 = v0, x2 = v1; v0 = x1 * cs - x2 * sn; v1 = x1 * sn + x2 * cs; }
                *(u32x4*)P32(Q, ((b * 8 + h) * SEQ + s) * 192 + j) = pack8(v0, v1); }
        EPI_ROWS_END
    }
};
struct EpiKV { static constexpr bool PERM = true;
    bf16 *KF, *V; const float* ssq;
    DI void operator()(const Acc& acc, const Unit& u, int wr, int wc, int fr, int fq) const {
        EPI_ROWS_BEGIN
            const f32x4 q2 = *(const f32x4*)P32(ssq, row * 12 + 8); const float rs = __builtin_amdgcn_rsqf(((q2.x + q2.y) + (q2.z + q2.w)) * (1.f / 256.f) + RMS_EPS); const int b = row / SEQ, s = row % SEQ, h = u.pn, j = 32 * wc + 8 * fq; const int tok = (b * 8 + h) * SEQ + s;
            *(u32x4*)P32(KF, tok * 192 + j) = pack8(acc[ai][0][m][0] * rs, acc[ai][0][m][1] * rs);
            *(u32x4*)P32(V, tok * 128 + j) = pack8(acc[ai][1][m][0] * rs, acc[ai][1][m][1] * rs);
        EPI_ROWS_END
    }
};
struct S5Order { int G, c;
    DI bool next(int i, Unit& u) const { const int L = i * G + c; if (L >= 256) return false; u.pm = L; u.pn = L >> 2; u.aux = 0; return true; }
    DI int arow(const Unit&, int) const { return 0; }
    DI int koff(const Unit&) const { return 0; } };
struct EpiS5E { static constexpr bool PERM = false;
    float* ES;
    DI void operator()(const Acc& acc, const Unit& u, int wr, int wc, int fr, int fq) const {
        EPI_ROWS_BEGIN
#pragma unroll
            for (int n = 0; n < 2; ++n) *(f32x4*)P32(ES, row * 128 + 32 * wc + 16 * n + 4 * fq) = acc[ai][0][m][n];
        EPI_ROWS_END
    }
};
DI float gelu_tanh(float x) { const float t = 0.7978845608028654f * (x + 0.044715f * x * x * x); const float e = __expf(2.f * t); return 0.5f * x * (1.f + (1.f - 2.f * __builtin_amdgcn_rcpf(e + 1.f))); }
struct EpiS5Y { static constexpr bool PERM = true;
    bf16* YS5; const bf16* XH; const float* dsk;
    DI void operator()(const Acc& acc, const Unit& u, int wr, int wc, int fr, int fq) const {
        EPI_ROWS_BEGIN
            const int g = row >> 10, chunk = row & 1023;
#pragma unroll
            for (int bj = 0; bj < 2; ++bj) { const int col = 128 * bj + 32 * wc + 8 * fq, tl = col >> 4, c0 = col & 15; const u32x4 uu = *(const u32x4*)P32(XH, row * 384 + col);
                const f32x4 d0 = *(const f32x4*)P32(dsk, g * 16 + c0), d1 = *(const f32x4*)P32(dsk, g * 16 + c0 + 4); const f32x4 a0 = acc[ai][bj][m][0], a1 = acc[ai][bj][m][1];
                f32x4 y0 = {a0.x + d0.x * bflo(uu.x), a0.y + d0.y * bfhi(uu.x), a0.z + d0.z * bflo(uu.y), a0.w + d0.w * bfhi(uu.y)};
                f32x4 y1 = {a1.x + d1.x * bflo(uu.z), a1.y + d1.y * bfhi(uu.z), a1.z + d1.z * bflo(uu.w), a1.w + d1.w * bfhi(uu.w)};
#pragma unroll
                for (int e = 0; e < 4; ++e) { y0[e] = gelu_tanh(y0[e]); y1[e] = gelu_tanh(y1[e]); }
                *(u32x4*)P32(YS5, (chunk * 16 + tl) * 1024 + g * 16 + c0) = pack8(y0, y1); }
        EPI_ROWS_END
    }
};
struct EpiGlu { static constexpr bool PERM = true;
    bf16* MIX; const bf16* YS5;
    DI void operator()(const Acc& acc, const Unit& u, int wr, int wc, int fr, int fq) const {
        EPI_ROWS_BEGIN
#pragma unroll
            for (int bj = 0; bj < 2; ++bj) { const int col = u.pn * 256 + 128 * bj + 32 * wc + 8 * fq; const u32x4 yy = *(const u32x4*)P32(YS5, row * 1024 + col); const f32x4 a0 = acc[ai][bj][m][0], a1 = acc[ai][bj][m][1];
                const f32x4 o0 = {bflo(yy.x) * sigmoidf_(a0.x), bfhi(yy.x) * sigmoidf_(a0.y), bflo(yy.y) * sigmoidf_(a0.z), bfhi(yy.y) * sigmoidf_(a0.w)};
                const f32x4 o1 = {bflo(yy.z) * sigmoidf_(a1.x), bfhi(yy.z) * sigmoidf_(a1.y), bflo(yy.w) * sigmoidf_(a1.z), bfhi(yy.w) * sigmoidf_(a1.w)};
                { unsigned char* mx = (unsigned char*)MIX; u32x2 o8 = {pk4_fp8(o0.x, o0.y, o0.z, o0.w), pk4_fp8(o1.x, o1.y, o1.z, o1.w)}; *(u32x2*)P32(mx, row * 2048 + 1024 + col) = o8; } }
        EPI_ROWS_END
    }
};
template <bool XBF> struct EpiRes { static constexpr bool PERM = true;
    bf16* XPRE; const void* xres; const float* gate;
    DI void operator()(const Acc& acc, const Unit& u, int wr, int wc, int fr, int fq) const {
        EPI_ROWS_BEGIN
            const int b = row / SEQ;
#pragma unroll
            for (int bj = 0; bj < 2; ++bj) { const int col = u.pn * 256 + 128 * bj + 32 * wc + 8 * fq;
                f32x4 x0, x1;
                if (XBF) { const bf16* xb = (const bf16*)xres; const u32x4 xq = *(const u32x4*)P32(xb, row * D + col); x0 = (f32x4){bflo(xq.x), bfhi(xq.x), bflo(xq.y), bfhi(xq.y)}; x1 = (f32x4){bflo(xq.z), bfhi(xq.z), bflo(xq.w), bfhi(xq.w)}; }
                else { const float* xf = (const float*)xres; x0 = *(const f32x4*)P32(xf, row * D + col); x1 = *(const f32x4*)P32(xf, row * D + col + 4); }
                const f32x4 g0 = *(const f32x4*)P32(gate, b * 12288 + col), g1 = *(const f32x4*)P32(gate, b * 12288 + col + 4);
                *(u32x4*)P32(XPRE, row * D + col) = pack8(x0 * DN_ALPHA + (g0 + 1.f) * acc[ai][bj][m][0], x1 * DN_ALPHA + (g1 + 1.f) * acc[ai][bj][m][1]); }
        EPI_ROWS_END
    }
};

DI void krope_pass(const bf16* KR, const float* rope, bf16* KF, int wv) {
    const int gt = blockIdx.x * 512 + otid(wv), NT_ = gridDim.x * 512;
    for (int i = gt; i < T * 8; i += NT_) { const int row = i >> 3, q = i & 7, b = row / SEQ, s = row % SEQ; const u32x4 r = *(const u32x4*)(KR + (size_t)row * 64 + q * 8);
        const f32x4 x1 = {bflo(r.x), bfhi(r.x), bflo(r.y), bfhi(r.y)}, x2 = {bflo(r.z), bfhi(r.z), bflo(r.w), bfhi(r.w)};
        const f32x4 cs = *(const f32x4*)(rope + s * 32 + 4 * q), sn = *(const f32x4*)(rope + 4096 * 32 + s * 32 + 4 * q);
        const u32x4 o = pack8(x1 * cs - x2 * sn, x1 * sn + x2 * cs);
#pragma unroll
        for (int h = 0; h < 8; ++h) *(u32x4*)(KF + ((size_t)(b * 8 + h) * SEQ + s) * 192 + 128 + q * 8) = o; }
}
DI void s5_carry(const float* ES, const float* L16, bf16* XH, LAS unsigned char* lds, int wv) {
    const int tid = otid(wv), lane = tid & 63, w = tid >> 6; LAS float* SEG = (LAS float*)lds;
    for (int base = blockIdx.x * 64; base < 4 * 64 * 64; base += gridDim.x * 64) {
        const int gt = base + lane, p = gt & 63, g = (gt >> 6) & 63, b = gt >> 12; const float lr = L16[(g * 64 + p) * 2], li = L16[(g * 64 + p) * 2 + 1];
        const size_t r0 = (size_t)g * 1024 + b * 256 + 32 * w;
        float hr = 0.f, hi = 0.f;
#pragma unroll 16
        for (int k = 0; k < 32; ++k) { const float er = ES[(r0 + k) * 128 + p], ei = ES[(r0 + k) * 128 + 64 + p]; const float nr = lr * hr - li * hi + er, ni = lr * hi + li * hr + ei; hr = nr; hi = ni; }
        __syncthreads();
        SEG[(w * 64 + lane) * 2] = hr; SEG[(w * 64 + lane) * 2 + 1] = hi;
        float pr = lr, pi = li;
#pragma unroll
        for (int q = 0; q < 5; ++q) { const float nr = pr * pr - pi * pi, ni = 2.f * pr * pi; pr = nr; pi = ni; }
        __syncthreads();
        hr = 0.f; hi = 0.f;
        for (int u = 0; u < w; ++u) { const float er = SEG[(u * 64 + lane) * 2], ei = SEG[(u * 64 + lane) * 2 + 1]; const float nr = pr * hr - pi * hi + er, ni = pr * hi + pi * hr + ei; hr = nr; hi = ni; }
#pragma unroll 16
        for (int k = 0; k < 32; ++k) { const float er = ES[(r0 + k) * 128 + p], ei = ES[(r0 + k) * 128 + 64 + p];
            XH[(r0 + k) * 384 + 256 + p] = f2bf(hr); XH[(r0 + k) * 384 + 320 + p] = f2bf(hi);
            const float nr = lr * hr - li * hi + er, ni = lr * hi + li * hr + ei; hr = nr; hi = ni; }
    }
    __syncthreads();
}

#define MFMA32(a, b, c) __builtin_amdgcn_mfma_f32_32x32x16_bf16((a), (b), (c), 0, 0, 0)
constexpr int AT_KROW = 384, AT_VROW = 256, AT_KBYTES = 64 * AT_KROW, AT_STG = AT_KBYTES + 64 * AT_VROW, AT_NST = 3;
static_assert(AT_NST * AT_STG <= RING_BYTES, "attention LDS");
DI void mla_attn_unit(LAS unsigned char* lds, const bf16* Qg, const bf16* KFg, const bf16* Vg, bf16* MIX, int unit, int wv) {
    const int tid = otid(wv), lane = tid & 63, w = tid >> 6, r = lane & 31, hh = lane >> 5;
    const int b = unit >> 6, h = (unit >> 3) & 7, pi = unit & 7;
    const bf16* Qh = Qg + (size_t)(b * 8 + h) * SEQ * 192; const bf16* Kh = KFg + (size_t)(b * 8 + h) * SEQ * 192; const bf16* Vh = Vg + (size_t)(b * 8 + h) * SEQ * 128;
    const int w_ = __builtin_amdgcn_readfirstlane(w);
    int koff[3], voff[2];
#pragma unroll
    for (int i = 0; i < 3; ++i) { const int p = (3 * w_ + i) * 64 + lane, row = p / 24, cs = p % 24, c = (cs & ~7) | ((cs ^ (row >> 1)) & 7); koff[i] = row * 192 + c * 8; }
#pragma unroll
    for (int i = 0; i < 2; ++i) { const int p = (2 * w_ + i) * 64 + lane, row = p >> 4, cs = p & 15, c = cs ^ ((row & 3) << 2); voff[i] = row * 128 + c * 8; }
    const int kx = (r >> 1) & 7, vq = (lane >> 2) & 3;
    for (int half = 0; half < 2; ++half) {
        const int qb = half ? 15 - pi : pi, q0 = qb * 256 + 32 * w, nkt = (qb + 1) * 4;
        bf16x8 qf[12];
#pragma unroll
        for (int ks = 0; ks < 12; ++ks) qf[ks] = *(const GAS bf16x8*)P32(Qh, (q0 + r) * 192 + 16 * ks + 8 * hh);
        f32x16 O[4];
#pragma unroll
        for (int i = 0; i < 4; ++i) for (int e = 0; e < 16; ++e) O[i][e] = 0.f;
        float mrow = -1e30f, lrow = 0.f;
#define AT_DMA(kt, stg) do { LAS unsigned char* sb_ = lds + (stg) * AT_STG; \
        _Pragma("unroll") for (int i = 0; i < 3; ++i) __builtin_amdgcn_global_load_lds((const unsigned*)P32(Kh, (kt) * 64 * 192 + koff[i]), (LAS unsigned*)(sb_ + (3 * w_ + i) * 1024), 16, 0, 0); \
        _Pragma("unroll") for (int i = 0; i < 2; ++i) __builtin_amdgcn_global_load_lds((const unsigned*)P32(Vh, (kt) * 64 * 128 + voff[i]), (LAS unsigned*)(sb_ + AT_KBYTES + (2 * w_ + i) * 1024), 16, 0, 0); } while (0)
#define AT_BAR() do { asm volatile("s_waitcnt lgkmcnt(0)" ::: "memory"); __builtin_amdgcn_s_barrier(); asm volatile("" ::: "memory"); } while (0)
        __syncthreads();
        AT_DMA(0, 0); AT_DMA(1, 1);
        asm volatile("s_waitcnt vmcnt(5)" ::: "memory");
        AT_BAR();
        int stg = 0;
        for (int kt = 0; kt < nkt; ++kt) {
            if (kt + 2 < nkt) AT_DMA(kt + 2, stg == 0 ? 2 : stg - 1);
            const LAS unsigned char* sb = lds + stg * AT_STG;
            if (kt * 64 <= q0 + 31) {
                f32x16 st[2];
#pragma unroll
                for (int mt = 0; mt < 2; ++mt) for (int e = 0; e < 16; ++e) st[mt][e] = 0.f;
                __builtin_amdgcn_sched_barrier(0);
                {
                    const LAS unsigned char* kb = sb + r * AT_KROW; const LAS unsigned char* kx4[4];
#pragma unroll
                    for (int j = 0; j < 4; ++j) kx4[j] = kb + (((2 * j + hh) ^ kx) & 7) * 16;
                    bf16x8 kf[24];
#pragma unroll
                    for (int i = 0; i < 24; ++i) kf[i] = *(const LAS bf16x8*)(kx4[(i >> 1) & 3] + 32 * (i & 1) * AT_KROW + 128 * (i >> 3));
#pragma unroll
                    for (int i = 0; i < 24; ++i) st[i & 1] = MFMA32(kf[i], qf[i >> 1], st[i & 1]);
                    __builtin_amdgcn_sched_group_barrier(0x100, 4, 0);
#pragma unroll
                    for (int i = 0; i < 24; ++i) { __builtin_amdgcn_sched_group_barrier(0x008, 1, 0); __builtin_amdgcn_sched_group_barrier(0x100, 1, 0); }
                }
                __builtin_amdgcn_sched_barrier(0);
                if (kt * 64 + 63 > q0) {
                    const int qg = q0 + r;
#pragma unroll
                    for (int mt = 0; mt < 2; ++mt)
#pragma unroll
                        for (int e = 0; e < 16; ++e) { const int kg = kt * 64 + 32 * mt + (e & 3) + 8 * (e >> 2) + 4 * hh; if (kg > qg) st[mt][e] = -1e30f; }
                }
                float mx = st[0][0];
#pragma unroll
                for (int mt = 0; mt < 2; ++mt)
#pragma unroll
                    for (int e = 0; e < 16; ++e) mx = fmaxf(mx, st[mt][e]);
                { const unsigned xi_ = __float_as_uint(mx); const auto rr_ = __builtin_amdgcn_permlane32_swap(xi_, xi_, false, false); mx = fmaxf(__uint_as_float(rr_[0]), __uint_as_float(rr_[1])); }
                float alpha = 1.f;
                if (__any(mx - mrow > 8.f)) { const float mnew = fmaxf(mrow, mx); alpha = __builtin_amdgcn_exp2f(mrow - mnew); mrow = mnew;
#pragma unroll
                    for (int i = 0; i < 4; ++i) O[i] *= alpha; }
                float ls = 0.f;
#pragma unroll
                for (int mt = 0; mt < 2; ++mt)
#pragma unroll
                    for (int e = 0; e < 16; ++e) { const float p = __builtin_amdgcn_exp2f(st[mt][e] - mrow); st[mt][e] = p; ls += p; }
                lrow = lrow * alpha + ls;
                bf16x8 pf[2][2];
#pragma unroll
                for (int mt = 0; mt < 2; ++mt)
#pragma unroll
                    for (int s = 0; s < 2; ++s) { u32x4 pk = {pk2(st[mt][8 * s], st[mt][8 * s + 1]), pk2(st[mt][8 * s + 2], st[mt][8 * s + 3]), pk2(st[mt][8 * s + 4], st[mt][8 * s + 5]), pk2(st[mt][8 * s + 6], st[mt][8 * s + 7])};
                        pf[mt][s] = __builtin_bit_cast(bf16x8, pk); }
                __builtin_amdgcn_sched_barrier(0);
                {
                    const LAS unsigned char* vb = sb + AT_KBYTES + (4 * hh + vq) * AT_VROW + 32 * ((lane >> 4) & 1) + 8 * (lane & 3); const LAS unsigned char* vx4[4];
#pragma unroll
                    for (int d = 0; d < 4; ++d) vx4[d] = vb + ((d ^ vq) & 3) * 64;
                    bf16x8 af[16];
#pragma unroll
                    for (int i = 0; i < 16; ++i) { const LAS unsigned char* vp = vx4[i & 3] + 16 * (i >> 2) * AT_VROW;
                        const s16x4 lo = __builtin_amdgcn_ds_read_tr16_b64_v4i16((LAS s16x4*)vp), hi = __builtin_amdgcn_ds_read_tr16_b64_v4i16((LAS s16x4*)(vp + 8 * AT_VROW)); af[i] = __builtin_shufflevector(lo, hi, 0, 1, 2, 3, 4, 5, 6, 7); }
#pragma unroll
                    for (int i = 0; i < 16; ++i) O[i & 3] = MFMA32(af[i], pf[i >> 3][(i >> 2) & 1], O[i & 3]);
                    __builtin_amdgcn_sched_group_barrier(0x100, 8, 0);
#pragma unroll
                    for (int i = 0; i < 16; ++i) { __builtin_amdgcn_sched_group_barrier(0x008, 1, 0); __builtin_amdgcn_sched_group_barrier(0x100, 2, 0); }
                }
                __builtin_amdgcn_sched_barrier(0);
            }
            if (kt + 2 < nkt) asm volatile("s_waitcnt vmcnt(5)" ::: "memory"); else asm volatile("s_waitcnt vmcnt(0)" ::: "memory");
            AT_BAR();
            stg = stg == 2 ? 0 : stg + 1;
        }
        lrow += __shfl_xor(lrow, 32);
        const float inv = 1.f / lrow;
        unsigned char* mx_ = (unsigned char*)MIX; unsigned char* orow = P32(mx_, (b * SEQ + q0 + r) * 2048 + h * 128);
#pragma unroll
        for (int dvt = 0; dvt < 4; ++dvt)
#pragma unroll
            for (int g4 = 0; g4 < 4; ++g4) *(GAS unsigned*)(orow + dvt * 32 + 8 * g4 + 4 * hh) = pk4_fp8(O[dvt][4 * g4] * inv, O[dvt][4 * g4 + 1] * inv, O[dvt][4 * g4 + 2] * inv, O[dvt][4 * g4 + 3] * inv);
    }
#undef AT_DMA
#undef AT_BAR
}

DI void ln_router_phase(const KArgs& a, LAS unsigned char* lds, int layer, const bf16* XPRE, bf16* X1, bf16* H, int wv) {
    const int tid = otid(wv), lane = tid & 63, wave = tid >> 6;
    LAS float* wT = (LAS float*)lds;
    { f32x4 rw[4][4];
#pragma unroll
      for (int i = 0; i < 4; ++i)
#pragma unroll
          for (int q4 = 0; q4 < 4; ++q4) rw[i][q4] = *(const f32x4*)(a.in[I_RW] + (size_t)(tid + 512 * i) * 16 + 4 * q4);
#pragma unroll
      for (int i = 0; i < 4; ++i)
#pragma unroll
          for (int q4 = 0; q4 < 4; ++q4)
#pragma unroll
              for (int e4 = 0; e4 < 4; ++e4) wT[(4 * q4 + e4) * 2048 + tid + 512 * i] = rw[i][q4][e4]; }
    __syncthreads();
    const float* MODl = (const float*)(a.ws + CTL_MOD) + (size_t)layer * 4 * 12288;
    const float* lg = a.in[I_LNMG] + layer * D; const float* lb = a.in[I_LNMB] + layer * D;
    unsigned* cnt = (unsigned*)(a.ws + CTL_CNT) + layer * 16 * 64;
    LAS int* lcnt = (LAS int*)(lds + LDS_MISC + 256); LAS int* lbase = lcnt + 16; LAS int* rec = lcnt + 32;
    if (tid < 16) lcnt[tid] = 0;
    int* RTE = (int*)(a.ws + A_RT); int* RTP = RTE + 2 * T; float* RTW = (float*)(RTP + 2 * T); int* TOKL = (int*)(a.ws + A_TOKL);
    const LAS float* wp[16];
#pragma unroll
    for (int e = 0; e < 16; ++e) { wp[e] = wT + e * 2048 + lane * 4; asm volatile("" : "+v"(wp[e])); }
    const float rbl = a.in[I_RB][lane >> 2];
    int lr = wave;
    for (int m = blockIdx.x * 8 + wave; m < T; m += gridDim.x * 8, lr += 8) {
        const int b = m / SEQ; const float* sh = MODl + (size_t)b * 12288 + 3 * 2048; const float* sc = sh + 2048;
        f32x4 v[8]; float s = 0.f;
#pragma unroll
        for (int j = 0; j < 8; ++j) { const u32x2 xp = *(const GAS u32x2*)(XPRE + (size_t)m * D + (lane + 64 * j) * 4); v[j] = (f32x4){bflo(xp.x), bfhi(xp.x), bflo(xp.y), bfhi(xp.y)}; s += (v[j].x + v[j].y) + (v[j].z + v[j].w); }
        const float mean = wave_sum(s) * (1.f / D); float s2 = 0.f;
#pragma unroll
        for (int j = 0; j < 8; ++j) { v[j] = v[j] - mean; s2 += (v[j].x * v[j].x + v[j].y * v[j].y) + (v[j].z * v[j].z + v[j].w * v[j].w); }
        const float rstd = rsqrtf(wave_sum(s2) * (1.f / D) + LN_EPS);
#pragma unroll
        for (int j = 0; j < 8; ++j) { const int col = (lane + 64 * j) * 4; const f32x4 x1 = v[j] * rstd * *(const f32x4*)(lg + col) + *(const f32x4*)(lb + col);
            { u32x2 ox = {pk2(x1.x, x1.y), pk2(x1.z, x1.w)}; *(GAS u32x2*)(X1 + (size_t)m * D + col) = ox; }
            const f32x4 hv = x1 * (*(const f32x4*)(sc + col) + 1.f) + *(const f32x4*)(sh + col);
            *(GAS unsigned*)((unsigned char*)H + (size_t)m * D + col) = pk4_fp8(hv.x, hv.y, hv.z, hv.w); v[j] = hv; }
        f32x2 part2[16];
#pragma unroll
        for (int e = 0; e < 16; ++e) part2[e] = (f32x2){0.f, 0.f};
#pragma unroll
        for (int j = 0; j < 8; ++j) { f32x4 wr_[16];
#pragma unroll
            for (int e = 0; e < 16; ++e) wr_[e] = *(const LAS f32x4*)(wp[e] + j * 256);
            __builtin_amdgcn_sched_barrier(0);
#pragma unroll
            for (int e = 0; e < 16; ++e) { part2[e] += (f32x2){v[j].x, v[j].y} * (f32x2){wr_[e].x, wr_[e].y}; part2[e] += (f32x2){v[j].z, v[j].w} * (f32x2){wr_[e].z, wr_[e].w}; }
            __builtin_amdgcn_sched_barrier(0); }
        float part[16];
#pragma unroll
        for (int e = 0; e < 16; ++e) part[e] = part2[e].x + part2[e].y;
        float r8[8], r4[4], r2[2], lg1;
        { const bool hi = lane & 32;
#pragma unroll
          for (int i = 0; i < 8; ++i) { const float mine = hi ? part[8 + i] : part[i], oth = hi ? part[i] : part[8 + i]; r8[i] = mine + __shfl_xor(oth, 32); } }
        { const bool hi = lane & 16;
#pragma unroll
          for (int i = 0; i < 4; ++i) { const float mine = hi ? r8[4 + i] : r8[i], oth = hi ? r8[i] : r8[4 + i]; r4[i] = mine + __shfl_xor(oth, 16); } }
        { const bool hi = lane & 8;
#pragma unroll
          for (int i = 0; i < 2; ++i) { const float mine = hi ? r4[2 + i] : r4[i], oth = hi ? r4[i] : r4[2 + i]; r2[i] = mine + __shfl_xor(oth, 8); } }
        { const bool hi = lane & 4; const float mine = hi ? r2[1] : r2[0], oth = hi ? r2[0] : r2[1]; lg1 = mine + __shfl_xor(oth, 4); }
        lg1 += dpp_xor1(lg1); lg1 += dpp_xor2(lg1);
        const float sgl = 1.f / (1.f + expf(-lg1)), sbl = sgl + rbl;
        float gs; { const float y1 = dpp_ror<4>(sbl), y2 = dpp_ror<8>(sbl), y3 = dpp_ror<12>(sbl);
            gs = fmaxf(fmaxf(fmaxf(sbl + y1, sbl + y2), fmaxf(sbl + y3, y1 + y2)), fmaxf(y1 + y3, y2 + y3)); }
        int bg = 0; float bgs = __builtin_bit_cast(float, __builtin_amdgcn_readlane(__builtin_bit_cast(int, gs), 0)); asm volatile("" : "+v"(bgs));
#pragma unroll
        for (int g = 1; g < 4; ++g) { float x = __builtin_bit_cast(float, __builtin_amdgcn_readlane(__builtin_bit_cast(int, gs), 16 * g)); asm volatile("" : "+v"(x)); const bool c = x > bgs; bgs = c ? x : bgs; bg = c ? g : bg; }
        const int bgu = __builtin_amdgcn_readfirstlane(bg);
        int e0 = 0, e1 = 0; float b0 = -1e30f, b1 = -1e30f, s0 = 0.f, s1 = 0.f;
#pragma unroll
        for (int i = 0; i < 4; ++i) { float x = __builtin_bit_cast(float, __builtin_amdgcn_readlane(__builtin_bit_cast(int, sbl), 16 * bgu + 4 * i)), sx = __builtin_bit_cast(float, __builtin_amdgcn_readlane(__builtin_bit_cast(int, sgl), 16 * bgu + 4 * i));
            asm volatile("" : "+v"(x), "+v"(sx)); const int e = 4 * bg + i; const bool g0 = x > b0, g1 = x > b1;
            b1 = g0 ? b0 : (g1 ? x : b1); e1 = g0 ? e0 : (g1 ? e : e1); s1 = g0 ? s0 : (g1 ? sx : s1);
            b0 = g0 ? x : b0; e0 = g0 ? e : e0; s0 = g0 ? sx : s0; }
        if (lane == 0) { const float inv = 1.f / (s0 + s1);
            const int p0 = __hip_atomic_fetch_add(lcnt + e0, 1, __ATOMIC_RELAXED, __HIP_MEMORY_SCOPE_WORKGROUP), p1 = __hip_atomic_fetch_add(lcnt + e1, 1, __ATOMIC_RELAXED, __HIP_MEMORY_SCOPE_WORKGROUP);
            rec[lr * 4] = m; rec[lr * 4 + 1] = e0; rec[lr * 4 + 2] = e1; rec[lr * 4 + 3] = p0 | (p1 << 16);
            RTE[2 * m] = e0; RTE[2 * m + 1] = e1; RTW[2 * m] = s0 * inv; RTW[2 * m + 1] = s1 * inv; }
    }
    __syncthreads();
    if (tid < 16) lbase[tid] = (int)atomicAdd(cnt + tid * 64, (unsigned)lcnt[tid]);
    __syncthreads();
    const int nrows = (T - (int)blockIdx.x * 8 + (int)gridDim.x * 8 - 1) / ((int)gridDim.x * 8) * 8;
    for (int i = tid; i < nrows; i += 512) { const int k = i >> 3, w8 = i & 7, m = (int)blockIdx.x * 8 + w8 + k * (int)gridDim.x * 8;
        if (m < T) { const int e0 = rec[i * 4 + 1], e1 = rec[i * 4 + 2], pp = rec[i * 4 + 3], q0 = lbase[e0] + (pp & 0xffff), q1 = lbase[e1] + (pp >> 16);
            TOKL[e0 * T + q0] = m; TOKL[e1 * T + q1] = m; RTP[2 * m] = q0; RTP[2 * m + 1] = q1; } }
    __syncthreads();
}

DI void moe_table(const KArgs& a, LAS unsigned char* lds, int layer, int wv) {
    LAS int* tab = (LAS int*)(lds + LDS_TAB);
    if (otid(wv) == 0) { const unsigned* cnt = (const unsigned*)(a.ws + CTL_CNT) + layer * 16 * 64; int acc = 0;
        for (int e = 0; e < 16; ++e) { const int c = (int)cnt[e * 64]; tab[e] = acc; tab[32 + e] = c; acc += (c + 255) >> 8; } tab[16] = acc; }
    __syncthreads();
}
template <int NTB> struct MoeOrder {
    int G, c, layer; const LAS int* tab; const int* tokl;
    DI bool next(int i, Unit& u) const { const int L = i * G + c, mt = L / NTB, nt = L % NTB; if (mt >= tab[16]) return false; int e = 0;
#pragma unroll
        for (int k = 1; k < 16; ++k) e += (mt >= tab[k]) ? 1 : 0;
        u.pm = mt; u.pn = (layer * 16 + e) * NTB + nt; u.aux = e | (nt << 8) | ((mt - tab[e]) << 16); return true; }
    DI int arow(const Unit& u, int r) const { const int e = u.aux & 255, j = (u.aux >> 16) * 256 + r; return j < tab[32 + e] ? tokl[e * T + j] : 0; }
    DI int koff(const Unit&) const { return 0; }
};
struct EpiGateUp { static constexpr bool PERM = true;
    unsigned char* ACT;
    DI void operator()(const Acc& acc, const Unit& u, int wr, int wc, int fr, int fq) const {
        const int nt = (u.aux >> 8) & 255;
        EPI_ROWS_BEGIN
            const f32x4 g0 = acc[ai][0][m][0], g1 = acc[ai][0][m][1], u0 = acc[ai][1][m][0], u1 = acc[ai][1][m][1];
            f32x4 o0, o1;
#pragma unroll
            for (int e = 0; e < 4; ++e) { o0[e] = g0[e] * sigmoidf_(g0[e]) * u0[e]; o1[e] = g1[e] * sigmoidf_(g1[e]) * u1[e]; }
            u32x2 o8 = {pk4_fp8(o0.x, o0.y, o0.z, o0.w), pk4_fp8(o1.x, o1.y, o1.z, o1.w)}; *(u32x2*)P32(ACT, row * 512 + nt * 128 + 32 * wc + 8 * fq) = o8;
        EPI_ROWS_END
    }
};
struct EpiDown { static constexpr bool PERM = true;
    bf16* YS;
    DI void operator()(const Acc& acc, const Unit& u, int wr, int wc, int fr, int fq) const {
        const int nt = (u.aux >> 8) & 255;
        EPI_ROWS_BEGIN
#pragma unroll
            for (int bj = 0; bj < 2; ++bj) *(u32x4*)P32(YS, row * 2048 + nt * 256 + 128 * bj + 32 * wc + 8 * fq) = pack8(acc[ai][bj][m][0], acc[ai][bj][m][1]);
        EPI_ROWS_END
    }
};
DI void ln_ffn_phase(const KArgs& a, int layer, const bf16* X1, float* XO, bf16* Hn, int wv) {
    const int lane = otid(wv) & 63, wave = otid(wv) >> 6;
    const float* MODl = (const float*)(a.ws + CTL_MOD) + (size_t)layer * 4 * 12288; const float* MODn = MODl + 4 * 12288;
    const float* lg = a.in[I_LNFG] + layer * D; const float* lb = a.in[I_LNFB] + layer * D;
    const unsigned* cnt = (const unsigned*)(a.ws + CTL_CNT) + layer * 16 * 64;
    const int* RTE = (const int*)(a.ws + A_RT); const int* RTP = RTE + 2 * T; const float* RTW = (const float*)(RTP + 2 * T); const bf16* YS = (const bf16*)(a.ws + A_YS);
    for (int m = blockIdx.x * 8 + wave; m < T; m += gridDim.x * 8) {
        const int b = m / SEQ; const float* gf = MODl + (size_t)b * 12288 + 5 * 2048;
        const int e0 = RTE[2 * m], e1 = RTE[2 * m + 1]; int t0 = 0, t1 = 0;
        for (int e = 0; e < 16; ++e) { const int tl = ((int)cnt[e * 64] + 255) >> 8; t0 += e < e0 ? tl : 0; t1 += e < e1 ? tl : 0; }
        const bf16* y0 = YS + ((size_t)t0 * 256 + RTP[2 * m]) * 2048; const bf16* y1 = YS + ((size_t)t1 * 256 + RTP[2 * m + 1]) * 2048; const float w0 = RTW[2 * m], w1 = RTW[2 * m + 1];
        f32x4 v[8]; float s = 0.f;
#pragma unroll
        for (int j = 0; j < 8; ++j) { const int col = (lane + 64 * j) * 4; const u32x2 a0 = *(const u32x2*)(y0 + col), a1 = *(const u32x2*)(y1 + col);
            const f32x4 y = {w0 * bflo(a0.x) + w1 * bflo(a1.x), w0 * bfhi(a0.x) + w1 * bfhi(a1.x), w0 * bflo(a0.y) + w1 * bflo(a1.y), w0 * bfhi(a0.y) + w1 * bfhi(a1.y)};
            const u32x2 xq = *(const u32x2*)(X1 + (size_t)m * D + col); const f32x4 xv = {bflo(xq.x), bfhi(xq.x), bflo(xq.y), bfhi(xq.y)};
            v[j] = xv * DN_ALPHA + (*(const f32x4*)(gf + col) + 1.f) * y; s += (v[j].x + v[j].y) + (v[j].z + v[j].w); }
        const float mean = wave_sum(s) * (1.f / D); float s2 = 0.f;
#pragma unroll
        for (int j = 0; j < 8; ++j) { v[j] = v[j] - mean; s2 += (v[j].x * v[j].x + v[j].y * v[j].y) + (v[j].z * v[j].z + v[j].w * v[j].w); }
        const float rstd = rsqrtf(wave_sum(s2) * (1.f / D) + LN_EPS);
#pragma unroll
        for (int j = 0; j < 8; ++j) { const int col = (lane + 64 * j) * 4; const f32x4 xo = v[j] * rstd * *(const f32x4*)(lg + col) + *(const f32x4*)(lb + col);
            if (Hn) { u32x2 oq = {pk2(xo.x, xo.y), pk2(xo.z, xo.w)}; *(u32x2*)((bf16*)XO + (size_t)m * D + col) = oq; }
            else *(f32x4*)(XO + (size_t)m * D + col) = xo;
            if (Hn) { const float* sh = MODn + (size_t)b * 12288; const f32x4 hv = xo * (*(const f32x4*)(sh + 2048 + col) + 1.f) + *(const f32x4*)(sh + col);
                *(unsigned*)((unsigned char*)Hn + (size_t)m * D + col) = pk4_fp8(hv.x, hv.y, hv.z, hv.w); } }
    }
}

struct EpiIn1 { static constexpr bool PERM = true;
    bf16 *ZD, *ZR;
    DI void operator()(const Acc& acc, const Unit& u, int wr, int wc, int fr, int fq) const {
        EPI_ROWS_BEGIN
#pragma unroll
            for (int bj = 0; bj < 2; ++bj) { const int col = u.pn * 256 + 128 * bj + 32 * wc + 8 * fq; const u32x4 o = pack8(acc[ai][bj][m][0], acc[ai][bj][m][1]);
                if (col < DIL_IN) *(u32x4*)P32(ZD, row * DIL_IN + col) = o; else if (col < ODD_IN) *(u32x4*)P32(ZR, row * RW_IN + (col - DIL_IN)) = o; }
        EPI_ROWS_END
    }
};
constexpr int DA_KSTR = 272, DA_VROW = 320, DA_KBYTES = 64 * DA_KSTR, DA_STG = DA_KBYTES + 64 * DA_VROW;
struct DilPre { bf16x8 qf[4]; u32x4 kreg[2], vreg[2]; float blv[2]; };
DI void dil_issue(const bf16* ZD, const float* BL, int unit, int wv, DilPre& P) {
    const int tid = otid(wv), lane = tid & 63, w = tid >> 6, r = lane & 31, hh = lane >> 5, hd = w >> 2, qs = w & 3;
    const int hp = unit & 3, sb_ = (unit >> 2) & 31, gi = (unit >> 7) % 3, b = unit / 384;
    const int dil = gi == 0 ? 1 : (gi == 1 ? 4 : 16), nb = 32 / dil, rr = sb_ / nb, n = sb_ % nb, h = hp * 2 + hd, kt0 = n == 0 ? 2 : 0;
    const bf16* Zb = ZD + (size_t)b * SEQ * DIL_IN + gi * 1536;
    const int qtok = (n * 128 + 32 * qs + r) * dil + rr;
#pragma unroll
    for (int k = 0; k < 2; ++k) { const int i = tid + 512 * k, hd_ = i >= 384 ? 1 : 0, d = i - 384 * hd_ - 127;
        P.blv[k] = (i < 768 && d >= 0 && d <= 128) ? ((const GAS float*)BL)[(gi * 8 + hp * 2 + hd_) * 132 + d] : -1e30f; }
#pragma unroll
    for (int ks = 0; ks < 4; ++ks) P.qf[ks] = *(const GAS bf16x8*)P32(Zb, qtok * DIL_IN + h * 64 + 16 * ks + 8 * hh);
#pragma unroll
    for (int i = 0; i < 2; ++i) { const int p = tid + 512 * i, kr = p >> 4, c16 = p & 15; const int ktok = ((n - 1) * 128 + kt0 * 64 + kr) * dil + rr;
        P.kreg[i] = *(const GAS u32x4*)P32(Zb, ktok * DIL_IN + 512 + hp * 128 + c16 * 8); P.vreg[i] = *(const GAS u32x4*)P32(Zb, ktok * DIL_IN + 1024 + hp * 128 + c16 * 8); }
}
DI void dil_attn_unit(LAS unsigned char* lds, const bf16* ZD, const float* BL, bf16* DPO, float* DPM, float* DPL, int unit, int next, DilPre& P, int wv) {
    const int tid = otid(wv), lane = tid & 63, w = tid >> 6, r = lane & 31, hh = lane >> 5, hd = w >> 2, qs = w & 3;
    const int hp = unit & 3, sb_ = (unit >> 2) & 31, gi = (unit >> 7) % 3, b = unit / 384;
    const int dil = gi == 0 ? 1 : (gi == 1 ? 4 : 16), nb = 32 / dil, rr = sb_ / nb, n = sb_ % nb;
    const int h = hp * 2 + hd;
    const bf16* Zb = ZD + (size_t)b * SEQ * DIL_IN + gi * 1536;
    LAS float* bl = (LAS float*)(lds + 2 * DA_STG);
    __syncthreads();
    bl[tid] = P.blv[0]; if (tid < 256) bl[512 + tid] = P.blv[1];
    const int qi = 32 * qs + r, qtok = (n * 128 + qi) * dil + rr;
    bf16x8 qf[4];
#pragma unroll
    for (int ks = 0; ks < 4; ++ks) qf[ks] = P.qf[ks];
    f32x16 O[2];
#pragma unroll
    for (int i = 0; i < 2; ++i) for (int e = 0; e < 16; ++e) O[i][e] = 0.f;
    float mrow = -1e30f, lrow = 0.f;
    u32x4 kreg[2] = {P.kreg[0], P.kreg[1]}, vreg[2] = {P.vreg[0], P.vreg[1]};
    const int kt0 = n == 0 ? 2 : 0;
#define DA_LOAD(kt) do { _Pragma("unroll") for (int i = 0; i < 2; ++i) { const int p = tid + 512 * i, kr = p >> 4, c16 = p & 15; const int ktok = ((n - 1) * 128 + (kt) * 64 + kr) * dil + rr; \
            kreg[i] = *(const GAS u32x4*)P32(Zb, ktok * DIL_IN + 512 + hp * 128 + c16 * 8); } \
        _Pragma("unroll") for (int i = 0; i < 2; ++i) { const int p = tid + 512 * i, kr = p >> 4, c16 = p & 15; const int ktok = ((n - 1) * 128 + (kt) * 64 + kr) * dil + rr; vreg[i] = *(const GAS u32x4*)P32(Zb, ktok * DIL_IN + 1024 + hp * 128 + c16 * 8); } } while (0)
#define DA_STORE(buf) do { LAS unsigned char* sb = lds + (buf) * DA_STG; _Pragma("unroll") for (int i = 0; i < 2; ++i) { const int p = tid + 512 * i, kr = p >> 4, c16 = p & 15; *(LAS u32x4*)(sb + kr * DA_KSTR + c16 * 16) = kreg[i]; } \
        _Pragma("unroll") for (int i = 0; i < 2; ++i) { const int p = tid + 512 * i; *(LAS u32x4*)(sb + DA_KBYTES + (p >> 4) * DA_VROW + (p & 15) * 16) = vreg[i]; } } while (0)
    DA_STORE(kt0 & 1);
    __syncthreads();
    for (int kt = kt0; kt < 4; ++kt) {
        if (kt + 1 < 4) DA_LOAD(kt + 1); else if (next >= 0) dil_issue(ZD, BL, next, wv, P);
        const LAS unsigned char* sb = lds + (kt & 1) * DA_STG;
        if (64 * kt + 63 >= 32 * qs && 64 * kt <= 32 * qs + 31 + 128) {
            f32x16 st[2];
#pragma unroll
            for (int mt = 0; mt < 2; ++mt) for (int e = 0; e < 16; ++e) st[mt][e] = 0.f;
            __builtin_amdgcn_sched_barrier(0);
            {
                const LAS unsigned char* kb = sb + r * DA_KSTR + (hd * 64 + 8 * hh) * 2; bf16x8 kf[8];
#pragma unroll
                for (int i = 0; i < 8; ++i) kf[i] = *(const LAS bf16x8*)(kb + 32 * (i & 1) * DA_KSTR + 32 * (i >> 1));
#pragma unroll
                for (int i = 0; i < 8; ++i) st[i & 1] = MFMA32(kf[i], qf[i >> 1], st[i & 1]);
                __builtin_amdgcn_sched_group_barrier(0x100, 3, 0);
#pragma unroll
                for (int i = 0; i < 8; ++i) { __builtin_amdgcn_sched_group_barrier(0x008, 1, 0); __builtin_amdgcn_sched_group_barrier(0x100, 1, 0); }
            }
            __builtin_amdgcn_sched_barrier(0);
#pragma unroll
            for (int mt = 0; mt < 2; ++mt) { const LAS float* lp = bl + hd * 384 + 127 + (128 + qi - 64 * kt - 32 * mt - 4 * hh) - 27;
#pragma unroll
                for (int e = 0; e < 16; ++e) st[mt][e] = st[mt][e] * (0.125f * 1.44269504089f) + lp[27 - ((e & 3) + 8 * (e >> 2))]; }
            float mx = st[0][0];
#pragma unroll
            for (int mt = 0; mt < 2; ++mt)
#pragma unroll
                for (int e = 0; e < 16; ++e) mx = fmaxf(mx, st[mt][e]);
            { const unsigned xi_ = __float_as_uint(mx); const auto rr_ = __builtin_amdgcn_permlane32_swap(xi_, xi_, false, false); mx = fmaxf(__uint_as_float(rr_[0]), __uint_as_float(rr_[1])); }
            float alpha = 1.f;
            if (__any(mx - mrow > 8.f)) { const float mnew = fmaxf(mrow, mx); alpha = __builtin_amdgcn_exp2f(mrow - mnew); mrow = mnew; O[0] *= alpha; O[1] *= alpha; }
            float ls = 0.f;
#pragma unroll
            for (int mt = 0; mt < 2; ++mt)
#pragma unroll
                for (int e = 0; e < 16; ++e) { const float p = __builtin_amdgcn_exp2f(st[mt][e] - mrow); st[mt][e] = p; ls += p; }
            lrow = lrow * alpha + ls;
            bf16x8 pf[2][2];
#pragma unroll
            for (int mt = 0; mt < 2; ++mt)
#pragma unroll
                for (int s = 0; s < 2; ++s) { u32x4 pk = {pk2(st[mt][8 * s], st[mt][8 * s + 1]), pk2(st[mt][8 * s + 2], st[mt][8 * s + 3]), pk2(st[mt][8 * s + 4], st[mt][8 * s + 5]), pk2(st[mt][8 * s + 6], st[mt][8 * s + 7])};
                    pf[mt][s] = __builtin_bit_cast(bf16x8, pk); }
            __builtin_amdgcn_sched_barrier(0);
            {
                const LAS unsigned char* vb = sb + DA_KBYTES + (4 * hh + ((lane >> 2) & 3)) * DA_VROW + (hd * 64 + 16 * ((lane >> 4) & 1)) * 2 + 8 * (lane & 3); bf16x8 af[8];
#pragma unroll
                for (int i = 0; i < 8; ++i) { const LAS unsigned char* vp = vb + 16 * (i >> 1) * DA_VROW + (i & 1) * 64;
                    const s16x4 lo = __builtin_amdgcn_ds_read_tr16_b64_v4i16((LAS s16x4*)vp), hi = __builtin_amdgcn_ds_read_tr16_b64_v4i16((LAS s16x4*)(vp + 8 * DA_VROW)); af[i] = __builtin_shufflevector(lo, hi, 0, 1, 2, 3, 4, 5, 6, 7); }
#pragma unroll
                for (int i = 0; i < 8; ++i) O[i & 1] = MFMA32(af[i], pf[i >> 2][(i >> 1) & 1], O[i & 1]);
                __builtin_amdgcn_sched_group_barrier(0x100, 6, 0);
#pragma unroll
                for (int i = 0; i < 8; ++i) { __builtin_amdgcn_sched_group_barrier(0x008, 1, 0); __builtin_amdgcn_sched_group_barrier(0x100, 2, 0); }
            }
            __builtin_amdgcn_sched_barrier(0);
        }
        if (kt + 1 < 4) DA_STORE((kt + 1) & 1);
        __syncthreads();
    }
    lrow += __shfl_xor(lrow, 32);
    const float inv = 1.f / lrow;
    const int tokg = b * SEQ + qtok;
    bf16* orow = P32(DPO, (gi * T + tokg) * 512 + h * 64);
#pragma unroll
    for (int dvt = 0; dvt < 2; ++dvt)
#pragma unroll
        for (int g4 = 0; g4 < 4; ++g4) { u32x2 o = {pk2(O[dvt][4 * g4] * inv, O[dvt][4 * g4 + 1] * inv), pk2(O[dvt][4 * g4 + 2] * inv, O[dvt][4 * g4 + 3] * inv)};
            *(GAS u32x2*)(orow + dvt * 32 + 8 * g4 + 4 * hh) = o; }
    if (hh == 0) { *(GAS float*)P32(DPM, (gi * T + tokg) * 8 + h) = mrow; *(GAS float*)P32(DPL, (gi * T + tokg) * 8 + h) = lrow; }
#undef DA_LOAD
#undef DA_STORE
}
DI void dil_merge(const bf16* DPO, const float* DPM, const float* DPL, bf16* MIX, int wv) {
    const int gt = blockIdx.x * 512 + otid(wv), NT_ = gridDim.x * 512;
    for (int i = gt; i < T * 64; i += NT_) { const int tok = i >> 6, c8 = i & 63, h = c8 >> 3;
        float m[3], l[3];
#pragma unroll
        for (int g = 0; g < 3; ++g) { m[g] = DPM[((size_t)g * T + tok) * 8 + h]; l[g] = DPL[((size_t)g * T + tok) * 8 + h]; }
        const float M = fmaxf(m[0], fmaxf(m[1], m[2])); float wsum = 0.f, wg[3];
#pragma unroll
        for (int g = 0; g < 3; ++g) { wg[g] = __builtin_amdgcn_exp2f(m[g] - M) * l[g]; wsum += wg[g]; }
        const float inv = __builtin_amdgcn_rcpf(wsum); float o[8];
#pragma unroll
        for (int e = 0; e < 8; ++e) o[e] = 0.f;
#pragma unroll
        for (int g = 0; g < 3; ++g) { const u32x4 v = *(const u32x4*)(DPO + ((size_t)g * T + tok) * 512 + c8 * 8); const float wn = wg[g] * inv;
            o[0] += wn * bflo(v.x); o[1] += wn * bfhi(v.x); o[2] += wn * bflo(v.y); o[3] += wn * bfhi(v.y); o[4] += wn * bflo(v.z); o[5] += wn * bfhi(v.z); o[6] += wn * bflo(v.w); o[7] += wn * bfhi(v.w); }
        u32x2 r = {pk4_fp8(o[0], o[1], o[2], o[3]), pk4_fp8(o[4], o[5], o[6], o[7])}; *(u32x2*)((unsigned char*)MIX + (size_t)tok * 2048 + c8 * 8) = r; }
}

DI void rwkv_prep(const bf16* ZR, const float* mu, bf16* LIN, int wv) {
    const int gt = blockIdx.x * 512 + otid(wv), NT_ = gridDim.x * 512;
    for (int i = gt; i < T * 48; i += NT_) { const int tok = i / 48, c0 = (i % 48) * 8, s = tok % SEQ; float o[8];
        if (c0 < 352) { const u32x4 z = *(const u32x4*)(ZR + (size_t)tok * RW_IN + 4608 + c0); u32x4 zp = {0u, 0u, 0u, 0u}; if (s > 0) zp = *(const u32x4*)(ZR + (size_t)(tok - 1) * RW_IN + 4608 + c0);
            const unsigned* zz = (const unsigned*)&z; const unsigned* pp = (const unsigned*)&zp;
#pragma unroll
            for (int e = 0; e < 8; ++e) { const float zv = (e & 1) ? bfhi(zz[e >> 1]) : bflo(zz[e >> 1]), pv = (e & 1) ? bfhi(pp[e >> 1]) : bflo(pp[e >> 1]); const float xs = zv + (pv - zv) * mu[4608 + c0 + e];
                o[e] = c0 < 64 ? 1.f - 2.f * __builtin_amdgcn_rcpf(1.f + __expf(2.f * xs)) : (c0 < 128 ? xs : sigmoidf_(xs)); } }
        else {
#pragma unroll
            for (int e = 0; e < 8; ++e) o[e] = 0.f; }
        u32x4 r = {pk2(o[0], o[1]), pk2(o[2], o[3]), pk2(o[4], o[5]), pk2(o[6], o[7])}; *(u32x4*)(LIN + (size_t)tok * 384 + c0) = r; }
}
struct LoraOrder : pg8::StaticOrder { DI int koff(const Unit& u) const { return u.pn >= 12 ? 128 : 0; } };
struct EpiLora { static constexpr bool PERM = true;
    bf16 *WDEC, *AA, *GG; const float *w0, *a0;
    DI void operator()(const Acc& acc, const Unit& u, int wr, int wc, int fr, int fq) const {
        const int kind = u.pn / 6;
        EPI_ROWS_BEGIN
#pragma unroll
            for (int bj = 0; bj < 2; ++bj) { const int col = (u.pn % 6) * 256 + 128 * bj + 32 * wc + 8 * fq; f32x4 v0 = acc[ai][bj][m][0], v1 = acc[ai][bj][m][1];
                if (kind == 0) { const f32x4 b0 = *(const f32x4*)P32(w0, col), b1 = *(const f32x4*)P32(w0, col + 4);
#pragma unroll
                    for (int e = 0; e < 4; ++e) { v0[e] = -0.6065306597f * sigmoidf_(v0[e] + b0[e]); v1[e] = -0.6065306597f * sigmoidf_(v1[e] + b1[e]); }
                    *(u32x4*)P32(WDEC, row * RWW + col) = pack8(v0, v1); }
                else if (kind == 1) { const f32x4 b0 = *(const f32x4*)P32(a0, col), b1 = *(const f32x4*)P32(a0, col + 4);
#pragma unroll
                    for (int e = 0; e < 4; ++e) { v0[e] = sigmoidf_(v0[e] + b0[e]); v1[e] = sigmoidf_(v1[e] + b1[e]); }
                    *(u32x4*)P32(AA, row * RWW + col) = pack8(v0, v1); }
                else *(u32x4*)P32(GG, row * RWW + col) = pack8(v0, v1); }
        EPI_ROWS_END
    }
};
constexpr int CK_AT = 0, CK_RT = 2048, CK_BH = 4096, CK_KH = 6144, CK_MT = 8192, CK_NK = 8704, CK_PB = 9216, CK_PK = 9728, CK_G15 = 10240, CK_VT = 10496  , CK_VTS = 40, CK_BS = 13056  , CK_SLOT = 13120;
constexpr int CK_HALF = 128;
constexpr int CK_N1 = (int)((128 * MiB) / CK_SLOT) - 1;
DI unsigned char* ck_slot(unsigned char* ws, int job) { return job < CK_N1 ? ws + WS_X1 + (size_t)job * CK_SLOT : ws + WS_W_GU + (size_t)(job - CK_N1) * CK_SLOT; }
static_assert((size_t)(96 * CK_HALF - CK_N1 + 1) * CK_SLOT <= 64 * MiB, "chunk buffer");
constexpr int PJ = 4;
constexpr int PL_AT = 0, PL_BT = 2304, PL_KT = 4608, PL_RT = 6912, PL_BH = 9216, PL_KH = 11520  ,
              PL_NAB = 13824  , PL_MTS = 14848  , PL_LDT = 15616  , PL_C = 19968  ,
              PL_T = 24064  , PL_VT = 24320  , PL_END = 26880;
static_assert(PJ * PL_END <= RING_BYTES && PJ == 4, "prep LDS");
DI bf16x8 ldfrag(const LAS unsigned char* p) { return *(const LAS bf16x8*)p; }
DI u32x4 ld2x8(const LAS unsigned char* p0, const LAS unsigned char* p1) { const u32x2 lo = *(const LAS u32x2*)p0, hi = *(const LAS u32x2*)p1; return (u32x4){lo.x, lo.y, hi.x, hi.y}; }
DI void unpk8(const u32x4 v, float (&o)[8]) { o[0] = bflo(v.x); o[1] = bfhi(v.x); o[2] = bflo(v.y); o[3] = bfhi(v.y); o[4] = bflo(v.z); o[5] = bfhi(v.z); o[6] = bflo(v.w); o[7] = bfhi(v.w); }
DI void ldf8(const float* p, float (&o)[8]) { const f32x4 x = *(const f32x4*)p, y = *(const f32x4*)(p + 4); o[0] = x.x; o[1] = x.y; o[2] = x.z; o[3] = x.w; o[4] = y.x; o[5] = y.y; o[6] = y.z; o[7] = y.w; }
DI u32x4 pack8(const float (&x)[8]) { return (u32x4){pk2(x[0], x[1]), pk2(x[2], x[3]), pk2(x[4], x[5]), pk2(x[6], x[7])}; }
DI void rwkv_chunk_prep(const KArgs& a, LAS unsigned char* lds0, int half, int wv) {
    const int tid = otid(wv), lane = tid & 63, w = tid >> 6;
    const bf16* ZR = (const bf16*)(a.ws + A_ZR); const bf16* WDEC = (const bf16*)(a.ws + A_WDEC); const bf16* AA = (const bf16*)(a.ws + A_AA);
    const int js = tid >> 7, st = (tid >> 3) & 15, oc = tid & 7;
    LAS unsigned char* ldj = lds0 + js * PL_END;
    const float* mu = a.in[I_MU];
    bf16x8 lfrag;
#pragma unroll
    for (int j = 0; j < 8; ++j) lfrag[j] = ((lane & 31) >= 16 || 8 * (lane >> 5) + j <= (lane & 31)) ? (short)0x3F80 : (short)0;
    for (int it = blockIdx.x; it < 96 * CK_HALF / PJ; it += gridDim.x) {
        const int job0 = it * PJ, bh = job0 / CK_HALF, cl0 = job0 % CK_HALF, b = bh / 24, h = bh % 24, col = h * 64 + 8 * oc;
        const int s = (half * CK_HALF + cl0 + js) * 16 + st; const size_t tok = (size_t)b * SEQ + s;
        unsigned char* slot = ck_slot(a.ws, job0 + js);
        const bf16* z = ZR + tok * RW_IN + col;
        const u32x4 zr = *(const u32x4*)z, zk = *(const u32x4*)(z + 1536), zv = *(const u32x4*)(z + 3072);
        u32x4 pr = {0u, 0u, 0u, 0u}, pk_ = {0u, 0u, 0u, 0u}, pv = {0u, 0u, 0u, 0u};
        if (s > 0) { pr = *(const u32x4*)(z - RW_IN); pk_ = *(const u32x4*)(z - RW_IN + 1536); pv = *(const u32x4*)(z - RW_IN + 3072); }
        const u32x4 za = *(const u32x4*)(AA + tok * RWW + col), zw = *(const u32x4*)(WDEC + tok * RWW + col);
        float r[8], km[8], q[8], bb[8], ld[8];
        {   float cz[8], cp[8], m_[8], k_[8], v_[8], as_[8], c1[8], c2[8];
            unpk8(zr, cz); unpk8(pr, cp); ldf8(mu + col, m_);
#pragma unroll
            for (int e = 0; e < 8; ++e) r[e] = cz[e] + (cp[e] - cz[e]) * m_[e];
            unpk8(zk, cz); unpk8(pk_, cp); ldf8(mu + 1536 + col, m_);
#pragma unroll
            for (int e = 0; e < 8; ++e) k_[e] = cz[e] + (cp[e] - cz[e]) * m_[e];
            unpk8(zv, cz); unpk8(pv, cp); ldf8(mu + 3072 + col, m_);
#pragma unroll
            for (int e = 0; e < 8; ++e) v_[e] = cz[e] + (cp[e] - cz[e]) * m_[e];
            unpk8(za, as_); unpk8(zw, ld); ldf8(a.in[I_KK] + col, c1);
            float nn = 0.f;
#pragma unroll
            for (int e = 0; e < 8; ++e) { q[e] = k_[e] * c1[e]; nn += q[e] * q[e]; }
            nn = red8(nn);
            const float invn = fminf(__builtin_amdgcn_rsqf(nn), 1e12f);
            ldf8(a.in[I_KA] + col, c1); ldf8(a.in[I_RK] + col, c2);
            float bs = 0.f;
#pragma unroll
            for (int e = 0; e < 8; ++e) { q[e] *= invn; km[e] = k_[e] * (1.f + (as_[e] - 1.f) * c1[e]); bb[e] = q[e] * as_[e]; bs += r[e] * km[e] * c2[e]; }
            bs = red8(bs);
            if (oc == 0) *(float*)(slot + CK_BS + st * 4) = bs;
#pragma unroll
            for (int e = 0; e < 8; ++e) *(LAS float*)(ldj + PL_LDT + ((8 * oc + e) * 17 + st) * 4) = ld[e];
#pragma unroll
            for (int e = 0; e < 8; e += 2) { const unsigned pv2 = pk2(v_[e], v_[e + 1]);
                *(LAS bf16*)(ldj + PL_VT + (8 * oc + e) * CK_VTS + st * 2) = (bf16)(pv2 & 0xffffu); *(LAS bf16*)(ldj + PL_VT + (8 * oc + e + 1) * CK_VTS + st * 2) = (bf16)(pv2 >> 16); } }
        __syncthreads();
        {
            LAS unsigned char* lds = lds0 + (w >> 1) * PL_END; const int r_ = lane & 31, hh = lane >> 5, ch = 32 * (w & 1) + r_;
            float x[8];
#pragma unroll
            for (int j = 0; j < 8; ++j) x[j] = *(const LAS float*)(lds + PL_LDT + (ch * 17 + 8 * hh + j) * 4);
            const u32x4 ph = {pk2(x[0], x[1]), pk2(x[2], x[3]), pk2(x[4], x[5]), pk2(x[6], x[7])};
            const u32x4 pl = {pk2(x[0] - bflo(ph.x), x[1] - bfhi(ph.x)), pk2(x[2] - bflo(ph.y), x[3] - bfhi(ph.y)), pk2(x[4] - bflo(ph.z), x[5] - bfhi(ph.z)), pk2(x[6] - bflo(ph.w), x[7] - bfhi(ph.w))};
            f32x16 cs; for (int e = 0; e < 16; ++e) cs[e] = 0.f;
            cs = MFMA32(lfrag, __builtin_bit_cast(bf16x8, ph), cs); cs = MFMA32(lfrag, __builtin_bit_cast(bf16x8, pl), cs);
#pragma unroll
            for (int e = 0; e < 8; ++e) *(LAS float*)(lds + PL_C + (((e & 3) + 8 * (e >> 2) + 4 * hh) * 64 + ch) * 4) = cs[e];
            if (hh == 0) *(LAS float*)(lds + PL_T + ch * 4) = cs[8]; }
        __syncthreads();
        {
            float c[8], t[8];
            { const f32x4 ca = *(const LAS f32x4*)(ldj + PL_C + (st * 64 + 8 * oc) * 4), cb = *(const LAS f32x4*)(ldj + PL_C + (st * 64 + 8 * oc + 4) * 4), ta = *(const LAS f32x4*)(ldj + PL_T + 8 * oc * 4), tb = *(const LAS f32x4*)(ldj + PL_T + (8 * oc + 4) * 4);
              c[0] = ca.x; c[1] = ca.y; c[2] = ca.z; c[3] = ca.w; c[4] = cb.x; c[5] = cb.y; c[6] = cb.z; c[7] = cb.w; t[0] = ta.x; t[1] = ta.y; t[2] = ta.z; t[3] = ta.w; t[4] = tb.x; t[5] = tb.y; t[6] = tb.z; t[7] = tb.w; }
            float at[8], bt[8], kt[8], rt[8], bhv[8], khv[8];
#pragma unroll
            for (int e = 0; e < 8; ++e) { const float g = __expf(c[e]), gp = __expf(c[e] - ld[e]), gi = __expf(-c[e]), gr = __expf(t[e] - c[e]);
                at[e] = -q[e] * gp; bt[e] = bb[e] * gi; kt[e] = km[e] * gi; rt[e] = r[e] * g; bhv[e] = bb[e] * gr; khv[e] = km[e] * gr; }
            LAS unsigned char* row = ldj + st * 144 + oc * 16;
            *(LAS u32x4*)(row + PL_AT) = pack8(at); *(LAS u32x4*)(row + PL_BT) = pack8(bt); *(LAS u32x4*)(row + PL_KT) = pack8(kt); *(LAS u32x4*)(row + PL_RT) = pack8(rt);
            *(LAS u32x4*)(row + PL_BH) = pack8(bhv); *(LAS u32x4*)(row + PL_KH) = pack8(khv);
            if (st == 0) { *(f32x4*)(slot + CK_G15 + 8 * oc * 4) = (f32x4){__expf(t[0]), __expf(t[1]), __expf(t[2]), __expf(t[3])}; *(f32x4*)(slot + CK_G15 + (8 * oc + 4) * 4) = (f32x4){__expf(t[4]), __expf(t[5]), __expf(t[6]), __expf(t[7])}; } }
        __syncthreads();
        if (w < PJ) {
            LAS unsigned char* lds = lds0 + w * PL_END; unsigned char* slot = ck_slot(a.ws, job0 + w); const int r = lane & 31, hh = lane >> 5, r16 = r & 15;
            f32x16 d; for (int e = 0; e < 16; ++e) d[e] = 0.f;
#pragma unroll
            for (int ks = 0; ks < 4; ++ks) d = MFMA32(ldfrag(lds + (r < 16 ? PL_BT : PL_KT) + r16 * 144 + ks * 32 + hh * 16), ldfrag(lds + (r < 16 ? PL_AT : PL_RT) + r16 * 144 + ks * 32 + hh * 16), d);
            float lo8[8], hi8[8];
#pragma unroll
            for (int e = 0; e < 8; ++e) { const int sr = (e & 3) + 8 * (e >> 2) + 4 * hh; const bool keep = r < 16 ? sr < r16 : sr <= r16; lo8[e] = keep ? d[e] : 0.f; hi8[e] = keep ? d[8 + e] : 0.f; }
            const u32x4 plo = {pk2(lo8[0], lo8[1]), pk2(lo8[2], lo8[3]), pk2(lo8[4], lo8[5]), pk2(lo8[6], lo8[7])}, phi = {pk2(hi8[0], hi8[1]), pk2(hi8[2], hi8[3]), pk2(hi8[4], hi8[5]), pk2(hi8[6], hi8[7])};
            if (r < 16) {
#pragma unroll
                for (int e = 0; e < 8; ++e) *(LAS float*)(lds + PL_NAB + (((e & 3) + 8 * (e >> 2) + 4 * hh) * 16 + r16) * 4) = lo8[e];
                *(u32x4*)(slot + CK_NK + (r16 + 16 * hh) * 16) = phi; }
            else { *(u32x4*)(slot + CK_PB + (r16 + 16 * hh) * 16) = plo; *(u32x4*)(slot + CK_PK + (r16 + 16 * hh) * 16) = phi; }
            asm volatile("s_waitcnt lgkmcnt(0)" ::: "memory");
            if (lane < 16) { float mr[16]; int ln = lane; asm volatile("" : "+v"(ln));
#pragma unroll
                for (int t = 0; t < 16; ++t) { float acc = (ln == t) ? 1.f : 0.f;
#pragma unroll
                    for (int u = 0; u < t; ++u) acc += mr[u] * *(const LAS float*)(lds + PL_NAB + (u * 16 + t) * 4);
                    mr[t] = acc; *(LAS bf16*)(lds + PL_MTS + t * 48 + lane * 2) = f2bf(acc); } }
            asm volatile("s_waitcnt lgkmcnt(0)" ::: "memory");
            if (r < 16) *(u32x4*)(slot + CK_MT + (r + 16 * hh) * 16) = ld2x8(lds + PL_MTS + r * 48 + 8 * hh, lds + PL_MTS + r * 48 + 16 + 8 * hh);
        } else {
            const int e2 = tid - 256;
#pragma unroll
            for (int q4 = 0; q4 < PJ; ++q4) { const LAS unsigned char* lds = lds0 + q4 * PL_END; unsigned char* slot = ck_slot(a.ws, job0 + q4);
                { const int arr = e2 >> 7, i7 = e2 & 127, ks = i7 >> 5, t = i7 & 15, hh = (i7 >> 4) & 1;
                  const LAS unsigned char* p = lds + (arr ? PL_RT : PL_AT) + t * 144 + (16 * ks + 4 * hh) * 2;
                  *(u32x4*)(slot + (arr ? CK_RT : CK_AT) + (ks * 32 + t + 16 * hh) * 16) = ld2x8(p, p + 16); }
                { const int arr = e2 >> 7, J = (e2 >> 6) & 1;
                  const LAS unsigned char* p = lds + (arr ? PL_KH : PL_BH) + (4 * (lane >> 5) + ((lane >> 2) & 3)) * 144 + (32 * J + 16 * ((lane >> 4) & 1)) * 2 + 8 * (lane & 3);
                  const s16x4 lo = __builtin_amdgcn_ds_read_tr16_b64_v4i16((LAS s16x4*)p), hi = __builtin_amdgcn_ds_read_tr16_b64_v4i16((LAS s16x4*)(p + 8 * 144));
                  *(bf16x8*)(slot + (arr ? CK_KH : CK_BH) + (J * 64 + lane) * 16) = __builtin_shufflevector(lo, hi, 0, 1, 2, 3, 4, 5, 6, 7); }
                if (e2 < 160) *(u32x4*)(slot + CK_VT + e2 * 16) = *(const LAS u32x4*)(lds + PL_VT + e2 * 16); }
        }
    }
    __syncthreads();
}
constexpr int RC_NS = 8, RC_SLOT = 15360, RC_GG = 13312, RC_AHEAD = 6, RC_Y = RC_NS * RC_SLOT;
static_assert(RC_Y + 8192 <= RING_BYTES && CK_SLOT <= RC_GG, "rwkv ring");
template <int PM = 0> DI void rwkv_chunk_rec(const KArgs& a, LAS unsigned char* lds, int unit, int half, int wv) {
    const int tid = otid(wv), lane = tid & 63, w = __builtin_amdgcn_readfirstlane(tid >> 6), r = lane & 31, hh = lane >> 5;
    const int b = unit / 24, h = unit % 24;
    float* GST = (float*)(a.ws + A_GST) + (size_t)unit * 4096;
    const unsigned char* GGb = a.ws + A_GG; bf16* MIX = (bf16*)(a.ws + WS_H);
#define RC_DMA(srcp, dstp) __builtin_amdgcn_global_load_lds((const unsigned*)(srcp), (LAS unsigned*)(dstp), 16, 0, 0)
#define RC_ISSUE(cc) do { if ((PM & 1) == 0 && (w == 4 || w == 5)) { const unsigned char* src = ck_slot(a.ws, unit * CK_HALF + (cc)) + lane * 16; LAS unsigned char* dst = lds + ((cc) % RC_NS) * RC_SLOT; \
        if (w == 4) { _Pragma("unroll") for (int i_ = 0; i_ < 8; ++i_) RC_DMA(src + i_ * 1024, dst + i_ * 1024); } \
        else { _Pragma("unroll") for (int i_ = 8; i_ < 13; ++i_) RC_DMA(src + i_ * 1024, dst + i_ * 1024); \
            const unsigned char* gsrc = GGb + ((size_t)b * SEQ + (half * CK_HALF + (cc)) * 16 + (lane >> 3)) * (RWW * 2) + h * 128 + (lane & 7) * 16; \
            RC_DMA(gsrc, dst + RC_GG); RC_DMA(gsrc + 8 * RWW * 2, dst + RC_GG + 1024); } } } while (0)
#define RC_BAR() do { asm volatile("s_waitcnt lgkmcnt(0)" ::: "memory"); __builtin_amdgcn_s_barrier(); asm volatile("" ::: "memory"); } while (0)
    const bool epi = (w & 2) != 0; const int et = 4 * ((w & 1) + 2 * (w >> 2)) + (lane >> 4), eiq = lane & 15, ecol = h * 64 + 4 * eiq;
    const f32x4 elg = *(const f32x4*)(a.in[I_LNXG] + ecol), elb = *(const f32x4*)(a.in[I_LNXB] + ecol);
#define RC_EPI(sp, Yp, tokv) do { const f32x4 y = *(const LAS f32x4*)((Yp) + et * 64 + 4 * eiq); const u32x2 gq = *(const LAS u32x2*)((sp) + RC_GG + et * 128 + eiq * 8); \
        const float bsv = *(const LAS float*)((sp) + CK_BS + et * 4); const LAS unsigned char* vq = (sp) + CK_VT + 4 * eiq * CK_VTS + et * 2; \
        const f32x4 v4 = {bflo(*(const LAS unsigned short*)vq), bflo(*(const LAS unsigned short*)(vq + CK_VTS)), bflo(*(const LAS unsigned short*)(vq + 2 * CK_VTS)), bflo(*(const LAS unsigned short*)(vq + 3 * CK_VTS))}; \
        const float mean = red16((y.x + y.y) + (y.z + y.w)) * (1.f / 64.f); const f32x4 d = y - mean; \
        const float rstd = __builtin_amdgcn_rsqf(red16((d.x * d.x + d.y * d.y) + (d.z * d.z + d.w * d.w)) * (1.f / 64.f) + 64e-5f); \
        const f32x4 gg4 = {bflo(gq.x), bfhi(gq.x), bflo(gq.y), bfhi(gq.y)}, o = (d * rstd * elg + elb + v4 * bsv) * gg4; \
        if (PM == 0 || o.x == 1.2345f) *(unsigned*)((unsigned char*)MIX + (size_t)(tokv) * 2048 + 512 + ecol) = pk4_fp8(o.x, o.y, o.z, o.w); } while (0)
    f32x16 G0, G1;
#pragma unroll
    for (int e = 0; e < 16; ++e) { G0[e] = 0.f; G1[e] = 0.f; }
    if (half == 1 && w < 2) {
#pragma unroll
        for (int e = 0; e < 16; ++e) { G0[e] = GST[(w * 2 + 0) * 1024 + e * 64 + lane]; G1[e] = GST[(w * 2 + 1) * 1024 + e * 64 + lane]; } }
    __syncthreads();
#pragma unroll
    for (int cc = 0; cc < RC_AHEAD; ++cc) RC_ISSUE(cc);
    asm volatile("s_waitcnt vmcnt(0)" ::: "memory");
    RC_BAR();
    bf16x8 pAR[4], pNP, pVT;
#define RC_PRE(slotp) do { const LAS unsigned char* sp_ = (slotp); _Pragma("unroll") for (int ks = 0; ks < 4; ++ks) pAR[ks] = ldfrag(sp_ + ((r >> 4) ? CK_RT : CK_AT) + (ks * 32 + (r & 15) + 16 * hh) * 16); \
        pNP = ldfrag(sp_ + ((r >> 4) ? CK_PK : CK_NK) + ((r & 15) + 16 * hh) * 16); \
        { const LAS unsigned char* vq_ = sp_ + CK_VT + (32 * w + r) * CK_VTS + 8 * hh; const s16x4 vlo_ = *(const LAS s16x4*)vq_, vhi_ = *(const LAS s16x4*)(vq_ + 16); pVT = __builtin_shufflevector(vlo_, vhi_, 0, 1, 2, 3, 4, 5, 6, 7); } } while (0)
    if (w < 2) RC_PRE(lds);
    for (int c = 0; c < CK_HALF; ++c) {
        if (c + RC_AHEAD < CK_HALF) RC_ISSUE(c + RC_AHEAD);
        const LAS unsigned char* sb = lds + (c % RC_NS) * RC_SLOT;
        if (w < 2) {
            const int r16 = r & 15, up = r >> 4;
            bf16x8 fAR[4], fBH0, fBH1, fKH0, fKH1, fM, fNP, fPB; f32x4 gs0[4], gs1[4];
#pragma unroll
            for (int ks = 0; ks < 4; ++ks) fAR[ks] = pAR[ks];
            fNP = pNP; const bf16x8 vtf = pVT;
            __builtin_amdgcn_sched_barrier(0);
            fM = ldfrag(sb + CK_MT + (r16 + 16 * hh) * 16); fPB = ldfrag(sb + CK_PB + (r16 + 16 * hh) * 16);
            fBH0 = ldfrag(sb + CK_BH + lane * 16); fBH1 = ldfrag(sb + CK_BH + (64 + lane) * 16); fKH0 = ldfrag(sb + CK_KH + lane * 16); fKH1 = ldfrag(sb + CK_KH + (64 + lane) * 16);
#pragma unroll
            for (int g4 = 0; g4 < 4; ++g4) { gs0[g4] = *(const LAS f32x4*)(sb + CK_G15 + (8 * g4 + 4 * hh) * 4); gs1[g4] = *(const LAS f32x4*)(sb + CK_G15 + (32 + 8 * g4 + 4 * hh) * 4); }
            __builtin_amdgcn_sched_barrier(0);
            bf16x8 gf[4];
#pragma unroll
            for (int s2 = 0; s2 < 2; ++s2) { u32x4 p0 = {pk2(G0[8 * s2], G0[8 * s2 + 1]), pk2(G0[8 * s2 + 2], G0[8 * s2 + 3]), pk2(G0[8 * s2 + 4], G0[8 * s2 + 5]), pk2(G0[8 * s2 + 6], G0[8 * s2 + 7])};
                u32x4 p1 = {pk2(G1[8 * s2], G1[8 * s2 + 1]), pk2(G1[8 * s2 + 2], G1[8 * s2 + 3]), pk2(G1[8 * s2 + 4], G1[8 * s2 + 5]), pk2(G1[8 * s2 + 6], G1[8 * s2 + 7])};
                gf[s2] = __builtin_bit_cast(bf16x8, p0); gf[2 + s2] = __builtin_bit_cast(bf16x8, p1); }
            f32x16 XY;
#pragma unroll
            for (int e = 0; e < 16; ++e) XY[e] = 0.f;
#pragma unroll
            for (int ks = 0; ks < 4; ++ks) XY = MFMA32(fAR[ks], gf[ks], XY);
            XY = MFMA32(fNP, vtf, XY);
            { u32x4 px = {pk2(XY[0], XY[1]), pk2(XY[2], XY[3]), pk2(XY[4], XY[5]), pk2(XY[6], XY[7])}; const bf16x8 xf = __builtin_bit_cast(bf16x8, px);
              f32x16 U; for (int e = 0; e < 16; ++e) U[e] = 0.f;
              U = MFMA32(fM, xf, U);
              u32x4 pu = {pk2(U[0], U[1]), pk2(U[2], U[3]), pk2(U[4], U[5]), pk2(U[6], U[7])}; const bf16x8 uf = __builtin_bit_cast(bf16x8, pu);
              XY = MFMA32(fPB, uf, XY);
#pragma unroll
              for (int e = 0; e < 16; ++e) { G0[e] *= gs0[e >> 2][e & 3]; G1[e] *= gs1[e >> 2][e & 3]; }
              G0 = MFMA32(fBH0, uf, G0); G1 = MFMA32(fBH1, uf, G1); G0 = MFMA32(fKH0, vtf, G0); G1 = MFMA32(fKH1, vtf, G1); }
            __builtin_amdgcn_sched_barrier(0);
            if (c + 1 < CK_HALF) RC_PRE(lds + ((c + 1) % RC_NS) * RC_SLOT);
            LAS float* Y = (LAS float*)(lds + RC_Y + (c & 1) * 4096);
#pragma unroll
            for (int e = 0; e < 8; ++e) Y[((e & 3) + 8 * (e >> 2) + 4 * hh) * 64 + 32 * w + r] = XY[8 + e];
        } else if (epi) {
            if (c > 0) RC_EPI(lds + ((c - 1) % RC_NS) * RC_SLOT, (const LAS float*)(lds + RC_Y + ((c - 1) & 1) * 4096), (size_t)b * SEQ + (half * CK_HALF + c - 1) * 16 + et);
        } else {
            if (c + RC_AHEAD >= CK_HALF) asm volatile("s_waitcnt vmcnt(0)" ::: "memory"); else if (w == 4) asm volatile("s_waitcnt vmcnt(32)" ::: "memory"); else asm volatile("s_waitcnt vmcnt(28)" ::: "memory");
        }
        RC_BAR();
    }
    if (epi) RC_EPI(lds + ((CK_HALF - 1) % RC_NS) * RC_SLOT, (const LAS float*)(lds + RC_Y + ((CK_HALF - 1) & 1) * 4096), (size_t)b * SEQ + (half * CK_HALF + CK_HALF - 1) * 16 + et);
    else if (w < 2 && half == 0 && (PM == 0 || G0[0] == 1.2345f)) {
#pragma unroll
        for (int e = 0; e < 16; ++e) { GST[(w * 2 + 0) * 1024 + e * 64 + lane] = G0[e]; GST[(w * 2 + 1) * 1024 + e * 64 + lane] = G1[e]; } }
    asm volatile("s_waitcnt vmcnt(0)" ::: "memory");
    __syncthreads();
#undef RC_PRE
#undef RC_EPI
#undef RC_DMA
#undef RC_ISSUE
#undef RC_BAR
}

constexpr int N_PHASES = 25;
__global__ void __launch_bounds__(512, 2) fwd(KArgs a) {
    extern __shared__ __attribute__((aligned(16))) unsigned char lds_[];
    LAS unsigned char* lds = (LAS unsigned char*)lds_;
    const int wv = __builtin_amdgcn_readfirstlane((int)threadIdx.x >> 6), G = gridDim.x, bid = blockIdx.x;
    volatile LAS unsigned* MISC = (volatile LAS unsigned*)(lds + LDS_MISC);
    if (wv == 0) MISC[lane_id()] = 0u;
    __syncthreads();
    unsigned char* ws0 = a.ws;
#if N_LAUNCH_MODE == 0
    XcdBarrier bar = xcd_barrier_post((unsigned*)(ws0 + CTL_BAR), MISC + 8, wv);
#ifdef DBG_TIME_K1
#define SEAM(k) do { if (IN(k) && IN((k) + 1)) xcd_barrier(bar); if (bid == 0 && wv == 0 && lane_id() == 0) ((unsigned long long*)(ws0 + CTL_CHK))[1 + (k)] = __builtin_amdgcn_s_memrealtime(); } while (0)
#else
#define SEAM(k) do { if (IN(k) && IN((k) + 1)) xcd_barrier(bar); } while (0)
#endif
#else
#define SEAM(k) do { } while (0)
#endif
    const int lo = a.ph_lo, hi = a.ph_hi;
#ifdef DBG_TIME_K1
    if (bid == 0 && wv == 0 && lane_id() == 0) ((unsigned long long*)(ws0 + CTL_CHK))[0] = __builtin_amdgcn_s_memrealtime();
#endif
#ifndef PH_MASK
#define PH_MASK 0xFFFFFFFFu
#endif
#define IN(k) (((PH_MASK >> (k)) & 1u) && lo <= (k) && (k) < hi)
#ifndef REP_REC
#define REP_REC 0
#endif
#ifndef REP_DIL
#define REP_DIL 0
#endif
#ifndef REPEAT_MASK
#define REPEAT_MASK 0u
#endif
#define PH(k) for (int rp_ = 0; rp_ < (IN(k) ? 1 + (int)((REPEAT_MASK >> (k)) & 1u) : 0); ++rp_)
#define MOD ((float*)(ws + CTL_MOD))
#define Hb ((bf16*)(ws + WS_H))
#define X1 ((bf16*)(ws + WS_X1))
#define XPRE ((bf16*)(ws + A_XPRE))
    pg8::StaticOrder SO;

    PH(0) { unsigned char* ws = wsl(a.ws); p0_prologue(a, lds, wv); } SEAM(0);
    PH(1) { unsigned char* ws = wsl(a.ws); modulate_rows(a.in[I_X], (const unsigned long long*)(ws + CTL_MODI), MOD, Hb, wv); } SEAM(1);
    PH(2) { unsigned char* ws = wsl(a.ws); pg8::Gemm g{Hb, (const bf16*)(ws + WS_W_IN0), 2048, 2048, 2048}; SO.init(T, 2048, G, bid);
        EpiIn0 E{(bf16*)(ws + A_QC), (bf16*)(ws + A_KVC), (bf16*)(ws + A_KR), (bf16*)(ws + A_XH), (float*)(ws + CTL_SSQ)};
        pg8::gemm_phase<EpiIn0, pg8::StaticOrder, false, true>(lds, g, SO, E, wv); } SEAM(2);
    PH(3) { unsigned char* ws = wsl(a.ws);
        krope_pass((const bf16*)(ws + A_KR), (const float*)(ws + WS_ROPE), (bf16*)(ws + A_KF), wv);
        { pg8::Gemm g{(const bf16*)(ws + A_QC), (const bf16*)(ws + WS_W_UQ), 512, 512, 512}; SO.init(T, 1536, G, bid);
          EpiQ E{(bf16*)(ws + A_Q), (const float*)(ws + CTL_SSQ), (const float*)(ws + WS_ROPE)}; pg8::gemm_phase<EpiQ, pg8::StaticOrder, false>(lds, g, SO, E, wv); }
        { pg8::Gemm g{(const bf16*)(ws + A_KVC), (const bf16*)(ws + WS_W_UKV), 256, 256, 256}; SO.init(T, 2048, G, bid);
          EpiKV E{(bf16*)(ws + A_KF), (bf16*)(ws + A_V), (const float*)(ws + CTL_SSQ)}; pg8::gemm_phase<EpiKV, pg8::StaticOrder, false>(lds, g, SO, E, wv); }
        { pg8::Gemm g{(const bf16*)(ws + A_XH), (const bf16*)(ws + WS_S5BE), 384, 256, 256}; S5Order S{G, bid}; EpiS5E E{(float*)(ws + A_ES)}; pg8::gemm_phase<EpiS5E, S5Order, false>(lds, g, S, E, wv); }
    } SEAM(3);
    PH(4) { unsigned char* ws = wsl(a.ws);
        s5_carry((const float*)(ws + A_ES), (const float*)(ws + WS_S5L), (bf16*)(ws + A_XH), lds, wv);
        for (int u = bid; u < 256; u += G) mla_attn_unit(lds, (const bf16*)(ws + A_Q), (const bf16*)(ws + A_KF), (const bf16*)(ws + A_V), Hb, u, wv);
    } SEAM(4);
    PH(5) { unsigned char* ws = wsl(a.ws); pg8::Gemm g{(const bf16*)(ws + A_XH), (const bf16*)(ws + WS_S5BY), 384, 384, 384}; S5Order S{G, bid};
        EpiS5Y E{(bf16*)(ws + A_YS5), (const bf16*)(ws + A_XH), a.in[I_S5D]}; pg8::gemm_phase<EpiS5Y, S5Order, false>(lds, g, S, E, wv); } SEAM(5);
    PH(6) { unsigned char* ws = wsl(a.ws); pg8::Gemm g{(const bf16*)(ws + A_YS5), (const bf16*)(ws + WS_W_GLU), 1024, 1024, 1024}; SO.init(T, 1024, G, bid);
        EpiGlu E{Hb, (const bf16*)(ws + A_YS5)}; pg8::gemm_phase<EpiGlu, pg8::StaticOrder, false>(lds, g, SO, E, wv); } SEAM(6);
    PH(7) { unsigned char* ws = wsl(a.ws); pg8::Gemm g{Hb, (const bf16*)(ws + WS_W_OUT0), 2048, 2048, 2048}; SO.init(T, 2048, G, bid);
        EpiRes<false> E{XPRE, a.in[I_X], MOD + 2 * 2048}; pg8::gemm_phase<EpiRes<false>, pg8::StaticOrder, false, true>(lds, g, SO, E, wv); } SEAM(7);
#define MOE_PHASES(layer, pb) \
        PH(pb) { unsigned char* ws = wsl(a.ws); ln_router_phase(a, lds, layer, XPRE, X1, Hb, wv); } SEAM(pb); \
        PH(pb + 1) { unsigned char* ws = wsl(a.ws); moe_table(a, lds, layer, wv); pg8::Gemm g{Hb, (const bf16*)(ws + WS_W_GU8), 2048, 2048, 2048}; \
            MoeOrder<4> S{G, bid, layer, (const LAS int*)(lds + LDS_TAB), (const int*)(ws + A_TOKL)}; EpiGateUp E{ws + A_ACT}; pg8::gemm_phase<EpiGateUp, MoeOrder<4>, true, true>(lds, g, S, E, wv); } SEAM(pb + 1); \
        PH(pb + 2) { unsigned char* ws = wsl(a.ws); moe_table(a, lds, layer, wv); pg8::Gemm g{(const bf16*)(ws + A_ACT), (const bf16*)(ws + WS_W_DN), 512, 512, 512}; \
            MoeOrder<8> S{G, bid, layer, (const LAS int*)(lds + LDS_TAB), (const int*)(ws + A_TOKL)}; EpiDown E{(bf16*)(ws + A_YS)}; pg8::gemm_phase<EpiDown, MoeOrder<8>, false, true>(lds, g, S, E, wv); } SEAM(pb + 2); \
        PH(pb + 3) { unsigned char* ws = wsl(a.ws); ln_ffn_phase(a, layer, X1, a.out, layer == 0 ? Hb : nullptr, wv); } SEAM(pb + 3);
    MOE_PHASES(0, 8)
    PH(12) { unsigned char* ws = wsl(a.ws); pg8::Gemm g{Hb, (const bf16*)(ws + WS_W_IN1), 2048, 2048, 2048}; SO.init(T, 9728, G, bid);
        EpiIn1 E{(bf16*)(ws + A_ZD), (bf16*)(ws + A_ZR)}; pg8::gemm_phase<EpiIn1, pg8::StaticOrder, false, true>(lds, g, SO, E, wv); } SEAM(12);
    PH(13) { unsigned char* ws = wsl(a.ws); rwkv_prep((const bf16*)(ws + A_ZR), a.in[I_MU], (bf16*)(ws + A_LIN), wv); } SEAM(13);
    PH(14) { unsigned char* ws = wsl(a.ws);
        pg8::Gemm g{(const bf16*)(ws + A_LIN), (const bf16*)(ws + WS_W_LORA), 384, 384, 256}; LoraOrder LO; LO.init(T, 4608, G, bid);
        EpiLora E{(bf16*)(ws + A_WDEC), (bf16*)(ws + A_AA), (bf16*)(ws + A_GG), a.in[I_W0], a.in[I_A0]}; pg8::gemm_phase<EpiLora, LoraOrder, false>(lds, g, LO, E, wv);
} SEAM(14);
    PH(15) { rwkv_chunk_prep(a, lds, 0, wv); } SEAM(15);
    PH(16) { unsigned char* ws = wsl(a.ws); if (bid < 96 || G <= 96) { for (int u = bid; u < 96; u += G) { rwkv_chunk_rec(a, lds, u, 0, wv); if (REP_REC) rwkv_chunk_rec<REP_REC>(a, lds, u, 0, wv); } }
        if (G <= 96 || bid >= 96) { const int nb_ = G <= 96 ? G : G - 96, b0_ = G <= 96 ? bid : bid - 96;
            DilPre P; if (b0_ < 768) dil_issue((const bf16*)(ws + A_ZD), (const float*)(ws + WS_BIAS), b0_, wv, P);
            for (int u = b0_; u < 768; u += nb_) dil_attn_unit(lds, (const bf16*)(ws + A_ZD), (const float*)(ws + WS_BIAS), (bf16*)(ws + A_DPO), (float*)(ws + A_DPM), (float*)(ws + A_DPL), u, u + nb_ < 768 ? u + nb_ : -1, P, wv); } } SEAM(16);
    PH(17) { rwkv_chunk_prep(a, lds, 1, wv); } SEAM(17);
    PH(18) { unsigned char* ws = wsl(a.ws); if (bid < 96 || G <= 96) { for (int u = bid; u < 96; u += G) { rwkv_chunk_rec(a, lds, u, 1, wv); if (REP_REC) rwkv_chunk_rec<REP_REC>(a, lds, u, 1, wv); } }
        if (G <= 96 || bid >= 96) { const int nb_ = G <= 96 ? G : G - 96, b0_ = G <= 96 ? bid : bid - 96;
            DilPre P; if (768 + b0_ < 1536) dil_issue((const bf16*)(ws + A_ZD), (const float*)(ws + WS_BIAS), 768 + b0_, wv, P);
            for (int u = 768 + b0_; u < 1536; u += nb_) dil_attn_unit(lds, (const bf16*)(ws + A_ZD), (const float*)(ws + WS_BIAS), (bf16*)(ws + A_DPO), (float*)(ws + A_DPM), (float*)(ws + A_DPL), u, u + nb_ < 1536 ? u + nb_ : -1, P, wv); } } SEAM(18);
    PH(19) { unsigned char* ws = wsl(a.ws); dil_merge((const bf16*)(ws + A_DPO), (const float*)(ws + A_DPM), (const float*)(ws + A_DPL), Hb, wv); } SEAM(19);
    PH(20) { unsigned char* ws = wsl(a.ws); pg8::Gemm g{Hb, (const bf16*)(ws + WS_W_OUT1), 2048, 2048, 2048}; SO.init(T, 2048, G, bid);
        EpiRes<true> E{XPRE, a.out, MOD + 4 * 12288 + 2 * 2048}; pg8::gemm_phase<EpiRes<true>, pg8::StaticOrder, false, true>(lds, g, SO, E, wv); } SEAM(20);
    MOE_PHASES(1, 21)
#undef MOE_PHASES
#ifdef DBG_TIME_K1
    {
        xcd_barrier(bar);
        const unsigned long long* ts = (const unsigned long long*)(ws0 + CTL_CHK);
        const unsigned long long t0 = ts[0], te = __builtin_amdgcn_s_memrealtime();
        const float tot = (float)(te - t0), f1 = (float)(ts[1 + DBG_TIME_K1] - t0) / tot, f2 = (float)(ts[1 + DBG_TIME_K2] - t0) / tot;
        const float c1 = sqrtf(100.f * f1);
        for (size_t i = (size_t)bid * 512 + wv * 64 + lane_id(); i < (size_t)T * D; i += (size_t)G * 512) a.out[i] = c1;
        xcd_barrier(bar);
        if (bid == 0 && wv == 0 && lane_id() == 0) a.out[0] = 100.f * f2;
    }
#endif
#undef IN
#undef SEAM
#undef MOD
#undef Hb
#undef X1
#undef XPRE
}


#ifdef DBG_DUMP_OFF
__global__ void dbg_dump(const unsigned char* ws, float* out) {
    const size_t n = (size_t)T * D;
    for (size_t i = (size_t)blockIdx.x * 256 + threadIdx.x; i < n; i += (size_t)gridDim.x * 256) {
#if defined(DBG_DUMP_RT)
        { const int m = (int)(i >> 11), c = (int)(i & 2047); const int* RTE = (const int*)(ws + A_RT); const float* RTW = (const float*)(RTE + 4 * T); out[i] = c < 2 ? (float)RTE[2 * m + c] : (c < 4 ? RTW[2 * m + c - 2] : 0.f); }
#elif DBG_DUMP_F32
        out[i] = ((const float*)(ws + DBG_DUMP_OFF))[i];
#else
        out[i] = bf2f(((const bf16*)(ws + DBG_DUMP_OFF))[i]);
#endif
    }
}
#endif
extern "C" void kernel_launch(void* const* d_in, const int* in_sizes, int n_in, void* d_out, int out_size, void* d_ws, size_t ws_size, hipStream_t stream) {
    static int grid = 0;
    if (grid == 0) {
        if (n_in != 41 || out_size != T * D || ws_size < WS_END) { fprintf(stderr, "kernel_launch: unexpected shapes: n_in %d out %d ws %zu (need %zu)\n", n_in, out_size, ws_size, (size_t)WS_END); grid = -1; return; }
        int dev = 0, cus = 0, per_cu = 0;
        if (hipGetDevice(&dev) != hipSuccess || hipDeviceGetAttribute(&cus, hipDeviceAttributeMultiprocessorCount, dev) != hipSuccess) { grid = -1; return; }
        if (hipFuncSetAttribute((const void*)fwd, hipFuncAttributeMaxDynamicSharedMemorySize, LDS_BYTES) != hipSuccess) { fprintf(stderr, "kernel_launch: hipFuncSetAttribute failed\n"); grid = -1; return; }
        if (hipOccupancyMaxActiveBlocksPerMultiprocessor(&per_cu, (const void*)fwd, 512, LDS_BYTES) != hipSuccess || per_cu < 1) fprintf(stderr, "kernel_launch: occupancy query says %d blocks/CU\n", per_cu);
        (void)hipGetLastError();
        grid = cus;
    }
    if (grid < 0) return;
    (void)hipMemsetAsync(d_ws, 0, CTL_ZERO_BYTES, stream);
#ifdef DBG_ZERO_WS
    (void)hipMemsetAsync((char*)d_ws + CTL_ZERO_BYTES, 0, WS_END - CTL_ZERO_BYTES, stream);
#endif
    KArgs a{};
    for (int i = 0; i < 41; ++i) a.in[i] = (const float*)d_in[i];
    a.out = (float*)d_out; a.ws = (unsigned char*)d_ws;
#if N_LAUNCH_MODE == 0
    a.ph_lo = 0; a.ph_hi = N_PHASES;
    hipLaunchKernelGGL(fwd, dim3(grid), dim3(512), LDS_BYTES, stream, a);
#else
#ifdef DBG_DUMP_AFTER
    for (int p = 0; p <= DBG_DUMP_AFTER; ++p) { a.ph_lo = p; a.ph_hi = p + 1; hipLaunchKernelGGL(fwd, dim3(grid), dim3(512), LDS_BYTES, stream, a); }
#ifdef DBG_DUMP_OFF
    hipLaunchKernelGGL(dbg_dump, dim3(2048), dim3(256), 0, stream, (const unsigned char*)d_ws, (float*)d_out);
#endif
#else
    for (int p = 0; p < N_PHASES; ++p) { a.ph_lo = p; a.ph_hi = p + 1; hipLaunchKernelGGL(fwd, dim3(grid), dim3(512), LDS_BYTES, stream, a); }
#endif
#endif
}
```

```cpp
#include <hip/hip_runtime.h>
#include <cstdio>
#include <cstdint>

#ifndef N_LAUNCH_MODE
#define N_LAUNCH_MODE 0
#endif
#ifndef CHK
#define CHK 0
#endif

#define GAS __attribute__((address_space(1)))
#define LAS __attribute__((address_space(3)))
typedef unsigned short bf16;
typedef short bf16x8 __attribute__((ext_vector_type(8)));
typedef short s16x4 __attribute__((ext_vector_type(4)));
typedef float f32x4 __attribute__((ext_vector_type(4)));
typedef float f32x16 __attribute__((ext_vector_type(16)));
typedef float f32x2 __attribute__((ext_vector_type(2)));
typedef unsigned u32x4 __attribute__((ext_vector_type(4)));
typedef unsigned u32x2 __attribute__((ext_vector_type(2)));
#define DI __device__ __forceinline__

constexpr int D = 2048, NB = 4, SEQ = 4096, T = NB * SEQ;
constexpr float LN_EPS = 1e-5f, RMS_EPS = 1e-6f;
constexpr float DN_ALPHA = 1.41421356237f;
constexpr int EVEN_IN = 1856, ODD_IN = 9568, DIL_IN = 4608, RW_IN = 4960, RWW = 1536;
constexpr int NEXP = 16, DEXP = 512;

typedef __bf16 bf16x2_t __attribute__((ext_vector_type(2)));
DI unsigned pk2(float lo, float hi) { f32x2 v = {lo, hi}; bf16x2_t r = __builtin_convertvector(v, bf16x2_t); return __builtin_bit_cast(unsigned, r); }
DI float bf2f(bf16 b) { return __uint_as_float(((unsigned)b) << 16); }
DI float bflo(unsigned u) { return __uint_as_float(u << 16); }
DI float bfhi(unsigned u) { return __uint_as_float(u & 0xffff0000u); }
DI bf16 f2bf(float f) { unsigned u = __float_as_uint(f); u += 0x7fffu + ((u >> 16) & 1u); return (bf16)(u >> 16); }
DI float wave_sum_bp(float v) {
#pragma unroll
    for (int o = 1; o < 64; o <<= 1) v += __shfl_xor(v, o);
    return v;
}
DI unsigned char* wsl(unsigned char* p) { asm volatile("" : "+s"(p)); return p; }
DI int lane_id() { return (int)__builtin_amdgcn_mbcnt_hi(~0u, __builtin_amdgcn_mbcnt_lo(~0u, 0u)); }
DI int otid(int wv) { int t = wv * 64 + lane_id(); asm volatile("" : "+v"(t)); return t; }
DI float dpp_xor1(float x) { return __builtin_bit_cast(float, __builtin_amdgcn_mov_dpp(__builtin_bit_cast(int, x), 0xB1, 0xF, 0xF, true)); }
DI float dpp_xor2(float x) { return __builtin_bit_cast(float, __builtin_amdgcn_mov_dpp(__builtin_bit_cast(int, x), 0x4E, 0xF, 0xF, true)); }
DI float dpp_hmir(float x) { return __builtin_bit_cast(float, __builtin_amdgcn_mov_dpp(__builtin_bit_cast(int, x), 0x141, 0xF, 0xF, true)); }
template <int N> DI float dpp_ror(float x) { return __builtin_bit_cast(float, __builtin_amdgcn_mov_dpp(__builtin_bit_cast(int, x), 0x120 + N, 0xF, 0xF, true)); }
DI float dpp_rmir(float x) { return __builtin_bit_cast(float, __builtin_amdgcn_mov_dpp(__builtin_bit_cast(int, x), 0x140, 0xF, 0xF, true)); }
DI float red8(float x) { x += dpp_xor1(x); x += dpp_xor2(x); x += dpp_hmir(x); return x; }
DI float red16(float x) { x += dpp_xor1(x); x += dpp_xor2(x); x += dpp_hmir(x); x += dpp_rmir(x); return x; }
DI float wave_sum(float v) { float x = red16(v);
    { const auto rr = __builtin_amdgcn_permlane16_swap(__float_as_uint(x), __float_as_uint(x), false, false); x = __uint_as_float(rr[0]) + __uint_as_float(rr[1]); }
    { const auto rr = __builtin_amdgcn_permlane32_swap(__float_as_uint(x), __float_as_uint(x), false, false); x = __uint_as_float(rr[0]) + __uint_as_float(rr[1]); }
    return x; }
DI float sat448(float x) { return __builtin_amdgcn_fmed3f(x, -448.f, 448.f); }
DI unsigned pk4_fp8(float a, float b, float c, float d) { int w = 0; w = __builtin_amdgcn_cvt_pk_fp8_f32(sat448(a), sat448(b), w, false); w = __builtin_amdgcn_cvt_pk_fp8_f32(sat448(c), sat448(d), w, true); return (unsigned)w; }
constexpr float F8_WSCALE = 32.f;
DI float sigmoidf_(float x) { return __builtin_amdgcn_rcpf(1.f + __expf(-x)); }

namespace pg8 {
constexpr int BM = 256, BK = 64, HALF = 128, HTB = HALF * BK * 2, STAGE_BYTES = 8 * HTB, NXCD = 8, WGM = 8;
__host__ __device__ __forceinline__ int lds_byte(int r, int c) { const int st = (r >> 4) * 2 + (c >> 5), rr = r & 15, cc = c & 31, ob = rr * 64 + cc * 2; return st * 1024 + (ob ^ (((ob >> 9) & 1) << 5)); }
__host__ __device__ __forceinline__ void stage_rc(int b, int& R, int& C) { const int st = b / 1024, sb = b % 1024, swz = sb ^ (((sb >> 9) & 1) << 5); R = (st >> 1) * 16 + swz / 64; C = (st & 1) * 32 + (swz % 64) / 2; }
__host__ __device__ __forceinline__ int perm32(int rho) { const int n = rho >> 4, i = rho & 15; return 8 * (i >> 2) + 4 * n + (i & 3); }

struct Unit { int pm, pn, aux; };
struct Gemm { const bf16* A; const bf16* Bt; int lda, ldb, K; };

struct StaticOrder {
    int nM, nN, nwg, G, c;
    __host__ __device__ void init(int M, int N, int G_, int c_) { nM = M / BM; nN = N / BM; nwg = nM * nN; G = G_; c = c_; }
    __host__ __device__ bool next(int i, Unit& u) const {
        const long L = (long)i * G + c; if (L >= nwg) return false;
        int wgid = (int)L; { const int q = nwg / NXCD, r = nwg % NXCD, xcd = wgid % NXCD, off = wgid / NXCD; wgid = (xcd < r ? xcd * (q + 1) : r * (q + 1) + (xcd - r) * q) + off; }
        const int nig = WGM * nN, gid = wgid / nig, fm = gid * WGM, gsz = (nM - fm) < WGM ? (nM - fm) : WGM;
        u.pm = fm + ((wgid % nig) % gsz); u.pn = (wgid % nig) / gsz; u.aux = 0; return true;
    }
    __device__ __forceinline__ int arow(const Unit&, int) const { return 0; }
    __device__ __forceinline__ int koff(const Unit&) const { return 0; }
};

typedef int v8i __attribute__((ext_vector_type(8)));
template <class Epi, class Sched, bool GATHER, bool F8 = false>
__device__ __forceinline__ void gemm_phase(LAS unsigned char* lds, const Gemm g, const Sched& S, const Epi& E, int wv) {
    const int tid = otid(wv), wid = __builtin_amdgcn_readfirstlane(tid >> 6), lane = tid & 63, wr = wid >> 2, wc = wid & 3, fr = lane & 15, fq = lane >> 4;
    int K = g.K; asm volatile("" : "+s"(K));
    constexpr int ES = F8 ? 1 : 2;
    const int nt = K / (F8 ? 2 * BK : BK);
    unsigned voffB[2], vA0[2], vA1[2], nA0[2], nA1[2]; int Rr[2], Cc[2];
#pragma unroll
    for (int i = 0; i < 2; ++i) { int R, C; stage_rc(tid * 16 + i * 8192, R, C); const int Rb = Epi::PERM ? ((R & ~31) + perm32(R & 31)) : R;
        Rr[i] = R; Cc[i] = C; voffB[i] = (unsigned)(Rb * g.ldb * ES + C * 2);
        vA0[i] = (unsigned)(R * g.lda * ES + C * 2); vA1[i] = (unsigned)((R + HALF) * g.lda * ES + C * 2); nA0[i] = vA0[i]; nA1[i] = vA1[i]; }
    const size_t kstep = (size_t)(BK * 2);
    const size_t hstepB = (size_t)HALF * g.ldb * ES, tstepB = 2 * hstepB, tstepA = (size_t)BM * g.lda * ES, hstepA = (size_t)HALF * g.lda * ES, rbA = (size_t)g.lda * ES, rbB = (size_t)g.ldb * ES;
    const unsigned ldsw = (unsigned)wid * 1024u;
    const int aoff = lds_byte(wr * 64 + fr, F8 ? fq * 16 : fq * 8), boff = lds_byte(wc * 32 + fr, F8 ? fq * 16 : fq * 8);
#define PG8_SA(b, h) (((b) * 2 + (h)) * HTB)
#define PG8_SB(b, h) ((4 + (b) * 2 + (h)) * HTB)
#define PG8_STAGE(bufoff, gbase, voff) do { _Pragma("unroll") for (int _i = 0; _i < 2; ++_i) \
        __builtin_amdgcn_global_load_lds((const unsigned*)((const char*)(gbase) + (voff)[_i]), (LAS unsigned*)(lds + (bufoff) + ldsw + _i * 8192), 16, 0, 0); } while (0)
#define PG8_STAGE1(bufoff, gbase, voff0, rowbytes) do { __builtin_amdgcn_global_load_lds((const unsigned*)((const char*)(gbase) + (voff0)), (LAS unsigned*)(lds + (bufoff) + ldsw), 16, 0, 0); \
        __builtin_amdgcn_global_load_lds((const unsigned*)((const char*)(gbase) + (size_t)64 * (rowbytes) + (voff0)), (LAS unsigned*)(lds + (bufoff) + ldsw + 8192), 16, 0, 0); } while (0)
#define PG8_STAGEA(bufoff, gbase, half, arr) do { if constexpr (GATHER) PG8_STAGE(bufoff, gbase, arr); else PG8_STAGE1(bufoff, (const char*)(gbase) + (half) * hstepA, vA0[0], rbA); } while (0)
#define PG8_LD32(p) __builtin_bit_cast(v8i, __builtin_shufflevector(*(const LAS u32x4*)(p), *(const LAS u32x4*)((p) + 16), 0, 1, 2, 3, 4, 5, 6, 7))
#define PG8_LDA(dst, b, h) do { if constexpr (F8) { _Pragma("unroll") for (int m = 0; m < 4; ++m) dst##8[m] = PG8_LD32(lds + PG8_SA(b, h) + aoff + m * 2048); } \
        else { _Pragma("unroll") for (int m = 0; m < 4; ++m) _Pragma("unroll") for (int k = 0; k < 2; ++k) dst[m][k] = *(const LAS bf16x8*)(lds + PG8_SA(b, h) + aoff + m * 2048 + k * 1024); } } while (0)
#define PG8_LDB(dst, b, h) do { if constexpr (F8) { _Pragma("unroll") for (int n = 0; n < 2; ++n) dst##8[n] = PG8_LD32(lds + PG8_SB(b, h) + boff + n * 2048); } \
        else { _Pragma("unroll") for (int n = 0; n < 2; ++n) _Pragma("unroll") for (int k = 0; k < 2; ++k) dst[n][k] = *(const LAS bf16x8*)(lds + PG8_SB(b, h) + boff + n * 2048 + k * 1024); } } while (0)
#define PG8_MMA(ai, bj, At, Bt) do { __builtin_amdgcn_s_setprio(1); if constexpr (F8) { _Pragma("unroll") for (int m = 0; m < 4; ++m) _Pragma("unroll") for (int n = 0; n < 2; ++n) \
            asm volatile("v_mfma_scale_f32_16x16x128_f8f6f4 %0, %1, %2, %0, %3, %4 op_sel_hi:[0,0,0]" : "+v"(acc[ai][bj][m][n]) : "v"(Bt##8[n]), "v"(At##8[m]), "v"(sc_w), "v"(sc_x)); }     \
        else { _Pragma("unroll") for (int m = 0; m < 4; ++m) _Pragma("unroll") for (int n = 0; n < 2; ++n) _Pragma("unroll") for (int k = 0; k < 2; ++k) \
            acc[ai][bj][m][n] = __builtin_amdgcn_mfma_f32_16x16x32_bf16(Bt[n][k], At[m][k], acc[ai][bj][m][n], 0, 0, 0); } __builtin_amdgcn_s_setprio(0); } while (0)
#define PG8_WAIT_V(n) asm volatile("s_waitcnt vmcnt(" #n ")" ::: "memory")
#define PG8_WAIT_L(n) asm volatile("s_waitcnt lgkmcnt(" #n ")" ::: "memory")
#define PG8_BAR __builtin_amdgcn_s_barrier()
#define PG8_SCHED __builtin_amdgcn_sched_barrier(0)
    Unit cur, nxt; int ui = 0;
    if (!S.next(0, cur)) return;
    f32x4 acc[2][2][4][2];
#pragma unroll
    for (int a = 0; a < 2; ++a)
#pragma unroll
        for (int b = 0; b < 2; ++b)
#pragma unroll
            for (int m = 0; m < 4; ++m)
#pragma unroll
                for (int n = 0; n < 2; ++n) acc[a][b][m][n] = (f32x4){0.f, 0.f, 0.f, 0.f};
    int sc_w = 122, sc_x = 127; if constexpr (F8) asm volatile("" : "+v"(sc_w), "+v"(sc_x));
    bf16x8 At[4][2], B0[2][2], B1[2][2]; v8i At8[4], B08[2], B18[2];
    const char* cA = (GATHER ? (const char*)g.A : (const char*)g.A + (size_t)cur.pm * tstepA) + ES * S.koff(cur);
    const char* cB = (const char*)g.Bt + (size_t)cur.pn * tstepB + ES * S.koff(cur);
    if (GATHER) {
#pragma unroll
        for (int i = 0; i < 2; ++i) { vA0[i] = (unsigned)(S.arow(cur, Rr[i]) * g.lda * ES + Cc[i] * 2); vA1[i] = (unsigned)(S.arow(cur, Rr[i] + HALF) * g.lda * ES + Cc[i] * 2); nA0[i] = vA0[i]; nA1[i] = vA1[i]; } }
    PG8_STAGE1(PG8_SB(0, 0), cB, voffB[0], rbB); PG8_STAGEA(PG8_SA(0, 0), cA, 0, vA0); PG8_STAGE1(PG8_SB(0, 1), cB + hstepB, voffB[0], rbB); PG8_STAGEA(PG8_SA(0, 1), cA, 1, vA1);
    if (wr == 1) PG8_BAR;
    PG8_WAIT_V(4); PG8_BAR;
    PG8_STAGE1(PG8_SB(1, 0), cB + kstep, voffB[0], rbB); PG8_STAGEA(PG8_SA(1, 0), cA + kstep, 0, vA0); PG8_STAGE1(PG8_SB(1, 1), cB + hstepB + kstep, voffB[0], rbB);
    PG8_WAIT_V(6); PG8_BAR;
    for (;;) {
        const bool has_next = S.next(ui + 1, nxt);
        const char* nAp = GATHER ? cA : (has_next ? (const char*)g.A + (size_t)nxt.pm * tstepA + ES * S.koff(nxt) : cA);
        const char* nB = has_next ? (const char*)g.Bt + (size_t)nxt.pn * tstepB + ES * S.koff(nxt) : cB;
        if (GATHER) {
#pragma unroll
            for (int i = 0; i < 2; ++i) { nA0[i] = vA0[i]; nA1[i] = vA1[i]; } }
        for (int t = 0; t < nt; t += 2) {
            const bool last = (t == nt - 2);
            if (GATHER && has_next && t == (nt >= 4 ? nt - 4 : 0)) {
#pragma unroll
                for (int i = 0; i < 2; ++i) { nA0[i] = (unsigned)(S.arow(nxt, Rr[i]) * g.lda * ES + Cc[i] * 2); nA1[i] = (unsigned)(S.arow(nxt, Rr[i] + HALF) * g.lda * ES + Cc[i] * 2); } }
            const char* a1 = cA + (size_t)(t + 1) * kstep;
            const char* a2 = last ? nAp : cA + (size_t)(t + 2) * kstep; const char* b2 = last ? nB : cB + (size_t)(t + 2) * kstep;
            const char* a3 = a2 + kstep; const char* b3 = b2 + kstep;
            unsigned w0[2], w1[2];
#pragma unroll
            for (int i = 0; i < 2; ++i) { w0[i] = (GATHER && last) ? nA0[i] : vA0[i]; w1[i] = (GATHER && last) ? nA1[i] : vA1[i]; }
            PG8_LDB(B0, 0, 0); PG8_SCHED; PG8_LDA(At, 0, 0); PG8_STAGEA(PG8_SA(1, 1), a1, 1, vA1);
            PG8_WAIT_L(8); PG8_BAR; PG8_WAIT_L(0); PG8_MMA(0, 0, At, B0); PG8_BAR; PG8_SCHED;
            PG8_LDB(B1, 0, 1); PG8_STAGE1(PG8_SB(0, 0), b2, voffB[0], rbB);
            PG8_BAR; PG8_WAIT_L(0); PG8_MMA(0, 1, At, B1); PG8_BAR;
            PG8_LDA(At, 0, 1); PG8_STAGEA(PG8_SA(0, 0), a2, 0, w0);
            PG8_BAR; PG8_WAIT_L(0); PG8_MMA(1, 0, At, B0); PG8_BAR; PG8_SCHED;
            PG8_STAGE1(PG8_SB(0, 1), b2 + hstepB, voffB[0], rbB);
            PG8_WAIT_V(6); PG8_BAR; PG8_MMA(1, 1, At, B1); PG8_BAR;
            PG8_LDB(B0, 1, 0); PG8_SCHED; PG8_LDA(At, 1, 0); PG8_STAGEA(PG8_SA(0, 1), a2, 1, w1);
            PG8_WAIT_L(8); PG8_BAR; PG8_WAIT_L(0); PG8_MMA(0, 0, At, B0); PG8_BAR; PG8_SCHED;
            PG8_LDB(B1, 1, 1); PG8_STAGE1(PG8_SB(1, 0), b3, voffB[0], rbB);
            PG8_BAR; PG8_WAIT_L(0); PG8_MMA(0, 1, At, B1); PG8_BAR;
            PG8_LDA(At, 1, 1); PG8_STAGEA(PG8_SA(1, 0), a3, 0, w0);
            PG8_BAR; PG8_WAIT_L(0); PG8_MMA(1, 0, At, B0); PG8_BAR; PG8_SCHED;
            PG8_STAGE1(PG8_SB(1, 1), b3 + hstepB, voffB[0], rbB);
            PG8_WAIT_V(6); PG8_BAR; PG8_MMA(1, 1, At, B1); PG8_BAR;
        }
        if constexpr (F8) asm volatile("s_nop 15\n\ts_nop 15\n\ts_nop 15\n\ts_nop 15" ::: "memory");
        { int frr = fr, fqq = fq; asm volatile("" : "+v"(frr), "+v"(fqq));
          E(acc, cur, wr, wc, frr, fqq); }
        if (!has_next) break;
#pragma unroll
        for (int a = 0; a < 2; ++a)
#pragma unroll
            for (int b = 0; b < 2; ++b)
#pragma unroll
                for (int m = 0; m < 4; ++m)
#pragma unroll
                    for (int n = 0; n < 2; ++n) acc[a][b][m][n] = (f32x4){0.f, 0.f, 0.f, 0.f};
        cur = nxt; cA = nAp; cB = nB; ++ui;
        if (GATHER) {
#pragma unroll
            for (int i = 0; i < 2; ++i) { vA0[i] = nA0[i]; vA1[i] = nA1[i]; } }
    }
    PG8_WAIT_V(0);
    if (wr == 0) PG8_BAR;
    PG8_BAR;
#undef PG8_SA
#undef PG8_SB
#undef PG8_STAGE
#undef PG8_STAGE1
#undef PG8_STAGEA
#undef PG8_LDA
#undef PG8_LDB
#undef PG8_MMA
#undef PG8_LD32
#undef PG8_WAIT_V
#undef PG8_WAIT_L
#undef PG8_BAR
#undef PG8_SCHED
}
}

#define XB_TMO      128
#define XB_XCNT(j)  (256  + 64 * (j))
#define XB_XSUB(j)  (1280 + 64 * (j))
#define XB_XGEN(j)  (2304 + 64 * (j))
#define XB_TOP      3328
#define XB_TOPGEN   3392
#define XCD_BAR_WORDS 3456
#define XB_SPIN_CAP (1u << 18)
__device__ __forceinline__ unsigned xb_ld(unsigned* p)              { return __hip_atomic_load(p, __ATOMIC_RELAXED, __HIP_MEMORY_SCOPE_AGENT); }
__device__ __forceinline__ unsigned xb_add(unsigned* p, unsigned v) { return __hip_atomic_fetch_add(p, v, __ATOMIC_RELAXED, __HIP_MEMORY_SCOPE_AGENT); }
__device__ __forceinline__ unsigned xb_xcc_id() { return (unsigned)__builtin_amdgcn_s_getreg((3 << 11) | 20) & 0xFu; }
#define XB_SPIN(cond, bar) do { unsigned _sp = 0; while (cond) { __builtin_amdgcn_s_sleep(1); \
    if ((++_sp & 255u) == 0u) { if (xb_ld(&(bar)[XB_TMO])) break; if (_sp > XB_SPIN_CAP) { atomicAdd(&(bar)[XB_TMO], 1u); break; } } } } while (0)
struct XcdBarrier { unsigned* bar; unsigned x; volatile LAS unsigned* st; int wv; };
__device__ __forceinline__ XcdBarrier xcd_barrier_post(unsigned* bar, volatile LAS unsigned* st, int wv) {
    XcdBarrier b; b.bar = bar; b.x = xb_xcc_id(); b.st = st; b.wv = wv;
    if (wv == 0 && lane_id() == 0) (void)xb_add(&bar[XB_XCNT(b.x)], 1u);
    return b;
}
__device__ __forceinline__ void xcd_barrier_complete(unsigned* bar, unsigned x, unsigned& nloc, unsigned& nx) {
    const unsigned G = gridDim.x * gridDim.y * gridDim.z;
    unsigned sum, cnt, mine, sp = 0u;
    for (;;) {
        sum = 0u; cnt = 0u; mine = 0u;
#pragma unroll
        for (unsigned j = 0; j < 16; ++j) { const unsigned c = xb_ld(&bar[XB_XCNT(j)]); sum += c; cnt += (c > 0u) ? 1u : 0u; mine = (j == x) ? c : mine; }
        if (sum == G) break;
        __builtin_amdgcn_s_sleep(1);
        if ((++sp & 255u) == 0u) { if (xb_ld(&bar[XB_TMO])) break; if (sp > XB_SPIN_CAP) { atomicAdd(&bar[XB_TMO], 1u); break; } }
    }
    nloc = mine > 0u ? mine : 1u; nx = cnt > 0u ? cnt : 1u;
}
__device__ __forceinline__ void xcd_barrier(const XcdBarrier& b) {
    asm volatile("s_waitcnt vmcnt(0)" ::: "memory");
    __syncthreads();
    if (b.wv == 0 && lane_id() == 0) {
        unsigned* bar = b.bar;
        __builtin_amdgcn_s_waitcnt(0);
        unsigned nloc = b.st[0], nx = b.st[1];
        if (nloc == 0u) { xcd_barrier_complete(bar, b.x, nloc, nx); b.st[0] = nloc; b.st[1] = nx; }
        const unsigned old = xb_add(&bar[XB_XSUB(b.x)], 1u);
        const unsigned gen = old / nloc;
        if (old + 1u == (gen + 1u) * nloc) {
            __builtin_amdgcn_fence(__ATOMIC_RELEASE, "agent");
            asm volatile("s_waitcnt vmcnt(0)" ::: "memory");
            const unsigned og = xb_add(&bar[XB_TOP], 1u);
            const unsigned tg = og / nx;
            if (og + 1u == (tg + 1u) * nx) xb_add(&bar[XB_TOPGEN], 1u);
            else XB_SPIN(xb_ld(&bar[XB_TOPGEN]) == tg, bar);
            __builtin_amdgcn_fence(__ATOMIC_ACQUIRE, "agent");
            xb_add(&bar[XB_XGEN(b.x)], 1u);
            asm volatile("s_waitcnt vmcnt(0)" ::: "memory");
        } else {
            XB_SPIN(xb_ld(&bar[XB_XGEN(b.x)]) == gen, bar);
            __builtin_amdgcn_fence(__ATOMIC_ACQUIRE, "agent");
            asm volatile("s_waitcnt vmcnt(0)" ::: "memory");
        }
    }
    __syncthreads();
}

constexpr size_t MiB = 1u << 20;
constexpr size_t CTL_BAR = 0, CTL_MODI = 16384  , CTL_MOD = CTL_MODI + 2 * 4 * 12288 * 8  , CTL_SSQ = CTL_MOD + 2 * 4 * 12288 * 4  ,
                 CTL_CNT = CTL_SSQ + (size_t)T * 12 * 4  , CTL_CHK = CTL_CNT + 2 * 16 * 256, CTL_ZERO_BYTES = 2 * MiB;
static_assert(CTL_CHK % 8 == 0 && CTL_CHK + 1024 <= CTL_ZERO_BYTES, "ctl");
constexpr size_t WS_W_IN0 = 2 * MiB, WS_W_UQ = WS_W_IN0 + 8 * MiB, WS_W_UKV = WS_W_UQ + 1536 * 512 * 2, WS_W_GLU = WS_W_UKV + 2048 * 256 * 2, WS_W_OUT0 = WS_W_GLU + 2 * MiB,
                 WS_W_IN1 = WS_W_OUT0 + 8 * MiB, WS_W_OUT1 = WS_W_IN1 + (size_t)9728 * 2048 * 2, WS_W_GU = WS_W_OUT1 + 8 * MiB, WS_W_DN = WS_W_GU + 128 * MiB,
                 WS_W_LORA = WS_W_DN + 64 * MiB, WS_S5BY = WS_W_LORA + (size_t)4608 * 384 * 2, WS_S5BE = WS_S5BY + (size_t)64 * 256 * 384 * 2, WS_ROPE = WS_S5BE + (size_t)64 * 256 * 256 * 2,
                 WS_BIAS = WS_ROPE + 1 * MiB, WS_S5L = WS_BIAS + 16384, WS_H = WS_S5L + 65536;
static_assert(WS_H % 256 == 0, "align");
constexpr size_t WS_W_GU8 = WS_W_GU + 64 * MiB;
constexpr size_t WS_X1 = WS_H + 64 * MiB, WS_ARENA = WS_X1 + 128 * MiB;
constexpr size_t A_QC = WS_ARENA, A_KVC = A_QC + 16 * MiB, A_KR = A_KVC + 8 * MiB, A_XH = A_KR + 2 * MiB, A_ES = A_XH + 48 * MiB, A_Q = A_ES + 32 * MiB, A_KF = A_Q + 48 * MiB,
                 A_V = A_KF + 48 * MiB, A_YS5 = A_V + 32 * MiB;
constexpr size_t A_XPRE = WS_ARENA, A_RT = WS_ARENA + 128 * MiB, A_TOKL = A_RT + 1 * MiB, A_ACT = WS_ARENA, A_YS = WS_ARENA + 130 * MiB;
constexpr int MOE_ROWS = 2 * T + 16 * 256;
constexpr size_t A_ZD = WS_ARENA, A_ZR = A_ZD + 144 * MiB, A_LIN = A_ZR + 156 * MiB, A_WDEC = A_LIN + 12 * MiB, A_AA = A_WDEC + 48 * MiB, A_GG = A_AA + 48 * MiB,
                 A_DPO = A_GG + 48 * MiB, A_DPM = A_DPO + 48 * MiB, A_DPL = A_DPM + 2 * MiB, A_BSG = A_DPL + 2 * MiB  , A_YR = WS_ARENA  , A_GST = A_BSG + 2 * MiB  , WS_END = A_GST + 2 * MiB;
static_assert(A_YS + (size_t)MOE_ROWS * 2048 * 2 <= WS_END && A_YS5 + 32 * MiB <= WS_END && WS_END <= 1024 * MiB, "ws map");

constexpr int RING_BYTES = 131072, LDS_TAB = RING_BYTES, LDS_MISC = RING_BYTES + 1024, LDS_BYTES = 147456;

struct KArgs { const float* in[41]; float* out; unsigned char* ws; int ph_lo, ph_hi; };
enum { I_X = 0, I_C, I_ADAW, I_ADAB, I_LNMG, I_LNMB, I_LNFG, I_LNFB, I_RW, I_RB, I_WGU, I_WDN, I_RELB, I_EVIN, I_QN, I_WUQ, I_KVN, I_WUKV, I_LRE, I_LIM, I_BRE, I_BIM, I_CRE, I_CIM,
       I_S5D, I_LOGDT, I_WGLU, I_EVOUT, I_ODIN, I_MU, I_W0, I_W2, I_A0, I_A2, I_G2, I_KK, I_KA, I_RK, I_LNXG, I_LNXB, I_ODOUT };

DI int ropeperm(int c) { return ((c >> 2) & 1) * 32 + (c >> 3) * 4 + (c & 3); }
DI int srccol(int map, int n) {
    switch (map) {
        case 1: if (n < 768) return n; if (n < 1792) return 832 + (n - 768); if (n < 1856) return 768 + ropeperm(n - 1792); return -1;
        case 2: { const int h = n / 192, j = n % 192; return j < 128 ? n : h * 192 + 128 + ropeperm(j - 128); }
        case 3: { const int pn = n >> 8, half = (n >> 7) & 1, idx = n & 127; return half * 512 + pn * 128 + idx; }
        case 4: return n < ODD_IN ? n : -1;
        default: return n;
    }
}
struct ConvJob { const float* src; bf16* dst; const float* kscale; int ldsrc, K, Nd, nmat, map, kbeg, kend, f8; size_t smat, dmat; };
DI void conv_item(const ConvJob& J, LAS unsigned char* scr, int item, int lane) {
    const int nblk = J.Nd / 64, per = (J.K / 64) * nblk, mat = item / per, r = item % per, kb = r / nblk, nb = r % nblk, k0 = 64 * kb, n0 = 64 * nb;
    const float* W = J.src + (size_t)mat * J.smat; bf16* WT = J.f8 ? (bf16*)((unsigned char*)J.dst + (size_t)mat * J.dmat) : J.dst + (size_t)mat * J.dmat;
    const int kq = lane >> 4, nq = lane & 15, sc = srccol(J.map, n0 + 4 * nq);
    f32x4 v[16];
#pragma unroll
    for (int i = 0; i < 16; ++i) { const int kg = k0 + 4 * i + kq; v[i] = (f32x4){0.f, 0.f, 0.f, 0.f};
        if (sc >= 0 && kg >= J.kbeg && kg < J.kend) { v[i] = *(const f32x4*)(W + (size_t)(kg - J.kbeg) * J.ldsrc + sc); if (J.kscale) v[i] *= J.kscale[kg]; } }
#pragma unroll
    for (int i = 0; i < 16; ++i) { LAS bf16* t = (LAS bf16*)(scr + (4 * nq) * 132 + (4 * i + kq) * 2); const unsigned p0 = pk2(v[i].x, v[i].y), p1 = pk2(v[i].z, v[i].w);
        t[0] = (bf16)(p0 & 0xffffu); t[66] = (bf16)(p0 >> 16); t[132] = (bf16)(p1 & 0xffffu); t[198] = (bf16)(p1 >> 16); }
    asm volatile("s_waitcnt lgkmcnt(0)" ::: "memory");
#pragma unroll
    for (int q = 0; q < 8; ++q) { const int id = lane + 64 * q, n = id >> 3, c = id & 7; const LAS unsigned* t = (const LAS unsigned*)(scr + n * 132 + c * 16);
        u32x4 o = {t[0], t[1], t[2], t[3]};
        if (J.f8) { u32x2 o8 = {pk4_fp8(bflo(o.x) * F8_WSCALE, bfhi(o.x) * F8_WSCALE, bflo(o.y) * F8_WSCALE, bfhi(o.y) * F8_WSCALE), pk4_fp8(bflo(o.z) * F8_WSCALE, bfhi(o.z) * F8_WSCALE, bflo(o.w) * F8_WSCALE, bfhi(o.w) * F8_WSCALE)};
            *(u32x2*)((unsigned char*)WT + (size_t)(n0 + n) * J.K + k0 + 8 * c) = o8; }
        else *(u32x4*)(WT + (size_t)(n0 + n) * J.K + k0 + 8 * c) = o; }
    asm volatile("s_waitcnt lgkmcnt(0)" ::: "memory");
}
DI ConvJob conv_job(const KArgs& a, int j) {
    unsigned char* ws = a.ws; ConvJob J; J.kscale = nullptr; J.nmat = 1; J.map = 0; J.smat = 0; J.dmat = 0; J.kbeg = 0; J.kend = 1 << 30; J.f8 = 0;
    switch (j) {
        case 0: J.src = a.in[I_EVIN]; J.dst = (bf16*)(ws + WS_W_IN0); J.f8 = 1; J.ldsrc = EVEN_IN; J.K = 2048; J.Nd = 2048; J.map = 1; break;
        case 1: J.src = a.in[I_WUQ]; J.dst = (bf16*)(ws + WS_W_UQ); J.ldsrc = 1536; J.K = 512; J.Nd = 1536; J.map = 2; J.kscale = a.in[I_QN]; break;
        case 2: J.src = a.in[I_WUKV]; J.dst = (bf16*)(ws + WS_W_UKV); J.ldsrc = 2048; J.K = 256; J.Nd = 2048; J.kscale = a.in[I_KVN]; break;
        case 3: J.src = a.in[I_WGLU]; J.dst = (bf16*)(ws + WS_W_GLU); J.ldsrc = 1024; J.K = 1024; J.Nd = 1024; break;
        case 4: J.src = a.in[I_EVOUT]; J.dst = (bf16*)(ws + WS_W_OUT0); J.f8 = 1; J.ldsrc = 2048; J.K = 2048; J.Nd = 2048; break;
        case 5: J.src = a.in[I_ODIN]; J.dst = (bf16*)(ws + WS_W_IN1); J.f8 = 1; J.ldsrc = ODD_IN; J.K = 2048; J.Nd = 9728; J.map = 4; break;
        case 6: J.src = a.in[I_ODOUT]; J.dst = (bf16*)(ws + WS_W_OUT1); J.f8 = 1; J.ldsrc = 2048; J.K = 2048; J.Nd = 2048; break;
        case 7: J.src = a.in[I_WGU]; J.dst = (bf16*)(ws + WS_W_GU8); J.f8 = 1; J.ldsrc = 1024; J.K = 2048; J.Nd = 1024; J.map = 3; J.nmat = 32; J.smat = (size_t)2048 * 1024; J.dmat = (size_t)1024 * 2048; break;
        case 8: J.src = a.in[I_WDN]; J.dst = (bf16*)(ws + WS_W_DN); J.f8 = 1; J.ldsrc = 2048; J.K = 512; J.Nd = 2048; J.nmat = 32; J.smat = (size_t)512 * 2048; J.dmat = (size_t)2048 * 512; break;
        case 9: J.src = a.in[I_W2]; J.dst = (bf16*)(ws + WS_W_LORA); J.ldsrc = 1536; J.K = 384; J.Nd = 1536; J.kbeg = 0; J.kend = 64; break;
        case 10: J.src = a.in[I_A2]; J.dst = (bf16*)(ws + WS_W_LORA) + (size_t)1536 * 384; J.ldsrc = 1536; J.K = 384; J.Nd = 1536; J.kbeg = 64; J.kend = 128; break;
        default: J.src = a.in[I_G2]; J.dst = (bf16*)(ws + WS_W_LORA) + (size_t)3072 * 384; J.ldsrc = 1536; J.K = 384; J.Nd = 1536; J.kbeg = 128; J.kend = 352; break;
    }
    return J;
}
constexpr int N_CONV_JOBS = 12;

DI void s5_precompute(const KArgs& a, LAS unsigned char* lds, int g, int wv) {
    LAS float* PW = (LAS float*)lds; LAS float* BB = PW + 17 * 64 * 2; LAS float* CC = BB + 64 * 16 * 2; LAS float* KK = CC + 16 * 64 * 2;
    const int tid = otid(wv);
    const float dt = expf(a.in[I_LOGDT][g]);
    for (int idx = tid; idx < 17 * 64; idx += 512) { const int d = idx / 64, p = idx % 64; const float lre = a.in[I_LRE][g * 64 + p], lim = a.in[I_LIM][g * 64 + p];
        const float mag = expf(lre * dt * (float)d); float sn, cs; sincosf(lim * dt * (float)d, &sn, &cs); PW[idx * 2] = mag * cs; PW[idx * 2 + 1] = mag * sn;
        if (d == 16) { float* L = (float*)(a.ws + WS_S5L); L[(g * 64 + p) * 2] = mag * cs; L[(g * 64 + p) * 2 + 1] = mag * sn; } }
    for (int idx = tid; idx < 64 * 16; idx += 512) { const int p = idx / 16, c = idx % 16; const float lre = a.in[I_LRE][g * 64 + p], lim = a.in[I_LIM][g * 64 + p];
        float sn, cs; sincosf(lim * dt, &sn, &cs); const float mag = expf(lre * dt), sh = sinf(0.5f * lim * dt);
        const float nr = expm1f(lre * dt) * cs - 2.f * sh * sh, ni = mag * sn, den = 1.f / (lre * lre + lim * lim);
        const float cr = (nr * lre + ni * lim) * den, ci = (ni * lre - nr * lim) * den;
        const float br = a.in[I_BRE][(g * 64 + p) * 16 + c], bi = a.in[I_BIM][(g * 64 + p) * 16 + c];
        BB[idx * 2] = cr * br - ci * bi; BB[idx * 2 + 1] = cr * bi + ci * br; }
    for (int idx = tid; idx < 16 * 64; idx += 512) { CC[idx * 2] = a.in[I_CRE][g * 1024 + idx]; CC[idx * 2 + 1] = a.in[I_CIM][g * 1024 + idx]; }
    __syncthreads();
    for (int idx = tid; idx < 4096; idx += 512) { const int d = idx >> 8, c = (idx >> 4) & 15, cp = idx & 15; float s = 0.f;
        for (int p = 0; p < 64; ++p) { const float cr = CC[(c * 64 + p) * 2], ci = CC[(c * 64 + p) * 2 + 1], pr = PW[(d * 64 + p) * 2], pi = PW[(d * 64 + p) * 2 + 1];
            const float xr = cr * pr - ci * pi, xi = cr * pi + ci * pr; s += xr * BB[(p * 16 + cp) * 2] - xi * BB[(p * 16 + cp) * 2 + 1]; }
        KK[idx] = s; }
    __syncthreads();
    bf16* BY = (bf16*)(a.ws + WS_S5BY) + (size_t)g * 256 * 384; bf16* BE = (bf16*)(a.ws + WS_S5BE) + (size_t)g * 256 * 256;
    for (int idx = tid; idx < 256 * 48; idx += 512) { const int row = idx / 48, col0 = (idx % 48) * 8, t = row >> 4, c = row & 15; float v[8];
        if (col0 < 256) { const int s = col0 >> 4, c0 = col0 & 15;
#pragma unroll
            for (int j = 0; j < 8; ++j) v[j] = (s <= t) ? KK[((t - s) << 8) + (c << 4) + c0 + j] : 0.f; }
        else { const int pp = col0 - 256; const bool im = pp >= 64; const int p0 = im ? pp - 64 : pp;
#pragma unroll
            for (int j = 0; j < 8; ++j) { const int p = p0 + j; const float cr = CC[(c * 64 + p) * 2], ci = CC[(c * 64 + p) * 2 + 1], pr = PW[((t + 1) * 64 + p) * 2], pi = PW[((t + 1) * 64 + p) * 2 + 1];
                v[j] = im ? -(cr * pi + ci * pr) : (cr * pr - ci * pi); } }
        u32x4 o = {pk2(v[0], v[1]), pk2(v[2], v[3]), pk2(v[4], v[5]), pk2(v[6], v[7])}; *(u32x4*)(BY + (size_t)row * 384 + col0) = o; }
    for (int idx = tid; idx < 256 * 32; idx += 512) { const int row = idx / 32, col0 = (idx % 32) * 8, s = col0 >> 4, c0 = col0 & 15; float v[8];
#pragma unroll
        for (int j = 0; j < 8; ++j) { if (row < 128) { const int p = row & 63; const float pr = PW[((15 - s) * 64 + p) * 2], pi = PW[((15 - s) * 64 + p) * 2 + 1], br = BB[(p * 16 + c0 + j) * 2], bi = BB[(p * 16 + c0 + j) * 2 + 1];
                v[j] = row < 64 ? (pr * br - pi * bi) : (pr * bi + pi * br); } else v[j] = 0.f; }
        u32x4 o = {pk2(v[0], v[1]), pk2(v[2], v[3]), pk2(v[4], v[5]), pk2(v[6], v[7])}; *(u32x4*)(BE + (size_t)row * 256 + col0) = o; }
    __syncthreads();
}

DI int t5_bucket(int dist) { if (dist < 16) return dist; const float logd = logf((float)dist / 16.f) / logf(128.f); int lg = 16 + (int)(logd * 16.f); return lg < 31 ? lg : 31; }

DI void p0_prologue(const KArgs& a, LAS unsigned char* lds, int wv) {
    const int tid = otid(wv), lane = tid & 63, wave = tid >> 6, G = gridDim.x, gw = blockIdx.x * 8 + wave, NGW = G * 8;
    LAS float* cond = (LAS float*)(lds + 98304);
    for (int i = tid; i < 4 * 2048; i += 512) { const float c = a.in[I_C][i]; cond[i] = c / (1.f + expf(-c)); }
    if (blockIdx.x < 64) s5_precompute(a, lds, blockIdx.x, wv); else __syncthreads();
    unsigned long long* MODI = (unsigned long long*)(a.ws + CTL_MODI);
    for (int it = gw; it < 2 * 48 * 16; it += NGW) { const int l = it / 768, cc = (it % 768) / 16, kc = it % 16, col = cc * 256 + lane * 4;
        const float* W = a.in[I_ADAW] + ((size_t)l * 2048 + kc * 128) * 12288 + col;
        f32x4 acc[4]; for (int b = 0; b < 4; ++b) acc[b] = (f32x4){0.f, 0.f, 0.f, 0.f};
#pragma unroll 8
        for (int k = 0; k < 128; ++k) { const f32x4 w = *(const f32x4*)(W + (size_t)k * 12288);
#pragma unroll
            for (int b = 0; b < 4; ++b) acc[b] += w * cond[b * 2048 + kc * 128 + k]; }
        if (kc == 0) { const f32x4 bb = *(const f32x4*)(a.in[I_ADAB] + l * 12288 + col); for (int b = 0; b < 4; ++b) acc[b] += bb; }
#pragma unroll
        for (int b = 0; b < 4; ++b) { unsigned long long* o = MODI + (size_t)(l * 4 + b) * 12288 + col;
#pragma unroll
            for (int e = 0; e < 4; ++e) atomicAdd(o + e, (unsigned long long)__double2ll_rn((double)acc[b][e] * 1099511627776.0)); } }
    LAS unsigned char* scr = lds + wave * 8704;
    for (int j = 0; j < N_CONV_JOBS; ++j) { const ConvJob J = conv_job(a, j); const int nit = J.nmat * (J.K / 64) * (J.Nd / 64);
        for (int it = gw; it < nit; it += NGW) conv_item(J, scr, it, lane); }
    { float* RC = (float*)(a.ws + WS_ROPE); float* RS = RC + 4096 * 32; const int gt = blockIdx.x * 512 + tid;
      for (int i = gt; i < 4096 * 32; i += G * 512) { const int pos = i >> 5, j = i & 31; const float inv = powf(10000.f, -(float)(2 * j) / 64.f); float sn, cs; sincosf((float)pos * inv, &sn, &cs); RC[i] = cs; RS[i] = sn; }
      float* BL = (float*)(a.ws + WS_BIAS);
      for (int i = gt; i < 3 * 8 * 132; i += G * 512) { const int gi = i / (8 * 132), h = (i / 132) % 8, dl = i % 132; const int dil = gi == 0 ? 1 : (gi == 1 ? 4 : 16);
          BL[i] = dl <= 128 ? a.in[I_RELB][t5_bucket(dl * dil) * 24 + gi * 8 + h] * 1.44269504089f : 0.f; } }
}

DI float modi2f(unsigned long long v) { return fmaf((float)(unsigned)v, 0x1p-40f, (float)(int)(v >> 32) * 0x1p-8f); }
DI void modulate_rows(const float* x, const unsigned long long* MODI, float* MODF, bf16* H, int wv) {
    const int lane = otid(wv) & 63, gw = blockIdx.x * 8 + (otid(wv) >> 6), NGW = gridDim.x * 8;
    for (int i = gw * 64 + lane; i < 2 * 4 * 12288; i += NGW * 64) MODF[i] = modi2f(MODI[i]);
    for (int m = gw; m < T; m += NGW) { const int b = m / SEQ; const unsigned long long* sh = MODI + (size_t)b * 12288; const unsigned long long* sc = sh + 2048;
#pragma unroll
        for (int j = 0; j < 8; ++j) { const int col = (lane + 64 * j) * 4; const f32x4 v = *(const f32x4*)(x + (size_t)m * D + col);
            const f32x4 s1 = {modi2f(sc[col]), modi2f(sc[col + 1]), modi2f(sc[col + 2]), modi2f(sc[col + 3])}, s0 = {modi2f(sh[col]), modi2f(sh[col + 1]), modi2f(sh[col + 2]), modi2f(sh[col + 3])};
            const f32x4 h = v * (s1 + 1.f) + s0; *(unsigned*)((unsigned char*)H + (size_t)m * D + col) = pk4_fp8(h.x, h.y, h.z, h.w); } }
}

using pg8::Unit;
#define P32(ptr, elemoff) ((decltype(ptr))((char*)(ptr) + (unsigned)((unsigned)(elemoff) * (unsigned)sizeof(*(ptr)))))
typedef f32x4 Acc[2][2][4][2];
#define EPI_ROWS_BEGIN const int row0 = u.pm * 256 + wr * 64 + fr; _Pragma("unroll") for (int ai = 0; ai < 2; ++ai) _Pragma("unroll") for (int m = 0; m < 4; ++m) { const int row = row0 + ai * 128 + m * 16;
#define EPI_ROWS_END __builtin_amdgcn_sched_barrier(0); }
DI u32x4 pack8(const f32x4& v0, const f32x4& v1) { u32x4 o = {pk2(v0.x, v0.y), pk2(v0.z, v0.w), pk2(v1.x, v1.y), pk2(v1.z, v1.w)}; return o; }

struct EpiIn0 { static constexpr bool PERM = true;
    bf16 *QC, *KVC, *KR, *XH; float *ssq;
    DI void operator()(const Acc& acc, const Unit& u, int wr, int wc, int fr, int fq) const {
        EPI_ROWS_BEGIN
            float ss = 0.f;
#pragma unroll
            for (int bj = 0; bj < 2; ++bj) { const f32x4 v0 = acc[ai][bj][m][0], v1 = acc[ai][bj][m][1]; const int col = 128 * bj + 32 * wc + 8 * fq; const u32x4 o = pack8(v0, v1);
                if (u.pn < 2) { *(u32x4*)P32(QC, row * 512 + u.pn * 256 + col) = o; ss += v0.x * v0.x + v0.y * v0.y + v0.z * v0.z + v0.w * v0.w + v1.x * v1.x + v1.y * v1.y + v1.z * v1.z + v1.w * v1.w; }
                else if (u.pn == 2) { *(u32x4*)P32(KVC, row * 256 + col) = o; ss += v0.x * v0.x + v0.y * v0.y + v0.z * v0.z + v0.w * v0.w + v1.x * v1.x + v1.y * v1.y + v1.z * v1.z + v1.w * v1.w; }
                else if (u.pn < 7) { const int uc = (u.pn - 3) * 256 + col, g = uc >> 4; *(u32x4*)P32(XH, (g * 1024 + (row >> 4)) * 384 + (row & 15) * 16 + (uc & 15)) = o; }
                else if (col < 64) { *(u32x4*)P32(KR, row * 64 + col) = o; } }
            if (u.pn <= 2) { ss += __shfl_xor(ss, 16); ss += __shfl_xor(ss, 32); if (fq == 0) *P32(ssq, row * 12 + u.pn * 4 + wc) = ss; }
        EPI_ROWS_END
    }
};
struct EpiQ { static constexpr bool PERM = true;
    bf16* Q; const float* ssq; const float* rope;
    DI void operator()(const Acc& acc, const Unit& u, int wr, int wc, int fr, int fq) const {
        EPI_ROWS_BEGIN
            const f32x4 q0 = *(const f32x4*)P32(ssq, row * 12), q1 = *(const f32x4*)P32(ssq, row * 12 + 4);
            const float rs = __builtin_amdgcn_rsqf((((q0.x + q0.y) + (q0.z + q0.w)) + ((q1.x + q1.y) + (q1.z + q1.w))) * (1.f / 512.f) + RMS_EPS) * (0.07216878364870322f * 1.44269504089f);
            const int b = row / SEQ, s = row % SEQ;
#pragma unroll
            for (int bj = 0; bj < 2; ++bj) { f32x4 v0 = acc[ai][bj][m][0] * rs, v1 = acc[ai][bj][m][1] * rs; const int n = u.pn * 256 + 128 * bj + 32 * wc + 8 * fq, h = n / 192, j = n % 192;
                if (j >= 128) { const int q = (j - 128) >> 3; const f32x4 cs = *(const f32x4*)P32(rope, s * 32 + 4 * q), sn = *(const f32x4*)P32(rope, 4096 * 32 + s * 32 + 4 * q);
                    const f32x4 x1 = v0, x2 = v1; v0 = x1 * cs - x2 * sn; v1 = x1 * sn + x2 * cs; }
                *(u32x4*)P32(Q, ((b * 8 + h) * SEQ + s) * 192 + j) = pack8(v0, v1); }
        EPI_ROWS_END
    }
};
struct EpiKV { static constexpr bool PERM = true;
    bf16 *KF, *V; const float* ssq;
    DI void operator()(const Acc& acc, const Unit& u, int wr, int wc, int fr, int fq) const {
        EPI_ROWS_BEGIN
            const f32x4 q2 = *(const f32x4*)P32(ssq, row * 12 + 8); const float rs = __builtin_amdgcn_rsqf(((q2.x + q2.y) + (q2.z + q2.w)) * (1.f / 256.f) + RMS_EPS); const int b = row / SEQ, s = row % SEQ, h = u.pn, j = 32 * wc + 8 * fq; const int tok = (b * 8 + h) * SEQ + s;
            *(u32x4*)P32(KF, tok * 192 + j) = pack8(acc[ai][0][m][0] * rs, acc[ai][0][m][1] * rs);
            *(u32x4*)P32(V, tok * 128 + j) = pack8(acc[ai][1][m][0] * rs, acc[ai][1][m][1] * rs);
        EPI_ROWS_END
    }
};
struct S5Order { int G, c;
    DI bool next(int i, Unit& u) const { const int L = i * G + c; if (L >= 256) return false; u.pm = L; u.pn = L >> 2; u.aux = 0; return true; }
    DI int arow(const Unit&, int) const { return 0; }
    DI int koff(const Unit&) const { return 0; } };
struct EpiS5E { static constexpr bool PERM = false;
    float* ES;
    DI void operator()(const Acc& acc, const Unit& u, int wr, int wc, int fr, int fq) const {
        EPI_ROWS_BEGIN
#pragma unroll
            for (int n = 0; n < 2; ++n) *(f32x4*)P32(ES, row * 128 + 32 * wc + 16 * n + 4 * fq) = acc[ai][0][m][n];
        EPI_ROWS_END
    }
};
DI float gelu_tanh(float x) { const float t = 0.7978845608028654f * (x + 0.044715f * x * x * x); const float e = __expf(2.f * t); return 0.5f * x * (1.f + (1.f - 2.f * __builtin_amdgcn_rcpf(e + 1.f))); }
struct EpiS5Y { static constexpr bool PERM = true;
    bf16* YS5; const bf16* XH; const float* dsk;
    DI void operator()(const Acc& acc, const Unit& u, int wr, int wc, int fr, int fq) const {
        EPI_ROWS_BEGIN
            const int g = row >> 10, chunk = row & 1023;
#pragma unroll
            for (int bj = 0; bj < 2; ++bj) { const int col = 128 * bj + 32 * wc + 8 * fq, tl = col >> 4, c0 = col & 15; const u32x4 uu = *(const u32x4*)P32(XH, row * 384 + col);
                const f32x4 d0 = *(const f32x4*)P32(dsk, g * 16 + c0), d1 = *(const f32x4*)P32(dsk, g * 16 + c0 + 4); const f32x4 a0 = acc[ai][bj][m][0], a1 = acc[ai][bj][m][1];
                f32x4 y0 = {a0.x + d0.x * bflo(uu.x), a0.y + d0.y * bfhi(uu.x), a0.z + d0.z * bflo(uu.y), a0.w + d0.w * bfhi(uu.y)};
                f32x4 y1 = {a1.x + d1.x * bflo(uu.z), a1.y + d1.y * bfhi(uu.z), a1.z + d1.z * bflo(uu.w), a1.w + d1.w * bfhi(uu.w)};
#pragma unroll
                for (int e = 0; e < 4; ++e) { y0[e] = gelu_tanh(y0[e]); y1[e] = gelu_tanh(y1[e]); }
                *(u32x4*)P32(YS5, (chunk * 16 + tl) * 1024 + g * 16 + c0) = pack8(y0, y1); }
        EPI_ROWS_END
    }
};
struct EpiGlu { static constexpr bool PERM = true;
    bf16* MIX; const bf16* YS5;
    DI void operator()(const Acc& acc, const Unit& u, int wr, int wc, int fr, int fq) const {
        EPI_ROWS_BEGIN
#pragma unroll
            for (int bj = 0; bj < 2; ++bj) { const int col = u.pn * 256 + 128 * bj + 32 * wc + 8 * fq; const u32x4 yy = *(const u32x4*)P32(YS5, row * 1024 + col); const f32x4 a0 = acc[ai][bj][m][0], a1 = acc[ai][bj][m][1];
                const f32x4 o0 = {bflo(yy.x) * sigmoidf_(a0.x), bfhi(yy.x) * sigmoidf_(a0.y), bflo(yy.y) * sigmoidf_(a0.z), bfhi(yy.y) * sigmoidf_(a0.w)};
                const f32x4 o1 = {bflo(yy.z) * sigmoidf_(a1.x), bfhi(yy.z) * sigmoidf_(a1.y), bflo(yy.w) * sigmoidf_(a1.z), bfhi(yy.w) * sigmoidf_(a1.w)};
                { unsigned char* mx = (unsigned char*)MIX; u32x2 o8 = {pk4_fp8(o0.x, o0.y, o0.z, o0.w), pk4_fp8(o1.x, o1.y, o1.z, o1.w)}; *(u32x2*)P32(mx, row * 2048 + 1024 + col) = o8; } }
        EPI_ROWS_END
    }
};
template <bool XBF> struct EpiRes { static constexpr bool PERM = true;
    bf16* XPRE; const void* xres; const float* gate;
    DI void operator()(const Acc& acc, const Unit& u, int wr, int wc, int fr, int fq) const {
        EPI_ROWS_BEGIN
            const int b = row / SEQ;
#pragma unroll
            for (int bj = 0; bj < 2; ++bj) { const int col = u.pn * 256 + 128 * bj + 32 * wc + 8 * fq;
                f32x4 x0, x1;
                if (XBF) { const bf16* xb = (const bf16*)xres; const u32x4 xq = *(const u32x4*)P32(xb, row * D + col); x0 = (f32x4){bflo(xq.x), bfhi(xq.x), bflo(xq.y), bfhi(xq.y)}; x1 = (f32x4){bflo(xq.z), bfhi(xq.z), bflo(xq.w), bfhi(xq.w)}; }
                else { const float* xf = (const float*)xres; x0 = *(const f32x4*)P32(xf, row * D + col); x1 = *(const f32x4*)P32(xf, row * D + col + 4); }
                const f32x4 g0 = *(const f32x4*)P32(gate, b * 12288 + col), g1 = *(const f32x4*)P32(gate, b * 12288 + col + 4);
                *(u32x4*)P32(XPRE, row * D + col) = pack8(x0 * DN_ALPHA + (g0 + 1.f) * acc[ai][bj][m][0], x1 * DN_ALPHA + (g1 + 1.f) * acc[ai][bj][m][1]); }
        EPI_ROWS_END
    }
};

DI void krope_pass(const bf16* KR, const float* rope, bf16* KF, int wv) {
    const int gt = blockIdx.x * 512 + otid(wv), NT_ = gridDim.x * 512;
    for (int i = gt; i < T * 8; i += NT_) { const int row = i >> 3, q = i & 7, b = row / SEQ, s = row % SEQ; const u32x4 r = *(const u32x4*)(KR + (size_t)row * 64 + q * 8);
        const f32x4 x1 = {bflo(r.x), bfhi(r.x), bflo(r.y), bfhi(r.y)}, x2 = {bflo(r.z), bfhi(r.z), bflo(r.w), bfhi(r.w)};
        const f32x4 cs = *(const f32x4*)(rope + s * 32 + 4 * q), sn = *(const f32x4*)(rope + 4096 * 32 + s * 32 + 4 * q);
        const u32x4 o = pack8(x1 * cs - x2 * sn, x1 * sn + x2 * cs);
#pragma unroll
        for (int h = 0; h < 8; ++h) *(u32x4*)(KF + ((size_t)(b * 8 + h) * SEQ + s) * 192 + 128 + q * 8) = o; }
}
DI void s5_carry(const float* ES, const float* L16, bf16* XH, LAS unsigned char* lds, int wv) {
    const int tid = otid(wv), lane = tid & 63, w = tid >> 6; LAS float* SEG = (LAS float*)lds;
    for (int base = blockIdx.x * 64; base < 4 * 64 * 64; base += gridDim.x * 64) {
        const int gt = base + lane, p = gt & 63, g = (gt >> 6) & 63, b = gt >> 12; const float lr = L16[(g * 64 + p) * 2], li = L16[(g * 64 + p) * 2 + 1];
        const size_t r0 = (size_t)g * 1024 + b * 256 + 32 * w;
        float hr = 0.f, hi = 0.f;
#pragma unroll 16
        for (int k = 0; k < 32; ++k) { const float er = ES[(r0 + k) * 128 + p], ei = ES[(r0 + k) * 128 + 64 + p]; const float nr = lr * hr - li * hi + er, ni = lr * hi + li * hr + ei; hr = nr; hi = ni; }
        __syncthreads();
        SEG[(w * 64 + lane) * 2] = hr; SEG[(w * 64 + lane) * 2 + 1] = hi;
        float pr = lr, pi = li;
#pragma unroll
        for (int q = 0; q < 5; ++q) { const float nr = pr * pr - pi * pi, ni = 2.f * pr * pi; pr = nr; pi = ni; }
        __syncthreads();
        hr = 0.f; hi = 0.f;
        for (int u = 0; u < w; ++u) { const float er = SEG[(u * 64 + lane) * 2], ei = SEG[(u * 64 + lane) * 2 + 1]; const float nr = pr * hr - pi * hi + er, ni = pr * hi + pi * hr + ei; hr = nr; hi = ni; }
#pragma unroll 16
        for (int k = 0; k < 32; ++k) { const float er = ES[(r0 + k) * 128 + p], ei = ES[(r0 + k) * 128 + 64 + p];
            XH[(r0 + k) * 384 + 256 + p] = f2bf(hr); XH[(r0 + k) * 384 + 320 + p] = f2bf(hi);
            const float nr = lr * hr - li * hi + er, ni = lr * hi + li * hr + ei; hr = nr; hi = ni; }
    }
    __syncthreads();
}

#define MFMA32(a, b, c) __builtin_amdgcn_mfma_f32_32x32x16_bf16((a), (b), (c), 0, 0, 0)
constexpr int AT_KROW = 384, AT_VROW = 256, AT_KBYTES = 64 * AT_KROW, AT_STG = AT_KBYTES + 64 * AT_VROW, AT_NST = 3;
static_assert(AT_NST * AT_STG <= RING_BYTES, "attention LDS");
DI void mla_attn_unit(LAS unsigned char* lds, const bf16* Qg, const bf16* KFg, const bf16* Vg, bf16* MIX, int unit, int wv) {
    const int tid = otid(wv), lane = tid & 63, w = tid >> 6, r = lane & 31, hh = lane >> 5;
    const int b = unit >> 6, h = (unit >> 3) & 7, pi = unit & 7;
    const bf16* Qh = Qg + (size_t)(b * 8 + h) * SEQ * 192; const bf16* Kh = KFg + (size_t)(b * 8 + h) * SEQ * 192; const bf16* Vh = Vg + (size_t)(b * 8 + h) * SEQ * 128;
    const int w_ = __builtin_amdgcn_readfirstlane(w);
    int koff[3], voff[2];
#pragma unroll
    for (int i = 0; i < 3; ++i) { const int p = (3 * w_ + i) * 64 + lane, row = p / 24, cs = p % 24, c = (cs & ~7) | ((cs ^ (row >> 1)) & 7); koff[i] = row * 192 + c * 8; }
#pragma unroll
    for (int i = 0; i < 2; ++i) { const int p = (2 * w_ + i) * 64 + lane, row = p >> 4, cs = p & 15, c = cs ^ ((row & 3) << 2); voff[i] = row * 128 + c * 8; }
    const int kx = (r >> 1) & 7, vq = (lane >> 2) & 3;
    for (int half = 0; half < 2; ++half) {
        const int qb = half ? 15 - pi : pi, q0 = qb * 256 + 32 * w, nkt = (qb + 1) * 4;
        bf16x8 qf[12];
#pragma unroll
        for (int ks = 0; ks < 12; ++ks) qf[ks] = *(const GAS bf16x8*)P32(Qh, (q0 + r) * 192 + 16 * ks + 8 * hh);
        f32x16 O[4];
#pragma unroll
        for (int i = 0; i < 4; ++i) for (int e = 0; e < 16; ++e) O[i][e] = 0.f;
        float mrow = -1e30f, lrow = 0.f;
#define AT_DMA(kt, stg) do { LAS unsigned char* sb_ = lds + (stg) * AT_STG; \
        _Pragma("unroll") for (int i = 0; i < 3; ++i) __builtin_amdgcn_global_load_lds((const unsigned*)P32(Kh, (kt) * 64 * 192 + koff[i]), (LAS unsigned*)(sb_ + (3 * w_ + i) * 1024), 16, 0, 0); \
        _Pragma("unroll") for (int i = 0; i < 2; ++i) __builtin_amdgcn_global_load_lds((const unsigned*)P32(Vh, (kt) * 64 * 128 + voff[i]), (LAS unsigned*)(sb_ + AT_KBYTES + (2 * w_ + i) * 1024), 16, 0, 0); } while (0)
#define AT_BAR() do { asm volatile("s_waitcnt lgkmcnt(0)" ::: "memory"); __builtin_amdgcn_s_barrier(); asm volatile("" ::: "memory"); } while (0)
        __syncthreads();
        AT_DMA(0, 0); AT_DMA(1, 1);
        asm volatile("s_waitcnt vmcnt(5)" ::: "memory");
        AT_BAR();
        int stg = 0;
        for (int kt = 0; kt < nkt; ++kt) {
            if (kt + 2 < nkt) AT_DMA(kt + 2, stg == 0 ? 2 : stg - 1);
            const LAS unsigned char* sb = lds + stg * AT_STG;
            if (kt * 64 <= q0 + 31) {
                f32x16 st[2];
#pragma unroll
                for (int mt = 0; mt < 2; ++mt) for (int e = 0; e < 16; ++e) st[mt][e] = 0.f;
                __builtin_amdgcn_sched_barrier(0);
                {
                    const LAS unsigned char* kb = sb + r * AT_KROW; const LAS unsigned char* kx4[4];
#pragma unroll
                    for (int j = 0; j < 4; ++j) kx4[j] = kb + (((2 * j + hh) ^ kx) & 7) * 16;
                    bf16x8 kf[24];
#pragma unroll
                    for (int i = 0; i < 24; ++i) kf[i] = *(const LAS bf16x8*)(kx4[(i >> 1) & 3] + 32 * (i & 1) * AT_KROW + 128 * (i >> 3));
#pragma unroll
                    for (int i = 0; i < 24; ++i) st[i & 1] = MFMA32(kf[i], qf[i >> 1], st[i & 1]);
                    __builtin_amdgcn_sched_group_barrier(0x100, 4, 0);
#pragma unroll
                    for (int i = 0; i < 24; ++i) { __builtin_amdgcn_sched_group_barrier(0x008, 1, 0); __builtin_amdgcn_sched_group_barrier(0x100, 1, 0); }
                }
                __builtin_amdgcn_sched_barrier(0);
                if (kt * 64 + 63 > q0) {
                    const int qg = q0 + r;
#pragma unroll
                    for (int mt = 0; mt < 2; ++mt)
#pragma unroll
                        for (int e = 0; e < 16; ++e) { const int kg = kt * 64 + 32 * mt + (e & 3) + 8 * (e >> 2) + 4 * hh; if (kg > qg) st[mt][e] = -1e30f; }
                }
                float mx = st[0][0];
#pragma unroll
                for (int mt = 0; mt < 2; ++mt)
#pragma unroll
                    for (int e = 0; e < 16; ++e) mx = fmaxf(mx, st[mt][e]);
                { const unsigned xi_ = __float_as_uint(mx); const auto rr_ = __builtin_amdgcn_permlane32_swap(xi_, xi_, false, false); mx = fmaxf(__uint_as_float(rr_[0]), __uint_as_float(rr_[1])); }
                float alpha = 1.f;
                if (__any(mx - mrow > 8.f)) { const float mnew = fmaxf(mrow, mx); alpha = __builtin_amdgcn_exp2f(mrow - mnew); mrow = mnew;
#pragma unroll
                    for (int i = 0; i < 4; ++i) O[i] *= alpha; }
                float ls = 0.f;
#pragma unroll
                for (int mt = 0; mt < 2; ++mt)
#pragma unroll
                    for (int e = 0; e < 16; ++e) { const float p = __builtin_amdgcn_exp2f(st[mt][e] - mrow); st[mt][e] = p; ls += p; }
                lrow = lrow * alpha + ls;
                bf16x8 pf[2][2];
#pragma unroll
                for (int mt = 0; mt < 2; ++mt)
#pragma unroll
                    for (int s = 0; s < 2; ++s) { u32x4 pk = {pk2(st[mt][8 * s], st[mt][8 * s + 1]), pk2(st[mt][8 * s + 2], st[mt][8 * s + 3]), pk2(st[mt][8 * s + 4], st[mt][8 * s + 5]), pk2(st[mt][8 * s + 6], st[mt][8 * s + 7])};
                        pf[mt][s] = __builtin_bit_cast(bf16x8, pk); }
                __builtin_amdgcn_sched_barrier(0);
                {
                    const LAS unsigned char* vb = sb + AT_KBYTES + (4 * hh + vq) * AT_VROW + 32 * ((lane >> 4) & 1) + 8 * (lane & 3); const LAS unsigned char* vx4[4];
#pragma unroll
                    for (int d = 0; d < 4; ++d) vx4[d] = vb + ((d ^ vq) & 3) * 64;
                    bf16x8 af[16];
#pragma unroll
                    for (int i = 0; i < 16; ++i) { const LAS unsigned char* vp = vx4[i & 3] + 16 * (i >> 2) * AT_VROW;
                        const s16x4 lo = __builtin_amdgcn_ds_read_tr16_b64_v4i16((LAS s16x4*)vp), hi = __builtin_amdgcn_ds_read_tr16_b64_v4i16((LAS s16x4*)(vp + 8 * AT_VROW)); af[i] = __builtin_shufflevector(lo, hi, 0, 1, 2, 3, 4, 5, 6, 7); }
#pragma unroll
                    for (int i = 0; i < 16; ++i) O[i & 3] = MFMA32(af[i], pf[i >> 3][(i >> 2) & 1], O[i & 3]);
                    __builtin_amdgcn_sched_group_barrier(0x100, 8, 0);
#pragma unroll
                    for (int i = 0; i < 16; ++i) { __builtin_amdgcn_sched_group_barrier(0x008, 1, 0); __builtin_amdgcn_sched_group_barrier(0x100, 2, 0); }
                }
                __builtin_amdgcn_sched_barrier(0);
            }
            if (kt + 2 < nkt) asm volatile("s_waitcnt vmcnt(5)" ::: "memory"); else asm volatile("s_waitcnt vmcnt(0)" ::: "memory");
            AT_BAR();
            stg = stg == 2 ? 0 : stg + 1;
        }
        lrow += __shfl_xor(lrow, 32);
        const float inv = 1.f / lrow;
        unsigned char* mx_ = (unsigned char*)MIX; unsigned char* orow = P32(mx_, (b * SEQ + q0 + r) * 2048 + h * 128);
#pragma unroll
        for (int dvt = 0; dvt < 4; ++dvt)
#pragma unroll
            for (int g4 = 0; g4 < 4; ++g4) *(GAS unsigned*)(orow + dvt * 32 + 8 * g4 + 4 * hh) = pk4_fp8(O[dvt][4 * g4] * inv, O[dvt][4 * g4 + 1] * inv, O[dvt][4 * g4 + 2] * inv, O[dvt][4 * g4 + 3] * inv);
    }
#undef AT_DMA
#undef AT_BAR
}

DI void ln_router_phase(const KArgs& a, LAS unsigned char* lds, int layer, const bf16* XPRE, bf16* X1, bf16* H, int wv) {
    const int tid = otid(wv), lane = tid & 63, wave = tid >> 6;
    LAS float* wT = (LAS float*)lds;
    { f32x4 rw[4][4];
#pragma unroll
      for (int i = 0; i < 4; ++i)
#pragma unroll
          for (int q4 = 0; q4 < 4; ++q4) rw[i][q4] = *(const f32x4*)(a.in[I_RW] + (size_t)(tid + 512 * i) * 16 + 4 * q4);
#pragma unroll
      for (int i = 0; i < 4; ++i)
#pragma unroll
          for (int q4 = 0; q4 < 4; ++q4)
#pragma unroll
              for (int e4 = 0; e4 < 4; ++e4) wT[(4 * q4 + e4) * 2048 + tid + 512 * i] = rw[i][q4][e4]; }
    __syncthreads();
    const float* MODl = (const float*)(a.ws + CTL_MOD) + (size_t)layer * 4 * 12288;
    const float* lg = a.in[I_LNMG] + layer * D; const float* lb = a.in[I_LNMB] + layer * D;
    unsigned* cnt = (unsigned*)(a.ws + CTL_CNT) + layer * 16 * 64;
    LAS int* lcnt = (LAS int*)(lds + LDS_MISC + 256); LAS int* lbase = lcnt + 16; LAS int* rec = lcnt + 32;
    if (tid < 16) lcnt[tid] = 0;
    int* RTE = (int*)(a.ws + A_RT); int* RTP = RTE + 2 * T; float* RTW = (float*)(RTP + 2 * T); int* TOKL = (int*)(a.ws + A_TOKL);
    const LAS float* wp[16];
#pragma unroll
    for (int e = 0; e < 16; ++e) { wp[e] = wT + e * 2048 + lane * 4; asm volatile("" : "+v"(wp[e])); }
    const float rbl = a.in[I_RB][lane >> 2];
    int lr = wave;
    for (int m = blockIdx.x * 8 + wave; m < T; m += gridDim.x * 8, lr += 8) {
        const int b = m / SEQ; const float* sh = MODl + (size_t)b * 12288 + 3 * 2048; const float* sc = sh + 2048;
        f32x4 v[8]; float s = 0.f;
#pragma unroll
        for (int j = 0; j < 8; ++j) { const u32x2 xp = *(const GAS u32x2*)(XPRE + (size_t)m * D + (lane + 64 * j) * 4); v[j] = (f32x4){bflo(xp.x), bfhi(xp.x), bflo(xp.y), bfhi(xp.y)}; s += (v[j].x + v[j].y) + (v[j].z + v[j].w); }
        const float mean = wave_sum(s) * (1.f / D); float s2 = 0.f;
#pragma unroll
        for (int j = 0; j < 8; ++j) { v[j] = v[j] - mean; s2 += (v[j].x * v[j].x + v[j].y * v[j].y) + (v[j].z * v[j].z + v[j].w * v[j].w); }
        const float rstd = rsqrtf(wave_sum(s2) * (1.f / D) + LN_EPS);
#pragma unroll
        for (int j = 0; j < 8; ++j) { const int col = (lane + 64 * j) * 4; const f32x4 x1 = v[j] * rstd * *(const f32x4*)(lg + col) + *(const f32x4*)(lb + col);
            { u32x2 ox = {pk2(x1.x, x1.y), pk2(x1.z, x1.w)}; *(GAS u32x2*)(X1 + (size_t)m * D + col) = ox; }
            const f32x4 hv = x1 * (*(const f32x4*)(sc + col) + 1.f) + *(const f32x4*)(sh + col);
            *(GAS unsigned*)((unsigned char*)H + (size_t)m * D + col) = pk4_fp8(hv.x, hv.y, hv.z, hv.w); v[j] = hv; }
        f32x2 part2[16];
#pragma unroll
        for (int e = 0; e < 16; ++e) part2[e] = (f32x2){0.f, 0.f};
#pragma unroll
        for (int j = 0; j < 8; ++j) { f32x4 wr_[16];
#pragma unroll
            for (int e = 0; e < 16; ++e) wr_[e] = *(const LAS f32x4*)(wp[e] + j * 256);
            __builtin_amdgcn_sched_barrier(0);
#pragma unroll
            for (int e = 0; e < 16; ++e) { part2[e] += (f32x2){v[j].x, v[j].y} * (f32x2){wr_[e].x, wr_[e].y}; part2[e] += (f32x2){v[j].z, v[j].w} * (f32x2){wr_[e].z, wr_[e].w}; }
            __builtin_amdgcn_sched_barrier(0); }
        float part[16];
#pragma unroll
        for (int e = 0; e < 16; ++e) part[e] = part2[e].x + part2[e].y;
        float r8[8], r4[4], r2[2], lg1;
        { const bool hi = lane & 32;
#pragma unroll
          for (int i = 0; i < 8; ++i) { const float mine = hi ? part[8 + i] : part[i], oth = hi ? part[i] : part[8 + i]; r8[i] = mine + __shfl_xor(oth, 32); } }
        { const bool hi = lane & 16;
#pragma unroll
          for (int i = 0; i < 4; ++i) { const float mine = hi ? r8[4 + i] : r8[i], oth = hi ? r8[i] : r8[4 + i]; r4[i] = mine + __shfl_xor(oth, 16); } }
        { const bool hi = lane & 8;
#pragma unroll
          for (int i = 0; i < 2; ++i) { const float mine = hi ? r4[2 + i] : r4[i], oth = hi ? r4[i] : r4[2 + i]; r2[i] = mine + __shfl_xor(oth, 8); } }
        { const bool hi = lane & 4; const float mine = hi ? r2[1] : r2[0], oth = hi ? r2[0] : r2[1]; lg1 = mine + __shfl_xor(oth, 4); }
        lg1 += dpp_xor1(lg1); lg1 += dpp_xor2(lg1);
        const float sgl = 1.f / (1.f + expf(-lg1)), sbl = sgl + rbl;
        float gs; { const float y1 = dpp_ror<4>(sbl), y2 = dpp_ror<8>(sbl), y3 = dpp_ror<12>(sbl);
            gs = fmaxf(fmaxf(fmaxf(sbl + y1, sbl + y2), fmaxf(sbl + y3, y1 + y2)), fmaxf(y1 + y3, y2 + y3)); }
        int bg = 0; float bgs = __builtin_bit_cast(float, __builtin_amdgcn_readlane(__builtin_bit_cast(int, gs), 0)); asm volatile("" : "+v"(bgs));
#pragma unroll
        for (int g = 1; g < 4; ++g) { float x = __builtin_bit_cast(float, __builtin_amdgcn_readlane(__builtin_bit_cast(int, gs), 16 * g)); asm volatile("" : "+v"(x)); const bool c = x > bgs; bgs = c ? x : bgs; bg = c ? g : bg; }
        const int bgu = __builtin_amdgcn_readfirstlane(bg);
        int e0 = 0, e1 = 0; float b0 = -1e30f, b1 = -1e30f, s0 = 0.f, s1 = 0.f;
#pragma unroll
        for (int i = 0; i < 4; ++i) { float x = __builtin_bit_cast(float, __builtin_amdgcn_readlane(__builtin_bit_cast(int, sbl), 16 * bgu + 4 * i)), sx = __builtin_bit_cast(float, __builtin_amdgcn_readlane(__builtin_bit_cast(int, sgl), 16 * bgu + 4 * i));
            asm volatile("" : "+v"(x), "+v"(sx)); const int e = 4 * bg + i; const bool g0 = x > b0, g1 = x > b1;
            b1 = g0 ? b0 : (g1 ? x : b1); e1 = g0 ? e0 : (g1 ? e : e1); s1 = g0 ? s0 : (g1 ? sx : s1);
            b0 = g0 ? x : b0; e0 = g0 ? e : e0; s0 = g0 ? sx : s0; }
        if (lane == 0) { const float inv = 1.f / (s0 + s1);
            const int p0 = __hip_atomic_fetch_add(lcnt + e0, 1, __ATOMIC_RELAXED, __HIP_MEMORY_SCOPE_WORKGROUP), p1 = __hip_atomic_fetch_add(lcnt + e1, 1, __ATOMIC_RELAXED, __HIP_MEMORY_SCOPE_WORKGROUP);
            rec[lr * 4] = m; rec[lr * 4 + 1] = e0; rec[lr * 4 + 2] = e1; rec[lr * 4 + 3] = p0 | (p1 << 16);
            RTE[2 * m] = e0; RTE[2 * m + 1] = e1; RTW[2 * m] = s0 * inv; RTW[2 * m + 1] = s1 * inv; }
    }
    __syncthreads();
    if (tid < 16) lbase[tid] = (int)atomicAdd(cnt + tid * 64, (unsigned)lcnt[tid]);
    __syncthreads();
    const int nrows = (T - (int)blockIdx.x * 8 + (int)gridDim.x * 8 - 1) / ((int)gridDim.x * 8) * 8;
    for (int i = tid; i < nrows; i += 512) { const int k = i >> 3, w8 = i & 7, m = (int)blockIdx.x * 8 + w8 + k * (int)gridDim.x * 8;
        if (m < T) { const int e0 = rec[i * 4 + 1], e1 = rec[i * 4 + 2], pp = rec[i * 4 + 3], q0 = lbase[e0] + (pp & 0xffff), q1 = lbase[e1] + (pp >> 16);
            TOKL[e0 * T + q0] = m; TOKL[e1 * T + q1] = m; RTP[2 * m] = q0; RTP[2 * m + 1] = q1; } }
    __syncthreads();
}

DI void moe_table(const KArgs& a, LAS unsigned char* lds, int layer, int wv) {
    LAS int* tab = (LAS int*)(lds + LDS_TAB);
    if (otid(wv) == 0) { const unsigned* cnt = (const unsigned*)(a.ws + CTL_CNT) + layer * 16 * 64; int acc = 0;
        for (int e = 0; e < 16; ++e) { const int c = (int)cnt[e * 64]; tab[e] = acc; tab[32 + e] = c; acc += (c + 255) >> 8; } tab[16] = acc; }
    __syncthreads();
}
template <int NTB> struct MoeOrder {
    int G, c, layer; const LAS int* tab; const int* tokl;
    DI bool next(int i, Unit& u) const { const int L = i * G + c, mt = L / NTB, nt = L % NTB; if (mt >= tab[16]) return false; int e = 0;
#pragma unroll
        for (int k = 1; k < 16; ++k) e += (mt >= tab[k]) ? 1 : 0;
        u.pm = mt; u.pn = (layer * 16 + e) * NTB + nt; u.aux = e | (nt << 8) | ((mt - tab[e]) << 16); return true; }
    DI int arow(const Unit& u, int r) const { const int e = u.aux & 255, j = (u.aux >> 16) * 256 + r; return j < tab[32 + e] ? tokl[e * T + j] : 0; }
    DI int koff(const Unit&) const { return 0; }
};
struct EpiGateUp { static constexpr bool PERM = true;
    unsigned char* ACT;
    DI void operator()(const Acc& acc, const Unit& u, int wr, int wc, int fr, int fq) const {
        const int nt = (u.aux >> 8) & 255;
        EPI_ROWS_BEGIN
            const f32x4 g0 = acc[ai][0][m][0], g1 = acc[ai][0][m][1], u0 = acc[ai][1][m][0], u1 = acc[ai][1][m][1];
            f32x4 o0, o1;
#pragma unroll
            for (int e = 0; e < 4; ++e) { o0[e] = g0[e] * sigmoidf_(g0[e]) * u0[e]; o1[e] = g1[e] * sigmoidf_(g1[e]) * u1[e]; }
            u32x2 o8 = {pk4_fp8(o0.x, o0.y, o0.z, o0.w), pk4_fp8(o1.x, o1.y, o1.z, o1.w)}; *(u32x2*)P32(ACT, row * 512 + nt * 128 + 32 * wc + 8 * fq) = o8;
        EPI_ROWS_END
    }
};
struct EpiDown { static constexpr bool PERM = true;
    bf16* YS;
    DI void operator()(const Acc& acc, const Unit& u, int wr, int wc, int fr, int fq) const {
        const int nt = (u.aux >> 8) & 255;
        EPI_ROWS_BEGIN
#pragma unroll
            for (int bj = 0; bj < 2; ++bj) *(u32x4*)P32(YS, row * 2048 + nt * 256 + 128 * bj + 32 * wc + 8 * fq) = pack8(acc[ai][bj][m][0], acc[ai][bj][m][1]);
        EPI_ROWS_END
    }
};
DI void ln_ffn_phase(const KArgs& a, int layer, const bf16* X1, float* XO, bf16* Hn, int wv) {
    const int lane = otid(wv) & 63, wave = otid(wv) >> 6;
    const float* MODl = (const float*)(a.ws + CTL_MOD) + (size_t)layer * 4 * 12288; const float* MODn = MODl + 4 * 12288;
    const float* lg = a.in[I_LNFG] + layer * D; const float* lb = a.in[I_LNFB] + layer * D;
    const unsigned* cnt = (const unsigned*)(a.ws + CTL_CNT) + layer * 16 * 64;
    const int* RTE = (const int*)(a.ws + A_RT); const int* RTP = RTE + 2 * T; const float* RTW = (const float*)(RTP + 2 * T); const bf16* YS = (const bf16*)(a.ws + A_YS);
    for (int m = blockIdx.x * 8 + wave; m < T; m += gridDim.x * 8) {
        const int b = m / SEQ; const float* gf = MODl + (size_t)b * 12288 + 5 * 2048;
        const int e0 = RTE[2 * m], e1 = RTE[2 * m + 1]; int t0 = 0, t1 = 0;
        for (int e = 0; e < 16; ++e) { const int tl = ((int)cnt[e * 64] + 255) >> 8; t0 += e < e0 ? tl : 0; t1 += e < e1 ? tl : 0; }
        const bf16* y0 = YS + ((size_t)t0 * 256 + RTP[2 * m]) * 2048; const bf16* y1 = YS + ((size_t)t1 * 256 + RTP[2 * m + 1]) * 2048; const float w0 = RTW[2 * m], w1 = RTW[2 * m + 1];
        f32x4 v[8]; float s = 0.f;
#pragma unroll
        for (int j = 0; j < 8; ++j) { const int col = (lane + 64 * j) * 4; const u32x2 a0 = *(const u32x2*)(y0 + col), a1 = *(const u32x2*)(y1 + col);
            const f32x4 y = {w0 * bflo(a0.x) + w1 * bflo(a1.x), w0 * bfhi(a0.x) + w1 * bfhi(a1.x), w0 * bflo(a0.y) + w1 * bflo(a1.y), w0 * bfhi(a0.y) + w1 * bfhi(a1.y)};
            const u32x2 xq = *(const u32x2*)(X1 + (size_t)m * D + col); const f32x4 xv = {bflo(xq.x), bfhi(xq.x), bflo(xq.y), bfhi(xq.y)};
            v[j] = xv * DN_ALPHA + (*(const f32x4*)(gf + col) + 1.f) * y; s += (v[j].x + v[j].y) + (v[j].z + v[j].w); }
        const float mean = wave_sum(s) * (1.f / D); float s2 = 0.f;
#pragma unroll
        for (int j = 0; j < 8; ++j) { v[j] = v[j] - mean; s2 += (v[j].x * v[j].x + v[j].y * v[j].y) + (v[j].z * v[j].z + v[j].w * v[j].w); }
        const float rstd = rsqrtf(wave_sum(s2) * (1.f / D) + LN_EPS);
#pragma unroll
        for (int j = 0; j < 8; ++j) { const int col = (lane + 64 * j) * 4; const f32x4 xo = v[j] * rstd * *(const f32x4*)(lg + col) + *(const f32x4*)(lb + col);
            if (Hn) { u32x2 oq = {pk2(xo.x, xo.y), pk2(xo.z, xo.w)}; *(u32x2*)((bf16*)XO + (size_t)m * D + col) = oq; }
            else *(f32x4*)(XO + (size_t)m * D + col) = xo;
            if (Hn) { const float* sh = MODn + (size_t)b * 12288; const f32x4 hv = xo * (*(const f32x4*)(sh + 2048 + col) + 1.f) + *(const f32x4*)(sh + col);
                *(unsigned*)((unsigned char*)Hn + (size_t)m * D + col) = pk4_fp8(hv.x, hv.y, hv.z, hv.w); } }
    }
}

struct EpiIn1 { static constexpr bool PERM = true;
    bf16 *ZD, *ZR;
    DI void operator()(const Acc& acc, const Unit& u, int wr, int wc, int fr, int fq) const {
        EPI_ROWS_BEGIN
#pragma unroll
            for (int bj = 0; bj < 2; ++bj) { const int col = u.pn * 256 + 128 * bj + 32 * wc + 8 * fq; const u32x4 o = pack8(acc[ai][bj][m][0], acc[ai][bj][m][1]);
                if (col < DIL_IN) *(u32x4*)P32(ZD, row * DIL_IN + col) = o; else if (col < ODD_IN) *(u32x4*)P32(ZR, row * RW_IN + (col - DIL_IN)) = o; }
        EPI_ROWS_END
    }
};
constexpr int DA_KSTR = 272, DA_VROW = 320, DA_KBYTES = 64 * DA_KSTR, DA_STG = DA_KBYTES + 64 * DA_VROW;
struct DilPre { bf16x8 qf[4]; u32x4 kreg[2], vreg[2]; float blv[2]; };
DI void dil_issue(const bf16* ZD, const float* BL, int unit, int wv, DilPre& P) {
    const int tid = otid(wv), lane = tid & 63, w = tid >> 6, r = lane & 31, hh = lane >> 5, hd = w >> 2, qs = w & 3;
    const int hp = unit & 3, sb_ = (unit >> 2) & 31, gi = (unit >> 7) % 3, b = unit / 384;
    const int dil = gi == 0 ? 1 : (gi == 1 ? 4 : 16), nb = 32 / dil, rr = sb_ / nb, n = sb_ % nb, h = hp * 2 + hd, kt0 = n == 0 ? 2 : 0;
    const bf16* Zb = ZD + (size_t)b * SEQ * DIL_IN + gi * 1536;
    const int qtok = (n * 128 + 32 * qs + r) * dil + rr;
#pragma unroll
    for (int k = 0; k < 2; ++k) { const int i = tid + 512 * k, hd_ = i >= 384 ? 1 : 0, d = i - 384 * hd_ - 127;
        P.blv[k] = (i < 768 && d >= 0 && d <= 128) ? ((const GAS float*)BL)[(gi * 8 + hp * 2 + hd_) * 132 + d] : -1e30f; }
#pragma unroll
    for (int ks = 0; ks < 4; ++ks) P.qf[ks] = *(const GAS bf16x8*)P32(Zb, qtok * DIL_IN + h * 64 + 16 * ks + 8 * hh);
#pragma unroll
    for (int i = 0; i < 2; ++i) { const int p = tid + 512 * i, kr = p >> 4, c16 = p & 15; const int ktok = ((n - 1) * 128 + kt0 * 64 + kr) * dil + rr;
        P.kreg[i] = *(const GAS u32x4*)P32(Zb, ktok * DIL_IN + 512 + hp * 128 + c16 * 8); P.vreg[i] = *(const GAS u32x4*)P32(Zb, ktok * DIL_IN + 1024 + hp * 128 + c16 * 8); }
}
DI void dil_attn_unit(LAS unsigned char* lds, const bf16* ZD, const float* BL, bf16* DPO, float* DPM, float* DPL, int unit, int next, DilPre& P, int wv) {
    const int tid = otid(wv), lane = tid & 63, w = tid >> 6, r = lane & 31, hh = lane >> 5, hd = w >> 2, qs = w & 3;
    const int hp = unit & 3, sb_ = (unit >> 2) & 31, gi = (unit >> 7) % 3, b = unit / 384;
    const int dil = gi == 0 ? 1 : (gi == 1 ? 4 : 16), nb = 32 / dil, rr = sb_ / nb, n = sb_ % nb;
    const int h = hp * 2 + hd;
    const bf16* Zb = ZD + (size_t)b * SEQ * DIL_IN + gi * 1536;
    LAS float* bl = (LAS float*)(lds + 2 * DA_STG);
    __syncthreads();
    bl[tid] = P.blv[0]; if (tid < 256) bl[512 + tid] = P.blv[1];
    const int qi = 32 * qs + r, qtok = (n * 128 + qi) * dil + rr;
    bf16x8 qf[4];
#pragma unroll
    for (int ks = 0; ks < 4; ++ks) qf[ks] = P.qf[ks];
    f32x16 O[2];
#pragma unroll
    for (int i = 0; i < 2; ++i) for (int e = 0; e < 16; ++e) O[i][e] = 0.f;
    float mrow = -1e30f, lrow = 0.f;
    u32x4 kreg[2] = {P.kreg[0], P.kreg[1]}, vreg[2] = {P.vreg[0], P.vreg[1]};
    const int kt0 = n == 0 ? 2 : 0;
#define DA_LOAD(kt) do { _Pragma("unroll") for (int i = 0; i < 2; ++i) { const int p = tid + 512 * i, kr = p >> 4, c16 = p & 15; const int ktok = ((n - 1) * 128 + (kt) * 64 + kr) * dil + rr; \
            kreg[i] = *(const GAS u32x4*)P32(Zb, ktok * DIL_IN + 512 + hp * 128 + c16 * 8); } \
        _Pragma("unroll") for (int i = 0; i < 2; ++i) { const int p = tid + 512 * i, kr = p >> 4, c16 = p & 15; const int ktok = ((n - 1) * 128 + (kt) * 64 + kr) * dil + rr; vreg[i] = *(const GAS u32x4*)P32(Zb, ktok * DIL_IN + 1024 + hp * 128 + c16 * 8); } } while (0)
#define DA_STORE(buf) do { LAS unsigned char* sb = lds + (buf) * DA_STG; _Pragma("unroll") for (int i = 0; i < 2; ++i) { const int p = tid + 512 * i, kr = p >> 4, c16 = p & 15; *(LAS u32x4*)(sb + kr * DA_KSTR + c16 * 16) = kreg[i]; } \
        _Pragma("unroll") for (int i = 0; i < 2; ++i) { const int p = tid + 512 * i; *(LAS u32x4*)(sb + DA_KBYTES + (p >> 4) * DA_VROW + (p & 15) * 16) = vreg[i]; } } while (0)
    DA_STORE(kt0 & 1);
    __syncthreads();
    for (int kt = kt0; kt < 4; ++kt) {
        if (kt + 1 < 4) DA_LOAD(kt + 1); else if (next >= 0) dil_issue(ZD, BL, next, wv, P);
        const LAS unsigned char* sb = lds + (kt & 1) * DA_STG;
        if (64 * kt + 63 >= 32 * qs && 64 * kt <= 32 * qs + 31 + 128) {
            f32x16 st[2];
#pragma unroll
            for (int mt = 0; mt < 2; ++mt) for (int e = 0; e < 16; ++e) st[mt][e] = 0.f;
            __builtin_amdgcn_sched_barrier(0);
            {
                const LAS unsigned char* kb = sb + r * DA_KSTR + (hd * 64 + 8 * hh) * 2; bf16x8 kf[8];
#pragma unroll
                for (int i = 0; i < 8; ++i) kf[i] = *(const LAS bf16x8*)(kb + 32 * (i & 1) * DA_KSTR + 32 * (i >> 1));
#pragma unroll
                for (int i = 0; i < 8; ++i) st[i & 1] = MFMA32(kf[i], qf[i >> 1], st[i & 1]);
                __builtin_amdgcn_sched_group_barrier(0x100, 3, 0);
#pragma unroll
                for (int i = 0; i < 8; ++i) { __builtin_amdgcn_sched_group_barrier(0x008, 1, 0); __builtin_amdgcn_sched_group_barrier(0x100, 1, 0); }
            }
            __builtin_amdgcn_sched_barrier(0);
#pragma unroll
            for (int mt = 0; mt < 2; ++mt) { const LAS float* lp = bl + hd * 384 + 127 + (128 + qi - 64 * kt - 32 * mt - 4 * hh) - 27;
#pragma unroll
                for (int e = 0; e < 16; ++e) st[mt][e] = st[mt][e] * (0.125f * 1.44269504089f) + lp[27 - ((e & 3) + 8 * (e >> 2))]; }
            float mx = st[0][0];
#pragma unroll
            for (int mt = 0; mt < 2; ++mt)
#pragma unroll
                for (int e = 0; e < 16; ++e) mx = fmaxf(mx, st[mt][e]);
            { const unsigned xi_ = __float_as_uint(mx); const auto rr_ = __builtin_amdgcn_permlane32_swap(xi_, xi_, false, false); mx = fmaxf(__uint_as_float(rr_[0]), __uint_as_float(rr_[1])); }
            float alpha = 1.f;
            if (__any(mx - mrow > 8.f)) { const float mnew = fmaxf(mrow, mx); alpha = __builtin_amdgcn_exp2f(mrow - mnew); mrow = mnew; O[0] *= alpha; O[1] *= alpha; }
            float ls = 0.f;
#pragma unroll
            for (int mt = 0; mt < 2; ++mt)
#pragma unroll
                for (int e = 0; e < 16; ++e) { const float p = __builtin_amdgcn_exp2f(st[mt][e] - mrow); st[mt][e] = p; ls += p; }
            lrow = lrow * alpha + ls;
            bf16x8 pf[2][2];
#pragma unroll
            for (int mt = 0; mt < 2; ++mt)
#pragma unroll
                for (int s = 0; s < 2; ++s) { u32x4 pk = {pk2(st[mt][8 * s], st[mt][8 * s + 1]), pk2(st[mt][8 * s + 2], st[mt][8 * s + 3]), pk2(st[mt][8 * s + 4], st[mt][8 * s + 5]), pk2(st[mt][8 * s + 6], st[mt][8 * s + 7])};
                    pf[mt][s] = __builtin_bit_cast(bf16x8, pk); }
            __builtin_amdgcn_sched_barrier(0);
            {
                const LAS unsigned char* vb = sb + DA_KBYTES + (4 * hh + ((lane >> 2) & 3)) * DA_VROW + (hd * 64 + 16 * ((lane >> 4) & 1)) * 2 + 8 * (lane & 3); bf16x8 af[8];
#pragma unroll
                for (int i = 0; i < 8; ++i) { const LAS unsigned char* vp = vb + 16 * (i >> 1) * DA_VROW + (i & 1) * 64;
                    const s16x4 lo = __builtin_amdgcn_ds_read_tr16_b64_v4i16((LAS s16x4*)vp), hi = __builtin_amdgcn_ds_read_tr16_b64_v4i16((LAS s16x4*)(vp + 8 * DA_VROW)); af[i] = __builtin_shufflevector(lo, hi, 0, 1, 2, 3, 4, 5, 6, 7); }
#pragma unroll
                for (int i = 0; i < 8; ++i) O[i & 1] = MFMA32(af[i], pf[i >> 2][(i >> 1) & 1], O[i & 1]);
                __builtin_amdgcn_sched_group_barrier(0x100, 6, 0);
#pragma unroll
                for (int i = 0; i < 8; ++i) { __builtin_amdgcn_sched_group_barrier(0x008, 1, 0); __builtin_amdgcn_sched_group_barrier(0x100, 2, 0); }
            }
            __builtin_amdgcn_sched_barrier(0);
        }
        if (kt + 1 < 4) DA_STORE((kt + 1) & 1);
        __syncthreads();
    }
    lrow += __shfl_xor(lrow, 32);
    const float inv = 1.f / lrow;
    const int tokg = b * SEQ + qtok;
    bf16* orow = P32(DPO, (gi * T + tokg) * 512 + h * 64);
#pragma unroll
    for (int dvt = 0; dvt < 2; ++dvt)
#pragma unroll
        for (int g4 = 0; g4 < 4; ++g4) { u32x2 o = {pk2(O[dvt][4 * g4] * inv, O[dvt][4 * g4 + 1] * inv), pk2(O[dvt][4 * g4 + 2] * inv, O[dvt][4 * g4 + 3] * inv)};
            *(GAS u32x2*)(orow + dvt * 32 + 8 * g4 + 4 * hh) = o; }
    if (hh == 0) { *(GAS float*)P32(DPM, (gi * T + tokg) * 8 + h) = mrow; *(GAS float*)P32(DPL, (gi * T + tokg) * 8 + h) = lrow; }
#undef DA_LOAD
#undef DA_STORE
}
DI void dil_merge(const bf16* DPO, const float* DPM, const float* DPL, bf16* MIX, int wv) {
    const int gt = blockIdx.x * 512 + otid(wv), NT_ = gridDim.x * 512;
    for (int i = gt; i < T * 64; i += NT_) { const int tok = i >> 6, c8 = i & 63, h = c8 >> 3;
        float m[3], l[3];
#pragma unroll
        for (int g = 0; g < 3; ++g) { m[g] = DPM[((size_t)g * T + tok) * 8 + h]; l[g] = DPL[((size_t)g * T + tok) * 8 + h]; }
        const float M = fmaxf(m[0], fmaxf(m[1], m[2])); float wsum = 0.f, wg[3];
#pragma unroll
        for (int g = 0; g < 3; ++g) { wg[g] = __builtin_amdgcn_exp2f(m[g] - M) * l[g]; wsum += wg[g]; }
        const float inv = __builtin_amdgcn_rcpf(wsum); float o[8];
#pragma unroll
        for (int e = 0; e < 8; ++e) o[e] = 0.f;
#pragma unroll
        for (int g = 0; g < 3; ++g) { const u32x4 v = *(const u32x4*)(DPO + ((size_t)g * T + tok) * 512 + c8 * 8); const float wn = wg[g] * inv;
            o[0] += wn * bflo(v.x); o[1] += wn * bfhi(v.x); o[2] += wn * bflo(v.y); o[3] += wn * bfhi(v.y); o[4] += wn * bflo(v.z); o[5] += wn * bfhi(v.z); o[6] += wn * bflo(v.w); o[7] += wn * bfhi(v.w); }
        u32x2 r = {pk4_fp8(o[0], o[1], o[2], o[3]), pk4_fp8(o[4], o[5], o[6], o[7])}; *(u32x2*)((unsigned char*)MIX + (size_t)tok * 2048 + c8 * 8) = r; }
}

DI void rwkv_prep(const bf16* ZR, const float* mu, bf16* LIN, int wv) {
    const int gt = blockIdx.x * 512 + otid(wv), NT_ = gridDim.x * 512;
    for (int i = gt; i < T * 48; i += NT_) { const int tok = i / 48, c0 = (i % 48) * 8, s = tok % SEQ; float o[8];
        if (c0 < 352) { const u32x4 z = *(const u32x4*)(ZR + (size_t)tok * RW_IN + 4608 + c0); u32x4 zp = {0u, 0u, 0u, 0u}; if (s > 0) zp = *(const u32x4*)(ZR + (size_t)(tok - 1) * RW_IN + 4608 + c0);
            const unsigned* zz = (const unsigned*)&z; const unsigned* pp = (const unsigned*)&zp;
#pragma unroll
            for (int e = 0; e < 8; ++e) { const float zv = (e & 1) ? bfhi(zz[e >> 1]) : bflo(zz[e >> 1]), pv = (e & 1) ? bfhi(pp[e >> 1]) : bflo(pp[e >> 1]); const float xs = zv + (pv - zv) * mu[4608 + c0 + e];
                o[e] = c0 < 64 ? 1.f - 2.f * __builtin_amdgcn_rcpf(1.f + __expf(2.f * xs)) : (c0 < 128 ? xs : sigmoidf_(xs)); } }
        else {
#pragma unroll
            for (int e = 0; e < 8; ++e) o[e] = 0.f; }
        u32x4 r = {pk2(o[0], o[1]), pk2(o[2], o[3]), pk2(o[4], o[5]), pk2(o[6], o[7])}; *(u32x4*)(LIN + (size_t)tok * 384 + c0) = r; }
}
struct LoraOrder : pg8::StaticOrder { int ko; DI int koff(const Unit&) const { return ko; } };
struct EpiLora { static constexpr bool PERM = true;
    bf16 *WDEC, *AA, *GG; const float *w0, *a0; int pn0;
    DI void operator()(const Acc& acc, const Unit& u, int wr, int wc, int fr, int fq) const {
        const int pnn = u.pn + pn0, kind = pnn / 6;
        EPI_ROWS_BEGIN
#pragma unroll
            for (int bj = 0; bj < 2; ++bj) { const int col = (pnn % 6) * 256 + 128 * bj + 32 * wc + 8 * fq; f32x4 v0 = acc[ai][bj][m][0], v1 = acc[ai][bj][m][1];
                if (kind == 0) { const f32x4 b0 = *(const f32x4*)P32(w0, col), b1 = *(const f32x4*)P32(w0, col + 4);
#pragma unroll
                    for (int e = 0; e < 4; ++e) { v0[e] = -0.6065306597f * sigmoidf_(v0[e] + b0[e]); v1[e] = -0.6065306597f * sigmoidf_(v1[e] + b1[e]); }
                    *(u32x4*)P32(WDEC, row * RWW + col) = pack8(v0, v1); }
                else if (kind == 1) { const f32x4 b0 = *(const f32x4*)P32(a0, col), b1 = *(const f32x4*)P32(a0, col + 4);
#pragma unroll
                    for (int e = 0; e < 4; ++e) { v0[e] = sigmoidf_(v0[e] + b0[e]); v1[e] = sigmoidf_(v1[e] + b1[e]); }
                    *(u32x4*)P32(AA, row * RWW + col) = pack8(v0, v1); }
                else *(u32x4*)P32(GG, row * RWW + col) = pack8(v0, v1); }
        EPI_ROWS_END
    }
};
constexpr int CK_AT = 0, CK_RT = 2048, CK_BH = 4096, CK_KH = 6144, CK_MT = 8192, CK_NK = 8704, CK_PB = 9216, CK_PK = 9728, CK_G15 = 10240, CK_VT = 10496  , CK_VTS = 40, CK_BS = 13056  , CK_SLOT = 13120;
constexpr int CK_HALF = 128;
constexpr int CK_N1 = (int)((128 * MiB) / CK_SLOT) - 1;
DI unsigned char* ck_slot(unsigned char* ws, int job) { return job < CK_N1 ? ws + WS_X1 + (size_t)job * CK_SLOT : ws + WS_W_GU + (size_t)(job - CK_N1) * CK_SLOT; }
static_assert((size_t)(96 * CK_HALF - CK_N1 + 1) * CK_SLOT <= 64 * MiB, "chunk buffer");
constexpr int PJ = 4;
constexpr int PL_AT = 0, PL_BT = 2304, PL_KT = 4608, PL_RT = 6912, PL_BH = 9216, PL_KH = 11520  ,
              PL_NAB = 13824  , PL_MTS = 14848  , PL_LDT = 15616  , PL_C = 19968  ,
              PL_T = 24064  , PL_VT = 24320  , PL_END = 26880;
static_assert(PJ * PL_END <= RING_BYTES && PJ == 4, "prep LDS");
DI bf16x8 ldfrag(const LAS unsigned char* p) { return *(const LAS bf16x8*)p; }
DI u32x4 ld2x8(const LAS unsigned char* p0, const LAS unsigned char* p1) { const u32x2 lo = *(const LAS u32x2*)p0, hi = *(const LAS u32x2*)p1; return (u32x4){lo.x, lo.y, hi.x, hi.y}; }
DI void unpk8(const u32x4 v, float (&o)[8]) { o[0] = bflo(v.x); o[1] = bfhi(v.x); o[2] = bflo(v.y); o[3] = bfhi(v.y); o[4] = bflo(v.z); o[5] = bfhi(v.z); o[6] = bflo(v.w); o[7] = bfhi(v.w); }
DI void ldf8(const float* p, float (&o)[8]) { const f32x4 x = *(const f32x4*)p, y = *(const f32x4*)(p + 4); o[0] = x.x; o[1] = x.y; o[2] = x.z; o[3] = x.w; o[4] = y.x; o[5] = y.y; o[6] = y.z; o[7] = y.w; }
DI u32x4 pack8(const float (&x)[8]) { return (u32x4){pk2(x[0], x[1]), pk2(x[2], x[3]), pk2(x[4], x[5]), pk2(x[6], x[7])}; }
DI void rwkv_chunk_prep(const KArgs& a, LAS unsigned char* lds0, int half, int wv) {
    const int tid = otid(wv), lane = tid & 63, w = tid >> 6;
    const bf16* ZR = (const bf16*)(a.ws + A_ZR); const bf16* WDEC = (const bf16*)(a.ws + A_WDEC); const bf16* AA = (const bf16*)(a.ws + A_AA);
    const int js = tid >> 7, st = (tid >> 3) & 15, oc = tid & 7;
    LAS unsigned char* ldj = lds0 + js * PL_END;
    const float* mu = a.in[I_MU];
    bf16x8 lfrag;
#pragma unroll
    for (int j = 0; j < 8; ++j) lfrag[j] = ((lane & 31) >= 16 || 8 * (lane >> 5) + j <= (lane & 31)) ? (short)0x3F80 : (short)0;
    for (int it = blockIdx.x; it < 96 * CK_HALF / PJ; it += gridDim.x) {
        const int job0 = it * PJ, bh = job0 / CK_HALF, cl0 = job0 % CK_HALF, b = bh / 24, h = bh % 24, col = h * 64 + 8 * oc;
        const int s = (half * CK_HALF + cl0 + js) * 16 + st; const size_t tok = (size_t)b * SEQ + s;
        unsigned char* slot = ck_slot(a.ws, job0 + js);
        const bf16* z = ZR + tok * RW_IN + col;
        const u32x4 zr = *(const u32x4*)z, zk = *(const u32x4*)(z + 1536), zv = *(const u32x4*)(z + 3072);
        u32x4 pr = {0u, 0u, 0u, 0u}, pk_ = {0u, 0u, 0u, 0u}, pv = {0u, 0u, 0u, 0u};
        if (s > 0) { pr = *(const u32x4*)(z - RW_IN); pk_ = *(const u32x4*)(z - RW_IN + 1536); pv = *(const u32x4*)(z - RW_IN + 3072); }
        const u32x4 za = *(const u32x4*)(AA + tok * RWW + col), zw = *(const u32x4*)(WDEC + tok * RWW + col);
        float r[8], km[8], q[8], bb[8], ld[8];
        {   float cz[8], cp[8], m_[8], k_[8], v_[8], as_[8], c1[8], c2[8];
            unpk8(zr, cz); unpk8(pr, cp); ldf8(mu + col, m_);
#pragma unroll
            for (int e = 0; e < 8; ++e) r[e] = cz[e] + (cp[e] - cz[e]) * m_[e];
            unpk8(zk, cz); unpk8(pk_, cp); ldf8(mu + 1536 + col, m_);
#pragma unroll
            for (int e = 0; e < 8; ++e) k_[e] = cz[e] + (cp[e] - cz[e]) * m_[e];
            unpk8(zv, cz); unpk8(pv, cp); ldf8(mu + 3072 + col, m_);
#pragma unroll
            for (int e = 0; e < 8; ++e) v_[e] = cz[e] + (cp[e] - cz[e]) * m_[e];
            unpk8(za, as_); unpk8(zw, ld); ldf8(a.in[I_KK] + col, c1);
            float nn = 0.f;
#pragma unroll
            for (int e = 0; e < 8; ++e) { q[e] = k_[e] * c1[e]; nn += q[e] * q[e]; }
            nn = red8(nn);
            const float invn = fminf(__builtin_amdgcn_rsqf(nn), 1e12f);
            ldf8(a.in[I_KA] + col, c1); ldf8(a.in[I_RK] + col, c2);
            float bs = 0.f;
#pragma unroll
            for (int e = 0; e < 8; ++e) { q[e] *= invn; km[e] = k_[e] * (1.f + (as_[e] - 1.f) * c1[e]); bb[e] = q[e] * as_[e]; bs += r[e] * km[e] * c2[e]; }
            bs = red8(bs);
            if (oc == 0) *(float*)(slot + CK_BS + st * 4) = bs;
#pragma unroll
            for (int e = 0; e < 8; ++e) *(LAS float*)(ldj + PL_LDT + ((8 * oc + e) * 17 + st) * 4) = ld[e];
#pragma unroll
            for (int e = 0; e < 8; e += 2) { const unsigned pv2 = pk2(v_[e], v_[e + 1]);
                *(LAS bf16*)(ldj + PL_VT + (8 * oc + e) * CK_VTS + st * 2) = (bf16)(pv2 & 0xffffu); *(LAS bf16*)(ldj + PL_VT + (8 * oc + e + 1) * CK_VTS + st * 2) = (bf16)(pv2 >> 16); } }
        __syncthreads();
        {
            LAS unsigned char* lds = lds0 + (w >> 1) * PL_END; const int r_ = lane & 31, hh = lane >> 5, ch = 32 * (w & 1) + r_;
            float x[8];
#pragma unroll
            for (int j = 0; j < 8; ++j) x[j] = *(const LAS float*)(lds + PL_LDT + (ch * 17 + 8 * hh + j) * 4);
            const u32x4 ph = {pk2(x[0], x[1]), pk2(x[2], x[3]), pk2(x[4], x[5]), pk2(x[6], x[7])};
            const u32x4 pl = {pk2(x[0] - bflo(ph.x), x[1] - bfhi(ph.x)), pk2(x[2] - bflo(ph.y), x[3] - bfhi(ph.y)), pk2(x[4] - bflo(ph.z), x[5] - bfhi(ph.z)), pk2(x[6] - bflo(ph.w), x[7] - bfhi(ph.w))};
            f32x16 cs; for (int e = 0; e < 16; ++e) cs[e] = 0.f;
            cs = MFMA32(lfrag, __builtin_bit_cast(bf16x8, ph), cs); cs = MFMA32(lfrag, __builtin_bit_cast(bf16x8, pl), cs);
#pragma unroll
            for (int e = 0; e < 8; ++e) *(LAS float*)(lds + PL_C + (((e & 3) + 8 * (e >> 2) + 4 * hh) * 64 + ch) * 4) = cs[e];
            if (hh == 0) *(LAS float*)(lds + PL_T + ch * 4) = cs[8]; }
        __syncthreads();
        {
            float c[8], t[8];
            { const f32x4 ca = *(const LAS f32x4*)(ldj + PL_C + (st * 64 + 8 * oc) * 4), cb = *(const LAS f32x4*)(ldj + PL_C + (st * 64 + 8 * oc + 4) * 4), ta = *(const LAS f32x4*)(ldj + PL_T + 8 * oc * 4), tb = *(const LAS f32x4*)(ldj + PL_T + (8 * oc + 4) * 4);
              c[0] = ca.x; c[1] = ca.y; c[2] = ca.z; c[3] = ca.w; c[4] = cb.x; c[5] = cb.y; c[6] = cb.z; c[7] = cb.w; t[0] = ta.x; t[1] = ta.y; t[2] = ta.z; t[3] = ta.w; t[4] = tb.x; t[5] = tb.y; t[6] = tb.z; t[7] = tb.w; }
            float at[8], bt[8], kt[8], rt[8], bhv[8], khv[8];
#pragma unroll
            for (int e = 0; e < 8; ++e) { const float g = __expf(c[e]), gp = __expf(c[e] - ld[e]), gi = __expf(-c[e]), gr = __expf(t[e] - c[e]);
                at[e] = -q[e] * gp; bt[e] = bb[e] * gi; kt[e] = km[e] * gi; rt[e] = r[e] * g; bhv[e] = bb[e] * gr; khv[e] = km[e] * gr; }
            LAS unsigned char* row = ldj + st * 144 + oc * 16;
            *(LAS u32x4*)(row + PL_AT) = pack8(at); *(LAS u32x4*)(row + PL_BT) = pack8(bt); *(LAS u32x4*)(row + PL_KT) = pack8(kt); *(LAS u32x4*)(row + PL_RT) = pack8(rt);
            *(LAS u32x4*)(row + PL_BH) = pack8(bhv); *(LAS u32x4*)(row + PL_KH) = pack8(khv);
            if (st == 0) { *(f32x4*)(slot + CK_G15 + 8 * oc * 4) = (f32x4){__expf(t[0]), __expf(t[1]), __expf(t[2]), __expf(t[3])}; *(f32x4*)(slot + CK_G15 + (8 * oc + 4) * 4) = (f32x4){__expf(t[4]), __expf(t[5]), __expf(t[6]), __expf(t[7])}; } }
        __syncthreads();
        if (w < PJ) {
            LAS unsigned char* lds = lds0 + w * PL_END; unsigned char* slot = ck_slot(a.ws, job0 + w); const int r = lane & 31, hh = lane >> 5, r16 = r & 15;
            f32x16 d; for (int e = 0; e < 16; ++e) d[e] = 0.f;
#pragma unroll
            for (int ks = 0; ks < 4; ++ks) d = MFMA32(ldfrag(lds + (r < 16 ? PL_BT : PL_KT) + r16 * 144 + ks * 32 + hh * 16), ldfrag(lds + (r < 16 ? PL_AT : PL_RT) + r16 * 144 + ks * 32 + hh * 16), d);
            float lo8[8], hi8[8];
#pragma unroll
            for (int e = 0; e < 8; ++e) { const int sr = (e & 3) + 8 * (e >> 2) + 4 * hh; const bool keep = r < 16 ? sr < r16 : sr <= r16; lo8[e] = keep ? d[e] : 0.f; hi8[e] = keep ? d[8 + e] : 0.f; }
            const u32x4 plo = {pk2(lo8[0], lo8[1]), pk2(lo8[2], lo8[3]), pk2(lo8[4], lo8[5]), pk2(lo8[6], lo8[7])}, phi = {pk2(hi8[0], hi8[1]), pk2(hi8[2], hi8[3]), pk2(hi8[4], hi8[5]), pk2(hi8[6], hi8[7])};
            if (r < 16) {
#pragma unroll
                for (int e = 0; e < 8; ++e) *(LAS float*)(lds + PL_NAB + (((e & 3) + 8 * (e >> 2) + 4 * hh) * 16 + r16) * 4) = lo8[e];
                *(u32x4*)(slot + CK_NK + (r16 + 16 * hh) * 16) = phi; }
            else { *(u32x4*)(slot + CK_PB + (r16 + 16 * hh) * 16) = plo; *(u32x4*)(slot + CK_PK + (r16 + 16 * hh) * 16) = phi; }
            asm volatile("s_waitcnt lgkmcnt(0)" ::: "memory");
            if (lane < 16) { float mr[16]; int ln = lane; asm volatile("" : "+v"(ln));
#pragma unroll
                for (int t = 0; t < 16; ++t) { float acc = (ln == t) ? 1.f : 0.f;
#pragma unroll
                    for (int u = 0; u < t; ++u) acc += mr[u] * *(const LAS float*)(lds + PL_NAB + (u * 16 + t) * 4);
                    mr[t] = acc; *(LAS bf16*)(lds + PL_MTS + t * 48 + lane * 2) = f2bf(acc); } }
            asm volatile("s_waitcnt lgkmcnt(0)" ::: "memory");
            if (r < 16) *(u32x4*)(slot + CK_MT + (r + 16 * hh) * 16) = ld2x8(lds + PL_MTS + r * 48 + 8 * hh, lds + PL_MTS + r * 48 + 16 + 8 * hh);
        } else {
            const int e2 = tid - 256;
#pragma unroll
            for (int q4 = 0; q4 < PJ; ++q4) { const LAS unsigned char* lds = lds0 + q4 * PL_END; unsigned char* slot = ck_slot(a.ws, job0 + q4);
                { const int arr = e2 >> 7, i7 = e2 & 127, ks = i7 >> 5, t = i7 & 15, hh = (i7 >> 4) & 1;
                  const LAS unsigned char* p = lds + (arr ? PL_RT : PL_AT) + t * 144 + (16 * ks + 4 * hh) * 2;
                  *(u32x4*)(slot + (arr ? CK_RT : CK_AT) + (ks * 32 + t + 16 * hh) * 16) = ld2x8(p, p + 16); }
                { const int arr = e2 >> 7, J = (e2 >> 6) & 1;
                  const LAS unsigned char* p = lds + (arr ? PL_KH : PL_BH) + (4 * (lane >> 5) + ((lane >> 2) & 3)) * 144 + (32 * J + 16 * ((lane >> 4) & 1)) * 2 + 8 * (lane & 3);
                  const s16x4 lo = __builtin_amdgcn_ds_read_tr16_b64_v4i16((LAS s16x4*)p), hi = __builtin_amdgcn_ds_read_tr16_b64_v4i16((LAS s16x4*)(p + 8 * 144));
                  *(bf16x8*)(slot + (arr ? CK_KH : CK_BH) + (J * 64 + lane) * 16) = __builtin_shufflevector(lo, hi, 0, 1, 2, 3, 4, 5, 6, 7); }
                if (e2 < 160) *(u32x4*)(slot + CK_VT + e2 * 16) = *(const LAS u32x4*)(lds + PL_VT + e2 * 16); }
        }
    }
    __syncthreads();
}
constexpr int RC_NS = 8, RC_SLOT = 15360, RC_GG = 13312, RC_AHEAD = 6, RC_Y = RC_NS * RC_SLOT;
static_assert(RC_Y + 8192 <= RING_BYTES && CK_SLOT <= RC_GG, "rwkv ring");
template <int PM = 0> DI void rwkv_chunk_rec(const KArgs& a, LAS unsigned char* lds, int unit, int half, int wv) {
    const int tid = otid(wv), lane = tid & 63, w = __builtin_amdgcn_readfirstlane(tid >> 6), r = lane & 31, hh = lane >> 5;
    const int b = unit / 24, h = unit % 24;
    float* GST = (float*)(a.ws + A_GST) + (size_t)unit * 4096;
    const unsigned char* GGb = a.ws + A_GG; bf16* MIX = (bf16*)(a.ws + WS_H);
#define RC_DMA(srcp, dstp) __builtin_amdgcn_global_load_lds((const unsigned*)(srcp), (LAS unsigned*)(dstp), 16, 0, 0)
#define RC_ISSUE(cc) do { if ((PM & 1) == 0 && (w == 4 || w == 5)) { const unsigned char* src = ck_slot(a.ws, unit * CK_HALF + (cc)) + lane * 16; LAS unsigned char* dst = lds + ((cc) % RC_NS) * RC_SLOT; \
        if (w == 4) { _Pragma("unroll") for (int i_ = 0; i_ < 8; ++i_) RC_DMA(src + i_ * 1024, dst + i_ * 1024); } \
        else { _Pragma("unroll") for (int i_ = 8; i_ < 13; ++i_) RC_DMA(src + i_ * 1024, dst + i_ * 1024); \
            const unsigned char* gsrc = GGb + ((size_t)b * SEQ + (half * CK_HALF + (cc)) * 16 + (lane >> 3)) * (RWW * 2) + h * 128 + (lane & 7) * 16; \
            RC_DMA(gsrc, dst + RC_GG); RC_DMA(gsrc + 8 * RWW * 2, dst + RC_GG + 1024); } } } while (0)
#define RC_BAR() do { asm volatile("s_waitcnt lgkmcnt(0)" ::: "memory"); __builtin_amdgcn_s_barrier(); asm volatile("" ::: "memory"); } while (0)
    const bool epi = (w & 2) != 0; const int et = 4 * ((w & 1) + 2 * (w >> 2)) + (lane >> 4), eiq = lane & 15, ecol = h * 64 + 4 * eiq;
    const f32x4 elg = *(const f32x4*)(a.in[I_LNXG] + ecol), elb = *(const f32x4*)(a.in[I_LNXB] + ecol);
#define RC_EPI(sp, Yp, tokv) do { const f32x4 y = *(const LAS f32x4*)((Yp) + et * 64 + 4 * eiq); const u32x2 gq = *(const LAS u32x2*)((sp) + RC_GG + et * 128 + eiq * 8); \
        const float bsv = *(const LAS float*)((sp) + CK_BS + et * 4); const LAS unsigned char* vq = (sp) + CK_VT + 4 * eiq * CK_VTS + et * 2; \
        const f32x4 v4 = {bflo(*(const LAS unsigned short*)vq), bflo(*(const LAS unsigned short*)(vq + CK_VTS)), bflo(*(const LAS unsigned short*)(vq + 2 * CK_VTS)), bflo(*(const LAS unsigned short*)(vq + 3 * CK_VTS))}; \
        const float mean = red16((y.x + y.y) + (y.z + y.w)) * (1.f / 64.f); const f32x4 d = y - mean; \
        const float rstd = __builtin_amdgcn_rsqf(red16((d.x * d.x + d.y * d.y) + (d.z * d.z + d.w * d.w)) * (1.f / 64.f) + 64e-5f); \
        const f32x4 gg4 = {bflo(gq.x), bfhi(gq.x), bflo(gq.y), bfhi(gq.y)}, o = (d * rstd * elg + elb + v4 * bsv) * gg4; \
        if (PM == 0 || o.x == 1.2345f) *(unsigned*)((unsigned char*)MIX + (size_t)(tokv) * 2048 + 512 + ecol) = pk4_fp8(o.x, o.y, o.z, o.w); } while (0)
    f32x16 G0, G1;
#pragma unroll
    for (int e = 0; e < 16; ++e) { G0[e] = 0.f; G1[e] = 0.f; }
    if (half == 1 && w < 2) {
#pragma unroll
        for (int e = 0; e < 16; ++e) { G0[e] = GST[(w * 2 + 0) * 1024 + e * 64 + lane]; G1[e] = GST[(w * 2 + 1) * 1024 + e * 64 + lane]; } }
    __syncthreads();
#pragma unroll
    for (int cc = 0; cc < RC_AHEAD; ++cc) RC_ISSUE(cc);
    asm volatile("s_waitcnt vmcnt(0)" ::: "memory");
    RC_BAR();
    bf16x8 pAR[4], pNP, pVT;
#define RC_PRE(slotp) do { const LAS unsigned char* sp_ = (slotp); _Pragma("unroll") for (int ks = 0; ks < 4; ++ks) pAR[ks] = ldfrag(sp_ + ((r >> 4) ? CK_RT : CK_AT) + (ks * 32 + (r & 15) + 16 * hh) * 16); \
        pNP = ldfrag(sp_ + ((r >> 4) ? CK_PK : CK_NK) + ((r & 15) + 16 * hh) * 16); \
        { const LAS unsigned char* vq_ = sp_ + CK_VT + (32 * w + r) * CK_VTS + 8 * hh; const s16x4 vlo_ = *(const LAS s16x4*)vq_, vhi_ = *(const LAS s16x4*)(vq_ + 16); pVT = __builtin_shufflevector(vlo_, vhi_, 0, 1, 2, 3, 4, 5, 6, 7); } } while (0)
    if (w < 2) RC_PRE(lds);
    for (int c = 0; c < CK_HALF; ++c) {
        if (c + RC_AHEAD < CK_HALF) RC_ISSUE(c + RC_AHEAD);
        const LAS unsigned char* sb = lds + (c % RC_NS) * RC_SLOT;
        if (w < 2) {
            const int r16 = r & 15, up = r >> 4;
            bf16x8 fAR[4], fBH0, fBH1, fKH0, fKH1, fM, fNP, fPB; f32x4 gs0[4], gs1[4];
#pragma unroll
            for (int ks = 0; ks < 4; ++ks) fAR[ks] = pAR[ks];
            fNP = pNP; const bf16x8 vtf = pVT;
            __builtin_amdgcn_sched_barrier(0);
            fM = ldfrag(sb + CK_MT + (r16 + 16 * hh) * 16); fPB = ldfrag(sb + CK_PB + (r16 + 16 * hh) * 16);
            fBH0 = ldfrag(sb + CK_BH + lane * 16); fBH1 = ldfrag(sb + CK_BH + (64 + lane) * 16); fKH0 = ldfrag(sb + CK_KH + lane * 16); fKH1 = ldfrag(sb + CK_KH + (64 + lane) * 16);
#pragma unroll
            for (int g4 = 0; g4 < 4; ++g4) { gs0[g4] = *(const LAS f32x4*)(sb + CK_G15 + (8 * g4 + 4 * hh) * 4); gs1[g4] = *(const LAS f32x4*)(sb + CK_G15 + (32 + 8 * g4 + 4 * hh) * 4); }
            __builtin_amdgcn_sched_barrier(0);
            bf16x8 gf[4];
#pragma unroll
            for (int s2 = 0; s2 < 2; ++s2) { u32x4 p0 = {pk2(G0[8 * s2], G0[8 * s2 + 1]), pk2(G0[8 * s2 + 2], G0[8 * s2 + 3]), pk2(G0[8 * s2 + 4], G0[8 * s2 + 5]), pk2(G0[8 * s2 + 6], G0[8 * s2 + 7])};
                u32x4 p1 = {pk2(G1[8 * s2], G1[8 * s2 + 1]), pk2(G1[8 * s2 + 2], G1[8 * s2 + 3]), pk2(G1[8 * s2 + 4], G1[8 * s2 + 5]), pk2(G1[8 * s2 + 6], G1[8 * s2 + 7])};
                gf[s2] = __builtin_bit_cast(bf16x8, p0); gf[2 + s2] = __builtin_bit_cast(bf16x8, p1); }
            f32x16 XY;
#pragma unroll
            for (int e = 0; e < 16; ++e) XY[e] = 0.f;
#pragma unroll
            for (int ks = 0; ks < 4; ++ks) XY = MFMA32(fAR[ks], gf[ks], XY);
            XY = MFMA32(fNP, vtf, XY);
            { u32x4 px = {pk2(XY[0], XY[1]), pk2(XY[2], XY[3]), pk2(XY[4], XY[5]), pk2(XY[6], XY[7])}; const bf16x8 xf = __builtin_bit_cast(bf16x8, px);
              f32x16 U; for (int e = 0; e < 16; ++e) U[e] = 0.f;
              U = MFMA32(fM, xf, U);
              u32x4 pu = {pk2(U[0], U[1]), pk2(U[2], U[3]), pk2(U[4], U[5]), pk2(U[6], U[7])}; const bf16x8 uf = __builtin_bit_cast(bf16x8, pu);
              XY = MFMA32(fPB, uf, XY);
#pragma unroll
              for (int e = 0; e < 16; ++e) { G0[e] *= gs0[e >> 2][e & 3]; G1[e] *= gs1[e >> 2][e & 3]; }
              G0 = MFMA32(fBH0, uf, G0); G1 = MFMA32(fBH1, uf, G1); G0 = MFMA32(fKH0, vtf, G0); G1 = MFMA32(fKH1, vtf, G1); }
            __builtin_amdgcn_sched_barrier(0);
            if (c + 1 < CK_HALF) RC_PRE(lds + ((c + 1) % RC_NS) * RC_SLOT);
            LAS float* Y = (LAS float*)(lds + RC_Y + (c & 1) * 4096);
#pragma unroll
            for (int e = 0; e < 8; ++e) Y[((e & 3) + 8 * (e >> 2) + 4 * hh) * 64 + 32 * w + r] = XY[8 + e];
        } else if (epi) {
            if (c > 0) RC_EPI(lds + ((c - 1) % RC_NS) * RC_SLOT, (const LAS float*)(lds + RC_Y + ((c - 1) & 1) * 4096), (size_t)b * SEQ + (half * CK_HALF + c - 1) * 16 + et);
        } else {
            if (c + RC_AHEAD >= CK_HALF) asm volatile("s_waitcnt vmcnt(0)" ::: "memory"); else if (w == 4) asm volatile("s_waitcnt vmcnt(32)" ::: "memory"); else asm volatile("s_waitcnt vmcnt(28)" ::: "memory");
        }
        RC_BAR();
    }
    if (epi) RC_EPI(lds + ((CK_HALF - 1) % RC_NS) * RC_SLOT, (const LAS float*)(lds + RC_Y + ((CK_HALF - 1) & 1) * 4096), (size_t)b * SEQ + (half * CK_HALF + CK_HALF - 1) * 16 + et);
    else if (w < 2 && half == 0 && (PM == 0 || G0[0] == 1.2345f)) {
#pragma unroll
        for (int e = 0; e < 16; ++e) { GST[(w * 2 + 0) * 1024 + e * 64 + lane] = G0[e]; GST[(w * 2 + 1) * 1024 + e * 64 + lane] = G1[e]; } }
    asm volatile("s_waitcnt vmcnt(0)" ::: "memory");
    __syncthreads();
#undef RC_PRE
#undef RC_EPI
#undef RC_DMA
#undef RC_ISSUE
#undef RC_BAR
}

constexpr int N_PHASES = 25;
__global__ void __launch_bounds__(512, 2) fwd(KArgs a) {
    extern __shared__ __attribute__((aligned(16))) unsigned char lds_[];
    LAS unsigned char* lds = (LAS unsigned char*)lds_;
    const int wv = __builtin_amdgcn_readfirstlane((int)threadIdx.x >> 6), G = gridDim.x, bid = blockIdx.x;
    volatile LAS unsigned* MISC = (volatile LAS unsigned*)(lds + LDS_MISC);
    if (wv == 0) MISC[lane_id()] = 0u;
    __syncthreads();
    unsigned char* ws0 = a.ws;
#if N_LAUNCH_MODE == 0
    XcdBarrier bar = xcd_barrier_post((unsigned*)(ws0 + CTL_BAR), MISC + 8, wv);
#ifdef DBG_TIME_K1
#define SEAM(k) do { if (IN(k) && IN((k) + 1)) xcd_barrier(bar); if (bid == 0 && wv == 0 && lane_id() == 0) ((unsigned long long*)(ws0 + CTL_CHK))[1 + (k)] = __builtin_amdgcn_s_memrealtime(); } while (0)
#else
#define SEAM(k) do { if (IN(k) && IN((k) + 1)) xcd_barrier(bar); } while (0)
#endif
#else
#define SEAM(k) do { } while (0)
#endif
    const int lo = a.ph_lo, hi = a.ph_hi;
#ifdef DBG_TIME_K1
    if (bid == 0 && wv == 0 && lane_id() == 0) ((unsigned long long*)(ws0 + CTL_CHK))[0] = __builtin_amdgcn_s_memrealtime();
#endif
#ifndef PH_MASK
#define PH_MASK 0xFFFFFFFFu
#endif
#define IN(k) (((PH_MASK >> (k)) & 1u) && lo <= (k) && (k) < hi)
#ifndef REP_REC
#define REP_REC 0
#endif
#ifndef REP_DIL
#define REP_DIL 0
#endif
#ifndef REPEAT_MASK
#define REPEAT_MASK 0u
#endif
#define PH(k) for (int rp_ = 0; rp_ < (IN(k) ? 1 + (int)((REPEAT_MASK >> (k)) & 1u) : 0); ++rp_)
#define MOD ((float*)(ws + CTL_MOD))
#define Hb ((bf16*)(ws + WS_H))
#define X1 ((bf16*)(ws + WS_X1))
#define XPRE ((bf16*)(ws + A_XPRE))
    pg8::StaticOrder SO;

    PH(0) { unsigned char* ws = wsl(a.ws); p0_prologue(a, lds, wv); } SEAM(0);
    PH(1) { unsigned char* ws = wsl(a.ws); modulate_rows(a.in[I_X], (const unsigned long long*)(ws + CTL_MODI), MOD, Hb, wv); } SEAM(1);
    PH(2) { unsigned char* ws = wsl(a.ws); pg8::Gemm g{Hb, (const bf16*)(ws + WS_W_IN0), 2048, 2048, 2048}; SO.init(T, 2048, G, bid);
        EpiIn0 E{(bf16*)(ws + A_QC), (bf16*)(ws + A_KVC), (bf16*)(ws + A_KR), (bf16*)(ws + A_XH), (float*)(ws + CTL_SSQ)};
        pg8::gemm_phase<EpiIn0, pg8::StaticOrder, false, true>(lds, g, SO, E, wv); } SEAM(2);
    PH(3) { unsigned char* ws = wsl(a.ws);
        krope_pass((const bf16*)(ws + A_KR), (const float*)(ws + WS_ROPE), (bf16*)(ws + A_KF), wv);
        { pg8::Gemm g{(const bf16*)(ws + A_QC), (const bf16*)(ws + WS_W_UQ), 512, 512, 512}; SO.init(T, 1536, G, bid);
          EpiQ E{(bf16*)(ws + A_Q), (const float*)(ws + CTL_SSQ), (const float*)(ws + WS_ROPE)}; pg8::gemm_phase<EpiQ, pg8::StaticOrder, false>(lds, g, SO, E, wv); }
        { pg8::Gemm g{(const bf16*)(ws + A_KVC), (const bf16*)(ws + WS_W_UKV), 256, 256, 256}; SO.init(T, 2048, G, bid);
          EpiKV E{(bf16*)(ws + A_KF), (bf16*)(ws + A_V), (const float*)(ws + CTL_SSQ)}; pg8::gemm_phase<EpiKV, pg8::StaticOrder, false>(lds, g, SO, E, wv); }
        { pg8::Gemm g{(const bf16*)(ws + A_XH), (const bf16*)(ws + WS_S5BE), 384, 256, 256}; S5Order S{G, bid}; EpiS5E E{(float*)(ws + A_ES)}; pg8::gemm_phase<EpiS5E, S5Order, false>(lds, g, S, E, wv); }
    } SEAM(3);
    PH(4) { unsigned char* ws = wsl(a.ws);
        s5_carry((const float*)(ws + A_ES), (const float*)(ws + WS_S5L), (bf16*)(ws + A_XH), lds, wv);
        for (int u = bid; u < 256; u += G) mla_attn_unit(lds, (const bf16*)(ws + A_Q), (const bf16*)(ws + A_KF), (const bf16*)(ws + A_V), Hb, u, wv);
    } SEAM(4);
    PH(5) { unsigned char* ws = wsl(a.ws); pg8::Gemm g{(const bf16*)(ws + A_XH), (const bf16*)(ws + WS_S5BY), 384, 384, 384}; S5Order S{G, bid};
        EpiS5Y E{(bf16*)(ws + A_YS5), (const bf16*)(ws + A_XH), a.in[I_S5D]}; pg8::gemm_phase<EpiS5Y, S5Order, false>(lds, g, S, E, wv); } SEAM(5);
    PH(6) { unsigned char* ws = wsl(a.ws); pg8::Gemm g{(const bf16*)(ws + A_YS5), (const bf16*)(ws + WS_W_GLU), 1024, 1024, 1024}; SO.init(T, 1024, G, bid);
        EpiGlu E{Hb, (const bf16*)(ws + A_YS5)}; pg8::gemm_phase<EpiGlu, pg8::StaticOrder, false>(lds, g, SO, E, wv); } SEAM(6);
    PH(7) { unsigned char* ws = wsl(a.ws); pg8::Gemm g{Hb, (const bf16*)(ws + WS_W_OUT0), 2048, 2048, 2048}; SO.init(T, 2048, G, bid);
        EpiRes<false> E{XPRE, a.in[I_X], MOD + 2 * 2048}; pg8::gemm_phase<EpiRes<false>, pg8::StaticOrder, false, true>(lds, g, SO, E, wv); } SEAM(7);
#define MOE_PHASES(layer, pb) \
        PH(pb) { unsigned char* ws = wsl(a.ws); ln_router_phase(a, lds, layer, XPRE, X1, Hb, wv); } SEAM(pb); \
        PH(pb + 1) { unsigned char* ws = wsl(a.ws); moe_table(a, lds, layer, wv); pg8::Gemm g{Hb, (const bf16*)(ws + WS_W_GU8), 2048, 2048, 2048}; \
            MoeOrder<4> S{G, bid, layer, (const LAS int*)(lds + LDS_TAB), (const int*)(ws + A_TOKL)}; EpiGateUp E{ws + A_ACT}; pg8::gemm_phase<EpiGateUp, MoeOrder<4>, true, true>(lds, g, S, E, wv); } SEAM(pb + 1); \
        PH(pb + 2) { unsigned char* ws = wsl(a.ws); moe_table(a, lds, layer, wv); pg8::Gemm g{(const bf16*)(ws + A_ACT), (const bf16*)(ws + WS_W_DN), 512, 512, 512}; \
            MoeOrder<8> S{G, bid, layer, (const LAS int*)(lds + LDS_TAB), (const int*)(ws + A_TOKL)}; EpiDown E{(bf16*)(ws + A_YS)}; pg8::gemm_phase<EpiDown, MoeOrder<8>, false, true>(lds, g, S, E, wv); } SEAM(pb + 2); \
        PH(pb + 3) { unsigned char* ws = wsl(a.ws); ln_ffn_phase(a, layer, X1, a.out, layer == 0 ? Hb : nullptr, wv); } SEAM(pb + 3);
    MOE_PHASES(0, 8)
    PH(12) { unsigned char* ws = wsl(a.ws); pg8::Gemm g{Hb, (const bf16*)(ws + WS_W_IN1), 2048, 2048, 2048}; SO.init(T, 9728, G, bid);
        EpiIn1 E{(bf16*)(ws + A_ZD), (bf16*)(ws + A_ZR)}; pg8::gemm_phase<EpiIn1, pg8::StaticOrder, false, true>(lds, g, SO, E, wv); } SEAM(12);
    PH(13) { unsigned char* ws = wsl(a.ws); rwkv_prep((const bf16*)(ws + A_ZR), a.in[I_MU], (bf16*)(ws + A_LIN), wv); } SEAM(13);
    PH(14) { unsigned char* ws = wsl(a.ws);
        { pg8::Gemm g{(const bf16*)(ws + A_LIN), (const bf16*)(ws + WS_W_LORA), 384, 384, 128}; LoraOrder LO; LO.init(T, 3072, G, bid); LO.ko = 0;
          EpiLora E{(bf16*)(ws + A_WDEC), (bf16*)(ws + A_AA), (bf16*)(ws + A_GG), a.in[I_W0], a.in[I_A0], 0}; pg8::gemm_phase<EpiLora, LoraOrder, false>(lds, g, LO, E, wv); }
        { pg8::Gemm g{(const bf16*)(ws + A_LIN), (const bf16*)(ws + WS_W_LORA) + (size_t)3072 * 384, 384, 384, 256}; LoraOrder LO; LO.init(T, 1536, G, bid); LO.ko = 128;
          EpiLora E{(bf16*)(ws + A_WDEC), (bf16*)(ws + A_AA), (bf16*)(ws + A_GG), a.in[I_W0], a.in[I_A0], 12}; pg8::gemm_phase<EpiLora, LoraOrder, false>(lds, g, LO, E, wv); }
} SEAM(14);
    PH(15) { rwkv_chunk_prep(a, lds, 0, wv); } SEAM(15);
    PH(16) { unsigned char* ws = wsl(a.ws); if (bid < 96 || G <= 96) { for (int u = bid; u < 96; u += G) { rwkv_chunk_rec(a, lds, u, 0, wv); if (REP_REC) rwkv_chunk_rec<REP_REC>(a, lds, u, 0, wv); } }
        if (G <= 96 || bid >= 96) { const int nb_ = G <= 96 ? G : G - 96, b0_ = G <= 96 ? bid : bid - 96;
            DilPre P; if (b0_ < 768) dil_issue((const bf16*)(ws + A_ZD), (const float*)(ws + WS_BIAS), b0_, wv, P);
            for (int u = b0_; u < 768; u += nb_) dil_attn_unit(lds, (const bf16*)(ws + A_ZD), (const float*)(ws + WS_BIAS), (bf16*)(ws + A_DPO), (float*)(ws + A_DPM), (float*)(ws + A_DPL), u, u + nb_ < 768 ? u + nb_ : -1, P, wv); } } SEAM(16);
    PH(17) { rwkv_chunk_prep(a, lds, 1, wv); } SEAM(17);
    PH(18) { unsigned char* ws = wsl(a.ws); if (bid < 96 || G <= 96) { for (int u = bid; u < 96; u += G) { rwkv_chunk_rec(a, lds, u, 1, wv); if (REP_REC) rwkv_chunk_rec<REP_REC>(a, lds, u, 1, wv); } }
        if (G <= 96 || bid >= 96) { const int nb_ = G <= 96 ? G : G - 96, b0_ = G <= 96 ? bid : bid - 96;
            DilPre P; if (768 + b0_ < 1536) dil_issue((const bf16*)(ws + A_ZD), (const float*)(ws + WS_BIAS), 768 + b0_, wv, P);
            for (int u = 768 + b0_; u < 1536; u += nb_) dil_attn_unit(lds, (const bf16*)(ws + A_ZD), (const float*)(ws + WS_BIAS), (bf16*)(ws + A_DPO), (float*)(ws + A_DPM), (float*)(ws + A_DPL), u, u + nb_ < 1536 ? u + nb_ : -1, P, wv); } } SEAM(18);
    PH(19) { unsigned char* ws = wsl(a.ws); dil_merge((const bf16*)(ws + A_DPO), (const float*)(ws + A_DPM), (const float*)(ws + A_DPL), Hb, wv); } SEAM(19);
    PH(20) { unsigned char* ws = wsl(a.ws); pg8::Gemm g{Hb, (const bf16*)(ws + WS_W_OUT1), 2048, 2048, 2048}; SO.init(T, 2048, G, bid);
        EpiRes<true> E{XPRE, a.out, MOD + 4 * 12288 + 2 * 2048}; pg8::gemm_phase<EpiRes<true>, pg8::StaticOrder, false, true>(lds, g, SO, E, wv); } SEAM(20);
    MOE_PHASES(1, 21)
#undef MOE_PHASES
#ifdef DBG_TIME_K1
    {
        xcd_barrier(bar);
        const unsigned long long* ts = (const unsigned long long*)(ws0 + CTL_CHK);
        const unsigned long long t0 = ts[0], te = __builtin_amdgcn_s_memrealtime();
        const float tot = (float)(te - t0), f1 = (float)(ts[1 + DBG_TIME_K1] - t0) / tot, f2 = (float)(ts[1 + DBG_TIME_K2] - t0) / tot;
        const float c1 = sqrtf(100.f * f1);
        for (size_t i = (size_t)bid * 512 + wv * 64 + lane_id(); i < (size_t)T * D; i += (size_t)G * 512) a.out[i] = c1;
        xcd_barrier(bar);
        if (bid == 0 && wv == 0 && lane_id() == 0) a.out[0] = 100.f * f2;
    }
#endif
#undef IN
#undef SEAM
#undef MOD
#undef Hb
#undef X1
#undef XPRE
}


#ifdef DBG_DUMP_OFF
__global__ void dbg_dump(const unsigned char* ws, float* out) {
    const size_t n = (size_t)T * D;
    for (size_t i = (size_t)blockIdx.x * 256 + threadIdx.x; i < n; i += (size_t)gridDim.x * 256) {
#if defined(DBG_DUMP_RT)
        { const int m = (int)(i >> 11), c = (int)(i & 2047); const int* RTE = (const int*)(ws + A_RT); const float* RTW = (const float*)(RTE + 4 * T); out[i] = c < 2 ? (float)RTE[2 * m + c] : (c < 4 ? RTW[2 * m + c - 2] : 0.f); }
#elif DBG_DUMP_F32
        out[i] = ((const float*)(ws + DBG_DUMP_OFF))[i];
#else
        out[i] = bf2f(((const bf16*)(ws + DBG_DUMP_OFF))[i]);
#endif
    }
}
#endif
extern "C" void kernel_launch(void* const* d_in, const int* in_sizes, int n_in, void* d_out, int out_size, void* d_ws, size_t ws_size, hipStream_t stream) {
    static int grid = 0;
    if (grid == 0) {
        if (n_in != 41 || out_size != T * D || ws_size < WS_END) { fprintf(stderr, "kernel_launch: unexpected shapes: n_in %d out %d ws %zu (need %zu)\n", n_in, out_size, ws_size, (size_t)WS_END); grid = -1; return; }
        int dev = 0, cus = 0, per_cu = 0;
        if (hipGetDevice(&dev) != hipSuccess || hipDeviceGetAttribute(&cus, hipDeviceAttributeMultiprocessorCount, dev) != hipSuccess) { grid = -1; return; }
        if (hipFuncSetAttribute((const void*)fwd, hipFuncAttributeMaxDynamicSharedMemorySize, LDS_BYTES) != hipSuccess) { fprintf(stderr, "kernel_launch: hipFuncSetAttribute failed\n"); grid = -1; return; }
        if (hipOccupancyMaxActiveBlocksPerMultiprocessor(&per_cu, (const void*)fwd, 512, LDS_BYTES) != hipSuccess || per_cu < 1) fprintf(stderr, "kernel_launch: occupancy query says %d blocks/CU\n", per_cu);
        (void)hipGetLastError();
        grid = cus;
    }
    if (grid < 0) return;
    (void)hipMemsetAsync(d_ws, 0, CTL_ZERO_BYTES, stream);
#ifdef DBG_ZERO_WS
    (void)hipMemsetAsync((char*)d_ws + CTL_ZERO_BYTES, 0, WS_END - CTL_ZERO_BYTES, stream);
#endif
    KArgs a{};
    for (int i = 0; i < 41; ++i) a.in[i] = (const float*)d_in[i];
    a.out = (float*)d_out; a.ws = (unsigned char*)d_ws;
#if N_LAUNCH_MODE == 0
    a.ph_lo = 0; a.ph_hi = N_PHASES;
    hipLaunchKernelGGL(fwd, dim3(grid), dim3(512), LDS_BYTES, stream, a);
#else
#ifdef DBG_DUMP_AFTER
    for (int p = 0; p <= DBG_DUMP_AFTER; ++p) { a.ph_lo = p; a.ph_hi = p + 1; hipLaunchKernelGGL(fwd, dim3(grid), dim3(512), LDS_BYTES, stream, a); }
#ifdef DBG_DUMP_OFF
    hipLaunchKernelGGL(dbg_dump, dim3(2048), dim3(256), 0, stream, (const unsigned char*)d_ws, (float*)d_out);
#endif
#else
    for (int p = 0; p < N_PHASES; ++p) { a.ph_lo = p; a.ph_hi = p + 1; hipLaunchKernelGGL(fwd, dim3(grid), dim3(512), LDS_BYTES, stream, a); }
#endif
#endif
}
```

```cpp
#include <hip/hip_runtime.h>
#include <cstdio>
#include <cstdint>

#ifndef N_LAUNCH_MODE
#define N_LAUNCH_MODE 0
#endif
#ifndef CHK
#define CHK 0
#endif

#define GAS __attribute__((address_space(1)))
#define LAS __attribute__((address_space(3)))
typedef unsigned short bf16;
typedef short bf16x8 __attribute__((ext_vector_type(8)));
typedef short s16x4 __attribute__((ext_vector_type(4)));
typedef float f32x4 __attribute__((ext_vector_type(4)));
typedef float f32x16 __attribute__((ext_vector_type(16)));
typedef float f32x2 __attribute__((ext_vector_type(2)));
typedef unsigned u32x4 __attribute__((ext_vector_type(4)));
typedef unsigned u32x2 __attribute__((ext_vector_type(2)));
#define DI __device__ __forceinline__

constexpr int D = 2048, NB = 4, SEQ = 4096, T = NB * SEQ;
constexpr float LN_EPS = 1e-5f, RMS_EPS = 1e-6f;
constexpr float DN_ALPHA = 1.41421356237f;
constexpr int EVEN_IN = 1856, ODD_IN = 9568, DIL_IN = 4608, RW_IN = 4960, RWW = 1536;
constexpr int NEXP = 16, DEXP = 512;

typedef __bf16 bf16x2_t __attribute__((ext_vector_type(2)));
DI unsigned pk2(float lo, float hi) { f32x2 v = {lo, hi}; bf16x2_t r = __builtin_convertvector(v, bf16x2_t); return __builtin_bit_cast(unsigned, r); }
DI float bf2f(bf16 b) { return __uint_as_float(((unsigned)b) << 16); }
DI float bflo(unsigned u) { return __uint_as_float(u << 16); }
DI float bfhi(unsigned u) { return __uint_as_float(u & 0xffff0000u); }
DI bf16 f2bf(float f) { unsigned u = __float_as_uint(f); u += 0x7fffu + ((u >> 16) & 1u); return (bf16)(u >> 16); }
DI float wave_sum_bp(float v) {
#pragma unroll
    for (int o = 1; o < 64; o <<= 1) v += __shfl_xor(v, o);
    return v;
}
DI unsigned char* wsl(unsigned char* p) { asm volatile("" : "+s"(p)); return p; }
DI int lane_id() { return (int)__builtin_amdgcn_mbcnt_hi(~0u, __builtin_amdgcn_mbcnt_lo(~0u, 0u)); }
DI int otid(int wv) { int t = wv * 64 + lane_id(); asm volatile("" : "+v"(t)); return t; }
DI float dpp_xor1(float x) { return __builtin_bit_cast(float, __builtin_amdgcn_mov_dpp(__builtin_bit_cast(int, x), 0xB1, 0xF, 0xF, true)); }
DI float dpp_xor2(float x) { return __builtin_bit_cast(float, __builtin_amdgcn_mov_dpp(__builtin_bit_cast(int, x), 0x4E, 0xF, 0xF, true)); }
DI float dpp_hmir(float x) { return __builtin_bit_cast(float, __builtin_amdgcn_mov_dpp(__builtin_bit_cast(int, x), 0x141, 0xF, 0xF, true)); }
template <int N> DI float dpp_ror(float x) { return __builtin_bit_cast(float, __builtin_amdgcn_mov_dpp(__builtin_bit_cast(int, x), 0x120 + N, 0xF, 0xF, true)); }
DI float dpp_rmir(float x) { return __builtin_bit_cast(float, __builtin_amdgcn_mov_dpp(__builtin_bit_cast(int, x), 0x140, 0xF, 0xF, true)); }
DI float red8(float x) { x += dpp_xor1(x); x += dpp_xor2(x); x += dpp_hmir(x); return x; }
DI float red16(float x) { x += dpp_xor1(x); x += dpp_xor2(x); x += dpp_hmir(x); x += dpp_rmir(x); return x; }
DI float wave_sum(float v) { float x = red16(v);
    { const auto rr = __builtin_amdgcn_permlane16_swap(__float_as_uint(x), __float_as_uint(x), false, false); x = __uint_as_float(rr[0]) + __uint_as_float(rr[1]); }
    { const auto rr = __builtin_amdgcn_permlane32_swap(__float_as_uint(x), __float_as_uint(x), false, false); x = __uint_as_float(rr[0]) + __uint_as_float(rr[1]); }
    return x; }
DI float sat448(float x) { return __builtin_amdgcn_fmed3f(x, -448.f, 448.f); }
DI unsigned pk4_fp8(float a, float b, float c, float d) { int w = 0; w = __builtin_amdgcn_cvt_pk_fp8_f32(sat448(a), sat448(b), w, false); w = __builtin_amdgcn_cvt_pk_fp8_f32(sat448(c), sat448(d), w, true); return (unsigned)w; }
constexpr float F8_WSCALE = 32.f;
DI float sigmoidf_(float x) { return __builtin_amdgcn_rcpf(1.f + __expf(-x)); }

namespace pg8 {
constexpr int BM = 256, BK = 64, HALF = 128, HTB = HALF * BK * 2, STAGE_BYTES = 8 * HTB, NXCD = 8, WGM = 8;
__host__ __device__ __forceinline__ int lds_byte(int r, int c) { const int st = (r >> 4) * 2 + (c >> 5), rr = r & 15, cc = c & 31, ob = rr * 64 + cc * 2; return st * 1024 + (ob ^ (((ob >> 9) & 1) << 5)); }
__host__ __device__ __forceinline__ void stage_rc(int b, int& R, int& C) { const int st = b / 1024, sb = b % 1024, swz = sb ^ (((sb >> 9) & 1) << 5); R = (st >> 1) * 16 + swz / 64; C = (st & 1) * 32 + (swz % 64) / 2; }
__host__ __device__ __forceinline__ int perm32(int rho) { const int n = rho >> 4, i = rho & 15; return 8 * (i >> 2) + 4 * n + (i & 3); }

struct Unit { int pm, pn, aux; };
struct Gemm { const bf16* A; const bf16* Bt; int lda, ldb, K; };

struct StaticOrder {
    int nM, nN, nwg, G, c;
    __host__ __device__ void init(int M, int N, int G_, int c_) { nM = M / BM; nN = N / BM; nwg = nM * nN; G = G_; c = c_; }
    __host__ __device__ bool next(int i, Unit& u) const {
        const long L = (long)i * G + c; if (L >= nwg) return false;
        int wgid = (int)L; { const int q = nwg / NXCD, r = nwg % NXCD, xcd = wgid % NXCD, off = wgid / NXCD; wgid = (xcd < r ? xcd * (q + 1) : r * (q + 1) + (xcd - r) * q) + off; }
        const int nig = WGM * nN, gid = wgid / nig, fm = gid * WGM, gsz = (nM - fm) < WGM ? (nM - fm) : WGM;
        u.pm = fm + ((wgid % nig) % gsz); u.pn = (wgid % nig) / gsz; u.aux = 0; return true;
    }
    __device__ __forceinline__ int arow(const Unit&, int) const { return 0; }
    __device__ __forceinline__ int koff(const Unit&) const { return 0; }
};

typedef int v8i __attribute__((ext_vector_type(8)));
template <class Epi, class Sched, bool GATHER, bool F8 = false>
__device__ __forceinline__ void gemm_phase(LAS unsigned char* lds, const Gemm g, const Sched& S, const Epi& E, int wv) {
    const int tid = otid(wv), wid = __builtin_amdgcn_readfirstlane(tid >> 6), lane = tid & 63, wr = wid >> 2, wc = wid & 3, fr = lane & 15, fq = lane >> 4;
    int K = g.K; asm volatile("" : "+s"(K));
    constexpr int ES = F8 ? 1 : 2;
    const int nt = K / (F8 ? 2 * BK : BK);
    unsigned voffB[2], vA0[2], vA1[2], nA0[2], nA1[2]; int Rr[2], Cc[2];
#pragma unroll
    for (int i = 0; i < 2; ++i) { int R, C; stage_rc(tid * 16 + i * 8192, R, C); const int Rb = Epi::PERM ? ((R & ~31) + perm32(R & 31)) : R;
        Rr[i] = R; Cc[i] = C; voffB[i] = (unsigned)(Rb * g.ldb * ES + C * 2);
        vA0[i] = (unsigned)(R * g.lda * ES + C * 2); vA1[i] = (unsigned)((R + HALF) * g.lda * ES + C * 2); nA0[i] = vA0[i]; nA1[i] = vA1[i]; }
    const size_t kstep = (size_t)(BK * 2);
    const size_t hstepB = (size_t)HALF * g.ldb * ES, tstepB = 2 * hstepB, tstepA = (size_t)BM * g.lda * ES, hstepA = (size_t)HALF * g.lda * ES, rbA = (size_t)g.lda * ES, rbB = (size_t)g.ldb * ES;
    const unsigned ldsw = (unsigned)wid * 1024u;
    const int aoff = lds_byte(wr * 64 + fr, F8 ? fq * 16 : fq * 8), boff = lds_byte(wc * 32 + fr, F8 ? fq * 16 : fq * 8);
#define PG8_SA(b, h) (((b) * 2 + (h)) * HTB)
#define PG8_SB(b, h) ((4 + (b) * 2 + (h)) * HTB)
#define PG8_STAGE(bufoff, gbase, voff) do { _Pragma("unroll") for (int _i = 0; _i < 2; ++_i) \
        __builtin_amdgcn_global_load_lds((const unsigned*)((const char*)(gbase) + (voff)[_i]), (LAS unsigned*)(lds + (bufoff) + ldsw + _i * 8192), 16, 0, 0); } while (0)
#define PG8_STAGE1(bufoff, gbase, voff0, rowbytes) do { __builtin_amdgcn_global_load_lds((const unsigned*)((const char*)(gbase) + (voff0)), (LAS unsigned*)(lds + (bufoff) + ldsw), 16, 0, 0); \
        __builtin_amdgcn_global_load_lds((const unsigned*)((const char*)(gbase) + (size_t)64 * (rowbytes) + (voff0)), (LAS unsigned*)(lds + (bufoff) + ldsw + 8192), 16, 0, 0); } while (0)
#define PG8_STAGEA(bufoff, gbase, half, arr) do { if constexpr (GATHER) PG8_STAGE(bufoff, gbase, arr); else PG8_STAGE1(bufoff, (const char*)(gbase) + (half) * hstepA, vA0[0], rbA); } while (0)
#define PG8_LD32(p) __builtin_bit_cast(v8i, __builtin_shufflevector(*(const LAS u32x4*)(p), *(const LAS u32x4*)((p) + 16), 0, 1, 2, 3, 4, 5, 6, 7))
#define PG8_LDA(dst, b, h) do { if constexpr (F8) { _Pragma("unroll") for (int m = 0; m < 4; ++m) dst##8[m] = PG8_LD32(lds + PG8_SA(b, h) + aoff + m * 2048); } \
        else { _Pragma("unroll") for (int m = 0; m < 4; ++m) _Pragma("unroll") for (int k = 0; k < 2; ++k) dst[m][k] = *(const LAS bf16x8*)(lds + PG8_SA(b, h) + aoff + m * 2048 + k * 1024); } } while (0)
#define PG8_LDB(dst, b, h) do { if constexpr (F8) { _Pragma("unroll") for (int n = 0; n < 2; ++n) dst##8[n] = PG8_LD32(lds + PG8_SB(b, h) + boff + n * 2048); } \
        else { _Pragma("unroll") for (int n = 0; n < 2; ++n) _Pragma("unroll") for (int k = 0; k < 2; ++k) dst[n][k] = *(const LAS bf16x8*)(lds + PG8_SB(b, h) + boff + n * 2048 + k * 1024); } } while (0)
#define PG8_MMA(ai, bj, At, Bt) do { __builtin_amdgcn_s_setprio(1); if constexpr (F8) { _Pragma("unroll") for (int m = 0; m < 4; ++m) _Pragma("unroll") for (int n = 0; n < 2; ++n) \
            asm volatile("v_mfma_scale_f32_16x16x128_f8f6f4 %0, %1, %2, %0, %3, %4 op_sel_hi:[0,0,0]" : "+v"(acc[ai][bj][m][n]) : "v"(Bt##8[n]), "v"(At##8[m]), "v"(sc_w), "v"(sc_x)); }     \
        else { _Pragma("unroll") for (int m = 0; m < 4; ++m) _Pragma("unroll") for (int n = 0; n < 2; ++n) _Pragma("unroll") for (int k = 0; k < 2; ++k) \
            acc[ai][bj][m][n] = __builtin_amdgcn_mfma_f32_16x16x32_bf16(Bt[n][k], At[m][k], acc[ai][bj][m][n], 0, 0, 0); } __builtin_amdgcn_s_setprio(0); } while (0)
#define PG8_WAIT_V(n) asm volatile("s_waitcnt vmcnt(" #n ")" ::: "memory")
#define PG8_WAIT_L(n) asm volatile("s_waitcnt lgkmcnt(" #n ")" ::: "memory")
#define PG8_BAR __builtin_amdgcn_s_barrier()
#define PG8_SCHED __builtin_amdgcn_sched_barrier(0)
    Unit cur, nxt; int ui = 0;
    if (!S.next(0, cur)) return;
    f32x4 acc[2][2][4][2];
#pragma unroll
    for (int a = 0; a < 2; ++a)
#pragma unroll
        for (int b = 0; b < 2; ++b)
#pragma unroll
            for (int m = 0; m < 4; ++m)
#pragma unroll
                for (int n = 0; n < 2; ++n) acc[a][b][m][n] = (f32x4){0.f, 0.f, 0.f, 0.f};
    int sc_w = 122, sc_x = 127; if constexpr (F8) asm volatile("" : "+v"(sc_w), "+v"(sc_x));
    bf16x8 At[4][2], B0[2][2], B1[2][2]; v8i At8[4], B08[2], B18[2];
    const char* cA = (GATHER ? (const char*)g.A : (const char*)g.A + (size_t)cur.pm * tstepA) + ES * S.koff(cur);
    const char* cB = (const char*)g.Bt + (size_t)cur.pn * tstepB + ES * S.koff(cur);
    if (GATHER) {
#pragma unroll
        for (int i = 0; i < 2; ++i) { vA0[i] = (unsigned)(S.arow(cur, Rr[i]) * g.lda * ES + Cc[i] * 2); vA1[i] = (unsigned)(S.arow(cur, Rr[i] + HALF) * g.lda * ES + Cc[i] * 2); nA0[i] = vA0[i]; nA1[i] = vA1[i]; } }
    PG8_STAGE1(PG8_SB(0, 0), cB, voffB[0], rbB); PG8_STAGEA(PG8_SA(0, 0), cA, 0, vA0); PG8_STAGE1(PG8_SB(0, 1), cB + hstepB, voffB[0], rbB); PG8_STAGEA(PG8_SA(0, 1), cA, 1, vA1);
    if (wr == 1) PG8_BAR;
    PG8_WAIT_V(4); PG8_BAR;
    PG8_STAGE1(PG8_SB(1, 0), cB + kstep, voffB[0], rbB); PG8_STAGEA(PG8_SA(1, 0), cA + kstep, 0, vA0); PG8_STAGE1(PG8_SB(1, 1), cB + hstepB + kstep, voffB[0], rbB);
    PG8_WAIT_V(6); PG8_BAR;
    for (;;) {
        const bool has_next = S.next(ui + 1, nxt);
        const char* nAp = GATHER ? cA : (has_next ? (const char*)g.A + (size_t)nxt.pm * tstepA + ES * S.koff(nxt) : cA);
        const char* nB = has_next ? (const char*)g.Bt + (size_t)nxt.pn * tstepB + ES * S.koff(nxt) : cB;
        if (GATHER) {
#pragma unroll
            for (int i = 0; i < 2; ++i) { nA0[i] = vA0[i]; nA1[i] = vA1[i]; } }
        for (int t = 0; t < nt; t += 2) {
            const bool last = (t == nt - 2);
            if (GATHER && has_next && t == (nt >= 4 ? nt - 4 : 0)) {
#pragma unroll
                for (int i = 0; i < 2; ++i) { nA0[i] = (unsigned)(S.arow(nxt, Rr[i]) * g.lda * ES + Cc[i] * 2); nA1[i] = (unsigned)(S.arow(nxt, Rr[i] + HALF) * g.lda * ES + Cc[i] * 2); } }
            const char* a1 = cA + (size_t)(t + 1) * kstep;
            const char* a2 = last ? nAp : cA + (size_t)(t + 2) * kstep; const char* b2 = last ? nB : cB + (size_t)(t + 2) * kstep;
            const char* a3 = a2 + kstep; const char* b3 = b2 + kstep;
            unsigned w0[2], w1[2];
#pragma unroll
            for (int i = 0; i < 2; ++i) { w0[i] = (GATHER && last) ? nA0[i] : vA0[i]; w1[i] = (GATHER && last) ? nA1[i] : vA1[i]; }
            PG8_LDB(B0, 0, 0); PG8_SCHED; PG8_LDA(At, 0, 0); PG8_STAGEA(PG8_SA(1, 1), a1, 1, vA1);
            PG8_WAIT_L(8); PG8_BAR; PG8_WAIT_L(0); PG8_MMA(0, 0, At, B0); PG8_BAR; PG8_SCHED;
            PG8_LDB(B1, 0, 1); PG8_STAGE1(PG8_SB(0, 0), b2, voffB[0], rbB);
            PG8_BAR; PG8_WAIT_L(0); PG8_MMA(0, 1, At, B1); PG8_BAR;
            PG8_LDA(At, 0, 1); PG8_STAGEA(PG8_SA(0, 0), a2, 0, w0);
            PG8_BAR; PG8_WAIT_L(0); PG8_MMA(1, 0, At, B0); PG8_BAR; PG8_SCHED;
            PG8_STAGE1(PG8_SB(0, 1), b2 + hstepB, voffB[0], rbB);
            PG8_WAIT_V(6); PG8_BAR; PG8_MMA(1, 1, At, B1); PG8_BAR;
            PG8_LDB(B0, 1, 0); PG8_SCHED; PG8_LDA(At, 1, 0); PG8_STAGEA(PG8_SA(0, 1), a2, 1, w1);
            PG8_WAIT_L(8); PG8_BAR; PG8_WAIT_L(0); PG8_MMA(0, 0, At, B0); PG8_BAR; PG8_SCHED;
            PG8_LDB(B1, 1, 1); PG8_STAGE1(PG8_SB(1, 0), b3, voffB[0], rbB);
            PG8_BAR; PG8_WAIT_L(0); PG8_MMA(0, 1, At, B1); PG8_BAR;
            PG8_LDA(At, 1, 1); PG8_STAGEA(PG8_SA(1, 0), a3, 0, w0);
            PG8_BAR; PG8_WAIT_L(0); PG8_MMA(1, 0, At, B0); PG8_BAR; PG8_SCHED;
            PG8_STAGE1(PG8_SB(1, 1), b3 + hstepB, voffB[0], rbB);
            PG8_WAIT_V(6); PG8_BAR; PG8_MMA(1, 1, At, B1); PG8_BAR;
        }
        if constexpr (F8) asm volatile("s_nop 15\n\ts_nop 15\n\ts_nop 15\n\ts_nop 15" ::: "memory");
        { int frr = fr, fqq = fq; asm volatile("" : "+v"(frr), "+v"(fqq));
          E(acc, cur, wr, wc, frr, fqq); }
        if (!has_next) break;
#pragma unroll
        for (int a = 0; a < 2; ++a)
#pragma unroll
            for (int b = 0; b < 2; ++b)
#pragma unroll
                for (int m = 0; m < 4; ++m)
#pragma unroll
                    for (int n = 0; n < 2; ++n) acc[a][b][m][n] = (f32x4){0.f, 0.f, 0.f, 0.f};
        cur = nxt; cA = nAp; cB = nB; ++ui;
        if (GATHER) {
#pragma unroll
            for (int i = 0; i < 2; ++i) { vA0[i] = nA0[i]; vA1[i] = nA1[i]; } }
    }
    PG8_WAIT_V(0);
    if (wr == 0) PG8_BAR;
    PG8_BAR;
#undef PG8_SA
#undef PG8_SB
#undef PG8_STAGE
#undef PG8_STAGE1
#undef PG8_STAGEA
#undef PG8_LDA
#undef PG8_LDB
#undef PG8_MMA
#undef PG8_LD32
#undef PG8_WAIT_V
#undef PG8_WAIT_L
#undef PG8_BAR
#undef PG8_SCHED
}
}

#define XB_TMO      128
#define XB_XCNT(j)  (256  + 64 * (j))
#define XB_XSUB(j)  (1280 + 64 * (j))
#define XB_XGEN(j)  (2304 + 64 * (j))
#define XB_TOP      3328
#define XB_TOPGEN   3392
#define XCD_BAR_WORDS 3456
#define XB_SPIN_CAP (1u << 18)
__device__ __forceinline__ unsigned xb_ld(unsigned* p)              { return __hip_atomic_load(p, __ATOMIC_RELAXED, __HIP_MEMORY_SCOPE_AGENT); }
__device__ __forceinline__ unsigned xb_add(unsigned* p, unsigned v) { return __hip_atomic_fetch_add(p, v, __ATOMIC_RELAXED, __HIP_MEMORY_SCOPE_AGENT); }
__device__ __forceinline__ unsigned xb_xcc_id() { return (unsigned)__builtin_amdgcn_s_getreg((3 << 11) | 20) & 0xFu; }
#define XB_SPIN(cond, bar) do { unsigned _sp = 0; while (cond) { __builtin_amdgcn_s_sleep(1); \
    if ((++_sp & 255u) == 0u) { if (xb_ld(&(bar)[XB_TMO])) break; if (_sp > XB_SPIN_CAP) { atomicAdd(&(bar)[XB_TMO], 1u); break; } } } } while (0)
struct XcdBarrier { unsigned* bar; unsigned x; volatile LAS unsigned* st; int wv; };
__device__ __forceinline__ XcdBarrier xcd_barrier_post(unsigned* bar, volatile LAS unsigned* st, int wv) {
    XcdBarrier b; b.bar = bar; b.x = xb_xcc_id(); b.st = st; b.wv = wv;
    if (wv == 0 && lane_id() == 0) (void)xb_add(&bar[XB_XCNT(b.x)], 1u);
    return b;
}
__device__ __forceinline__ void xcd_barrier_complete(unsigned* bar, unsigned x, unsigned& nloc, unsigned& nx) {
    const unsigned G = gridDim.x * gridDim.y * gridDim.z;
    unsigned sum, cnt, mine, sp = 0u;
    for (;;) {
        sum = 0u; cnt = 0u; mine = 0u;
#pragma unroll
        for (unsigned j = 0; j < 16; ++j) { const unsigned c = xb_ld(&bar[XB_XCNT(j)]); sum += c; cnt += (c > 0u) ? 1u : 0u; mine = (j == x) ? c : mine; }
        if (sum == G) break;
        __builtin_amdgcn_s_sleep(1);
        if ((++sp & 255u) == 0u) { if (xb_ld(&bar[XB_TMO])) break; if (sp > XB_SPIN_CAP) { atomicAdd(&bar[XB_TMO], 1u); break; } }
    }
    nloc = mine > 0u ? mine : 1u; nx = cnt > 0u ? cnt : 1u;
}
__device__ __forceinline__ void xcd_barrier(const XcdBarrier& b) {
    asm volatile("s_waitcnt vmcnt(0)" ::: "memory");
    __syncthreads();
    if (b.wv == 0 && lane_id() == 0) {
        unsigned* bar = b.bar;
        __builtin_amdgcn_s_waitcnt(0);
        unsigned nloc = b.st[0], nx = b.st[1];
        if (nloc == 0u) { xcd_barrier_complete(bar, b.x, nloc, nx); b.st[0] = nloc; b.st[1] = nx; }
        const unsigned old = xb_add(&bar[XB_XSUB(b.x)], 1u);
        const unsigned gen = old / nloc;
        if (old + 1u == (gen + 1u) * nloc) {
            __builtin_amdgcn_fence(__ATOMIC_RELEASE, "agent");
            asm volatile("s_waitcnt vmcnt(0)" ::: "memory");
            const unsigned og = xb_add(&bar[XB_TOP], 1u);
            const unsigned tg = og / nx;
            if (og + 1u == (tg + 1u) * nx) xb_add(&bar[XB_TOPGEN], 1u);
            else XB_SPIN(xb_ld(&bar[XB_TOPGEN]) == tg, bar);
            __builtin_amdgcn_fence(__ATOMIC_ACQUIRE, "agent");
            xb_add(&bar[XB_XGEN(b.x)], 1u);
            asm volatile("s_waitcnt vmcnt(0)" ::: "memory");
        } else {
            XB_SPIN(xb_ld(&bar[XB_XGEN(b.x)]) == gen, bar);
            __builtin_amdgcn_fence(__ATOMIC_ACQUIRE, "agent");
            asm volatile("s_waitcnt vmcnt(0)" ::: "memory");
        }
    }
    __syncthreads();
}

constexpr size_t MiB = 1u << 20;
constexpr size_t CTL_BAR = 0, CTL_MODI = 16384  , CTL_MOD = CTL_MODI + 2 * 4 * 12288 * 8  , CTL_SSQ = CTL_MOD + 2 * 4 * 12288 * 4  ,
                 CTL_CNT = CTL_SSQ + (size_t)T * 12 * 4  , CTL_CHK = CTL_CNT + 2 * 16 * 256, CTL_ZERO_BYTES = 2 * MiB;
static_assert(CTL_CHK % 8 == 0 && CTL_CHK + 1024 <= CTL_ZERO_BYTES, "ctl");
constexpr size_t WS_W_IN0 = 2 * MiB, WS_W_UQ = WS_W_IN0 + 8 * MiB, WS_W_UKV = WS_W_UQ + 1536 * 512 * 2, WS_W_GLU = WS_W_UKV + 2048 * 256 * 2, WS_W_OUT0 = WS_W_GLU + 2 * MiB,
                 WS_W_IN1 = WS_W_OUT0 + 8 * MiB, WS_W_OUT1 = WS_W_IN1 + (size_t)9728 * 2048 * 2, WS_W_GU = WS_W_OUT1 + 8 * MiB, WS_W_DN = WS_W_GU + 128 * MiB,
                 WS_W_LORA = WS_W_DN + 64 * MiB, WS_S5BY = WS_W_LORA + (size_t)4608 * 384 * 2, WS_S5BE = WS_S5BY + (size_t)64 * 256 * 384 * 2, WS_ROPE = WS_S5BE + (size_t)64 * 256 * 256 * 2,
                 WS_BIAS = WS_ROPE + 1 * MiB, WS_S5L = WS_BIAS + 16384, WS_H = WS_S5L + 65536;
static_assert(WS_H % 256 == 0, "align");
constexpr size_t WS_W_GU8 = WS_W_GU + 64 * MiB;
constexpr size_t WS_X1 = WS_H + 64 * MiB, WS_ARENA = WS_X1 + 128 * MiB;
constexpr size_t A_QC = WS_ARENA, A_KVC = A_QC + 16 * MiB, A_KR = A_KVC + 8 * MiB, A_XH = A_KR + 2 * MiB, A_ES = A_XH + 48 * MiB, A_Q = A_ES + 32 * MiB, A_KF = A_Q + 48 * MiB,
                 A_V = A_KF + 48 * MiB, A_YS5 = A_V + 32 * MiB;
constexpr size_t A_XPRE = WS_ARENA, A_RT = WS_ARENA + 128 * MiB, A_TOKL = A_RT + 1 * MiB, A_ACT = WS_ARENA, A_YS = WS_ARENA + 130 * MiB;
constexpr int MOE_ROWS = 2 * T + 16 * 256;
constexpr size_t A_ZD = WS_ARENA, A_ZR = A_ZD + 144 * MiB, A_LIN = A_ZR + 156 * MiB, A_WDEC = A_LIN + 12 * MiB, A_AA = A_WDEC + 48 * MiB, A_GG = A_AA + 48 * MiB,
                 A_DPO = A_GG + 48 * MiB, A_DPM = A_DPO + 48 * MiB, A_DPL = A_DPM + 2 * MiB, A_BSG = A_DPL + 2 * MiB  , A_YR = WS_ARENA  , A_GST = A_BSG + 2 * MiB  , WS_END = A_GST + 2 * MiB;
static_assert(A_YS + (size_t)MOE_ROWS * 2048 * 2 <= WS_END && A_YS5 + 32 * MiB <= WS_END && WS_END <= 1024 * MiB, "ws map");

constexpr int RING_BYTES = 131072, LDS_TAB = RING_BYTES, LDS_MISC = RING_BYTES + 1024, LDS_BYTES = 147456;

struct KArgs { const float* in[41]; float* out; unsigned char* ws; int ph_lo, ph_hi; };
enum { I_X = 0, I_C, I_ADAW, I_ADAB, I_LNMG, I_LNMB, I_LNFG, I_LNFB, I_RW, I_RB, I_WGU, I_WDN, I_RELB, I_EVIN, I_QN, I_WUQ, I_KVN, I_WUKV, I_LRE, I_LIM, I_BRE, I_BIM, I_CRE, I_CIM,
       I_S5D, I_LOGDT, I_WGLU, I_EVOUT, I_ODIN, I_MU, I_W0, I_W2, I_A0, I_A2, I_G2, I_KK, I_KA, I_RK, I_LNXG, I_LNXB, I_ODOUT };

DI int ropeperm(int c) { return ((c >> 2) & 1) * 32 + (c >> 3) * 4 + (c & 3); }
DI int srccol(int map, int n) {
    switch (map) {
        case 1: if (n < 768) return n; if (n < 1792) return 832 + (n - 768); if (n < 1856) return 768 + ropeperm(n - 1792); return -1;
        case 2: { const int h = n / 192, j = n % 192; return j < 128 ? n : h * 192 + 128 + ropeperm(j - 128); }
        case 3: { const int pn = n >> 8, half = (n >> 7) & 1, idx = n & 127; return half * 512 + pn * 128 + idx; }
        case 4: return n < ODD_IN ? n : -1;
        default: return n;
    }
}
struct ConvJob { const float* src; bf16* dst; const float* kscale; int ldsrc, K, Nd, nmat, map, kbeg, kend, f8; size_t smat, dmat; };
DI void conv_item(const ConvJob& J, LAS unsigned char* scr, int item, int lane) {
    const int nblk = J.Nd / 64, per = (J.K / 64) * nblk, mat = item / per, r = item % per, kb = r / nblk, nb = r % nblk, k0 = 64 * kb, n0 = 64 * nb;
    const float* W = J.src + (size_t)mat * J.smat; bf16* WT = J.f8 ? (bf16*)((unsigned char*)J.dst + (size_t)mat * J.dmat) : J.dst + (size_t)mat * J.dmat;
    const int kq = lane >> 4, nq = lane & 15, sc = srccol(J.map, n0 + 4 * nq);
    f32x4 v[16];
#pragma unroll
    for (int i = 0; i < 16; ++i) { const int kg = k0 + 4 * i + kq; v[i] = (f32x4){0.f, 0.f, 0.f, 0.f};
        if (sc >= 0 && kg >= J.kbeg && kg < J.kend) { v[i] = *(const f32x4*)(W + (size_t)(kg - J.kbeg) * J.ldsrc + sc); if (J.kscale) v[i] *= J.kscale[kg]; } }
#pragma unroll
    for (int i = 0; i < 16; ++i) { LAS bf16* t = (LAS bf16*)(scr + (4 * nq) * 132 + (4 * i + kq) * 2); const unsigned p0 = pk2(v[i].x, v[i].y), p1 = pk2(v[i].z, v[i].w);
        t[0] = (bf16)(p0 & 0xffffu); t[66] = (bf16)(p0 >> 16); t[132] = (bf16)(p1 & 0xffffu); t[198] = (bf16)(p1 >> 16); }
    asm volatile("s_waitcnt lgkmcnt(0)" ::: "memory");
#pragma unroll
    for (int q = 0; q < 8; ++q) { const int id = lane + 64 * q, n = id >> 3, c = id & 7; const LAS unsigned* t = (const LAS unsigned*)(scr + n * 132 + c * 16);
        u32x4 o = {t[0], t[1], t[2], t[3]};
        if (J.f8) { u32x2 o8 = {pk4_fp8(bflo(o.x) * F8_WSCALE, bfhi(o.x) * F8_WSCALE, bflo(o.y) * F8_WSCALE, bfhi(o.y) * F8_WSCALE), pk4_fp8(bflo(o.z) * F8_WSCALE, bfhi(o.z) * F8_WSCALE, bflo(o.w) * F8_WSCALE, bfhi(o.w) * F8_WSCALE)};
            *(u32x2*)((unsigned char*)WT + (size_t)(n0 + n) * J.K + k0 + 8 * c) = o8; }
        else *(u32x4*)(WT + (size_t)(n0 + n) * J.K + k0 + 8 * c) = o; }
    asm volatile("s_waitcnt lgkmcnt(0)" ::: "memory");
}
DI ConvJob conv_job(const KArgs& a, int j) {
    unsigned char* ws = a.ws; ConvJob J; J.kscale = nullptr; J.nmat = 1; J.map = 0; J.smat = 0; J.dmat = 0; J.kbeg = 0; J.kend = 1 << 30; J.f8 = 0;
    switch (j) {
        case 0: J.src = a.in[I_EVIN]; J.dst = (bf16*)(ws + WS_W_IN0); J.f8 = 1; J.ldsrc = EVEN_IN; J.K = 2048; J.Nd = 2048; J.map = 1; break;
        case 1: J.src = a.in[I_WUQ]; J.dst = (bf16*)(ws + WS_W_UQ); J.ldsrc = 1536; J.K = 512; J.Nd = 1536; J.map = 2; J.kscale = a.in[I_QN]; break;
        case 2: J.src = a.in[I_WUKV]; J.dst = (bf16*)(ws + WS_W_UKV); J.ldsrc = 2048; J.K = 256; J.Nd = 2048; J.kscale = a.in[I_KVN]; break;
        case 3: J.src = a.in[I_WGLU]; J.dst = (bf16*)(ws + WS_W_GLU); J.ldsrc = 1024; J.K = 1024; J.Nd = 1024; break;
        case 4: J.src = a.in[I_EVOUT]; J.dst = (bf16*)(ws + WS_W_OUT0); J.f8 = 1; J.ldsrc = 2048; J.K = 2048; J.Nd = 2048; break;
        case 5: J.src = a.in[I_ODIN]; J.dst = (bf16*)(ws + WS_W_IN1); J.f8 = 1; J.ldsrc = ODD_IN; J.K = 2048; J.Nd = 9728; J.map = 4; break;
        case 6: J.src = a.in[I_ODOUT]; J.dst = (bf16*)(ws + WS_W_OUT1); J.f8 = 1; J.ldsrc = 2048; J.K = 2048; J.Nd = 2048; break;
        case 7: J.src = a.in[I_WGU]; J.dst = (bf16*)(ws + WS_W_GU8); J.f8 = 1; J.ldsrc = 1024; J.K = 2048; J.Nd = 1024; J.map = 3; J.nmat = 32; J.smat = (size_t)2048 * 1024; J.dmat = (size_t)1024 * 2048; break;
        case 8: J.src = a.in[I_WDN]; J.dst = (bf16*)(ws + WS_W_DN); J.f8 = 1; J.ldsrc = 2048; J.K = 512; J.Nd = 2048; J.nmat = 32; J.smat = (size_t)512 * 2048; J.dmat = (size_t)2048 * 512; break;
        case 9: J.src = a.in[I_W2]; J.dst = (bf16*)(ws + WS_W_LORA); J.ldsrc = 1536; J.K = 384; J.Nd = 1536; J.kbeg = 0; J.kend = 64; break;
        case 10: J.src = a.in[I_A2]; J.dst = (bf16*)(ws + WS_W_LORA) + (size_t)1536 * 384; J.ldsrc = 1536; J.K = 384; J.Nd = 1536; J.kbeg = 64; J.kend = 128; break;
        default: J.src = a.in[I_G2]; J.dst = (bf16*)(ws + WS_W_LORA) + (size_t)3072 * 384; J.ldsrc = 1536; J.K = 384; J.Nd = 1536; J.kbeg = 128; J.kend = 352; break;
    }
    return J;
}
constexpr int N_CONV_JOBS = 12;

DI void s5_precompute(const KArgs& a, LAS unsigned char* lds, int g, int wv) {
    LAS float* PW = (LAS float*)lds; LAS float* BB = PW + 17 * 64 * 2; LAS float* CC = BB + 64 * 16 * 2; LAS float* KK = CC + 16 * 64 * 2;
    const int tid = otid(wv);
    const float dt = expf(a.in[I_LOGDT][g]);
    for (int idx = tid; idx < 17 * 64; idx += 512) { const int d = idx / 64, p = idx % 64; const float lre = a.in[I_LRE][g * 64 + p], lim = a.in[I_LIM][g * 64 + p];
        const float mag = expf(lre * dt * (float)d); float sn, cs; sincosf(lim * dt * (float)d, &sn, &cs); PW[idx * 2] = mag * cs; PW[idx * 2 + 1] = mag * sn;
        if (d == 16) { float* L = (float*)(a.ws + WS_S5L); L[(g * 64 + p) * 2] = mag * cs; L[(g * 64 + p) * 2 + 1] = mag * sn; } }
    for (int idx = tid; idx < 64 * 16; idx += 512) { const int p = idx / 16, c = idx % 16; const float lre = a.in[I_LRE][g * 64 + p], lim = a.in[I_LIM][g * 64 + p];
        float sn, cs; sincosf(lim * dt, &sn, &cs); const float mag = expf(lre * dt), sh = sinf(0.5f * lim * dt);
        const float nr = expm1f(lre * dt) * cs - 2.f * sh * sh, ni = mag * sn, den = 1.f / (lre * lre + lim * lim);
        const float cr = (nr * lre + ni * lim) * den, ci = (ni * lre - nr * lim) * den;
        const float br = a.in[I_BRE][(g * 64 + p) * 16 + c], bi = a.in[I_BIM][(g * 64 + p) * 16 + c];
        BB[idx * 2] = cr * br - ci * bi; BB[idx * 2 + 1] = cr * bi + ci * br; }
    for (int idx = tid; idx < 16 * 64; idx += 512) { CC[idx * 2] = a.in[I_CRE][g * 1024 + idx]; CC[idx * 2 + 1] = a.in[I_CIM][g * 1024 + idx]; }
    __syncthreads();
    for (int idx = tid; idx < 4096; idx += 512) { const int d = idx >> 8, c = (idx >> 4) & 15, cp = idx & 15; float s = 0.f;
        for (int p = 0; p < 64; ++p) { const float cr = CC[(c * 64 + p) * 2], ci = CC[(c * 64 + p) * 2 + 1], pr = PW[(d * 64 + p) * 2], pi = PW[(d * 64 + p) * 2 + 1];
            const float xr = cr * pr - ci * pi, xi = cr * pi + ci * pr; s += xr * BB[(p * 16 + cp) * 2] - xi * BB[(p * 16 + cp) * 2 + 1]; }
        KK[idx] = s; }
    __syncthreads();
    bf16* BY = (bf16*)(a.ws + WS_S5BY) + (size_t)g * 256 * 384; bf16* BE = (bf16*)(a.ws + WS_S5BE) + (size_t)g * 256 * 256;
    for (int idx = tid; idx < 256 * 48; idx += 512) { const int row = idx / 48, col0 = (idx % 48) * 8, t = row >> 4, c = row & 15; float v[8];
        if (col0 < 256) { const int s = col0 >> 4, c0 = col0 & 15;
#pragma unroll
            for (int j = 0; j < 8; ++j) v[j] = (s <= t) ? KK[((t - s) << 8) + (c << 4) + c0 + j] : 0.f; }
        else { const int pp = col0 - 256; const bool im = pp >= 64; const int p0 = im ? pp - 64 : pp;
#pragma unroll
            for (int j = 0; j < 8; ++j) { const int p = p0 + j; const float cr = CC[(c * 64 + p) * 2], ci = CC[(c * 64 + p) * 2 + 1], pr = PW[((t + 1) * 64 + p) * 2], pi = PW[((t + 1) * 64 + p) * 2 + 1];
                v[j] = im ? -(cr * pi + ci * pr) : (cr * pr - ci * pi); } }
        u32x4 o = {pk2(v[0], v[1]), pk2(v[2], v[3]), pk2(v[4], v[5]), pk2(v[6], v[7])}; *(u32x4*)(BY + (size_t)row * 384 + col0) = o; }
    for (int idx = tid; idx < 256 * 32; idx += 512) { const int row = idx / 32, col0 = (idx % 32) * 8, s = col0 >> 4, c0 = col0 & 15; float v[8];
#pragma unroll
        for (int j = 0; j < 8; ++j) { if (row < 128) { const int p = row & 63; const float pr = PW[((15 - s) * 64 + p) * 2], pi = PW[((15 - s) * 64 + p) * 2 + 1], br = BB[(p * 16 + c0 + j) * 2], bi = BB[(p * 16 + c0 + j) * 2 + 1];
                v[j] = row < 64 ? (pr * br - pi * bi) : (pr * bi + pi * br); } else v[j] = 0.f; }
        u32x4 o = {pk2(v[0], v[1]), pk2(v[2], v[3]), pk2(v[4], v[5]), pk2(v[6], v[7])}; *(u32x4*)(BE + (size_t)row * 256 + col0) = o; }
    __syncthreads();
}

DI int t5_bucket(int dist) { if (dist < 16) return dist; const float logd = logf((float)dist / 16.f) / logf(128.f); int lg = 16 + (int)(logd * 16.f); return lg < 31 ? lg : 31; }

DI void p0_prologue(const KArgs& a, LAS unsigned char* lds, int wv) {
    const int tid = otid(wv), lane = tid & 63, wave = tid >> 6, G = gridDim.x, gw = blockIdx.x * 8 + wave, NGW = G * 8;
    LAS float* cond = (LAS float*)(lds + 98304);
    for (int i = tid; i < 4 * 2048; i += 512) { const float c = a.in[I_C][i]; cond[i] = c / (1.f + expf(-c)); }
    if (blockIdx.x < 64) s5_precompute(a, lds, blockIdx.x, wv); else __syncthreads();
    unsigned long long* MODI = (unsigned long long*)(a.ws + CTL_MODI);
    for (int it = gw; it < 2 * 48 * 16; it += NGW) { const int l = it / 768, cc = (it % 768) / 16, kc = it % 16, col = cc * 256 + lane * 4;
        const float* W = a.in[I_ADAW] + ((size_t)l * 2048 + kc * 128) * 12288 + col;
        f32x4 acc[4]; for (int b = 0; b < 4; ++b) acc[b] = (f32x4){0.f, 0.f, 0.f, 0.f};
#pragma unroll 8
        for (int k = 0; k < 128; ++k) { const f32x4 w = *(const f32x4*)(W + (size_t)k * 12288);
#pragma unroll
            for (int b = 0; b < 4; ++b) acc[b] += w * cond[b * 2048 + kc * 128 + k]; }
        if (kc == 0) { const f32x4 bb = *(const f32x4*)(a.in[I_ADAB] + l * 12288 + col); for (int b = 0; b < 4; ++b) acc[b] += bb; }
#pragma unroll
        for (int b = 0; b < 4; ++b) { unsigned long long* o = MODI + (size_t)(l * 4 + b) * 12288 + col;
#pragma unroll
            for (int e = 0; e < 4; ++e) atomicAdd(o + e, (unsigned long long)__double2ll_rn((double)acc[b][e] * 1099511627776.0)); } }
    LAS unsigned char* scr = lds + wave * 8704;
    for (int j = 0; j < N_CONV_JOBS; ++j) { const ConvJob J = conv_job(a, j); const int nit = J.nmat * (J.K / 64) * (J.Nd / 64);
        for (int it = gw; it < nit; it += NGW) conv_item(J, scr, it, lane); }
    { float* RC = (float*)(a.ws + WS_ROPE); float* RS = RC + 4096 * 32; const int gt = blockIdx.x * 512 + tid;
      for (int i = gt; i < 4096 * 32; i += G * 512) { const int pos = i >> 5, j = i & 31; const float inv = powf(10000.f, -(float)(2 * j) / 64.f); float sn, cs; sincosf((float)pos * inv, &sn, &cs); RC[i] = cs; RS[i] = sn; }
      float* BL = (float*)(a.ws + WS_BIAS);
      for (int i = gt; i < 3 * 8 * 132; i += G * 512) { const int gi = i / (8 * 132), h = (i / 132) % 8, dl = i % 132; const int dil = gi == 0 ? 1 : (gi == 1 ? 4 : 16);
          BL[i] = dl <= 128 ? a.in[I_RELB][t5_bucket(dl * dil) * 24 + gi * 8 + h] * 1.44269504089f : 0.f; } }
}

DI float modi2f(unsigned long long v) { return fmaf((float)(unsigned)v, 0x1p-40f, (float)(int)(v >> 32) * 0x1p-8f); }
DI void modulate_rows(const float* x, const unsigned long long* MODI, float* MODF, bf16* H, int wv) {
    const int lane = otid(wv) & 63, gw = blockIdx.x * 8 + (otid(wv) >> 6), NGW = gridDim.x * 8;
    for (int i = gw * 64 + lane; i < 2 * 4 * 12288; i += NGW * 64) MODF[i] = modi2f(MODI[i]);
    for (int m = gw; m < T; m += NGW) { const int b = m / SEQ; const unsigned long long* sh = MODI + (size_t)b * 12288; const unsigned long long* sc = sh + 2048;
#pragma unroll
        for (int j = 0; j < 8; ++j) { const int col = (lane + 64 * j) * 4; const f32x4 v = *(const f32x4*)(x + (size_t)m * D + col);
            const f32x4 s1 = {modi2f(sc[col]), modi2f(sc[col + 1]), modi2f(sc[col + 2]), modi2f(sc[col + 3])}, s0 = {modi2f(sh[col]), modi2f(sh[col + 1]), modi2f(sh[col + 2]), modi2f(sh[col + 3])};
            const f32x4 h = v * (s1 + 1.f) + s0; *(unsigned*)((unsigned char*)H + (size_t)m * D + col) = pk4_fp8(h.x, h.y, h.z, h.w); } }
}

using pg8::Unit;
#define P32(ptr, elemoff) ((decltype(ptr))((char*)(ptr) + (unsigned)((unsigned)(elemoff) * (unsigned)sizeof(*(ptr)))))
typedef f32x4 Acc[2][2][4][2];
#define EPI_ROWS_BEGIN const int row0 = u.pm * 256 + wr * 64 + fr; _Pragma("unroll") for (int ai = 0; ai < 2; ++ai) _Pragma("unroll") for (int m = 0; m < 4; ++m) { const int row = row0 + ai * 128 + m * 16;
#define EPI_ROWS_END __builtin_amdgcn_sched_barrier(0); }
DI u32x4 pack8(const f32x4& v0, const f32x4& v1) { u32x4 o = {pk2(v0.x, v0.y), pk2(v0.z, v0.w), pk2(v1.x, v1.y), pk2(v1.z, v1.w)}; return o; }

struct EpiIn0 { static constexpr bool PERM = true;
    bf16 *QC, *KVC, *KR, *XH; float *ssq;
    DI void operator()(const Acc& acc, const Unit& u, int wr, int wc, int fr, int fq) const {
        EPI_ROWS_BEGIN
            float ss = 0.f;
#pragma unroll
            for (int bj = 0; bj < 2; ++bj) { const f32x4 v0 = acc[ai][bj][m][0], v1 = acc[ai][bj][m][1]; const int col = 128 * bj + 32 * wc + 8 * fq; const u32x4 o = pack8(v0, v1);
                if (u.pn < 2) { *(u32x4*)P32(QC, row * 512 + u.pn * 256 + col) = o; ss += v0.x * v0.x + v0.y * v0.y + v0.z * v0.z + v0.w * v0.w + v1.x * v1.x + v1.y * v1.y + v1.z * v1.z + v1.w * v1.w; }
                else if (u.pn == 2) { *(u32x4*)P32(KVC, row * 256 + col) = o; ss += v0.x * v0.x + v0.y * v0.y + v0.z * v0.z + v0.w * v0.w + v1.x * v1.x + v1.y * v1.y + v1.z * v1.z + v1.w * v1.w; }
                else if (u.pn < 7) { const int uc = (u.pn - 3) * 256 + col, g = uc >> 4; *(u32x4*)P32(XH, (g * 1024 + (row >> 4)) * 384 + (row & 15) * 16 + (uc & 15)) = o; }
                else if (col < 64) { *(u32x4*)P32(KR, row * 64 + col) = o; } }
            if (u.pn <= 2) { ss += __shfl_xor(ss, 16); ss += __shfl_xor(ss, 32); if (fq == 0) *P32(ssq, row * 12 + u.pn * 4 + wc) = ss; }
        EPI_ROWS_END
    }
};
struct EpiQ { static constexpr bool PERM = true;
    bf16* Q; const float* ssq; const float* rope;
    DI void operator()(const Acc& acc, const Unit& u, int wr, int wc, int fr, int fq) const {
        EPI_ROWS_BEGIN
            const f32x4 q0 = *(const f32x4*)P32(ssq, row * 12), q1 = *(const f32x4*)P32(ssq, row * 12 + 4);
            const float rs = __builtin_amdgcn_rsqf((((q0.x + q0.y) + (q0.z + q0.w)) + ((q1.x + q1.y) + (q1.z + q1.w))) * (1.f / 512.f) + RMS_EPS) * (0.07216878364870322f * 1.44269504089f);
            const int b = row / SEQ, s = row % SEQ;
#pragma unroll
            for (int bj = 0; bj < 2; ++bj) { f32x4 v0 = acc[ai][bj][m][0] * rs, v1 = acc[ai][bj][m][1] * rs; const int n = u.pn * 256 + 128 * bj + 32 * wc + 8 * fq, h = n / 192, j = n % 192;
                if (j >= 128) { const int q = (j - 128) >> 3; const f32x4 cs = *(const f32x4*)P32(rope, s * 32 + 4 * q), sn = *(const f32x4*)P32(rope, 4096 * 32 + s * 32 + 4 * q);
                    const f32x4 x1 = v0, x2 = v1; v0 = x1 * cs - x2 * sn; v1 = x1 * sn + x2 * cs; }
                *(u32x4*)P32(Q, ((b * 8 + h) * SEQ + s) * 192 + j) = pack8(v0, v1); }
        EPI_ROWS_END
    }
};
struct EpiKV { static constexpr bool PERM = true;
    bf16 *KF, *V; const float* ssq;
    DI void operator()(const Acc& acc, const Unit& u, int wr, int wc, int fr, int fq) const {
        EPI_ROWS_BEGIN
            const f32x4 q2 = *(const f32x4*)P32(ssq, row * 12 + 8); const float rs = __builtin_amdgcn_rsqf(((q2.x + q2.y) + (q2.z + q2.w)) * (1.f / 256.f) + RMS_EPS); const int b = row / SEQ, s = row % SEQ, h = u.pn, j = 32 * wc + 8 * fq; const int tok = (b * 8 + h) * SEQ + s;
            *(u32x4*)P32(KF, tok * 192 + j) = pack8(acc[ai][0][m][0] * rs, acc[ai][0][m][1] * rs);
            *(u32x4*)P32(V, tok * 128 + j) = pack8(acc[ai][1][m][0] * rs, acc[ai][1][m][1] * rs);
        EPI_ROWS_END
    }
};
struct S5Order { int G, c;
    DI bool next(int i, Unit& u) const { const int L = i * G + c; if (L >= 256) return false; u.pm = L; u.pn = L >> 2; u.aux = 0; return true; }
    DI int arow(const Unit&, int) const { return 0; }
    DI int koff(const Unit&) const { return 0; } };
struct EpiS5E { static constexpr bool PERM = false;
    float* ES;
    DI void operator()(const Acc& acc, const Unit& u, int wr, int wc, int fr, int fq) const {
        EPI_ROWS_BEGIN
#pragma unroll
            for (int n = 0; n < 2; ++n) *(f32x4*)P32(ES, row * 128 + 32 * wc + 16 * n + 4 * fq) = acc[ai][0][m][n];
        EPI_ROWS_END
    }
};
DI float gelu_tanh(float x) { const float t = 0.7978845608028654f * (x + 0.044715f * x * x * x); const float e = __expf(2.f * t); return 0.5f * x * (1.f + (1.f - 2.f * __builtin_amdgcn_rcpf(e + 1.f))); }
struct EpiS5Y { static constexpr bool PERM = true;
    bf16* YS5; const bf16* XH; const float* dsk;
    DI void operator()(const Acc& acc, const Unit& u, int wr, int wc, int fr, int fq) const {
        EPI_ROWS_BEGIN
            const int g = row >> 10, chunk = row & 1023;
#pragma unroll
            for (int bj = 0; bj < 2; ++bj) { const int col = 128 * bj + 32 * wc + 8 * fq, tl = col >> 4, c0 = col & 15; const u32x4 uu = *(const u32x4*)P32(XH, row * 384 + col);
                const f32x4 d0 = *(const f32x4*)P32(dsk, g * 16 + c0), d1 = *(const f32x4*)P32(dsk, g * 16 + c0 + 4); const f32x4 a0 = acc[ai][bj][m][0], a1 = acc[ai][bj][m][1];
                f32x4 y0 = {a0.x + d0.x * bflo(uu.x), a0.y + d0.y * bfhi(uu.x), a0.z + d0.z * bflo(uu.y), a0.w + d0.w * bfhi(uu.y)};
                f32x4 y1 = {a1.x + d1.x * bflo(uu.z), a1.y + d1.y * bfhi(uu.z), a1.z + d1.z * bflo(uu.w), a1.w + d1.w * bfhi(uu.w)};
#pragma unroll
                for (int e = 0; e < 4; ++e) { y0[e] = gelu_tanh(y0[e]); y1[e] = gelu_tanh(y1[e]); }
                *(u32x4*)P32(YS5, (chunk * 16 + tl) * 1024 + g * 16 + c0) = pack8(y0, y1); }
        EPI_ROWS_END
    }
};
struct EpiGlu { static constexpr bool PERM = true;
    bf16* MIX; const bf16* YS5;
    DI void operator()(const Acc& acc, const Unit& u, int wr, int wc, int fr, int fq) const {
        EPI_ROWS_BEGIN
#pragma unroll
            for (int bj = 0; bj < 2; ++bj) { const int col = u.pn * 256 + 128 * bj + 32 * wc + 8 * fq; const u32x4 yy = *(const u32x4*)P32(YS5, row * 1024 + col); const f32x4 a0 = acc[ai][bj][m][0], a1 = acc[ai][bj][m][1];
                const f32x4 o0 = {bflo(yy.x) * sigmoidf_(a0.x), bfhi(yy.x) * sigmoidf_(a0.y), bflo(yy.y) * sigmoidf_(a0.z), bfhi(yy.y) * sigmoidf_(a0.w)};
                const f32x4 o1 = {bflo(yy.z) * sigmoidf_(a1.x), bfhi(yy.z) * sigmoidf_(a1.y), bflo(yy.w) * sigmoidf_(a1.z), bfhi(yy.w) * sigmoidf_(a1.w)};
                { unsigned char* mx = (unsigned char*)MIX; u32x2 o8 = {pk4_fp8(o0.x, o0.y, o0.z, o0.w), pk4_fp8(o1.x, o1.y, o1.z, o1.w)}; *(u32x2*)P32(mx, row * 2048 + 1024 + col) = o8; } }
        EPI_ROWS_END
    }
};
template <bool XBF> struct EpiRes { static constexpr bool PERM = true;
    bf16* XPRE; const void* xres; const float* gate;
    DI void operator()(const Acc& acc, const Unit& u, int wr, int wc, int fr, int fq) const {
        EPI_ROWS_BEGIN
            const int b = row / SEQ;
#pragma unroll
            for (int bj = 0; bj < 2; ++bj) { const int col = u.pn * 256 + 128 * bj + 32 * wc + 8 * fq;
                f32x4 x0, x1;
                if (XBF) { const bf16* xb = (const bf16*)xres; const u32x4 xq = *(const u32x4*)P32(xb, row * D + col); x0 = (f32x4){bflo(xq.x), bfhi(xq.x), bflo(xq.y), bfhi(xq.y)}; x1 = (f32x4){bflo(xq.z), bfhi(xq.z), bflo(xq.w), bfhi(xq.w)}; }
                else { const float* xf = (const float*)xres; x0 = *(const f32x4*)P32(xf, row * D + col); x1 = *(const f32x4*)P32(xf, row * D + col + 4); }
                const f32x4 g0 = *(const f32x4*)P32(gate, b * 12288 + col), g1 = *(const f32x4*)P32(gate, b * 12288 + col + 4);
                *(u32x4*)P32(XPRE, row * D + col) = pack8(x0 * DN_ALPHA + (g0 + 1.f) * acc[ai][bj][m][0], x1 * DN_ALPHA + (g1 + 1.f) * acc[ai][bj][m][1]); }
        EPI_ROWS_END
    }
};

DI void krope_pass(const bf16* KR, const float* rope, bf16* KF, int wv) {
    const int gt = blockIdx.x * 512 + otid(wv), NT_ = gridDim.x * 512;
    for (int i = gt; i < T * 8; i += NT_) { const int row = i >> 3, q = i & 7, b = row / SEQ, s = row % SEQ; const u32x4 r = *(const u32x4*)(KR + (size_t)row * 64 + q * 8);
        const f32x4 x1 = {bflo(r.x), bfhi(r.x), bflo(r.y), bfhi(r.y)}, x2 = {bflo(r.z), bfhi(r.z), bflo(r.w), bfhi(r.w)};
        const f32x4 cs = *(const f32x4*)(rope + s * 32 + 4 * q), sn = *(const f32x4*)(rope + 4096 * 32 + s * 32 + 4 * q);
        const u32x4 o = pack8(x1 * cs - x2 * sn, x1 * sn + x2 * cs);
#pragma unroll
        for (int h = 0; h < 8; ++h) *(u32x4*)(KF + ((size_t)(b * 8 + h) * SEQ + s) * 192 + 128 + q * 8) = o; }
}
DI void s5_carry(const float* ES, const float* L16, bf16* XH, LAS unsigned char* lds, int wv) {
    const int tid = otid(wv), lane = tid & 63, w = tid >> 6; LAS float* SEG = (LAS float*)lds;
    for (int base = blockIdx.x * 64; base < 4 * 64 * 64; base += gridDim.x * 64) {
        const int gt = base + lane, p = gt & 63, g = (gt >> 6) & 63, b = gt >> 12; const float lr = L16[(g * 64 + p) * 2], li = L16[(g * 64 + p) * 2 + 1];
        const size_t r0 = (size_t)g * 1024 + b * 256 + 32 * w;
        float hr = 0.f, hi = 0.f;
#pragma unroll 16
        for (int k = 0; k < 32; ++k) { const float er = ES[(r0 + k) * 128 + p], ei = ES[(r0 + k) * 128 + 64 + p]; const float nr = lr * hr - li * hi + er, ni = lr * hi + li * hr + ei; hr = nr; hi = ni; }
        __syncthreads();
        SEG[(w * 64 + lane) * 2] = hr; SEG[(w * 64 + lane) * 2 + 1] = hi;
        float pr = lr, pi = li;
#pragma unroll
        for (int q = 0; q < 5; ++q) { const float nr = pr * pr - pi * pi, ni = 2.f * pr * pi; pr = nr; pi = ni; }
        __syncthreads();
        hr = 0.f; hi = 0.f;
        for (int u = 0; u < w; ++u) { const float er = SEG[(u * 64 + lane) * 2], ei = SEG[(u * 64 + lane) * 2 + 1]; const float nr = pr * hr - pi * hi + er, ni = pr * hi + pi * hr + ei; hr = nr; hi = ni; }
#pragma unroll 16
        for (int k = 0; k < 32; ++k) { const float er = ES[(r0 + k) * 128 + p], ei = ES[(r0 + k) * 128 + 64 + p];
            XH[(r0 + k) * 384 + 256 + p] = f2bf(hr); XH[(r0 + k) * 384 + 320 + p] = f2bf(hi);
            const float nr = lr * hr - li * hi + er, ni = lr * hi + li * hr + ei; hr = nr; hi = ni; }
    }
    __syncthreads();
}

#define MFMA32(a, b, c) __builtin_amdgcn_mfma_f32_32x32x16_bf16((a), (b), (c), 0, 0, 0)
constexpr int AT_KROW = 384, AT_VROW = 256, AT_KBYTES = 64 * AT_KROW, AT_STG = AT_KBYTES + 64 * AT_VROW, AT_NST = 3;
static_assert(AT_NST * AT_STG <= RING_BYTES, "attention LDS");
DI void mla_attn_unit(LAS unsigned char* lds, const bf16* Qg, const bf16* KFg, const bf16* Vg, bf16* MIX, int unit, int wv) {
    const int tid = otid(wv), lane = tid & 63, w = tid >> 6, r = lane & 31, hh = lane >> 5;
    const int b = unit >> 6, h = (unit >> 3) & 7, pi = unit & 7;
    const bf16* Qh = Qg + (size_t)(b * 8 + h) * SEQ * 192; const bf16* Kh = KFg + (size_t)(b * 8 + h) * SEQ * 192; const bf16* Vh = Vg + (size_t)(b * 8 + h) * SEQ * 128;
    const int w_ = __builtin_amdgcn_readfirstlane(w);
    int koff[3], voff[2];
#pragma unroll
    for (int i = 0; i < 3; ++i) { const int p = (3 * w_ + i) * 64 + lane, row = p / 24, cs = p % 24, c = (cs & ~7) | ((cs ^ (row >> 1)) & 7); koff[i] = row * 192 + c * 8; }
#pragma unroll
    for (int i = 0; i < 2; ++i) { const int p = (2 * w_ + i) * 64 + lane, row = p >> 4, cs = p & 15, c = cs ^ ((row & 3) << 2); voff[i] = row * 128 + c * 8; }
    const int kx = (r >> 1) & 7, vq = (lane >> 2) & 3;
    for (int half = 0; half < 2; ++half) {
        const int qb = half ? 15 - pi : pi, q0 = qb * 256 + 32 * w, nkt = (qb + 1) * 4;
        bf16x8 qf[12];
#pragma unroll
        for (int ks = 0; ks < 12; ++ks) qf[ks] = *(const GAS bf16x8*)P32(Qh, (q0 + r) * 192 + 16 * ks + 8 * hh);
        f32x16 O[4];
#pragma unroll
        for (int i = 0; i < 4; ++i) for (int e = 0; e < 16; ++e) O[i][e] = 0.f;
        float mrow = -1e30f, lrow = 0.f;
#define AT_DMA(kt, stg) do { LAS unsigned char* sb_ = lds + (stg) * AT_STG; \
        _Pragma("unroll") for (int i = 0; i < 3; ++i) __builtin_amdgcn_global_load_lds((const unsigned*)P32(Kh, (kt) * 64 * 192 + koff[i]), (LAS unsigned*)(sb_ + (3 * w_ + i) * 1024), 16, 0, 0); \
        _Pragma("unroll") for (int i = 0; i < 2; ++i) __builtin_amdgcn_global_load_lds((const unsigned*)P32(Vh, (kt) * 64 * 128 + voff[i]), (LAS unsigned*)(sb_ + AT_KBYTES + (2 * w_ + i) * 1024), 16, 0, 0); } while (0)
#define AT_BAR() do { asm volatile("s_waitcnt lgkmcnt(0)" ::: "memory"); __builtin_amdgcn_s_barrier(); asm volatile("" ::: "memory"); } while (0)
        __syncthreads();
        AT_DMA(0, 0); AT_DMA(1, 1);
        asm volatile("s_waitcnt vmcnt(5)" ::: "memory");
        AT_BAR();
        int stg = 0;
        for (int kt = 0; kt < nkt; ++kt) {
            if (kt + 2 < nkt) AT_DMA(kt + 2, stg == 0 ? 2 : stg - 1);
            const LAS unsigned char* sb = lds + stg * AT_STG;
            if (kt * 64 <= q0 + 31) {
                f32x16 st[2];
#pragma unroll
                for (int mt = 0; mt < 2; ++mt) for (int e = 0; e < 16; ++e) st[mt][e] = 0.f;
                __builtin_amdgcn_sched_barrier(0);
                {
                    const LAS unsigned char* kb = sb + r * AT_KROW; const LAS unsigned char* kx4[4];
#pragma unroll
                    for (int j = 0; j < 4; ++j) kx4[j] = kb + (((2 * j + hh) ^ kx) & 7) * 16;
                    bf16x8 kf[24];
#pragma unroll
                    for (int i = 0; i < 24; ++i) kf[i] = *(const LAS bf16x8*)(kx4[(i >> 1) & 3] + 32 * (i & 1) * AT_KROW + 128 * (i >> 3));
#pragma unroll
                    for (int i = 0; i < 24; ++i) st[i & 1] = MFMA32(kf[i], qf[i >> 1], st[i & 1]);
                    __builtin_amdgcn_sched_group_barrier(0x100, 4, 0);
#pragma unroll
                    for (int i = 0; i < 24; ++i) { __builtin_amdgcn_sched_group_barrier(0x008, 1, 0); __builtin_amdgcn_sched_group_barrier(0x100, 1, 0); }
                }
                __builtin_amdgcn_sched_barrier(0);
                if (kt * 64 + 63 > q0) {
                    const int qg = q0 + r;
#pragma unroll
                    for (int mt = 0; mt < 2; ++mt)
#pragma unroll
                        for (int e = 0; e < 16; ++e) { const int kg = kt * 64 + 32 * mt + (e & 3) + 8 * (e >> 2) + 4 * hh; if (kg > qg) st[mt][e] = -1e30f; }
                }
                float mx = st[0][0];
#pragma unroll
                for (int mt = 0; mt < 2; ++mt)
#pragma unroll
                    for (int e = 0; e < 16; ++e) mx = fmaxf(mx, st[mt][e]);
                { const unsigned xi_ = __float_as_uint(mx); const auto rr_ = __builtin_amdgcn_permlane32_swap(xi_, xi_, false, false); mx = fmaxf(__uint_as_float(rr_[0]), __uint_as_float(rr_[1])); }
                float alpha = 1.f;
                if (__any(mx - mrow > 8.f)) { const float mnew = fmaxf(mrow, mx); alpha = __builtin_amdgcn_exp2f(mrow - mnew); mrow = mnew;
#pragma unroll
                    for (int i = 0; i < 4; ++i) O[i] *= alpha; }
                float ls = 0.f;
#pragma unroll
                for (int mt = 0; mt < 2; ++mt)
#pragma unroll
                    for (int e = 0; e < 16; ++e) { const float p = __builtin_amdgcn_exp2f(st[mt][e] - mrow); st[mt][e] = p; ls += p; }
                lrow = lrow * alpha + ls;
                bf16x8 pf[2][2];
#pragma unroll
                for (int mt = 0; mt < 2; ++mt)
#pragma unroll
                    for (int s = 0; s < 2; ++s) { u32x4 pk = {pk2(st[mt][8 * s], st[mt][8 * s + 1]), pk2(st[mt][8 * s + 2], st[mt][8 * s + 3]), pk2(st[mt][8 * s + 4], st[mt][8 * s + 5]), pk2(st[mt][8 * s + 6], st[mt][8 * s + 7])};
                        pf[mt][s] = __builtin_bit_cast(bf16x8, pk); }
                __builtin_amdgcn_sched_barrier(0);
                {
                    const LAS unsigned char* vb = sb + AT_KBYTES + (4 * hh + vq) * AT_VROW + 32 * ((lane >> 4) & 1) + 8 * (lane & 3); const LAS unsigned char* vx4[4];
#pragma unroll
                    for (int d = 0; d < 4; ++d) vx4[d] = vb + ((d ^ vq) & 3) * 64;
                    bf16x8 af[16];
#pragma unroll
                    for (int i = 0; i < 16; ++i) { const LAS unsigned char* vp = vx4[i & 3] + 16 * (i >> 2) * AT_VROW;
                        const s16x4 lo = __builtin_amdgcn_ds_read_tr16_b64_v4i16((LAS s16x4*)vp), hi = __builtin_amdgcn_ds_read_tr16_b64_v4i16((LAS s16x4*)(vp + 8 * AT_VROW)); af[i] = __builtin_shufflevector(lo, hi, 0, 1, 2, 3, 4, 5, 6, 7); }
#pragma unroll
                    for (int i = 0; i < 16; ++i) O[i & 3] = MFMA32(af[i], pf[i >> 3][(i >> 2) & 1], O[i & 3]);
                    __builtin_amdgcn_sched_group_barrier(0x100, 8, 0);
#pragma unroll
                    for (int i = 0; i < 16; ++i) { __builtin_amdgcn_sched_group_barrier(0x008, 1, 0); __builtin_amdgcn_sched_group_barrier(0x100, 2, 0); }
                }
                __builtin_amdgcn_sched_barrier(0);
            }
            if (kt + 2 < nkt) asm volatile("s_waitcnt vmcnt(5)" ::: "memory"); else asm volatile("s_waitcnt vmcnt(0)" ::: "memory");
            AT_BAR();
            stg = stg == 2 ? 0 : stg + 1;
        }
        lrow += __shfl_xor(lrow, 32);
        const float inv = 1.f / lrow;
        unsigned char* mx_ = (unsigned char*)MIX; unsigned char* orow = P32(mx_, (b * SEQ + q0 + r) * 2048 + h * 128);
#pragma unroll
        for (int dvt = 0; dvt < 4; ++dvt)
#pragma unroll
            for (int g4 = 0; g4 < 4; ++g4) *(GAS unsigned*)(orow + dvt * 32 + 8 * g4 + 4 * hh) = pk4_fp8(O[dvt][4 * g4] * inv, O[dvt][4 * g4 + 1] * inv, O[dvt][4 * g4 + 2] * inv, O[dvt][4 * g4 + 3] * inv);
    }
#undef AT_DMA
#undef AT_BAR
}

DI void ln_router_phase(const KArgs& a, LAS unsigned char* lds, int layer, const bf16* XPRE, bf16* X1, bf16* H, int wv) {
    const int tid = otid(wv), lane = tid & 63, wave = tid >> 6;
    LAS float* wT = (LAS float*)lds;
    { f32x4 rw[4][4];
#pragma unroll
      for (int i = 0; i < 4; ++i)
#pragma unroll
          for (int q4 = 0; q4 < 4; ++q4) rw[i][q4] = *(const f32x4*)(a.in[I_RW] + (size_t)(tid + 512 * i) * 16 + 4 * q4);
#pragma unroll
      for (int i = 0; i < 4; ++i)
#pragma unroll
          for (int q4 = 0; q4 < 4; ++q4)
#pragma unroll
              for (int e4 = 0; e4 < 4; ++e4) wT[(4 * q4 + e4) * 2048 + tid + 512 * i] = rw[i][q4][e4]; }
    __syncthreads();
    const float* MODl = (const float*)(a.ws + CTL_MOD) + (size_t)layer * 4 * 12288;
    const float* lg = a.in[I_LNMG] + layer * D; const float* lb = a.in[I_LNMB] + layer * D;
    unsigned* cnt = (unsigned*)(a.ws + CTL_CNT) + layer * 16 * 64;
    LAS int* lcnt = (LAS int*)(lds + LDS_MISC + 256); LAS int* lbase = lcnt + 16; LAS int* rec = lcnt + 32;
    if (tid < 16) lcnt[tid] = 0;
    int* RTE = (int*)(a.ws + A_RT); int* RTP = RTE + 2 * T; float* RTW = (float*)(RTP + 2 * T); int* TOKL = (int*)(a.ws + A_TOKL);
    const LAS float* wp[16];
#pragma unroll
    for (int e = 0; e < 16; ++e) { wp[e] = wT + e * 2048 + lane * 4; asm volatile("" : "+v"(wp[e])); }
    const float rbl = a.in[I_RB][lane >> 2];
    int lr = wave;
    for (int m = blockIdx.x * 8 + wave; m < T; m += gridDim.x * 8, lr += 8) {
        const int b = m / SEQ; const float* sh = MODl + (size_t)b * 12288 + 3 * 2048; const float* sc = sh + 2048;
        f32x4 v[8]; float s = 0.f;
#pragma unroll
        for (int j = 0; j < 8; ++j) { const u32x2 xp = *(const GAS u32x2*)(XPRE + (size_t)m * D + (lane + 64 * j) * 4); v[j] = (f32x4){bflo(xp.x), bfhi(xp.x), bflo(xp.y), bfhi(xp.y)}; s += (v[j].x + v[j].y) + (v[j].z + v[j].w); }
        const float mean = wave_sum(s) * (1.f / D); float s2 = 0.f;
#pragma unroll
        for (int j = 0; j < 8; ++j) { v[j] = v[j] - mean; s2 += (v[j].x * v[j].x + v[j].y * v[j].y) + (v[j].z * v[j].z + v[j].w * v[j].w); }
        const float rstd = rsqrtf(wave_sum(s2) * (1.f / D) + LN_EPS);
#pragma unroll
        for (int j = 0; j < 8; ++j) { const int col = (lane + 64 * j) * 4; const f32x4 x1 = v[j] * rstd * *(const f32x4*)(lg + col) + *(const f32x4*)(lb + col);
            { u32x2 ox = {pk2(x1.x, x1.y), pk2(x1.z, x1.w)}; *(GAS u32x2*)(X1 + (size_t)m * D + col) = ox; }
            const f32x4 hv = x1 * (*(const f32x4*)(sc + col) + 1.f) + *(const f32x4*)(sh + col);
            *(GAS unsigned*)((unsigned char*)H + (size_t)m * D + col) = pk4_fp8(hv.x, hv.y, hv.z, hv.w); v[j] = hv; }
        f32x2 part2[16];
#pragma unroll
        for (int e = 0; e < 16; ++e) part2[e] = (f32x2){0.f, 0.f};
#pragma unroll
        for (int j = 0; j < 8; ++j) { f32x4 wr_[16];
#pragma unroll
            for (int e = 0; e < 16; ++e) wr_[e] = *(const LAS f32x4*)(wp[e] + j * 256);
            __builtin_amdgcn_sched_barrier(0);
#pragma unroll
            for (int e = 0; e < 16; ++e) { part2[e] += (f32x2){v[j].x, v[j].y} * (f32x2){wr_[e].x, wr_[e].y}; part2[e] += (f32x2){v[j].z, v[j].w} * (f32x2){wr_[e].z, wr_[e].w}; }
            __builtin_amdgcn_sched_barrier(0); }
        float part[16];
#pragma unroll
        for (int e = 0; e < 16; ++e) part[e] = part2[e].x + part2[e].y;
        float r8[8], r4[4], r2[2], lg1;
        { const bool hi = lane & 32;
#pragma unroll
          for (int i = 0; i < 8; ++i) { const float mine = hi ? part[8 + i] : part[i], oth = hi ? part[i] : part[8 + i]; r8[i] = mine + __shfl_xor(oth, 32); } }
        { const bool hi = lane & 16;
#pragma unroll
          for (int i = 0; i < 4; ++i) { const float mine = hi ? r8[4 + i] : r8[i], oth = hi ? r8[i] : r8[4 + i]; r4[i] = mine + __shfl_xor(oth, 16); } }
        { const bool hi = lane & 8;
#pragma unroll
          for (int i = 0; i < 2; ++i) { const float mine = hi ? r4[2 + i] : r4[i], oth = hi ? r4[i] : r4[2 + i]; r2[i] = mine + __shfl_xor(oth, 8); } }
        { const bool hi = lane & 4; const float mine = hi ? r2[1] : r2[0], oth = hi ? r2[0] : r2[1]; lg1 = mine + __shfl_xor(oth, 4); }
        lg1 += dpp_xor1(lg1); lg1 += dpp_xor2(lg1);
        const float sgl = 1.f / (1.f + expf(-lg1)), sbl = sgl + rbl;
        float gs; { const float y1 = dpp_ror<4>(sbl), y2 = dpp_ror<8>(sbl), y3 = dpp_ror<12>(sbl);
            gs = fmaxf(fmaxf(fmaxf(sbl + y1, sbl + y2), fmaxf(sbl + y3, y1 + y2)), fmaxf(y1 + y3, y2 + y3)); }
        int bg = 0; float bgs = __builtin_bit_cast(float, __builtin_amdgcn_readlane(__builtin_bit_cast(int, gs), 0)); asm volatile("" : "+v"(bgs));
#pragma unroll
        for (int g = 1; g < 4; ++g) { float x = __builtin_bit_cast(float, __builtin_amdgcn_readlane(__builtin_bit_cast(int, gs), 16 * g)); asm volatile("" : "+v"(x)); const bool c = x > bgs; bgs = c ? x : bgs; bg = c ? g : bg; }
        const int bgu = __builtin_amdgcn_readfirstlane(bg);
        int e0 = 0, e1 = 0; float b0 = -1e30f, b1 = -1e30f, s0 = 0.f, s1 = 0.f;
#pragma unroll
        for (int i = 0; i < 4; ++i) { float x = __builtin_bit_cast(float, __builtin_amdgcn_readlane(__builtin_bit_cast(int, sbl), 16 * bgu + 4 * i)), sx = __builtin_bit_cast(float, __builtin_amdgcn_readlane(__builtin_bit_cast(int, sgl), 16 * bgu + 4 * i));
            asm volatile("" : "+v"(x), "+v"(sx)); const int e = 4 * bg + i; const bool g0 = x > b0, g1 = x > b1;
            b1 = g0 ? b0 : (g1 ? x : b1); e1 = g0 ? e0 : (g1 ? e : e1); s1 = g0 ? s0 : (g1 ? sx : s1);
            b0 = g0 ? x : b0; e0 = g0 ? e : e0; s0 = g0 ? sx : s0; }
        if (lane == 0) { const float inv = 1.f / (s0 + s1);
            const int p0 = __hip_atomic_fetch_add(lcnt + e0, 1, __ATOMIC_RELAXED, __HIP_MEMORY_SCOPE_WORKGROUP), p1 = __hip_atomic_fetch_add(lcnt + e1, 1, __ATOMIC_RELAXED, __HIP_MEMORY_SCOPE_WORKGROUP);
            rec[lr * 4] = m; rec[lr * 4 + 1] = e0; rec[lr * 4 + 2] = e1; rec[lr * 4 + 3] = p0 | (p1 << 16);
            RTE[2 * m] = e0; RTE[2 * m + 1] = e1; RTW[2 * m] = s0 * inv; RTW[2 * m + 1] = s1 * inv; }
    }
    __syncthreads();
    if (tid < 16) lbase[tid] = (int)atomicAdd(cnt + tid * 64, (unsigned)lcnt[tid]);
    __syncthreads();
    const int nrows = (T - (int)blockIdx.x * 8 + (int)gridDim.x * 8 - 1) / ((int)gridDim.x * 8) * 8;
    for (int i = tid; i < nrows; i += 512) { const int k = i >> 3, w8 = i & 7, m = (int)blockIdx.x * 8 + w8 + k * (int)gridDim.x * 8;
        if (m < T) { const int e0 = rec[i * 4 + 1], e1 = rec[i * 4 + 2], pp = rec[i * 4 + 3], q0 = lbase[e0] + (pp & 0xffff), q1 = lbase[e1] + (pp >> 16);
            TOKL[e0 * T + q0] = m; TOKL[e1 * T + q1] = m; RTP[2 * m] = q0; RTP[2 * m + 1] = q1; } }
    __syncthreads();
}

DI void moe_table(const KArgs& a, LAS unsigned char* lds, int layer, int wv) {
    LAS int* tab = (LAS int*)(lds + LDS_TAB);
    if (otid(wv) == 0) { const unsigned* cnt = (const unsigned*)(a.ws + CTL_CNT) + layer * 16 * 64; int acc = 0;
        for (int e = 0; e < 16; ++e) { const int c = (int)cnt[e * 64]; tab[e] = acc; tab[32 + e] = c; acc += (c + 255) >> 8; } tab[16] = acc; }
    __syncthreads();
}
template <int NTB> struct MoeOrder {
    int G, c, layer; const LAS int* tab; const int* tokl;
    DI bool next(int i, Unit& u) const { const int L = i * G + c, mt = L / NTB, nt = L % NTB; if (mt >= tab[16]) return false; int e = 0;
#pragma unroll
        for (int k = 1; k < 16; ++k) e += (mt >= tab[k]) ? 1 : 0;
        u.pm = mt; u.pn = (layer * 16 + e) * NTB + nt; u.aux = e | (nt << 8) | ((mt - tab[e]) << 16); return true; }
    DI int arow(const Unit& u, int r) const { const int e = u.aux & 255, j = (u.aux >> 16) * 256 + r; return j < tab[32 + e] ? tokl[e * T + j] : 0; }
    DI int koff(const Unit&) const { return 0; }
};
struct EpiGateUp { static constexpr bool PERM = true;
    unsigned char* ACT;
    DI void operator()(const Acc& acc, const Unit& u, int wr, int wc, int fr, int fq) const {
        const int nt = (u.aux >> 8) & 255;
        EPI_ROWS_BEGIN
            const f32x4 g0 = acc[ai][0][m][0], g1 = acc[ai][0][m][1], u0 = acc[ai][1][m][0], u1 = acc[ai][1][m][1];
            f32x4 o0, o1;
#pragma unroll
            for (int e = 0; e < 4; ++e) { o0[e] = g0[e] * sigmoidf_(g0[e]) * u0[e]; o1[e] = g1[e] * sigmoidf_(g1[e]) * u1[e]; }
            u32x2 o8 = {pk4_fp8(o0.x, o0.y, o0.z, o0.w), pk4_fp8(o1.x, o1.y, o1.z, o1.w)}; *(u32x2*)P32(ACT, row * 512 + nt * 128 + 32 * wc + 8 * fq) = o8;
        EPI_ROWS_END
    }
};
struct EpiDown { static constexpr bool PERM = true;
    bf16* YS;
    DI void operator()(const Acc& acc, const Unit& u, int wr, int wc, int fr, int fq) const {
        const int nt = (u.aux >> 8) & 255;
        EPI_ROWS_BEGIN
#pragma unroll
            for (int bj = 0; bj < 2; ++bj) *(u32x4*)P32(YS, row * 2048 + nt * 256 + 128 * bj + 32 * wc + 8 * fq) = pack8(acc[ai][bj][m][0], acc[ai][bj][m][1]);
        EPI_ROWS_END
    }
};
DI void ln_ffn_phase(const KArgs& a, int layer, const bf16* X1, float* XO, bf16* Hn, int wv) {
    const int lane = otid(wv) & 63, wave = otid(wv) >> 6;
    const float* MODl = (const float*)(a.ws + CTL_MOD) + (size_t)layer * 4 * 12288; const float* MODn = MODl + 4 * 12288;
    const float* lg = a.in[I_LNFG] + layer * D; const float* lb = a.in[I_LNFB] + layer * D;
    const unsigned* cnt = (const unsigned*)(a.ws + CTL_CNT) + layer * 16 * 64;
    const int* RTE = (const int*)(a.ws + A_RT); const int* RTP = RTE + 2 * T; const float* RTW = (const float*)(RTP + 2 * T); const bf16* YS = (const bf16*)(a.ws + A_YS);
    for (int m = blockIdx.x * 8 + wave; m < T; m += gridDim.x * 8) {
        const int b = m / SEQ; const float* gf = MODl + (size_t)b * 12288 + 5 * 2048;
        const int e0 = RTE[2 * m], e1 = RTE[2 * m + 1]; int t0 = 0, t1 = 0;
        for (int e = 0; e < 16; ++e) { const int tl = ((int)cnt[e * 64] + 255) >> 8; t0 += e < e0 ? tl : 0; t1 += e < e1 ? tl : 0; }
        const bf16* y0 = YS + ((size_t)t0 * 256 + RTP[2 * m]) * 2048; const bf16* y1 = YS + ((size_t)t1 * 256 + RTP[2 * m + 1]) * 2048; const float w0 = RTW[2 * m], w1 = RTW[2 * m + 1];
        f32x4 v[8]; float s = 0.f;
#pragma unroll
        for (int j = 0; j < 8; ++j) { const int col = (lane + 64 * j) * 4; const u32x2 a0 = *(const u32x2*)(y0 + col), a1 = *(const u32x2*)(y1 + col);
            const f32x4 y = {w0 * bflo(a0.x) + w1 * bflo(a1.x), w0 * bfhi(a0.x) + w1 * bfhi(a1.x), w0 * bflo(a0.y) + w1 * bflo(a1.y), w0 * bfhi(a0.y) + w1 * bfhi(a1.y)};
            const u32x2 xq = *(const u32x2*)(X1 + (size_t)m * D + col); const f32x4 xv = {bflo(xq.x), bfhi(xq.x), bflo(xq.y), bfhi(xq.y)};
            v[j] = xv * DN_ALPHA + (*(const f32x4*)(gf + col) + 1.f) * y; s += (v[j].x + v[j].y) + (v[j].z + v[j].w); }
        const float mean = wave_sum(s) * (1.f / D); float s2 = 0.f;
#pragma unroll
        for (int j = 0; j < 8; ++j) { v[j] = v[j] - mean; s2 += (v[j].x * v[j].x + v[j].y * v[j].y) + (v[j].z * v[j].z + v[j].w * v[j].w); }
        const float rstd = rsqrtf(wave_sum(s2) * (1.f / D) + LN_EPS);
#pragma unroll
        for (int j = 0; j < 8; ++j) { const int col = (lane + 64 * j) * 4; const f32x4 xo = v[j] * rstd * *(const f32x4*)(lg + col) + *(const f32x4*)(lb + col);
            if (Hn) { u32x2 oq = {pk2(xo.x, xo.y), pk2(xo.z, xo.w)}; *(u32x2*)((bf16*)XO + (size_t)m * D + col) = oq; }
            else *(f32x4*)(XO + (size_t)m * D + col) = xo;
            if (Hn) { const float* sh = MODn + (size_t)b * 12288; const f32x4 hv = xo * (*(const f32x4*)(sh + 2048 + col) + 1.f) + *(const f32x4*)(sh + col);
                *(unsigned*)((unsigned char*)Hn + (size_t)m * D + col) = pk4_fp8(hv.x, hv.y, hv.z, hv.w); } }
    }
}

struct EpiIn1 { static constexpr bool PERM = true;
    bf16 *ZD, *ZR;
    DI void operator()(const Acc& acc, const Unit& u, int wr, int wc, int fr, int fq) const {
        EPI_ROWS_BEGIN
#pragma unroll
            for (int bj = 0; bj < 2; ++bj) { const int col = u.pn * 256 + 128 * bj + 32 * wc + 8 * fq; const u32x4 o = pack8(acc[ai][bj][m][0], acc[ai][bj][m][1]);
                if (col < DIL_IN) *(u32x4*)P32(ZD, row * DIL_IN + col) = o; else if (col < ODD_IN) *(u32x4*)P32(ZR, row * RW_IN + (col - DIL_IN)) = o; }
        EPI_ROWS_END
    }
};
constexpr int DA_KSTR = 272, DA_VROW = 320, DA_KBYTES = 64 * DA_KSTR, DA_STG = DA_KBYTES + 64 * DA_VROW;
struct DilPre { bf16x8 qf[4]; u32x4 kreg[2], vreg[2]; float blv[2]; };
DI void dil_issue(const bf16* ZD, const float* BL, int unit, int wv, DilPre& P) {
    const int tid = otid(wv), lane = tid & 63, w = tid >> 6, r = lane & 31, hh = lane >> 5, hd = w >> 2, qs = w & 3;
    const int hp = unit & 3, sb_ = ((unit >> 2) + (unit >> 7)) & 31, gi = (unit >> 7) % 3, b = unit / 384;
    const int dil = gi == 0 ? 1 : (gi == 1 ? 4 : 16), nb = 32 / dil, rr = sb_ / nb, n = sb_ % nb, h = hp * 2 + hd, kt0 = n == 0 ? 2 : 0;
    const bf16* Zb = ZD + (size_t)b * SEQ * DIL_IN + gi * 1536;
    const int qtok = (n * 128 + 32 * qs + r) * dil + rr;
#pragma unroll
    for (int k = 0; k < 2; ++k) { const int i = tid + 512 * k, hd_ = i >= 384 ? 1 : 0, d = i - 384 * hd_ - 127;
        P.blv[k] = (i < 768 && d >= 0 && d <= 128) ? ((const GAS float*)BL)[(gi * 8 + hp * 2 + hd_) * 132 + d] : -1e30f; }
#pragma unroll
    for (int ks = 0; ks < 4; ++ks) P.qf[ks] = *(const GAS bf16x8*)P32(Zb, qtok * DIL_IN + h * 64 + 16 * ks + 8 * hh);
#pragma unroll
    for (int i = 0; i < 2; ++i) { const int p = tid + 512 * i, kr = p >> 4, c16 = p & 15; const int ktok = ((n - 1) * 128 + kt0 * 64 + kr) * dil + rr;
        P.kreg[i] = *(const GAS u32x4*)P32(Zb, ktok * DIL_IN + 512 + hp * 128 + c16 * 8); P.vreg[i] = *(const GAS u32x4*)P32(Zb, ktok * DIL_IN + 1024 + hp * 128 + c16 * 8); }
}
DI void dil_attn_unit(LAS unsigned char* lds, const bf16* ZD, const float* BL, bf16* DPO, float* DPM, float* DPL, int unit, int next, DilPre& P, int wv) {
    const int tid = otid(wv), lane = tid & 63, w = tid >> 6, r = lane & 31, hh = lane >> 5, hd = w >> 2, qs = w & 3;
    const int hp = unit & 3, sb_ = ((unit >> 2) + (unit >> 7)) & 31, gi = (unit >> 7) % 3, b = unit / 384;
    const int dil = gi == 0 ? 1 : (gi == 1 ? 4 : 16), nb = 32 / dil, rr = sb_ / nb, n = sb_ % nb;
    const int h = hp * 2 + hd;
    const bf16* Zb = ZD + (size_t)b * SEQ * DIL_IN + gi * 1536;
    LAS float* bl = (LAS float*)(lds + 2 * DA_STG);
    __syncthreads();
    bl[tid] = P.blv[0]; if (tid < 256) bl[512 + tid] = P.blv[1];
    const int qi = 32 * qs + r, qtok = (n * 128 + qi) * dil + rr;
    bf16x8 qf[4];
#pragma unroll
    for (int ks = 0; ks < 4; ++ks) qf[ks] = P.qf[ks];
    f32x16 O[2];
#pragma unroll
    for (int i = 0; i < 2; ++i) for (int e = 0; e < 16; ++e) O[i][e] = 0.f;
    float mrow = -1e30f, lrow = 0.f;
    u32x4 kreg[2] = {P.kreg[0], P.kreg[1]}, vreg[2] = {P.vreg[0], P.vreg[1]};
    const int kt0 = n == 0 ? 2 : 0;
#define DA_LOAD(kt) do { _Pragma("unroll") for (int i = 0; i < 2; ++i) { const int p = tid + 512 * i, kr = p >> 4, c16 = p & 15; const int ktok = ((n - 1) * 128 + (kt) * 64 + kr) * dil + rr; \
            kreg[i] = *(const GAS u32x4*)P32(Zb, ktok * DIL_IN + 512 + hp * 128 + c16 * 8); } \
        _Pragma("unroll") for (int i = 0; i < 2; ++i) { const int p = tid + 512 * i, kr = p >> 4, c16 = p & 15; const int ktok = ((n - 1) * 128 + (kt) * 64 + kr) * dil + rr; vreg[i] = *(const GAS u32x4*)P32(Zb, ktok * DIL_IN + 1024 + hp * 128 + c16 * 8); } } while (0)
#define DA_STORE(buf) do { LAS unsigned char* sb = lds + (buf) * DA_STG; _Pragma("unroll") for (int i = 0; i < 2; ++i) { const int p = tid + 512 * i, kr = p >> 4, c16 = p & 15; *(LAS u32x4*)(sb + kr * DA_KSTR + c16 * 16) = kreg[i]; } \
        _Pragma("unroll") for (int i = 0; i < 2; ++i) { const int p = tid + 512 * i; *(LAS u32x4*)(sb + DA_KBYTES + (p >> 4) * DA_VROW + (p & 15) * 16) = vreg[i]; } } while (0)
    DA_STORE(kt0 & 1);
    __syncthreads();
    for (int kt = kt0; kt < 4; ++kt) {
        if (kt + 1 < 4) DA_LOAD(kt + 1); else if (next >= 0) dil_issue(ZD, BL, next, wv, P);
        const LAS unsigned char* sb = lds + (kt & 1) * DA_STG;
        if (64 * kt + 63 >= 32 * qs && 64 * kt <= 32 * qs + 31 + 128) {
            f32x16 st[2];
#pragma unroll
            for (int mt = 0; mt < 2; ++mt) for (int e = 0; e < 16; ++e) st[mt][e] = 0.f;
            __builtin_amdgcn_sched_barrier(0);
            {
                const LAS unsigned char* kb = sb + r * DA_KSTR + (hd * 64 + 8 * hh) * 2; bf16x8 kf[8];
#pragma unroll
                for (int i = 0; i < 8; ++i) kf[i] = *(const LAS bf16x8*)(kb + 32 * (i & 1) * DA_KSTR + 32 * (i >> 1));
#pragma unroll
                for (int i = 0; i < 8; ++i) st[i & 1] = MFMA32(kf[i], qf[i >> 1], st[i & 1]);
                __builtin_amdgcn_sched_group_barrier(0x100, 3, 0);
#pragma unroll
                for (int i = 0; i < 8; ++i) { __builtin_amdgcn_sched_group_barrier(0x008, 1, 0); __builtin_amdgcn_sched_group_barrier(0x100, 1, 0); }
            }
            __builtin_amdgcn_sched_barrier(0);
#pragma unroll
            for (int mt = 0; mt < 2; ++mt) { const LAS float* lp = bl + hd * 384 + 127 + (128 + qi - 64 * kt - 32 * mt - 4 * hh) - 27;
#pragma unroll
                for (int e = 0; e < 16; ++e) st[mt][e] = st[mt][e] * (0.125f * 1.44269504089f) + lp[27 - ((e & 3) + 8 * (e >> 2))]; }
            float mx = st[0][0];
#pragma unroll
            for (int mt = 0; mt < 2; ++mt)
#pragma unroll
                for (int e = 0; e < 16; ++e) mx = fmaxf(mx, st[mt][e]);
            { const unsigned xi_ = __float_as_uint(mx); const auto rr_ = __builtin_amdgcn_permlane32_swap(xi_, xi_, false, false); mx = fmaxf(__uint_as_float(rr_[0]), __uint_as_float(rr_[1])); }
            float alpha = 1.f;
            if (__any(mx - mrow > 8.f)) { const float mnew = fmaxf(mrow, mx); alpha = __builtin_amdgcn_exp2f(mrow - mnew); mrow = mnew; O[0] *= alpha; O[1] *= alpha; }
            float ls = 0.f;
#pragma unroll
            for (int mt = 0; mt < 2; ++mt)
#pragma unroll
                for (int e = 0; e < 16; ++e) { const float p = __builtin_amdgcn_exp2f(st[mt][e] - mrow); st[mt][e] = p; ls += p; }
            lrow = lrow * alpha + ls;
            bf16x8 pf[2][2];
#pragma unroll
            for (int mt = 0; mt < 2; ++mt)
#pragma unroll
                for (int s = 0; s < 2; ++s) { u32x4 pk = {pk2(st[mt][8 * s], st[mt][8 * s + 1]), pk2(st[mt][8 * s + 2], st[mt][8 * s + 3]), pk2(st[mt][8 * s + 4], st[mt][8 * s + 5]), pk2(st[mt][8 * s + 6], st[mt][8 * s + 7])};
                    pf[mt][s] = __builtin_bit_cast(bf16x8, pk); }
            __builtin_amdgcn_sched_barrier(0);
            {
                const LAS unsigned char* vb = sb + DA_KBYTES + (4 * hh + ((lane >> 2) & 3)) * DA_VROW + (hd * 64 + 16 * ((lane >> 4) & 1)) * 2 + 8 * (lane & 3); bf16x8 af[8];
#pragma unroll
                for (int i = 0; i < 8; ++i) { const LAS unsigned char* vp = vb + 16 * (i >> 1) * DA_VROW + (i & 1) * 64;
                    const s16x4 lo = __builtin_amdgcn_ds_read_tr16_b64_v4i16((LAS s16x4*)vp), hi = __builtin_amdgcn_ds_read_tr16_b64_v4i16((LAS s16x4*)(vp + 8 * DA_VROW)); af[i] = __builtin_shufflevector(lo, hi, 0, 1, 2, 3, 4, 5, 6, 7); }
#pragma unroll
                for (int i = 0; i < 8; ++i) O[i & 1] = MFMA32(af[i], pf[i >> 2][(i >> 1) & 1], O[i & 1]);
                __builtin_amdgcn_sched_group_barrier(0x100, 6, 0);
#pragma unroll
                for (int i = 0; i < 8; ++i) { __builtin_amdgcn_sched_group_barrier(0x008, 1, 0); __builtin_amdgcn_sched_group_barrier(0x100, 2, 0); }
            }
            __builtin_amdgcn_sched_barrier(0);
        }
        if (kt + 1 < 4) DA_STORE((kt + 1) & 1);
        __syncthreads();
    }
    lrow += __shfl_xor(lrow, 32);
    const float inv = 1.f / lrow;
    const int tokg = b * SEQ + qtok;
    bf16* orow = P32(DPO, (gi * T + tokg) * 512 + h * 64);
#pragma unroll
    for (int dvt = 0; dvt < 2; ++dvt)
#pragma unroll
        for (int g4 = 0; g4 < 4; ++g4) { u32x2 o = {pk2(O[dvt][4 * g4] * inv, O[dvt][4 * g4 + 1] * inv), pk2(O[dvt][4 * g4 + 2] * inv, O[dvt][4 * g4 + 3] * inv)};
            *(GAS u32x2*)(orow + dvt * 32 + 8 * g4 + 4 * hh) = o; }
    if (hh == 0) { *(GAS float*)P32(DPM, (gi * T + tokg) * 8 + h) = mrow; *(GAS float*)P32(DPL, (gi * T + tokg) * 8 + h) = lrow; }
#undef DA_LOAD
#undef DA_STORE
}
DI void dil_merge(const bf16* DPO, const float* DPM, const float* DPL, bf16* MIX, int wv) {
    const int gt = blockIdx.x * 512 + otid(wv), NT_ = gridDim.x * 512;
    for (int i = gt; i < T * 64; i += NT_) { const int tok = i >> 6, c8 = i & 63, h = c8 >> 3;
        float m[3], l[3];
#pragma unroll
        for (int g = 0; g < 3; ++g) { m[g] = DPM[((size_t)g * T + tok) * 8 + h]; l[g] = DPL[((size_t)g * T + tok) * 8 + h]; }
        const float M = fmaxf(m[0], fmaxf(m[1], m[2])); float wsum = 0.f, wg[3];
#pragma unroll
        for (int g = 0; g < 3; ++g) { wg[g] = __builtin_amdgcn_exp2f(m[g] - M) * l[g]; wsum += wg[g]; }
        const float inv = __builtin_amdgcn_rcpf(wsum); float o[8];
#pragma unroll
        for (int e = 0; e < 8; ++e) o[e] = 0.f;
#pragma unroll
        for (int g = 0; g < 3; ++g) { const u32x4 v = *(const u32x4*)(DPO + ((size_t)g * T + tok) * 512 + c8 * 8); const float wn = wg[g] * inv;
            o[0] += wn * bflo(v.x); o[1] += wn * bfhi(v.x); o[2] += wn * bflo(v.y); o[3] += wn * bfhi(v.y); o[4] += wn * bflo(v.z); o[5] += wn * bfhi(v.z); o[6] += wn * bflo(v.w); o[7] += wn * bfhi(v.w); }
        u32x2 r = {pk4_fp8(o[0], o[1], o[2], o[3]), pk4_fp8(o[4], o[5], o[6], o[7])}; *(u32x2*)((unsigned char*)MIX + (size_t)tok * 2048 + c8 * 8) = r; }
}

DI void rwkv_prep(const bf16* ZR, const float* mu, bf16* LIN, int wv) {
    const int gt = blockIdx.x * 512 + otid(wv), NT_ = gridDim.x * 512;
    for (int i = gt; i < T * 48; i += NT_) { const int tok = i / 48, c0 = (i % 48) * 8, s = tok % SEQ; float o[8];
        if (c0 < 352) { const u32x4 z = *(const u32x4*)(ZR + (size_t)tok * RW_IN + 4608 + c0); u32x4 zp = {0u, 0u, 0u, 0u}; if (s > 0) zp = *(const u32x4*)(ZR + (size_t)(tok - 1) * RW_IN + 4608 + c0);
            const unsigned* zz = (const unsigned*)&z; const unsigned* pp = (const unsigned*)&zp;
#pragma unroll
            for (int e = 0; e < 8; ++e) { const float zv = (e & 1) ? bfhi(zz[e >> 1]) : bflo(zz[e >> 1]), pv = (e & 1) ? bfhi(pp[e >> 1]) : bflo(pp[e >> 1]); const float xs = zv + (pv - zv) * mu[4608 + c0 + e];
                o[e] = c0 < 64 ? 1.f - 2.f * __builtin_amdgcn_rcpf(1.f + __expf(2.f * xs)) : (c0 < 128 ? xs : sigmoidf_(xs)); } }
        else {
#pragma unroll
            for (int e = 0; e < 8; ++e) o[e] = 0.f; }
        u32x4 r = {pk2(o[0], o[1]), pk2(o[2], o[3]), pk2(o[4], o[5]), pk2(o[6], o[7])}; *(u32x4*)(LIN + (size_t)tok * 384 + c0) = r; }
}
struct LoraOrder : pg8::StaticOrder { int ko; DI int koff(const Unit&) const { return ko; } };
struct EpiLora { static constexpr bool PERM = true;
    bf16 *WDEC, *AA, *GG; const float *w0, *a0; int pn0;
    DI void operator()(const Acc& acc, const Unit& u, int wr, int wc, int fr, int fq) const {
        const int pnn = u.pn + pn0, kind = pnn / 6;
        EPI_ROWS_BEGIN
#pragma unroll
            for (int bj = 0; bj < 2; ++bj) { const int col = (pnn % 6) * 256 + 128 * bj + 32 * wc + 8 * fq; f32x4 v0 = acc[ai][bj][m][0], v1 = acc[ai][bj][m][1];
                if (kind == 0) { const f32x4 b0 = *(const f32x4*)P32(w0, col), b1 = *(const f32x4*)P32(w0, col + 4);
#pragma unroll
                    for (int e = 0; e < 4; ++e) { v0[e] = -0.6065306597f * sigmoidf_(v0[e] + b0[e]); v1[e] = -0.6065306597f * sigmoidf_(v1[e] + b1[e]); }
                    *(u32x4*)P32(WDEC, row * RWW + col) = pack8(v0, v1); }
                else if (kind == 1) { const f32x4 b0 = *(const f32x4*)P32(a0, col), b1 = *(const f32x4*)P32(a0, col + 4);
#pragma unroll
                    for (int e = 0; e < 4; ++e) { v0[e] = sigmoidf_(v0[e] + b0[e]); v1[e] = sigmoidf_(v1[e] + b1[e]); }
                    *(u32x4*)P32(AA, row * RWW + col) = pack8(v0, v1); }
                else *(u32x4*)P32(GG, row * RWW + col) = pack8(v0, v1); }
        EPI_ROWS_END
    }
};
constexpr int CK_AT = 0, CK_RT = 2048, CK_BH = 4096, CK_KH = 6144, CK_MT = 8192, CK_NK = 8704, CK_PB = 9216, CK_PK = 9728, CK_G15 = 10240, CK_VT = 10496  , CK_VTS = 40, CK_BS = 13056  , CK_SLOT = 13120;
constexpr int CK_HALF = 128;
constexpr int CK_N1 = (int)((128 * MiB) / CK_SLOT) - 1;
DI unsigned char* ck_slot(unsigned char* ws, int job) { return job < CK_N1 ? ws + WS_X1 + (size_t)job * CK_SLOT : ws + WS_W_GU + (size_t)(job - CK_N1) * CK_SLOT; }
static_assert((size_t)(96 * CK_HALF - CK_N1 + 1) * CK_SLOT <= 64 * MiB, "chunk buffer");
constexpr int PJ = 4;
constexpr int PL_AT = 0, PL_BT = 2304, PL_KT = 4608, PL_RT = 6912, PL_BH = 9216, PL_KH = 11520  ,
              PL_NAB = 13824  , PL_MTS = 14848  , PL_LDT = 15616  , PL_C = 19968  ,
              PL_T = 24064  , PL_VT = 24320  , PL_END = 26880;
static_assert(PJ * PL_END <= RING_BYTES && PJ == 4, "prep LDS");
DI bf16x8 ldfrag(const LAS unsigned char* p) { return *(const LAS bf16x8*)p; }
DI u32x4 ld2x8(const LAS unsigned char* p0, const LAS unsigned char* p1) { const u32x2 lo = *(const LAS u32x2*)p0, hi = *(const LAS u32x2*)p1; return (u32x4){lo.x, lo.y, hi.x, hi.y}; }
DI void unpk8(const u32x4 v, float (&o)[8]) { o[0] = bflo(v.x); o[1] = bfhi(v.x); o[2] = bflo(v.y); o[3] = bfhi(v.y); o[4] = bflo(v.z); o[5] = bfhi(v.z); o[6] = bflo(v.w); o[7] = bfhi(v.w); }
DI void ldf8(const float* p, float (&o)[8]) { const f32x4 x = *(const f32x4*)p, y = *(const f32x4*)(p + 4); o[0] = x.x; o[1] = x.y; o[2] = x.z; o[3] = x.w; o[4] = y.x; o[5] = y.y; o[6] = y.z; o[7] = y.w; }
DI u32x4 pack8(const float (&x)[8]) { return (u32x4){pk2(x[0], x[1]), pk2(x[2], x[3]), pk2(x[4], x[5]), pk2(x[6], x[7])}; }
DI void rwkv_chunk_prep(const KArgs& a, LAS unsigned char* lds0, int half, int wv) {
    const int tid = otid(wv), lane = tid & 63, w = tid >> 6;
    const bf16* ZR = (const bf16*)(a.ws + A_ZR); const bf16* WDEC = (const bf16*)(a.ws + A_WDEC); const bf16* AA = (const bf16*)(a.ws + A_AA);
    const int js = tid >> 7, st = (tid >> 3) & 15, oc = tid & 7;
    LAS unsigned char* ldj = lds0 + js * PL_END;
    const float* mu = a.in[I_MU];
    bf16x8 lfrag;
#pragma unroll
    for (int j = 0; j < 8; ++j) lfrag[j] = ((lane & 31) >= 16 || 8 * (lane >> 5) + j <= (lane & 31)) ? (short)0x3F80 : (short)0;
    for (int it = blockIdx.x; it < 96 * CK_HALF / PJ; it += gridDim.x) {
        const int job0 = it * PJ, bh = job0 / CK_HALF, cl0 = job0 % CK_HALF, b = bh / 24, h = bh % 24, col = h * 64 + 8 * oc;
        const int s = (half * CK_HALF + cl0 + js) * 16 + st; const size_t tok = (size_t)b * SEQ + s;
        unsigned char* slot = ck_slot(a.ws, job0 + js);
        const bf16* z = ZR + tok * RW_IN + col;
        const u32x4 zr = *(const u32x4*)z, zk = *(const u32x4*)(z + 1536), zv = *(const u32x4*)(z + 3072);
        u32x4 pr = {0u, 0u, 0u, 0u}, pk_ = {0u, 0u, 0u, 0u}, pv = {0u, 0u, 0u, 0u};
        if (s > 0) { pr = *(const u32x4*)(z - RW_IN); pk_ = *(const u32x4*)(z - RW_IN + 1536); pv = *(const u32x4*)(z - RW_IN + 3072); }
        const u32x4 za = *(const u32x4*)(AA + tok * RWW + col), zw = *(const u32x4*)(WDEC + tok * RWW + col);
        float r[8], km[8], q[8], bb[8], ld[8];
        {   float cz[8], cp[8], m_[8], k_[8], v_[8], as_[8], c1[8], c2[8];
            unpk8(zr, cz); unpk8(pr, cp); ldf8(mu + col, m_);
#pragma unroll
            for (int e = 0; e < 8; ++e) r[e] = cz[e] + (cp[e] - cz[e]) * m_[e];
            unpk8(zk, cz); unpk8(pk_, cp); ldf8(mu + 1536 + col, m_);
#pragma unroll
            for (int e = 0; e < 8; ++e) k_[e] = cz[e] + (cp[e] - cz[e]) * m_[e];
            unpk8(zv, cz); unpk8(pv, cp); ldf8(mu + 3072 + col, m_);
#pragma unroll
            for (int e = 0; e < 8; ++e) v_[e] = cz[e] + (cp[e] - cz[e]) * m_[e];
            unpk8(za, as_); unpk8(zw, ld); ldf8(a.in[I_KK] + col, c1);
            float nn = 0.f;
#pragma unroll
            for (int e = 0; e < 8; ++e) { q[e] = k_[e] * c1[e]; nn += q[e] * q[e]; }
            nn = red8(nn);
            const float invn = fminf(__builtin_amdgcn_rsqf(nn), 1e12f);
            ldf8(a.in[I_KA] + col, c1); ldf8(a.in[I_RK] + col, c2);
            float bs = 0.f;
#pragma unroll
            for (int e = 0; e < 8; ++e) { q[e] *= invn; km[e] = k_[e] * (1.f + (as_[e] - 1.f) * c1[e]); bb[e] = q[e] * as_[e]; bs += r[e] * km[e] * c2[e]; }
            bs = red8(bs);
            if (oc == 0) *(float*)(slot + CK_BS + st * 4) = bs;
#pragma unroll
            for (int e = 0; e < 8; ++e) *(LAS float*)(ldj + PL_LDT + ((8 * oc + e) * 17 + st) * 4) = ld[e];
#pragma unroll
            for (int e = 0; e < 8; e += 2) { const unsigned pv2 = pk2(v_[e], v_[e + 1]);
                *(LAS bf16*)(ldj + PL_VT + (8 * oc + e) * CK_VTS + st * 2) = (bf16)(pv2 & 0xffffu); *(LAS bf16*)(ldj + PL_VT + (8 * oc + e + 1) * CK_VTS + st * 2) = (bf16)(pv2 >> 16); } }
        __syncthreads();
        {
            LAS unsigned char* lds = lds0 + (w >> 1) * PL_END; const int r_ = lane & 31, hh = lane >> 5, ch = 32 * (w & 1) + r_;
            float x[8];
#pragma unroll
            for (int j = 0; j < 8; ++j) x[j] = *(const LAS float*)(lds + PL_LDT + (ch * 17 + 8 * hh + j) * 4);
            const u32x4 ph = {pk2(x[0], x[1]), pk2(x[2], x[3]), pk2(x[4], x[5]), pk2(x[6], x[7])};
            const u32x4 pl = {pk2(x[0] - bflo(ph.x), x[1] - bfhi(ph.x)), pk2(x[2] - bflo(ph.y), x[3] - bfhi(ph.y)), pk2(x[4] - bflo(ph.z), x[5] - bfhi(ph.z)), pk2(x[6] - bflo(ph.w), x[7] - bfhi(ph.w))};
            f32x16 cs; for (int e = 0; e < 16; ++e) cs[e] = 0.f;
            cs = MFMA32(lfrag, __builtin_bit_cast(bf16x8, ph), cs); cs = MFMA32(lfrag, __builtin_bit_cast(bf16x8, pl), cs);
#pragma unroll
            for (int e = 0; e < 8; ++e) *(LAS float*)(lds + PL_C + (((e & 3) + 8 * (e >> 2) + 4 * hh) * 64 + ch) * 4) = cs[e];
            if (hh == 0) *(LAS float*)(lds + PL_T + ch * 4) = cs[8]; }
        __syncthreads();
        {
            float c[8], t[8];
            { const f32x4 ca = *(const LAS f32x4*)(ldj + PL_C + (st * 64 + 8 * oc) * 4), cb = *(const LAS f32x4*)(ldj + PL_C + (st * 64 + 8 * oc + 4) * 4), ta = *(const LAS f32x4*)(ldj + PL_T + 8 * oc * 4), tb = *(const LAS f32x4*)(ldj + PL_T + (8 * oc + 4) * 4);
              c[0] = ca.x; c[1] = ca.y; c[2] = ca.z; c[3] = ca.w; c[4] = cb.x; c[5] = cb.y; c[6] = cb.z; c[7] = cb.w; t[0] = ta.x; t[1] = ta.y; t[2] = ta.z; t[3] = ta.w; t[4] = tb.x; t[5] = tb.y; t[6] = tb.z; t[7] = tb.w; }
            float at[8], bt[8], kt[8], rt[8], bhv[8], khv[8];
#pragma unroll
            for (int e = 0; e < 8; ++e) { const float g = __expf(c[e]), gp = __expf(c[e] - ld[e]), gi = __expf(-c[e]), gr = __expf(t[e] - c[e]);
                at[e] = -q[e] * gp; bt[e] = bb[e] * gi; kt[e] = km[e] * gi; rt[e] = r[e] * g; bhv[e] = bb[e] * gr; khv[e] = km[e] * gr; }
            LAS unsigned char* row = ldj + st * 144 + oc * 16;
            *(LAS u32x4*)(row + PL_AT) = pack8(at); *(LAS u32x4*)(row + PL_BT) = pack8(bt); *(LAS u32x4*)(row + PL_KT) = pack8(kt); *(LAS u32x4*)(row + PL_RT) = pack8(rt);
            *(LAS u32x4*)(row + PL_BH) = pack8(bhv); *(LAS u32x4*)(row + PL_KH) = pack8(khv);
            if (st == 0) { *(f32x4*)(slot + CK_G15 + 8 * oc * 4) = (f32x4){__expf(t[0]), __expf(t[1]), __expf(t[2]), __expf(t[3])}; *(f32x4*)(slot + CK_G15 + (8 * oc + 4) * 4) = (f32x4){__expf(t[4]), __expf(t[5]), __expf(t[6]), __expf(t[7])}; } }
        __syncthreads();
        if (w < PJ) {
            LAS unsigned char* lds = lds0 + w * PL_END; unsigned char* slot = ck_slot(a.ws, job0 + w); const int r = lane & 31, hh = lane >> 5, r16 = r & 15;
            f32x16 d; for (int e = 0; e < 16; ++e) d[e] = 0.f;
#pragma unroll
            for (int ks = 0; ks < 4; ++ks) d = MFMA32(ldfrag(lds + (r < 16 ? PL_BT : PL_KT) + r16 * 144 + ks * 32 + hh * 16), ldfrag(lds + (r < 16 ? PL_AT : PL_RT) + r16 * 144 + ks * 32 + hh * 16), d);
            float lo8[8], hi8[8];
#pragma unroll
            for (int e = 0; e < 8; ++e) { const int sr = (e & 3) + 8 * (e >> 2) + 4 * hh; const bool keep = r < 16 ? sr < r16 : sr <= r16; lo8[e] = keep ? d[e] : 0.f; hi8[e] = keep ? d[8 + e] : 0.f; }
            const u32x4 plo = {pk2(lo8[0], lo8[1]), pk2(lo8[2], lo8[3]), pk2(lo8[4], lo8[5]), pk2(lo8[6], lo8[7])}, phi = {pk2(hi8[0], hi8[1]), pk2(hi8[2], hi8[3]), pk2(hi8[4], hi8[5]), pk2(hi8[6], hi8[7])};
            if (r < 16) {
#pragma unroll
                for (int e = 0; e < 8; ++e) *(LAS float*)(lds + PL_NAB + (((e & 3) + 8 * (e >> 2) + 4 * hh) * 16 + r16) * 4) = lo8[e];
                *(u32x4*)(slot + CK_NK + (r16 + 16 * hh) * 16) = phi; }
            else { *(u32x4*)(slot + CK_PB + (r16 + 16 * hh) * 16) = plo; *(u32x4*)(slot + CK_PK + (r16 + 16 * hh) * 16) = phi; }
            asm volatile("s_waitcnt lgkmcnt(0)" ::: "memory");
            if (lane < 16) { float mr[16]; int ln = lane; asm volatile("" : "+v"(ln));
#pragma unroll
                for (int t = 0; t < 16; ++t) { float acc = (ln == t) ? 1.f : 0.f;
#pragma unroll
                    for (int u = 0; u < t; ++u) acc += mr[u] * *(const LAS float*)(lds + PL_NAB + (u * 16 + t) * 4);
                    mr[t] = acc; *(LAS bf16*)(lds + PL_MTS + t * 48 + lane * 2) = f2bf(acc); } }
            asm volatile("s_waitcnt lgkmcnt(0)" ::: "memory");
            if (r < 16) *(u32x4*)(slot + CK_MT + (r + 16 * hh) * 16) = ld2x8(lds + PL_MTS + r * 48 + 8 * hh, lds + PL_MTS + r * 48 + 16 + 8 * hh);
        } else {
            const int e2 = tid - 256;
#pragma unroll
            for (int q4 = 0; q4 < PJ; ++q4) { const LAS unsigned char* lds = lds0 + q4 * PL_END; unsigned char* slot = ck_slot(a.ws, job0 + q4);
                { const int arr = e2 >> 7, i7 = e2 & 127, ks = i7 >> 5, t = i7 & 15, hh = (i7 >> 4) & 1;
                  const LAS unsigned char* p = lds + (arr ? PL_RT : PL_AT) + t * 144 + (16 * ks + 4 * hh) * 2;
                  *(u32x4*)(slot + (arr ? CK_RT : CK_AT) + (ks * 32 + t + 16 * hh) * 16) = ld2x8(p, p + 16); }
                { const int arr = e2 >> 7, J = (e2 >> 6) & 1;
                  const LAS unsigned char* p = lds + (arr ? PL_KH : PL_BH) + (4 * (lane >> 5) + ((lane >> 2) & 3)) * 144 + (32 * J + 16 * ((lane >> 4) & 1)) * 2 + 8 * (lane & 3);
                  const s16x4 lo = __builtin_amdgcn_ds_read_tr16_b64_v4i16((LAS s16x4*)p), hi = __builtin_amdgcn_ds_read_tr16_b64_v4i16((LAS s16x4*)(p + 8 * 144));
                  *(bf16x8*)(slot + (arr ? CK_KH : CK_BH) + (J * 64 + lane) * 16) = __builtin_shufflevector(lo, hi, 0, 1, 2, 3, 4, 5, 6, 7); }
                if (e2 < 160) *(u32x4*)(slot + CK_VT + e2 * 16) = *(const LAS u32x4*)(lds + PL_VT + e2 * 16); }
        }
    }
    __syncthreads();
}
constexpr int RC_NS = 8, RC_SLOT = 15360, RC_GG = 13312, RC_AHEAD = 6, RC_Y = RC_NS * RC_SLOT;
static_assert(RC_Y + 8192 <= RING_BYTES && CK_SLOT <= RC_GG, "rwkv ring");
template <int PM = 0> DI void rwkv_chunk_rec(const KArgs& a, LAS unsigned char* lds, int unit, int half, int wv) {
    const int tid = otid(wv), lane = tid & 63, w = __builtin_amdgcn_readfirstlane(tid >> 6), r = lane & 31, hh = lane >> 5;
    const int b = unit / 24, h = unit % 24;
    float* GST = (float*)(a.ws + A_GST) + (size_t)unit * 4096;
    const unsigned char* GGb = a.ws + A_GG; bf16* MIX = (bf16*)(a.ws + WS_H);
#define RC_DMA(srcp, dstp) __builtin_amdgcn_global_load_lds((const unsigned*)(srcp), (LAS unsigned*)(dstp), 16, 0, 0)
#define RC_ISSUE(cc) do { if ((PM & 1) == 0 && (w == 4 || w == 5)) { const unsigned char* src = ck_slot(a.ws, unit * CK_HALF + (cc)) + lane * 16; LAS unsigned char* dst = lds + ((cc) % RC_NS) * RC_SLOT; \
        if (w == 4) { _Pragma("unroll") for (int i_ = 0; i_ < 8; ++i_) RC_DMA(src + i_ * 1024, dst + i_ * 1024); } \
        else { _Pragma("unroll") for (int i_ = 8; i_ < 13; ++i_) RC_DMA(src + i_ * 1024, dst + i_ * 1024); \
            const unsigned char* gsrc = GGb + ((size_t)b * SEQ + (half * CK_HALF + (cc)) * 16 + (lane >> 3)) * (RWW * 2) + h * 128 + (lane & 7) * 16; \
            RC_DMA(gsrc, dst + RC_GG); RC_DMA(gsrc + 8 * RWW * 2, dst + RC_GG + 1024); } } } while (0)
#define RC_BAR() do { asm volatile("s_waitcnt lgkmcnt(0)" ::: "memory"); __builtin_amdgcn_s_barrier(); asm volatile("" ::: "memory"); } while (0)
    const bool epi = (w & 2) != 0; const int et = 4 * ((w & 1) + 2 * (w >> 2)) + (lane >> 4), eiq = lane & 15, ecol = h * 64 + 4 * eiq;
    const f32x4 elg = *(const f32x4*)(a.in[I_LNXG] + ecol), elb = *(const f32x4*)(a.in[I_LNXB] + ecol);
#define RC_EPI(sp, Yp, tokv) do { const f32x4 y = *(const LAS f32x4*)((Yp) + et * 64 + 4 * eiq); const u32x2 gq = *(const LAS u32x2*)((sp) + RC_GG + et * 128 + eiq * 8); \
        const float bsv = *(const LAS float*)((sp) + CK_BS + et * 4); const LAS unsigned char* vq = (sp) + CK_VT + 4 * eiq * CK_VTS + et * 2; \
        const f32x4 v4 = {bflo(*(const LAS unsigned short*)vq), bflo(*(const LAS unsigned short*)(vq + CK_VTS)), bflo(*(const LAS unsigned short*)(vq + 2 * CK_VTS)), bflo(*(const LAS unsigned short*)(vq + 3 * CK_VTS))}; \
        const float mean = red16((y.x + y.y) + (y.z + y.w)) * (1.f / 64.f); const f32x4 d = y - mean; \
        const float rstd = __builtin_amdgcn_rsqf(red16((d.x * d.x + d.y * d.y) + (d.z * d.z + d.w * d.w)) * (1.f / 64.f) + 64e-5f); \
        const f32x4 gg4 = {bflo(gq.x), bfhi(gq.x), bflo(gq.y), bfhi(gq.y)}, o = (d * rstd * elg + elb + v4 * bsv) * gg4; \
        if (PM == 0 || o.x == 1.2345f) *(unsigned*)((unsigned char*)MIX + (size_t)(tokv) * 2048 + 512 + ecol) = pk4_fp8(o.x, o.y, o.z, o.w); } while (0)
    f32x16 G0, G1;
#pragma unroll
    for (int e = 0; e < 16; ++e) { G0[e] = 0.f; G1[e] = 0.f; }
    if (half == 1 && w < 2) {
#pragma unroll
        for (int e = 0; e < 16; ++e) { G0[e] = GST[(w * 2 + 0) * 1024 + e * 64 + lane]; G1[e] = GST[(w * 2 + 1) * 1024 + e * 64 + lane]; } }
    __syncthreads();
#pragma unroll
    for (int cc = 0; cc < RC_AHEAD; ++cc) RC_ISSUE(cc);
    asm volatile("s_waitcnt vmcnt(0)" ::: "memory");
    RC_BAR();
    bf16x8 pAR[4], pNP, pVT;
#define RC_PRE(slotp) do { const LAS unsigned char* sp_ = (slotp); _Pragma("unroll") for (int ks = 0; ks < 4; ++ks) pAR[ks] = ldfrag(sp_ + ((r >> 4) ? CK_RT : CK_AT) + (ks * 32 + (r & 15) + 16 * hh) * 16); \
        pNP = ldfrag(sp_ + ((r >> 4) ? CK_PK : CK_NK) + ((r & 15) + 16 * hh) * 16); \
        { const LAS unsigned char* vq_ = sp_ + CK_VT + (32 * w + r) * CK_VTS + 8 * hh; const s16x4 vlo_ = *(const LAS s16x4*)vq_, vhi_ = *(const LAS s16x4*)(vq_ + 16); pVT = __builtin_shufflevector(vlo_, vhi_, 0, 1, 2, 3, 4, 5, 6, 7); } } while (0)
    if (w < 2) RC_PRE(lds);
    for (int c = 0; c < CK_HALF; ++c) {
        if (c + RC_AHEAD < CK_HALF) RC_ISSUE(c + RC_AHEAD);
        const LAS unsigned char* sb = lds + (c % RC_NS) * RC_SLOT;
        if (w < 2) {
            const int r16 = r & 15, up = r >> 4;
            bf16x8 fAR[4], fBH0, fBH1, fKH0, fKH1, fM, fNP, fPB; f32x4 gs0[4], gs1[4];
#pragma unroll
            for (int ks = 0; ks < 4; ++ks) fAR[ks] = pAR[ks];
            fNP = pNP; const bf16x8 vtf = pVT;
            __builtin_amdgcn_sched_barrier(0);
            fM = ldfrag(sb + CK_MT + (r16 + 16 * hh) * 16); fPB = ldfrag(sb + CK_PB + (r16 + 16 * hh) * 16);
            fBH0 = ldfrag(sb + CK_BH + lane * 16); fBH1 = ldfrag(sb + CK_BH + (64 + lane) * 16); fKH0 = ldfrag(sb + CK_KH + lane * 16); fKH1 = ldfrag(sb + CK_KH + (64 + lane) * 16);
#pragma unroll
            for (int g4 = 0; g4 < 4; ++g4) { gs0[g4] = *(const LAS f32x4*)(sb + CK_G15 + (8 * g4 + 4 * hh) * 4); gs1[g4] = *(const LAS f32x4*)(sb + CK_G15 + (32 + 8 * g4 + 4 * hh) * 4); }
            __builtin_amdgcn_sched_barrier(0);
            bf16x8 gf[4];
#pragma unroll
            for (int s2 = 0; s2 < 2; ++s2) { u32x4 p0 = {pk2(G0[8 * s2], G0[8 * s2 + 1]), pk2(G0[8 * s2 + 2], G0[8 * s2 + 3]), pk2(G0[8 * s2 + 4], G0[8 * s2 + 5]), pk2(G0[8 * s2 + 6], G0[8 * s2 + 7])};
                u32x4 p1 = {pk2(G1[8 * s2], G1[8 * s2 + 1]), pk2(G1[8 * s2 + 2], G1[8 * s2 + 3]), pk2(G1[8 * s2 + 4], G1[8 * s2 + 5]), pk2(G1[8 * s2 + 6], G1[8 * s2 + 7])};
                gf[s2] = __builtin_bit_cast(bf16x8, p0); gf[2 + s2] = __builtin_bit_cast(bf16x8, p1); }
            f32x16 XY;
#pragma unroll
            for (int e = 0; e < 16; ++e) XY[e] = 0.f;
#pragma unroll
            for (int ks = 0; ks < 4; ++ks) XY = MFMA32(fAR[ks], gf[ks], XY);
            XY = MFMA32(fNP, vtf, XY);
            { u32x4 px = {pk2(XY[0], XY[1]), pk2(XY[2], XY[3]), pk2(XY[4], XY[5]), pk2(XY[6], XY[7])}; const bf16x8 xf = __builtin_bit_cast(bf16x8, px);
              f32x16 U; for (int e = 0; e < 16; ++e) U[e] = 0.f;
              U = MFMA32(fM, xf, U);
              u32x4 pu = {pk2(U[0], U[1]), pk2(U[2], U[3]), pk2(U[4], U[5]), pk2(U[6], U[7])}; const bf16x8 uf = __builtin_bit_cast(bf16x8, pu);
              XY = MFMA32(fPB, uf, XY);
#pragma unroll
              for (int e = 0; e < 16; ++e) { G0[e] *= gs0[e >> 2][e & 3]; G1[e] *= gs1[e >> 2][e & 3]; }
              G0 = MFMA32(fBH0, uf, G0); G1 = MFMA32(fBH1, uf, G1); G0 = MFMA32(fKH0, vtf, G0); G1 = MFMA32(fKH1, vtf, G1); }
            __builtin_amdgcn_sched_barrier(0);
            if (c + 1 < CK_HALF) RC_PRE(lds + ((c + 1) % RC_NS) * RC_SLOT);
            LAS float* Y = (LAS float*)(lds + RC_Y + (c & 1) * 4096);
#pragma unroll
            for (int e = 0; e < 8; ++e) Y[((e & 3) + 8 * (e >> 2) + 4 * hh) * 64 + 32 * w + r] = XY[8 + e];
        } else if (epi) {
            if (c > 0) RC_EPI(lds + ((c - 1) % RC_NS) * RC_SLOT, (const LAS float*)(lds + RC_Y + ((c - 1) & 1) * 4096), (size_t)b * SEQ + (half * CK_HALF + c - 1) * 16 + et);
        } else {
            if (c + RC_AHEAD >= CK_HALF) asm volatile("s_waitcnt vmcnt(0)" ::: "memory"); else if (w == 4) asm volatile("s_waitcnt vmcnt(32)" ::: "memory"); else asm volatile("s_waitcnt vmcnt(28)" ::: "memory");
        }
        RC_BAR();
    }
    if (epi) RC_EPI(lds + ((CK_HALF - 1) % RC_NS) * RC_SLOT, (const LAS float*)(lds + RC_Y + ((CK_HALF - 1) & 1) * 4096), (size_t)b * SEQ + (half * CK_HALF + CK_HALF - 1) * 16 + et);
    else if (w < 2 && half == 0 && (PM == 0 || G0[0] == 1.2345f)) {
#pragma unroll
        for (int e = 0; e < 16; ++e) { GST[(w * 2 + 0) * 1024 + e * 64 + lane] = G0[e]; GST[(w * 2 + 1) * 1024 + e * 64 + lane] = G1[e]; } }
    asm volatile("s_waitcnt vmcnt(0)" ::: "memory");
    __syncthreads();
#undef RC_PRE
#undef RC_EPI
#undef RC_DMA
#undef RC_ISSUE
#undef RC_BAR
}

constexpr int N_PHASES = 25;
__global__ void __launch_bounds__(512, 2) fwd(KArgs a) {
    extern __shared__ __attribute__((aligned(16))) unsigned char lds_[];
    LAS unsigned char* lds = (LAS unsigned char*)lds_;
    const int wv = __builtin_amdgcn_readfirstlane((int)threadIdx.x >> 6), G = gridDim.x, bid = blockIdx.x;
    volatile LAS unsigned* MISC = (volatile LAS unsigned*)(lds + LDS_MISC);
    if (wv == 0) MISC[lane_id()] = 0u;
    __syncthreads();
    unsigned char* ws0 = a.ws;
#if N_LAUNCH_MODE == 0
    XcdBarrier bar = xcd_barrier_post((unsigned*)(ws0 + CTL_BAR), MISC + 8, wv);
#ifdef DBG_TIME_K1
#define SEAM(k) do { if (IN(k) && IN((k) + 1)) xcd_barrier(bar); if (bid == 0 && wv == 0 && lane_id() == 0) ((unsigned long long*)(ws0 + CTL_CHK))[1 + (k)] = __builtin_amdgcn_s_memrealtime(); } while (0)
#else
#define SEAM(k) do { if (IN(k) && IN((k) + 1)) xcd_barrier(bar); } while (0)
#endif
#else
#define SEAM(k) do { } while (0)
#endif
    const int lo = a.ph_lo, hi = a.ph_hi;
#ifdef DBG_TIME_K1
    if (bid == 0 && wv == 0 && lane_id() == 0) ((unsigned long long*)(ws0 + CTL_CHK))[0] = __builtin_amdgcn_s_memrealtime();
#endif
#ifndef PH_MASK
#define PH_MASK 0xFFFFFFFFu
#endif
#define IN(k) (((PH_MASK >> (k)) & 1u) && lo <= (k) && (k) < hi)
#ifndef REP_REC
#define REP_REC 0
#endif
#ifndef REP_DIL
#define REP_DIL 0
#endif
#ifndef REPEAT_MASK
#define REPEAT_MASK 0u
#endif
#define PH(k) for (int rp_ = 0; rp_ < (IN(k) ? 1 + (int)((REPEAT_MASK >> (k)) & 1u) : 0); ++rp_)
#define MOD ((float*)(ws + CTL_MOD))
#define Hb ((bf16*)(ws + WS_H))
#define X1 ((bf16*)(ws + WS_X1))
#define XPRE ((bf16*)(ws + A_XPRE))
    pg8::StaticOrder SO;

    PH(0) { unsigned char* ws = wsl(a.ws); p0_prologue(a, lds, wv); } SEAM(0);
    PH(1) { unsigned char* ws = wsl(a.ws); modulate_rows(a.in[I_X], (const unsigned long long*)(ws + CTL_MODI), MOD, Hb, wv); } SEAM(1);
    PH(2) { unsigned char* ws = wsl(a.ws); pg8::Gemm g{Hb, (const bf16*)(ws + WS_W_IN0), 2048, 2048, 2048}; SO.init(T, 2048, G, bid);
        EpiIn0 E{(bf16*)(ws + A_QC), (bf16*)(ws + A_KVC), (bf16*)(ws + A_KR), (bf16*)(ws + A_XH), (float*)(ws + CTL_SSQ)};
        pg8::gemm_phase<EpiIn0, pg8::StaticOrder, false, true>(lds, g, SO, E, wv); } SEAM(2);
    PH(3) { unsigned char* ws = wsl(a.ws);
        krope_pass((const bf16*)(ws + A_KR), (const float*)(ws + WS_ROPE), (bf16*)(ws + A_KF), wv);
        { pg8::Gemm g{(const bf16*)(ws + A_QC), (const bf16*)(ws + WS_W_UQ), 512, 512, 512}; SO.init(T, 1536, G, bid);
          EpiQ E{(bf16*)(ws + A_Q), (const float*)(ws + CTL_SSQ), (const float*)(ws + WS_ROPE)}; pg8::gemm_phase<EpiQ, pg8::StaticOrder, false>(lds, g, SO, E, wv); }
        { pg8::Gemm g{(const bf16*)(ws + A_KVC), (const bf16*)(ws + WS_W_UKV), 256, 256, 256}; SO.init(T, 2048, G, bid);
          EpiKV E{(bf16*)(ws + A_KF), (bf16*)(ws + A_V), (const float*)(ws + CTL_SSQ)}; pg8::gemm_phase<EpiKV, pg8::StaticOrder, false>(lds, g, SO, E, wv); }
        { pg8::Gemm g{(const bf16*)(ws + A_XH), (const bf16*)(ws + WS_S5BE), 384, 256, 256}; S5Order S{G, bid}; EpiS5E E{(float*)(ws + A_ES)}; pg8::gemm_phase<EpiS5E, S5Order, false>(lds, g, S, E, wv); }
    } SEAM(3);
    PH(4) { unsigned char* ws = wsl(a.ws);
        s5_carry((const float*)(ws + A_ES), (const float*)(ws + WS_S5L), (bf16*)(ws + A_XH), lds, wv);
        for (int u = bid; u < 256; u += G) mla_attn_unit(lds, (const bf16*)(ws + A_Q), (const bf16*)(ws + A_KF), (const bf16*)(ws + A_V), Hb, u, wv);
    } SEAM(4);
    PH(5) { unsigned char* ws = wsl(a.ws); pg8::Gemm g{(const bf16*)(ws + A_XH), (const bf16*)(ws + WS_S5BY), 384, 384, 384}; S5Order S{G, bid};
        EpiS5Y E{(bf16*)(ws + A_YS5), (const bf16*)(ws + A_XH), a.in[I_S5D]}; pg8::gemm_phase<EpiS5Y, S5Order, false>(lds, g, S, E, wv); } SEAM(5);
    PH(6) { unsigned char* ws = wsl(a.ws); pg8::Gemm g{(const bf16*)(ws + A_YS5), (const bf16*)(ws + WS_W_GLU), 1024, 1024, 1024}; SO.init(T, 1024, G, bid);
        EpiGlu E{Hb, (const bf16*)(ws + A_YS5)}; pg8::gemm_phase<EpiGlu, pg8::StaticOrder, false>(lds, g, SO, E, wv); } SEAM(6);
    PH(7) { unsigned char* ws = wsl(a.ws); pg8::Gemm g{Hb, (const bf16*)(ws + WS_W_OUT0), 2048, 2048, 2048}; SO.init(T, 2048, G, bid);
        EpiRes<false> E{XPRE, a.in[I_X], MOD + 2 * 2048}; pg8::gemm_phase<EpiRes<false>, pg8::StaticOrder, false, true>(lds, g, SO, E, wv); } SEAM(7);
#define MOE_PHASES(layer, pb) \
        PH(pb) { unsigned char* ws = wsl(a.ws); ln_router_phase(a, lds, layer, XPRE, X1, Hb, wv); } SEAM(pb); \
        PH(pb + 1) { unsigned char* ws = wsl(a.ws); moe_table(a, lds, layer, wv); pg8::Gemm g{Hb, (const bf16*)(ws + WS_W_GU8), 2048, 2048, 2048}; \
            MoeOrder<4> S{G, bid, layer, (const LAS int*)(lds + LDS_TAB), (const int*)(ws + A_TOKL)}; EpiGateUp E{ws + A_ACT}; pg8::gemm_phase<EpiGateUp, MoeOrder<4>, true, true>(lds, g, S, E, wv); } SEAM(pb + 1); \
        PH(pb + 2) { unsigned char* ws = wsl(a.ws); moe_table(a, lds, layer, wv); pg8::Gemm g{(const bf16*)(ws + A_ACT), (const bf16*)(ws + WS_W_DN), 512, 512, 512}; \
            MoeOrder<8> S{G, bid, layer, (const LAS int*)(lds + LDS_TAB), (const int*)(ws + A_TOKL)}; EpiDown E{(bf16*)(ws + A_YS)}; pg8::gemm_phase<EpiDown, MoeOrder<8>, false, true>(lds, g, S, E, wv); } SEAM(pb + 2); \
        PH(pb + 3) { unsigned char* ws = wsl(a.ws); ln_ffn_phase(a, layer, X1, a.out, layer == 0 ? Hb : nullptr, wv); } SEAM(pb + 3);
    MOE_PHASES(0, 8)
    PH(12) { unsigned char* ws = wsl(a.ws); pg8::Gemm g{Hb, (const bf16*)(ws + WS_W_IN1), 2048, 2048, 2048}; SO.init(T, 9728, G, bid);
        EpiIn1 E{(bf16*)(ws + A_ZD), (bf16*)(ws + A_ZR)}; pg8::gemm_phase<EpiIn1, pg8::StaticOrder, false, true>(lds, g, SO, E, wv); } SEAM(12);
    PH(13) { unsigned char* ws = wsl(a.ws); rwkv_prep((const bf16*)(ws + A_ZR), a.in[I_MU], (bf16*)(ws + A_LIN), wv); } SEAM(13);
    PH(14) { unsigned char* ws = wsl(a.ws);
        { pg8::Gemm g{(const bf16*)(ws + A_LIN), (const bf16*)(ws + WS_W_LORA), 384, 384, 128}; LoraOrder LO; LO.init(T, 3072, G, bid); LO.ko = 0;
          EpiLora E{(bf16*)(ws + A_WDEC), (bf16*)(ws + A_AA), (bf16*)(ws + A_GG), a.in[I_W0], a.in[I_A0], 0}; pg8::gemm_phase<EpiLora, LoraOrder, false>(lds, g, LO, E, wv); }
        { pg8::Gemm g{(const bf16*)(ws + A_LIN), (const bf16*)(ws + WS_W_LORA) + (size_t)3072 * 384, 384, 384, 256}; LoraOrder LO; LO.init(T, 1536, G, bid); LO.ko = 128;
          EpiLora E{(bf16*)(ws + A_WDEC), (bf16*)(ws + A_AA), (bf16*)(ws + A_GG), a.in[I_W0], a.in[I_A0], 12}; pg8::gemm_phase<EpiLora, LoraOrder, false>(lds, g, LO, E, wv); }
} SEAM(14);
    PH(15) { rwkv_chunk_prep(a, lds, 0, wv); } SEAM(15);
    PH(16) { unsigned char* ws = wsl(a.ws); if (bid < 96 || G <= 96) { for (int u = bid; u < 96; u += G) { rwkv_chunk_rec(a, lds, u, 0, wv); if (REP_REC) rwkv_chunk_rec<REP_REC>(a, lds, u, 0, wv); } }
        if (G <= 96 || bid >= 96) { const int nb_ = G <= 96 ? G : G - 96, b0_ = G <= 96 ? bid : bid - 96;
            DilPre P; if (b0_ < 768) dil_issue((const bf16*)(ws + A_ZD), (const float*)(ws + WS_BIAS), b0_, wv, P);
            for (int u = b0_; u < 768; u += nb_) dil_attn_unit(lds, (const bf16*)(ws + A_ZD), (const float*)(ws + WS_BIAS), (bf16*)(ws + A_DPO), (float*)(ws + A_DPM), (float*)(ws + A_DPL), u, u + nb_ < 768 ? u + nb_ : -1, P, wv); } } SEAM(16);
    PH(17) { rwkv_chunk_prep(a, lds, 1, wv); } SEAM(17);
    PH(18) { unsigned char* ws = wsl(a.ws); if (bid < 96 || G <= 96) { for (int u = bid; u < 96; u += G) { rwkv_chunk_rec(a, lds, u, 1, wv); if (REP_REC) rwkv_chunk_rec<REP_REC>(a, lds, u, 1, wv); } }
        if (G <= 96 || bid >= 96) { const int nb_ = G <= 96 ? G : G - 96, b0_ = G <= 96 ? bid : bid - 96;
            DilPre P; if (768 + b0_ < 1536) dil_issue((const bf16*)(ws + A_ZD), (const float*)(ws + WS_BIAS), 768 + b0_, wv, P);
            for (int u = 768 + b0_; u < 1536; u += nb_) dil_attn_unit(lds, (const bf16*)(ws + A_ZD), (const float*)(ws + WS_BIAS), (bf16*)(ws + A_DPO), (float*)(ws + A_DPM), (float*)(ws + A_DPL), u, u + nb_ < 1536 ? u + nb_ : -1, P, wv); } } SEAM(18);
    PH(19) { unsigned char* ws = wsl(a.ws); dil_merge((const bf16*)(ws + A_DPO), (const float*)(ws + A_DPM), (const float*)(ws + A_DPL), Hb, wv); } SEAM(19);
    PH(20) { unsigned char* ws = wsl(a.ws); pg8::Gemm g{Hb, (const bf16*)(ws + WS_W_OUT1), 2048, 2048, 2048}; SO.init(T, 2048, G, bid);
        EpiRes<true> E{XPRE, a.out, MOD + 4 * 12288 + 2 * 2048}; pg8::gemm_phase<EpiRes<true>, pg8::StaticOrder, false, true>(lds, g, SO, E, wv); } SEAM(20);
    MOE_PHASES(1, 21)
#undef MOE_PHASES
#ifdef DBG_TIME_K1
    {
        xcd_barrier(bar);
        const unsigned long long* ts = (const unsigned long long*)(ws0 + CTL_CHK);
        const unsigned long long t0 = ts[0], te = __builtin_amdgcn_s_memrealtime();
        const float tot = (float)(te - t0), f1 = (float)(ts[1 + DBG_TIME_K1] - t0) / tot, f2 = (float)(ts[1 + DBG_TIME_K2] - t0) / tot;
        const float c1 = sqrtf(100.f * f1);
        for (size_t i = (size_t)bid * 512 + wv * 64 + lane_id(); i < (size_t)T * D; i += (size_t)G * 512) a.out[i] = c1;
        xcd_barrier(bar);
        if (bid == 0 && wv == 0 && lane_id() == 0) a.out[0] = 100.f * f2;
    }
#endif
#undef IN
#undef SEAM
#undef MOD
#undef Hb
#undef X1
#undef XPRE
}


#ifdef DBG_DUMP_OFF
__global__ void dbg_dump(const unsigned char* ws, float* out) {
    const size_t n = (size_t)T * D;
    for (size_t i = (size_t)blockIdx.x * 256 + threadIdx.x; i < n; i += (size_t)gridDim.x * 256) {
#if defined(DBG_DUMP_RT)
        { const int m = (int)(i >> 11), c = (int)(i & 2047); const int* RTE = (const int*)(ws + A_RT); const float* RTW = (const float*)(RTE + 4 * T); out[i] = c < 2 ? (float)RTE[2 * m + c] : (c < 4 ? RTW[2 * m + c - 2] : 0.f); }
#elif DBG_DUMP_F32
        out[i] = ((const float*)(ws + DBG_DUMP_OFF))[i];
#else
        out[i] = bf2f(((const bf16*)(ws + DBG_DUMP_OFF))[i]);
#endif
    }
}
#endif
extern "C" void kernel_launch(void* const* d_in, const int* in_sizes, int n_in, void* d_out, int out_size, void* d_ws, size_t ws_size, hipStream_t stream) {
    static int grid = 0;
    if (grid == 0) {
        if (n_in != 41 || out_size != T * D || ws_size < WS_END) { fprintf(stderr, "kernel_launch: unexpected shapes: n_in %d out %d ws %zu (need %zu)\n", n_in, out_size, ws_size, (size_t)WS_END); grid = -1; return; }
        int dev = 0, cus = 0, per_cu = 0;
        if (hipGetDevice(&dev) != hipSuccess || hipDeviceGetAttribute(&cus, hipDeviceAttributeMultiprocessorCount, dev) != hipSuccess) { grid = -1; return; }
        if (hipFuncSetAttribute((const void*)fwd, hipFuncAttributeMaxDynamicSharedMemorySize, LDS_BYTES) != hipSuccess) { fprintf(stderr, "kernel_launch: hipFuncSetAttribute failed\n"); grid = -1; return; }
        if (hipOccupancyMaxActiveBlocksPerMultiprocessor(&per_cu, (const void*)fwd, 512, LDS_BYTES) != hipSuccess || per_cu < 1) fprintf(stderr, "kernel_launch: occupancy query says %d blocks/CU\n", per_cu);
        (void)hipGetLastError();
        grid = cus;
    }
    if (grid < 0) return;
    (void)hipMemsetAsync(d_ws, 0, CTL_ZERO_BYTES, stream);
#ifdef DBG_ZERO_WS
    (void)hipMemsetAsync((char*)d_ws + CTL_ZERO_BYTES, 0, WS_END - CTL_ZERO_BYTES, stream);
#endif
    KArgs a{};
    for (int i = 0; i < 41; ++i) a.in[i] = (const float*)d_in[i];
    a.out = (float*)d_out; a.ws = (unsigned char*)d_ws;
#if N_LAUNCH_MODE == 0
    a.ph_lo = 0; a.ph_hi = N_PHASES;
    hipLaunchKernelGGL(fwd, dim3(grid), dim3(512), LDS_BYTES, stream, a);
#else
#ifdef DBG_DUMP_AFTER
    for (int p = 0; p <= DBG_DUMP_AFTER; ++p) { a.ph_lo = p; a.ph_hi = p + 1; hipLaunchKernelGGL(fwd, dim3(grid), dim3(512), LDS_BYTES, stream, a); }
#ifdef DBG_DUMP_OFF
    hipLaunchKernelGGL(dbg_dump, dim3(2048), dim3(256), 0, stream, (const unsigned char*)d_ws, (float*)d_out);
#endif
#else
    for (int p = 0; p < N_PHASES; ++p) { a.ph_lo = p; a.ph_hi = p + 1; hipLaunchKernelGGL(fwd, dim3(grid), dim3(512), LDS_BYTES, stream, a); }
#endif
#endif
}
```

```cpp
#include <hip/hip_runtime.h>
#include <cstdio>
#include <cstdint>

#ifndef N_LAUNCH_MODE
#define N_LAUNCH_MODE 0
#endif
#ifndef CHK
#define CHK 0
#endif

#define GAS __attribute__((address_space(1)))
#define LAS __attribute__((address_space(3)))
typedef unsigned short bf16;
typedef short bf16x8 __attribute__((ext_vector_type(8)));
typedef short s16x4 __attribute__((ext_vector_type(4)));
typedef float f32x4 __attribute__((ext_vector_type(4)));
typedef float f32x16 __attribute__((ext_vector_type(16)));
typedef float f32x2 __attribute__((ext_vector_type(2)));
typedef unsigned u32x4 __attribute__((ext_vector_type(4)));
typedef unsigned u32x2 __attribute__((ext_vector_type(2)));
#define DI __device__ __forceinline__

constexpr int D = 2048, NB = 4, SEQ = 4096, T = NB * SEQ;
constexpr float LN_EPS = 1e-5f, RMS_EPS = 1e-6f;
constexpr float DN_ALPHA = 1.41421356237f;
constexpr int EVEN_IN = 1856, ODD_IN = 9568, DIL_IN = 4608, RW_IN = 4960, RWW = 1536;
constexpr int NEXP = 16, DEXP = 512;

typedef __bf16 bf16x2_t __attribute__((ext_vector_type(2)));
DI unsigned pk2(float lo, float hi) { f32x2 v = {lo, hi}; bf16x2_t r = __builtin_convertvector(v, bf16x2_t); return __builtin_bit_cast(unsigned, r); }
DI float bf2f(bf16 b) { return __uint_as_float(((unsigned)b) << 16); }
DI float bflo(unsigned u) { return __uint_as_float(u << 16); }
DI float bfhi(unsigned u) { return __uint_as_float(u & 0xffff0000u); }
DI bf16 f2bf(float f) { unsigned u = __float_as_uint(f); u += 0x7fffu + ((u >> 16) & 1u); return (bf16)(u >> 16); }
DI float wave_sum_bp(float v) {
#pragma unroll
    for (int o = 1; o < 64; o <<= 1) v += __shfl_xor(v, o);
    return v;
}
DI unsigned char* wsl(unsigned char* p) { asm volatile("" : "+s"(p)); return p; }
DI int lane_id() { return (int)__builtin_amdgcn_mbcnt_hi(~0u, __builtin_amdgcn_mbcnt_lo(~0u, 0u)); }
DI int otid(int wv) { int t = wv * 64 + lane_id(); asm volatile("" : "+v"(t)); return t; }
DI float dpp_xor1(float x) { return __builtin_bit_cast(float, __builtin_amdgcn_mov_dpp(__builtin_bit_cast(int, x), 0xB1, 0xF, 0xF, true)); }
DI float dpp_xor2(float x) { return __builtin_bit_cast(float, __builtin_amdgcn_mov_dpp(__builtin_bit_cast(int, x), 0x4E, 0xF, 0xF, true)); }
DI float dpp_hmir(float x) { return __builtin_bit_cast(float, __builtin_amdgcn_mov_dpp(__builtin_bit_cast(int, x), 0x141, 0xF, 0xF, true)); }
template <int N> DI float dpp_ror(float x) { return __builtin_bit_cast(float, __builtin_amdgcn_mov_dpp(__builtin_bit_cast(int, x), 0x120 + N, 0xF, 0xF, true)); }
DI float dpp_rmir(float x) { return __builtin_bit_cast(float, __builtin_amdgcn_mov_dpp(__builtin_bit_cast(int, x), 0x140, 0xF, 0xF, true)); }
DI float red8(float x) { x += dpp_xor1(x); x += dpp_xor2(x); x += dpp_hmir(x); return x; }
DI float red16(float x) { x += dpp_xor1(x); x += dpp_xor2(x); x += dpp_hmir(x); x += dpp_rmir(x); return x; }
DI float wave_sum(float v) { float x = red16(v);
    { const auto rr = __builtin_amdgcn_permlane16_swap(__float_as_uint(x), __float_as_uint(x), false, false); x = __uint_as_float(rr[0]) + __uint_as_float(rr[1]); }
    { const auto rr = __builtin_amdgcn_permlane32_swap(__float_as_uint(x), __float_as_uint(x), false, false); x = __uint_as_float(rr[0]) + __uint_as_float(rr[1]); }
    return x; }
DI float sat448(float x) { return __builtin_amdgcn_fmed3f(x, -448.f, 448.f); }
DI unsigned pk4_fp8(float a, float b, float c, float d) { int w = 0; w = __builtin_amdgcn_cvt_pk_fp8_f32(sat448(a), sat448(b), w, false); w = __builtin_amdgcn_cvt_pk_fp8_f32(sat448(c), sat448(d), w, true); return (unsigned)w; }
constexpr float F8_WSCALE = 32.f;
DI float sigmoidf_(float x) { return __builtin_amdgcn_rcpf(1.f + __expf(-x)); }

namespace pg8 {
constexpr int BM = 256, BK = 64, HALF = 128, HTB = HALF * BK * 2, STAGE_BYTES = 8 * HTB, NXCD = 8, WGM = 8;
__host__ __device__ __forceinline__ int lds_byte(int r, int c) { const int st = (r >> 4) * 2 + (c >> 5), rr = r & 15, cc = c & 31, ob = rr * 64 + cc * 2; return st * 1024 + (ob ^ (((ob >> 9) & 1) << 5)); }
__host__ __device__ __forceinline__ void stage_rc(int b, int& R, int& C) { const int st = b / 1024, sb = b % 1024, swz = sb ^ (((sb >> 9) & 1) << 5); R = (st >> 1) * 16 + swz / 64; C = (st & 1) * 32 + (swz % 64) / 2; }
__host__ __device__ __forceinline__ int perm32(int rho) { const int n = rho >> 4, i = rho & 15; return 8 * (i >> 2) + 4 * n + (i & 3); }

struct Unit { int pm, pn, aux; };
struct Gemm { const bf16* A; const bf16* Bt; int lda, ldb, K; };

struct StaticOrder {
    int nM, nN, nwg, G, c;
    __host__ __device__ void init(int M, int N, int G_, int c_) { nM = M / BM; nN = N / BM; nwg = nM * nN; G = G_; c = c_; }
    __host__ __device__ bool next(int i, Unit& u) const {
        const long L = (long)i * G + c; if (L >= nwg) return false;
        int wgid = (int)L; { const int q = nwg / NXCD, r = nwg % NXCD, xcd = wgid % NXCD, off = wgid / NXCD; wgid = (xcd < r ? xcd * (q + 1) : r * (q + 1) + (xcd - r) * q) + off; }
        const int nig = WGM * nN, gid = wgid / nig, fm = gid * WGM, gsz = (nM - fm) < WGM ? (nM - fm) : WGM;
        u.pm = fm + ((wgid % nig) % gsz); u.pn = (wgid % nig) / gsz; u.aux = 0; return true;
    }
    __device__ __forceinline__ int arow(const Unit&, int) const { return 0; }
    __device__ __forceinline__ int koff(const Unit&) const { return 0; }
};

typedef int v8i __attribute__((ext_vector_type(8)));
template <class Epi, class Sched, bool GATHER, bool F8 = false>
__device__ __forceinline__ void gemm_phase(LAS unsigned char* lds, const Gemm g, const Sched& S, const Epi& E, int wv) {
    const int tid = otid(wv), wid = __builtin_amdgcn_readfirstlane(tid >> 6), lane = tid & 63, wr = wid >> 2, wc = wid & 3, fr = lane & 15, fq = lane >> 4;
    int K = g.K; asm volatile("" : "+s"(K));
    constexpr int ES = F8 ? 1 : 2;
    const int nt = K / (F8 ? 2 * BK : BK);
    unsigned voffB[2], vA0[2], vA1[2], nA0[2], nA1[2]; int Rr[2], Cc[2];
#pragma unroll
    for (int i = 0; i < 2; ++i) { int R, C; stage_rc(tid * 16 + i * 8192, R, C); const int Rb = Epi::PERM ? ((R & ~31) + perm32(R & 31)) : R;
        Rr[i] = R; Cc[i] = C; voffB[i] = (unsigned)(Rb * g.ldb * ES + C * 2);
        vA0[i] = (unsigned)(R * g.lda * ES + C * 2); vA1[i] = (unsigned)((R + HALF) * g.lda * ES + C * 2); nA0[i] = vA0[i]; nA1[i] = vA1[i]; }
    const size_t kstep = (size_t)(BK * 2);
    const size_t hstepB = (size_t)HALF * g.ldb * ES, tstepB = 2 * hstepB, tstepA = (size_t)BM * g.lda * ES, hstepA = (size_t)HALF * g.lda * ES, rbA = (size_t)g.lda * ES, rbB = (size_t)g.ldb * ES;
    const unsigned ldsw = (unsigned)wid * 1024u;
    const int aoff = lds_byte(wr * 64 + fr, F8 ? fq * 16 : fq * 8), boff = lds_byte(wc * 32 + fr, F8 ? fq * 16 : fq * 8);
#define PG8_SA(b, h) (((b) * 2 + (h)) * HTB)
#define PG8_SB(b, h) ((4 + (b) * 2 + (h)) * HTB)
#define PG8_STAGE(bufoff, gbase, voff) do { _Pragma("unroll") for (int _i = 0; _i < 2; ++_i) \
        __builtin_amdgcn_global_load_lds((const unsigned*)((const char*)(gbase) + (voff)[_i]), (LAS unsigned*)(lds + (bufoff) + ldsw + _i * 8192), 16, 0, 0); } while (0)
#define PG8_STAGE1(bufoff, gbase, voff0, rowbytes) do { __builtin_amdgcn_global_load_lds((const unsigned*)((const char*)(gbase) + (voff0)), (LAS unsigned*)(lds + (bufoff) + ldsw), 16, 0, 0); \
        __builtin_amdgcn_global_load_lds((const unsigned*)((const char*)(gbase) + (size_t)64 * (rowbytes) + (voff0)), (LAS unsigned*)(lds + (bufoff) + ldsw + 8192), 16, 0, 0); } while (0)
#define PG8_STAGEA(bufoff, gbase, half, arr) do { if constexpr (GATHER) PG8_STAGE(bufoff, gbase, arr); else PG8_STAGE1(bufoff, (const char*)(gbase) + (half) * hstepA, vA0[0], rbA); } while (0)
#define PG8_LD32(p) __builtin_bit_cast(v8i, __builtin_shufflevector(*(const LAS u32x4*)(p), *(const LAS u32x4*)((p) + 16), 0, 1, 2, 3, 4, 5, 6, 7))
#define PG8_LDA(dst, b, h) do { if constexpr (F8) { _Pragma("unroll") for (int m = 0; m < 4; ++m) dst##8[m] = PG8_LD32(lds + PG8_SA(b, h) + aoff + m * 2048); } \
        else { _Pragma("unroll") for (int m = 0; m < 4; ++m) _Pragma("unroll") for (int k = 0; k < 2; ++k) dst[m][k] = *(const LAS bf16x8*)(lds + PG8_SA(b, h) + aoff + m * 2048 + k * 1024); } } while (0)
#define PG8_LDB(dst, b, h) do { if constexpr (F8) { _Pragma("unroll") for (int n = 0; n < 2; ++n) dst##8[n] = PG8_LD32(lds + PG8_SB(b, h) + boff + n * 2048); } \
        else { _Pragma("unroll") for (int n = 0; n < 2; ++n) _Pragma("unroll") for (int k = 0; k < 2; ++k) dst[n][k] = *(const LAS bf16x8*)(lds + PG8_SB(b, h) + boff + n * 2048 + k * 1024); } } while (0)
#define PG8_MMA(ai, bj, At, Bt) do { __builtin_amdgcn_s_setprio(1); if constexpr (F8) { _Pragma("unroll") for (int m = 0; m < 4; ++m) _Pragma("unroll") for (int n = 0; n < 2; ++n) \
            asm volatile("v_mfma_scale_f32_16x16x128_f8f6f4 %0, %1, %2, %0, %3, %4 op_sel_hi:[0,0,0]" : "+v"(acc[ai][bj][m][n]) : "v"(Bt##8[n]), "v"(At##8[m]), "v"(sc_w), "v"(sc_x)); }     \
        else { _Pragma("unroll") for (int m = 0; m < 4; ++m) _Pragma("unroll") for (int n = 0; n < 2; ++n) _Pragma("unroll") for (int k = 0; k < 2; ++k) \
            acc[ai][bj][m][n] = __builtin_amdgcn_mfma_f32_16x16x32_bf16(Bt[n][k], At[m][k], acc[ai][bj][m][n], 0, 0, 0); } __builtin_amdgcn_s_setprio(0); } while (0)
#define PG8_WAIT_V(n) asm volatile("s_waitcnt vmcnt(" #n ")" ::: "memory")
#define PG8_WAIT_L(n) asm volatile("s_waitcnt lgkmcnt(" #n ")" ::: "memory")
#define PG8_BAR __builtin_amdgcn_s_barrier()
#define PG8_SCHED __builtin_amdgcn_sched_barrier(0)
    Unit cur, nxt; int ui = 0;
    if (!S.next(0, cur)) return;
    f32x4 acc[2][2][4][2];
#pragma unroll
    for (int a = 0; a < 2; ++a)
#pragma unroll
        for (int b = 0; b < 2; ++b)
#pragma unroll
            for (int m = 0; m < 4; ++m)
#pragma unroll
                for (int n = 0; n < 2; ++n) acc[a][b][m][n] = (f32x4){0.f, 0.f, 0.f, 0.f};
    int sc_w = 122, sc_x = 127; if constexpr (F8) asm volatile("" : "+v"(sc_w), "+v"(sc_x));
    bf16x8 At[4][2], B0[2][2], B1[2][2]; v8i At8[4], B08[2], B18[2];
    const char* cA = (GATHER ? (const char*)g.A : (const char*)g.A + (size_t)cur.pm * tstepA) + ES * S.koff(cur);
    const char* cB = (const char*)g.Bt + (size_t)cur.pn * tstepB + ES * S.koff(cur);
    if (GATHER) {
#pragma unroll
        for (int i = 0; i < 2; ++i) { vA0[i] = (unsigned)(S.arow(cur, Rr[i]) * g.lda * ES + Cc[i] * 2); vA1[i] = (unsigned)(S.arow(cur, Rr[i] + HALF) * g.lda * ES + Cc[i] * 2); nA0[i] = vA0[i]; nA1[i] = vA1[i]; } }
    PG8_STAGE1(PG8_SB(0, 0), cB, voffB[0], rbB); PG8_STAGEA(PG8_SA(0, 0), cA, 0, vA0); PG8_STAGE1(PG8_SB(0, 1), cB + hstepB, voffB[0], rbB); PG8_STAGEA(PG8_SA(0, 1), cA, 1, vA1);
    if (wr == 1) PG8_BAR;
    PG8_WAIT_V(4); PG8_BAR;
    PG8_STAGE1(PG8_SB(1, 0), cB + kstep, voffB[0], rbB); PG8_STAGEA(PG8_SA(1, 0), cA + kstep, 0, vA0); PG8_STAGE1(PG8_SB(1, 1), cB + hstepB + kstep, voffB[0], rbB);
    PG8_WAIT_V(6); PG8_BAR;
    for (;;) {
        const bool has_next = S.next(ui + 1, nxt);
        const char* nAp = GATHER ? cA : (has_next ? (const char*)g.A + (size_t)nxt.pm * tstepA + ES * S.koff(nxt) : cA);
        const char* nB = has_next ? (const char*)g.Bt + (size_t)nxt.pn * tstepB + ES * S.koff(nxt) : cB;
        if (GATHER) {
#pragma unroll
            for (int i = 0; i < 2; ++i) { nA0[i] = vA0[i]; nA1[i] = vA1[i]; } }
        for (int t = 0; t < nt; t += 2) {
            const bool last = (t == nt - 2);
            if (GATHER && has_next && t == (nt >= 4 ? nt - 4 : 0)) {
#pragma unroll
                for (int i = 0; i < 2; ++i) { nA0[i] = (unsigned)(S.arow(nxt, Rr[i]) * g.lda * ES + Cc[i] * 2); nA1[i] = (unsigned)(S.arow(nxt, Rr[i] + HALF) * g.lda * ES + Cc[i] * 2); } }
            const char* a1 = cA + (size_t)(t + 1) * kstep;
            const char* a2 = last ? nAp : cA + (size_t)(t + 2) * kstep; const char* b2 = last ? nB : cB + (size_t)(t + 2) * kstep;
            const char* a3 = a2 + kstep; const char* b3 = b2 + kstep;
            unsigned w0[2], w1[2];
#pragma unroll
            for (int i = 0; i < 2; ++i) { w0[i] = (GATHER && last) ? nA0[i] : vA0[i]; w1[i] = (GATHER && last) ? nA1[i] : vA1[i]; }
            PG8_LDB(B0, 0, 0); PG8_SCHED; PG8_LDA(At, 0, 0); PG8_STAGEA(PG8_SA(1, 1), a1, 1, vA1);
            PG8_WAIT_L(8); PG8_BAR; PG8_WAIT_L(0); PG8_MMA(0, 0, At, B0); PG8_BAR; PG8_SCHED;
            PG8_LDB(B1, 0, 1); PG8_STAGE1(PG8_SB(0, 0), b2, voffB[0], rbB);
            PG8_BAR; PG8_WAIT_L(0); PG8_MMA(0, 1, At, B1); PG8_BAR;
            PG8_LDA(At, 0, 1); PG8_STAGEA(PG8_SA(0, 0), a2, 0, w0);
            PG8_BAR; PG8_WAIT_L(0); PG8_MMA(1, 0, At, B0); PG8_BAR; PG8_SCHED;
            PG8_STAGE1(PG8_SB(0, 1), b2 + hstepB, voffB[0], rbB);
            PG8_WAIT_V(6); PG8_BAR; PG8_MMA(1, 1, At, B1); PG8_BAR;
            PG8_LDB(B0, 1, 0); PG8_SCHED; PG8_LDA(At, 1, 0); PG8_STAGEA(PG8_SA(0, 1), a2, 1, w1);
            PG8_WAIT_L(8); PG8_BAR; PG8_WAIT_L(0); PG8_MMA(0, 0, At, B0); PG8_BAR; PG8_SCHED;
            PG8_LDB(B1, 1, 1); PG8_STAGE1(PG8_SB(1, 0), b3, voffB[0], rbB);
            PG8_BAR; PG8_WAIT_L(0); PG8_MMA(0, 1, At, B1); PG8_BAR;
            PG8_LDA(At, 1, 1); PG8_STAGEA(PG8_SA(1, 0), a3, 0, w0);
            PG8_BAR; PG8_WAIT_L(0); PG8_MMA(1, 0, At, B0); PG8_BAR; PG8_SCHED;
            PG8_STAGE1(PG8_SB(1, 1), b3 + hstepB, voffB[0], rbB);
            PG8_WAIT_V(6); PG8_BAR; PG8_MMA(1, 1, At, B1); PG8_BAR;
        }
        if constexpr (F8) asm volatile("s_nop 15\n\ts_nop 15\n\ts_nop 15\n\ts_nop 15" ::: "memory");
        { int frr = fr, fqq = fq; asm volatile("" : "+v"(frr), "+v"(fqq));
          E(acc, cur, wr, wc, frr, fqq); }
        if (!has_next) break;
#pragma unroll
        for (int a = 0; a < 2; ++a)
#pragma unroll
            for (int b = 0; b < 2; ++b)
#pragma unroll
                for (int m = 0; m < 4; ++m)
#pragma unroll
                    for (int n = 0; n < 2; ++n) acc[a][b][m][n] = (f32x4){0.f, 0.f, 0.f, 0.f};
        cur = nxt; cA = nAp; cB = nB; ++ui;
        if (GATHER) {
#pragma unroll
            for (int i = 0; i < 2; ++i) { vA0[i] = nA0[i]; vA1[i] = nA1[i]; } }
    }
    PG8_WAIT_V(0);
    if (wr == 0) PG8_BAR;
    PG8_BAR;
#undef PG8_SA
#undef PG8_SB
#undef PG8_STAGE
#undef PG8_STAGE1
#undef PG8_STAGEA
#undef PG8_LDA
#undef PG8_LDB
#undef PG8_MMA
#undef PG8_LD32
#undef PG8_WAIT_V
#undef PG8_WAIT_L
#undef PG8_BAR
#undef PG8_SCHED
}
}

#define XB_TMO      128
#define XB_XCNT(j)  (256  + 64 * (j))
#define XB_XSUB(j)  (1280 + 64 * (j))
#define XB_XGEN(j)  (2304 + 64 * (j))
#define XB_TOP      3328
#define XB_TOPGEN   3392
#define XCD_BAR_WORDS 3456
#define XB_SPIN_CAP (1u << 18)
__device__ __forceinline__ unsigned xb_ld(unsigned* p)              { return __hip_atomic_load(p, __ATOMIC_RELAXED, __HIP_MEMORY_SCOPE_AGENT); }
__device__ __forceinline__ unsigned xb_add(unsigned* p, unsigned v) { return __hip_atomic_fetch_add(p, v, __ATOMIC_RELAXED, __HIP_MEMORY_SCOPE_AGENT); }
__device__ __forceinline__ unsigned xb_xcc_id() { return (unsigned)__builtin_amdgcn_s_getreg((3 << 11) | 20) & 0xFu; }
#define XB_SPIN(cond, bar) do { unsigned _sp = 0; while (cond) { __builtin_amdgcn_s_sleep(1); \
    if ((++_sp & 255u) == 0u) { if (xb_ld(&(bar)[XB_TMO])) break; if (_sp > XB_SPIN_CAP) { atomicAdd(&(bar)[XB_TMO], 1u); break; } } } } while (0)
struct XcdBarrier { unsigned* bar; unsigned x; volatile LAS unsigned* st; int wv; };
__device__ __forceinline__ XcdBarrier xcd_barrier_post(unsigned* bar, volatile LAS unsigned* st, int wv) {
    XcdBarrier b; b.bar = bar; b.x = xb_xcc_id(); b.st = st; b.wv = wv;
    if (wv == 0 && lane_id() == 0) (void)xb_add(&bar[XB_XCNT(b.x)], 1u);
    return b;
}
__device__ __forceinline__ void xcd_barrier_complete(unsigned* bar, unsigned x, unsigned& nloc, unsigned& nx) {
    const unsigned G = gridDim.x * gridDim.y * gridDim.z;
    unsigned sum, cnt, mine, sp = 0u;
    for (;;) {
        sum = 0u; cnt = 0u; mine = 0u;
#pragma unroll
        for (unsigned j = 0; j < 16; ++j) { const unsigned c = xb_ld(&bar[XB_XCNT(j)]); sum += c; cnt += (c > 0u) ? 1u : 0u; mine = (j == x) ? c : mine; }
        if (sum == G) break;
        __builtin_amdgcn_s_sleep(1);
        if ((++sp & 255u) == 0u) { if (xb_ld(&bar[XB_TMO])) break; if (sp > XB_SPIN_CAP) { atomicAdd(&bar[XB_TMO], 1u); break; } }
    }
    nloc = mine > 0u ? mine : 1u; nx = cnt > 0u ? cnt : 1u;
}
__device__ __forceinline__ void xcd_barrier(const XcdBarrier& b) {
    asm volatile("s_waitcnt vmcnt(0)" ::: "memory");
    __syncthreads();
    if (b.wv == 0 && lane_id() == 0) {
        unsigned* bar = b.bar;
        __builtin_amdgcn_s_waitcnt(0);
        unsigned nloc = b.st[0], nx = b.st[1];
        if (nloc == 0u) { xcd_barrier_complete(bar, b.x, nloc, nx); b.st[0] = nloc; b.st[1] = nx; }
        const unsigned old = xb_add(&bar[XB_XSUB(b.x)], 1u);
        const unsigned gen = old / nloc;
        if (old + 1u == (gen + 1u) * nloc) {
            __builtin_amdgcn_fence(__ATOMIC_RELEASE, "agent");
            asm volatile("s_waitcnt vmcnt(0)" ::: "memory");
            const unsigned og = xb_add(&bar[XB_TOP], 1u);
            const unsigned tg = og / nx;
            if (og + 1u == (tg + 1u) * nx) xb_add(&bar[XB_TOPGEN], 1u);
            else XB_SPIN(xb_ld(&bar[XB_TOPGEN]) == tg, bar);
            __builtin_amdgcn_fence(__ATOMIC_ACQUIRE, "agent");
            xb_add(&bar[XB_XGEN(b.x)], 1u);
            asm volatile("s_waitcnt vmcnt(0)" ::: "memory");
        } else {
            XB_SPIN(xb_ld(&bar[XB_XGEN(b.x)]) == gen, bar);
            __builtin_amdgcn_fence(__ATOMIC_ACQUIRE, "agent");
            asm volatile("s_waitcnt vmcnt(0)" ::: "memory");
        }
    }
    __syncthreads();
}

constexpr size_t MiB = 1u << 20;
constexpr size_t CTL_BAR = 0, CTL_MODI = 16384  , CTL_MOD = CTL_MODI + 2 * 4 * 12288 * 8  , CTL_SSQ = CTL_MOD + 2 * 4 * 12288 * 4  ,
                 CTL_CNT = CTL_SSQ + (size_t)T * 12 * 4  , CTL_CHK = CTL_CNT + 2 * 16 * 256, CTL_ZERO_BYTES = 2 * MiB;
static_assert(CTL_CHK % 8 == 0 && CTL_CHK + 1024 <= CTL_ZERO_BYTES, "ctl");
constexpr size_t WS_W_IN0 = 2 * MiB, WS_W_UQ = WS_W_IN0 + 8 * MiB, WS_W_UKV = WS_W_UQ + 1536 * 512 * 2, WS_W_GLU = WS_W_UKV + 2048 * 256 * 2, WS_W_OUT0 = WS_W_GLU + 2 * MiB,
                 WS_W_IN1 = WS_W_OUT0 + 8 * MiB, WS_W_OUT1 = WS_W_IN1 + (size_t)9728 * 2048 * 2, WS_W_GU = WS_W_OUT1 + 8 * MiB, WS_W_DN = WS_W_GU + 128 * MiB,
                 WS_W_LORA = WS_W_DN + 64 * MiB, WS_S5BY = WS_W_LORA + (size_t)4608 * 384 * 2, WS_S5BE = WS_S5BY + (size_t)64 * 256 * 384 * 2, WS_ROPE = WS_S5BE + (size_t)64 * 256 * 256 * 2,
                 WS_BIAS = WS_ROPE + 1 * MiB, WS_S5L = WS_BIAS + 16384, WS_H = WS_S5L + 65536;
static_assert(WS_H % 256 == 0, "align");
constexpr size_t WS_W_GU8 = WS_W_GU + 64 * MiB;
constexpr size_t WS_X1 = WS_H + 64 * MiB, WS_ARENA = WS_X1 + 128 * MiB;
constexpr size_t A_QC = WS_ARENA, A_KVC = A_QC + 16 * MiB, A_KR = A_KVC + 8 * MiB, A_XH = A_KR + 2 * MiB, A_ES = A_XH + 48 * MiB, A_Q = A_ES + 32 * MiB, A_KF = A_Q + 48 * MiB,
                 A_V = A_KF + 48 * MiB, A_YS5 = A_V + 32 * MiB;
constexpr size_t A_XPRE = WS_ARENA, A_RT = WS_ARENA + 128 * MiB, A_TOKL = A_RT + 1 * MiB, A_ACT = WS_ARENA, A_YS = WS_ARENA + 130 * MiB;
constexpr int MOE_ROWS = 2 * T + 16 * 256;
constexpr size_t A_ZD = WS_ARENA, A_ZR = A_ZD + 144 * MiB, A_LIN = A_ZR + 156 * MiB, A_WDEC = A_LIN + 12 * MiB, A_AA = A_WDEC + 48 * MiB, A_GG = A_AA + 48 * MiB,
                 A_DPO = A_GG + 48 * MiB, A_DPM = A_DPO + 48 * MiB, A_DPL = A_DPM + 2 * MiB, A_BSG = A_DPL + 2 * MiB  , A_YR = WS_ARENA  , A_GST = A_BSG + 2 * MiB  , WS_END = A_GST + 2 * MiB;
static_assert(A_YS + (size_t)MOE_ROWS * 2048 * 2 <= WS_END && A_YS5 + 32 * MiB <= WS_END && WS_END <= 1024 * MiB, "ws map");

constexpr int RING_BYTES = 131072, LDS_TAB = RING_BYTES, LDS_MISC = RING_BYTES + 1024, LDS_BYTES = 151552;

struct KArgs { const float* in[41]; float* out; unsigned char* ws; int ph_lo, ph_hi; };
enum { I_X = 0, I_C, I_ADAW, I_ADAB, I_LNMG, I_LNMB, I_LNFG, I_LNFB, I_RW, I_RB, I_WGU, I_WDN, I_RELB, I_EVIN, I_QN, I_WUQ, I_KVN, I_WUKV, I_LRE, I_LIM, I_BRE, I_BIM, I_CRE, I_CIM,
       I_S5D, I_LOGDT, I_WGLU, I_EVOUT, I_ODIN, I_MU, I_W0, I_W2, I_A0, I_A2, I_G2, I_KK, I_KA, I_RK, I_LNXG, I_LNXB, I_ODOUT };

DI int ropeperm(int c) { return ((c >> 2) & 1) * 32 + (c >> 3) * 4 + (c & 3); }
DI int srccol(int map, int n) {
    switch (map) {
        case 1: if (n < 768) return n; if (n < 1792) return 832 + (n - 768); if (n < 1856) return 768 + ropeperm(n - 1792); return -1;
        case 2: { const int h = n / 192, j = n % 192; return j < 128 ? n : h * 192 + 128 + ropeperm(j - 128); }
        case 3: { const int pn = n >> 8, half = (n >> 7) & 1, idx = n & 127; return half * 512 + pn * 128 + idx; }
        case 4: return n < ODD_IN ? n : -1;
        default: return n;
    }
}
struct ConvJob { const float* src; bf16* dst; const float* kscale; int ldsrc, K, Nd, nmat, map, kbeg, kend, f8; size_t smat, dmat; };
DI void conv_item(const ConvJob& J, LAS unsigned char* scr, int item, int lane) {
    const int nblk = J.Nd / 64, per = (J.K / 64) * nblk, mat = item / per, r = item % per, kb = r / nblk, nb = r % nblk, k0 = 64 * kb, n0 = 64 * nb;
    const float* W = J.src + (size_t)mat * J.smat; bf16* WT = J.f8 ? (bf16*)((unsigned char*)J.dst + (size_t)mat * J.dmat) : J.dst + (size_t)mat * J.dmat;
    const int kq = lane >> 4, nq = lane & 15, sc = srccol(J.map, n0 + 4 * nq);
    f32x4 v[16];
#pragma unroll
    for (int i = 0; i < 16; ++i) { const int kg = k0 + 4 * i + kq; v[i] = (f32x4){0.f, 0.f, 0.f, 0.f};
        if (sc >= 0 && kg >= J.kbeg && kg < J.kend) { v[i] = __builtin_nontemporal_load((const f32x4*)(W + (size_t)(kg - J.kbeg) * J.ldsrc + sc));        if (J.kscale) v[i] *= J.kscale[kg]; } }
#pragma unroll
    for (int i = 0; i < 16; ++i) { LAS bf16* t = (LAS bf16*)(scr + (4 * nq) * 132 + (4 * i + kq) * 2); const unsigned p0 = pk2(v[i].x, v[i].y), p1 = pk2(v[i].z, v[i].w);
        t[0] = (bf16)(p0 & 0xffffu); t[66] = (bf16)(p0 >> 16); t[132] = (bf16)(p1 & 0xffffu); t[198] = (bf16)(p1 >> 16); }
    asm volatile("s_waitcnt lgkmcnt(0)" ::: "memory");
#pragma unroll
    for (int q = 0; q < 8; ++q) { const int id = lane + 64 * q, n = id >> 3, c = id & 7; const LAS unsigned* t = (const LAS unsigned*)(scr + n * 132 + c * 16);
        u32x4 o = {t[0], t[1], t[2], t[3]};
        if (J.f8) { u32x2 o8 = {pk4_fp8(bflo(o.x) * F8_WSCALE, bfhi(o.x) * F8_WSCALE, bflo(o.y) * F8_WSCALE, bfhi(o.y) * F8_WSCALE), pk4_fp8(bflo(o.z) * F8_WSCALE, bfhi(o.z) * F8_WSCALE, bflo(o.w) * F8_WSCALE, bfhi(o.w) * F8_WSCALE)};
            *(u32x2*)((unsigned char*)WT + (size_t)(n0 + n) * J.K + k0 + 8 * c) = o8; }
        else *(u32x4*)(WT + (size_t)(n0 + n) * J.K + k0 + 8 * c) = o; }
    asm volatile("s_waitcnt lgkmcnt(0)" ::: "memory");
}
DI ConvJob conv_job(const KArgs& a, int j) {
    unsigned char* ws = a.ws; ConvJob J; J.kscale = nullptr; J.nmat = 1; J.map = 0; J.smat = 0; J.dmat = 0; J.kbeg = 0; J.kend = 1 << 30; J.f8 = 0;
    switch (j) {
        case 0: J.src = a.in[I_EVIN]; J.dst = (bf16*)(ws + WS_W_IN0); J.f8 = 1; J.ldsrc = EVEN_IN; J.K = 2048; J.Nd = 2048; J.map = 1; break;
        case 1: J.src = a.in[I_WUQ]; J.dst = (bf16*)(ws + WS_W_UQ); J.ldsrc = 1536; J.K = 512; J.Nd = 1536; J.map = 2; J.kscale = a.in[I_QN]; break;
        case 2: J.src = a.in[I_WUKV]; J.dst = (bf16*)(ws + WS_W_UKV); J.ldsrc = 2048; J.K = 256; J.Nd = 2048; J.kscale = a.in[I_KVN]; break;
        case 3: J.src = a.in[I_WGLU]; J.dst = (bf16*)(ws + WS_W_GLU); J.ldsrc = 1024; J.K = 1024; J.Nd = 1024; break;
        case 4: J.src = a.in[I_EVOUT]; J.dst = (bf16*)(ws + WS_W_OUT0); J.f8 = 1; J.ldsrc = 2048; J.K = 2048; J.Nd = 2048; break;
        case 5: J.src = a.in[I_ODIN]; J.dst = (bf16*)(ws + WS_W_IN1); J.f8 = 1; J.ldsrc = ODD_IN; J.K = 2048; J.Nd = 9728; J.map = 4; break;
        case 6: J.src = a.in[I_ODOUT]; J.dst = (bf16*)(ws + WS_W_OUT1); J.f8 = 1; J.ldsrc = 2048; J.K = 2048; J.Nd = 2048; break;
        case 7: J.src = a.in[I_WGU]; J.dst = (bf16*)(ws + WS_W_GU8); J.f8 = 1; J.ldsrc = 1024; J.K = 2048; J.Nd = 1024; J.map = 3; J.nmat = 32; J.smat = (size_t)2048 * 1024; J.dmat = (size_t)1024 * 2048; break;
        case 8: J.src = a.in[I_WDN]; J.dst = (bf16*)(ws + WS_W_DN); J.f8 = 1; J.ldsrc = 2048; J.K = 512; J.Nd = 2048; J.nmat = 32; J.smat = (size_t)512 * 2048; J.dmat = (size_t)2048 * 512; break;
        case 9: J.src = a.in[I_W2]; J.dst = (bf16*)(ws + WS_W_LORA); J.ldsrc = 1536; J.K = 384; J.Nd = 1536; J.kbeg = 0; J.kend = 64; break;
        case 10: J.src = a.in[I_A2]; J.dst = (bf16*)(ws + WS_W_LORA) + (size_t)1536 * 384; J.ldsrc = 1536; J.K = 384; J.Nd = 1536; J.kbeg = 64; J.kend = 128; break;
        default: J.src = a.in[I_G2]; J.dst = (bf16*)(ws + WS_W_LORA) + (size_t)3072 * 384; J.ldsrc = 1536; J.K = 384; J.Nd = 1536; J.kbeg = 128; J.kend = 352; break;
    }
    return J;
}
constexpr int N_CONV_JOBS = 12;

DI void s5_precompute(const KArgs& a, LAS unsigned char* lds, int g, int wv) {
    LAS float* PW = (LAS float*)lds; LAS float* BB = PW + 17 * 64 * 2; LAS float* CC = BB + 64 * 16 * 2; LAS float* KK = CC + 16 * 64 * 2;
    const int tid = otid(wv);
    const float dt = expf(a.in[I_LOGDT][g]);
    for (int idx = tid; idx < 17 * 64; idx += 512) { const int d = idx / 64, p = idx % 64; const float lre = a.in[I_LRE][g * 64 + p], lim = a.in[I_LIM][g * 64 + p];
        const float mag = expf(lre * dt * (float)d); float sn, cs; sincosf(lim * dt * (float)d, &sn, &cs); PW[idx * 2] = mag * cs; PW[idx * 2 + 1] = mag * sn;
        if (d == 16) { float* L = (float*)(a.ws + WS_S5L); L[(g * 64 + p) * 2] = mag * cs; L[(g * 64 + p) * 2 + 1] = mag * sn; } }
    for (int idx = tid; idx < 64 * 16; idx += 512) { const int p = idx / 16, c = idx % 16; const float lre = a.in[I_LRE][g * 64 + p], lim = a.in[I_LIM][g * 64 + p];
        float sn, cs; sincosf(lim * dt, &sn, &cs); const float mag = expf(lre * dt), sh = sinf(0.5f * lim * dt);
        const float nr = expm1f(lre * dt) * cs - 2.f * sh * sh, ni = mag * sn, den = 1.f / (lre * lre + lim * lim);
        const float cr = (nr * lre + ni * lim) * den, ci = (ni * lre - nr * lim) * den;
        const float br = a.in[I_BRE][(g * 64 + p) * 16 + c], bi = a.in[I_BIM][(g * 64 + p) * 16 + c];
        BB[idx * 2] = cr * br - ci * bi; BB[idx * 2 + 1] = cr * bi + ci * br; }
    for (int idx = tid; idx < 16 * 64; idx += 512) { CC[idx * 2] = a.in[I_CRE][g * 1024 + idx]; CC[idx * 2 + 1] = a.in[I_CIM][g * 1024 + idx]; }
    __syncthreads();
    for (int idx = tid; idx < 4096; idx += 512) { const int d = idx >> 8, c = (idx >> 4) & 15, cp = idx & 15; float s = 0.f;
        for (int p = 0; p < 64; ++p) { const float cr = CC[(c * 64 + p) * 2], ci = CC[(c * 64 + p) * 2 + 1], pr = PW[(d * 64 + p) * 2], pi = PW[(d * 64 + p) * 2 + 1];
            const float xr = cr * pr - ci * pi, xi = cr * pi + ci * pr; s += xr * BB[(p * 16 + cp) * 2] - xi * BB[(p * 16 + cp) * 2 + 1]; }
        KK[idx] = s; }
    __syncthreads();
    bf16* BY = (bf16*)(a.ws + WS_S5BY) + (size_t)g * 256 * 384; bf16* BE = (bf16*)(a.ws + WS_S5BE) + (size_t)g * 256 * 256;
    for (int idx = tid; idx < 256 * 48; idx += 512) { const int row = idx / 48, col0 = (idx % 48) * 8, t = row >> 4, c = row & 15; float v[8];
        if (col0 < 256) { const int s = col0 >> 4, c0 = col0 & 15;
#pragma unroll
            for (int j = 0; j < 8; ++j) v[j] = (s <= t) ? KK[((t - s) << 8) + (c << 4) + c0 + j] : 0.f; }
        else { const int pp = col0 - 256; const bool im = pp >= 64; const int p0 = im ? pp - 64 : pp;
#pragma unroll
            for (int j = 0; j < 8; ++j) { const int p = p0 + j; const float cr = CC[(c * 64 + p) * 2], ci = CC[(c * 64 + p) * 2 + 1], pr = PW[((t + 1) * 64 + p) * 2], pi = PW[((t + 1) * 64 + p) * 2 + 1];
                v[j] = im ? -(cr * pi + ci * pr) : (cr * pr - ci * pi); } }
        u32x4 o = {pk2(v[0], v[1]), pk2(v[2], v[3]), pk2(v[4], v[5]), pk2(v[6], v[7])}; *(u32x4*)(BY + (size_t)row * 384 + col0) = o; }
    for (int idx = tid; idx < 256 * 32; idx += 512) { const int row = idx / 32, col0 = (idx % 32) * 8, s = col0 >> 4, c0 = col0 & 15; float v[8];
#pragma unroll
        for (int j = 0; j < 8; ++j) { if (row < 128) { const int p = row & 63; const float pr = PW[((15 - s) * 64 + p) * 2], pi = PW[((15 - s) * 64 + p) * 2 + 1], br = BB[(p * 16 + c0 + j) * 2], bi = BB[(p * 16 + c0 + j) * 2 + 1];
                v[j] = row < 64 ? (pr * br - pi * bi) : (pr * bi + pi * br); } else v[j] = 0.f; }
        u32x4 o = {pk2(v[0], v[1]), pk2(v[2], v[3]), pk2(v[4], v[5]), pk2(v[6], v[7])}; *(u32x4*)(BE + (size_t)row * 256 + col0) = o; }
    __syncthreads();
}

DI int t5_bucket(int dist) { if (dist < 16) return dist; const float logd = logf((float)dist / 16.f) / logf(128.f); int lg = 16 + (int)(logd * 16.f); return lg < 31 ? lg : 31; }

DI void p0_prologue(const KArgs& a, LAS unsigned char* lds, int wv) {
    const int tid = otid(wv), lane = tid & 63, wave = tid >> 6, G = gridDim.x, gw = blockIdx.x * 8 + wave, NGW = G * 8;
    LAS float* cond = (LAS float*)(lds + 98304);
    for (int i = tid; i < 4 * 2048; i += 512) { const float c = a.in[I_C][i]; cond[i] = c / (1.f + expf(-c)); }
    if (blockIdx.x < 64) s5_precompute(a, lds, blockIdx.x, wv); else __syncthreads();
    unsigned long long* MODI = (unsigned long long*)(a.ws + CTL_MODI);
    for (int it = gw; it < 2 * 48 * 16; it += NGW) { const int l = it / 768, cc = (it % 768) / 16, kc = it % 16, col = cc * 256 + lane * 4;
        const float* W = a.in[I_ADAW] + ((size_t)l * 2048 + kc * 128) * 12288 + col;
        f32x4 acc[4]; for (int b = 0; b < 4; ++b) acc[b] = (f32x4){0.f, 0.f, 0.f, 0.f};
#pragma unroll 8
        for (int k = 0; k < 128; ++k) { const f32x4 w = __builtin_nontemporal_load((const f32x4*)(W + (size_t)k * 12288));
#pragma unroll
            for (int b = 0; b < 4; ++b) acc[b] += w * cond[b * 2048 + kc * 128 + k]; }
        if (kc == 0) { const f32x4 bb = *(const f32x4*)(a.in[I_ADAB] + l * 12288 + col); for (int b = 0; b < 4; ++b) acc[b] += bb; }
#pragma unroll
        for (int b = 0; b < 4; ++b) { unsigned long long* o = MODI + (size_t)(l * 4 + b) * 12288 + col;
#pragma unroll
            for (int e = 0; e < 4; ++e) atomicAdd(o + e, (unsigned long long)__double2ll_rn((double)acc[b][e] * 1099511627776.0)); } }
    LAS unsigned char* scr = lds + wave * 8704;
    int base = 0;
    for (int j = 0; j < N_CONV_JOBS; ++j) { const ConvJob J = conv_job(a, j); const int nit = J.nmat * (J.K / 64) * (J.Nd / 64);
        for (int it = ((gw - base) % NGW + NGW) % NGW; it < nit; it += NGW) conv_item(J, scr, it, lane);
        base += nit; }
    { float* RC = (float*)(a.ws + WS_ROPE); float* RS = RC + 4096 * 32; const int gt = blockIdx.x * 512 + tid;
      for (int i = gt; i < 4096 * 32; i += G * 512) { const int pos = i >> 5, j = i & 31; const float inv = powf(10000.f, -(float)(2 * j) / 64.f); float sn, cs; sincosf((float)pos * inv, &sn, &cs); RC[i] = cs; RS[i] = sn; }
      float* BL = (float*)(a.ws + WS_BIAS);
      for (int i = gt; i < 3 * 8 * 132; i += G * 512) { const int gi = i / (8 * 132), h = (i / 132) % 8, dl = i % 132; const int dil = gi == 0 ? 1 : (gi == 1 ? 4 : 16);
          BL[i] = dl <= 128 ? a.in[I_RELB][t5_bucket(dl * dil) * 24 + gi * 8 + h] * 1.44269504089f : 0.f; } }
}

DI float modi2f(unsigned long long v) { return fmaf((float)(unsigned)v, 0x1p-40f, (float)(int)(v >> 32) * 0x1p-8f); }
DI void modulate_rows(const float* x, const unsigned long long* MODI, float* MODF, bf16* H, LAS unsigned char* lds, int wv) {
    const int tid = otid(wv), lane = tid & 63, wave = tid >> 6, gw = blockIdx.x * 8 + wave, NGW = gridDim.x * 8;
    for (int i = gw * 64 + lane; i < 2 * 4 * 12288; i += NGW * 64) MODF[i] = modi2f(MODI[i]);
    LAS float* vec = (LAS float*)lds;
    for (int rg = blockIdx.x; rg < T / 64; rg += gridDim.x) { const int b = (rg * 64) / SEQ; const unsigned long long* sh = MODI + (size_t)b * 12288; const unsigned long long* sc = sh + 2048;
        __syncthreads();
        { const int c4 = tid * 4; const f32x4 s1 = {modi2f(sc[c4]), modi2f(sc[c4 + 1]), modi2f(sc[c4 + 2]), modi2f(sc[c4 + 3])}, s0 = {modi2f(sh[c4]), modi2f(sh[c4 + 1]), modi2f(sh[c4 + 2]), modi2f(sh[c4 + 3])};
          *(LAS f32x4*)(vec + c4) = s0; *(LAS f32x4*)(vec + 2048 + c4) = s1 + 1.f; }
        __syncthreads();
        for (int m = rg * 64 + wave; m < rg * 64 + 64; m += 8) {
#pragma unroll
        for (int j = 0; j < 8; ++j) { const int col = (lane + 64 * j) * 4; const f32x4 v = __builtin_nontemporal_load((const f32x4*)(x + (size_t)m * D + col));
            const f32x4 h = v * *(LAS f32x4*)(vec + 2048 + col) + *(LAS f32x4*)(vec + col); *(unsigned*)((unsigned char*)H + (size_t)m * D + col) = pk4_fp8(h.x, h.y, h.z, h.w); } } }
}

using pg8::Unit;
#define P32(ptr, elemoff) ((decltype(ptr))((char*)(ptr) + (unsigned)((unsigned)(elemoff) * (unsigned)sizeof(*(ptr)))))
typedef f32x4 Acc[2][2][4][2];
#define EPI_ROWS_BEGIN const int row0 = u.pm * 256 + wr * 64 + fr; _Pragma("unroll") for (int ai = 0; ai < 2; ++ai) _Pragma("unroll") for (int m = 0; m < 4; ++m) { const int row = row0 + ai * 128 + m * 16;
#define EPI_ROWS_END __builtin_amdgcn_sched_barrier(0); }
DI u32x4 pack8(const f32x4& v0, const f32x4& v1) { u32x4 o = {pk2(v0.x, v0.y), pk2(v0.z, v0.w), pk2(v1.x, v1.y), pk2(v1.z, v1.w)}; return o; }

struct EpiIn0 { static constexpr bool PERM = true;
    bf16 *QC, *KVC, *KR, *XH; float *ssq;
    DI void operator()(const Acc& acc, const Unit& u, int wr, int wc, int fr, int fq) const {
        EPI_ROWS_BEGIN
            float ss = 0.f;
#pragma unroll
            for (int bj = 0; bj < 2; ++bj) { const f32x4 v0 = acc[ai][bj][m][0], v1 = acc[ai][bj][m][1]; const int col = 128 * bj + 32 * wc + 8 * fq; const u32x4 o = pack8(v0, v1);
                if (u.pn < 2) { *(u32x4*)P32(QC, row * 512 + u.pn * 256 + col) = o; ss += v0.x * v0.x + v0.y * v0.y + v0.z * v0.z + v0.w * v0.w + v1.x * v1.x + v1.y * v1.y + v1.z * v1.z + v1.w * v1.w; }
                else if (u.pn == 2) { *(u32x4*)P32(KVC, row * 256 + col) = o; ss += v0.x * v0.x + v0.y * v0.y + v0.z * v0.z + v0.w * v0.w + v1.x * v1.x + v1.y * v1.y + v1.z * v1.z + v1.w * v1.w; }
                else if (u.pn < 7) { const int uc = (u.pn - 3) * 256 + col, g = uc >> 4; *(u32x4*)P32(XH, (g * 1024 + (row >> 4)) * 384 + (row & 15) * 16 + (uc & 15)) = o; }
                else if (col < 64) { *(u32x4*)P32(KR, row * 64 + col) = o; } }
            if (u.pn <= 2) { ss += __shfl_xor(ss, 16); ss += __shfl_xor(ss, 32); if (fq == 0) *P32(ssq, row * 12 + u.pn * 4 + wc) = ss; }
        EPI_ROWS_END
    }
};
struct EpiQ { static constexpr bool PERM = true;
    bf16* Q; const float* ssq; const float* rope;
    DI void operator()(const Acc& acc, const Unit& u, int wr, int wc, int fr, int fq) const {
        EPI_ROWS_BEGIN
            const f32x4 q0 = *(const f32x4*)P32(ssq, row * 12), q1 = *(const f32x4*)P32(ssq, row * 12 + 4);
            const float rs = __builtin_amdgcn_rsqf((((q0.x + q0.y) + (q0.z + q0.w)) + ((q1.x + q1.y) + (q1.z + q1.w))) * (1.f / 512.f) + RMS_EPS) * (0.07216878364870322f * 1.44269504089f);
            const int b = row / SEQ, s = row % SEQ;
#pragma unroll
            for (int bj = 0; bj < 2; ++bj) { f32x4 v0 = acc[ai][bj][m][0] * rs, v1 = acc[ai][bj][m][1] * rs; const int n = u.pn * 256 + 128 * bj + 32 * wc + 8 * fq, h = n / 192, j = n % 192;
                if (j >= 128) { const int q = (j - 128) >> 3; const f32x4 cs = *(const f32x4*)P32(rope, s * 32 + 4 * q), sn = *(const f32x4*)P32(rope, 4096 * 32 + s * 32 + 4 * q);
                    const f32x4 x1 = v0, x2 = v1; v0 = x1 * cs - x2 * sn; v1 = x1 * sn + x2 * cs; }
                *(u32x4*)P32(Q, ((b * 8 + h) * SEQ + s) * 192 + j) = pack8(v0, v1); }
        EPI_ROWS_END
    }
};
struct EpiKV { static constexpr bool PERM = true;
    bf16 *KF, *V; const float* ssq;
    DI void operator()(const Acc& acc, const Unit& u, int wr, int wc, int fr, int fq) const {
        EPI_ROWS_BEGIN
            const f32x4 q2 = *(const f32x4*)P32(ssq, row * 12 + 8); const float rs = __builtin_amdgcn_rsqf(((q2.x + q2.y) + (q2.z + q2.w)) * (1.f / 256.f) + RMS_EPS); const int b = row / SEQ, s = row % SEQ, h = u.pn, j = 32 * wc + 8 * fq; const int tok = (b * 8 + h) * SEQ + s;
            *(u32x4*)P32(KF, tok * 192 + j) = pack8(acc[ai][0][m][0] * rs, acc[ai][0][m][1] * rs);
            *(u32x4*)P32(V, tok * 128 + j) = pack8(acc[ai][1][m][0] * rs, acc[ai][1][m][1] * rs);
        EPI_ROWS_END
    }
};
struct S5Order { int G, c;
    DI bool next(int i, Unit& u) const { int L = i * G + c; if (L >= 256) return false;
        if (G == 256) L = ((c & 7) << 5) | (c >> 3);
        u.pm = L; u.pn = L >> 2; u.aux = 0; return true; }
    DI int arow(const Unit&, int) const { return 0; }
    DI int koff(const Unit&) const { return 0; } };
struct EpiS5E { static constexpr bool PERM = false;
    float* ES;
    DI void operator()(const Acc& acc, const Unit& u, int wr, int wc, int fr, int fq) const {
        EPI_ROWS_BEGIN
#pragma unroll
            for (int n = 0; n < 2; ++n) *(f32x4*)P32(ES, row * 128 + 32 * wc + 16 * n + 4 * fq) = acc[ai][0][m][n];
        EPI_ROWS_END
    }
};
DI float gelu_tanh(float x) { const float t = 0.7978845608028654f * (x + 0.044715f * x * x * x); const float e = __expf(2.f * t); return 0.5f * x * (1.f + (1.f - 2.f * __builtin_amdgcn_rcpf(e + 1.f))); }
struct EpiS5Y { static constexpr bool PERM = true;
    bf16* YS5; const bf16* XH; const float* dsk;
    DI void operator()(const Acc& acc, const Unit& u, int wr, int wc, int fr, int fq) const {
        EPI_ROWS_BEGIN
            const int g = row >> 10, chunk = row & 1023;
#pragma unroll
            for (int bj = 0; bj < 2; ++bj) { const int col = 128 * bj + 32 * wc + 8 * fq, tl = col >> 4, c0 = col & 15; const u32x4 uu = *(const u32x4*)P32(XH, row * 384 + col);
                const f32x4 d0 = *(const f32x4*)P32(dsk, g * 16 + c0), d1 = *(const f32x4*)P32(dsk, g * 16 + c0 + 4); const f32x4 a0 = acc[ai][bj][m][0], a1 = acc[ai][bj][m][1];
                f32x4 y0 = {a0.x + d0.x * bflo(uu.x), a0.y + d0.y * bfhi(uu.x), a0.z + d0.z * bflo(uu.y), a0.w + d0.w * bfhi(uu.y)};
                f32x4 y1 = {a1.x + d1.x * bflo(uu.z), a1.y + d1.y * bfhi(uu.z), a1.z + d1.z * bflo(uu.w), a1.w + d1.w * bfhi(uu.w)};
#pragma unroll
                for (int e = 0; e < 4; ++e) { y0[e] = gelu_tanh(y0[e]); y1[e] = gelu_tanh(y1[e]); }
                *(u32x4*)P32(YS5, (chunk * 16 + tl) * 1024 + g * 16 + c0) = pack8(y0, y1); }
        EPI_ROWS_END
    }
};
struct EpiGlu { static constexpr bool PERM = true;
    bf16* MIX; const bf16* YS5;
    DI void operator()(const Acc& acc, const Unit& u, int wr, int wc, int fr, int fq) const {
        EPI_ROWS_BEGIN
#pragma unroll
            for (int bj = 0; bj < 2; ++bj) { const int col = u.pn * 256 + 128 * bj + 32 * wc + 8 * fq; const u32x4 yy = *(const u32x4*)P32(YS5, row * 1024 + col); const f32x4 a0 = acc[ai][bj][m][0], a1 = acc[ai][bj][m][1];
                const f32x4 o0 = {bflo(yy.x) * sigmoidf_(a0.x), bfhi(yy.x) * sigmoidf_(a0.y), bflo(yy.y) * sigmoidf_(a0.z), bfhi(yy.y) * sigmoidf_(a0.w)};
                const f32x4 o1 = {bflo(yy.z) * sigmoidf_(a1.x), bfhi(yy.z) * sigmoidf_(a1.y), bflo(yy.w) * sigmoidf_(a1.z), bfhi(yy.w) * sigmoidf_(a1.w)};
                { unsigned char* mx = (unsigned char*)MIX; u32x2 o8 = {pk4_fp8(o0.x, o0.y, o0.z, o0.w), pk4_fp8(o1.x, o1.y, o1.z, o1.w)}; *(u32x2*)P32(mx, row * 2048 + 1024 + col) = o8; } }
        EPI_ROWS_END
    }
};
template <bool XBF> struct EpiRes { static constexpr bool PERM = true;
    bf16* XPRE; const void* xres; const float* gate;
    DI void operator()(const Acc& acc, const Unit& u, int wr, int wc, int fr, int fq) const {
        EPI_ROWS_BEGIN
            const int b = row / SEQ;
#pragma unroll
            for (int bj = 0; bj < 2; ++bj) { const int col = u.pn * 256 + 128 * bj + 32 * wc + 8 * fq;
                f32x4 x0, x1;
                if (XBF) { const bf16* xb = (const bf16*)xres; const u32x4 xq = *(const u32x4*)P32(xb, row * D + col); x0 = (f32x4){bflo(xq.x), bfhi(xq.x), bflo(xq.y), bfhi(xq.y)}; x1 = (f32x4){bflo(xq.z), bfhi(xq.z), bflo(xq.w), bfhi(xq.w)}; }
                else { const float* xf = (const float*)xres; x0 = *(const f32x4*)P32(xf, row * D + col); x1 = *(const f32x4*)P32(xf, row * D + col + 4); }
                const f32x4 g0 = *(const f32x4*)P32(gate, b * 12288 + col), g1 = *(const f32x4*)P32(gate, b * 12288 + col + 4);
                *(u32x4*)P32(XPRE, row * D + col) = pack8(x0 * DN_ALPHA + (g0 + 1.f) * acc[ai][bj][m][0], x1 * DN_ALPHA + (g1 + 1.f) * acc[ai][bj][m][1]); }
        EPI_ROWS_END
    }
};

DI void krope_pass(const bf16* KR, const float* rope, bf16* KF, int wv) {
    const int gt = blockIdx.x * 512 + otid(wv), NT_ = gridDim.x * 512;
    for (int i = gt; i < T * 8; i += NT_) { const int row = i >> 3, q = i & 7, b = row / SEQ, s = row % SEQ; const u32x4 r = *(const u32x4*)(KR + (size_t)row * 64 + q * 8);
        const f32x4 x1 = {bflo(r.x), bfhi(r.x), bflo(r.y), bfhi(r.y)}, x2 = {bflo(r.z), bfhi(r.z), bflo(r.w), bfhi(r.w)};
        const f32x4 cs = *(const f32x4*)(rope + s * 32 + 4 * q), sn = *(const f32x4*)(rope + 4096 * 32 + s * 32 + 4 * q);
        const u32x4 o = pack8(x1 * cs - x2 * sn, x1 * sn + x2 * cs);
#pragma unroll
        for (int h = 0; h < 8; ++h) *(u32x4*)(KF + ((size_t)(b * 8 + h) * SEQ + s) * 192 + 128 + q * 8) = o; }
}
DI void s5_carry(const float* ES, const float* L16, bf16* XH, LAS unsigned char* lds, int wv) {
    const int tid = otid(wv), lane = tid & 63, w = tid >> 6; LAS float* SEG = (LAS float*)lds;
    for (int base = blockIdx.x * 64; base < 4 * 64 * 64; base += gridDim.x * 64) {
        const int gt = base + lane, p = gt & 63, g = (gt >> 6) & 63, b = gt >> 12; const float lr = L16[(g * 64 + p) * 2], li = L16[(g * 64 + p) * 2 + 1];
        const size_t r0 = (size_t)g * 1024 + b * 256 + 32 * w;
        float hr = 0.f, hi = 0.f;
#pragma unroll 16
        for (int k = 0; k < 32; ++k) { const float er = ES[(r0 + k) * 128 + p], ei = ES[(r0 + k) * 128 + 64 + p]; const float nr = lr * hr - li * hi + er, ni = lr * hi + li * hr + ei; hr = nr; hi = ni; }
        __syncthreads();
        SEG[(w * 64 + lane) * 2] = hr; SEG[(w * 64 + lane) * 2 + 1] = hi;
        float pr = lr, pi = li;
#pragma unroll
        for (int q = 0; q < 5; ++q) { const float nr = pr * pr - pi * pi, ni = 2.f * pr * pi; pr = nr; pi = ni; }
        __syncthreads();
        hr = 0.f; hi = 0.f;
        for (int u = 0; u < w; ++u) { const float er = SEG[(u * 64 + lane) * 2], ei = SEG[(u * 64 + lane) * 2 + 1]; const float nr = pr * hr - pi * hi + er, ni = pr * hi + pi * hr + ei; hr = nr; hi = ni; }
#pragma unroll 16
        for (int k = 0; k < 32; ++k) { const float er = ES[(r0 + k) * 128 + p], ei = ES[(r0 + k) * 128 + 64 + p];
            XH[(r0 + k) * 384 + 256 + p] = f2bf(hr); XH[(r0 + k) * 384 + 320 + p] = f2bf(hi);
            const float nr = lr * hr - li * hi + er, ni = lr * hi + li * hr + ei; hr = nr; hi = ni; }
    }
    __syncthreads();
}

#define MFMA32(a, b, c) __builtin_amdgcn_mfma_f32_32x32x16_bf16((a), (b), (c), 0, 0, 0)
constexpr int AT_KROW = 384, AT_VROW = 256, AT_KBYTES = 64 * AT_KROW, AT_STG = AT_KBYTES + 64 * AT_VROW, AT_NST = 3;
static_assert(AT_NST * AT_STG <= RING_BYTES, "attention LDS");
DI void mla_attn_unit(LAS unsigned char* lds, const bf16* Qg, const bf16* KFg, const bf16* Vg, bf16* MIX, int unit, int wv) {
    const int tid = otid(wv), lane = tid & 63, w = tid >> 6, r = lane & 31, hh = lane >> 5;
    const int b = unit >> 6, h = (unit >> 3) & 7, pi = unit & 7;
    const bf16* Qh = Qg + (size_t)(b * 8 + h) * SEQ * 192; const bf16* Kh = KFg + (size_t)(b * 8 + h) * SEQ * 192; const bf16* Vh = Vg + (size_t)(b * 8 + h) * SEQ * 128;
    const int w_ = __builtin_amdgcn_readfirstlane(w);
    int koff[3], voff[2];
#pragma unroll
    for (int i = 0; i < 3; ++i) { const int p = (3 * w_ + i) * 64 + lane, row = p / 24, cs = p % 24, c = (cs & ~7) | ((cs ^ (row >> 1)) & 7); koff[i] = row * 192 + c * 8; }
#pragma unroll
    for (int i = 0; i < 2; ++i) { const int p = (2 * w_ + i) * 64 + lane, row = p >> 4, cs = p & 15, c = cs ^ ((row & 3) << 2); voff[i] = row * 128 + c * 8; }
    const int kx = (r >> 1) & 7, vq = (lane >> 2) & 3;
    for (int half = 0; half < 2; ++half) {
        const int qb = half ? 15 - pi : pi, q0 = qb * 256 + 32 * w, nkt = (qb + 1) * 4;
        bf16x8 qf[12];
#pragma unroll
        for (int ks = 0; ks < 12; ++ks) qf[ks] = *(const GAS bf16x8*)P32(Qh, (q0 + r) * 192 + 16 * ks + 8 * hh);
        f32x16 O[4];
#pragma unroll
        for (int i = 0; i < 4; ++i) for (int e = 0; e < 16; ++e) O[i][e] = 0.f;
        float mrow = -1e30f, lrow = 0.f;
#define AT_DMA(kt, stg) do { LAS unsigned char* sb_ = lds + (stg) * AT_STG; \
        _Pragma("unroll") for (int i = 0; i < 3; ++i) __builtin_amdgcn_global_load_lds((const unsigned*)P32(Kh, (kt) * 64 * 192 + koff[i]), (LAS unsigned*)(sb_ + (3 * w_ + i) * 1024), 16, 0, 0); \
        _Pragma("unroll") for (int i = 0; i < 2; ++i) __builtin_amdgcn_global_load_lds((const unsigned*)P32(Vh, (kt) * 64 * 128 + voff[i]), (LAS unsigned*)(sb_ + AT_KBYTES + (2 * w_ + i) * 1024), 16, 0, 0); } while (0)
#define AT_BAR() do { asm volatile("s_waitcnt lgkmcnt(0)" ::: "memory"); __builtin_amdgcn_s_barrier(); asm volatile("" ::: "memory"); } while (0)
        __syncthreads();
        AT_DMA(0, 0); AT_DMA(1, 1);
        asm volatile("s_waitcnt vmcnt(5)" ::: "memory");
        AT_BAR();
        int stg = 0;
        for (int kt = 0; kt < nkt; ++kt) {
            if (kt + 2 < nkt) AT_DMA(kt + 2, stg == 0 ? 2 : stg - 1);
            const LAS unsigned char* sb = lds + stg * AT_STG;
            if (kt * 64 <= q0 + 31) {
                f32x16 st[2];
#pragma unroll
                for (int mt = 0; mt < 2; ++mt) for (int e = 0; e < 16; ++e) st[mt][e] = 0.f;
                __builtin_amdgcn_sched_barrier(0);
                {
                    const LAS unsigned char* kb = sb + r * AT_KROW; const LAS unsigned char* kx4[4];
#pragma unroll
                    for (int j = 0; j < 4; ++j) kx4[j] = kb + (((2 * j + hh) ^ kx) & 7) * 16;
                    bf16x8 kf[24];
#pragma unroll
                    for (int i = 0; i < 24; ++i) kf[i] = *(const LAS bf16x8*)(kx4[(i >> 1) & 3] + 32 * (i & 1) * AT_KROW + 128 * (i >> 3));
#pragma unroll
                    for (int i = 0; i < 24; ++i) st[i & 1] = MFMA32(kf[i], qf[i >> 1], st[i & 1]);
                    __builtin_amdgcn_sched_group_barrier(0x100, 4, 0);
#pragma unroll
                    for (int i = 0; i < 24; ++i) { __builtin_amdgcn_sched_group_barrier(0x008, 1, 0); __builtin_amdgcn_sched_group_barrier(0x100, 1, 0); }
                }
                __builtin_amdgcn_sched_barrier(0);
                if (kt * 64 + 63 > q0) {
                    const int qg = q0 + r;
#pragma unroll
                    for (int mt = 0; mt < 2; ++mt)
#pragma unroll
                        for (int e = 0; e < 16; ++e) { const int kg = kt * 64 + 32 * mt + (e & 3) + 8 * (e >> 2) + 4 * hh; if (kg > qg) st[mt][e] = -1e30f; }
                }
                float mx = st[0][0];
#pragma unroll
                for (int mt = 0; mt < 2; ++mt)
#pragma unroll
                    for (int e = 0; e < 16; ++e) mx = fmaxf(mx, st[mt][e]);
                { const unsigned xi_ = __float_as_uint(mx); const auto rr_ = __builtin_amdgcn_permlane32_swap(xi_, xi_, false, false); mx = fmaxf(__uint_as_float(rr_[0]), __uint_as_float(rr_[1])); }
                float alpha = 1.f;
                if (__any(mx - mrow > 8.f)) { const float mnew = fmaxf(mrow, mx); alpha = __builtin_amdgcn_exp2f(mrow - mnew); mrow = mnew;
#pragma unroll
                    for (int i = 0; i < 4; ++i) O[i] *= alpha; }
                float ls = 0.f;
#pragma unroll
                for (int mt = 0; mt < 2; ++mt)
#pragma unroll
                    for (int e = 0; e < 16; ++e) { const float p = __builtin_amdgcn_exp2f(st[mt][e] - mrow); st[mt][e] = p; ls += p; }
                lrow = lrow * alpha + ls;
                bf16x8 pf[2][2];
#pragma unroll
                for (int mt = 0; mt < 2; ++mt)
#pragma unroll
                    for (int s = 0; s < 2; ++s) { u32x4 pk = {pk2(st[mt][8 * s], st[mt][8 * s + 1]), pk2(st[mt][8 * s + 2], st[mt][8 * s + 3]), pk2(st[mt][8 * s + 4], st[mt][8 * s + 5]), pk2(st[mt][8 * s + 6], st[mt][8 * s + 7])};
                        pf[mt][s] = __builtin_bit_cast(bf16x8, pk); }
                __builtin_amdgcn_sched_barrier(0);
                {
                    const LAS unsigned char* vb = sb + AT_KBYTES + (4 * hh + vq) * AT_VROW + 32 * ((lane >> 4) & 1) + 8 * (lane & 3); const LAS unsigned char* vx4[4];
#pragma unroll
                    for (int d = 0; d < 4; ++d) vx4[d] = vb + ((d ^ vq) & 3) * 64;
                    bf16x8 af[16];
#pragma unroll
                    for (int i = 0; i < 16; ++i) { const LAS unsigned char* vp = vx4[i & 3] + 16 * (i >> 2) * AT_VROW;
                        const s16x4 lo = __builtin_amdgcn_ds_read_tr16_b64_v4i16((LAS s16x4*)vp), hi = __builtin_amdgcn_ds_read_tr16_b64_v4i16((LAS s16x4*)(vp + 8 * AT_VROW)); af[i] = __builtin_shufflevector(lo, hi, 0, 1, 2, 3, 4, 5, 6, 7); }
#pragma unroll
                    for (int i = 0; i < 16; ++i) O[i & 3] = MFMA32(af[i], pf[i >> 3][(i >> 2) & 1], O[i & 3]);
                    __builtin_amdgcn_sched_group_barrier(0x100, 8, 0);
#pragma unroll
                    for (int i = 0; i < 16; ++i) { __builtin_amdgcn_sched_group_barrier(0x008, 1, 0); __builtin_amdgcn_sched_group_barrier(0x100, 2, 0); }
                }
                __builtin_amdgcn_sched_barrier(0);
            }
            if (kt + 2 < nkt) asm volatile("s_waitcnt vmcnt(5)" ::: "memory"); else asm volatile("s_waitcnt vmcnt(0)" ::: "memory");
            AT_BAR();
            stg = stg == 2 ? 0 : stg + 1;
        }
        lrow += __shfl_xor(lrow, 32);
        const float inv = 1.f / lrow;
        unsigned char* mx_ = (unsigned char*)MIX; unsigned char* orow = P32(mx_, (b * SEQ + q0 + r) * 2048 + h * 128);
#pragma unroll
        for (int dvt = 0; dvt < 4; ++dvt)
#pragma unroll
            for (int g4 = 0; g4 < 4; ++g4) *(GAS unsigned*)(orow + dvt * 32 + 8 * g4 + 4 * hh) = pk4_fp8(O[dvt][4 * g4] * inv, O[dvt][4 * g4 + 1] * inv, O[dvt][4 * g4 + 2] * inv, O[dvt][4 * g4 + 3] * inv);
    }
#undef AT_DMA
#undef AT_BAR
}

DI void ln_router_phase(const KArgs& a, LAS unsigned char* lds, int layer, const bf16* XPRE, bf16* X1, bf16* H, int wv) {
    const int tid = otid(wv), lane = tid & 63, wave = tid >> 6;
    LAS float* wT = (LAS float*)lds;
    { f32x4 rw[4][4];
#pragma unroll
      for (int i = 0; i < 4; ++i)
#pragma unroll
          for (int q4 = 0; q4 < 4; ++q4) rw[i][q4] = *(const f32x4*)(a.in[I_RW] + (size_t)(tid + 512 * i) * 16 + 4 * q4);
#pragma unroll
      for (int i = 0; i < 4; ++i)
#pragma unroll
          for (int q4 = 0; q4 < 4; ++q4)
#pragma unroll
              for (int e4 = 0; e4 < 4; ++e4) wT[(4 * q4 + e4) * 2048 + tid + 512 * i] = rw[i][q4][e4]; }
    __syncthreads();
    const float* MODl = (const float*)(a.ws + CTL_MOD) + (size_t)layer * 4 * 12288;
    const float* lg = a.in[I_LNMG] + layer * D; const float* lb = a.in[I_LNMB] + layer * D;
    unsigned* cnt = (unsigned*)(a.ws + CTL_CNT) + layer * 16 * 64;
    LAS int* lcnt = (LAS int*)(lds + LDS_MISC + 256); LAS int* lbase = lcnt + 16; LAS int* rec = lcnt + 32;
    if (tid < 16) lcnt[tid] = 0;
    int* RTE = (int*)(a.ws + A_RT); int* RTP = RTE + 2 * T; float* RTW = (float*)(RTP + 2 * T); int* TOKL = (int*)(a.ws + A_TOKL);
    const LAS float* wp[16];
#pragma unroll
    for (int e = 0; e < 16; ++e) { wp[e] = wT + e * 2048 + lane * 4; asm volatile("" : "+v"(wp[e])); }
    const float rbl = a.in[I_RB][lane >> 2];
    int lr = wave, nslot = 0;
    LAS unsigned short* vb = (LAS unsigned short*)(lds + LDS_BYTES - 16384);
    for (int rg = blockIdx.x; rg < T / 64; rg += gridDim.x, nslot += 64) {
        const int b = (rg * 64) / SEQ; const float* sh = MODl + (size_t)b * 12288 + 3 * 2048; const float* sc = sh + 2048;
        __syncthreads();
        { const int c4 = tid * 4; const f32x4 g4 = *(const f32x4*)(lg + c4), b4 = *(const f32x4*)(lb + c4), s4 = *(const f32x4*)(sc + c4), h4 = *(const f32x4*)(sh + c4);
          *(LAS u32x2*)(vb + 6144 + c4) = (u32x2){pk2(h4.x, h4.y), pk2(h4.z, h4.w)};
          *(LAS u32x2*)(vb + c4) = (u32x2){pk2(g4.x, g4.y), pk2(g4.z, g4.w)}; *(LAS u32x2*)(vb + 2048 + c4) = (u32x2){pk2(b4.x, b4.y), pk2(b4.z, b4.w)}; *(LAS u32x2*)(vb + 4096 + c4) = (u32x2){pk2(s4.x, s4.y), pk2(s4.z, s4.w)}; }
        __syncthreads();
    for (int m = rg * 64 + wave; m < rg * 64 + 64; m += 8, lr += 8) {
        f32x4 v[8]; float s = 0.f;
#pragma unroll
        for (int j = 0; j < 8; ++j) { const u32x2 xp = __builtin_nontemporal_load((const GAS u32x2*)(XPRE + (size_t)m * D + (lane + 64 * j) * 4)); v[j] = (f32x4){bflo(xp.x), bfhi(xp.x), bflo(xp.y), bfhi(xp.y)}; s += (v[j].x + v[j].y) + (v[j].z + v[j].w); }
        const float mean = wave_sum(s) * (1.f / D); float s2 = 0.f;
#pragma unroll
        for (int j = 0; j < 8; ++j) { v[j] = v[j] - mean; s2 += (v[j].x * v[j].x + v[j].y * v[j].y) + (v[j].z * v[j].z + v[j].w * v[j].w); }
        const float rstd = rsqrtf(wave_sum(s2) * (1.f / D) + LN_EPS);
#pragma unroll
        for (int j = 0; j < 8; ++j) { const int col = (lane + 64 * j) * 4; const u32x2 gq = *(LAS u32x2*)(vb + col), bq = *(LAS u32x2*)(vb + 2048 + col), sq = *(LAS u32x2*)(vb + 4096 + col), hq = *(LAS u32x2*)(vb + 6144 + col);
            const f32x4 x1 = v[j] * rstd * (f32x4){bflo(gq.x), bfhi(gq.x), bflo(gq.y), bfhi(gq.y)} + (f32x4){bflo(bq.x), bfhi(bq.x), bflo(bq.y), bfhi(bq.y)};
            { u32x2 ox = {pk2(x1.x, x1.y), pk2(x1.z, x1.w)}; *(GAS u32x2*)(X1 + (size_t)m * D + col) = ox; }
            const f32x4 hv = x1 * ((f32x4){bflo(sq.x), bfhi(sq.x), bflo(sq.y), bfhi(sq.y)} + 1.f) + (f32x4){bflo(hq.x), bfhi(hq.x), bflo(hq.y), bfhi(hq.y)};
            *(GAS unsigned*)((unsigned char*)H + (size_t)m * D + col) = pk4_fp8(hv.x, hv.y, hv.z, hv.w); v[j] = hv; }
        f32x2 part2[16];
#pragma unroll
        for (int e = 0; e < 16; ++e) part2[e] = (f32x2){0.f, 0.f};
#pragma unroll
        for (int j = 0; j < 8; ++j) { f32x4 wr_[16];
#pragma unroll
            for (int e = 0; e < 16; ++e) wr_[e] = *(const LAS f32x4*)(wp[e] + j * 256);
            __builtin_amdgcn_sched_barrier(0);
#pragma unroll
            for (int e = 0; e < 16; ++e) { part2[e] += (f32x2){v[j].x, v[j].y} * (f32x2){wr_[e].x, wr_[e].y}; part2[e] += (f32x2){v[j].z, v[j].w} * (f32x2){wr_[e].z, wr_[e].w}; }
            __builtin_amdgcn_sched_barrier(0); }
        float part[16];
#pragma unroll
        for (int e = 0; e < 16; ++e) part[e] = part2[e].x + part2[e].y;
        float r8[8], r4[4], r2[2], lg1;
        { const bool hi = lane & 32;
#pragma unroll
          for (int i = 0; i < 8; ++i) { const float mine = hi ? part[8 + i] : part[i], oth = hi ? part[i] : part[8 + i]; r8[i] = mine + __shfl_xor(oth, 32); } }
        { const bool hi = lane & 16;
#pragma unroll
          for (int i = 0; i < 4; ++i) { const float mine = hi ? r8[4 + i] : r8[i], oth = hi ? r8[i] : r8[4 + i]; r4[i] = mine + __shfl_xor(oth, 16); } }
        { const bool hi = lane & 8;
#pragma unroll
          for (int i = 0; i < 2; ++i) { const float mine = hi ? r4[2 + i] : r4[i], oth = hi ? r4[i] : r4[2 + i]; r2[i] = mine + __shfl_xor(oth, 8); } }
        { const bool hi = lane & 4; const float mine = hi ? r2[1] : r2[0], oth = hi ? r2[0] : r2[1]; lg1 = mine + __shfl_xor(oth, 4); }
        lg1 += dpp_xor1(lg1); lg1 += dpp_xor2(lg1);
        const float sgl = 1.f / (1.f + expf(-lg1)), sbl = sgl + rbl;
        float gs; { const float y1 = dpp_ror<4>(sbl), y2 = dpp_ror<8>(sbl), y3 = dpp_ror<12>(sbl);
            gs = fmaxf(fmaxf(fmaxf(sbl + y1, sbl + y2), fmaxf(sbl + y3, y1 + y2)), fmaxf(y1 + y3, y2 + y3)); }
        int bg = 0; float bgs = __builtin_bit_cast(float, __builtin_amdgcn_readlane(__builtin_bit_cast(int, gs), 0)); asm volatile("" : "+v"(bgs));
#pragma unroll
        for (int g = 1; g < 4; ++g) { float x = __builtin_bit_cast(float, __builtin_amdgcn_readlane(__builtin_bit_cast(int, gs), 16 * g)); asm volatile("" : "+v"(x)); const bool c = x > bgs; bgs = c ? x : bgs; bg = c ? g : bg; }
        const int bgu = __builtin_amdgcn_readfirstlane(bg);
        int e0 = 0, e1 = 0; float b0 = -1e30f, b1 = -1e30f, s0 = 0.f, s1 = 0.f;
#pragma unroll
        for (int i = 0; i < 4; ++i) { float x = __builtin_bit_cast(float, __builtin_amdgcn_readlane(__builtin_bit_cast(int, sbl), 16 * bgu + 4 * i)), sx = __builtin_bit_cast(float, __builtin_amdgcn_readlane(__builtin_bit_cast(int, sgl), 16 * bgu + 4 * i));
            asm volatile("" : "+v"(x), "+v"(sx)); const int e = 4 * bg + i; const bool g0 = x > b0, g1 = x > b1;
            b1 = g0 ? b0 : (g1 ? x : b1); e1 = g0 ? e0 : (g1 ? e : e1); s1 = g0 ? s0 : (g1 ? sx : s1);
            b0 = g0 ? x : b0; e0 = g0 ? e : e0; s0 = g0 ? sx : s0; }
        if (lane == 0) { const float inv = 1.f / (s0 + s1);
            const int p0 = __hip_atomic_fetch_add(lcnt + e0, 1, __ATOMIC_RELAXED, __HIP_MEMORY_SCOPE_WORKGROUP), p1 = __hip_atomic_fetch_add(lcnt + e1, 1, __ATOMIC_RELAXED, __HIP_MEMORY_SCOPE_WORKGROUP);
            rec[lr * 4] = m; rec[lr * 4 + 1] = e0; rec[lr * 4 + 2] = e1; rec[lr * 4 + 3] = p0 | (p1 << 16);
            RTE[2 * m] = e0; RTE[2 * m + 1] = e1; RTW[2 * m] = s0 * inv; RTW[2 * m + 1] = s1 * inv; }
    }
    }
    __syncthreads();
    if (tid < 16) lbase[tid] = (int)atomicAdd(cnt + tid * 64, (unsigned)lcnt[tid]);
    __syncthreads();
    const int nrows = nslot;
    for (int i = tid; i < nrows; i += 512) { const int m = rec[i * 4];
        { const int e0 = rec[i * 4 + 1], e1 = rec[i * 4 + 2], pp = rec[i * 4 + 3], q0 = lbase[e0] + (pp & 0xffff), q1 = lbase[e1] + (pp >> 16);
            TOKL[e0 * T + q0] = m; TOKL[e1 * T + q1] = m; RTP[2 * m] = q0; RTP[2 * m + 1] = q1; } }
    __syncthreads();
}

DI void moe_table(const KArgs& a, LAS unsigned char* lds, int layer, int wv) {
    LAS int* tab = (LAS int*)(lds + LDS_TAB);
    if (otid(wv) == 0) { const unsigned* cnt = (const unsigned*)(a.ws + CTL_CNT) + layer * 16 * 64; int acc = 0;
        for (int e = 0; e < 16; ++e) { const int c = (int)cnt[e * 64]; tab[e] = acc; tab[32 + e] = c; acc += (c + 255) >> 8; } tab[16] = acc; }
    __syncthreads();
}
template <int NTB> struct MoeOrder {
    int G, c, layer; const LAS int* tab; const int* tokl;
    DI bool next(int i, Unit& u) const { const int L = i * G + c, mt = L / NTB, nt = L % NTB; if (mt >= tab[16]) return false; int e = 0;
#pragma unroll
        for (int k = 1; k < 16; ++k) e += (mt >= tab[k]) ? 1 : 0;
        u.pm = mt; u.pn = (layer * 16 + e) * NTB + nt; u.aux = e | (nt << 8) | ((mt - tab[e]) << 16); return true; }
    DI int arow(const Unit& u, int r) const { const int e = u.aux & 255, j = (u.aux >> 16) * 256 + r; return j < tab[32 + e] ? tokl[e * T + j] : 0; }
    DI int koff(const Unit&) const { return 0; }
};
struct EpiGateUp { static constexpr bool PERM = true;
    unsigned char* ACT;
    DI void operator()(const Acc& acc, const Unit& u, int wr, int wc, int fr, int fq) const {
        const int nt = (u.aux >> 8) & 255;
        EPI_ROWS_BEGIN
            const f32x4 g0 = acc[ai][0][m][0], g1 = acc[ai][0][m][1], u0 = acc[ai][1][m][0], u1 = acc[ai][1][m][1];
            f32x4 o0, o1;
#pragma unroll
            for (int e = 0; e < 4; ++e) { o0[e] = g0[e] * sigmoidf_(g0[e]) * u0[e]; o1[e] = g1[e] * sigmoidf_(g1[e]) * u1[e]; }
            u32x2 o8 = {pk4_fp8(o0.x, o0.y, o0.z, o0.w), pk4_fp8(o1.x, o1.y, o1.z, o1.w)}; *(u32x2*)P32(ACT, row * 512 + nt * 128 + 32 * wc + 8 * fq) = o8;
        EPI_ROWS_END
    }
};
struct EpiDown { static constexpr bool PERM = true;
    bf16* YS;
    DI void operator()(const Acc& acc, const Unit& u, int wr, int wc, int fr, int fq) const {
        const int nt = (u.aux >> 8) & 255;
        EPI_ROWS_BEGIN
#pragma unroll
            for (int bj = 0; bj < 2; ++bj) *(u32x4*)P32(YS, row * 2048 + nt * 256 + 128 * bj + 32 * wc + 8 * fq) = pack8(acc[ai][bj][m][0], acc[ai][bj][m][1]);
        EPI_ROWS_END
    }
};
DI void ln_ffn_phase(const KArgs& a, LAS unsigned char* lds, int layer, const bf16* X1, float* XO, bf16* Hn, int wv) {
    const int lane = otid(wv) & 63, wave = otid(wv) >> 6;
    const float* MODl = (const float*)(a.ws + CTL_MOD) + (size_t)layer * 4 * 12288; const float* MODn = MODl + 4 * 12288;
    const float* lg = a.in[I_LNFG] + layer * D; const float* lb = a.in[I_LNFB] + layer * D;
    const unsigned* cnt = (const unsigned*)(a.ws + CTL_CNT) + layer * 16 * 64;
    const int* RTE = (const int*)(a.ws + A_RT); const int* RTP = RTE + 2 * T; const float* RTW = (const float*)(RTP + 2 * T); const bf16* YS = (const bf16*)(a.ws + A_YS);
    int tlx = 0;
    if (lane < 16) tlx = ((int)cnt[lane * 64] + 255) >> 8;
    LAS float* vec = (LAS float*)lds;
    for (int rg = blockIdx.x; rg < T / 64; rg += gridDim.x) {
    const int b = (rg * 64) / SEQ; const int m0 = rg * 64 + wave, mstep = 8, mend = rg * 64 + 64;
    __syncthreads();
    { const int c4 = otid(wv) * 4; const float* shn = MODn + (size_t)b * 12288;
      *(LAS f32x4*)(vec + c4) = *(const f32x4*)(MODl + (size_t)b * 12288 + 5 * 2048 + c4); *(LAS f32x4*)(vec + 2048 + c4) = *(const f32x4*)(lg + c4); *(LAS f32x4*)(vec + 4096 + c4) = *(const f32x4*)(lb + c4);
      if (Hn) { *(LAS f32x4*)(vec + 6144 + c4) = *(const f32x4*)(shn + c4); *(LAS f32x4*)(vec + 8192 + c4) = *(const f32x4*)(shn + 2048 + c4); } }
    int nE = 0, nP = 0; float nW = 0.f;
    if (lane < 2) { nE = RTE[2 * m0 + lane]; nP = RTP[2 * m0 + lane]; nW = RTW[2 * m0 + lane]; }
    __syncthreads();
    for (int m = m0; m < mend; m += mstep) {
        const int e0 = __builtin_amdgcn_readlane(nE, 0), e1 = __builtin_amdgcn_readlane(nE, 1), p0 = __builtin_amdgcn_readlane(nP, 0), p1 = __builtin_amdgcn_readlane(nP, 1);
        const float w0 = __builtin_bit_cast(float, __builtin_amdgcn_readlane(__builtin_bit_cast(int, nW), 0)), w1 = __builtin_bit_cast(float, __builtin_amdgcn_readlane(__builtin_bit_cast(int, nW), 1));
        { const int mn = m + mstep; if (mn < mend && lane < 2) { nE = RTE[2 * mn + lane]; nP = RTP[2 * mn + lane]; nW = RTW[2 * mn + lane]; } }
        int t0 = 0, t1 = 0;
#pragma unroll
        for (int e = 0; e < 16; ++e) { const int tl = __builtin_amdgcn_readlane(tlx, e); t0 += e < e0 ? tl : 0; t1 += e < e1 ? tl : 0; }
        const bf16* y0 = YS + ((size_t)t0 * 256 + p0) * 2048; const bf16* y1 = YS + ((size_t)t1 * 256 + p1) * 2048;
        f32x4 v[8]; float s = 0.f;
#pragma unroll
        for (int j = 0; j < 8; ++j) { const int col = (lane + 64 * j) * 4; const u32x2 a0 = __builtin_nontemporal_load((const u32x2*)(y0 + col)), a1 = __builtin_nontemporal_load((const u32x2*)(y1 + col));
            const f32x4 y = {w0 * bflo(a0.x) + w1 * bflo(a1.x), w0 * bfhi(a0.x) + w1 * bfhi(a1.x), w0 * bflo(a0.y) + w1 * bflo(a1.y), w0 * bfhi(a0.y) + w1 * bfhi(a1.y)};
            const u32x2 xq = __builtin_nontemporal_load((const u32x2*)(X1 + (size_t)m * D + col)); const f32x4 xv = {bflo(xq.x), bfhi(xq.x), bflo(xq.y), bfhi(xq.y)};
            v[j] = xv * DN_ALPHA + (*(LAS f32x4*)(vec + col) + 1.f) * y; s += (v[j].x + v[j].y) + (v[j].z + v[j].w); }
        const float mean = wave_sum(s) * (1.f / D); float s2 = 0.f;
#pragma unroll
        for (int j = 0; j < 8; ++j) { v[j] = v[j] - mean; s2 += (v[j].x * v[j].x + v[j].y * v[j].y) + (v[j].z * v[j].z + v[j].w * v[j].w); }
        const float rstd = rsqrtf(wave_sum(s2) * (1.f / D) + LN_EPS);
#pragma unroll
        for (int j = 0; j < 8; ++j) { const int col = (lane + 64 * j) * 4; const f32x4 xo = v[j] * rstd * *(LAS f32x4*)(vec + 2048 + col) + *(LAS f32x4*)(vec + 4096 + col);
            if (Hn) { u32x2 oq = {pk2(xo.x, xo.y), pk2(xo.z, xo.w)}; *(u32x2*)((bf16*)XO + (size_t)m * D + col) = oq; }
            else *(f32x4*)(XO + (size_t)m * D + col) = xo;
            if (Hn) { const f32x4 hv = xo * (*(LAS f32x4*)(vec + 8192 + col) + 1.f) + *(LAS f32x4*)(vec + 6144 + col);
                *(unsigned*)((unsigned char*)Hn + (size_t)m * D + col) = pk4_fp8(hv.x, hv.y, hv.z, hv.w); } }
    }
    }
}

struct EpiIn1 { static constexpr bool PERM = true;
    bf16 *ZD, *ZR;
    DI void operator()(const Acc& acc, const Unit& u, int wr, int wc, int fr, int fq) const {
        EPI_ROWS_BEGIN
#pragma unroll
            for (int bj = 0; bj < 2; ++bj) { const int col = u.pn * 256 + 128 * bj + 32 * wc + 8 * fq; const u32x4 o = pack8(acc[ai][bj][m][0], acc[ai][bj][m][1]);
                if (col < DIL_IN) *(u32x4*)P32(ZD, row * DIL_IN + col) = o; else if (col < ODD_IN) *(u32x4*)P32(ZR, row * RW_IN + (col - DIL_IN)) = o; }
        EPI_ROWS_END
    }
};
constexpr int DA_KSTR = 272, DA_VROW = 320, DA_KBYTES = 64 * DA_KSTR, DA_STG = DA_KBYTES + 64 * DA_VROW;
struct DilPre { bf16x8 qf[4]; u32x4 kreg[2], vreg[2]; float blv[2]; };
DI void dil_issue(const bf16* ZD, const float* BL, int unit, int wv, DilPre& P) {
    const int tid = otid(wv), lane = tid & 63, w = tid >> 6, r = lane & 31, hh = lane >> 5, hd = w >> 2, qs = w & 3;
    const int hp = unit & 3, sb_ = ((unit >> 2) + (unit >> 7)) & 31, gi = (unit >> 7) % 3, b = unit / 384;
    const int dil = gi == 0 ? 1 : (gi == 1 ? 4 : 16), nb = 32 / dil, rr = sb_ / nb, n = sb_ % nb, h = hp * 2 + hd, kt0 = n == 0 ? 2 : 0;
    const bf16* Zb = ZD + (size_t)b * SEQ * DIL_IN + gi * 1536;
    const int qtok = (n * 128 + 32 * qs + r) * dil + rr;
#pragma unroll
    for (int k = 0; k < 2; ++k) { const int i = tid + 512 * k, hd_ = i >= 384 ? 1 : 0, d = i - 384 * hd_ - 127;
        P.blv[k] = (i < 768 && d >= 0 && d <= 128) ? ((const GAS float*)BL)[(gi * 8 + hp * 2 + hd_) * 132 + d] : -1e30f; }
#pragma unroll
    for (int ks = 0; ks < 4; ++ks) P.qf[ks] = *(const GAS bf16x8*)P32(Zb, qtok * DIL_IN + h * 64 + 16 * ks + 8 * hh);
#pragma unroll
    for (int i = 0; i < 2; ++i) { const int p = tid + 512 * i, kr = p >> 4, c16 = p & 15; const int ktok = ((n - 1) * 128 + kt0 * 64 + kr) * dil + rr;
        P.kreg[i] = *(const GAS u32x4*)P32(Zb, ktok * DIL_IN + 512 + hp * 128 + c16 * 8); P.vreg[i] = *(const GAS u32x4*)P32(Zb, ktok * DIL_IN + 1024 + hp * 128 + c16 * 8); }
}
DI void dil_attn_unit(LAS unsigned char* lds, const bf16* ZD, const float* BL, bf16* DPO, float* DPM, float* DPL, int unit, int next, DilPre& P, int wv) {
    const int tid = otid(wv), lane = tid & 63, w = tid >> 6, r = lane & 31, hh = lane >> 5, hd = w >> 2, qs = w & 3;
    const int hp = unit & 3, sb_ = ((unit >> 2) + (unit >> 7)) & 31, gi = (unit >> 7) % 3, b = unit / 384;
    const int dil = gi == 0 ? 1 : (gi == 1 ? 4 : 16), nb = 32 / dil, rr = sb_ / nb, n = sb_ % nb;
    const int h = hp * 2 + hd;
    const bf16* Zb = ZD + (size_t)b * SEQ * DIL_IN + gi * 1536;
    LAS float* bl = (LAS float*)(lds + 2 * DA_STG);
    __syncthreads();
    bl[tid] = P.blv[0]; if (tid < 256) bl[512 + tid] = P.blv[1];
    const int qi = 32 * qs + r, qtok = (n * 128 + qi) * dil + rr;
    bf16x8 qf[4];
#pragma unroll
    for (int ks = 0; ks < 4; ++ks) qf[ks] = P.qf[ks];
    f32x16 O[2];
#pragma unroll
    for (int i = 0; i < 2; ++i) for (int e = 0; e < 16; ++e) O[i][e] = 0.f;
    float mrow = -1e30f, lrow = 0.f;
    u32x4 kreg[2] = {P.kreg[0], P.kreg[1]}, vreg[2] = {P.vreg[0], P.vreg[1]};
    const int kt0 = n == 0 ? 2 : 0;
#define DA_LOAD(kt) do { _Pragma("unroll") for (int i = 0; i < 2; ++i) { const int p = tid + 512 * i, kr = p >> 4, c16 = p & 15; const int ktok = ((n - 1) * 128 + (kt) * 64 + kr) * dil + rr; \
            kreg[i] = *(const GAS u32x4*)P32(Zb, ktok * DIL_IN + 512 + hp * 128 + c16 * 8); } \
        _Pragma("unroll") for (int i = 0; i < 2; ++i) { const int p = tid + 512 * i, kr = p >> 4, c16 = p & 15; const int ktok = ((n - 1) * 128 + (kt) * 64 + kr) * dil + rr; vreg[i] = *(const GAS u32x4*)P32(Zb, ktok * DIL_IN + 1024 + hp * 128 + c16 * 8); } } while (0)
#define DA_STORE(buf) do { LAS unsigned char* sb = lds + (buf) * DA_STG; _Pragma("unroll") for (int i = 0; i < 2; ++i) { const int p = tid + 512 * i, kr = p >> 4, c16 = p & 15; *(LAS u32x4*)(sb + kr * DA_KSTR + c16 * 16) = kreg[i]; } \
        _Pragma("unroll") for (int i = 0; i < 2; ++i) { const int p = tid + 512 * i; *(LAS u32x4*)(sb + DA_KBYTES + (p >> 4) * DA_VROW + (p & 15) * 16) = vreg[i]; } } while (0)
    DA_STORE(kt0 & 1);
    __syncthreads();
    for (int kt = kt0; kt < 4; ++kt) {
        if (kt + 1 < 4) DA_LOAD(kt + 1); else if (next >= 0) dil_issue(ZD, BL, next, wv, P);
        const LAS unsigned char* sb = lds + (kt & 1) * DA_STG;
        if (64 * kt + 63 >= 32 * qs && 64 * kt <= 32 * qs + 31 + 128) {
            f32x16 st[2];
#pragma unroll
            for (int mt = 0; mt < 2; ++mt) for (int e = 0; e < 16; ++e) st[mt][e] = 0.f;
            __builtin_amdgcn_sched_barrier(0);
            {
                const LAS unsigned char* kb = sb + r * DA_KSTR + (hd * 64 + 8 * hh) * 2; bf16x8 kf[8];
#pragma unroll
                for (int i = 0; i < 8; ++i) kf[i] = *(const LAS bf16x8*)(kb + 32 * (i & 1) * DA_KSTR + 32 * (i >> 1));
#pragma unroll
                for (int i = 0; i < 8; ++i) st[i & 1] = MFMA32(kf[i], qf[i >> 1], st[i & 1]);
                __builtin_amdgcn_sched_group_barrier(0x100, 3, 0);
#pragma unroll
                for (int i = 0; i < 8; ++i) { __builtin_amdgcn_sched_group_barrier(0x008, 1, 0); __builtin_amdgcn_sched_group_barrier(0x100, 1, 0); }
            }
            __builtin_amdgcn_sched_barrier(0);
#pragma unroll
            for (int mt = 0; mt < 2; ++mt) { const LAS float* lp = bl + hd * 384 + 127 + (128 + qi - 64 * kt - 32 * mt - 4 * hh) - 27;
#pragma unroll
                for (int e = 0; e < 16; ++e) st[mt][e] = st[mt][e] * (0.125f * 1.44269504089f) + lp[27 - ((e & 3) + 8 * (e >> 2))]; }
            float mx = st[0][0];
#pragma unroll
            for (int mt = 0; mt < 2; ++mt)
#pragma unroll
                for (int e = 0; e < 16; ++e) mx = fmaxf(mx, st[mt][e]);
            { const unsigned xi_ = __float_as_uint(mx); const auto rr_ = __builtin_amdgcn_permlane32_swap(xi_, xi_, false, false); mx = fmaxf(__uint_as_float(rr_[0]), __uint_as_float(rr_[1])); }
            float alpha = 1.f;
            if (__any(mx - mrow > 8.f)) { const float mnew = fmaxf(mrow, mx); alpha = __builtin_amdgcn_exp2f(mrow - mnew); mrow = mnew; O[0] *= alpha; O[1] *= alpha; }
            float ls = 0.f;
#pragma unroll
            for (int mt = 0; mt < 2; ++mt)
#pragma unroll
                for (int e = 0; e < 16; ++e) { const float p = __builtin_amdgcn_exp2f(st[mt][e] - mrow); st[mt][e] = p; ls += p; }
            lrow = lrow * alpha + ls;
            bf16x8 pf[2][2];
#pragma unroll
            for (int mt = 0; mt < 2; ++mt)
#pragma unroll
                for (int s = 0; s < 2; ++s) { u32x4 pk = {pk2(st[mt][8 * s], st[mt][8 * s + 1]), pk2(st[mt][8 * s + 2], st[mt][8 * s + 3]), pk2(st[mt][8 * s + 4], st[mt][8 * s + 5]), pk2(st[mt][8 * s + 6], st[mt][8 * s + 7])};
                    pf[mt][s] = __builtin_bit_cast(bf16x8, pk); }
            __builtin_amdgcn_sched_barrier(0);
            {
                const LAS unsigned char* vb = sb + DA_KBYTES + (4 * hh + ((lane >> 2) & 3)) * DA_VROW + (hd * 64 + 16 * ((lane >> 4) & 1)) * 2 + 8 * (lane & 3); bf16x8 af[8];
#pragma unroll
                for (int i = 0; i < 8; ++i) { const LAS unsigned char* vp = vb + 16 * (i >> 1) * DA_VROW + (i & 1) * 64;
                    const s16x4 lo = __builtin_amdgcn_ds_read_tr16_b64_v4i16((LAS s16x4*)vp), hi = __builtin_amdgcn_ds_read_tr16_b64_v4i16((LAS s16x4*)(vp + 8 * DA_VROW)); af[i] = __builtin_shufflevector(lo, hi, 0, 1, 2, 3, 4, 5, 6, 7); }
#pragma unroll
                for (int i = 0; i < 8; ++i) O[i & 1] = MFMA32(af[i], pf[i >> 2][(i >> 1) & 1], O[i & 1]);
                __builtin_amdgcn_sched_group_barrier(0x100, 6, 0);
#pragma unroll
                for (int i = 0; i < 8; ++i) { __builtin_amdgcn_sched_group_barrier(0x008, 1, 0); __builtin_amdgcn_sched_group_barrier(0x100, 2, 0); }
            }
            __builtin_amdgcn_sched_barrier(0);
        }
        if (kt + 1 < 4) DA_STORE((kt + 1) & 1);
        __syncthreads();
    }
    lrow += __shfl_xor(lrow, 32);
    const float inv = 1.f / lrow;
    const int tokg = b * SEQ + qtok;
    bf16* orow = P32(DPO, (gi * T + tokg) * 512 + h * 64);
#pragma unroll
    for (int dvt = 0; dvt < 2; ++dvt)
#pragma unroll
        for (int g4 = 0; g4 < 4; ++g4) { u32x2 o = {pk2(O[dvt][4 * g4] * inv, O[dvt][4 * g4 + 1] * inv), pk2(O[dvt][4 * g4 + 2] * inv, O[dvt][4 * g4 + 3] * inv)};
            *(GAS u32x2*)(orow + dvt * 32 + 8 * g4 + 4 * hh) = o; }
    if (hh == 0) { *(GAS float*)P32(DPM, (gi * T + tokg) * 8 + h) = mrow; *(GAS float*)P32(DPL, (gi * T + tokg) * 8 + h) = lrow; }
#undef DA_LOAD
#undef DA_STORE
}
DI void dil_merge(const bf16* DPO, const float* DPM, const float* DPL, bf16* MIX, int wv) {
    const int gt = blockIdx.x * 512 + otid(wv), NT_ = gridDim.x * 512;
    for (int i = gt; i < T * 64; i += NT_) { const int tok = i >> 6, c8 = i & 63, h = c8 >> 3;
        float m[3], l[3];
#pragma unroll
        for (int g = 0; g < 3; ++g) { m[g] = DPM[((size_t)g * T + tok) * 8 + h]; l[g] = DPL[((size_t)g * T + tok) * 8 + h]; }
        const float M = fmaxf(m[0], fmaxf(m[1], m[2])); float wsum = 0.f, wg[3];
#pragma unroll
        for (int g = 0; g < 3; ++g) { wg[g] = __builtin_amdgcn_exp2f(m[g] - M) * l[g]; wsum += wg[g]; }
        const float inv = __builtin_amdgcn_rcpf(wsum); float o[8];
#pragma unroll
        for (int e = 0; e < 8; ++e) o[e] = 0.f;
#pragma unroll
        for (int g = 0; g < 3; ++g) { const u32x4 v = *(const u32x4*)(DPO + ((size_t)g * T + tok) * 512 + c8 * 8); const float wn = wg[g] * inv;
            o[0] += wn * bflo(v.x); o[1] += wn * bfhi(v.x); o[2] += wn * bflo(v.y); o[3] += wn * bfhi(v.y); o[4] += wn * bflo(v.z); o[5] += wn * bfhi(v.z); o[6] += wn * bflo(v.w); o[7] += wn * bfhi(v.w); }
        u32x2 r = {pk4_fp8(o[0], o[1], o[2], o[3]), pk4_fp8(o[4], o[5], o[6], o[7])}; *(u32x2*)((unsigned char*)MIX + (size_t)tok * 2048 + c8 * 8) = r; }
}

DI void rwkv_prep(const bf16* ZR, const float* mu, bf16* LIN, int wv) {
    const int gt = blockIdx.x * 512 + otid(wv), NT_ = gridDim.x * 512;
    for (int i = gt; i < T * 48; i += NT_) { const int tok = i / 48, c0 = (i % 48) * 8, s = tok % SEQ; float o[8];
        if (c0 < 352) { const u32x4 z = *(const u32x4*)(ZR + (size_t)tok * RW_IN + 4608 + c0); u32x4 zp = {0u, 0u, 0u, 0u}; if (s > 0) zp = *(const u32x4*)(ZR + (size_t)(tok - 1) * RW_IN + 4608 + c0);
            const unsigned* zz = (const unsigned*)&z; const unsigned* pp = (const unsigned*)&zp;
#pragma unroll
            for (int e = 0; e < 8; ++e) { const float zv = (e & 1) ? bfhi(zz[e >> 1]) : bflo(zz[e >> 1]), pv = (e & 1) ? bfhi(pp[e >> 1]) : bflo(pp[e >> 1]); const float xs = zv + (pv - zv) * mu[4608 + c0 + e];
                o[e] = c0 < 64 ? 1.f - 2.f * __builtin_amdgcn_rcpf(1.f + __expf(2.f * xs)) : (c0 < 128 ? xs : sigmoidf_(xs)); } }
        else {
#pragma unroll
            for (int e = 0; e < 8; ++e) o[e] = 0.f; }
        u32x4 r = {pk2(o[0], o[1]), pk2(o[2], o[3]), pk2(o[4], o[5]), pk2(o[6], o[7])}; *(u32x4*)(LIN + (size_t)tok * 384 + c0) = r; }
}
struct LoraOrder : pg8::StaticOrder { int ko; DI int koff(const Unit&) const { return ko; } };
struct EpiLora { static constexpr bool PERM = true;
    bf16 *WDEC, *AA, *GG; const float *w0, *a0; int pn0;
    DI void operator()(const Acc& acc, const Unit& u, int wr, int wc, int fr, int fq) const {
        const int pnn = u.pn + pn0, kind = pnn / 6;
        EPI_ROWS_BEGIN
#pragma unroll
            for (int bj = 0; bj < 2; ++bj) { const int col = (pnn % 6) * 256 + 128 * bj + 32 * wc + 8 * fq; f32x4 v0 = acc[ai][bj][m][0], v1 = acc[ai][bj][m][1];
                if (kind == 0) { const f32x4 b0 = *(const f32x4*)P32(w0, col), b1 = *(const f32x4*)P32(w0, col + 4);
#pragma unroll
                    for (int e = 0; e < 4; ++e) { v0[e] = -0.6065306597f * sigmoidf_(v0[e] + b0[e]); v1[e] = -0.6065306597f * sigmoidf_(v1[e] + b1[e]); }
                    *(u32x4*)P32(WDEC, row * RWW + col) = pack8(v0, v1); }
                else if (kind == 1) { const f32x4 b0 = *(const f32x4*)P32(a0, col), b1 = *(const f32x4*)P32(a0, col + 4);
#pragma unroll
                    for (int e = 0; e < 4; ++e) { v0[e] = sigmoidf_(v0[e] + b0[e]); v1[e] = sigmoidf_(v1[e] + b1[e]); }
                    *(u32x4*)P32(AA, row * RWW + col) = pack8(v0, v1); }
                else *(u32x4*)P32(GG, row * RWW + col) = pack8(v0, v1); }
        EPI_ROWS_END
    }
};
constexpr int CK_AT = 0, CK_RT = 2048, CK_BH = 4096, CK_KH = 6144, CK_MT = 8192, CK_NK = 8704, CK_PB = 9216, CK_PK = 9728, CK_G15 = 10240, CK_VT = 10496  , CK_VTS = 40, CK_BS = 13056  , CK_SLOT = 13120;
constexpr int CK_HALF = 128;
constexpr int CK_N1 = (int)((128 * MiB) / CK_SLOT) - 1;
DI unsigned char* ck_slot(unsigned char* ws, int job) { return job < CK_N1 ? ws + WS_X1 + (size_t)job * CK_SLOT : ws + WS_W_GU + (size_t)(job - CK_N1) * CK_SLOT; }
static_assert((size_t)(96 * CK_HALF - CK_N1 + 1) * CK_SLOT <= 64 * MiB, "chunk buffer");
constexpr int PJ = 4;
constexpr int PL_AT = 0, PL_BT = 2304, PL_KT = 4608, PL_RT = 6912, PL_BH = 9216, PL_KH = 11520  ,
              PL_NAB = 13824  , PL_MTS = 14848  , PL_LDT = 15616  , PL_C = 19968  ,
              PL_T = 24064  , PL_VT = 24320  , PL_END = 26880;
static_assert(PJ * PL_END <= RING_BYTES && PJ == 4, "prep LDS");
DI bf16x8 ldfrag(const LAS unsigned char* p) { return *(const LAS bf16x8*)p; }
DI u32x4 ld2x8(const LAS unsigned char* p0, const LAS unsigned char* p1) { const u32x2 lo = *(const LAS u32x2*)p0, hi = *(const LAS u32x2*)p1; return (u32x4){lo.x, lo.y, hi.x, hi.y}; }
DI void unpk8(const u32x4 v, float (&o)[8]) { o[0] = bflo(v.x); o[1] = bfhi(v.x); o[2] = bflo(v.y); o[3] = bfhi(v.y); o[4] = bflo(v.z); o[5] = bfhi(v.z); o[6] = bflo(v.w); o[7] = bfhi(v.w); }
DI void ldf8(const float* p, float (&o)[8]) { const f32x4 x = *(const f32x4*)p, y = *(const f32x4*)(p + 4); o[0] = x.x; o[1] = x.y; o[2] = x.z; o[3] = x.w; o[4] = y.x; o[5] = y.y; o[6] = y.z; o[7] = y.w; }
DI u32x4 pack8(const float (&x)[8]) { return (u32x4){pk2(x[0], x[1]), pk2(x[2], x[3]), pk2(x[4], x[5]), pk2(x[6], x[7])}; }
DI void rwkv_chunk_prep(const KArgs& a, LAS unsigned char* lds0, int half, int wv) {
    const int tid = otid(wv), lane = tid & 63, w = tid >> 6;
    const bf16* ZR = (const bf16*)(a.ws + A_ZR); const bf16* WDEC = (const bf16*)(a.ws + A_WDEC); const bf16* AA = (const bf16*)(a.ws + A_AA);
    const int js = tid >> 7, st = (tid >> 3) & 15, oc = tid & 7;
    LAS unsigned char* ldj = lds0 + js * PL_END;
    const float* mu = a.in[I_MU];
    bf16x8 lfrag;
#pragma unroll
    for (int j = 0; j < 8; ++j) lfrag[j] = ((lane & 31) >= 16 || 8 * (lane >> 5) + j <= (lane & 31)) ? (short)0x3F80 : (short)0;
    for (int it = blockIdx.x; it < 96 * CK_HALF / PJ; it += gridDim.x) {
        const int job0 = it * PJ, bh = job0 / CK_HALF, cl0 = job0 % CK_HALF, b = bh / 24, h = bh % 24, col = h * 64 + 8 * oc;
        const int s = (half * CK_HALF + cl0 + js) * 16 + st; const size_t tok = (size_t)b * SEQ + s;
        unsigned char* slot = ck_slot(a.ws, job0 + js);
        const bf16* z = ZR + tok * RW_IN + col;
        const u32x4 zr = __builtin_nontemporal_load((const u32x4*)z), zk = __builtin_nontemporal_load((const u32x4*)(z + 1536)), zv = __builtin_nontemporal_load((const u32x4*)(z + 3072));
        u32x4 pr = {0u, 0u, 0u, 0u}, pk_ = {0u, 0u, 0u, 0u}, pv = {0u, 0u, 0u, 0u};
        if (s > 0) { pr = *(const u32x4*)(z - RW_IN); pk_ = *(const u32x4*)(z - RW_IN + 1536); pv = *(const u32x4*)(z - RW_IN + 3072); }
        const u32x4 za = __builtin_nontemporal_load((const u32x4*)(AA + tok * RWW + col)), zw = __builtin_nontemporal_load((const u32x4*)(WDEC + tok * RWW + col));
        float r[8], km[8], q[8], bb[8], ld[8];
        {   float cz[8], cp[8], m_[8], k_[8], v_[8], as_[8], c1[8], c2[8];
            unpk8(zr, cz); unpk8(pr, cp); ldf8(mu + col, m_);
#pragma unroll
            for (int e = 0; e < 8; ++e) r[e] = cz[e] + (cp[e] - cz[e]) * m_[e];
            unpk8(zk, cz); unpk8(pk_, cp); ldf8(mu + 1536 + col, m_);
#pragma unroll
            for (int e = 0; e < 8; ++e) k_[e] = cz[e] + (cp[e] - cz[e]) * m_[e];
            unpk8(zv, cz); unpk8(pv, cp); ldf8(mu + 3072 + col, m_);
#pragma unroll
            for (int e = 0; e < 8; ++e) v_[e] = cz[e] + (cp[e] - cz[e]) * m_[e];
            unpk8(za, as_); unpk8(zw, ld); ldf8(a.in[I_KK] + col, c1);
            float nn = 0.f;
#pragma unroll
            for (int e = 0; e < 8; ++e) { q[e] = k_[e] * c1[e]; nn += q[e] * q[e]; }
            nn = red8(nn);
            const float invn = fminf(__builtin_amdgcn_rsqf(nn), 1e12f);
            ldf8(a.in[I_KA] + col, c1); ldf8(a.in[I_RK] + col, c2);
            float bs = 0.f;
#pragma unroll
            for (int e = 0; e < 8; ++e) { q[e] *= invn; km[e] = k_[e] * (1.f + (as_[e] - 1.f) * c1[e]); bb[e] = q[e] * as_[e]; bs += r[e] * km[e] * c2[e]; }
            bs = red8(bs);
            if (oc == 0) *(float*)(slot + CK_BS + st * 4) = bs;
#pragma unroll
            for (int e = 0; e < 8; ++e) *(LAS float*)(ldj + PL_LDT + ((8 * oc + e) * 17 + st) * 4) = ld[e];
#pragma unroll
            for (int e = 0; e < 8; e += 2) { const unsigned pv2 = pk2(v_[e], v_[e + 1]);
                *(LAS bf16*)(ldj + PL_VT + (8 * oc + e) * CK_VTS + st * 2) = (bf16)(pv2 & 0xffffu); *(LAS bf16*)(ldj + PL_VT + (8 * oc + e + 1) * CK_VTS + st * 2) = (bf16)(pv2 >> 16); } }
        __syncthreads();
        {
            LAS unsigned char* lds = lds0 + (w >> 1) * PL_END; const int r_ = lane & 31, hh = lane >> 5, ch = 32 * (w & 1) + r_;
            float x[8];
#pragma unroll
            for (int j = 0; j < 8; ++j) x[j] = *(const LAS float*)(lds + PL_LDT + (ch * 17 + 8 * hh + j) * 4);
            const u32x4 ph = {pk2(x[0], x[1]), pk2(x[2], x[3]), pk2(x[4], x[5]), pk2(x[6], x[7])};
            const u32x4 pl = {pk2(x[0] - bflo(ph.x), x[1] - bfhi(ph.x)), pk2(x[2] - bflo(ph.y), x[3] - bfhi(ph.y)), pk2(x[4] - bflo(ph.z), x[5] - bfhi(ph.z)), pk2(x[6] - bflo(ph.w), x[7] - bfhi(ph.w))};
            f32x16 cs; for (int e = 0; e < 16; ++e) cs[e] = 0.f;
            cs = MFMA32(lfrag, __builtin_bit_cast(bf16x8, ph), cs); cs = MFMA32(lfrag, __builtin_bit_cast(bf16x8, pl), cs);
#pragma unroll
            for (int e = 0; e < 8; ++e) *(LAS float*)(lds + PL_C + (((e & 3) + 8 * (e >> 2) + 4 * hh) * 64 + ch) * 4) = cs[e];
            if (hh == 0) *(LAS float*)(lds + PL_T + ch * 4) = cs[8]; }
        __syncthreads();
        {
            float c[8], t[8];
            { const f32x4 ca = *(const LAS f32x4*)(ldj + PL_C + (st * 64 + 8 * oc) * 4), cb = *(const LAS f32x4*)(ldj + PL_C + (st * 64 + 8 * oc + 4) * 4), ta = *(const LAS f32x4*)(ldj + PL_T + 8 * oc * 4), tb = *(const LAS f32x4*)(ldj + PL_T + (8 * oc + 4) * 4);
              c[0] = ca.x; c[1] = ca.y; c[2] = ca.z; c[3] = ca.w; c[4] = cb.x; c[5] = cb.y; c[6] = cb.z; c[7] = cb.w; t[0] = ta.x; t[1] = ta.y; t[2] = ta.z; t[3] = ta.w; t[4] = tb.x; t[5] = tb.y; t[6] = tb.z; t[7] = tb.w; }
            float at[8], bt[8], kt[8], rt[8], bhv[8], khv[8];
#pragma unroll
            for (int e = 0; e < 8; ++e) { const float g = __expf(c[e]), gp = __expf(c[e] - ld[e]), gi = __expf(-c[e]), gr = __expf(t[e] - c[e]);
                at[e] = -q[e] * gp; bt[e] = bb[e] * gi; kt[e] = km[e] * gi; rt[e] = r[e] * g; bhv[e] = bb[e] * gr; khv[e] = km[e] * gr; }
            LAS unsigned char* row = ldj + st * 144 + oc * 16;
            *(LAS u32x4*)(row + PL_AT) = pack8(at); *(LAS u32x4*)(row + PL_BT) = pack8(bt); *(LAS u32x4*)(row + PL_KT) = pack8(kt); *(LAS u32x4*)(row + PL_RT) = pack8(rt);
            *(LAS u32x4*)(row + PL_BH) = pack8(bhv); *(LAS u32x4*)(row + PL_KH) = pack8(khv);
            if (st == 0) { *(f32x4*)(slot + CK_G15 + 8 * oc * 4) = (f32x4){__expf(t[0]), __expf(t[1]), __expf(t[2]), __expf(t[3])}; *(f32x4*)(slot + CK_G15 + (8 * oc + 4) * 4) = (f32x4){__expf(t[4]), __expf(t[5]), __expf(t[6]), __expf(t[7])}; } }
        __syncthreads();
        if (w < PJ) {
            LAS unsigned char* lds = lds0 + w * PL_END; unsigned char* slot = ck_slot(a.ws, job0 + w); const int r = lane & 31, hh = lane >> 5, r16 = r & 15;
            f32x16 d; for (int e = 0; e < 16; ++e) d[e] = 0.f;
#pragma unroll
            for (int ks = 0; ks < 4; ++ks) d = MFMA32(ldfrag(lds + (r < 16 ? PL_BT : PL_KT) + r16 * 144 + ks * 32 + hh * 16), ldfrag(lds + (r < 16 ? PL_AT : PL_RT) + r16 * 144 + ks * 32 + hh * 16), d);
            float lo8[8], hi8[8];
#pragma unroll
            for (int e = 0; e < 8; ++e) { const int sr = (e & 3) + 8 * (e >> 2) + 4 * hh; const bool keep = r < 16 ? sr < r16 : sr <= r16; lo8[e] = keep ? d[e] : 0.f; hi8[e] = keep ? d[8 + e] : 0.f; }
            const u32x4 plo = {pk2(lo8[0], lo8[1]), pk2(lo8[2], lo8[3]), pk2(lo8[4], lo8[5]), pk2(lo8[6], lo8[7])}, phi = {pk2(hi8[0], hi8[1]), pk2(hi8[2], hi8[3]), pk2(hi8[4], hi8[5]), pk2(hi8[6], hi8[7])};
            if (r < 16) {
#pragma unroll
                for (int e = 0; e < 8; ++e) *(LAS float*)(lds + PL_NAB + (((e & 3) + 8 * (e >> 2) + 4 * hh) * 16 + r16) * 4) = lo8[e];
                *(u32x4*)(slot + CK_NK + (r16 + 16 * hh) * 16) = phi; }
            else { *(u32x4*)(slot + CK_PB + (r16 + 16 * hh) * 16) = plo; *(u32x4*)(slot + CK_PK + (r16 + 16 * hh) * 16) = phi; }
            asm volatile("s_waitcnt lgkmcnt(0)" ::: "memory");
            if (lane < 16) { float mr[16]; int ln = lane; asm volatile("" : "+v"(ln));
#pragma unroll
                for (int t = 0; t < 16; ++t) { float acc = (ln == t) ? 1.f : 0.f;
#pragma unroll
                    for (int u = 0; u < t; ++u) acc += mr[u] * *(const LAS float*)(lds + PL_NAB + (u * 16 + t) * 4);
                    mr[t] = acc; *(LAS bf16*)(lds + PL_MTS + t * 48 + lane * 2) = f2bf(acc); } }
            asm volatile("s_waitcnt lgkmcnt(0)" ::: "memory");
            if (r < 16) *(u32x4*)(slot + CK_MT + (r + 16 * hh) * 16) = ld2x8(lds + PL_MTS + r * 48 + 8 * hh, lds + PL_MTS + r * 48 + 16 + 8 * hh);
        } else {
            const int e2 = tid - 256;
#pragma unroll
            for (int q4 = 0; q4 < PJ; ++q4) { const LAS unsigned char* lds = lds0 + q4 * PL_END; unsigned char* slot = ck_slot(a.ws, job0 + q4);
                { const int arr = e2 >> 7, i7 = e2 & 127, ks = i7 >> 5, t = i7 & 15, hh = (i7 >> 4) & 1;
                  const LAS unsigned char* p = lds + (arr ? PL_RT : PL_AT) + t * 144 + (16 * ks + 4 * hh) * 2;
                  *(u32x4*)(slot + (arr ? CK_RT : CK_AT) + (ks * 32 + t + 16 * hh) * 16) = ld2x8(p, p + 16); }
                { const int arr = e2 >> 7, J = (e2 >> 6) & 1;
                  const LAS unsigned char* p = lds + (arr ? PL_KH : PL_BH) + (4 * (lane >> 5) + ((lane >> 2) & 3)) * 144 + (32 * J + 16 * ((lane >> 4) & 1)) * 2 + 8 * (lane & 3);
                  const s16x4 lo = __builtin_amdgcn_ds_read_tr16_b64_v4i16((LAS s16x4*)p), hi = __builtin_amdgcn_ds_read_tr16_b64_v4i16((LAS s16x4*)(p + 8 * 144));
                  *(bf16x8*)(slot + (arr ? CK_KH : CK_BH) + (J * 64 + lane) * 16) = __builtin_shufflevector(lo, hi, 0, 1, 2, 3, 4, 5, 6, 7); }
                if (e2 < 160) *(u32x4*)(slot + CK_VT + e2 * 16) = *(const LAS u32x4*)(lds + PL_VT + e2 * 16); }
        }
    }
    __syncthreads();
}
constexpr int RC_NS = 8, RC_SLOT = 15360, RC_GG = 13312, RC_AHEAD = 6, RC_Y = RC_NS * RC_SLOT;
static_assert(RC_Y + 8192 <= RING_BYTES && CK_SLOT <= RC_GG, "rwkv ring");
template <int PM = 0> DI void rwkv_chunk_rec(const KArgs& a, LAS unsigned char* lds, int unit, int half, int wv) {
    const int tid = otid(wv), lane = tid & 63, w = __builtin_amdgcn_readfirstlane(tid >> 6), r = lane & 31, hh = lane >> 5;
    const int b = unit / 24, h = unit % 24;
    float* GST = (float*)(a.ws + A_GST) + (size_t)unit * 4096;
    const unsigned char* GGb = a.ws + A_GG; bf16* MIX = (bf16*)(a.ws + WS_H);
#define RC_DMA(srcp, dstp) __builtin_amdgcn_global_load_lds((const unsigned*)(srcp), (LAS unsigned*)(dstp), 16, 0, 2)
#define RC_ISSUE(cc) do { if ((PM & 1) == 0 && (w == 4 || w == 5)) { const unsigned char* src = ck_slot(a.ws, unit * CK_HALF + (cc)) + lane * 16; LAS unsigned char* dst = lds + ((cc) % RC_NS) * RC_SLOT; \
        if (w == 4) { _Pragma("unroll") for (int i_ = 0; i_ < 8; ++i_) RC_DMA(src + i_ * 1024, dst + i_ * 1024); } \
        else { _Pragma("unroll") for (int i_ = 8; i_ < 13; ++i_) RC_DMA(src + i_ * 1024, dst + i_ * 1024); \
            const unsigned char* gsrc = GGb + ((size_t)b * SEQ + (half * CK_HALF + (cc)) * 16 + (lane >> 3)) * (RWW * 2) + h * 128 + (lane & 7) * 16; \
            RC_DMA(gsrc, dst + RC_GG); RC_DMA(gsrc + 8 * RWW * 2, dst + RC_GG + 1024); } } } while (0)
#define RC_BAR() do { asm volatile("s_waitcnt lgkmcnt(0)" ::: "memory"); __builtin_amdgcn_s_barrier(); asm volatile("" ::: "memory"); } while (0)
    const bool epi = (w & 2) != 0; const int et = 4 * ((w & 1) + 2 * (w >> 2)) + (lane >> 4), eiq = lane & 15, ecol = h * 64 + 4 * eiq;
    const f32x4 elg = *(const f32x4*)(a.in[I_LNXG] + ecol), elb = *(const f32x4*)(a.in[I_LNXB] + ecol);
#define RC_EPI(sp, Yp, tokv) do { const f32x4 y = *(const LAS f32x4*)((Yp) + et * 64 + 4 * eiq); const u32x2 gq = *(const LAS u32x2*)((sp) + RC_GG + et * 128 + eiq * 8); \
        const float bsv = *(const LAS float*)((sp) + CK_BS + et * 4); const LAS unsigned char* vq = (sp) + CK_VT + 4 * eiq * CK_VTS + et * 2; \
        const f32x4 v4 = {bflo(*(const LAS unsigned short*)vq), bflo(*(const LAS unsigned short*)(vq + CK_VTS)), bflo(*(const LAS unsigned short*)(vq + 2 * CK_VTS)), bflo(*(const LAS unsigned short*)(vq + 3 * CK_VTS))}; \
        const float mean = red16((y.x + y.y) + (y.z + y.w)) * (1.f / 64.f); const f32x4 d = y - mean; \
        const float rstd = __builtin_amdgcn_rsqf(red16((d.x * d.x + d.y * d.y) + (d.z * d.z + d.w * d.w)) * (1.f / 64.f) + 64e-5f); \
        const f32x4 gg4 = {bflo(gq.x), bfhi(gq.x), bflo(gq.y), bfhi(gq.y)}, o = (d * rstd * elg + elb + v4 * bsv) * gg4; \
        if (PM == 0 || o.x == 1.2345f) *(unsigned*)((unsigned char*)MIX + (size_t)(tokv) * 2048 + 512 + ecol) = pk4_fp8(o.x, o.y, o.z, o.w); } while (0)
    f32x16 G0, G1;
#pragma unroll
    for (int e = 0; e < 16; ++e) { G0[e] = 0.f; G1[e] = 0.f; }
    if (half == 1 && w < 2) {
#pragma unroll
        for (int e = 0; e < 16; ++e) { G0[e] = GST[(w * 2 + 0) * 1024 + e * 64 + lane]; G1[e] = GST[(w * 2 + 1) * 1024 + e * 64 + lane]; } }
    __syncthreads();
#pragma unroll
    for (int cc = 0; cc < RC_AHEAD; ++cc) RC_ISSUE(cc);
    asm volatile("s_waitcnt vmcnt(0)" ::: "memory");
    RC_BAR();
    bf16x8 pAR[4], pNP, pVT;
#define RC_PRE(slotp) do { const LAS unsigned char* sp_ = (slotp); _Pragma("unroll") for (int ks = 0; ks < 4; ++ks) pAR[ks] = ldfrag(sp_ + ((r >> 4) ? CK_RT : CK_AT) + (ks * 32 + (r & 15) + 16 * hh) * 16); \
        pNP = ldfrag(sp_ + ((r >> 4) ? CK_PK : CK_NK) + ((r & 15) + 16 * hh) * 16); \
        { const LAS unsigned char* vq_ = sp_ + CK_VT + (32 * w + r) * CK_VTS + 8 * hh; const s16x4 vlo_ = *(const LAS s16x4*)vq_, vhi_ = *(const LAS s16x4*)(vq_ + 16); pVT = __builtin_shufflevector(vlo_, vhi_, 0, 1, 2, 3, 4, 5, 6, 7); } } while (0)
    if (w < 2) RC_PRE(lds);
    for (int c = 0; c < CK_HALF; ++c) {
        if (c + RC_AHEAD < CK_HALF) RC_ISSUE(c + RC_AHEAD);
        const LAS unsigned char* sb = lds + (c % RC_NS) * RC_SLOT;
        if (w < 2) {
            const int r16 = r & 15, up = r >> 4;
            bf16x8 fAR[4], fBH0, fBH1, fKH0, fKH1, fM, fNP, fPB; f32x4 gs0[4], gs1[4];
#pragma unroll
            for (int ks = 0; ks < 4; ++ks) fAR[ks] = pAR[ks];
            fNP = pNP; const bf16x8 vtf = pVT;
            __builtin_amdgcn_sched_barrier(0);
            fM = ldfrag(sb + CK_MT + (r16 + 16 * hh) * 16); fPB = ldfrag(sb + CK_PB + (r16 + 16 * hh) * 16);
            fBH0 = ldfrag(sb + CK_BH + lane * 16); fBH1 = ldfrag(sb + CK_BH + (64 + lane) * 16); fKH0 = ldfrag(sb + CK_KH + lane * 16); fKH1 = ldfrag(sb + CK_KH + (64 + lane) * 16);
#pragma unroll
            for (int g4 = 0; g4 < 4; ++g4) { gs0[g4] = *(const LAS f32x4*)(sb + CK_G15 + (8 * g4 + 4 * hh) * 4); gs1[g4] = *(const LAS f32x4*)(sb + CK_G15 + (32 + 8 * g4 + 4 * hh) * 4); }
            __builtin_amdgcn_sched_barrier(0);
            bf16x8 gf[4];
#pragma unroll
            for (int s2 = 0; s2 < 2; ++s2) { u32x4 p0 = {pk2(G0[8 * s2], G0[8 * s2 + 1]), pk2(G0[8 * s2 + 2], G0[8 * s2 + 3]), pk2(G0[8 * s2 + 4], G0[8 * s2 + 5]), pk2(G0[8 * s2 + 6], G0[8 * s2 + 7])};
                u32x4 p1 = {pk2(G1[8 * s2], G1[8 * s2 + 1]), pk2(G1[8 * s2 + 2], G1[8 * s2 + 3]), pk2(G1[8 * s2 + 4], G1[8 * s2 + 5]), pk2(G1[8 * s2 + 6], G1[8 * s2 + 7])};
                gf[s2] = __builtin_bit_cast(bf16x8, p0); gf[2 + s2] = __builtin_bit_cast(bf16x8, p1); }
            f32x16 XY;
#pragma unroll
            for (int e = 0; e < 16; ++e) XY[e] = 0.f;
#pragma unroll
            for (int ks = 0; ks < 4; ++ks) XY = MFMA32(fAR[ks], gf[ks], XY);
            XY = MFMA32(fNP, vtf, XY);
            { u32x4 px = {pk2(XY[0], XY[1]), pk2(XY[2], XY[3]), pk2(XY[4], XY[5]), pk2(XY[6], XY[7])}; const bf16x8 xf = __builtin_bit_cast(bf16x8, px);
              f32x16 U; for (int e = 0; e < 16; ++e) U[e] = 0.f;
              U = MFMA32(fM, xf, U);
              u32x4 pu = {pk2(U[0], U[1]), pk2(U[2], U[3]), pk2(U[4], U[5]), pk2(U[6], U[7])}; const bf16x8 uf = __builtin_bit_cast(bf16x8, pu);
              XY = MFMA32(fPB, uf, XY);
#pragma unroll
              for (int e = 0; e < 16; ++e) { G0[e] *= gs0[e >> 2][e & 3]; G1[e] *= gs1[e >> 2][e & 3]; }
              G0 = MFMA32(fBH0, uf, G0); G1 = MFMA32(fBH1, uf, G1); G0 = MFMA32(fKH0, vtf, G0); G1 = MFMA32(fKH1, vtf, G1); }
            __builtin_amdgcn_sched_barrier(0);
            if (c + 1 < CK_HALF) RC_PRE(lds + ((c + 1) % RC_NS) * RC_SLOT);
            LAS float* Y = (LAS float*)(lds + RC_Y + (c & 1) * 4096);
#pragma unroll
            for (int e = 0; e < 8; ++e) Y[((e & 3) + 8 * (e >> 2) + 4 * hh) * 64 + 32 * w + r] = XY[8 + e];
        } else if (epi) {
            if (c > 0) RC_EPI(lds + ((c - 1) % RC_NS) * RC_SLOT, (const LAS float*)(lds + RC_Y + ((c - 1) & 1) * 4096), (size_t)b * SEQ + (half * CK_HALF + c - 1) * 16 + et);
        } else {
            if (c + RC_AHEAD >= CK_HALF) asm volatile("s_waitcnt vmcnt(0)" ::: "memory"); else if (w == 4) asm volatile("s_waitcnt vmcnt(32)" ::: "memory"); else asm volatile("s_waitcnt vmcnt(28)" ::: "memory");
        }
        RC_BAR();
    }
    if (epi) RC_EPI(lds + ((CK_HALF - 1) % RC_NS) * RC_SLOT, (const LAS float*)(lds + RC_Y + ((CK_HALF - 1) & 1) * 4096), (size_t)b * SEQ + (half * CK_HALF + CK_HALF - 1) * 16 + et);
    else if (w < 2 && half == 0 && (PM == 0 || G0[0] == 1.2345f)) {
#pragma unroll
        for (int e = 0; e < 16; ++e) { GST[(w * 2 + 0) * 1024 + e * 64 + lane] = G0[e]; GST[(w * 2 + 1) * 1024 + e * 64 + lane] = G1[e]; } }
    asm volatile("s_waitcnt vmcnt(0)" ::: "memory");
    __syncthreads();
#undef RC_PRE
#undef RC_EPI
#undef RC_DMA
#undef RC_ISSUE
#undef RC_BAR
}

constexpr int N_PHASES = 25;
__global__ void __launch_bounds__(512, 2) fwd(KArgs a) {
    extern __shared__ __attribute__((aligned(16))) unsigned char lds_[];
    LAS unsigned char* lds = (LAS unsigned char*)lds_;
    const int wv = __builtin_amdgcn_readfirstlane((int)threadIdx.x >> 6), G = gridDim.x, bid = blockIdx.x;
    volatile LAS unsigned* MISC = (volatile LAS unsigned*)(lds + LDS_MISC);
    if (wv == 0) MISC[lane_id()] = 0u;
    __syncthreads();
    unsigned char* ws0 = a.ws;
#if N_LAUNCH_MODE == 0
    XcdBarrier bar = xcd_barrier_post((unsigned*)(ws0 + CTL_BAR), MISC + 8, wv);
#ifdef DBG_TIME_K1
#define SEAM(k) do { if (IN(k) && IN((k) + 1)) xcd_barrier(bar); if (bid == 0 && wv == 0 && lane_id() == 0) ((unsigned long long*)(ws0 + CTL_CHK))[1 + (k)] = __builtin_amdgcn_s_memrealtime(); } while (0)
#else
#define SEAM(k) do { if (IN(k) && IN((k) + 1)) xcd_barrier(bar); } while (0)
#endif
#else
#define SEAM(k) do { } while (0)
#endif
    const int lo = a.ph_lo, hi = a.ph_hi;
#ifdef DBG_TIME_K1
    if (bid == 0 && wv == 0 && lane_id() == 0) ((unsigned long long*)(ws0 + CTL_CHK))[0] = __builtin_amdgcn_s_memrealtime();
#endif
#ifndef PH_MASK
#define PH_MASK 0xFFFFFFFFu
#endif
#define IN(k) (((PH_MASK >> (k)) & 1u) && lo <= (k) && (k) < hi)
#ifndef REP_REC
#define REP_REC 0
#endif
#ifndef REP_DIL
#define REP_DIL 0
#endif
#ifndef REPEAT_MASK
#define REPEAT_MASK 0u
#endif
#define PH(k) for (int rp_ = 0; rp_ < (IN(k) ? 1 + (int)((REPEAT_MASK >> (k)) & 1u) : 0); ++rp_)
#define MOD ((float*)(ws + CTL_MOD))
#define Hb ((bf16*)(ws + WS_H))
#define X1 ((bf16*)(ws + WS_X1))
#define XPRE ((bf16*)(ws + A_XPRE))
    pg8::StaticOrder SO;

    PH(0) { unsigned char* ws = wsl(a.ws); p0_prologue(a, lds, wv); } SEAM(0);
    PH(1) { unsigned char* ws = wsl(a.ws); modulate_rows(a.in[I_X], (const unsigned long long*)(ws + CTL_MODI), MOD, Hb, lds, wv); } SEAM(1);
    PH(2) { unsigned char* ws = wsl(a.ws); pg8::Gemm g{Hb, (const bf16*)(ws + WS_W_IN0), 2048, 2048, 2048}; SO.init(T, 2048, G, bid);
        EpiIn0 E{(bf16*)(ws + A_QC), (bf16*)(ws + A_KVC), (bf16*)(ws + A_KR), (bf16*)(ws + A_XH), (float*)(ws + CTL_SSQ)};
        pg8::gemm_phase<EpiIn0, pg8::StaticOrder, false, true>(lds, g, SO, E, wv); } SEAM(2);
    PH(3) { unsigned char* ws = wsl(a.ws);
        krope_pass((const bf16*)(ws + A_KR), (const float*)(ws + WS_ROPE), (bf16*)(ws + A_KF), wv);
        { pg8::Gemm g{(const bf16*)(ws + A_QC), (const bf16*)(ws + WS_W_UQ), 512, 512, 512}; SO.init(T, 1536, G, bid);
          EpiQ E{(bf16*)(ws + A_Q), (const float*)(ws + CTL_SSQ), (const float*)(ws + WS_ROPE)}; pg8::gemm_phase<EpiQ, pg8::StaticOrder, false>(lds, g, SO, E, wv); }
        { pg8::Gemm g{(const bf16*)(ws + A_KVC), (const bf16*)(ws + WS_W_UKV), 256, 256, 256}; SO.init(T, 2048, G, bid);
          EpiKV E{(bf16*)(ws + A_KF), (bf16*)(ws + A_V), (const float*)(ws + CTL_SSQ)}; pg8::gemm_phase<EpiKV, pg8::StaticOrder, false>(lds, g, SO, E, wv); }
        { pg8::Gemm g{(const bf16*)(ws + A_XH), (const bf16*)(ws + WS_S5BE), 384, 256, 256}; S5Order S{G, bid}; EpiS5E E{(float*)(ws + A_ES)}; pg8::gemm_phase<EpiS5E, S5Order, false>(lds, g, S, E, wv); }
    } SEAM(3);
    PH(4) { unsigned char* ws = wsl(a.ws);
        s5_carry((const float*)(ws + A_ES), (const float*)(ws + WS_S5L), (bf16*)(ws + A_XH), lds, wv);
        for (int u = bid; u < 256; u += G) mla_attn_unit(lds, (const bf16*)(ws + A_Q), (const bf16*)(ws + A_KF), (const bf16*)(ws + A_V), Hb, u, wv);
    } SEAM(4);
    PH(5) { unsigned char* ws = wsl(a.ws); pg8::Gemm g{(const bf16*)(ws + A_XH), (const bf16*)(ws + WS_S5BY), 384, 384, 384}; S5Order S{G, bid};
        EpiS5Y E{(bf16*)(ws + A_YS5), (const bf16*)(ws + A_XH), a.in[I_S5D]}; pg8::gemm_phase<EpiS5Y, S5Order, false>(lds, g, S, E, wv); } SEAM(5);
    PH(6) { unsigned char* ws = wsl(a.ws); pg8::Gemm g{(const bf16*)(ws + A_YS5), (const bf16*)(ws + WS_W_GLU), 1024, 1024, 1024}; SO.init(T, 1024, G, bid);
        EpiGlu E{Hb, (const bf16*)(ws + A_YS5)}; pg8::gemm_phase<EpiGlu, pg8::StaticOrder, false>(lds, g, SO, E, wv); } SEAM(6);
    PH(7) { unsigned char* ws = wsl(a.ws); pg8::Gemm g{Hb, (const bf16*)(ws + WS_W_OUT0), 2048, 2048, 2048}; SO.init(T, 2048, G, bid);
        EpiRes<false> E{XPRE, a.in[I_X], MOD + 2 * 2048}; pg8::gemm_phase<EpiRes<false>, pg8::StaticOrder, false, true>(lds, g, SO, E, wv); } SEAM(7);
#define MOE_PHASES(layer, pb) \
        PH(pb) { unsigned char* ws = wsl(a.ws); ln_router_phase(a, lds, layer, XPRE, X1, Hb, wv); } SEAM(pb); \
        PH(pb + 1) { unsigned char* ws = wsl(a.ws); moe_table(a, lds, layer, wv); pg8::Gemm g{Hb, (const bf16*)(ws + WS_W_GU8), 2048, 2048, 2048}; \
            MoeOrder<4> S{G, bid, layer, (const LAS int*)(lds + LDS_TAB), (const int*)(ws + A_TOKL)}; EpiGateUp E{ws + A_ACT}; pg8::gemm_phase<EpiGateUp, MoeOrder<4>, true, true>(lds, g, S, E, wv); } SEAM(pb + 1); \
        PH(pb + 2) { unsigned char* ws = wsl(a.ws); moe_table(a, lds, layer, wv); pg8::Gemm g{(const bf16*)(ws + A_ACT), (const bf16*)(ws + WS_W_DN), 512, 512, 512}; \
            MoeOrder<8> S{G, bid, layer, (const LAS int*)(lds + LDS_TAB), (const int*)(ws + A_TOKL)}; EpiDown E{(bf16*)(ws + A_YS)}; pg8::gemm_phase<EpiDown, MoeOrder<8>, false, true>(lds, g, S, E, wv); } SEAM(pb + 2); \
        PH(pb + 3) { unsigned char* ws = wsl(a.ws); ln_ffn_phase(a, lds, layer, X1, a.out, layer == 0 ? Hb : nullptr, wv); } SEAM(pb + 3);
    MOE_PHASES(0, 8)
    PH(12) { unsigned char* ws = wsl(a.ws); pg8::Gemm g{Hb, (const bf16*)(ws + WS_W_IN1), 2048, 2048, 2048}; SO.init(T, 9728, G, bid);
        EpiIn1 E{(bf16*)(ws + A_ZD), (bf16*)(ws + A_ZR)}; pg8::gemm_phase<EpiIn1, pg8::StaticOrder, false, true>(lds, g, SO, E, wv); } SEAM(12);
    PH(13) { unsigned char* ws = wsl(a.ws); rwkv_prep((const bf16*)(ws + A_ZR), a.in[I_MU], (bf16*)(ws + A_LIN), wv); } SEAM(13);
    PH(14) { unsigned char* ws = wsl(a.ws);
        { pg8::Gemm g{(const bf16*)(ws + A_LIN), (const bf16*)(ws + WS_W_LORA), 384, 384, 128}; LoraOrder LO; LO.init(T, 3072, G, bid); LO.ko = 0;
          EpiLora E{(bf16*)(ws + A_WDEC), (bf16*)(ws + A_AA), (bf16*)(ws + A_GG), a.in[I_W0], a.in[I_A0], 0}; pg8::gemm_phase<EpiLora, LoraOrder, false>(lds, g, LO, E, wv); }
        { pg8::Gemm g{(const bf16*)(ws + A_LIN), (const bf16*)(ws + WS_W_LORA) + (size_t)3072 * 384, 384, 384, 256}; LoraOrder LO; LO.init(T, 1536, G, bid); LO.ko = 128;
          EpiLora E{(bf16*)(ws + A_WDEC), (bf16*)(ws + A_AA), (bf16*)(ws + A_GG), a.in[I_W0], a.in[I_A0], 12}; pg8::gemm_phase<EpiLora, LoraOrder, false>(lds, g, LO, E, wv); }
} SEAM(14);
    PH(15) { rwkv_chunk_prep(a, lds, 0, wv); } SEAM(15);
    PH(16) { unsigned char* ws = wsl(a.ws); if (bid < 96 || G <= 96) { for (int u = bid; u < 96; u += G) { rwkv_chunk_rec(a, lds, u, 0, wv); if (REP_REC) rwkv_chunk_rec<REP_REC>(a, lds, u, 0, wv); } }
        if (G <= 96 || bid >= 96) { const int nb_ = G <= 96 ? G : G - 96, b0_ = G <= 96 ? bid : bid - 96;
            DilPre P; if (b0_ < 768) dil_issue((const bf16*)(ws + A_ZD), (const float*)(ws + WS_BIAS), b0_, wv, P);
            for (int u = b0_; u < 768; u += nb_) dil_attn_unit(lds, (const bf16*)(ws + A_ZD), (const float*)(ws + WS_BIAS), (bf16*)(ws + A_DPO), (float*)(ws + A_DPM), (float*)(ws + A_DPL), u, u + nb_ < 768 ? u + nb_ : -1, P, wv); } } SEAM(16);
    PH(17) { rwkv_chunk_prep(a, lds, 1, wv); } SEAM(17);
    PH(18) { unsigned char* ws = wsl(a.ws); if (bid < 96 || G <= 96) { for (int u = bid; u < 96; u += G) { rwkv_chunk_rec(a, lds, u, 1, wv); if (REP_REC) rwkv_chunk_rec<REP_REC>(a, lds, u, 1, wv); } }
        if (G <= 96 || bid >= 96) { const int nb_ = G <= 96 ? G : G - 96, b0_ = G <= 96 ? bid : bid - 96;
            DilPre P; if (768 + b0_ < 1536) dil_issue((const bf16*)(ws + A_ZD), (const float*)(ws + WS_BIAS), 768 + b0_, wv, P);
            for (int u = 768 + b0_; u < 1536; u += nb_) dil_attn_unit(lds, (const bf16*)(ws + A_ZD), (const float*)(ws + WS_BIAS), (bf16*)(ws + A_DPO), (float*)(ws + A_DPM), (float*)(ws + A_DPL), u, u + nb_ < 1536 ? u + nb_ : -1, P, wv); } } SEAM(18);
    PH(19) { unsigned char* ws = wsl(a.ws); dil_merge((const bf16*)(ws + A_DPO), (const float*)(ws + A_DPM), (const float*)(ws + A_DPL), Hb, wv); } SEAM(19);
    PH(20) { unsigned char* ws = wsl(a.ws); pg8::Gemm g{Hb, (const bf16*)(ws + WS_W_OUT1), 2048, 2048, 2048}; SO.init(T, 2048, G, bid);
        EpiRes<true> E{XPRE, a.out, MOD + 4 * 12288 + 2 * 2048}; pg8::gemm_phase<EpiRes<true>, pg8::StaticOrder, false, true>(lds, g, SO, E, wv); } SEAM(20);
    MOE_PHASES(1, 21)
#undef MOE_PHASES
#ifdef DBG_TIME_K1
    {
        xcd_barrier(bar);
        const unsigned long long* ts = (const unsigned long long*)(ws0 + CTL_CHK);
        const unsigned long long t0 = ts[0], te = __builtin_amdgcn_s_memrealtime();
        const float tot = (float)(te - t0), f1 = (float)(ts[1 + DBG_TIME_K1] - t0) / tot, f2 = (float)(ts[1 + DBG_TIME_K2] - t0) / tot;
        const float c1 = sqrtf(100.f * f1);
        for (size_t i = (size_t)bid * 512 + wv * 64 + lane_id(); i < (size_t)T * D; i += (size_t)G * 512) a.out[i] = c1;
        xcd_barrier(bar);
        if (bid == 0 && wv == 0 && lane_id() == 0) a.out[0] = 100.f * f2;
    }
#endif
#undef IN
#undef SEAM
#undef MOD
#undef Hb
#undef X1
#undef XPRE
}


#ifdef DBG_DUMP_OFF
__global__ void dbg_dump(const unsigned char* ws, float* out) {
    const size_t n = (size_t)T * D;
    for (size_t i = (size_t)blockIdx.x * 256 + threadIdx.x; i < n; i += (size_t)gridDim.x * 256) {
#if defined(DBG_DUMP_RT)
        { const int m = (int)(i >> 11), c = (int)(i & 2047); const int* RTE = (const int*)(ws + A_RT); const float* RTW = (const float*)(RTE + 4 * T); out[i] = c < 2 ? (float)RTE[2 * m + c] : (c < 4 ? RTW[2 * m + c - 2] : 0.f); }
#elif DBG_DUMP_F32
        out[i] = ((const float*)(ws + DBG_DUMP_OFF))[i];
#else
        out[i] = bf2f(((const bf16*)(ws + DBG_DUMP_OFF))[i]);
#endif
    }
}
#endif
extern "C" void kernel_launch(void* const* d_in, const int* in_sizes, int n_in, void* d_out, int out_size, void* d_ws, size_t ws_size, hipStream_t stream) {
    static int grid = 0;
    if (grid == 0) {
        if (n_in != 41 || out_size != T * D || ws_size < WS_END) { fprintf(stderr, "kernel_launch: unexpected shapes: n_in %d out %d ws %zu (need %zu)\n", n_in, out_size, ws_size, (size_t)WS_END); grid = -1; return; }
        int dev = 0, cus = 0, per_cu = 0;
        if (hipGetDevice(&dev) != hipSuccess || hipDeviceGetAttribute(&cus, hipDeviceAttributeMultiprocessorCount, dev) != hipSuccess) { grid = -1; return; }
        if (hipFuncSetAttribute((const void*)fwd, hipFuncAttributeMaxDynamicSharedMemorySize, LDS_BYTES) != hipSuccess) { fprintf(stderr, "kernel_launch: hipFuncSetAttribute failed\n"); grid = -1; return; }
        if (hipOccupancyMaxActiveBlocksPerMultiprocessor(&per_cu, (const void*)fwd, 512, LDS_BYTES) != hipSuccess || per_cu < 1) fprintf(stderr, "kernel_launch: occupancy query says %d blocks/CU\n", per_cu);
        (void)hipGetLastError();
        grid = cus;
    }
    if (grid < 0) return;
    (void)hipMemsetAsync(d_ws, 0, CTL_ZERO_BYTES, stream);
#ifdef DBG_ZERO_WS
    (void)hipMemsetAsync((char*)d_ws + CTL_ZERO_BYTES, 0, WS_END - CTL_ZERO_BYTES, stream);
#endif
    KArgs a{};
    for (int i = 0; i < 41; ++i) a.in[i] = (const float*)d_in[i];
    a.out = (float*)d_out; a.ws = (unsigned char*)d_ws;
#if N_LAUNCH_MODE == 0
    a.ph_lo = 0; a.ph_hi = N_PHASES;
    hipLaunchKernelGGL(fwd, dim3(grid), dim3(512), LDS_BYTES, stream, a);
#else
#ifdef DBG_DUMP_AFTER
    for (int p = 0; p <= DBG_DUMP_AFTER; ++p) { a.ph_lo = p; a.ph_hi = p + 1; hipLaunchKernelGGL(fwd, dim3(grid), dim3(512), LDS_BYTES, stream, a); }
#ifdef DBG_DUMP_OFF
    hipLaunchKernelGGL(dbg_dump, dim3(2048), dim3(256), 0, stream, (const unsigned char*)d_ws, (float*)d_out);
#endif
#else
    for (int p = 0; p < N_PHASES; ++p) { a.ph_lo = p; a.ph_hi = p + 1; hipLaunchKernelGGL(fwd, dim3(grid), dim3(512), LDS_BYTES, stream, a); }
#endif
#endif
}
```
